# Optimizing an MI355X kernel written in HIP

```python
import math
import jax, jax.numpy as jnp
from jax import lax
import numpy as np

D_MODEL = 1024
BATCH = 4
SEQ = 4096
DEPTH = 4

N_MIXERS = 2
DILATED_GROUPS = ((128, 1), (512, 4), (2048, 16))
N_DIL_GROUPS = len(DILATED_GROUPS)
A_HEADS = 16
A_HEAD_DIM = D_MODEL // A_HEADS
ATTN_BLOCK = 128
ROPE_THETA = 10000.0
GDN_HEADS = 8
GDN_HEAD_DIM = D_MODEL // GDN_HEADS
GDN_WIDTH = GDN_HEADS * GDN_HEAD_DIM
CONV_WIDTH = 4
GDN_CHUNK = 64
N_EXPERTS = 64
TOP_K = 8
N_EXPERT_GROUPS = 8
TOPK_GROUPS = 4
EXPERT_DIM = 256
SHARED_DIM = 256
ROUTED_SCALE = 2.5
MOE_BLOCK = 128
ALPHA = (2 * DEPTH) ** 0.25
BETA = (8 * DEPTH) ** -0.25
LN_EPS = 1e-5
RMS_EPS = 1e-6

kernel_name = "hybrid_dilated_attn_gdn_moe_deepnorm"


def layer_norm(x, g, b):
    xf = x.astype(jnp.float32)
    mu = jnp.mean(xf, -1, keepdims=True)
    var = jnp.mean(jnp.square(xf - mu), -1, keepdims=True)
    return ((xf - mu) * lax.rsqrt(var + LN_EPS) * g + b).astype(x.dtype)


def modulate(x, c, w_ada, b_ada):
    shift, scale, gate = jnp.split(c @ w_ada + b_ada, 3, axis=-1)
    h = x * (1.0 + scale[:, None, :]) + shift[:, None, :]
    return h, 1.0 + gate[:, None, :]


def deepnorm_residual(x, y, gate, g, b):
    return layer_norm(ALPHA * x + gate * y, g, b)


def rotary(t, positions):
    half = t.shape[-1] // 2
    inv_freq = ROPE_THETA ** (-jnp.arange(half, dtype=jnp.float32) / half)
    ang = positions.astype(jnp.float32)[..., None] * inv_freq
    cos = jnp.cos(ang)[:, :, None, :]
    sin = jnp.sin(ang)[:, :, None, :]
    t1 = t[..., :half].astype(jnp.float32)
    t2 = t[..., half:].astype(jnp.float32)
    return jnp.concatenate([t1 * cos - t2 * sin, t2 * cos + t1 * sin], axis=-1)


def dilated_window_attention(q, k, v, window, dil):
    B, H, S, hd = q.shape
    steps = window // dil
    assert steps <= ATTN_BLOCK
    span = dil * ATTN_BLOCK
    Sp = -(-S // span) * span
    L = Sp // dil
    nb = L // ATTN_BLOCK
    pad = ((0, 0), (0, 0), (0, Sp - S), (0, 0))

    def by_residue(t):
        return jnp.pad(t, pad).reshape(B, H, L, dil, hd).transpose(0, 1, 3, 2, 4)

    def kv_blocks(t):
        t = jnp.pad(by_residue(t), ((0, 0), (0, 0), (0, 0), (ATTN_BLOCK, 0), (0, 0)))
        t = t.reshape(B, H, dil, nb + 1, ATTN_BLOCK, hd)
        return jnp.concatenate([t[:, :, :, :-1], t[:, :, :, 1:]], axis=-2)

    qb = by_residue(q).reshape(B, H, dil, nb, ATTN_BLOCK, hd)
    kb = kv_blocks(k)
    vb = kv_blocks(v)
    s = jnp.einsum('bhrnqd,bhrnkd->bhrnqk', qb, kb)
    qi = jnp.arange(ATTN_BLOCK)[:, None]
    kj = jnp.arange(2 * ATTN_BLOCK)[None, :]
    dist = qi + ATTN_BLOCK - kj
    band = (dist >= 0) & (dist <= steps)
    before_start = (jnp.arange(nb)[:, None, None] == 0) & (kj[None] < ATTN_BLOCK)
    valid = band[None] & ~before_start
    s = jnp.where(valid, s, -jnp.inf)
    m = jnp.max(s, axis=-1, keepdims=True)
    p = jnp.exp(s - m)
    l = jnp.sum(p, axis=-1, keepdims=True)
    o = jnp.einsum('bhrnqk,bhrnkd->bhrnqd', p, vb) / l
    lse = (m + jnp.log(l))[..., 0]
    o = o.reshape(B, H, dil, L, hd).transpose(0, 1, 3, 2, 4).reshape(B, H, Sp, hd)[:, :, :S]
    lse = lse.reshape(B, H, dil, L).transpose(0, 1, 3, 2).reshape(B, H, Sp)[:, :, :S]
    return o, lse


def dilated_attention_mixer(h, positions, w_in, w_out):
    B, S, D = h.shape
    proj = (h @ w_in).reshape(B, S, N_DIL_GROUPS, 3, A_HEADS, A_HEAD_DIM)
    scale = A_HEAD_DIM ** -0.5
    outs, lses = [], []
    for gi, (window, dil) in enumerate(DILATED_GROUPS):
        q = (rotary(proj[:, :, gi, 0], positions) * scale).transpose(0, 2, 1, 3)
        k = rotary(proj[:, :, gi, 1], positions).transpose(0, 2, 1, 3)
        v = proj[:, :, gi, 2].astype(jnp.float32).transpose(0, 2, 1, 3)
        o, lse = dilated_window_attention(q, k, v, window, dil)
        outs.append(o)
        lses.append(lse)
    wts = jax.nn.softmax(jnp.stack(lses), axis=0)
    o = jnp.sum(wts[..., None] * jnp.stack(outs), axis=0)
    o = o.transpose(0, 2, 1, 3).reshape(B, S, A_HEADS * A_HEAD_DIM).astype(h.dtype)
    return o @ w_out


def causal_depthwise_conv(x, w):
    K = w.shape[0]
    S = x.shape[1]
    xp = jnp.pad(x, ((0, 0), (K - 1, 0), (0, 0)))
    y = xp[:, 0:S] * w[0]
    for j in range(1, K):
        y = y + xp[:, j:j + S] * w[j]
    return y


def l2_normalize(t):
    return t * lax.rsqrt(jnp.sum(jnp.square(t), -1, keepdims=True) + RMS_EPS)


def gated_delta_rule(q, k, v, g, beta):
    B, S, H, dk = q.shape
    dv = v.shape[-1]
    C = GDN_CHUNK
    N = S // C

    def chunks(t):
        t = jnp.moveaxis(t.astype(jnp.float32), 2, 1)
        return t.reshape((B, H, N, C) + t.shape[3:])

    q, k, v, g, beta = chunks(q), chunks(k), chunks(v), chunks(g), chunks(beta)
    gc = jnp.cumsum(g, axis=-1)
    causal = jnp.tril(jnp.ones((C, C), bool))
    strict = jnp.tril(jnp.ones((C, C), bool), -1)
    decay = jnp.exp(jnp.where(causal, gc[..., :, None] - gc[..., None, :], -jnp.inf))
    kb = k * beta[..., None]
    lower = jnp.where(strict, jnp.einsum('bhnid,bhnjd->bhnij', kb, k) * decay, 0.0)
    a_mat = lower + jnp.eye(C, dtype=jnp.float32)
    rhs = jnp.concatenate([v * beta[..., None], kb * jnp.exp(gc)[..., None]], axis=-1)
    sol = lax.linalg.triangular_solve(a_mat, rhs, left_side=True, lower=True,
                                      unit_diagonal=True)
    u, w = sol[..., :dv], sol[..., dv:]
    qk = jnp.einsum('bhnid,bhnjd->bhnij', q, k) * decay
    qg = q * jnp.exp(gc)[..., None]
    kdec = k * jnp.exp(gc[..., -1:] - gc)[..., None]
    glast = jnp.exp(gc[..., -1])

    def step(state, xs):
        u_n, w_n, qk_n, qg_n, kdec_n, gl_n = xs
        v_new = u_n - jnp.einsum('bhcd,bhde->bhce', w_n, state)
        o = (jnp.einsum('bhcd,bhde->bhce', qg_n, state)
             + jnp.einsum('bhij,bhje->bhie', qk_n, v_new))
        state = state * gl_n[..., None, None] + jnp.einsum('bhcd,bhce->bhde', kdec_n, v_new)
        return state, o

    xs = tuple(jnp.moveaxis(t, 2, 0) for t in (u, w, qk, qg, kdec, glast))
    _, o = lax.scan(step, jnp.zeros((B, H, dk, dv), jnp.float32), xs)
    return o.transpose(1, 0, 3, 2, 4).reshape(B, S, H, dv)


def gated_deltanet_mixer(h, w_in, conv_w, a_log, dt_bias, norm_w, w_out):
    B, S, D = h.shape
    H, dh, W = GDN_HEADS, GDN_HEAD_DIM, GDN_WIDTH
    proj = h @ w_in
    qkv = jax.nn.silu(causal_depthwise_conv(proj[..., :3 * W], conv_w))
    z = proj[..., 3 * W:4 * W].astype(jnp.float32).reshape(B, S, H, dh)
    a = proj[..., 4 * W:4 * W + H].astype(jnp.float32)
    b = proj[..., 4 * W + H:].astype(jnp.float32)
    qkv = qkv.astype(jnp.float32).reshape(B, S, 3, H, dh)
    q = l2_normalize(qkv[:, :, 0]) * dh ** -0.5
    k = l2_normalize(qkv[:, :, 1])
    v = qkv[:, :, 2]
    beta = jax.nn.sigmoid(b)
    g = -jnp.exp(a_log.astype(jnp.float32)) * jax.nn.softplus(a + dt_bias)
    o = gated_delta_rule(q, k, v, g, beta)
    o = o * lax.rsqrt(jnp.mean(jnp.square(o), -1, keepdims=True) + RMS_EPS) * norm_w
    o = o * jax.nn.silu(z)
    return o.reshape(B, S, W).astype(h.dtype) @ w_out


def swiglu(x, w1, w3, w2):
    return (jax.nn.silu(x @ w1) * (x @ w3)) @ w2


def moe(h, router_w, router_bias, w1, w3, w2, ws1, ws3, ws2):
    B, S, D = h.shape
    T = B * S
    xt = h.reshape(T, D)
    scores = jax.nn.sigmoid((xt @ router_w).astype(jnp.float32))
    biased = scores + router_bias.astype(jnp.float32)
    grp = biased.reshape(T, N_EXPERT_GROUPS, N_EXPERTS // N_EXPERT_GROUPS)
    gscore = jnp.sum(lax.top_k(grp, 2)[0], axis=-1)
    _, gidx = lax.top_k(gscore, TOPK_GROUPS)
    gmask = jnp.any(gidx[..., :, None] == jnp.arange(N_EXPERT_GROUPS), axis=-2)
    emask = jnp.repeat(gmask, N_EXPERTS // N_EXPERT_GROUPS, axis=-1)
    _, eidx = lax.top_k(jnp.where(emask, biased, -jnp.inf), TOP_K)
    gates = jnp.take_along_axis(scores, eidx, axis=-1)
    gates = gates / jnp.sum(gates, -1, keepdims=True) * ROUTED_SCALE

    n_assign = T * TOP_K
    flat_e = eidx.reshape(-1)
    flat_tok = jnp.repeat(jnp.arange(T, dtype=jnp.int32), TOP_K)
    flat_w = gates.reshape(-1)
    order = jnp.argsort(flat_e)
    se, stok, sw = flat_e[order], flat_tok[order], flat_w[order]
    counts = jnp.bincount(flat_e, length=N_EXPERTS)
    start = jnp.cumsum(counts) - counts
    padded = (counts + MOE_BLOCK - 1) // MOE_BLOCK * MOE_BLOCK
    pend = jnp.cumsum(padded)
    pstart = pend - padded
    dest = pstart[se] + jnp.arange(n_assign) - start[se]
    n_blocks = -(-n_assign // MOE_BLOCK) + N_EXPERTS
    P = n_blocks * MOE_BLOCK
    row_tok = jnp.full((P,), T, jnp.int32).at[dest].set(stok)
    row_w = jnp.zeros((P,), jnp.float32).at[dest].set(sw)
    blk_e = jnp.minimum(jnp.searchsorted(pend, jnp.arange(n_blocks) * MOE_BLOCK, side='right'),
                        N_EXPERTS - 1)
    x_pad = jnp.concatenate([xt, jnp.zeros((1, D), xt.dtype)], axis=0)

    def expert_block(acc, blk):
        tok, wt, e = blk
        y = swiglu(x_pad[tok], w1[e], w3[e], w2[e])
        return acc.at[tok].add(y * wt[:, None].astype(y.dtype)), None

    acc, _ = lax.scan(expert_block, jnp.zeros((T + 1, D), xt.dtype),
                      (row_tok.reshape(n_blocks, MOE_BLOCK),
                       row_w.reshape(n_blocks, MOE_BLOCK), blk_e))
    out = acc[:T] + swiglu(xt, ws1, ws3, ws2)
    return out.reshape(B, S, D)


def setup_inputs(seed: int = 0) -> dict:
    key = jax.random.key(seed)
    ks = jax.random.split(key, 24)
    D = D_MODEL
    n_a = (DEPTH + 1) // 2
    n_b = DEPTH // 2
    H = GDN_HEADS

    def nrm(k, shape, s):
        return jax.random.normal(k, shape, jnp.float32) * s

    x = nrm(ks[0], (BATCH, SEQ, D), 1.0)
    c = nrm(ks[1], (BATCH, D), 1.0)
    positions = jnp.broadcast_to(jnp.arange(SEQ, dtype=jnp.int32), (BATCH, SEQ))
    ada_w = nrm(ks[2], (DEPTH, 2, D, 3 * D), 0.1 * D ** -0.5)
    ada_b = nrm(ks[3], (DEPTH, 2, 3 * D), 0.02)
    ln_g = 1.0 + nrm(ks[4], (DEPTH, 2, D), 0.02)
    ln_b = nrm(ks[5], (DEPTH, 2, D), 0.02)
    attn_w_in = nrm(ks[6], (n_a, D, N_DIL_GROUPS * 3 * A_HEADS * A_HEAD_DIM), D ** -0.5)
    attn_w_out = nrm(ks[7], (n_a, A_HEADS * A_HEAD_DIM, D), BETA * (A_HEADS * A_HEAD_DIM) ** -0.5)
    gdn_w_in = nrm(ks[8], (n_b, D, 4 * GDN_WIDTH + 2 * H), D ** -0.5)
    gdn_conv_w = nrm(ks[9], (n_b, CONV_WIDTH, 3 * GDN_WIDTH), CONV_WIDTH ** -0.5)
    gdn_a_log = jnp.log(jax.random.uniform(ks[10], (n_b, H), jnp.float32, 1.0, 16.0))
    dt = jnp.exp(jax.random.uniform(ks[11], (n_b, H), jnp.float32,
                                    math.log(1e-3), math.log(1e-1)))
    gdn_dt_bias = jnp.log(jnp.expm1(dt))
    gdn_norm_w = 1.0 + nrm(ks[12], (n_b, GDN_HEAD_DIM), 0.02)
    gdn_w_out = nrm(ks[13], (n_b, GDN_WIDTH, D), BETA * GDN_WIDTH ** -0.5)
    router_w = nrm(ks[14], (DEPTH, D, N_EXPERTS), D ** -0.5)
    router_bias = nrm(ks[15], (DEPTH, N_EXPERTS), 0.01)
    expert_w1 = nrm(ks[16], (DEPTH, N_EXPERTS, D, EXPERT_DIM), D ** -0.5)
    expert_w3 = nrm(ks[17], (DEPTH, N_EXPERTS, D, EXPERT_DIM), D ** -0.5)
    expert_w2 = nrm(ks[18], (DEPTH, N_EXPERTS, EXPERT_DIM, D), BETA * EXPERT_DIM ** -0.5)
    shared_w1 = nrm(ks[19], (DEPTH, D, SHARED_DIM), D ** -0.5)
    shared_w3 = nrm(ks[20], (DEPTH, D, SHARED_DIM), D ** -0.5)
    shared_w2 = nrm(ks[21], (DEPTH, SHARED_DIM, D), BETA * SHARED_DIM ** -0.5)
    return {"x": x, "c": c, "positions": positions, "ada_w": ada_w, "ada_b": ada_b,
            "ln_g": ln_g, "ln_b": ln_b, "attn_w_in": attn_w_in, "attn_w_out": attn_w_out,
            "gdn_w_in": gdn_w_in, "gdn_conv_w": gdn_conv_w, "gdn_a_log": gdn_a_log,
            "gdn_dt_bias": gdn_dt_bias, "gdn_norm_w": gdn_norm_w, "gdn_w_out": gdn_w_out,
            "router_w": router_w, "router_bias": router_bias, "expert_w1": expert_w1,
            "expert_w3": expert_w3, "expert_w2": expert_w2, "shared_w1": shared_w1,
            "shared_w3": shared_w3, "shared_w2": shared_w2}


def reference(x, c, positions, ada_w, ada_b, ln_g, ln_b, attn_w_in, attn_w_out,
              gdn_w_in, gdn_conv_w, gdn_a_log, gdn_dt_bias, gdn_norm_w, gdn_w_out,
              router_w, router_bias, expert_w1, expert_w3, expert_w2,
              shared_w1, shared_w3, shared_w2):
    for i in range(DEPTH):
        j = i // N_MIXERS
        h, gate = modulate(x, c, ada_w[i, 0], ada_b[i, 0])
        if i % N_MIXERS == 0:
            y = dilated_attention_mixer(h, positions, attn_w_in[j], attn_w_out[j])
        else:
            y = gated_deltanet_mixer(h, gdn_w_in[j], gdn_conv_w[j], gdn_a_log[j],
                                     gdn_dt_bias[j], gdn_norm_w[j], gdn_w_out[j])
        x = deepnorm_residual(x, y, gate, ln_g[i, 0], ln_b[i, 0])
        h, gate = modulate(x, c, ada_w[i, 1], ada_b[i, 1])
        y = moe(h, router_w[i], router_bias[i], expert_w1[i], expert_w3[i], expert_w2[i],
                shared_w1[i], shared_w3[i], shared_w2[i])
        x = deepnorm_residual(x, y, gate, ln_g[i, 1], ln_b[i, 1])
    return x
```

```cpp
#include <hip/hip_runtime.h>
#include <cstdio>
#include <cstdint>

#define GAS __attribute__((address_space(1)))
#define LAS __attribute__((address_space(3)))
typedef unsigned short bf16;
typedef unsigned u32x4 __attribute__((ext_vector_type(4)));
typedef unsigned u32x2 __attribute__((ext_vector_type(2)));
typedef float f32x2 __attribute__((ext_vector_type(2)));
typedef float f32x4 __attribute__((ext_vector_type(4)));
typedef float f32x16 __attribute__((ext_vector_type(16)));
typedef short bf16x8 __attribute__((ext_vector_type(8)));
typedef short s16x4 __attribute__((ext_vector_type(4)));
typedef __bf16 bf16x2_t __attribute__((ext_vector_type(2)));
#define DI __device__ __forceinline__

DI unsigned cvtpk(float lo, float hi) { f32x2 v = {lo, hi}; bf16x2_t b = __builtin_convertvector(v, bf16x2_t); return __builtin_bit_cast(unsigned, b); }
DI unsigned cvtpk_fp8(float a, float b, float c, float d) { int w = __builtin_amdgcn_cvt_pk_fp8_f32(a, b, 0, false); w = __builtin_amdgcn_cvt_pk_fp8_f32(c, d, w, true); return (unsigned)w; }
constexpr bool YS_BF16 = true;
constexpr bool YS_MERGED = true;
constexpr float YE_SCALE = 16.0f;
DI float silu_f(float a) { return a * __builtin_amdgcn_rcpf(1.0f + __expf(-a)); }
DI float bf_lo(unsigned u) { return __builtin_bit_cast(float, u << 16); }
DI float bf_hi(unsigned u) { return __builtin_bit_cast(float, u & 0xffff0000u); }
template <int M> DI float shx(float v) { return __builtin_bit_cast(float, __builtin_amdgcn_ds_swizzle(__builtin_bit_cast(int, v), (M << 10) | 0x1f)); }
DI float bperm(float v, int srclane) { return __builtin_bit_cast(float, __builtin_amdgcn_ds_bpermute(srclane << 2, __builtin_bit_cast(int, v))); }
DI float rdlane(float v, int l) { return __builtin_bit_cast(float, __builtin_amdgcn_readlane(__builtin_bit_cast(int, v), l)); }
template <int CTRL> DI float dppmov(float v) { return __builtin_bit_cast(float, __builtin_amdgcn_update_dpp(0, __builtin_bit_cast(int, v), CTRL, 0xf, 0xf, true)); }
DI float wave_sum(float v) { v += dppmov<0xB1>(v); v += dppmov<0x4E>(v); v += dppmov<0x141>(v); v += dppmov<0x140>(v); return (rdlane(v, 0) + rdlane(v, 16)) + (rdlane(v, 32) + rdlane(v, 48)); }
DI float wave_max(float v) { v = fmaxf(v, dppmov<0xB1>(v)); v = fmaxf(v, dppmov<0x4E>(v)); v = fmaxf(v, dppmov<0x141>(v)); v = fmaxf(v, dppmov<0x140>(v)); return fmaxf(fmaxf(rdlane(v, 0), rdlane(v, 16)), fmaxf(rdlane(v, 32), rdlane(v, 48))); }
#define LDS_WAIT() asm volatile("s_waitcnt lgkmcnt(0)" ::: "memory")
#define VM_WAIT() asm volatile("s_waitcnt vmcnt(0)" ::: "memory")

namespace pg8 {
constexpr int BM = 256, BK = 64, HALF = 128, HTB = HALF * BK * 2, STAGE_BYTES = 8 * HTB;
DI int lds_byte(int r, int c) { const int st = (r >> 4) * 2 + (c >> 5), rr = r & 15, cc = c & 31, ob = rr * 64 + cc * 2; return st * 1024 + (ob ^ (((ob >> 9) & 1) << 5)); }
DI void stage_rc(int b, int& R, int& C) { const int st = b / 1024, sb = b % 1024, swz = sb ^ (((sb >> 9) & 1) << 5); R = (st >> 1) * 16 + swz / 64; C = (st & 1) * 32 + (swz % 64) / 2; }
DI int perm32(int rho) { const int n = rho >> 4, i = rho & 15; return 8 * (i >> 2) + 4 * n + (i & 3); }

DI const char* rfl_ptr(const char* p) {
    const unsigned long long v = (unsigned long long)p; const unsigned lo = __builtin_amdgcn_readfirstlane((unsigned)v), hi = __builtin_amdgcn_readfirstlane((unsigned)(v >> 32));
    return (const char*)(const __attribute__((address_space(1))) char*)(((unsigned long long)hi << 32) | lo); }
struct Unit { unsigned a; unsigned b; int r0; int c0; int e; int rb; int nv; };

template <class Epi, class Sched, bool ALIGN_EPI, bool SP2>
DI void gemm_phase(const int tid, const void* wsbase, LAS unsigned char* lds, LAS int* idxlds, const int K, const Sched& S, const Epi& E) {
    const __amdgpu_buffer_rsrc_t rsrc = __builtin_amdgcn_make_buffer_rsrc((void*)wsbase, 0, 0xffffffff, 0x00020000);
    const int wid = __builtin_amdgcn_readfirstlane(tid >> 6), lane = tid & 63, wr = wid >> 2, wc = wid & 3, fr = lane & 15, fq = lane >> 4;
    const int nt = K / BK;
    unsigned voffB[2], voffA[2][2];
#pragma unroll
    for (int i = 0; i < 2; ++i) { int R, C; stage_rc(tid * 16 + i * 8192, R, C); const int Rb = Epi::PERM ? ((R & ~31) + perm32(R & 31)) : R;
        voffB[i] = (unsigned)(Rb * K + C) * 2u;
        voffA[0][i] = (unsigned)(R * K + C) * 2u; voffA[1][i] = (unsigned)((R + HALF) * K + C) * 2u; }
    const unsigned kstep = (unsigned)(BK * 2);
    const unsigned hstep = (unsigned)(HALF * K * 2);
    const unsigned ldsw = (unsigned)wid * 1024u;
    const int aoff = lds_byte(wr * 64 + fr, fq * 8), boff = lds_byte(wc * 32 + fr, fq * 8);
#define PG8_SA(b, h) (((b) * 2 + (h)) * HTB)
#define PG8_SB(b, h) ((4 + (b) * 2 + (h)) * HTB)
#define PG8_STAGE(bufoff, soff, voff) do { const int _so = __builtin_amdgcn_readfirstlane((int)(soff)); _Pragma("unroll") for (int _i = 0; _i < 2; ++_i) \
        __builtin_amdgcn_raw_ptr_buffer_load_lds(rsrc, (LAS void*)(lds + (bufoff) + ldsw + _i * 8192), 16, (int)(voff)[_i], _so, 0, 0); } while (0)
#define PG8_LDA(dst, b, h) do { _Pragma("unroll") for (int m = 0; m < 4; ++m) _Pragma("unroll") for (int k = 0; k < 2; ++k) dst[m][k] = *(const LAS bf16x8*)(lds + PG8_SA(b, h) + aoff + m * 2048 + k * 1024); } while (0)
#define PG8_LDB(dst, b, h) do { _Pragma("unroll") for (int n = 0; n < 2; ++n) _Pragma("unroll") for (int k = 0; k < 2; ++k) dst[n][k] = *(const LAS bf16x8*)(lds + PG8_SB(b, h) + boff + n * 2048 + k * 1024); } while (0)
#define PG8_MMA(ai, bj, At, Bt) do { __builtin_amdgcn_s_setprio(1); _Pragma("unroll") for (int m = 0; m < 4; ++m) _Pragma("unroll") for (int n = 0; n < 2; ++n) _Pragma("unroll") for (int k = 0; k < 2; ++k) \
        acc[ai][bj][m][n] = __builtin_amdgcn_mfma_f32_16x16x32_bf16(Bt[n][k], At[m][k], acc[ai][bj][m][n], 0, 0, 0); __builtin_amdgcn_s_setprio(0); } while (0)
#define PG8_WAIT_V(n) asm volatile("s_waitcnt vmcnt(" #n ")" ::: "memory")
#define PG8_WAIT_L(n) asm volatile("s_waitcnt lgkmcnt(" #n ")" ::: "memory")
#define PG8_BAR __builtin_amdgcn_s_barrier()
#define PG8_SCHED __builtin_amdgcn_sched_barrier(0)
#define PG8_IDX_ISSUE(u, slot) __builtin_amdgcn_raw_ptr_buffer_load_lds(rsrc, (LAS void*)(idxlds + (slot) * 256 + (wid & 3) * 64), 4, lane * 4, \
        __builtin_amdgcn_readfirstlane((int)(S.idxoff + (unsigned)((u).rb + (wid & 3) * 64) * 4u)), 0, 0)
#define PG8_IDX_READ(dst, h_, slot, nv_) do { int _t = tid; asm volatile("" : "+v"(_t));   \
        _Pragma("unroll") for (int _i = 0; _i < 2; ++_i) { int _R, _C; stage_rc(_t * 16 + _i * 8192, _R, _C); \
        const int _ix = ((h_) * HALF + _R) < (nv_) ? idxlds[(slot) * 256 + (h_) * HALF + _R] : S.padrow;        \
        dst[_i] = (unsigned)_ix * (unsigned)(K * 2) + (unsigned)(_C * 2); } } while (0)
    Unit cur, nxt; int ui = 0;
    if (!S.next(0, cur)) return;
    f32x4 acc[2][2][4][2];
#pragma unroll
    for (int a = 0; a < 2; ++a)
#pragma unroll
        for (int b = 0; b < 2; ++b)
#pragma unroll
            for (int m = 0; m < 4; ++m)
#pragma unroll
                for (int n = 0; n < 2; ++n) acc[a][b][m][n] = (f32x4){0.f, 0.f, 0.f, 0.f};
    bf16x8 At[4][2], B0[2][2], B1[2][2];
    unsigned cA = cur.a, cB = cur.b;
    if constexpr (Sched::GATHER || Epi::ROWAUX) {
        PG8_IDX_ISSUE(cur, 0); PG8_WAIT_V(0); PG8_BAR;     asm volatile("" ::: "memory");
        if constexpr (Sched::GATHER) { PG8_IDX_READ(voffA[0], 0, 0, cur.nv); PG8_IDX_READ(voffA[1], 1, 0, cur.nv); }
    }
    if constexpr (SP2) {
        PG8_STAGE(PG8_SB(0, 0), cB, voffB); PG8_STAGE(PG8_SB(0, 1), cB + hstep, voffB); PG8_STAGE(PG8_SA(0, 0), cA, voffA[0]); PG8_STAGE(PG8_SA(0, 1), cA, voffA[1]);
        if (wr == 1) PG8_BAR;
        PG8_WAIT_V(2); PG8_BAR;
        PG8_STAGE(PG8_SB(1, 0), cB + kstep, voffB); PG8_STAGE(PG8_SA(1, 0), cA + kstep, voffA[0]); PG8_STAGE(PG8_SB(1, 1), cB + hstep + kstep, voffB);
        PG8_WAIT_V(6); PG8_BAR;
    } else {
        PG8_STAGE(PG8_SB(0, 0), cB, voffB); PG8_STAGE(PG8_SA(0, 0), cA, voffA[0]); PG8_STAGE(PG8_SB(0, 1), cB + hstep, voffB); PG8_STAGE(PG8_SA(0, 1), cA, voffA[1]);
        if (wr == 1) PG8_BAR;
        PG8_WAIT_V(4); PG8_BAR;
        PG8_STAGE(PG8_SB(1, 0), cB + kstep, voffB); PG8_STAGE(PG8_SA(1, 0), cA + kstep, voffA[0]); PG8_STAGE(PG8_SB(1, 1), cB + hstep + kstep, voffB);
        PG8_WAIT_V(6); PG8_BAR;
    }
    for (;;) {
        const bool has_next = S.next(ui + 1, nxt);
        const unsigned nA = has_next ? nxt.a : cA, nB = has_next ? nxt.b : cB;
        for (int t = 0; t < nt; t += 2) {
            const bool last = (t == nt - 2);
            const unsigned a1 = cA + (unsigned)(t + 1) * kstep;
            const unsigned a2 = last ? nA : cA + (unsigned)(t + 2) * kstep, b2 = last ? nB : cB + (unsigned)(t + 2) * kstep;
            const unsigned a3 = a2 + kstep, b3 = b2 + kstep;
            if constexpr (Sched::GATHER || Epi::ROWAUX) { if (t == 0 && has_next) PG8_IDX_ISSUE(nxt, (ui + 1) % 3); }
            if constexpr (Sched::GATHER) { if (last && has_next) PG8_IDX_READ(voffA[0], 0, (ui + 1) % 3, nxt.nv); }
#define PG8_NEXT_H1() do { if constexpr (Sched::GATHER) { if (last && has_next) PG8_IDX_READ(voffA[1], 1, (ui + 1) % 3, nxt.nv); } } while (0)
            if constexpr (SP2) {
            PG8_LDB(B0, 0, 0); PG8_LDB(B1, 0, 1); PG8_SCHED; PG8_LDA(At, 0, 0); PG8_STAGE(PG8_SA(1, 1), a1, voffA[1]); PG8_NEXT_H1();
            PG8_WAIT_V(8); PG8_WAIT_L(0); PG8_BAR; PG8_MMA(0, 0, At, B0); PG8_MMA(0, 1, At, B1); PG8_BAR; PG8_SCHED;
            PG8_LDA(At, 0, 1); PG8_STAGE(PG8_SB(0, 0), b2, voffB); PG8_STAGE(PG8_SB(0, 1), b2 + hstep, voffB); PG8_STAGE(PG8_SA(0, 0), a2, voffA[0]);
            PG8_WAIT_V(8); PG8_WAIT_L(0); PG8_BAR; PG8_MMA(1, 0, At, B0); PG8_MMA(1, 1, At, B1); PG8_BAR; PG8_SCHED;
            PG8_LDB(B0, 1, 0); PG8_LDB(B1, 1, 1); PG8_SCHED; PG8_LDA(At, 1, 0); PG8_STAGE(PG8_SA(0, 1), a2, voffA[1]);
            PG8_WAIT_V(8); PG8_WAIT_L(0); PG8_BAR; PG8_MMA(0, 0, At, B0); PG8_MMA(0, 1, At, B1); PG8_BAR; PG8_SCHED;
            PG8_LDA(At, 1, 1); PG8_STAGE(PG8_SB(1, 0), b3, voffB); PG8_STAGE(PG8_SB(1, 1), b3 + hstep, voffB); PG8_STAGE(PG8_SA(1, 0), a3, voffA[0]);
            PG8_WAIT_V(8); PG8_WAIT_L(0); PG8_BAR; PG8_MMA(1, 0, At, B0); PG8_MMA(1, 1, At, B1); PG8_BAR; PG8_SCHED;
            } else {
            PG8_LDB(B0, 0, 0); PG8_SCHED; PG8_LDA(At, 0, 0); PG8_STAGE(PG8_SA(1, 1), a1, voffA[1]); PG8_NEXT_H1();
            PG8_WAIT_L(8); PG8_BAR; PG8_WAIT_L(0); PG8_MMA(0, 0, At, B0); PG8_BAR; PG8_SCHED;
            PG8_LDB(B1, 0, 1); PG8_STAGE(PG8_SB(0, 0), b2, voffB);
            PG8_BAR; PG8_WAIT_L(0); PG8_MMA(0, 1, At, B1); PG8_BAR;
            PG8_LDA(At, 0, 1); PG8_STAGE(PG8_SA(0, 0), a2, voffA[0]);
            PG8_BAR; PG8_WAIT_L(0); PG8_MMA(1, 0, At, B0); PG8_BAR; PG8_SCHED;
            PG8_STAGE(PG8_SB(0, 1), b2 + hstep, voffB);
            PG8_WAIT_V(6); PG8_BAR; PG8_MMA(1, 1, At, B1); PG8_BAR;
            PG8_LDB(B0, 1, 0); PG8_SCHED; PG8_LDA(At, 1, 0); PG8_STAGE(PG8_SA(0, 1), a2, voffA[1]);
            PG8_WAIT_L(8); PG8_BAR; PG8_WAIT_L(0); PG8_MMA(0, 0, At, B0); PG8_BAR; PG8_SCHED;
            PG8_LDB(B1, 1, 1); PG8_STAGE(PG8_SB(1, 0), b3, voffB);
            PG8_BAR; PG8_WAIT_L(0); PG8_MMA(0, 1, At, B1); PG8_BAR;
            PG8_LDA(At, 1, 1); PG8_STAGE(PG8_SA(1, 0), a3, voffA[0]);
            PG8_BAR; PG8_WAIT_L(0); PG8_MMA(1, 0, At, B0); PG8_BAR; PG8_SCHED;
            PG8_STAGE(PG8_SB(1, 1), b3 + hstep, voffB);
            PG8_WAIT_V(6); PG8_BAR; PG8_MMA(1, 1, At, B1); PG8_BAR;
            }
        }
        if constexpr (ALIGN_EPI) { if (wr == 0) PG8_BAR; }
        if constexpr (Epi::ROWAUX) E(acc, cur, wr, wc, fr, fq, idxlds + (ui % 3) * 256); else E(acc, cur, wr, wc, fr, fq);
        if (!has_next) break;
#pragma unroll
        for (int a = 0; a < 2; ++a)
#pragma unroll
            for (int b = 0; b < 2; ++b)
#pragma unroll
                for (int m = 0; m < 4; ++m)
#pragma unroll
                    for (int n = 0; n < 2; ++n) acc[a][b][m][n] = (f32x4){0.f, 0.f, 0.f, 0.f};
        cur = nxt; cA = nA; cB = nB; ++ui;
        if constexpr (ALIGN_EPI) { if (wr == 1) PG8_BAR; }
    }
    PG8_WAIT_V(0);
    if constexpr (!ALIGN_EPI) { if (wr == 0) PG8_BAR; }
    PG8_BAR;
#undef PG8_SA
#undef PG8_SB
#undef PG8_STAGE
#undef PG8_LDA
#undef PG8_LDB
#undef PG8_MMA
#undef PG8_WAIT_V
#undef PG8_WAIT_L
#undef PG8_BAR
#undef PG8_SCHED
#undef PG8_IDX_ISSUE
#undef PG8_IDX_READ
#undef PG8_NEXT_H1
}
}
constexpr int T_ = 16384, D_ = 1024, NB_ = 4, S_ = 4096, NEXP = 64, TOPK = 8;
constexpr int ECAP = 16384;
constexpr int PMAX = 163840;
constexpr float LN_EPS = 1e-5f, RMS_EPS = 1e-6f;
constexpr float ALPHA_DN = 1.6817928305074290f;
constexpr float QSCALE = 0.125f * 1.4426950408889634f;

namespace pg8 {
constexpr int NXCD = 8, WGM = 8;
struct DenseOrder {
    static constexpr bool GATHER = false;
    unsigned A, Bt; int K; int nM, nN, nwg, G, c; unsigned idxoff; static constexpr int padrow = 0;
    DI void init(size_t A_, size_t Bt_, int M, int N, int K_, int G_, int c_) { A = (unsigned)A_; Bt = (unsigned)Bt_; K = K_; nM = M / BM; nN = N / BM; nwg = nM * nN; G = G_; c = c_; idxoff = 0u; }
    DI bool next(int i, Unit& u) const {
        const long L = (long)i * G + c; if (L >= nwg) return false;
        int wgid = (int)L; { const int q = nwg / NXCD, r = nwg % NXCD, xcd = wgid % NXCD, off = wgid / NXCD; wgid = (xcd < r ? xcd * (q + 1) : r * (q + 1) + (xcd - r) * q) + off; }
        const int nig = WGM * nN, gid = wgid / nig, fm = gid * WGM, gsz = (nM - fm) < WGM ? (nM - fm) : WGM;
        const int pm = fm + ((wgid % nig) % gsz), pn = (wgid % nig) / gsz;
        u.a = A + (unsigned)(pm * BM * K * 2); u.b = Bt + (unsigned)(pn * BM * K * 2); u.r0 = pm * BM; u.c0 = pn * BM; u.e = 0; u.rb = 0; u.nv = BM; return true;
    }
};
template <bool GATH> struct MoeOrder {
    static constexpr bool GATHER = GATH;
    unsigned A, Bt; int K; int nct_log, nunits, G, c; unsigned idxoff; const LAS int* tileoff; const LAS int* ecnt; unsigned bstride; static constexpr int padrow = T_;
    DI bool next(int i, Unit& u) const {
        const long L = (long)i * G + c; if (L >= nunits) return false;
        int wgid = (int)L; { const int q = nunits / NXCD, r = nunits % NXCD, xcd = wgid % NXCD, off = wgid / NXCD; wgid = (xcd < r ? xcd * (q + 1) : r * (q + 1) + (xcd - r) * q) + off; }
        const int tile = wgid >> nct_log, pn = wgid & ((1 << nct_log) - 1);
        int e = 0;
#pragma unroll 1
        for (int j = 32; j >= 1; j >>= 1) { const int cand = e + j; if (tileoff[cand] <= tile) e = cand; }
        if (e < NEXP && tileoff[e + 1] <= tile) e += 1;
        e = __builtin_amdgcn_readfirstlane(e);
        u.e = e; u.r0 = tile * BM; u.c0 = pn * BM;
        { const int ti = tile - __builtin_amdgcn_readfirstlane(tileoff[e]); u.rb = e * ECAP + ti * BM; u.nv = __builtin_amdgcn_readfirstlane(ecnt[e]) - ti * BM; }
        u.a = GATH ? A : A + (unsigned)(tile * BM * K * 2);
        u.b = Bt + (unsigned)e * bstride + (unsigned)(pn * BM * K * 2);
        return true;
    }
};

struct EpiF32 {
    static constexpr bool PERM = false, ROWAUX = false;
    float* C; int ldc;
    DI void operator()(const f32x4 (&acc)[2][2][4][2], const Unit& u, int wr, int wc, int fr, int fq) const {
        const int row0 = u.r0 + wr * 64 + fr, col0 = u.c0 + wc * 32 + 4 * fq;
#pragma unroll
        for (int ai = 0; ai < 2; ++ai)
#pragma unroll
            for (int m = 0; m < 4; ++m) { float* rowp = C + (size_t)(row0 + ai * HALF + m * 16) * ldc + col0;
#pragma unroll
                for (int bj = 0; bj < 2; ++bj)
#pragma unroll
                    for (int n = 0; n < 2; ++n) *(f32x4*)(rowp + bj * HALF + n * 16) = acc[ai][bj][m][n]; }
    }
};
struct EpiBf16 {
    static constexpr bool PERM = true, ROWAUX = false;
    bf16* O; int ldc;
    DI void operator()(const f32x4 (&acc)[2][2][4][2], const Unit& u, int wr, int wc, int fr, int fq) const {
        const int row0 = u.r0 + wr * 64 + fr, col0 = u.c0 + wc * 32 + 8 * fq;
#pragma unroll
        for (int ai = 0; ai < 2; ++ai)
#pragma unroll
            for (int m = 0; m < 4; ++m) { bf16* rowp = O + (size_t)(row0 + ai * HALF + m * 16) * ldc + col0;
#pragma unroll
                for (int bj = 0; bj < 2; ++bj) { const f32x4 v0 = acc[ai][bj][m][0], v1 = acc[ai][bj][m][1];
                    u32x4 w; w.x = cvtpk(v0[0], v0[1]); w.y = cvtpk(v0[2], v0[3]); w.z = cvtpk(v1[0], v1[1]); w.w = cvtpk(v1[2], v1[3]);
                    *(u32x4*)(rowp + bj * HALF) = w; } }
    }
};
struct EpiQKV {
    static constexpr bool PERM = true, ROWAUX = false;
    bf16* QKV; const float* COS; const float* SIN;
    DI void operator()(const f32x4 (&acc)[2][2][4][2], const Unit& u, int wr, int wc, int fr, int fq) const {
        const int pn = u.c0 >> 8, g = pn / 12, which = (pn >> 2) % 3, hq = pn & 3;
        const int ldil = 2 * g, dil = 1 << ldil;
        const int idx = 4 * (wc & 1) + fq, b = u.r0 >> 12;
        const int row0 = u.r0 + wr * 64 + fr;
#pragma unroll
        for (int ai = 0; ai < 2; ++ai)
#pragma unroll
            for (int m = 0; m < 4; ++m) {
                const int r = row0 + ai * HALF + m * 16, t = r & (S_ - 1);
                const int prow = (t & (dil - 1)) * (S_ >> ldil) + (t >> ldil);
                f32x4 c4 = (f32x4){1.f, 1.f, 1.f, 1.f}, s4 = (f32x4){0.f, 0.f, 0.f, 0.f};
                if (which < 2) { c4 = *(const f32x4*)(COS + (size_t)r * 32 + 4 * idx); s4 = *(const f32x4*)(SIN + (size_t)r * 32 + 4 * idx); }
#pragma unroll
                for (int bj = 0; bj < 2; ++bj) {
                    const int head = 4 * hq + 2 * bj + (wc >> 1);
                    const f32x4 v0 = acc[ai][bj][m][0], v1 = acc[ai][bj][m][1];
                    f32x4 o0 = v0 * c4 - v1 * s4, o1 = v1 * c4 + v0 * s4;
                    if (which == 0) { o0 = o0 * QSCALE; o1 = o1 * QSCALE; }
                    u32x4 w; w.x = cvtpk(o0[0], o0[1]); w.y = cvtpk(o0[2], o0[3]); w.z = cvtpk(o1[0], o1[1]); w.w = cvtpk(o1[2], o1[3]);
                    bf16* dst = QKV + ((((size_t)(which * 3 + g) * NB_ + b) * 16 + head) * S_ + prow) * 64 + 8 * idx;
                    *(u32x4*)dst = w;
                }
            }
    }
};
struct EpiSwiGLU {
    static constexpr bool PERM = true, ROWAUX = false;
    bf16* HID;
    DI void operator()(const f32x4 (&acc)[2][2][4][2], const Unit& u, int wr, int wc, int fr, int fq) const {
        const int row0 = u.r0 + wr * 64 + fr, col0 = (u.c0 >> 1) + wc * 32 + 8 * fq;
#pragma unroll
        for (int ai = 0; ai < 2; ++ai)
#pragma unroll
            for (int m = 0; m < 4; ++m) {
                float hv[8];
#pragma unroll
                for (int n = 0; n < 2; ++n)
#pragma unroll
                    for (int j = 0; j < 4; ++j) { const float a = acc[ai][0][m][n][j], bb = acc[ai][1][m][n][j]; hv[4 * n + j] = silu_f(a) * bb; }
                u32x4 w; w.x = cvtpk(hv[0], hv[1]); w.y = cvtpk(hv[2], hv[3]); w.z = cvtpk(hv[4], hv[5]); w.w = cvtpk(hv[6], hv[7]);
                *(u32x4*)(HID + (size_t)(row0 + ai * HALF + m * 16) * 256 + col0) = w;
            }
    }
};
constexpr size_t YS_OFF = (size_t)160 << 20;
struct EpiScale {
    static constexpr bool PERM = true, ROWAUX = true;
    unsigned char* YE;
    int s0;
    DI void operator()(const f32x4 (&acc)[2][2][4][2], const Unit& u, int wr, int wc, int fr, int fq, const LAS int* aux) const {
        const int row0 = wr * 64 + fr, col0 = u.c0 + wc * 32 + 8 * fq;
        if (u.e == NEXP) {
            bf16* base = (bf16*)pg8::rfl_ptr((const char*)(YE + YS_OFF) + (size_t)(u.r0 - s0) * (D_ * 2));
#pragma unroll
            for (int ai = 0; ai < 2; ++ai)
#pragma unroll
                for (int m = 0; m < 4; ++m) { const unsigned ro = (unsigned)((row0 + ai * HALF + m * 16) * D_ + col0) * 2u;
#pragma unroll
                    for (int bj = 0; bj < 2; ++bj) { const f32x4 v0 = acc[ai][bj][m][0], v1 = acc[ai][bj][m][1];
                        u32x4 w; w.x = cvtpk(v0[0], v0[1]); w.y = cvtpk(v0[2], v0[3]); w.z = cvtpk(v1[0], v1[1]); w.w = cvtpk(v1[2], v1[3]);
                        *(u32x4*)((char*)base + ro + bj * HALF * 2) = w; } }
        } else {
            unsigned char* base = (unsigned char*)pg8::rfl_ptr((const char*)YE + (size_t)u.r0 * D_);
#pragma unroll
            for (int ai = 0; ai < 2; ++ai)
#pragma unroll
                for (int m = 0; m < 4; ++m) { const int rl = row0 + ai * HALF + m * 16; const float wgt = __builtin_bit_cast(float, aux[rl]) * YE_SCALE; const unsigned ro = (unsigned)(rl * D_ + col0);
#pragma unroll
                    for (int bj = 0; bj < 2; ++bj) { const f32x4 v0 = acc[ai][bj][m][0] * wgt, v1 = acc[ai][bj][m][1] * wgt;
                        u32x2 w; w.x = cvtpk_fp8(v0[0], v0[1], v0[2], v0[3]); w.y = cvtpk_fp8(v1[0], v1[1], v1[2], v1[3]);
                        *(u32x2*)(base + ro + bj * HALF) = w; } }
        }
    }
};
}
constexpr size_t MiB = 1u << 20;
constexpr size_t WS_CTL = 0, CTL_ZERO_BYTES = 1 * MiB;
constexpr size_t WS_MOD = 1 * MiB;
constexpr size_t WS_COS = 2 * MiB;
constexpr size_t WS_SIN = 4 * MiB;
constexpr size_t WS_ASG_E = 6 * MiB;
constexpr size_t WS_ASG_R = 6 * MiB + 512 * 1024;
constexpr size_t WS_ASG_W = 7 * MiB;
constexpr size_t WS_ASG_ROW = 7 * MiB + 512 * 1024;
constexpr size_t WS_ROWTOK = 8 * MiB;
constexpr size_t WS_ROWW = 9 * MiB;
constexpr size_t WS_AB = 10 * MiB;
constexpr size_t WS_GALPHA = 11 * MiB;
constexpr size_t WS_GBETA = 11 * MiB + 512 * 1024;
constexpr size_t WS_X = 12 * MiB;
constexpr size_t WS_Y = 76 * MiB;
constexpr size_t WS_H = 140 * MiB;
constexpr size_t WS_O = 173 * MiB;
constexpr size_t WS_WA_IN = 205 * MiB;
constexpr size_t WS_WA_OUT = 241 * MiB;
constexpr size_t WS_WG_IN = 245 * MiB;
constexpr size_t WS_WG_OUT = 261 * MiB;
constexpr size_t WS_WE1 = 265 * MiB;
constexpr size_t WS_WE2 = 330 * MiB;
constexpr size_t WS_HID = 363 * MiB;
constexpr size_t WS_BIG = 443 * MiB;
constexpr size_t WS_YS_OFF = pg8::YS_OFF;
constexpr size_t WS_WEB = WS_BIG + 368 * MiB;
constexpr size_t WS_WRF = WS_BIG + 466 * MiB;
constexpr size_t WS_WABF = WS_WRF + 1 * MiB;
constexpr size_t WS_ETOK = WS_WABF + 1 * MiB;
constexpr size_t WS_EW = WS_ETOK + 5 * MiB;
constexpr size_t WS_END = WS_EW + 5 * MiB;
constexpr size_t BIG_PROJ = 0, BIG_QN = 128 * MiB, BIG_KN = 192 * MiB, BIG_VV = 256 * MiB, BIG_ORAW = 320 * MiB;
constexpr int CW_BAR = 4096;
constexpr int CW_CNT = 16384;
constexpr int RING_BYTES = 131072;
constexpr int LDS_IDX = RING_BYTES;
constexpr int LDS_TILEOFF = LDS_IDX + 3072;
constexpr int LDS_LCNT = LDS_TILEOFF + 512;
constexpr int LDS_LBASE = LDS_LCNT + 256;
constexpr int LDS_LASG = LDS_LBASE + 256;
constexpr int LDS_ECNT = LDS_LASG;
constexpr int LDS_LW = LDS_IDX;
constexpr int LDS_MISC = LDS_LASG + 2048;
constexpr int LDS_LG = LDS_MISC + 128;
constexpr int LDS_BYTES = 147456;
static_assert(LDS_LG + 8192 <= LDS_BYTES, "LDS map");
constexpr int NWAVES = 8, NTHR = 512;

#define XB_TMO      128
#define XB_XCNT(j)  (256  + 64 * (j))
#define XB_XSUB(j)  (1280 + 64 * (j))
#define XB_XGEN(j)  (2304 + 64 * (j))
#define XB_TOP      3328
#define XB_TOPGEN   3392
#define XCD_BAR_WORDS 3456
#define XB_SPIN_CAP (1u << 18)
__device__ __forceinline__ unsigned xb_ld(unsigned* p)              { return __hip_atomic_load(p, __ATOMIC_RELAXED, __HIP_MEMORY_SCOPE_AGENT); }
__device__ __forceinline__ unsigned xb_add(unsigned* p, unsigned v) { return __hip_atomic_fetch_add(p, v, __ATOMIC_RELAXED, __HIP_MEMORY_SCOPE_AGENT); }
__device__ __forceinline__ unsigned xb_xcc_id() { return (unsigned)__builtin_amdgcn_s_getreg((3 << 11) | 20) & 0xFu; }
#define XB_SPIN(cond, bar) do { unsigned _sp = 0; while (cond) { __builtin_amdgcn_s_sleep(1); \
    if ((++_sp & 255u) == 0u) { if (xb_ld(&(bar)[XB_TMO])) break; if (_sp > XB_SPIN_CAP) { atomicAdd(&(bar)[XB_TMO], 1u); break; } } } } while (0)
struct XcdBarrier { unsigned* bar; unsigned x; volatile LAS unsigned* st; };
__device__ __forceinline__ XcdBarrier xcd_barrier_post(unsigned* bar, volatile LAS unsigned* st) {
    XcdBarrier b; b.bar = bar; b.x = xb_xcc_id(); b.st = st;
    if (threadIdx.x == 0) (void)xb_add(&bar[XB_XCNT(b.x)], 1u);
    return b;
}
__device__ __forceinline__ void xcd_barrier_complete(unsigned* bar, unsigned x, unsigned& nloc, unsigned& nx) {
    const unsigned G = gridDim.x * gridDim.y * gridDim.z;
    unsigned sum, cnt, mine, sp = 0u;
    for (;;) {
        sum = 0u; cnt = 0u; mine = 0u;
#pragma unroll
        for (unsigned j = 0; j < 16; ++j) { const unsigned c = xb_ld(&bar[XB_XCNT(j)]); sum += c; cnt += (c > 0u) ? 1u : 0u; mine = (j == x) ? c : mine; }
        if (sum == G) break;
        __builtin_amdgcn_s_sleep(1);
        if ((++sp & 255u) == 0u) { if (xb_ld(&bar[XB_TMO])) break; if (sp > XB_SPIN_CAP) { atomicAdd(&bar[XB_TMO], 1u); break; } }
    }
    nloc = mine > 0u ? mine : 1u; nx = cnt > 0u ? cnt : 1u;
}
__device__ __forceinline__ void xcd_barrier(const XcdBarrier& b, const int tid) {
    asm volatile("s_waitcnt vmcnt(0)" ::: "memory");
    __syncthreads();
    if (tid == 0) {
        unsigned* bar = b.bar;
        __builtin_amdgcn_s_waitcnt(0);
        unsigned nloc = b.st[0], nx = b.st[1];
        if (nloc == 0u) { xcd_barrier_complete(bar, b.x, nloc, nx); b.st[0] = nloc; b.st[1] = nx; }
        const unsigned old = xb_add(&bar[XB_XSUB(b.x)], 1u);
        const unsigned gen = old / nloc;
        if (old + 1u == (gen + 1u) * nloc) {
            __builtin_amdgcn_fence(__ATOMIC_RELEASE, "agent");
            asm volatile("s_waitcnt vmcnt(0)" ::: "memory");
            const unsigned og = xb_add(&bar[XB_TOP], 1u);
            const unsigned tg = og / nx;
            if (og + 1u == (tg + 1u) * nx) xb_add(&bar[XB_TOPGEN], 1u);
            else XB_SPIN(xb_ld(&bar[XB_TOPGEN]) == tg, bar);
            __builtin_amdgcn_fence(__ATOMIC_ACQUIRE, "agent");
            xb_add(&bar[XB_XGEN(b.x)], 1u);
            asm volatile("s_waitcnt vmcnt(0)" ::: "memory");
        } else {
            XB_SPIN(xb_ld(&bar[XB_XGEN(b.x)]) == gen, bar);
            __builtin_amdgcn_fence(__ATOMIC_ACQUIRE, "agent");
            asm volatile("s_waitcnt vmcnt(0)" ::: "memory");
        }
    }
    __syncthreads();
}

struct Args {
    const float* x; const float* c; const int* pos; const float* ada_w; const float* ada_b; const float* ln_g; const float* ln_b;
    const float* attn_w_in; const float* attn_w_out; const float* gdn_w_in; const float* gdn_conv_w; const float* gdn_a_log; const float* gdn_dt_bias;
    const float* gdn_norm_w; const float* gdn_w_out; const float* router_w; const float* router_bias; const float* ew1; const float* ew3; const float* ew2;
    const float* sw1; const float* sw3; const float* sw2;
    float* out; unsigned char* ws; int ph_lo, ph_hi;
};
typedef __attribute__((address_space(1))) unsigned char gas_u8;
DI unsigned char* opq(unsigned char* p) { gas_u8* g = (gas_u8*)p; asm volatile("" : "+s"(g)); return (unsigned char*)g; }
template <class T> DI T* asg(T* p) { typedef __attribute__((address_space(1))) T gT; return (T*)(gT*)p; }
struct Frame {
    LAS unsigned char* lds;
    int tid, lane, wave, G, bid;
};
template <class Map> DI void transpose_item(const float* W, int ldn, int K, bf16* WT, const Map& map, LAS float* scr, int kb, int nb, int lane) {
    const int k0 = 64 * kb, n0 = 32 * nb;
    float tv[32];
#pragma unroll
    for (int i = 0; i < 32; ++i) tv[i] = W[(size_t)(k0 + 2 * i + (lane >> 5)) * ldn + n0 + (lane & 31)];
#pragma unroll
    for (int i = 0; i < 32; ++i) scr[(2 * i + (lane >> 5)) * 33 + (lane & 31)] = tv[i];
    LDS_WAIT(); asm volatile("" ::: "memory");
    const int c = lane & 7;
#pragma unroll
    for (int j = 0; j < 4; ++j) { const int n = (lane >> 3) + 8 * j; const LAS float* s = scr + (8 * c) * 33 + n;
        u32x4 o; o.x = cvtpk(s[0 * 33], s[1 * 33]); o.y = cvtpk(s[2 * 33], s[3 * 33]); o.z = cvtpk(s[4 * 33], s[5 * 33]); o.w = cvtpk(s[6 * 33], s[7 * 33]);
        *(u32x4*)(WT + (size_t)map(n0 + n) * K + k0 + 8 * c) = o; }
    LDS_WAIT(); asm volatile("" ::: "memory");
}
struct MapId { int off; DI int operator()(int n) const { return off + n; } };
struct MapQKV { DI int operator()(int n) const {
    const int which = (n >> 10) % 3; if (which == 2) return n;
    const int d = n & 63, idx = (d & 31) >> 2, lo = d & 3, hi = d >> 5; return (n & ~63) + 8 * idx + 4 * hi + lo; } };
struct MapW13 { int second; DI int operator()(int n) const { return (n >> 7) * 256 + second * 128 + (n & 127); } };
template <class Map> DI void convert_matrix(const Frame& F, const float* W, int ldn, int K, int N, bf16* WT, const Map& map) {
    LAS float* scr = (LAS float*)(F.lds + F.wave * 16384);
    const int gw = F.bid * NWAVES + F.wave, NGW = F.G * NWAVES, nblk = N / 32, nitems = (K / 64) * nblk;
    for (int it = gw; it < nitems; it += NGW) transpose_item(W, ldn, K, WT, map, scr, it / nblk, it % nblk, F.lane);
}

DI void prologue_phase(const Frame& F, const Args& A) {
    unsigned char* ws = opq(A.ws);
    {
        LAS float* red = (LAS float*)F.lds;
        float* MOD = (float*)(ws + WS_MOD);
        for (int item = F.bid; item < 8 * 48; item += F.G) {
            const int ls = item / 48, n = (item % 48) * 64 + F.lane;
            const float* w = A.ada_w + ((size_t)ls * D_ + F.wave * 128) * 3072 + n;
            const float* cc = A.c + F.wave * 128;
            float a0 = 0.f, a1 = 0.f, a2 = 0.f, a3 = 0.f;
#pragma unroll 8
            for (int k = 0; k < 128; ++k) { const float wv = w[(size_t)k * 3072]; a0 += cc[k] * wv; a1 += cc[D_ + k] * wv; a2 += cc[2 * D_ + k] * wv; a3 += cc[3 * D_ + k] * wv; }
            red[(F.wave * 4 + 0) * 64 + F.lane] = a0; red[(F.wave * 4 + 1) * 64 + F.lane] = a1; red[(F.wave * 4 + 2) * 64 + F.lane] = a2; red[(F.wave * 4 + 3) * 64 + F.lane] = a3;
            __syncthreads();
            if (F.wave < 4) { float s = A.ada_b[ls * 3072 + n];
#pragma unroll
                for (int w8 = 0; w8 < 8; ++w8) s += red[(w8 * 4 + F.wave) * 64 + F.lane];
                MOD[((size_t)ls * 4 + F.wave) * 3072 + n] = s; }
            __syncthreads();
        }
    }
    {
        float* COS = (float*)(ws + WS_COS); float* SIN = (float*)(ws + WS_SIN);
        for (int idx = F.bid * NTHR + F.tid; idx < T_ * 32; idx += F.G * NTHR) {
            const int t = idx >> 5, i = idx & 31;
            const float inv = powf(10000.0f, -(float)i / 32.0f);
            const float ang = (float)A.pos[t] * inv;
            COS[idx] = cosf(ang); SIN[idx] = sinf(ang);
        }
    }
    {
        bf16* WRF = (bf16*)(ws + WS_WRF); bf16* WABF = (bf16*)(ws + WS_WABF);
        for (int idx = F.bid * NTHR + F.tid; idx < 4 * 4 * 32 * 64 * 8; idx += F.G * NTHR) {
            const int jx = idx & 7, ln = (idx >> 3) & 63, ks = (idx >> 9) & 31, nt = (idx >> 14) & 3, layer = idx >> 16;
            const int d = 32 * ks + 8 * (ln >> 4) + jx, e = 16 * nt + (ln & 15);
            const float wv = A.router_w[((size_t)layer * D_ + d) * NEXP + e];
            const unsigned hi = cvtpk(wv, 0.f) & 0xffffu; const float res = wv - bf_lo(hi);
            const size_t o = (size_t)layer * 2 * 65536 + (idx & 65535);
            WRF[o] = (bf16)hi; WRF[o + 65536] = (bf16)(cvtpk(res, 0.f) & 0xffffu);
        }
        for (int idx = F.bid * NTHR + F.tid; idx < 2 * 32 * 64 * 8; idx += F.G * NTHR) {
            const int jx = idx & 7, ln = (idx >> 3) & 63, ks = (idx >> 9) & 31, jl = idx >> 14;
            const int d = 32 * ks + 8 * (ln >> 4) + jx, e = ln & 15;
            const float wv = A.gdn_w_in[((size_t)jl * D_ + d) * 4112 + 4096 + e];
            const unsigned hi = cvtpk(wv, 0.f) & 0xffffu; const float res = wv - bf_lo(hi);
            const size_t o = (size_t)jl * 2 * 16384 + (idx & 16383);
            WABF[o] = (bf16)hi; WABF[o + 16384] = (bf16)(cvtpk(res, 0.f) & 0xffffu);
        }
    }
    if (F.bid == 0) { bf16* H = (bf16*)(ws + WS_H); for (int cidx = F.tid; cidx < D_; cidx += NTHR) H[(size_t)T_ * D_ + cidx] = 0; }
    for (int j = 0; j < 2; ++j) {
        convert_matrix(F, A.attn_w_in + (size_t)j * D_ * 9216, 9216, D_, 9216, (bf16*)(ws + WS_WA_IN) + (size_t)j * 9216 * D_, MapQKV{});
        convert_matrix(F, A.attn_w_out + (size_t)j * D_ * D_, D_, D_, D_, (bf16*)(ws + WS_WA_OUT) + (size_t)j * D_ * D_, MapId{0});
        convert_matrix(F, A.gdn_w_in + (size_t)j * D_ * 4112, 4112, D_, 4096, (bf16*)(ws + WS_WG_IN) + (size_t)j * 4096 * D_, MapId{0});
        convert_matrix(F, A.gdn_w_out + (size_t)j * D_ * D_, D_, D_, D_, (bf16*)(ws + WS_WG_OUT) + (size_t)j * D_ * D_, MapId{0});
    }
}
struct XItem { const float* src; bf16* dst; int ldn, K, mode, n0; };
DI XItem xi_decode(const Args& A, int layer, bf16* WE1, bf16* WE2, int it) {
    constexpr int I13 = (D_ / 64) * (256 / 32), I2 = (256 / 64) * (D_ / 32), IPE = 2 * I13 + I2;
    const int e = it / IPE; int r = it % IPE; XItem x;
    if (r < 2 * I13) { const int second = r >= I13 ? 1 : 0; r -= second * I13; const int kb = r >> 3, nb = r & 7;
        const float* w = second ? (e < 64 ? A.ew3 + ((size_t)layer * 64 + e) * D_ * 256 : A.sw3 + (size_t)layer * D_ * 256) : (e < 64 ? A.ew1 + ((size_t)layer * 64 + e) * D_ * 256 : A.sw1 + (size_t)layer * D_ * 256);
        x.src = w + (size_t)(64 * kb) * 256 + 32 * nb; x.ldn = 256; x.K = D_; x.mode = 1 + second; x.n0 = 32 * nb; x.dst = WE1 + (size_t)e * 512 * D_ + 64 * kb;
    } else { r -= 2 * I13; const int kb = r >> 5, nb = r & 31;
        const float* w = e < 64 ? A.ew2 + ((size_t)layer * 64 + e) * 256 * D_ : A.sw2 + (size_t)layer * 256 * D_;
        x.src = w + (size_t)(64 * kb) * D_ + 32 * nb; x.ldn = D_; x.K = 256; x.mode = 0; x.n0 = 32 * nb; x.dst = WE2 + (size_t)e * D_ * 256 + 64 * kb; }
    return x;
}
#define XI_LOAD(buf, XT) do { const char* _b = pg8::rfl_ptr((const char*)(XT).src); const unsigned _ro = (unsigned)((XT).ldn * 4); \
    _Pragma("unroll") for (int _i = 0; _i < 8; ++_i) buf[_i] = *(const f32x4*)(_b + ((unsigned)(8 * _i + (lane >> 3)) * _ro + (unsigned)(lane & 7) * 16u)); } while (0)
#define XI_PUT(buf, XT) do { \
    _Pragma("unroll") for (int _i = 0; _i < 8; ++_i) _Pragma("unroll") for (int _e = 0; _e < 4; ++_e) scr[(8 * _i + (lane >> 3)) * 33 + 4 * (lane & 7) + _e] = buf[_i][_e]; \
    LDS_WAIT(); asm volatile("" ::: "memory"); \
    const int _c = lane & 7; \
    _Pragma("unroll") for (int _j = 0; _j < 4; ++_j) { const int _n = (XT).n0 + (lane >> 3) + 8 * _j; const LAS float* _s = scr + (8 * _c) * 33 + (lane >> 3) + 8 * _j; \
        const int _row = (XT).mode == 0 ? _n : (_n >> 7) * 256 + ((XT).mode - 1) * 128 + (_n & 127); \
        u32x4 _o; _o.x = cvtpk(_s[0 * 33], _s[1 * 33]); _o.y = cvtpk(_s[2 * 33], _s[3 * 33]); _o.z = cvtpk(_s[4 * 33], _s[5 * 33]); _o.w = cvtpk(_s[6 * 33], _s[7 * 33]); \
        *(u32x4*)((XT).dst + (size_t)_row * (XT).K + 8 * _c) = _o; } \
    LDS_WAIT(); asm volatile("" ::: "memory"); } while (0)
DI void convert_experts(const Frame& F, const Args& A, int layer, int set, int wg0, int nwg) {
    if (F.bid < wg0 || F.bid >= wg0 + nwg) return;
    unsigned char* ws = opq(A.ws);
    LAS float* scr = (LAS float*)(F.lds + F.wave * 16384);
    bf16* WE1 = (bf16*)(ws + (set ? WS_WEB : WS_WE1)); bf16* WE2 = (bf16*)(ws + (set ? WS_WEB + 65 * MiB : WS_WE2));
    const int gw = (F.bid - wg0) * NWAVES + F.wave, NGW = nwg * NWAVES, lane = F.lane;
    constexpr int NIT = 65 * 384;
    f32x4 ba[8], bb[8];
    int it = gw;
    if (it >= NIT) return;
    XItem xa = xi_decode(A, layer, WE1, WE2, it), xb = xa;
    XI_LOAD(ba, xa);
#pragma unroll 1
    for (;;) {
        const bool hb = it + NGW < NIT;
        if (hb) { xb = xi_decode(A, layer, WE1, WE2, it + NGW); XI_LOAD(bb, xb); }
        __builtin_amdgcn_sched_barrier(0);
        XI_PUT(ba, xa);
        if (!hb) break;
        it += NGW;
        const bool ha = it + NGW < NIT;
        if (ha) { xa = xi_decode(A, layer, WE1, WE2, it + NGW); XI_LOAD(ba, xa); }
        __builtin_amdgcn_sched_barrier(0);
        XI_PUT(bb, xb);
        if (!ha) break;
        it += NGW;
    }
}
#undef XI_LOAD
#undef XI_PUT

DI void load_row16(const float* p, int lane, f32x4 (&v)[4]) {
#pragma unroll
    for (int j = 0; j < 4; ++j) v[j] = *(const f32x4*)(p + 4 * lane + 256 * j);
}
DI void store_row16(float* p, int lane, const f32x4 (&v)[4]) {
#pragma unroll
    for (int j = 0; j < 4; ++j) *(f32x4*)(p + 4 * lane + 256 * j) = v[j];
}
DI void store_row16_bf16(bf16* p, int lane, const f32x4 (&v)[4]) {
#pragma unroll
    for (int j = 0; j < 4; ++j) { u32x2 w; w.x = cvtpk(v[j][0], v[j][1]); w.y = cvtpk(v[j][2], v[j][3]); *(u32x2*)(p + 4 * lane + 256 * j) = w; }
}
DI void add_row16_bf16(const bf16* p, int lane, f32x4 (&v)[4]) {
#pragma unroll
    for (int j = 0; j < 4; ++j) { const u32x2 w = *(const u32x2*)(p + 4 * lane + 256 * j); v[j][0] += bf_lo(w.x); v[j][1] += bf_hi(w.x); v[j][2] += bf_lo(w.y); v[j][3] += bf_hi(w.y); }
}
DI void add_row16_fp8(const unsigned char* p, int lane, f32x4 (&v)[4]) {
#pragma unroll
    for (int j = 0; j < 4; ++j) { const int w = *(const int*)(p + 4 * lane + 256 * j);
        const f32x2 a = __builtin_amdgcn_cvt_pk_f32_fp8(w, false), b = __builtin_amdgcn_cvt_pk_f32_fp8(w, true);
        v[j][0] += a[0]; v[j][1] += a[1]; v[j][2] += b[0]; v[j][3] += b[1]; }
}
DI void layer_norm16(f32x4 (&v)[4], const f32x4 (&g)[4], const f32x4 (&b)[4]) {
    float s = 0.f;
#pragma unroll
    for (int j = 0; j < 4; ++j) s += (v[j][0] + v[j][1]) + (v[j][2] + v[j][3]);
    const float mean = wave_sum(s) * (1.0f / D_);
    float q = 0.f;
#pragma unroll
    for (int j = 0; j < 4; ++j) { v[j] = v[j] - mean; q += (v[j][0] * v[j][0] + v[j][1] * v[j][1]) + (v[j][2] * v[j][2] + v[j][3] * v[j][3]); }
    const float rstd = 1.0f / sqrtf(wave_sum(q) * (1.0f / D_) + LN_EPS);
#pragma unroll
    for (int j = 0; j < 4; ++j) v[j] = v[j] * rstd * g[j] + b[j];
}

DI void modx_phase(const Frame& F, const Args& A) {
    unsigned char* ws = opq(A.ws);
    const float* MOD = (const float*)(ws + WS_MOD); bf16* H = (bf16*)(ws + WS_H);
    const int gw = F.bid * NWAVES + F.wave, NGW = F.G * NWAVES;
    for (int row = gw; row < T_; row += NGW) {
        const int b = row >> 12; f32x4 v[4], sc[4], sh[4];
        load_row16(A.x + (size_t)row * D_, F.lane, v); load_row16(MOD + (size_t)(0 * 4 + b) * 3072 + 1024, F.lane, sc); load_row16(MOD + (size_t)(0 * 4 + b) * 3072, F.lane, sh);
#pragma unroll
        for (int j = 0; j < 4; ++j) v[j] = v[j] * (1.0f + sc[j]) + sh[j];
        store_row16_bf16(H + (size_t)row * D_, F.lane, v);
    }
}

DI void build_tileoff(const Frame& F, const unsigned* gcount) {
    LAS int* tileoff = (LAS int*)(F.lds + LDS_TILEOFF);
    __syncthreads();
    if (F.wave == 0) {
        const unsigned cn = __hip_atomic_load(gcount + F.lane, __ATOMIC_RELAXED, __HIP_MEMORY_SCOPE_AGENT);
        const int nt = (int)((cn + 255u) >> 8); int inc = nt;
#pragma unroll
        for (int o = 1; o < 64; o <<= 1) { const int t = __builtin_amdgcn_ds_bpermute((F.lane - o) << 2, inc); if (F.lane >= o) inc += t; }
        tileoff[F.lane] = inc - nt; ((LAS int*)(F.lds + LDS_ECNT))[F.lane] = (int)cn;
        if (F.lane == 63) { tileoff[64] = inc; tileoff[65] = inc + T_ / 256; ((LAS int*)(F.lds + LDS_ECNT))[NEXP] = T_; }
    }
    __syncthreads();
}

DI void deepnorm_row(f32x4 (&v)[4], const f32x4 (&y)[4], const float* gate, const float* lng, const float* lnb, float* xout, const float* mod_shift, int lane) {
    f32x4 t[4];
    load_row16(gate, lane, t);
#pragma unroll
    for (int j = 0; j < 4; ++j) v[j] = ALPHA_DN * v[j] + (1.0f + t[j]) * y[j];
    float s = 0.f;
#pragma unroll
    for (int j = 0; j < 4; ++j) s += (v[j][0] + v[j][1]) + (v[j][2] + v[j][3]);
    const float mean = wave_sum(s) * (1.0f / D_);
    float q = 0.f;
#pragma unroll
    for (int j = 0; j < 4; ++j) { v[j] = v[j] - mean; q += (v[j][0] * v[j][0] + v[j][1] * v[j][1]) + (v[j][2] * v[j][2] + v[j][3] * v[j][3]); }
    const float rstd = 1.0f / sqrtf(wave_sum(q) * (1.0f / D_) + LN_EPS);
    load_row16(lng, lane, t);
#pragma unroll
    for (int j = 0; j < 4; ++j) v[j] = v[j] * rstd * t[j];
    load_row16(lnb, lane, t);
#pragma unroll
    for (int j = 0; j < 4; ++j) v[j] = v[j] + t[j];
    store_row16(xout, lane, v);
    if (mod_shift) {
        load_row16(mod_shift + 1024, lane, t);
#pragma unroll
        for (int j = 0; j < 4; ++j) v[j] = v[j] * (1.0f + t[j]);
        load_row16(mod_shift, lane, t);
#pragma unroll
        for (int j = 0; j < 4; ++j) v[j] = v[j] + t[j];
    }
}
DI void put_hilo(LAS unsigned char* lds, int p, int lane, const f32x4 (&v)[4]) {
#pragma unroll
    for (int j = 0; j < 4; ++j) {
        const int c = 4 * lane + 256 * j;
        const unsigned h0 = cvtpk(v[j][0], v[j][1]), h1 = cvtpk(v[j][2], v[j][3]);
        const unsigned l0 = cvtpk(v[j][0] - bf_lo(h0), v[j][1] - bf_hi(h0)), l1 = cvtpk(v[j][2] - bf_lo(h1), v[j][3] - bf_hi(h1));
        const int off = ((((p >> 4) * 32 + (c >> 5)) * 64 + ((c & 31) >> 3) * 16 + (p & 15)) * 16) + (c & 7) * 2;
        *(LAS u32x2*)(lds + off) = (u32x2){h0, h1}; *(LAS u32x2*)(lds + 65536 + off) = (u32x2){l0, l1};
    }
}
DI f32x4 small_proj(const LAS unsigned char* lds, int mt, int lane, const bf16* wf_hi, const bf16* wf_lo) {
    f32x4 a0 = (f32x4){0.f, 0.f, 0.f, 0.f}, a1 = a0, a2 = a0;
#pragma unroll 8
    for (int ks = 0; ks < 32; ++ks) {
        const bf16x8 ah = *(const LAS bf16x8*)(lds + ((mt * 32 + ks) * 64 + lane) * 16), al = *(const LAS bf16x8*)(lds + 65536 + ((mt * 32 + ks) * 64 + lane) * 16);
        const bf16x8 bh = *(const bf16x8*)(wf_hi + (ks * 64 + lane) * 8), bl = *(const bf16x8*)(wf_lo + (ks * 64 + lane) * 8);
        a0 = __builtin_amdgcn_mfma_f32_16x16x32_bf16(ah, bh, a0, 0, 0, 0); a1 = __builtin_amdgcn_mfma_f32_16x16x32_bf16(ah, bl, a1, 0, 0, 0); a2 = __builtin_amdgcn_mfma_f32_16x16x32_bf16(al, bh, a2, 0, 0, 0);
    }
    return a0 + (a1 + a2);
}
DI void small_proj2(const LAS unsigned char* lds, int kh, int lane, const bf16* wf_hi, const bf16* wf_lo, f32x4& o0, f32x4& o1) {
    f32x4 a[2][3];
#pragma unroll
    for (int mt = 0; mt < 2; ++mt)
#pragma unroll
        for (int e = 0; e < 3; ++e) a[mt][e] = (f32x4){0.f, 0.f, 0.f, 0.f};
#pragma unroll 8
    for (int k = 0; k < 16; ++k) {
        const int ks = 16 * kh + k;
        const bf16x8 bh = *(const bf16x8*)(wf_hi + (ks * 64 + lane) * 8), bl = *(const bf16x8*)(wf_lo + (ks * 64 + lane) * 8);
#pragma unroll
        for (int mt = 0; mt < 2; ++mt) {
            const bf16x8 ah = *(const LAS bf16x8*)(lds + ((mt * 32 + ks) * 64 + lane) * 16), al = *(const LAS bf16x8*)(lds + 65536 + ((mt * 32 + ks) * 64 + lane) * 16);
            a[mt][0] = __builtin_amdgcn_mfma_f32_16x16x32_bf16(ah, bh, a[mt][0], 0, 0, 0); a[mt][1] = __builtin_amdgcn_mfma_f32_16x16x32_bf16(ah, bl, a[mt][1], 0, 0, 0); a[mt][2] = __builtin_amdgcn_mfma_f32_16x16x32_bf16(al, bh, a[mt][2], 0, 0, 0);
        }
    }
    o0 = a[0][0] + (a[0][1] + a[0][2]); o1 = a[1][0] + (a[1][1] + a[1][2]);
}
DI void deepnorm_row_c(f32x4 (&v)[4], const f32x4 (&y)[4], const f32x4 (&cg)[4], const f32x4 (&cng)[4], const f32x4 (&cnb)[4]) {
#pragma unroll
    for (int j = 0; j < 4; ++j) v[j] = ALPHA_DN * v[j] + (1.0f + cg[j]) * y[j];
    float s = 0.f;
#pragma unroll
    for (int j = 0; j < 4; ++j) s += (v[j][0] + v[j][1]) + (v[j][2] + v[j][3]);
    const float mean = wave_sum(s) * (1.0f / D_);
    float q = 0.f;
#pragma unroll
    for (int j = 0; j < 4; ++j) { v[j] = v[j] - mean; q += (v[j][0] * v[j][0] + v[j][1] * v[j][1]) + (v[j][2] * v[j][2] + v[j][3] * v[j][3]); }
    const float rstd = 1.0f / sqrtf(wave_sum(q) * (1.0f / D_) + LN_EPS);
#pragma unroll
    for (int j = 0; j < 4; ++j) v[j] = v[j] * rstd * cng[j] + cnb[j];
}
template <bool L0> DI void ln_router_phase(const Frame& F, const Args& A, int layer, bool dry = false) {
    unsigned char* ws = opq(A.ws);
    const float* MOD = (const float*)(ws + WS_MOD); bf16* X = (bf16*)(ws + WS_X); const float* Y = (const float*)(ws + WS_Y); bf16* H = (bf16*)(ws + WS_H);
    int* asg_e = (int*)(ws + WS_ASG_E); int* asg_r = (int*)(ws + WS_ASG_R); int* etok = (int*)(ws + WS_ETOK); float* egate = (float*)(ws + WS_EW);
    unsigned* gcount = (unsigned*)(ws + WS_CTL) + CW_CNT + layer * 64;
    const int ls0 = layer * 2, ls1 = layer * 2 + 1;
    const bf16* wrf = (const bf16*)(ws + WS_WRF) + (size_t)layer * 2 * 65536 + (size_t)(F.wave & 3) * 32 * 512;
    const float rb = A.router_bias[layer * NEXP + F.lane];
    LAS float* lg = (LAS float*)(F.lds + LDS_LG);
    LAS int* lcnt = (LAS int*)(F.lds + LDS_LCNT); LAS int* lbase = (LAS int*)(F.lds + LDS_LBASE); LAS int* lasg = (LAS int*)(F.lds + LDS_LASG);
    const unsigned l8_ = (unsigned)F.lane * 8u, l16_ = (unsigned)F.lane * 16u;
    u32x2 yb[4][4], xb[L0 ? 1 : 4][4]; f32x4 xf[L0 ? 4 : 1][4];
#define LNR_LOAD(rb_) do { unsigned l8 = l8_, l16 = l16_; asm volatile("" : "+v"(l8), "+v"(l16)); \
        _Pragma("unroll") for (int t = 0; t < 4; ++t) { const int row = (rb_) + t; const char* py = pg8::rfl_ptr((const char*)Y + (size_t)row * (D_ * 2)); \
            if constexpr (L0) { const char* px = pg8::rfl_ptr((const char*)A.x + (size_t)row * (D_ * 4)); _Pragma("unroll") for (int j = 0; j < 4; ++j) xf[t][j] = *(const f32x4*)(px + l16 + 1024 * j); } \
            else { const char* px = pg8::rfl_ptr((const char*)X + (size_t)row * (D_ * 2)); _Pragma("unroll") for (int j = 0; j < 4; ++j) xb[t][j] = *(const u32x2*)(px + l8 + 512 * j); } \
            _Pragma("unroll") for (int j = 0; j < 4; ++j) yb[t][j] = *(const u32x2*)(py + l8 + 512 * j); } } while (0)
    for (int blk = F.bid; blk < T_ / 64; blk += F.G) {
        const int b = blk >> 6;
        const char* gate = pg8::rfl_ptr((const char*)(MOD + (size_t)(ls0 * 4 + b) * 3072 + 2048)); const char* modn = pg8::rfl_ptr((const char*)(MOD + (size_t)(ls1 * 4 + b) * 3072));
        const char* lng = pg8::rfl_ptr((const char*)(A.ln_g + (size_t)ls0 * D_)); const char* lnb = pg8::rfl_ptr((const char*)(A.ln_b + (size_t)ls0 * D_));
        f32x4 cg[4], cng[4], cnb[4], csc[4], csh[4];
#pragma unroll
        for (int j = 0; j < 4; ++j) { cg[j] = *(const f32x4*)(gate + l16_ + 1024 * j); cng[j] = *(const f32x4*)(lng + l16_ + 1024 * j); cnb[j] = *(const f32x4*)(lnb + l16_ + 1024 * j);
            csc[j] = *(const f32x4*)(modn + 4096 + l16_ + 1024 * j); csh[j] = *(const f32x4*)(modn + l16_ + 1024 * j); }
        if constexpr (!L0) { LNR_LOAD(blk * 64 + F.wave * 4); }
        __builtin_amdgcn_sched_barrier(0);
#pragma unroll 1
        for (int ps = 0; ps < 2; ++ps) {
            const int rbase = blk * 64 + ps * 32 + F.wave * 4;
            if constexpr (L0) { LNR_LOAD(rbase); }
            { unsigned l8 = l8_; asm volatile("" : "+v"(l8));
#pragma unroll
              for (int t = 0; t < 4; ++t) { const int row = rbase + t; f32x4 v[4], y[4];
#pragma unroll
                for (int j = 0; j < 4; ++j) { y[j] = (f32x4){bf_lo(yb[t][j].x), bf_hi(yb[t][j].x), bf_lo(yb[t][j].y), bf_hi(yb[t][j].y)};
                    if constexpr (L0) v[j] = xf[t][j]; else v[j] = (f32x4){bf_lo(xb[t][j].x), bf_hi(xb[t][j].x), bf_lo(xb[t][j].y), bf_hi(xb[t][j].y)}; }
                deepnorm_row_c(v, y, cg, cng, cnb);
                char* xp = (char*)pg8::rfl_ptr((const char*)(dry ? (const bf16*)(ws + WS_Y + 32 * MiB) : X) + (size_t)row * (D_ * 2));
                char* hp = (char*)pg8::rfl_ptr((const char*)H + (size_t)row * (D_ * 2));
#pragma unroll
                for (int j = 0; j < 4; ++j) { { u32x2 o; o.x = cvtpk(v[j][0], v[j][1]); o.y = cvtpk(v[j][2], v[j][3]); *(u32x2*)(xp + l8 + 512 * j) = o; }
                    v[j] = v[j] * (1.0f + csc[j]) + csh[j]; u32x2 o; o.x = cvtpk(v[j][0], v[j][1]); o.y = cvtpk(v[j][2], v[j][3]); *(u32x2*)(hp + l8 + 512 * j) = o; }
                put_hilo(F.lds, F.wave * 4 + t, F.lane, v); } }
            if constexpr (!L0) { if (ps == 0) { LNR_LOAD(blk * 64 + 32 + F.wave * 4); } }
            __syncthreads();
            { const int nt = F.wave & 3, kh = F.wave >> 2, r = F.lane & 15, q = F.lane >> 4;
              f32x4 acc0, acc1; small_proj2(F.lds, kh, F.lane, wrf, wrf + 65536, acc0, acc1);
              if (kh == 0) {
#pragma unroll
                  for (int reg = 0; reg < 4; ++reg) { lg[(4 * q + reg) * 64 + 16 * nt + r] = acc0[reg]; lg[(16 + 4 * q + reg) * 64 + 16 * nt + r] = acc1[reg]; } }
              __syncthreads();
              if (kh == 1) {
#pragma unroll
                  for (int reg = 0; reg < 4; ++reg) { lg[(4 * q + reg) * 64 + 16 * nt + r] += acc0[reg]; lg[(16 + 4 * q + reg) * 64 + 16 * nt + r] += acc1[reg]; } } }
            __syncthreads();
#pragma unroll 1
            for (int rr = 0; rr < 4; ++rr) {
                const int row = rbase + rr, rl = ps * 32 + F.wave * 4 + rr;
                int ln = F.lane; asm volatile("" : "+v"(ln));
                const float logit = lg[(F.wave * 4 + rr) * 64 + F.lane];
                const float s = 1.0f / (1.0f + __expf(-logit)); const float bi = s + rb;
                float m1 = bi; m1 = fmaxf(m1, dppmov<0xB1>(m1)); m1 = fmaxf(m1, dppmov<0x4E>(m1)); m1 = fmaxf(m1, dppmov<0x141>(m1));
                const unsigned long long eq = __ballot(bi == m1);
                const int first = __ffs((int)((eq >> (ln & ~7)) & 0xffull)) - 1;
                float m2 = ((ln & 7) == first) ? -INFINITY : bi; m2 = fmaxf(m2, dppmov<0xB1>(m2)); m2 = fmaxf(m2, dppmov<0x4E>(m2)); m2 = fmaxf(m2, dppmov<0x141>(m2));
                const float gs = m1 + m2; int grank = 0;
#pragma unroll
                for (int j = 0; j < 8; ++j) { const float gj = rdlane(gs, 8 * j); grank += ((gj > gs) || (gj == gs && j < (ln >> 3))) ? 1 : 0; }
                const bool gsel = grank < 4;
                float mv = gsel ? bi : -INFINITY; int cnt = -1;
#pragma unroll
                for (int it = 0; it < TOPK; ++it) { const float mx = wave_max(mv); const unsigned long long em = __ballot(mv == mx); const int fl = __ffsll((long long)em) - 1;
                    if (ln == fl) { cnt = it; mv = -INFINITY; } }
                const bool sel = cnt >= 0;
                const float gsum = wave_sum(sel ? s : 0.f);
                if (sel) { const int lr = __hip_atomic_fetch_add(&lcnt[F.lane], 1, __ATOMIC_RELAXED, __HIP_MEMORY_SCOPE_WORKGROUP); lasg[rl * 8 + cnt] = (F.lane << 16) | lr;
                    asg_e[(size_t)row * 8 + cnt] = F.lane; ((LAS float*)(F.lds + LDS_LW))[rl * 8 + cnt] = s / gsum * 2.5f; }
            }
        }
        __syncthreads();
        if (F.tid < NEXP) { const int cn = lcnt[F.tid]; lbase[F.tid] = (cn && !dry) ? (int)atomicAdd(&gcount[F.tid], (unsigned)cn) : 0; lcnt[F.tid] = 0; }
        __syncthreads();
        { const int v = lasg[F.tid], e = v >> 16, rank = lbase[e] + (v & 0xffff); asg_r[(size_t)blk * 512 + F.tid] = rank;
          etok[(size_t)e * ECAP + rank] = blk * 64 + (F.tid >> 3); egate[(size_t)e * ECAP + rank] = ((const LAS float*)(F.lds + LDS_LW))[F.tid];
          if (F.tid < 64) { etok[(size_t)NEXP * ECAP + blk * 64 + F.tid] = blk * 64 + F.tid; egate[(size_t)NEXP * ECAP + blk * 64 + F.tid] = 1.0f; } }
        __syncthreads();
    }
#undef LNR_LOAD
}

DI void moe_scatter_phase(const Frame& F, const Args& A, int layer) {
    unsigned char* ws = opq(A.ws);
    const int* asg_e = (const int*)(ws + WS_ASG_E); const int* asg_r = (const int*)(ws + WS_ASG_R); const float* asg_w = (const float*)(ws + WS_ASG_W); int* asg_row = (int*)(ws + WS_ASG_ROW);
    int* rowtok = (int*)(ws + WS_ROWTOK); float* roww = (float*)(ws + WS_ROWW);
    const unsigned* gcount = (const unsigned*)(ws + WS_CTL) + CW_CNT + layer * 64;
    build_tileoff(F, gcount);
    const LAS int* tileoff = (const LAS int*)(F.lds + LDS_TILEOFF);
    for (int idx = F.bid * NTHR + F.tid; idx < T_ * TOPK; idx += F.G * NTHR) {
        const int e = asg_e[idx], row = 256 * tileoff[e] + asg_r[idx];
        rowtok[row] = idx >> 3; roww[row] = asg_w[idx]; asg_row[idx] = row;
    }
    for (int e = F.bid; e < NEXP; e += F.G) {
        const int cnt = (int)__hip_atomic_load(gcount + e, __ATOMIC_RELAXED, __HIP_MEMORY_SCOPE_AGENT), end = 256 * tileoff[e + 1];
        for (int row = 256 * tileoff[e] + cnt + F.tid; row < end; row += NTHR) { rowtok[row] = T_; roww[row] = 0.f; }
    }
    const int s0 = 256 * tileoff[64];
    for (int t = F.bid * NTHR + F.tid; t < T_; t += F.G * NTHR) { rowtok[s0 + t] = t; roww[s0 + t] = 1.0f; }
}

DI void ln_moe_phase(const Frame& F, const Args& A, int layer, float* dry_out) {
    unsigned char* ws = opq(A.ws);
    const float* MOD = (const float*)(ws + WS_MOD); const char* YE = (const char*)(ws + WS_BIG);
    float* AB = (float*)(ws + WS_AB);
    int s0 = 0;
    { const unsigned* gcount = (const unsigned*)(ws + WS_CTL) + CW_CNT + layer * 64; build_tileoff(F, gcount); s0 = 256 * ((const LAS int*)(F.lds + LDS_TILEOFF))[64]; }
    const int* asg_e = (const int*)(ws + WS_ASG_E); const int* asg_r = (const int*)(ws + WS_ASG_R);
    const int ls0 = layer * 2 + 1, ls1 = layer * 2 + 2; const bool last = layer == 3, want_ab = (layer & 1) == 0;
    const bf16* wabf = (const bf16*)(ws + WS_WABF) + (size_t)(layer >> 1) * 2 * 16384;
    const unsigned l4_ = (unsigned)F.lane * 4u, l8_ = (unsigned)F.lane * 8u, l16_ = (unsigned)F.lane * 16u;
    for (int blk = F.bid; blk < T_ / 64; blk += F.G) {
        const int b = blk >> 6;
        const char* gate = pg8::rfl_ptr((const char*)(MOD + (size_t)(ls0 * 4 + b) * 3072 + 2048)); const char* modn = pg8::rfl_ptr((const char*)(MOD + (size_t)((last ? ls0 : ls1) * 4 + b) * 3072));
        const char* lng = pg8::rfl_ptr((const char*)(A.ln_g + (size_t)ls0 * D_)); const char* lnb = pg8::rfl_ptr((const char*)(A.ln_b + (size_t)ls0 * D_));
        f32x4 cg[4], cng[4], cnb[4], csc[4], csh[4];
#pragma unroll
        for (int j = 0; j < 4; ++j) { cg[j] = *(const f32x4*)(gate + l16_ + 1024 * j); cng[j] = *(const f32x4*)(lng + l16_ + 1024 * j); cnb[j] = *(const f32x4*)(lnb + l16_ + 1024 * j);
            csc[j] = *(const f32x4*)(modn + 4096 + l16_ + 1024 * j); csh[j] = *(const f32x4*)(modn + l16_ + 1024 * j); }
#pragma unroll 1
        for (int ps = 0; ps < 2; ++ps) {
            const int rbase = blk * 64 + ps * 32 + F.wave * 4;
            const int ev = *(const int*)(pg8::rfl_ptr((const char*)(asg_e + (size_t)rbase * 8)) + (l4_ & 127u)), rv = *(const int*)(pg8::rfl_ptr((const char*)(asg_r + (size_t)rbase * 8)) + (l4_ & 127u));
            const int idxv = 256 * ((const LAS int*)(F.lds + LDS_TILEOFF))[ev] + rv;
#pragma unroll 1
            for (int rr = 0; rr < 4; ++rr) {
                const int row = rbase + rr; f32x4 v[4], y[4]; int w[9][4]; u32x2 sh[4];
                unsigned l4 = l4_, l8 = l8_, l16 = l16_; asm volatile("" : "+v"(l4), "+v"(l8), "+v"(l16));
#pragma unroll
                for (int k = 0; k < TOPK; ++k) { const int src = __builtin_amdgcn_readlane(idxv, rr * 8 + k); const char* p = pg8::rfl_ptr(YE + (size_t)src * D_);
#pragma unroll
                    for (int j = 0; j < 4; ++j) w[k][j] = *(const int*)(p + l4 + 256 * j); }
                if (YS_BF16) { const char* p = pg8::rfl_ptr(YE + WS_YS_OFF + (size_t)row * (D_ * 2));
#pragma unroll
                    for (int j = 0; j < 4; ++j) sh[j] = *(const u32x2*)(p + l8 + 512 * j);
                } else { const char* p = pg8::rfl_ptr(YE + (size_t)(s0 + row) * D_);
#pragma unroll
                    for (int j = 0; j < 4; ++j) w[8][j] = *(const int*)(p + l4 + 256 * j);
                }
                u32x2 xb[4];
                { const char* p = pg8::rfl_ptr((const char*)(ws + WS_X) + (size_t)row * (D_ * 2));
#pragma unroll
                  for (int j = 0; j < 4; ++j) xb[j] = *(const u32x2*)(p + l8 + 512 * j); }
                __builtin_amdgcn_sched_barrier(0);
#pragma unroll
                for (int j = 0; j < 4; ++j) { y[j] = (f32x4){0.f, 0.f, 0.f, 0.f}; v[j] = (f32x4){bf_lo(xb[j].x), bf_hi(xb[j].x), bf_lo(xb[j].y), bf_hi(xb[j].y)}; }
#pragma unroll
                for (int k = 0; k < (YS_BF16 ? TOPK : TOPK + 1); ++k) {
                    asm volatile("" : "+v"(w[k][0]), "+v"(w[k][1]), "+v"(w[k][2]), "+v"(w[k][3]), "+v"(y[0]), "+v"(y[1]), "+v"(y[2]), "+v"(y[3]));
#pragma unroll
                    for (int j = 0; j < 4; ++j) { const f32x2 a = __builtin_amdgcn_cvt_pk_f32_fp8(w[k][j], false), c = __builtin_amdgcn_cvt_pk_f32_fp8(w[k][j], true);
                        y[j][0] += a[0]; y[j][1] += a[1]; y[j][2] += c[0]; y[j][3] += c[1]; }
                    __builtin_amdgcn_sched_barrier(0);
                }
#pragma unroll
                for (int j = 0; j < 4; ++j) y[j] = y[j] * (1.0f / YE_SCALE);
                if (YS_BF16) {
#pragma unroll
                    for (int j = 0; j < 4; ++j) { y[j][0] += bf_lo(sh[j].x); y[j][1] += bf_hi(sh[j].x); y[j][2] += bf_lo(sh[j].y); y[j][3] += bf_hi(sh[j].y); }
                }
                deepnorm_row_c(v, y, cg, cng, cnb);
                if (last || dry_out) { char* op = (char*)pg8::rfl_ptr((const char*)(dry_out ? dry_out : A.out) + (size_t)row * (D_ * 4));
#pragma unroll
                    for (int j = 0; j < 4; ++j) *(f32x4*)(op + l16 + 1024 * j) = v[j];
                } else { char* xp = (char*)pg8::rfl_ptr((const char*)(ws + WS_X) + (size_t)row * (D_ * 2));
#pragma unroll
                    for (int j = 0; j < 4; ++j) { u32x2 o; o.x = cvtpk(v[j][0], v[j][1]); o.y = cvtpk(v[j][2], v[j][3]); *(u32x2*)(xp + l8 + 512 * j) = o; } }
                if (!last) { char* hp = (char*)pg8::rfl_ptr((const char*)(ws + WS_H) + (size_t)row * (D_ * 2));
#pragma unroll
                    for (int j = 0; j < 4; ++j) { v[j] = v[j] * (1.0f + csc[j]) + csh[j]; u32x2 o; o.x = cvtpk(v[j][0], v[j][1]); o.y = cvtpk(v[j][2], v[j][3]); *(u32x2*)(hp + l8 + 512 * j) = o; }
                    if (want_ab) put_hilo(F.lds, F.wave * 4 + rr, F.lane, v);
                }
            }
            if (!last && want_ab) {
                __syncthreads();
                if (F.wave < 2) { const int mt = F.wave, r = F.lane & 15, q = F.lane >> 4;
                    const f32x4 acc = small_proj(F.lds, mt, F.lane, wabf, wabf + 16384);
#pragma unroll
                    for (int reg = 0; reg < 4; ++reg) AB[(size_t)(blk * 64 + ps * 32 + 16 * mt + 4 * q + reg) * 16 + r] = acc[reg]; }
                __syncthreads();
            }
        }
    }
}
DI int crow(int r, int h) { return (r & 3) + 8 * (r >> 2) + 4 * h; }
typedef short v4i16_t __attribute__((ext_vector_type(4)));
DI s16x4 vtr(const LAS unsigned char* p) { return __builtin_bit_cast(s16x4, __builtin_amdgcn_ds_read_tr16_b64_v4i16((LAS v4i16_t*)p)); }
#define MFMA32(a, b, c) __builtin_amdgcn_mfma_f32_32x32x16_bf16((a), (b), (c), 0, 0, 0)
constexpr int ATT_ORUN = 0, ATT_LRUN = 65536, ATT_VBUF = 65536 + 2048, ATT_VSTRIDE = 144, ATT_VBYTES = 32 * ATT_VSTRIDE;

#ifndef REP_A1
#define REP_A1 1
#define REP_A2 1
#endif
DI void attn_phase(const Frame& F, const Args& A) {
    unsigned char* ws = opq(A.ws);
    const bf16* QKV = (const bf16*)(ws + WS_BIG); bf16* O = (bf16*)(ws + WS_O);
    LAS unsigned char* orun = F.lds + ATT_ORUN;
    LAS float* lrun = (LAS float*)(F.lds + ATT_LRUN);
    LAS unsigned char* vbuf = F.lds + ATT_VBUF + F.wave * ATT_VBYTES;
    const int lane = F.lane, qi = lane & 31, h = lane >> 5;
    const int g16 = lane >> 4, q4 = (lane & 15) >> 2, p4 = lane & 3;
    for (int it = F.bid; it < NB_ * 16 * 8; it += F.G) {
        int item = it;
        if (F.G == 256) { const int w = it & 255, xcd = w & 7, j = w >> 3; item = (((it >> 8) * 32 + xcd * 4 + (j >> 3)) << 3) | (j & 7); }
        const int b = item >> 7, head = (item >> 3) & 15, ck = item & 7;
        for (int gi = 0; gi < 3; ++gi) {
            const int g = 2 - gi, ldil = 2 * g, Lg = S_ >> ldil;
            const size_t hb = (((size_t)g * NB_ + b) * 16 + head) * S_ * 64;
            const bf16* Qg = QKV + hb; const bf16* Kg = QKV + (size_t)3 * NB_ * 16 * S_ * 64 + hb; const bf16* Vg = QKV + (size_t)6 * NB_ * 16 * S_ * 64 + hb;
            for (int sub = F.wave; sub < 16; sub += NWAVES) {
                int r_, tile;
                if (g == 0) { r_ = 0; tile = sub; } else if (g == 1) { r_ = sub >> 2; tile = sub & 3; } else { r_ = sub; tile = 0; }
                const int m0 = ((512 * ck) >> ldil) + 32 * tile;
                const bf16* Kr = Kg + (size_t)r_ * Lg * 64; const bf16* Vr = Vg + (size_t)r_ * Lg * 64;
                f32x16 st[5]; u32x4 vv[5][4]; float mx, lsum;
#pragma unroll 1
                for (int rep1 = 0; rep1 < REP_A1; ++rep1) {
                unsigned lc = (unsigned)((lane >> 3) * 128 + (lane & 7) * 16); asm volatile("" : "+v"(lc));
                const int wofs = (lane >> 3) * ATT_VSTRIDE + (lane & 7) * 16, rofs = qi * ATT_VSTRIDE + 64 * h;
                u32x4 qv[4], kv[5][4];
                { const char* qp = pg8::rfl_ptr((const char*)(Qg + ((size_t)r_ * Lg + m0) * 64));
#pragma unroll
                  for (int i = 0; i < 4; ++i) qv[i] = *(const u32x4*)(qp + lc + 1024 * i); }
#pragma unroll
                for (int kt = 0; kt < 5; ++kt) { const int mk0 = m0 - 128 + 32 * kt; const char* kp = pg8::rfl_ptr((const char*)(Kr + (size_t)(mk0 < 0 ? 0 : mk0) * 64));
#pragma unroll
                    for (int i = 0; i < 4; ++i) kv[kt][i] = *(const u32x4*)(kp + lc + 1024 * i); }
                __builtin_amdgcn_sched_barrier(0);
                bf16x8 qf[4];
#pragma unroll
                for (int i = 0; i < 4; ++i) *(LAS u32x4*)(vbuf + wofs + 8 * i * ATT_VSTRIDE) = qv[i];
                LDS_WAIT(); asm volatile("" ::: "memory");
#pragma unroll
                for (int s = 0; s < 4; ++s) qf[s] = *(const LAS bf16x8*)(vbuf + rofs + 16 * s);
                LDS_WAIT(); asm volatile("" ::: "memory");
#pragma unroll
                for (int kt = 0; kt < 5; ++kt) {
                    const int mk0 = m0 - 128 + 32 * kt;
                    bf16x8 kf[4];
#pragma unroll
                    for (int i = 0; i < 4; ++i) *(LAS u32x4*)(vbuf + wofs + 8 * i * ATT_VSTRIDE) = kv[kt][i];
                    LDS_WAIT(); asm volatile("" ::: "memory");
#pragma unroll
                    for (int s = 0; s < 4; ++s) kf[s] = *(const LAS bf16x8*)(vbuf + rofs + 16 * s);
                    { const char* vp = pg8::rfl_ptr((const char*)(Vr + (size_t)(mk0 < 0 ? 0 : mk0) * 64));
#pragma unroll
                      for (int i = 0; i < 4; ++i) vv[kt][i] = *(const u32x4*)(vp + lc + 1024 * i); }
                    LDS_WAIT(); asm volatile("" ::: "memory");
#pragma unroll
                    for (int r = 0; r < 16; ++r) st[kt][r] = 0.f;
#pragma unroll
                    for (int s = 0; s < 4; ++s) st[kt] = MFMA32(kf[s], qf[s], st[kt]);
                    if (mk0 < 0) {
#pragma unroll
                        for (int r = 0; r < 16; ++r) st[kt][r] = -INFINITY;
                    }
                }
#pragma unroll
                for (int r = 0; r < 16; ++r) { const int kr = crow(r, h); if (kr < qi) st[0][r] = -INFINITY; if (kr > qi) st[4][r] = -INFINITY; }
                mx = -INFINITY;
#pragma unroll
                for (int kt = 0; kt < 5; ++kt)
#pragma unroll
                    for (int r = 0; r < 16; ++r) mx = fmaxf(mx, st[kt][r]);
                mx = fmaxf(mx, bperm(mx, F.lane ^ 32));
                lsum = 0.f;
#pragma unroll
                for (int kt = 0; kt < 5; ++kt)
#pragma unroll
                    for (int r = 0; r < 16; ++r) { const float p = __builtin_amdgcn_exp2f(st[kt][r] - mx); st[kt][r] = p; lsum += p; }
                lsum += bperm(lsum, F.lane ^ 32);
                }
                f32x16 oacc[2];
#pragma unroll 1
                for (int rep2 = 0; rep2 < REP_A2; ++rep2) {
#pragma unroll
                for (int r = 0; r < 16; ++r) { oacc[0][r] = 0.f; oacc[1][r] = 0.f; }
#pragma unroll
                for (int kt = 0; kt < 5; ++kt) {
                    const int mk0 = m0 - 128 + 32 * kt;
                    if (mk0 >= 0) {
#pragma unroll
                        for (int i = 0; i < 4; ++i) *(LAS u32x4*)(vbuf + ((lane >> 3) + 8 * i) * ATT_VSTRIDE + (lane & 7) * 16) = vv[kt][i];
                        LDS_WAIT(); asm volatile("" ::: "memory");
                        s16x4 flo[2][2], fhi[2][2];
#pragma unroll
                        for (int sp = 0; sp < 2; ++sp)
#pragma unroll
                            for (int dvt = 0; dvt < 2; ++dvt) {
                                const int colb = (32 * dvt + 16 * (g16 & 1) + 4 * p4) * 2;
                                flo[sp][dvt] = vtr(vbuf + (16 * sp + 4 * h + q4) * ATT_VSTRIDE + colb);
                                fhi[sp][dvt] = vtr(vbuf + (16 * sp + 8 + 4 * h + q4) * ATT_VSTRIDE + colb);
                            }
                        LDS_WAIT(); asm volatile("" ::: "memory");
#pragma unroll
                        for (int sp = 0; sp < 2; ++sp) {
                            bf16x8 pf; {
                                const unsigned w0 = cvtpk(st[kt][8 * sp + 0], st[kt][8 * sp + 1]), w1 = cvtpk(st[kt][8 * sp + 2], st[kt][8 * sp + 3]);
                                const unsigned w2 = cvtpk(st[kt][8 * sp + 4], st[kt][8 * sp + 5]), w3 = cvtpk(st[kt][8 * sp + 6], st[kt][8 * sp + 7]);
                                pf = __builtin_bit_cast(bf16x8, (u32x4){w0, w1, w2, w3}); }
#pragma unroll
                            for (int dvt = 0; dvt < 2; ++dvt) {
                                const bf16x8 vf = __builtin_shufflevector(flo[sp][dvt], fhi[sp][dvt], 0, 1, 2, 3, 4, 5, 6, 7);
                                oacc[dvt] = MFMA32(vf, pf, oacc[dvt]);
                            }
                        }
                    }
                }
                asm volatile("" : "+v"(oacc[0]), "+v"(oacc[1]));
                }
                const float inv = __builtin_amdgcn_rcpf(lsum), lse = mx + __builtin_amdgcn_logf(lsum);
                const int tl = ((32 * tile + qi) << ldil) + r_;
                float wa = 0.f, wb = 1.f;
                if (gi > 0) { const float L0 = lrun[tl]; const float M = fmaxf(L0, lse); const float ea = __builtin_amdgcn_exp2f(L0 - M), eb = __builtin_amdgcn_exp2f(lse - M);
                    const float isum = __builtin_amdgcn_rcpf(ea + eb); wa = ea * isum; wb = eb * isum; asm volatile("" ::: "memory");
                    if (h == 0) lrun[tl] = M + __builtin_amdgcn_logf(ea + eb); }
                else if (h == 0) lrun[tl] = lse;
                wb *= inv;
#pragma unroll
                for (int dvt = 0; dvt < 2; ++dvt)
#pragma unroll
                    for (int k4 = 0; k4 < 4; ++k4) {
                        const int dv = 32 * dvt + 8 * k4 + 4 * h;
                        float o0 = oacc[dvt][4 * k4 + 0] * wb, o1 = oacc[dvt][4 * k4 + 1] * wb, o2 = oacc[dvt][4 * k4 + 2] * wb, o3 = oacc[dvt][4 * k4 + 3] * wb;
                        LAS u32x2* op = (LAS u32x2*)(orun + tl * 128 + dv * 2);
                        if (gi > 0) { const u32x2 w = *op; o0 += wa * bf_lo(w.x); o1 += wa * bf_hi(w.x); o2 += wa * bf_lo(w.y); o3 += wa * bf_hi(w.y); }
                        u32x2 wo; wo.x = cvtpk(o0, o1); wo.y = cvtpk(o2, o3);
                        if (gi < 2) *op = wo;
                        else *(u32x2*)(O + ((size_t)b * S_ + 512 * ck + tl) * D_ + head * 64 + dv) = wo;
                    }
            }
            __syncthreads();
        }
    }
}

DI void gdn_post_phase(const Frame& F, const Args& A, int j) {
    unsigned char* ws = opq(A.ws); unsigned char* big = ws + WS_BIG;
    const bf16* Oraw = (const bf16*)(ws + WS_Y); const bf16* PROJ = (const bf16*)(big + BIG_PROJ); bf16* O = (bf16*)(ws + WS_O);
    const float* nw = A.gdn_norm_w + (size_t)j * 128;
    const int gw = F.bid * NWAVES + F.wave, NGW = F.G * NWAVES, lane = F.lane;
    const f32x4 nwv = *(const f32x4*)(nw + ((4 * lane) & 127));
    const unsigned l8_ = (unsigned)lane * 8u;
#pragma unroll 2
    for (int row = gw; row < T_; row += NGW) {
        unsigned l8 = l8_; asm volatile("" : "+v"(l8));
        const char* op = pg8::rfl_ptr((const char*)(Oraw + (size_t)row * D_)); const char* zp = pg8::rfl_ptr((const char*)(PROJ + (size_t)row * 4096 + 3072));
        u32x2 ow[4], zw[4];
#pragma unroll
        for (int jj = 0; jj < 4; ++jj) { ow[jj] = *(const u32x2*)(op + l8 + 512 * jj); zw[jj] = *(const u32x2*)(zp + l8 + 512 * jj); }
        f32x4 v[4];
#pragma unroll
        for (int jj = 0; jj < 4; ++jj) {
            v[jj] = (f32x4){bf_lo(ow[jj].x), bf_hi(ow[jj].x), bf_lo(ow[jj].y), bf_hi(ow[jj].y)};
            float ss = (v[jj][0] * v[jj][0] + v[jj][1] * v[jj][1]) + (v[jj][2] * v[jj][2] + v[jj][3] * v[jj][3]);
            ss += dppmov<0xB1>(ss); ss += dppmov<0x4E>(ss); ss += dppmov<0x141>(ss); ss += dppmov<0x140>(ss); ss += shx<16>(ss);
            const float rs = rsqrtf(ss * (1.0f / 128.0f) + RMS_EPS);
            const float z0 = bf_lo(zw[jj].x), z1 = bf_hi(zw[jj].x), z2 = bf_lo(zw[jj].y), z3 = bf_hi(zw[jj].y);
            v[jj][0] = v[jj][0] * rs * nwv[0] * silu_f(z0); v[jj][1] = v[jj][1] * rs * nwv[1] * silu_f(z1);
            v[jj][2] = v[jj][2] * rs * nwv[2] * silu_f(z2); v[jj][3] = v[jj][3] * rs * nwv[3] * silu_f(z3);
        }
        store_row16_bf16(O + (size_t)row * D_, lane, v);
    }
}
constexpr size_t GB_KR = 128 * MiB, GB_QR = 160 * MiB, GB_KT = 192 * MiB, GB_VT = 224 * MiB, GB_BLOB = 256 * MiB;
constexpr int BLOB_ELEMS = 28672, BLOB_W = 0, BLOB_QG = 8192, BLOB_QK = 16384, BLOB_KDT = 20480;
DI int frag_pos(int row, int k, int nks) { const int kk = k & 31; return ((((row >> 4) * nks + (k >> 5)) * 64 + ((kk >> 2) & 3) * 16 + (row & 15)) * 8) + 4 * (kk >> 4) + (kk & 3); }
#define MFMA16(a, b, c) __builtin_amdgcn_mfma_f32_16x16x32_bf16((a), (b), (c), 0, 0, 0)
DI u32x2 pk4(float a, float b, float c, float d) { u32x2 w; w.x = cvtpk(a, b); w.y = cvtpk(c, d); return w; }

DI int tile_off(int t, int c) { return t * 256 + ((((c >> 4) ^ (t & 7)) << 5) | ((c & 15) << 1)); }
template <int WH> DI void prep_conv_pass(const bf16* PROJ, const float* cw, int b, int hh, int t0, int lane, LAS unsigned char* tile, bf16* rowdst, const LAS float* escale, bool normalize, float nscale) {
    float w[4][2];
#pragma unroll
    for (int jj = 0; jj < 4; ++jj) { const f32x2 t = *(const f32x2*)(cw + (size_t)jj * 3072 + WH * 1024 + hh * 128 + 2 * lane); w[jj][0] = t.x; w[jj][1] = t.y; }
    float A0[35], A1[35];
#pragma unroll
    for (int jj = 0; jj < 3; ++jj) { const int t = t0 - 3 + jj; unsigned u = 0u;
        if (t >= 0) u = *(const unsigned*)(PROJ + ((size_t)b * S_ + t) * 4096 + WH * 1024 + hh * 128 + 2 * lane);
        A0[jj] = bf_lo(u); A1[jj] = bf_hi(u); }
#pragma unroll 1
    for (int hb = 0; hb < 2; ++hb) {
        { unsigned xin[32];
#pragma unroll
          for (int i = 0; i < 32; ++i) xin[i] = *(const unsigned*)(PROJ + ((size_t)b * S_ + t0 + 32 * hb + i) * 4096 + WH * 1024 + hh * 128 + 2 * lane);
#pragma unroll
          for (int i = 0; i < 32; ++i) { A0[3 + i] = bf_lo(xin[i]); A1[3 + i] = bf_hi(xin[i]); } }
#pragma unroll
        for (int i = 0; i < 32; ++i) {
            A0[i] = w[0][0] * A0[i] + w[1][0] * A0[i + 1] + w[2][0] * A0[i + 2] + w[3][0] * A0[i + 3];
            A1[i] = w[0][1] * A1[i] + w[1][1] * A1[i + 1] + w[2][1] * A1[i + 2] + w[3][1] * A1[i + 3]; }
#pragma unroll
        for (int i = 0; i < 32; ++i) { A0[i] = silu_f(A0[i]); A1[i] = silu_f(A1[i]); }
        if (normalize) {
            float rs[32];
#pragma unroll
            for (int i = 0; i < 32; ++i) rs[i] = wave_sum(A0[i] * A0[i] + A1[i] * A1[i]);
#pragma unroll
            for (int i = 0; i < 32; ++i) { const float r = rsqrtf(rs[i] + RMS_EPS) * nscale; A0[i] *= r; A1[i] *= r; }
        }
#pragma unroll
        for (int i = 0; i < 32; ++i) {
            const int tt = 32 * hb + i;
            if (rowdst) *(unsigned*)(rowdst + (size_t)tt * 128 + 2 * lane) = cvtpk(A0[i], A1[i]);
            const float es = escale ? escale[tt] : 1.0f;
            *(LAS unsigned*)(tile + tile_off(tt, 2 * lane)) = cvtpk(A0[i] * es, A1[i] * es);
        }
#pragma unroll
        for (int jj = 0; jj < 3; ++jj) { A0[jj] = A0[32 + jj]; A1[jj] = A1[32 + jj]; }
    }
    LDS_WAIT(); asm volatile("" ::: "memory");
}
DI void tile_tr8(const LAS unsigned char* tile, int tb, int tb2, int cb, int lane, s16x4& lo, s16x4& hi) {
    const int q4 = (lane & 15) >> 2, p4 = lane & 3;
    lo = vtr(tile + tile_off(tb + q4, cb + 4 * p4)); hi = vtr(tile + tile_off(tb2 + q4, cb + 4 * p4));
}
DI void gdn_prep2_phase(const Frame& F, const Args& A, int j) {
    unsigned char* ws = opq(A.ws); unsigned char* big = ws + WS_BIG;
    const bf16* PROJ = (const bf16*)(big + BIG_PROJ);
    bf16* KR = (bf16*)(big + GB_KR); bf16* QR = (bf16*)(big + GB_QR); bf16* KT = (bf16*)(big + GB_KT); bf16* VT = (bf16*)(big + GB_VT); bf16* BLOB = (bf16*)(big + GB_BLOB);
    const float* AB = (const float*)(ws + WS_AB); float* GC = (float*)(ws + WS_GALPHA); float* GB = (float*)(ws + WS_GBETA);
    const float* cw = A.gdn_conv_w + (size_t)j * 4 * 3072;
    const int gw = F.bid * NWAVES + F.wave, NGW = F.G * NWAVES, lane = F.lane, g16 = lane >> 4, i16 = lane & 15;
    LAS unsigned char* tile = F.lds + F.wave * 16384;
    LAS float* egl = (LAS float*)(F.lds + LDS_LG + F.wave * 512); LAS float* ekl = egl + 64;
    for (int it = gw; it < NB_ * 8 * 64; it += NGW) {
        const int b = it >> 9, hh = (it >> 6) & 7, n = it & 63, t0 = 64 * n, bh = b * 8 + hh;
        { const int row = b * S_ + t0 + lane; const float a = AB[(size_t)row * 16 + hh], bl = AB[(size_t)row * 16 + 8 + hh];
          const float xs = a + A.gdn_dt_bias[j * 8 + hh]; const float ey = __expf(xs); const float sp = xs > 20.f ? xs : (ey < 1e-3f ? ey * (1.0f - 0.5f * ey) : __logf(1.0f + ey));
          float gc = -__expf(A.gdn_a_log[j * 8 + hh]) * sp;
#pragma unroll
          for (int o = 1; o < 64; o <<= 1) { const float t = bperm(gc, lane - o); if (lane >= o) gc += t; }
          const float gl = rdlane(gc, 63);
          GC[(size_t)bh * S_ + t0 + lane] = gc; GB[(size_t)bh * S_ + t0 + lane] = 1.0f / (1.0f + __expf(-bl));
          egl[lane] = __expf(gc); ekl[lane] = __expf(gl - gc); }
        LDS_WAIT(); asm volatile("" ::: "memory");
        bf16* blob = BLOB + (size_t)it * BLOB_ELEMS;
        bf16* ktc = KT + (size_t)it * 8192; bf16* vtc = VT + (size_t)it * 8192;
        const size_t rbase = ((size_t)bh * S_ + t0) * 128;
        prep_conv_pass<1>(PROJ, cw, b, hh, t0, lane, tile, KR + rbase, nullptr, true, 1.0f);
#pragma unroll 2
        for (int db = 0; db < 8; ++db)
#pragma unroll
            for (int half = 0; half < 2; ++half) { s16x4 lo, hi; const int tb = 32 * half + 8 * g16; tile_tr8(tile, tb, tb + 4, 16 * db, lane, lo, hi);
                *(bf16x8*)(ktc + (16 * db + i16) * 64 + tb) = __builtin_shufflevector(lo, hi, 0, 1, 2, 3, 4, 5, 6, 7); }
#pragma unroll 2
        for (int a = 0; a < 8; ++a)
#pragma unroll
            for (int ks = 0; ks < 2; ++ks) { s16x4 lo, hi; const int tb = 32 * ks + 4 * g16; tile_tr8(tile, tb, tb + 16, 16 * a, lane, lo, hi);
                const f32x4 e0 = *(const LAS f32x4*)(ekl + tb), e1 = *(const LAS f32x4*)(ekl + tb + 16);
                u32x4 wv;
                wv.x = cvtpk(bf_lo((unsigned)(unsigned short)lo[0]) * e0[0], bf_lo((unsigned)(unsigned short)lo[1]) * e0[1]); wv.y = cvtpk(bf_lo((unsigned)(unsigned short)lo[2]) * e0[2], bf_lo((unsigned)(unsigned short)lo[3]) * e0[3]);
                wv.z = cvtpk(bf_lo((unsigned)(unsigned short)hi[0]) * e1[0], bf_lo((unsigned)(unsigned short)hi[1]) * e1[1]); wv.w = cvtpk(bf_lo((unsigned)(unsigned short)hi[2]) * e1[2], bf_lo((unsigned)(unsigned short)hi[3]) * e1[3]);
                *(u32x4*)(blob + BLOB_KDT + ((a * 2 + ks) * 64 + lane) * 8) = wv; }
        LDS_WAIT(); asm volatile("" ::: "memory");
        prep_conv_pass<2>(PROJ, cw, b, hh, t0, lane, tile, nullptr, nullptr, false, 1.0f);
#pragma unroll 2
        for (int db = 0; db < 8; ++db)
#pragma unroll
            for (int half = 0; half < 2; ++half) { s16x4 lo, hi; const int tb = 32 * half + 8 * g16; tile_tr8(tile, tb, tb + 4, 16 * db, lane, lo, hi);
                *(bf16x8*)(vtc + (16 * db + i16) * 64 + tb) = __builtin_shufflevector(lo, hi, 0, 1, 2, 3, 4, 5, 6, 7); }
        LDS_WAIT(); asm volatile("" ::: "memory");
        prep_conv_pass<0>(PROJ, cw, b, hh, t0, lane, tile, QR + rbase, egl, true, 0.08838834764831845f);
#pragma unroll 2
        for (int tm = 0; tm < 4; ++tm)
#pragma unroll
            for (int ks = 0; ks < 4; ++ks) {
                const u32x2 p0 = *(const LAS u32x2*)(tile + tile_off(16 * tm + i16, 32 * ks + 4 * g16)), p1 = *(const LAS u32x2*)(tile + tile_off(16 * tm + i16, 32 * ks + 16 + 4 * g16));
                *(u32x4*)(blob + BLOB_QG + ((tm * 4 + ks) * 64 + lane) * 8) = (u32x4){p0.x, p0.y, p1.x, p1.y}; }
        LDS_WAIT(); asm volatile("" ::: "memory");
    }
}

DI void gdn_wy_phase(const Frame& F, const Args& A) {
    unsigned char* ws = opq(A.ws); unsigned char* big = ws + WS_BIG;
    const bf16* KR = (const bf16*)(big + GB_KR); const bf16* QR = (const bf16*)(big + GB_QR); const bf16* KT = (const bf16*)(big + GB_KT); const bf16* VT = (const bf16*)(big + GB_VT);
    bf16* BLOB = (bf16*)(big + GB_BLOB); float* U = (float*)(ws + WS_HID);
    const float* GC = (const float*)(ws + WS_GALPHA); const float* GB = (const float*)(ws + WS_GBETA);
    const int gw = F.bid * NWAVES + F.wave, NGW = F.G * NWAVES, lane = F.lane, r = lane & 15, q = lane >> 4;
    LAS float* Af = (LAS float*)(F.lds + F.wave * 16384);
    asm volatile("s_waitcnt vmcnt(0)" ::: "memory"); __builtin_amdgcn_fence(__ATOMIC_ACQUIRE, "agent");
    for (int it = gw; it < NB_ * 8 * 64; it += NGW) {
        const int bh = it >> 6, n = it & 63;
        const char* kr = pg8::rfl_ptr((const char*)(KR + ((size_t)bh * S_ + 64 * n) * 128)); const char* qr = pg8::rfl_ptr((const char*)(QR + ((size_t)bh * S_ + 64 * n) * 128));
        const char* kt = pg8::rfl_ptr((const char*)(KT + (size_t)it * 8192)); const char* vt = pg8::rfl_ptr((const char*)(VT + (size_t)it * 8192));
        char* blob = (char*)pg8::rfl_ptr((const char*)(BLOB + (size_t)it * BLOB_ELEMS)); char* ub = (char*)pg8::rfl_ptr((const char*)(U + (size_t)it * 8192));
        const unsigned lrow = (unsigned)(r * 128 + 8 * q) * 2u, ltr = (unsigned)(r * 64 + 8 * q) * 2u, lfrag = (unsigned)(q * 16 + r) * 16u;
        const float gcl = GC[(size_t)bh * S_ + 64 * n + lane], bel = GB[(size_t)bh * S_ + 64 * n + lane];
        __builtin_amdgcn_wave_barrier();
        bf16x8 kfr[4][4], qfr[4][4];
#pragma unroll
        for (int t4 = 0; t4 < 4; ++t4)
#pragma unroll
            for (int ks = 0; ks < 4; ++ks) { kfr[t4][ks] = *(const bf16x8*)(kr + lrow + (16 * t4 * 128 + 32 * ks) * 2); qfr[t4][ks] = *(const bf16x8*)(qr + lrow + (16 * t4 * 128 + 32 * ks) * 2); }
#pragma unroll
        for (int ti = 0; ti < 4; ++ti) {
            const float gi = bperm(gcl, 16 * ti + r), bi = bperm(bel, 16 * ti + r);
#pragma unroll
            for (int tj = 0; tj < 4; ++tj) {
                char* qkdst = blob + (BLOB_QK + ((ti * 2 + (tj >> 1)) * 64) * 8 + 4 * (tj & 1)) * 2 + lfrag;
                if (tj > ti) { *(u32x2*)qkdst = (u32x2){0u, 0u}; *(LAS f32x4*)(Af + (16 * ti + r) * 64 + 16 * tj + 4 * q) = (f32x4){0.f, 0.f, 0.f, 0.f}; continue; }
                f32x4 p1 = (f32x4){0.f, 0.f, 0.f, 0.f}, p2 = p1;
#pragma unroll
                for (int ks = 0; ks < 4; ++ks) { p1 = MFMA16(kfr[tj][ks], kfr[ti][ks], p1); p2 = MFMA16(kfr[tj][ks], qfr[ti][ks], p2); }
                const int i = 16 * ti + r; f32x4 av, qv;
#pragma unroll
                for (int reg = 0; reg < 4; ++reg) { const int jx = 16 * tj + 4 * q + reg; const float gj = bperm(gcl, jx);
                    const float dec = (jx <= i) ? __expf(gi - gj) : 0.f;
                    av[reg] = (jx < i) ? bi * p1[reg] * dec : 0.f; qv[reg] = p2[reg] * dec; }
                *(LAS f32x4*)(Af + i * 64 + 16 * tj + 4 * q) = av;
                *(u32x2*)qkdst = pk4(qv[0], qv[1], qv[2], qv[3]);
                asm volatile("" ::: "memory");
            }
        }
        LDS_WAIT(); asm volatile("" ::: "memory");
#pragma unroll 1
        for (int i0 = 0; i0 < 64; i0 += 4) {
            float a0 = (i0 + 0 == lane) ? 1.0f : 0.0f, a1 = (i0 + 1 == lane) ? 1.0f : 0.0f, a2 = (i0 + 2 == lane) ? 1.0f : 0.0f, a3 = (i0 + 3 == lane) ? 1.0f : 0.0f;
#pragma unroll 2
            for (int j4 = 0; j4 < (i0 >> 2); ++j4) {
                const float t0 = Af[(4 * j4 + 0) * 64 + lane], t1 = Af[(4 * j4 + 1) * 64 + lane], t2 = Af[(4 * j4 + 2) * 64 + lane], t3 = Af[(4 * j4 + 3) * 64 + lane];
                const f32x4 r0 = *(const LAS f32x4*)(Af + (i0 + 0) * 64 + 4 * j4), r1 = *(const LAS f32x4*)(Af + (i0 + 1) * 64 + 4 * j4);
                const f32x4 r2 = *(const LAS f32x4*)(Af + (i0 + 2) * 64 + 4 * j4), r3 = *(const LAS f32x4*)(Af + (i0 + 3) * 64 + 4 * j4);
                a0 -= r0[0] * t0 + r0[1] * t1 + r0[2] * t2 + r0[3] * t3; a1 -= r1[0] * t0 + r1[1] * t1 + r1[2] * t2 + r1[3] * t3;
                a2 -= r2[0] * t0 + r2[1] * t1 + r2[2] * t2 + r2[3] * t3; a3 -= r3[0] * t0 + r3[1] * t1 + r3[2] * t2 + r3[3] * t3;
            }
            const f32x4 d1 = *(const LAS f32x4*)(Af + (i0 + 1) * 64 + i0), d2 = *(const LAS f32x4*)(Af + (i0 + 2) * 64 + i0), d3 = *(const LAS f32x4*)(Af + (i0 + 3) * 64 + i0);
            a1 -= d1[0] * a0; a2 -= d2[0] * a0 + d2[1] * a1; a3 -= d3[0] * a0 + d3[1] * a1 + d3[2] * a2;
            LDS_WAIT(); asm volatile("" ::: "memory");
            Af[(i0 + 0) * 64 + lane] = a0; Af[(i0 + 1) * 64 + lane] = a1; Af[(i0 + 2) * 64 + lane] = a2; Af[(i0 + 3) * 64 + lane] = a3;
            LDS_WAIT(); asm volatile("" ::: "memory");
        }
        bf16x8 tuf[4][2], twf[4][2];
        {
            const float* gcp = GC + (size_t)bh * S_ + 64 * n; const float* gbp = GB + (size_t)bh * S_ + 64 * n;
#pragma unroll
            for (int ks = 0; ks < 2; ++ks) {
                float su[8], sw[8];
#pragma unroll
                for (int h4 = 0; h4 < 2; ++h4) { const f32x4 bv = *(const f32x4*)(gbp + 32 * ks + 8 * q + 4 * h4), gv = *(const f32x4*)(gcp + 32 * ks + 8 * q + 4 * h4);
#pragma unroll
                    for (int e = 0; e < 4; ++e) { su[4 * h4 + e] = bv[e]; sw[4 * h4 + e] = -bv[e] * __expf(gv[e]); } }
#pragma unroll
                for (int tm = 0; tm < 4; ++tm) {
                    const f32x4 x0 = *(const LAS f32x4*)(Af + (16 * tm + r) * 64 + 32 * ks + 8 * q), x1 = *(const LAS f32x4*)(Af + (16 * tm + r) * 64 + 32 * ks + 8 * q + 4);
                    tuf[tm][ks] = __builtin_bit_cast(bf16x8, (u32x4){cvtpk(x0[0] * su[0], x0[1] * su[1]), cvtpk(x0[2] * su[2], x0[3] * su[3]), cvtpk(x1[0] * su[4], x1[1] * su[5]), cvtpk(x1[2] * su[6], x1[3] * su[7])});
                    twf[tm][ks] = __builtin_bit_cast(bf16x8, (u32x4){cvtpk(x0[0] * sw[0], x0[1] * sw[1]), cvtpk(x0[2] * sw[2], x0[3] * sw[3]), cvtpk(x1[0] * sw[4], x1[1] * sw[5]), cvtpk(x1[2] * sw[6], x1[3] * sw[7])});
                }
            }
        }
        LDS_WAIT(); asm volatile("" ::: "memory");
        {
#pragma unroll
            for (int w8 = 0; w8 < 8; ++w8) {
                bf16x8 vb[2];
#pragma unroll
                for (int ks = 0; ks < 2; ++ks) vb[ks] = *(const bf16x8*)(vt + ltr + (16 * w8 * 64 + 32 * ks) * 2);
#pragma unroll
                for (int tm = 0; tm < 4; ++tm) { f32x4 acc = (f32x4){0.f, 0.f, 0.f, 0.f};
#pragma unroll
                    for (int ks = 0; ks < 2; ++ks) acc = MFMA16(tuf[tm][ks], vb[ks], acc);
                    *(f32x4*)(ub + (unsigned)lane * 16u + ((w8 * 4 + tm) * 64) * 16) = acc; }
            }
        }
        {
#pragma unroll
            for (int a = 0; a < 8; ++a) {
                bf16x8 ka[2];
#pragma unroll
                for (int ks = 0; ks < 2; ++ks) ka[ks] = *(const bf16x8*)(kt + ltr + (16 * a * 64 + 32 * ks) * 2);
#pragma unroll
                for (int ti = 0; ti < 4; ++ti) { f32x4 acc = (f32x4){0.f, 0.f, 0.f, 0.f};
#pragma unroll
                    for (int ks = 0; ks < 2; ++ks) acc = MFMA16(ka[ks], twf[ti][ks], acc);
                    *(u32x2*)(blob + (BLOB_W + ((ti * 4 + (a >> 1)) * 64) * 8 + 4 * (a & 1)) * 2 + lfrag) = pk4(acc[0], acc[1], acc[2], acc[3]); }
            }
        }
        LDS_WAIT(); asm volatile("" ::: "memory");
    }
}

constexpr int SCAN_BUF = BLOB_ELEMS * 2;
DI bf16x8 pack8(const f32x4& lo, const f32x4& hi) { return __builtin_bit_cast(bf16x8, (u32x4){cvtpk(lo[0], lo[1]), cvtpk(lo[2], lo[3]), cvtpk(hi[0], hi[1]), cvtpk(hi[2], hi[3])}); }
DI void ld16_asm(u32x4& dst, const char* sbase, unsigned voff) { asm volatile("global_load_dwordx4 %0, %1, %2" : "=v"(dst) : "v"(voff), "s"(sbase) : "memory"); }
#define SCAN_LOAD(RSET, chunk) do { const char* _cb = pg8::rfl_ptr(src + (size_t)(chunk) * SCAN_BUF); \
    _Pragma("unroll") for (int i = 0; i < 14; ++i) ld16_asm(RSET[i], pg8::rfl_ptr(_cb + i * 4096), ltid16); } while (0)
#define SCAN_PUT(RSET, BUF) do { _Pragma("unroll") for (int i = 0; i < 14; ++i) *(LAS u32x4*)(F.lds + (BUF) * SCAN_BUF + i * 4096 + ltid16) = RSET[i]; } while (0)
#define SCAN_LSTEP(n_, BUFN, RFREE, RNEXT) do { const int n = (n_); \
    if (n + 3 < 64) { SCAN_LOAD(RFREE, n + 3); asm volatile("s_waitcnt vmcnt(28)" ::: "memory"); } else { asm volatile("s_waitcnt vmcnt(0)" ::: "memory"); } \
    __builtin_amdgcn_sched_barrier(0); \
    if (n + 1 < 64) SCAN_PUT(RNEXT, BUFN); \
    asm volatile("s_waitcnt lgkmcnt(0)" ::: "memory"); __builtin_amdgcn_s_barrier(); asm volatile("" ::: "memory"); } while (0)
#define SCAN_CSTEP(n_, BUFC, UC) do { const int n = (n_); \
        const LAS unsigned char* buf = F.lds + (BUFC) * SCAN_BUF; \
        f32x4 vn[4]; \
        _Pragma("unroll") for (int tm = 0; tm < 4; ++tm) vn[tm] = UC[tm]; \
        if (n + 2 < 64) { const char* u2 = pg8::rfl_ptr(ubase + (size_t)(n + 2) * 8192 * 4); _Pragma("unroll") for (int tm = 0; tm < 4; ++tm) UC[tm] = *(const f32x4*)(u2 + lane16 + tm * 1024); } \
        if (n > 0) { char* op = (char*)pg8::rfl_ptr(obase + (size_t)(64 * (n - 1)) * D_ * 2); \
            _Pragma("unroll") for (int tm = 0; tm < 4; ++tm) _Pragma("unroll") for (int reg = 0; reg < 4; ++reg) *(bf16*)(op + olane + (16 * tm + reg) * D_ * 2) = (bf16)cvtpk(o[tm][reg], 0.f); } \
        const float glast = rdlane(gl_all, n); \
        bf16x8 sb[4]; \
        _Pragma("unroll") for (int ks = 0; ks < 4; ++ks) sb[ks] = pack8(S[2 * ks], S[2 * ks + 1]); \
          \
        bf16x8 fw[16], fq[16], fk[8], fd[16]; bf16x8 vb[2]; \
        _Pragma("unroll") for (int i = 0; i < 16; ++i) fw[i] = *(const LAS bf16x8*)(buf + BLOB_W * 2 + (i * 64 + lane) * 16); \
        __builtin_amdgcn_sched_barrier(0); \
        _Pragma("unroll") for (int i = 0; i < 16; ++i) fq[i] = *(const LAS bf16x8*)(buf + BLOB_QG * 2 + (i * 64 + lane) * 16); \
        __builtin_amdgcn_sched_barrier(0); \
        _Pragma("unroll") for (int tm = 0; tm < 4; ++tm) _Pragma("unroll") for (int ks = 0; ks < 4; ++ks) vn[tm] = MFMA16(fw[tm * 4 + ks], sb[ks], vn[tm]); \
        __builtin_amdgcn_sched_barrier(0); \
        _Pragma("unroll") for (int i = 0; i < 8; ++i) fk[i] = *(const LAS bf16x8*)(buf + BLOB_QK * 2 + (i * 64 + lane) * 16); \
        __builtin_amdgcn_sched_barrier(0); \
        _Pragma("unroll") for (int tm = 0; tm < 4; ++tm) { o[tm] = (f32x4){0.f, 0.f, 0.f, 0.f}; \
            _Pragma("unroll") for (int ks = 0; ks < 4; ++ks) o[tm] = MFMA16(fq[tm * 4 + ks], sb[ks], o[tm]); } \
        _Pragma("unroll") for (int k2 = 0; k2 < 2; ++k2) vb[k2] = pack8(vn[2 * k2], vn[2 * k2 + 1]); \
        __builtin_amdgcn_sched_barrier(0); \
        _Pragma("unroll") for (int i = 0; i < 16; ++i) fd[i] = *(const LAS bf16x8*)(buf + BLOB_KDT * 2 + (i * 64 + lane) * 16); \
        __builtin_amdgcn_sched_barrier(0); \
        _Pragma("unroll") for (int tm = 0; tm < 4; ++tm) _Pragma("unroll") for (int k2 = 0; k2 < 2; ++k2) o[tm] = MFMA16(fk[tm * 2 + k2], vb[k2], o[tm]); \
        __builtin_amdgcn_sched_barrier(0); \
        _Pragma("unroll") for (int a = 0; a < 8; ++a) { S[a] = S[a] * glast; \
            _Pragma("unroll") for (int k2 = 0; k2 < 2; ++k2) S[a] = MFMA16(fd[a * 2 + k2], vb[k2], S[a]); } \
    asm volatile("s_waitcnt lgkmcnt(0)" ::: "memory"); __builtin_amdgcn_s_barrier(); asm volatile("" ::: "memory"); } while (0)

DI void gdn_scan2_phase(const Frame& F, const Args& A) {
    unsigned char* ws = opq(A.ws); unsigned char* big = ws + WS_BIG;
    const bf16* BLOB = (const bf16*)(big + GB_BLOB); const float* U = (const float*)(ws + WS_HID); bf16* Oraw = (bf16*)(ws + WS_Y);
    const float* GC = (const float*)(ws + WS_GALPHA);
    const int lane = F.lane, r = lane & 15, q = lane >> 4, w = F.wave;
    for (int it2 = F.bid; it2 < NB_ * 8 * 2; it2 += F.G) {
        const int item = it2 >> 1, half = it2 & 1, b = item >> 3, hh = item & 7, dvw = 4 * half + (w & 3);
        const char* src = pg8::rfl_ptr((const char*)(BLOB + (size_t)item * 64 * BLOB_ELEMS));
        __syncthreads();
        if (w >= 4) {
            const unsigned ltid16 = (unsigned)((w & 3) * 64 + lane) * 16u;
            u32x4 r0[14], r1[14], r2[14];
            SCAN_LOAD(r0, 0); SCAN_LOAD(r1, 1); SCAN_LOAD(r2, 2); asm volatile("s_waitcnt vmcnt(28)" ::: "memory"); __builtin_amdgcn_sched_barrier(0); SCAN_PUT(r0, 0);
            asm volatile("s_waitcnt lgkmcnt(0)" ::: "memory"); __builtin_amdgcn_s_barrier(); asm volatile("" ::: "memory");
#pragma unroll 1
            for (int n6 = 0; n6 < 60; n6 += 6) {
                SCAN_LSTEP(n6 + 0, 1, r0, r1); SCAN_LSTEP(n6 + 1, 0, r1, r2); SCAN_LSTEP(n6 + 2, 1, r2, r0);
                SCAN_LSTEP(n6 + 3, 0, r0, r1); SCAN_LSTEP(n6 + 4, 1, r1, r2); SCAN_LSTEP(n6 + 5, 0, r2, r0);
            }
            SCAN_LSTEP(60, 1, r0, r1); SCAN_LSTEP(61, 0, r1, r2); SCAN_LSTEP(62, 1, r2, r0); SCAN_LSTEP(63, 0, r0, r1);
        } else {
            f32x4 S[8];
#pragma unroll
            for (int a = 0; a < 8; ++a) S[a] = (f32x4){0.f, 0.f, 0.f, 0.f};
            const char* ubase = pg8::rfl_ptr((const char*)(U + (size_t)item * 64 * 8192 + (size_t)(dvw * 4) * 256));
            const char* obase = pg8::rfl_ptr((const char*)(Oraw + (size_t)b * S_ * D_ + hh * 128 + 16 * dvw));
            const unsigned lane16 = (unsigned)lane * 16u, olane = (unsigned)((4 * q) * D_ + r) * 2u;
            const float gl_all = __expf(GC[(size_t)item * S_ + 64 * lane + 63]);
            f32x4 ua[4], ub[4], o[4];
#pragma unroll
            for (int tm = 0; tm < 4; ++tm) { ua[tm] = *(const f32x4*)(ubase + lane16 + tm * 1024); ub[tm] = *(const f32x4*)(ubase + 8192 * 4 + lane16 + tm * 1024); o[tm] = (f32x4){0.f, 0.f, 0.f, 0.f}; }
            asm volatile("s_waitcnt lgkmcnt(0)" ::: "memory"); __builtin_amdgcn_s_barrier(); asm volatile("" ::: "memory");
#pragma unroll 1
            for (int n2 = 0; n2 < 64; n2 += 2) { SCAN_CSTEP(n2, 0, ua); SCAN_CSTEP(n2 + 1, 1, ub); }
            { char* op = (char*)obase + (size_t)(64 * 63) * D_ * 2;
#pragma unroll
              for (int tm = 0; tm < 4; ++tm)
#pragma unroll
                  for (int reg = 0; reg < 4; ++reg) *(bf16*)(op + olane + (16 * tm + reg) * D_ * 2) = (bf16)cvtpk(o[tm][reg], 0.f); }
        }
    }
}
#undef SCAN_LSTEP
#undef SCAN_CSTEP
#undef SCAN_LOAD
#undef SCAN_PUT
constexpr int N_PHASES = 42;
#ifndef MK_FUSED
#define MK_FUSED 1
#endif

#if MK_FUSED
typedef const __attribute__((address_space(4))) Args* CArgsP;
DI Args fresh_args() {
#if defined(__HIP_DEVICE_COMPILE__)
    CArgsP kp = (CArgsP)__builtin_amdgcn_kernarg_segment_ptr(); asm volatile("" : "+s"(kp)); Args a = *kp;
    a.x = asg(a.x); a.c = asg(a.c); a.pos = asg(a.pos); a.ada_w = asg(a.ada_w); a.ada_b = asg(a.ada_b); a.ln_g = asg(a.ln_g); a.ln_b = asg(a.ln_b);
    a.attn_w_in = asg(a.attn_w_in); a.attn_w_out = asg(a.attn_w_out); a.gdn_w_in = asg(a.gdn_w_in); a.gdn_conv_w = asg(a.gdn_conv_w); a.gdn_a_log = asg(a.gdn_a_log); a.gdn_dt_bias = asg(a.gdn_dt_bias);
    a.gdn_norm_w = asg(a.gdn_norm_w); a.gdn_w_out = asg(a.gdn_w_out); a.router_w = asg(a.router_w); a.router_bias = asg(a.router_bias); a.ew1 = asg(a.ew1); a.ew3 = asg(a.ew3); a.ew2 = asg(a.ew2);
    a.sw1 = asg(a.sw1); a.sw3 = asg(a.sw3); a.sw2 = asg(a.sw2); a.out = asg(a.out); a.ws = asg(a.ws);
    return a;
#else
    return Args{};
#endif
}
DI Frame fresh_frame(int wave_s) { Frame F; int g = gridDim.x; asm volatile("" : "+s"(g)); int b = blockIdx.x; asm volatile("" : "+s"(b)); unsigned l = 0u; asm volatile("" : "+s"(l));
    int w = wave_s; asm volatile("" : "+s"(w)); int ln; asm volatile("v_mbcnt_lo_u32_b32 %0, -1, 0\n\tv_mbcnt_hi_u32_b32 %0, -1, %0" : "=&v"(ln));
    F.lds = (LAS unsigned char*)(size_t)l; F.tid = w * 64 + ln; F.lane = ln; F.wave = w; F.G = g; F.bid = b; return F; }
#define PHF() const Args A = fresh_args(); const Frame F = fresh_frame(wave_s); \
    unsigned char* ws = opq(A.ws); LAS int* idxlds = (LAS int*)(F.lds + LDS_IDX); const LAS int* tileoff = (const LAS int*)(F.lds + LDS_TILEOFF); (void)ws; (void)idxlds; (void)tileoff;
DI void ph_pro(const int wave_s) { PHF(); prologue_phase(F, A); convert_experts(F, A, 0, 0, 0, F.G); }
DI void ph_modx(const int wave_s) { PHF(); modx_phase(F, A); }
DI void ph_attn(const int wave_s) { PHF(); attn_phase(F, A); }
DI void ph_lnr(const int wave_s, int L) { PHF(); if (L == 0) ln_router_phase<true>(F, A, L); else ln_router_phase<false>(F, A, L); }
DI void ph_lnr_dry(const int wave_s, int L) { PHF(); if (L == 0) ln_router_phase<true>(F, A, L, true); else ln_router_phase<false>(F, A, L, true); }
DI void ph_scat(const int wave_s, int L) { PHF(); moe_scatter_phase(F, A, L); }
DI void ph_lnm(const int wave_s, int L) { PHF(); ln_moe_phase(F, A, L, nullptr); }
DI void ph_lnm_dry(const int wave_s, int L) { PHF(); ln_moe_phase(F, A, L, (float*)(ws + WS_Y)); }
DI void ph_gprep(const int wave_s, int lp) { PHF(); gdn_prep2_phase(F, A, lp); }
DI void ph_gwy(const int wave_s) { PHF(); gdn_wy_phase(F, A); }
DI void ph_gscan(const int wave_s, int L) { PHF(); gdn_scan2_phase(F, A); if (F.G > 128) { convert_experts(F, A, L, 0, 64, F.G - 64); if (L == 1) convert_experts(F, A, 2, 1, 64, F.G - 64); } else { convert_experts(F, A, L, 0, 0, F.G); if (L == 1) convert_experts(F, A, 2, 1, 0, F.G); } }
DI void ph_gpost(const int wave_s, int lp) { PHF(); gdn_post_phase(F, A, lp); }
DI void ph_gemm_qkv(const int wave_s, int lp) { PHF();
    pg8::DenseOrder S; S.init(WS_H, WS_WA_IN + (size_t)lp * 9216 * D_ * 2, T_, 9216, D_, F.G, F.bid);
    pg8::EpiQKV E{(bf16*)(ws + WS_BIG), (const float*)(ws + WS_COS), (const float*)(ws + WS_SIN)};
    pg8::gemm_phase<pg8::EpiQKV, pg8::DenseOrder, true, true>(F.tid, ws, F.lds, idxlds, D_, S, E); }
DI void ph_gemm_out(const int wave_s, int lp, int isg) { PHF();
    pg8::DenseOrder S; S.init(WS_O, (isg ? WS_WG_OUT : WS_WA_OUT) + (size_t)lp * D_ * D_ * 2, T_, D_, D_, F.G, F.bid);
    pg8::EpiBf16 E{(bf16*)(ws + WS_Y), D_};
    pg8::gemm_phase<pg8::EpiBf16, pg8::DenseOrder, true, true>(F.tid, ws, F.lds, idxlds, D_, S, E); }
DI void ph_gemm_gin(const int wave_s, int lp) { PHF();
    pg8::DenseOrder S; S.init(WS_H, WS_WG_IN + (size_t)lp * 4096 * D_ * 2, T_, 4096, D_, F.G, F.bid);
    pg8::EpiBf16 E{(bf16*)(ws + WS_BIG + BIG_PROJ), 4096};
    pg8::gemm_phase<pg8::EpiBf16, pg8::DenseOrder, true, true>(F.tid, ws, F.lds, idxlds, D_, S, E); }
DI void ph_moe1(const int wave_s, int L) { PHF();
    const unsigned* gcount = (const unsigned*)(ws + WS_CTL) + CW_CNT + L * 64;
    build_tileoff(F, gcount);
    pg8::MoeOrder<true> S; S.A = (unsigned)WS_H; S.Bt = (unsigned)(L == 2 ? WS_WEB : WS_WE1); S.K = D_; S.nct_log = 1; S.nunits = __builtin_amdgcn_readfirstlane(tileoff[65]) * 2; S.G = F.G; S.c = F.bid;
    S.idxoff = (unsigned)WS_ETOK; S.tileoff = tileoff; S.ecnt = (const LAS int*)(F.lds + LDS_ECNT); S.bstride = (unsigned)(512 * D_ * 2);
    pg8::EpiSwiGLU E{(bf16*)(ws + WS_HID)};
    pg8::gemm_phase<pg8::EpiSwiGLU, pg8::MoeOrder<true>, true, true>(F.tid, ws, F.lds, idxlds, D_, S, E); }
DI void ph_moe2(const int wave_s, int L) { PHF();
    const unsigned* gcount = (const unsigned*)(ws + WS_CTL) + CW_CNT + L * 64;
    build_tileoff(F, gcount);
    pg8::MoeOrder<false> S; S.A = (unsigned)WS_HID; S.Bt = (unsigned)(L == 2 ? WS_WEB + 65 * MiB : WS_WE2); S.K = 256; S.nct_log = 2; S.nunits = __builtin_amdgcn_readfirstlane(tileoff[(YS_BF16 && !YS_MERGED) ? 64 : 65]) * 4; S.G = F.G; S.c = F.bid;
    S.idxoff = (unsigned)WS_EW; S.tileoff = tileoff; S.ecnt = (const LAS int*)(F.lds + LDS_ECNT); S.bstride = (unsigned)(D_ * 256 * 2);
    pg8::EpiScale E{ws + WS_BIG, 256 * __builtin_amdgcn_readfirstlane(tileoff[64])};
    pg8::gemm_phase<pg8::EpiScale, pg8::MoeOrder<false>, false, false>(F.tid, ws, F.lds, idxlds, 256, S, E); }
DI void ph_moe2s(const int wave_s, int L) { PHF();
    __syncthreads();
    const size_t s0 = (size_t)(256 * __builtin_amdgcn_readfirstlane(((const LAS int*)(F.lds + LDS_TILEOFF))[64]));
    pg8::DenseOrder S; S.init(WS_HID + s0 * 256 * 2, (L == 2 ? WS_WEB + 65 * MiB : WS_WE2) + (size_t)NEXP * D_ * 256 * 2, T_, D_, 256, F.G, F.bid);
    pg8::EpiBf16 E{(bf16*)(ws + WS_BIG + WS_YS_OFF), D_};
    pg8::gemm_phase<pg8::EpiBf16, pg8::DenseOrder, false, false>(F.tid, ws, F.lds, idxlds, 256, S, E); }

DI void grid_bar(const int wave_s) { PHF(); XcdBarrier b; b.bar = (unsigned*)(ws + WS_CTL) + CW_BAR; volatile LAS unsigned* misc = (volatile LAS unsigned*)(F.lds + LDS_MISC); b.st = misc + 8;
    b.x = (unsigned)__builtin_amdgcn_readfirstlane((int)misc[10]); xcd_barrier(b, F.tid); }
__global__ void __launch_bounds__(NTHR, 2) mk_fwd(Args Ain) {
    extern __shared__ __attribute__((aligned(16))) unsigned char lds_raw[];
    LAS unsigned char* lds = (LAS unsigned char*)lds_raw;
    for (int u = threadIdx.x; u < (LDS_BYTES - RING_BYTES) / 4; u += NTHR) ((LAS unsigned*)(lds + RING_BYTES))[u] = 0u;
    __syncthreads();
    const int wave_s = __builtin_amdgcn_readfirstlane((int)threadIdx.x >> 6);
    { XcdBarrier bar = xcd_barrier_post((unsigned*)(Ain.ws + WS_CTL) + CW_BAR, (volatile LAS unsigned*)(lds + LDS_MISC) + 8);
      if (threadIdx.x == 0) ((volatile LAS unsigned*)(lds + LDS_MISC))[10] = bar.x; }
    __syncthreads();
#ifndef REP_BAR
#define REP_BAR 1
#define REP_PRO 1
#define REP_POST 1
#define REP_QKV 1
#define REP_OUT 1
#define REP_GIN 1
#define REP_M1 1
#define REP_M2 1
#define REP_LNM 1
#define REP_LNR 1
#endif
#define GBAR() do { for (int _b = 0; _b < REP_BAR; ++_b) grid_bar(wave_s); } while (0)
#ifndef REP_ATTN
#define REP_ATTN 1
#define REP_SCAN 1
#define REP_GEMM 1
#define REP_PREP 1
#define REP_CONV 1
#define REP_WY 1
#endif
    for (int r = 0; r < REP_PRO; ++r) { ph_pro(wave_s); GBAR(); }
    ph_modx(wave_s); GBAR();
#pragma unroll 1
    for (int L = 0; L < 4; ++L) {
        const int lp = L >> 1;
        if ((L & 1) == 0) { for (int r = 0; r < REP_QKV; ++r) { ph_gemm_qkv(wave_s, lp); GBAR(); } for (int r = 0; r < REP_ATTN; ++r) { ph_attn(wave_s); GBAR(); } for (int r = 0; r < REP_OUT; ++r) { ph_gemm_out(wave_s, lp, 0); GBAR(); } }
        else { for (int r = 0; r < REP_GIN; ++r) { ph_gemm_gin(wave_s, lp); GBAR(); } for (int r = 0; r < REP_PREP; ++r) { ph_gprep(wave_s, lp); GBAR(); } for (int r = 0; r < REP_WY; ++r) { ph_gwy(wave_s); GBAR(); } for (int r = 0; r < REP_SCAN; ++r) { ph_gscan(wave_s, L); GBAR(); } for (int r = 0; r < REP_POST; ++r) { ph_gpost(wave_s, lp); GBAR(); } for (int r = 0; r < REP_OUT; ++r) { ph_gemm_out(wave_s, lp, 1); GBAR(); } }
        for (int r = 1; r < REP_LNR; ++r) { ph_lnr_dry(wave_s, L); GBAR(); }
        ph_lnr(wave_s, L); GBAR();
        for (int r = 0; r < REP_M1; ++r) { ph_moe1(wave_s, L); GBAR(); }
        for (int r = 0; r < REP_M2; ++r) { ph_moe2(wave_s, L); if (YS_BF16 && !YS_MERGED) ph_moe2s(wave_s, L); GBAR(); }
        for (int r = 1; r < REP_LNM; ++r) { ph_lnm_dry(wave_s, L); GBAR(); }
        ph_lnm(wave_s, L); if (L < 3) GBAR();
    }
#undef GBAR
}
#else

#define MKF() extern __shared__ __attribute__((aligned(16))) unsigned char lds_raw[]; Frame F; F.lds = (LAS unsigned char*)lds_raw; F.tid = threadIdx.x; F.lane = F.tid & 63; \
    F.wave = __builtin_amdgcn_readfirstlane(F.tid >> 6); F.G = gridDim.x; F.bid = blockIdx.x; unsigned char* ws = opq(A.ws); LAS int* idxlds = (LAS int*)(F.lds + LDS_IDX); \
    const LAS int* tileoff = (const LAS int*)(F.lds + LDS_TILEOFF); (void)ws; (void)idxlds; (void)tileoff; \
    for (int u = F.tid; u < (LDS_BYTES - RING_BYTES) / 4; u += NTHR) ((LAS unsigned*)(F.lds + RING_BYTES))[u] = 0u; __syncthreads();
__global__ void __launch_bounds__(NTHR, 2) k_pro(Args A) { MKF(); prologue_phase(F, A); }
__global__ void __launch_bounds__(NTHR, 2) k_modx(Args A) { MKF(); modx_phase(F, A); }
__global__ void __launch_bounds__(NTHR, 2) k_attn(Args A) { MKF(); attn_phase(F, A); }
__global__ void __launch_bounds__(NTHR, 2) k_lnr(Args A) { MKF(); const int L = A.ph_lo; ln_router_phase<false>(F, A, L); }
__global__ void __launch_bounds__(NTHR, 2) k_scat(Args A) { MKF(); moe_scatter_phase(F, A, A.ph_lo); convert_experts(F, A, A.ph_lo); }
__global__ void __launch_bounds__(NTHR, 2) k_lnm(Args A) { MKF(); const int L = A.ph_lo; ln_moe_phase(F, A, L, nullptr); }
__global__ void __launch_bounds__(NTHR, 2) k_gprep(Args A) { MKF(); gdn_prep_phase(F, A, A.ph_lo); }
__global__ void __launch_bounds__(NTHR, 2) k_gscan(Args A) { MKF(); gdn_scan_phase(F, A); }
__global__ void __launch_bounds__(NTHR, 2) k_gpost(Args A) { MKF(); gdn_post_phase(F, A, A.ph_lo); }
__global__ void __launch_bounds__(NTHR, 2) k_gemm_qkv(Args A) { MKF(); const int lp = A.ph_lo;
    pg8::DenseOrder S; S.init(WS_H, WS_WA_IN + (size_t)lp * 9216 * D_ * 2, T_, 9216, D_, F.G, F.bid);
    pg8::EpiQKV E{(bf16*)(ws + WS_BIG), (const float*)(ws + WS_COS), (const float*)(ws + WS_SIN)};
    pg8::gemm_phase<pg8::EpiQKV, pg8::DenseOrder, true, true>(F.tid, ws, F.lds, idxlds, D_, S, E); }
__global__ void __launch_bounds__(NTHR, 2) k_gemm_out(Args A) { MKF(); const int lp = A.ph_lo >> 1, isg = A.ph_lo & 1;
    pg8::DenseOrder S; S.init(WS_O, (isg ? WS_WG_OUT : WS_WA_OUT) + (size_t)lp * D_ * D_ * 2, T_, D_, D_, F.G, F.bid);
    pg8::EpiF32 E{(float*)(ws + WS_Y), D_};
    pg8::gemm_phase<pg8::EpiF32, pg8::DenseOrder, true, true>(F.tid, ws, F.lds, idxlds, D_, S, E); }
__global__ void __launch_bounds__(NTHR, 2) k_gemm_gin(Args A) { MKF(); const int lp = A.ph_lo;
    pg8::DenseOrder S; S.init(WS_H, WS_WG_IN + (size_t)lp * 4096 * D_ * 2, T_, 4096, D_, F.G, F.bid);
    pg8::EpiBf16 E{(bf16*)(ws + WS_BIG + BIG_PROJ), 4096};
    pg8::gemm_phase<pg8::EpiBf16, pg8::DenseOrder, true, true>(F.tid, ws, F.lds, idxlds, D_, S, E); }
__global__ void __launch_bounds__(NTHR, 2) k_moe1(Args A) { MKF();
    const unsigned* gcount = (const unsigned*)(ws + WS_CTL) + CW_CNT + A.ph_lo * 64;
    build_tileoff(F, gcount);
    pg8::MoeOrder<true> S; S.A = (unsigned)WS_H; S.Bt = (unsigned)(L == 2 ? WS_WEB : WS_WE1); S.K = D_; S.nct_log = 1; S.nunits = __builtin_amdgcn_readfirstlane(tileoff[65]) * 2; S.G = F.G; S.c = F.bid;
    S.idxoff = (unsigned)WS_ETOK; S.tileoff = tileoff; S.ecnt = (const LAS int*)(F.lds + LDS_ECNT); S.bstride = (unsigned)(512 * D_ * 2);
    pg8::EpiSwiGLU E{(bf16*)(ws + WS_HID)};
    pg8::gemm_phase<pg8::EpiSwiGLU, pg8::MoeOrder<true>, true, true>(F.tid, ws, F.lds, idxlds, D_, S, E); }
__global__ void __launch_bounds__(NTHR, 2) k_moe2(Args A) { MKF();
    const unsigned* gcount = (const unsigned*)(ws + WS_CTL) + CW_CNT + A.ph_lo * 64;
    build_tileoff(F, gcount);
    pg8::MoeOrder<false> S; S.A = (unsigned)WS_HID; S.Bt = (unsigned)(L == 2 ? WS_WEB + 65 * MiB : WS_WE2); S.K = 256; S.nct_log = 2; S.nunits = __builtin_amdgcn_readfirstlane(tileoff[65]) * 4; S.G = F.G; S.c = F.bid;
    S.idxoff = (unsigned)WS_EW; S.tileoff = tileoff; S.ecnt = (const LAS int*)(F.lds + LDS_ECNT); S.bstride = (unsigned)(D_ * 256 * 2);
    pg8::EpiScale E{ws + WS_BIG, 256 * __builtin_amdgcn_readfirstlane(tileoff[64])};
    pg8::gemm_phase<pg8::EpiScale, pg8::MoeOrder<false>, false, false>(F.tid, ws, F.lds, idxlds, 256, S, E); }
#endif
extern "C" void kernel_launch(void* const* d_in, const int* in_sizes, int n_in, void* d_out, int out_size, void* d_ws, size_t ws_size, hipStream_t stream) {
    static int grid = 0;
    if (grid == 0) {
        if (n_in != 23 || in_sizes[0] != T_ * D_ || out_size != T_ * D_ || ws_size < WS_END) {
            fprintf(stderr, "kernel_launch: unexpected shapes (n_in %d, in0 %d, out %d, ws %zu < %zu); nothing launched\n", n_in, n_in > 0 ? in_sizes[0] : -1, out_size, ws_size, (size_t)WS_END); grid = -1; return; }
        int dev = 0, cus = 0, per_cu = 0;
        if (hipGetDevice(&dev) != hipSuccess || hipDeviceGetAttribute(&cus, hipDeviceAttributeMultiprocessorCount, dev) != hipSuccess) { grid = -1; return; }
#if MK_FUSED
        if (hipFuncSetAttribute((const void*)mk_fwd, hipFuncAttributeMaxDynamicSharedMemorySize, LDS_BYTES) != hipSuccess) { fprintf(stderr, "kernel_launch: hipFuncSetAttribute failed\n"); grid = -1; return; }
        if (hipOccupancyMaxActiveBlocksPerMultiprocessor(&per_cu, (const void*)mk_fwd, NTHR, LDS_BYTES) != hipSuccess || per_cu < 1)
            fprintf(stderr, "kernel_launch: note: occupancy query reports %d workgroups per CU\n", per_cu);
#else
        { const void* ks[] = {(const void*)k_pro, (const void*)k_modx, (const void*)k_attn, (const void*)k_lnr, (const void*)k_scat, (const void*)k_lnm, (const void*)k_gprep, (const void*)k_gscan, (const void*)k_gpost,
                              (const void*)k_gemm_qkv, (const void*)k_gemm_out, (const void*)k_gemm_gin, (const void*)k_moe1, (const void*)k_moe2};
          for (const void* k : ks) if (hipFuncSetAttribute(k, hipFuncAttributeMaxDynamicSharedMemorySize, LDS_BYTES) != hipSuccess) { fprintf(stderr, "kernel_launch: hipFuncSetAttribute failed\n"); grid = -1; return; } }
        (void)per_cu;
#endif
        (void)hipGetLastError();
        grid = cus;
    }
    if (grid < 0) return;
    (void)hipMemsetAsync((char*)d_ws + WS_CTL, 0, CTL_ZERO_BYTES, stream);
    Args a{};
    a.x = (const float*)d_in[0]; a.c = (const float*)d_in[1]; a.pos = (const int*)d_in[2]; a.ada_w = (const float*)d_in[3]; a.ada_b = (const float*)d_in[4];
    a.ln_g = (const float*)d_in[5]; a.ln_b = (const float*)d_in[6]; a.attn_w_in = (const float*)d_in[7]; a.attn_w_out = (const float*)d_in[8];
    a.gdn_w_in = (const float*)d_in[9]; a.gdn_conv_w = (const float*)d_in[10]; a.gdn_a_log = (const float*)d_in[11]; a.gdn_dt_bias = (const float*)d_in[12];
    a.gdn_norm_w = (const float*)d_in[13]; a.gdn_w_out = (const float*)d_in[14]; a.router_w = (const float*)d_in[15]; a.router_bias = (const float*)d_in[16];
    a.ew1 = (const float*)d_in[17]; a.ew3 = (const float*)d_in[18]; a.ew2 = (const float*)d_in[19]; a.sw1 = (const float*)d_in[20]; a.sw3 = (const float*)d_in[21]; a.sw2 = (const float*)d_in[22];
    a.out = (float*)d_out; a.ws = (unsigned char*)d_ws;
#if MK_FUSED
    a.ph_lo = 0; a.ph_hi = N_PHASES;
    hipLaunchKernelGGL(mk_fwd, dim3(grid), dim3(NTHR), LDS_BYTES, stream, a);
#else
#define LAUNCH(k, arg) do { a.ph_lo = (arg); a.ph_hi = (arg) + 1; hipLaunchKernelGGL(k, dim3(grid), dim3(NTHR), LDS_BYTES, stream, a); } while (0)
    LAUNCH(k_pro, 0); LAUNCH(k_modx, 0);
    for (int L = 0; L < 4; ++L) {
        const int lp = L >> 1;
        if ((L & 1) == 0) { LAUNCH(k_gemm_qkv, lp); LAUNCH(k_attn, 0); LAUNCH(k_gemm_out, 2 * lp); }
        else { LAUNCH(k_gemm_gin, lp); LAUNCH(k_gprep, lp); LAUNCH(k_gscan, 0); LAUNCH(k_gpost, lp); LAUNCH(k_gemm_out, 2 * lp + 1); }
        LAUNCH(k_lnr, L); LAUNCH(k_scat, L); LAUNCH(k_moe1, L); LAUNCH(k_moe2, L); LAUNCH(k_lnm, L);
    }
#undef LAUNCH
#endif
    const hipError_t le = hipPeekAtLastError();
    if (le != hipSuccess) fprintf(stderr, "kernel_launch: launch failed: %s\n", hipGetErrorName(le));
}
```

```cpp
#include <hip/hip_runtime.h>
#include <cstdio>
#include <cstdint>

#define GAS __attribute__((address_space(1)))
#define LAS __attribute__((address_space(3)))
typedef unsigned short bf16;
typedef unsigned u32x4 __attribute__((ext_vector_type(4)));
typedef unsigned u32x2 __attribute__((ext_vector_type(2)));
typedef float f32x2 __attribute__((ext_vector_type(2)));
typedef float f32x4 __attribute__((ext_vector_type(4)));
typedef float f32x16 __attribute__((ext_vector_type(16)));
typedef short bf16x8 __attribute__((ext_vector_type(8)));
typedef short s16x4 __attribute__((ext_vector_type(4)));
typedef __bf16 bf16x2_t __attribute__((ext_vector_type(2)));
#define DI __device__ __forceinline__

DI unsigned cvtpk(float lo, float hi) { f32x2 v = {lo, hi}; bf16x2_t b = __builtin_convertvector(v, bf16x2_t); return __builtin_bit_cast(unsigned, b); }
DI unsigned cvtpk_fp8(float a, float b, float c, float d) { int w = __builtin_amdgcn_cvt_pk_fp8_f32(a, b, 0, false); w = __builtin_amdgcn_cvt_pk_fp8_f32(c, d, w, true); return (unsigned)w; }
constexpr bool YS_BF16 = true;
constexpr bool YS_MERGED = true;
constexpr float YE_SCALE = 16.0f;
DI float silu_f(float a) { return a * __builtin_amdgcn_rcpf(1.0f + __expf(-a)); }
DI float bf_lo(unsigned u) { return __builtin_bit_cast(float, u << 16); }
DI float bf_hi(unsigned u) { return __builtin_bit_cast(float, u & 0xffff0000u); }
template <int M> DI float shx(float v) { return __builtin_bit_cast(float, __builtin_amdgcn_ds_swizzle(__builtin_bit_cast(int, v), (M << 10) | 0x1f)); }
DI float bperm(float v, int srclane) { return __builtin_bit_cast(float, __builtin_amdgcn_ds_bpermute(srclane << 2, __builtin_bit_cast(int, v))); }
DI float rdlane(float v, int l) { return __builtin_bit_cast(float, __builtin_amdgcn_readlane(__builtin_bit_cast(int, v), l)); }
template <int CTRL> DI float dppmov(float v) { return __builtin_bit_cast(float, __builtin_amdgcn_update_dpp(0, __builtin_bit_cast(int, v), CTRL, 0xf, 0xf, true)); }
DI float wave_sum(float v) { v += dppmov<0xB1>(v); v += dppmov<0x4E>(v); v += dppmov<0x141>(v); v += dppmov<0x140>(v); return (rdlane(v, 0) + rdlane(v, 16)) + (rdlane(v, 32) + rdlane(v, 48)); }
DI float wave_max(float v) { v = fmaxf(v, dppmov<0xB1>(v)); v = fmaxf(v, dppmov<0x4E>(v)); v = fmaxf(v, dppmov<0x141>(v)); v = fmaxf(v, dppmov<0x140>(v)); return fmaxf(fmaxf(rdlane(v, 0), rdlane(v, 16)), fmaxf(rdlane(v, 32), rdlane(v, 48))); }
#define LDS_WAIT() asm volatile("s_waitcnt lgkmcnt(0)" ::: "memory")
#define VM_WAIT() asm volatile("s_waitcnt vmcnt(0)" ::: "memory")

namespace pg8 {
constexpr int BM = 256, BK = 64, HALF = 128, HTB = HALF * BK * 2, STAGE_BYTES = 8 * HTB;
DI int lds_byte(int r, int c) { const int st = (r >> 4) * 2 + (c >> 5), rr = r & 15, cc = c & 31, ob = rr * 64 + cc * 2; return st * 1024 + (ob ^ (((ob >> 9) & 1) << 5)); }
DI void stage_rc(int b, int& R, int& C) { const int st = b / 1024, sb = b % 1024, swz = sb ^ (((sb >> 9) & 1) << 5); R = (st >> 1) * 16 + swz / 64; C = (st & 1) * 32 + (swz % 64) / 2; }
DI int perm32(int rho) { const int n = rho >> 4, i = rho & 15; return 8 * (i >> 2) + 4 * n + (i & 3); }

DI const char* rfl_ptr(const char* p) {
    const unsigned long long v = (unsigned long long)p; const unsigned lo = __builtin_amdgcn_readfirstlane((unsigned)v), hi = __builtin_amdgcn_readfirstlane((unsigned)(v >> 32));
    return (const char*)(const __attribute__((address_space(1))) char*)(((unsigned long long)hi << 32) | lo); }
struct Unit { unsigned a; unsigned b; int r0; int c0; int e; int rb; int nv; };

template <class Epi, class Sched, bool ALIGN_EPI, bool SP2>
DI void gemm_phase(const int tid, const void* wsbase, LAS unsigned char* lds, LAS int* idxlds, const int K, const Sched& S, const Epi& E) {
    const __amdgpu_buffer_rsrc_t rsrc = __builtin_amdgcn_make_buffer_rsrc((void*)wsbase, 0, 0xffffffff, 0x00020000);
    const int wid = __builtin_amdgcn_readfirstlane(tid >> 6), lane = tid & 63, wr = wid >> 2, wc = wid & 3, fr = lane & 15, fq = lane >> 4;
    const int nt = K / BK;
    unsigned voffB[2], voffA[2][2];
#pragma unroll
    for (int i = 0; i < 2; ++i) { int R, C; stage_rc(tid * 16 + i * 8192, R, C); const int Rb = Epi::PERM ? ((R & ~31) + perm32(R & 31)) : R;
        voffB[i] = (unsigned)(Rb * K + C) * 2u;
        voffA[0][i] = (unsigned)(R * K + C) * 2u; voffA[1][i] = (unsigned)((R + HALF) * K + C) * 2u; }
    const unsigned kstep = (unsigned)(BK * 2);
    const unsigned hstep = (unsigned)(HALF * K * 2);
    const unsigned ldsw = (unsigned)wid * 1024u;
    const int aoff = lds_byte(wr * 64 + fr, fq * 8), boff = lds_byte(wc * 32 + fr, fq * 8);
#define PG8_SA(b, h) (((b) * 2 + (h)) * HTB)
#define PG8_SB(b, h) ((4 + (b) * 2 + (h)) * HTB)
#define PG8_STAGE(bufoff, soff, voff) do { const int _so = __builtin_amdgcn_readfirstlane((int)(soff)); _Pragma("unroll") for (int _i = 0; _i < 2; ++_i) \
        __builtin_amdgcn_raw_ptr_buffer_load_lds(rsrc, (LAS void*)(lds + (bufoff) + ldsw + _i * 8192), 16, (int)(voff)[_i], _so, 0, 0); } while (0)
#define PG8_LDA(dst, b, h) do { _Pragma("unroll") for (int m = 0; m < 4; ++m) _Pragma("unroll") for (int k = 0; k < 2; ++k) dst[m][k] = *(const LAS bf16x8*)(lds + PG8_SA(b, h) + aoff + m * 2048 + k * 1024); } while (0)
#define PG8_LDB(dst, b, h) do { _Pragma("unroll") for (int n = 0; n < 2; ++n) _Pragma("unroll") for (int k = 0; k < 2; ++k) dst[n][k] = *(const LAS bf16x8*)(lds + PG8_SB(b, h) + boff + n * 2048 + k * 1024); } while (0)
#define PG8_MMA(ai, bj, At, Bt) do { __builtin_amdgcn_s_setprio(1); _Pragma("unroll") for (int m = 0; m < 4; ++m) _Pragma("unroll") for (int n = 0; n < 2; ++n) _Pragma("unroll") for (int k = 0; k < 2; ++k) \
        acc[ai][bj][m][n] = __builtin_amdgcn_mfma_f32_16x16x32_bf16(Bt[n][k], At[m][k], acc[ai][bj][m][n], 0, 0, 0); __builtin_amdgcn_s_setprio(0); } while (0)
#define PG8_WAIT_V(n) asm volatile("s_waitcnt vmcnt(" #n ")" ::: "memory")
#define PG8_WAIT_L(n) asm volatile("s_waitcnt lgkmcnt(" #n ")" ::: "memory")
#define PG8_BAR __builtin_amdgcn_s_barrier()
#define PG8_SCHED __builtin_amdgcn_sched_barrier(0)
#define PG8_IDX_ISSUE(u, slot) __builtin_amdgcn_raw_ptr_buffer_load_lds(rsrc, (LAS void*)(idxlds + (slot) * 256 + (wid & 3) * 64), 4, lane * 4, \
        __builtin_amdgcn_readfirstlane((int)(S.idxoff + (unsigned)((u).rb + (wid & 3) * 64) * 4u)), 0, 0)
#define PG8_IDX_READ(dst, h_, slot, nv_) do { int _t = tid; asm volatile("" : "+v"(_t));   \
        _Pragma("unroll") for (int _i = 0; _i < 2; ++_i) { int _R, _C; stage_rc(_t * 16 + _i * 8192, _R, _C); \
        const int _ix = ((h_) * HALF + _R) < (nv_) ? idxlds[(slot) * 256 + (h_) * HALF + _R] : S.padrow;        \
        dst[_i] = (unsigned)_ix * (unsigned)(K * 2) + (unsigned)(_C * 2); } } while (0)
    Unit cur, nxt; int ui = 0;
    if (!S.next(0, cur)) return;
    f32x4 acc[2][2][4][2];
#pragma unroll
    for (int a = 0; a < 2; ++a)
#pragma unroll
        for (int b = 0; b < 2; ++b)
#pragma unroll
            for (int m = 0; m < 4; ++m)
#pragma unroll
                for (int n = 0; n < 2; ++n) acc[a][b][m][n] = (f32x4){0.f, 0.f, 0.f, 0.f};
    bf16x8 At[4][2], B0[2][2], B1[2][2];
    unsigned cA = cur.a, cB = cur.b;
    if constexpr (Sched::GATHER || Epi::ROWAUX) {
        PG8_IDX_ISSUE(cur, 0); PG8_WAIT_V(0); PG8_BAR;     asm volatile("" ::: "memory");
        if constexpr (Sched::GATHER) { PG8_IDX_READ(voffA[0], 0, 0, cur.nv); PG8_IDX_READ(voffA[1], 1, 0, cur.nv); }
    }
    if constexpr (SP2) {
        PG8_STAGE(PG8_SB(0, 0), cB, voffB); PG8_STAGE(PG8_SB(0, 1), cB + hstep, voffB); PG8_STAGE(PG8_SA(0, 0), cA, voffA[0]); PG8_STAGE(PG8_SA(0, 1), cA, voffA[1]);
        if (wr == 1) PG8_BAR;
        PG8_WAIT_V(2); PG8_BAR;
        PG8_STAGE(PG8_SB(1, 0), cB + kstep, voffB); PG8_STAGE(PG8_SA(1, 0), cA + kstep, voffA[0]); PG8_STAGE(PG8_SB(1, 1), cB + hstep + kstep, voffB);
        PG8_WAIT_V(6); PG8_BAR;
    } else {
        PG8_STAGE(PG8_SB(0, 0), cB, voffB); PG8_STAGE(PG8_SA(0, 0), cA, voffA[0]); PG8_STAGE(PG8_SB(0, 1), cB + hstep, voffB); PG8_STAGE(PG8_SA(0, 1), cA, voffA[1]);
        if (wr == 1) PG8_BAR;
        PG8_WAIT_V(4); PG8_BAR;
        PG8_STAGE(PG8_SB(1, 0), cB + kstep, voffB); PG8_STAGE(PG8_SA(1, 0), cA + kstep, voffA[0]); PG8_STAGE(PG8_SB(1, 1), cB + hstep + kstep, voffB);
        PG8_WAIT_V(6); PG8_BAR;
    }
    for (;;) {
        const bool has_next = S.next(ui + 1, nxt);
        const unsigned nA = has_next ? nxt.a : cA, nB = has_next ? nxt.b : cB;
        for (int t = 0; t < nt; t += 2) {
            const bool last = (t == nt - 2);
            const unsigned a1 = cA + (unsigned)(t + 1) * kstep;
            const unsigned a2 = last ? nA : cA + (unsigned)(t + 2) * kstep, b2 = last ? nB : cB + (unsigned)(t + 2) * kstep;
            const unsigned a3 = a2 + kstep, b3 = b2 + kstep;
            if constexpr (Sched::GATHER || Epi::ROWAUX) { if (t == 0 && has_next) PG8_IDX_ISSUE(nxt, (ui + 1) % 3); }
            if constexpr (Sched::GATHER) { if (last && has_next) PG8_IDX_READ(voffA[0], 0, (ui + 1) % 3, nxt.nv); }
#define PG8_NEXT_H1() do { if constexpr (Sched::GATHER) { if (last && has_next) PG8_IDX_READ(voffA[1], 1, (ui + 1) % 3, nxt.nv); } } while (0)
            if constexpr (SP2) {
            PG8_LDB(B0, 0, 0); PG8_LDB(B1, 0, 1); PG8_SCHED; PG8_LDA(At, 0, 0); PG8_STAGE(PG8_SA(1, 1), a1, voffA[1]); PG8_NEXT_H1();
            PG8_WAIT_V(8); PG8_WAIT_L(0); PG8_BAR; PG8_MMA(0, 0, At, B0); PG8_MMA(0, 1, At, B1); PG8_BAR; PG8_SCHED;
            PG8_LDA(At, 0, 1); PG8_STAGE(PG8_SB(0, 0), b2, voffB); PG8_STAGE(PG8_SB(0, 1), b2 + hstep, voffB); PG8_STAGE(PG8_SA(0, 0), a2, voffA[0]);
            PG8_WAIT_V(8); PG8_WAIT_L(0); PG8_BAR; PG8_MMA(1, 0, At, B0); PG8_MMA(1, 1, At, B1); PG8_BAR; PG8_SCHED;
            PG8_LDB(B0, 1, 0); PG8_LDB(B1, 1, 1); PG8_SCHED; PG8_LDA(At, 1, 0); PG8_STAGE(PG8_SA(0, 1), a2, voffA[1]);
            PG8_WAIT_V(8); PG8_WAIT_L(0); PG8_BAR; PG8_MMA(0, 0, At, B0); PG8_MMA(0, 1, At, B1); PG8_BAR; PG8_SCHED;
            PG8_LDA(At, 1, 1); PG8_STAGE(PG8_SB(1, 0), b3, voffB); PG8_STAGE(PG8_SB(1, 1), b3 + hstep, voffB); PG8_STAGE(PG8_SA(1, 0), a3, voffA[0]);
            PG8_WAIT_V(8); PG8_WAIT_L(0); PG8_BAR; PG8_MMA(1, 0, At, B0); PG8_MMA(1, 1, At, B1); PG8_BAR; PG8_SCHED;
            } else {
            PG8_LDB(B0, 0, 0); PG8_SCHED; PG8_LDA(At, 0, 0); PG8_STAGE(PG8_SA(1, 1), a1, voffA[1]); PG8_NEXT_H1();
            PG8_WAIT_L(8); PG8_BAR; PG8_WAIT_L(0); PG8_MMA(0, 0, At, B0); PG8_BAR; PG8_SCHED;
            PG8_LDB(B1, 0, 1); PG8_STAGE(PG8_SB(0, 0), b2, voffB);
            PG8_BAR; PG8_WAIT_L(0); PG8_MMA(0, 1, At, B1); PG8_BAR;
            PG8_LDA(At, 0, 1); PG8_STAGE(PG8_SA(0, 0), a2, voffA[0]);
            PG8_BAR; PG8_WAIT_L(0); PG8_MMA(1, 0, At, B0); PG8_BAR; PG8_SCHED;
            PG8_STAGE(PG8_SB(0, 1), b2 + hstep, voffB);
            PG8_WAIT_V(6); PG8_BAR; PG8_MMA(1, 1, At, B1); PG8_BAR;
            PG8_LDB(B0, 1, 0); PG8_SCHED; PG8_LDA(At, 1, 0); PG8_STAGE(PG8_SA(0, 1), a2, voffA[1]);
            PG8_WAIT_L(8); PG8_BAR; PG8_WAIT_L(0); PG8_MMA(0, 0, At, B0); PG8_BAR; PG8_SCHED;
            PG8_LDB(B1, 1, 1); PG8_STAGE(PG8_SB(1, 0), b3, voffB);
            PG8_BAR; PG8_WAIT_L(0); PG8_MMA(0, 1, At, B1); PG8_BAR;
            PG8_LDA(At, 1, 1); PG8_STAGE(PG8_SA(1, 0), a3, voffA[0]);
            PG8_BAR; PG8_WAIT_L(0); PG8_MMA(1, 0, At, B0); PG8_BAR; PG8_SCHED;
            PG8_STAGE(PG8_SB(1, 1), b3 + hstep, voffB);
            PG8_WAIT_V(6); PG8_BAR; PG8_MMA(1, 1, At, B1); PG8_BAR;
            }
        }
        if constexpr (ALIGN_EPI) { if (wr == 0) PG8_BAR; }
        if constexpr (Epi::ROWAUX) E(acc, cur, wr, wc, fr, fq, idxlds + (ui % 3) * 256); else E(acc, cur, wr, wc, fr, fq);
        if (!has_next) break;
#pragma unroll
        for (int a = 0; a < 2; ++a)
#pragma unroll
            for (int b = 0; b < 2; ++b)
#pragma unroll
                for (int m = 0; m < 4; ++m)
#pragma unroll
                    for (int n = 0; n < 2; ++n) acc[a][b][m][n] = (f32x4){0.f, 0.f, 0.f, 0.f};
        cur = nxt; cA = nA; cB = nB; ++ui;
        if constexpr (ALIGN_EPI) { if (wr == 1) PG8_BAR; }
    }
    PG8_WAIT_V(0);
    if constexpr (!ALIGN_EPI) { if (wr == 0) PG8_BAR; }
    PG8_BAR;
#undef PG8_SA
#undef PG8_SB
#undef PG8_STAGE
#undef PG8_LDA
#undef PG8_LDB
#undef PG8_MMA
#undef PG8_WAIT_V
#undef PG8_WAIT_L
#undef PG8_BAR
#undef PG8_SCHED
#undef PG8_IDX_ISSUE
#undef PG8_IDX_READ
#undef PG8_NEXT_H1
}
}
constexpr int T_ = 16384, D_ = 1024, NB_ = 4, S_ = 4096, NEXP = 64, TOPK = 8;
constexpr int ECAP = 16384;
constexpr int PMAX = 163840;
constexpr float LN_EPS = 1e-5f, RMS_EPS = 1e-6f;
constexpr float ALPHA_DN = 1.6817928305074290f;
constexpr float QSCALE = 0.125f * 1.4426950408889634f;

namespace pg8 {
constexpr int NXCD = 8, WGM = 8;
struct DenseOrder {
    static constexpr bool GATHER = false;
    unsigned A, Bt; int K; int nM, nN, nwg, G, c; unsigned idxoff; static constexpr int padrow = 0;
    DI void init(size_t A_, size_t Bt_, int M, int N, int K_, int G_, int c_) { A = (unsigned)A_; Bt = (unsigned)Bt_; K = K_; nM = M / BM; nN = N / BM; nwg = nM * nN; G = G_; c = c_; idxoff = 0u; }
    DI bool next(int i, Unit& u) const {
        const long L = (long)i * G + c; if (L >= nwg) return false;
        int wgid = (int)L; { const int q = nwg / NXCD, r = nwg % NXCD, xcd = wgid % NXCD, off = wgid / NXCD; wgid = (xcd < r ? xcd * (q + 1) : r * (q + 1) + (xcd - r) * q) + off; }
        const int nig = WGM * nN, gid = wgid / nig, fm = gid * WGM, gsz = (nM - fm) < WGM ? (nM - fm) : WGM;
        const int pm = fm + ((wgid % nig) % gsz), pn = (wgid % nig) / gsz;
        u.a = A + (unsigned)(pm * BM * K * 2); u.b = Bt + (unsigned)(pn * BM * K * 2); u.r0 = pm * BM; u.c0 = pn * BM; u.e = 0; u.rb = 0; u.nv = BM; return true;
    }
};
template <bool GATH> struct MoeOrder {
    static constexpr bool GATHER = GATH;
    unsigned A, Bt; int K; int nct_log, nunits, G, c; unsigned idxoff; const LAS int* tileoff; const LAS int* ecnt; unsigned bstride; static constexpr int padrow = T_;
    DI bool next(int i, Unit& u) const {
        const long L = (long)i * G + c; if (L >= nunits) return false;
        int wgid = (int)L; { const int q = nunits / NXCD, r = nunits % NXCD, xcd = wgid % NXCD, off = wgid / NXCD; wgid = (xcd < r ? xcd * (q + 1) : r * (q + 1) + (xcd - r) * q) + off; }
        const int tile = wgid >> nct_log, pn = wgid & ((1 << nct_log) - 1);
        int e = 0;
#pragma unroll 1
        for (int j = 32; j >= 1; j >>= 1) { const int cand = e + j; if (tileoff[cand] <= tile) e = cand; }
        if (e < NEXP && tileoff[e + 1] <= tile) e += 1;
        e = __builtin_amdgcn_readfirstlane(e);
        u.e = e; u.r0 = tile * BM; u.c0 = pn * BM;
        { const int ti = tile - __builtin_amdgcn_readfirstlane(tileoff[e]); u.rb = e * ECAP + ti * BM; u.nv = __builtin_amdgcn_readfirstlane(ecnt[e]) - ti * BM; }
        u.a = GATH ? A : A + (unsigned)(tile * BM * K * 2);
        u.b = Bt + (unsigned)e * bstride + (unsigned)(pn * BM * K * 2);
        return true;
    }
};

struct EpiF32 {
    static constexpr bool PERM = false, ROWAUX = false;
    float* C; int ldc;
    DI void operator()(const f32x4 (&acc)[2][2][4][2], const Unit& u, int wr, int wc, int fr, int fq) const {
        const int row0 = u.r0 + wr * 64 + fr, col0 = u.c0 + wc * 32 + 4 * fq;
#pragma unroll
        for (int ai = 0; ai < 2; ++ai)
#pragma unroll
            for (int m = 0; m < 4; ++m) { float* rowp = C + (size_t)(row0 + ai * HALF + m * 16) * ldc + col0;
#pragma unroll
                for (int bj = 0; bj < 2; ++bj)
#pragma unroll
                    for (int n = 0; n < 2; ++n) *(f32x4*)(rowp + bj * HALF + n * 16) = acc[ai][bj][m][n]; }
    }
};
struct EpiBf16 {
    static constexpr bool PERM = true, ROWAUX = false;
    bf16* O; int ldc;
    DI void operator()(const f32x4 (&acc)[2][2][4][2], const Unit& u, int wr, int wc, int fr, int fq) const {
        const int row0 = u.r0 + wr * 64 + fr, col0 = u.c0 + wc * 32 + 8 * fq;
#pragma unroll
        for (int ai = 0; ai < 2; ++ai)
#pragma unroll
            for (int m = 0; m < 4; ++m) { bf16* rowp = O + (size_t)(row0 + ai * HALF + m * 16) * ldc + col0;
#pragma unroll
                for (int bj = 0; bj < 2; ++bj) { const f32x4 v0 = acc[ai][bj][m][0], v1 = acc[ai][bj][m][1];
                    u32x4 w; w.x = cvtpk(v0[0], v0[1]); w.y = cvtpk(v0[2], v0[3]); w.z = cvtpk(v1[0], v1[1]); w.w = cvtpk(v1[2], v1[3]);
                    *(u32x4*)(rowp + bj * HALF) = w; } }
    }
};
struct EpiQKV {
    static constexpr bool PERM = true, ROWAUX = false;
    bf16* QKV; const float* COS; const float* SIN;
    DI void operator()(const f32x4 (&acc)[2][2][4][2], const Unit& u, int wr, int wc, int fr, int fq) const {
        const int pn = u.c0 >> 8, g = pn / 12, which = (pn >> 2) % 3, hq = pn & 3;
        const int ldil = 2 * g, dil = 1 << ldil;
        const int idx = 4 * (wc & 1) + fq, b = u.r0 >> 12;
        const int row0 = u.r0 + wr * 64 + fr;
#pragma unroll
        for (int ai = 0; ai < 2; ++ai)
#pragma unroll
            for (int m = 0; m < 4; ++m) {
                const int r = row0 + ai * HALF + m * 16, t = r & (S_ - 1);
                const int prow = (t & (dil - 1)) * (S_ >> ldil) + (t >> ldil);
                f32x4 c4 = (f32x4){1.f, 1.f, 1.f, 1.f}, s4 = (f32x4){0.f, 0.f, 0.f, 0.f};
                if (which < 2) { c4 = *(const f32x4*)(COS + (size_t)r * 32 + 4 * idx); s4 = *(const f32x4*)(SIN + (size_t)r * 32 + 4 * idx); }
#pragma unroll
                for (int bj = 0; bj < 2; ++bj) {
                    const int head = 4 * hq + 2 * bj + (wc >> 1);
                    const f32x4 v0 = acc[ai][bj][m][0], v1 = acc[ai][bj][m][1];
                    f32x4 o0 = v0 * c4 - v1 * s4, o1 = v1 * c4 + v0 * s4;
                    if (which == 0) { o0 = o0 * QSCALE; o1 = o1 * QSCALE; }
                    u32x4 w; w.x = cvtpk(o0[0], o0[1]); w.y = cvtpk(o0[2], o0[3]); w.z = cvtpk(o1[0], o1[1]); w.w = cvtpk(o1[2], o1[3]);
                    bf16* dst = QKV + ((((size_t)(which * 3 + g) * NB_ + b) * 16 + head) * S_ + prow) * 64 + 8 * idx;
                    *(u32x4*)dst = w;
                }
            }
    }
};
struct EpiSwiGLU {
    static constexpr bool PERM = true, ROWAUX = false;
    bf16* HID;
    DI void operator()(const f32x4 (&acc)[2][2][4][2], const Unit& u, int wr, int wc, int fr, int fq) const {
        const int row0 = u.r0 + wr * 64 + fr, col0 = (u.c0 >> 1) + wc * 32 + 8 * fq;
#pragma unroll
        for (int ai = 0; ai < 2; ++ai)
#pragma unroll
            for (int m = 0; m < 4; ++m) {
                float hv[8];
#pragma unroll
                for (int n = 0; n < 2; ++n)
#pragma unroll
                    for (int j = 0; j < 4; ++j) { const float a = acc[ai][0][m][n][j], bb = acc[ai][1][m][n][j]; hv[4 * n + j] = silu_f(a) * bb; }
                u32x4 w; w.x = cvtpk(hv[0], hv[1]); w.y = cvtpk(hv[2], hv[3]); w.z = cvtpk(hv[4], hv[5]); w.w = cvtpk(hv[6], hv[7]);
                *(u32x4*)(HID + (size_t)(row0 + ai * HALF + m * 16) * 256 + col0) = w;
            }
    }
};
constexpr size_t YS_OFF = (size_t)160 << 20;
struct EpiScale {
    static constexpr bool PERM = true, ROWAUX = true;
    unsigned char* YE;
    int s0;
    DI void operator()(const f32x4 (&acc)[2][2][4][2], const Unit& u, int wr, int wc, int fr, int fq, const LAS int* aux) const {
        const int row0 = wr * 64 + fr, col0 = u.c0 + wc * 32 + 8 * fq;
        if (u.e == NEXP) {
            bf16* base = (bf16*)pg8::rfl_ptr((const char*)(YE + YS_OFF) + (size_t)(u.r0 - s0) * (D_ * 2));
#pragma unroll
            for (int ai = 0; ai < 2; ++ai)
#pragma unroll
                for (int m = 0; m < 4; ++m) { const unsigned ro = (unsigned)((row0 + ai * HALF + m * 16) * D_ + col0) * 2u;
#pragma unroll
                    for (int bj = 0; bj < 2; ++bj) { const f32x4 v0 = acc[ai][bj][m][0], v1 = acc[ai][bj][m][1];
                        u32x4 w; w.x = cvtpk(v0[0], v0[1]); w.y = cvtpk(v0[2], v0[3]); w.z = cvtpk(v1[0], v1[1]); w.w = cvtpk(v1[2], v1[3]);
                        *(u32x4*)((char*)base + ro + bj * HALF * 2) = w; } }
        } else {
            unsigned char* base = (unsigned char*)pg8::rfl_ptr((const char*)YE + (size_t)u.r0 * D_);
#pragma unroll
            for (int ai = 0; ai < 2; ++ai)
#pragma unroll
                for (int m = 0; m < 4; ++m) { const int rl = row0 + ai * HALF + m * 16; const float wgt = __builtin_bit_cast(float, aux[rl]) * YE_SCALE; const unsigned ro = (unsigned)(rl * D_ + col0);
#pragma unroll
                    for (int bj = 0; bj < 2; ++bj) { const f32x4 v0 = acc[ai][bj][m][0] * wgt, v1 = acc[ai][bj][m][1] * wgt;
                        u32x2 w; w.x = cvtpk_fp8(v0[0], v0[1], v0[2], v0[3]); w.y = cvtpk_fp8(v1[0], v1[1], v1[2], v1[3]);
                        *(u32x2*)(base + ro + bj * HALF) = w; } }
        }
    }
};
}
constexpr size_t MiB = 1u << 20;
constexpr size_t WS_CTL = 0, CTL_ZERO_BYTES = 1 * MiB;
constexpr size_t WS_MOD = 1 * MiB;
constexpr size_t WS_COS = 2 * MiB;
constexpr size_t WS_SIN = 4 * MiB;
constexpr size_t WS_ASG_E = 6 * MiB;
constexpr size_t WS_ASG_R = 6 * MiB + 512 * 1024;
constexpr size_t WS_ASG_W = 7 * MiB;
constexpr size_t WS_ASG_ROW = 7 * MiB + 512 * 1024;
constexpr size_t WS_ROWTOK = 8 * MiB;
constexpr size_t WS_ROWW = 9 * MiB;
constexpr size_t WS_AB = 10 * MiB;
constexpr size_t WS_GALPHA = 11 * MiB;
constexpr size_t WS_GBETA = 11 * MiB + 512 * 1024;
constexpr size_t WS_X = 12 * MiB;
constexpr size_t WS_Y = 76 * MiB;
constexpr size_t WS_H = 140 * MiB;
constexpr size_t WS_O = 173 * MiB;
constexpr size_t WS_WA_IN = 205 * MiB;
constexpr size_t WS_WA_OUT = 241 * MiB;
constexpr size_t WS_WG_IN = 245 * MiB;
constexpr size_t WS_WG_OUT = 261 * MiB;
constexpr size_t WS_WE1 = 265 * MiB;
constexpr size_t WS_WE2 = 330 * MiB;
constexpr size_t WS_HID = 363 * MiB;
constexpr size_t WS_BIG = 443 * MiB;
constexpr size_t WS_YS_OFF = pg8::YS_OFF;
constexpr size_t WS_WEB = WS_BIG + 368 * MiB;
constexpr size_t WS_WRF = WS_BIG + 466 * MiB;
constexpr size_t WS_WABF = WS_WRF + 1 * MiB;
constexpr size_t WS_ETOK = WS_WABF + 1 * MiB;
constexpr size_t WS_EW = WS_ETOK + 5 * MiB;
constexpr size_t WS_END = WS_EW + 5 * MiB;
constexpr size_t BIG_PROJ = 0, BIG_QN = 128 * MiB, BIG_KN = 192 * MiB, BIG_VV = 256 * MiB, BIG_ORAW = 320 * MiB;
constexpr int CW_BAR = 4096;
constexpr int CW_CNT = 16384;
constexpr int RING_BYTES = 131072;
constexpr int LDS_IDX = RING_BYTES;
constexpr int LDS_TILEOFF = LDS_IDX + 3072;
constexpr int LDS_LCNT = LDS_TILEOFF + 512;
constexpr int LDS_LBASE = LDS_LCNT + 256;
constexpr int LDS_LASG = LDS_LBASE + 256;
constexpr int LDS_ECNT = LDS_LASG;
constexpr int LDS_LW = LDS_IDX;
constexpr int LDS_MISC = LDS_LASG + 2048;
constexpr int LDS_LG = LDS_MISC + 128;
constexpr int LDS_BYTES = 147456;
static_assert(LDS_LG + 8192 <= LDS_BYTES, "LDS map");
constexpr int NWAVES = 8, NTHR = 512;

#define XB_TMO      128
#define XB_XCNT(j)  (256  + 64 * (j))
#define XB_XSUB(j)  (1280 + 64 * (j))
#define XB_XGEN(j)  (2304 + 64 * (j))
#define XB_TOP      3328
#define XB_TOPGEN   3392
#define XCD_BAR_WORDS 3456
#define XB_SPIN_CAP (1u << 18)
__device__ __forceinline__ unsigned xb_ld(unsigned* p)              { return __hip_atomic_load(p, __ATOMIC_RELAXED, __HIP_MEMORY_SCOPE_AGENT); }
__device__ __forceinline__ unsigned xb_add(unsigned* p, unsigned v) { return __hip_atomic_fetch_add(p, v, __ATOMIC_RELAXED, __HIP_MEMORY_SCOPE_AGENT); }
__device__ __forceinline__ unsigned xb_xcc_id() { return (unsigned)__builtin_amdgcn_s_getreg((3 << 11) | 20) & 0xFu; }
#define XB_SPIN(cond, bar) do { unsigned _sp = 0; while (cond) { __builtin_amdgcn_s_sleep(1); \
    if ((++_sp & 255u) == 0u) { if (xb_ld(&(bar)[XB_TMO])) break; if (_sp > XB_SPIN_CAP) { atomicAdd(&(bar)[XB_TMO], 1u); break; } } } } while (0)
struct XcdBarrier { unsigned* bar; unsigned x; volatile LAS unsigned* st; };
__device__ __forceinline__ XcdBarrier xcd_barrier_post(unsigned* bar, volatile LAS unsigned* st) {
    XcdBarrier b; b.bar = bar; b.x = xb_xcc_id(); b.st = st;
    if (threadIdx.x == 0) (void)xb_add(&bar[XB_XCNT(b.x)], 1u);
    return b;
}
__device__ __forceinline__ void xcd_barrier_complete(unsigned* bar, unsigned x, unsigned& nloc, unsigned& nx) {
    const unsigned G = gridDim.x * gridDim.y * gridDim.z;
    unsigned sum, cnt, mine, sp = 0u;
    for (;;) {
        sum = 0u; cnt = 0u; mine = 0u;
#pragma unroll
        for (unsigned j = 0; j < 16; ++j) { const unsigned c = xb_ld(&bar[XB_XCNT(j)]); sum += c; cnt += (c > 0u) ? 1u : 0u; mine = (j == x) ? c : mine; }
        if (sum == G) break;
        __builtin_amdgcn_s_sleep(1);
        if ((++sp & 255u) == 0u) { if (xb_ld(&bar[XB_TMO])) break; if (sp > XB_SPIN_CAP) { atomicAdd(&bar[XB_TMO], 1u); break; } }
    }
    nloc = mine > 0u ? mine : 1u; nx = cnt > 0u ? cnt : 1u;
}
__device__ __forceinline__ void xcd_barrier(const XcdBarrier& b, const int tid) {
    asm volatile("s_waitcnt vmcnt(0)" ::: "memory");
    __syncthreads();
    if (tid == 0) {
        unsigned* bar = b.bar;
        __builtin_amdgcn_s_waitcnt(0);
        unsigned nloc = b.st[0], nx = b.st[1];
        if (nloc == 0u) { xcd_barrier_complete(bar, b.x, nloc, nx); b.st[0] = nloc; b.st[1] = nx; }
        const unsigned old = xb_add(&bar[XB_XSUB(b.x)], 1u);
        const unsigned gen = old / nloc;
        if (old + 1u == (gen + 1u) * nloc) {
            __builtin_amdgcn_fence(__ATOMIC_RELEASE, "agent");
            asm volatile("s_waitcnt vmcnt(0)" ::: "memory");
            const unsigned og = xb_add(&bar[XB_TOP], 1u);
            const unsigned tg = og / nx;
            if (og + 1u == (tg + 1u) * nx) xb_add(&bar[XB_TOPGEN], 1u);
            else XB_SPIN(xb_ld(&bar[XB_TOPGEN]) == tg, bar);
            __builtin_amdgcn_fence(__ATOMIC_ACQUIRE, "agent");
            xb_add(&bar[XB_XGEN(b.x)], 1u);
            asm volatile("s_waitcnt vmcnt(0)" ::: "memory");
        } else {
            XB_SPIN(xb_ld(&bar[XB_XGEN(b.x)]) == gen, bar);
            __builtin_amdgcn_fence(__ATOMIC_ACQUIRE, "agent");
            asm volatile("s_waitcnt vmcnt(0)" ::: "memory");
        }
    }
    __syncthreads();
}

struct Args {
    const float* x; const float* c; const int* pos; const float* ada_w; const float* ada_b; const float* ln_g; const float* ln_b;
    const float* attn_w_in; const float* attn_w_out; const float* gdn_w_in; const float* gdn_conv_w; const float* gdn_a_log; const float* gdn_dt_bias;
    const float* gdn_norm_w; const float* gdn_w_out; const float* router_w; const float* router_bias; const float* ew1; const float* ew3; const float* ew2;
    const float* sw1; const float* sw3; const float* sw2;
    float* out; unsigned char* ws; int ph_lo, ph_hi;
};
typedef __attribute__((address_space(1))) unsigned char gas_u8;
DI unsigned char* opq(unsigned char* p) { gas_u8* g = (gas_u8*)p; asm volatile("" : "+s"(g)); return (unsigned char*)g; }
template <class T> DI T* asg(T* p) { typedef __attribute__((address_space(1))) T gT; return (T*)(gT*)p; }
struct Frame {
    LAS unsigned char* lds;
    int tid, lane, wave, G, bid;
};
template <class Map> DI void transpose_item(const float* W, int ldn, int K, bf16* WT, const Map& map, LAS float* scr, int kb, int nb, int lane) {
    const int k0 = 64 * kb, n0 = 32 * nb;
    float tv[32];
#pragma unroll
    for (int i = 0; i < 32; ++i) tv[i] = __builtin_nontemporal_load(&W[(size_t)(k0 + 2 * i + (lane >> 5)) * ldn + n0 + (lane & 31)]);
#pragma unroll
    for (int i = 0; i < 32; ++i) scr[(2 * i + (lane >> 5)) * 33 + (lane & 31)] = tv[i];
    LDS_WAIT(); asm volatile("" ::: "memory");
    const int c = lane & 7;
#pragma unroll
    for (int j = 0; j < 4; ++j) { const int n = (lane >> 3) + 8 * j; const LAS float* s = scr + (8 * c) * 33 + n;
        u32x4 o; o.x = cvtpk(s[0 * 33], s[1 * 33]); o.y = cvtpk(s[2 * 33], s[3 * 33]); o.z = cvtpk(s[4 * 33], s[5 * 33]); o.w = cvtpk(s[6 * 33], s[7 * 33]);
        *(u32x4*)(WT + (size_t)map(n0 + n) * K + k0 + 8 * c) = o; }
    LDS_WAIT(); asm volatile("" ::: "memory");
}
struct MapId { int off; DI int operator()(int n) const { return off + n; } };
struct MapQKV { DI int operator()(int n) const {
    const int which = (n >> 10) % 3; if (which == 2) return n;
    const int d = n & 63, idx = (d & 31) >> 2, lo = d & 3, hi = d >> 5; return (n & ~63) + 8 * idx + 4 * hi + lo; } };
struct MapW13 { int second; DI int operator()(int n) const { return (n >> 7) * 256 + second * 128 + (n & 127); } };
template <class Map> DI void convert_matrix(const Frame& F, const float* W, int ldn, int K, int N, bf16* WT, const Map& map) {
    LAS float* scr = (LAS float*)(F.lds + F.wave * 16384);
    const int gw = F.bid * NWAVES + F.wave, NGW = F.G * NWAVES, nblk = N / 32, nitems = (K / 64) * nblk;
    for (int it = gw; it < nitems; it += NGW) transpose_item(W, ldn, K, WT, map, scr, it / nblk, it % nblk, F.lane);
}

DI void prologue_phase(const Frame& F, const Args& A) {
    unsigned char* ws = opq(A.ws);
    {
        LAS float* red = (LAS float*)F.lds;
        float* MOD = (float*)(ws + WS_MOD);
        for (int item = F.bid; item < 8 * 48; item += F.G) {
            const int ls = item / 48, n = (item % 48) * 64 + F.lane;
            const float* w = A.ada_w + ((size_t)ls * D_ + F.wave * 128) * 3072 + n;
            const float* cc = A.c + F.wave * 128;
            float a0 = 0.f, a1 = 0.f, a2 = 0.f, a3 = 0.f;
#pragma unroll 8
            for (int k = 0; k < 128; ++k) { const float wv = __builtin_nontemporal_load(&w[(size_t)k * 3072]); a0 += cc[k] * wv; a1 += cc[D_ + k] * wv; a2 += cc[2 * D_ + k] * wv; a3 += cc[3 * D_ + k] * wv; }
            red[(F.wave * 4 + 0) * 64 + F.lane] = a0; red[(F.wave * 4 + 1) * 64 + F.lane] = a1; red[(F.wave * 4 + 2) * 64 + F.lane] = a2; red[(F.wave * 4 + 3) * 64 + F.lane] = a3;
            __syncthreads();
            if (F.wave < 4) { float s = A.ada_b[ls * 3072 + n];
#pragma unroll
                for (int w8 = 0; w8 < 8; ++w8) s += red[(w8 * 4 + F.wave) * 64 + F.lane];
                MOD[((size_t)ls * 4 + F.wave) * 3072 + n] = s; }
            __syncthreads();
        }
    }
    {
        float* COS = (float*)(ws + WS_COS); float* SIN = (float*)(ws + WS_SIN);
        for (int idx = F.bid * NTHR + F.tid; idx < T_ * 32; idx += F.G * NTHR) {
            const int t = idx >> 5, i = idx & 31;
            const float inv = powf(10000.0f, -(float)i / 32.0f);
            const float ang = (float)A.pos[t] * inv;
            COS[idx] = cosf(ang); SIN[idx] = sinf(ang);
        }
    }
    {
        bf16* WRF = (bf16*)(ws + WS_WRF); bf16* WABF = (bf16*)(ws + WS_WABF);
        for (int idx = F.bid * NTHR + F.tid; idx < 4 * 4 * 32 * 64 * 8; idx += F.G * NTHR) {
            const int jx = idx & 7, ln = (idx >> 3) & 63, ks = (idx >> 9) & 31, nt = (idx >> 14) & 3, layer = idx >> 16;
            const int d = 32 * ks + 8 * (ln >> 4) + jx, e = 16 * nt + (ln & 15);
            const float wv = A.router_w[((size_t)layer * D_ + d) * NEXP + e];
            const unsigned hi = cvtpk(wv, 0.f) & 0xffffu; const float res = wv - bf_lo(hi);
            const size_t o = (size_t)layer * 2 * 65536 + (idx & 65535);
            WRF[o] = (bf16)hi; WRF[o + 65536] = (bf16)(cvtpk(res, 0.f) & 0xffffu);
        }
        for (int idx = F.bid * NTHR + F.tid; idx < 2 * 32 * 64 * 8; idx += F.G * NTHR) {
            const int jx = idx & 7, ln = (idx >> 3) & 63, ks = (idx >> 9) & 31, jl = idx >> 14;
            const int d = 32 * ks + 8 * (ln >> 4) + jx, e = ln & 15;
            const float wv = A.gdn_w_in[((size_t)jl * D_ + d) * 4112 + 4096 + e];
            const unsigned hi = cvtpk(wv, 0.f) & 0xffffu; const float res = wv - bf_lo(hi);
            const size_t o = (size_t)jl * 2 * 16384 + (idx & 16383);
            WABF[o] = (bf16)hi; WABF[o + 16384] = (bf16)(cvtpk(res, 0.f) & 0xffffu);
        }
    }
    if (F.bid == 0) { bf16* H = (bf16*)(ws + WS_H); for (int cidx = F.tid; cidx < D_; cidx += NTHR) H[(size_t)T_ * D_ + cidx] = 0; }
    for (int j = 0; j < 2; ++j) {
        convert_matrix(F, A.attn_w_in + (size_t)j * D_ * 9216, 9216, D_, 9216, (bf16*)(ws + WS_WA_IN) + (size_t)j * 9216 * D_, MapQKV{});
        convert_matrix(F, A.attn_w_out + (size_t)j * D_ * D_, D_, D_, D_, (bf16*)(ws + WS_WA_OUT) + (size_t)j * D_ * D_, MapId{0});
        convert_matrix(F, A.gdn_w_in + (size_t)j * D_ * 4112, 4112, D_, 4096, (bf16*)(ws + WS_WG_IN) + (size_t)j * 4096 * D_, MapId{0});
        convert_matrix(F, A.gdn_w_out + (size_t)j * D_ * D_, D_, D_, D_, (bf16*)(ws + WS_WG_OUT) + (size_t)j * D_ * D_, MapId{0});
    }
}
struct XItem { const float* src; bf16* dst; int ldn, K, mode, n0; };
DI XItem xi_decode(const Args& A, int layer, bf16* WE1, bf16* WE2, int it) {
    constexpr int I13 = (D_ / 64) * (256 / 32), I2 = (256 / 64) * (D_ / 32), IPE = 2 * I13 + I2;
    const int e = it / IPE; int r = it % IPE; XItem x;
    if (r < 2 * I13) { const int second = r >= I13 ? 1 : 0; r -= second * I13; const int kb = r >> 3, nb = r & 7;
        const float* w = second ? (e < 64 ? A.ew3 + ((size_t)layer * 64 + e) * D_ * 256 : A.sw3 + (size_t)layer * D_ * 256) : (e < 64 ? A.ew1 + ((size_t)layer * 64 + e) * D_ * 256 : A.sw1 + (size_t)layer * D_ * 256);
        x.src = w + (size_t)(64 * kb) * 256 + 32 * nb; x.ldn = 256; x.K = D_; x.mode = 1 + second; x.n0 = 32 * nb; x.dst = WE1 + (size_t)e * 512 * D_ + 64 * kb;
    } else { r -= 2 * I13; const int kb = r >> 5, nb = r & 31;
        const float* w = e < 64 ? A.ew2 + ((size_t)layer * 64 + e) * 256 * D_ : A.sw2 + (size_t)layer * 256 * D_;
        x.src = w + (size_t)(64 * kb) * D_ + 32 * nb; x.ldn = D_; x.K = 256; x.mode = 0; x.n0 = 32 * nb; x.dst = WE2 + (size_t)e * D_ * 256 + 64 * kb; }
    return x;
}
#define XI_LOAD(buf, XT) do { const char* _b = pg8::rfl_ptr((const char*)(XT).src); const unsigned _ro = (unsigned)((XT).ldn * 4); \
    _Pragma("unroll") for (int _i = 0; _i < 8; ++_i) buf[_i] = __builtin_nontemporal_load((const f32x4*)(_b + ((unsigned)(8 * _i + (lane >> 3)) * _ro + (unsigned)(lane & 7) * 16u))); } while (0)
#define XI_PUT(buf, XT) do { \
    _Pragma("unroll") for (int _i = 0; _i < 8; ++_i) _Pragma("unroll") for (int _e = 0; _e < 4; ++_e) scr[(8 * _i + (lane >> 3)) * 33 + 4 * (lane & 7) + _e] = buf[_i][_e]; \
    LDS_WAIT(); asm volatile("" ::: "memory"); \
    const int _c = lane & 7; \
    _Pragma("unroll") for (int _j = 0; _j < 4; ++_j) { const int _n = (XT).n0 + (lane >> 3) + 8 * _j; const LAS float* _s = scr + (8 * _c) * 33 + (lane >> 3) + 8 * _j; \
        const int _row = (XT).mode == 0 ? _n : (_n >> 7) * 256 + ((XT).mode - 1) * 128 + (_n & 127); \
        u32x4 _o; _o.x = cvtpk(_s[0 * 33], _s[1 * 33]); _o.y = cvtpk(_s[2 * 33], _s[3 * 33]); _o.z = cvtpk(_s[4 * 33], _s[5 * 33]); _o.w = cvtpk(_s[6 * 33], _s[7 * 33]); \
        *(u32x4*)((XT).dst + (size_t)_row * (XT).K + 8 * _c) = _o; } \
    LDS_WAIT(); asm volatile("" ::: "memory"); } while (0)
DI void convert_experts(const Frame& F, const Args& A, int layer, int set, int wg0, int nwg) {
    if (F.bid < wg0 || F.bid >= wg0 + nwg) return;
    unsigned char* ws = opq(A.ws);
    LAS float* scr = (LAS float*)(F.lds + F.wave * 16384);
    bf16* WE1 = (bf16*)(ws + (set ? WS_WEB : WS_WE1)); bf16* WE2 = (bf16*)(ws + (set ? WS_WEB + 65 * MiB : WS_WE2));
    const int gw = (F.bid - wg0) * NWAVES + F.wave, NGW = nwg * NWAVES, lane = F.lane;
    constexpr int NIT = 65 * 384;
    f32x4 ba[8], bb[8];
    int it = gw;
    if (it >= NIT) return;
    XItem xa = xi_decode(A, layer, WE1, WE2, it), xb = xa;
    XI_LOAD(ba, xa);
#pragma unroll 1
    for (;;) {
        const bool hb = it + NGW < NIT;
        if (hb) { xb = xi_decode(A, layer, WE1, WE2, it + NGW); XI_LOAD(bb, xb); }
        __builtin_amdgcn_sched_barrier(0);
        XI_PUT(ba, xa);
        if (!hb) break;
        it += NGW;
        const bool ha = it + NGW < NIT;
        if (ha) { xa = xi_decode(A, layer, WE1, WE2, it + NGW); XI_LOAD(ba, xa); }
        __builtin_amdgcn_sched_barrier(0);
        XI_PUT(bb, xb);
        if (!ha) break;
        it += NGW;
    }
}
#undef XI_LOAD
#undef XI_PUT

DI void load_row16(const float* p, int lane, f32x4 (&v)[4]) {
#pragma unroll
    for (int j = 0; j < 4; ++j) v[j] = *(const f32x4*)(p + 4 * lane + 256 * j);
}
DI void store_row16(float* p, int lane, const f32x4 (&v)[4]) {
#pragma unroll
    for (int j = 0; j < 4; ++j) *(f32x4*)(p + 4 * lane + 256 * j) = v[j];
}
DI void store_row16_bf16(bf16* p, int lane, const f32x4 (&v)[4]) {
#pragma unroll
    for (int j = 0; j < 4; ++j) { u32x2 w; w.x = cvtpk(v[j][0], v[j][1]); w.y = cvtpk(v[j][2], v[j][3]); *(u32x2*)(p + 4 * lane + 256 * j) = w; }
}
DI void add_row16_bf16(const bf16* p, int lane, f32x4 (&v)[4]) {
#pragma unroll
    for (int j = 0; j < 4; ++j) { const u32x2 w = *(const u32x2*)(p + 4 * lane + 256 * j); v[j][0] += bf_lo(w.x); v[j][1] += bf_hi(w.x); v[j][2] += bf_lo(w.y); v[j][3] += bf_hi(w.y); }
}
DI void add_row16_fp8(const unsigned char* p, int lane, f32x4 (&v)[4]) {
#pragma unroll
    for (int j = 0; j < 4; ++j) { const int w = *(const int*)(p + 4 * lane + 256 * j);
        const f32x2 a = __builtin_amdgcn_cvt_pk_f32_fp8(w, false), b = __builtin_amdgcn_cvt_pk_f32_fp8(w, true);
        v[j][0] += a[0]; v[j][1] += a[1]; v[j][2] += b[0]; v[j][3] += b[1]; }
}
DI void layer_norm16(f32x4 (&v)[4], const f32x4 (&g)[4], const f32x4 (&b)[4]) {
    float s = 0.f;
#pragma unroll
    for (int j = 0; j < 4; ++j) s += (v[j][0] + v[j][1]) + (v[j][2] + v[j][3]);
    const float mean = wave_sum(s) * (1.0f / D_);
    float q = 0.f;
#pragma unroll
    for (int j = 0; j < 4; ++j) { v[j] = v[j] - mean; q += (v[j][0] * v[j][0] + v[j][1] * v[j][1]) + (v[j][2] * v[j][2] + v[j][3] * v[j][3]); }
    const float rstd = 1.0f / sqrtf(wave_sum(q) * (1.0f / D_) + LN_EPS);
#pragma unroll
    for (int j = 0; j < 4; ++j) v[j] = v[j] * rstd * g[j] + b[j];
}

DI void modx_phase(const Frame& F, const Args& A) {
    unsigned char* ws = opq(A.ws);
    const float* MOD = (const float*)(ws + WS_MOD); bf16* H = (bf16*)(ws + WS_H);
    const int gw = F.bid * NWAVES + F.wave, NGW = F.G * NWAVES;
    for (int row = gw; row < T_; row += NGW) {
        const int b = row >> 12; f32x4 v[4], sc[4], sh[4];
        load_row16(A.x + (size_t)row * D_, F.lane, v); load_row16(MOD + (size_t)(0 * 4 + b) * 3072 + 1024, F.lane, sc); load_row16(MOD + (size_t)(0 * 4 + b) * 3072, F.lane, sh);
#pragma unroll
        for (int j = 0; j < 4; ++j) v[j] = v[j] * (1.0f + sc[j]) + sh[j];
        store_row16_bf16(H + (size_t)row * D_, F.lane, v);
    }
}

DI void build_tileoff(const Frame& F, const unsigned* gcount) {
    LAS int* tileoff = (LAS int*)(F.lds + LDS_TILEOFF);
    __syncthreads();
    if (F.wave == 0) {
        const unsigned cn = __hip_atomic_load(gcount + F.lane, __ATOMIC_RELAXED, __HIP_MEMORY_SCOPE_AGENT);
        const int nt = (int)((cn + 255u) >> 8); int inc = nt;
#pragma unroll
        for (int o = 1; o < 64; o <<= 1) { const int t = __builtin_amdgcn_ds_bpermute((F.lane - o) << 2, inc); if (F.lane >= o) inc += t; }
        tileoff[F.lane] = inc - nt; ((LAS int*)(F.lds + LDS_ECNT))[F.lane] = (int)cn;
        if (F.lane == 63) { tileoff[64] = inc; tileoff[65] = inc + T_ / 256; ((LAS int*)(F.lds + LDS_ECNT))[NEXP] = T_; }
    }
    __syncthreads();
}

DI void deepnorm_row(f32x4 (&v)[4], const f32x4 (&y)[4], const float* gate, const float* lng, const float* lnb, float* xout, const float* mod_shift, int lane) {
    f32x4 t[4];
    load_row16(gate, lane, t);
#pragma unroll
    for (int j = 0; j < 4; ++j) v[j] = ALPHA_DN * v[j] + (1.0f + t[j]) * y[j];
    float s = 0.f;
#pragma unroll
    for (int j = 0; j < 4; ++j) s += (v[j][0] + v[j][1]) + (v[j][2] + v[j][3]);
    const float mean = wave_sum(s) * (1.0f / D_);
    float q = 0.f;
#pragma unroll
    for (int j = 0; j < 4; ++j) { v[j] = v[j] - mean; q += (v[j][0] * v[j][0] + v[j][1] * v[j][1]) + (v[j][2] * v[j][2] + v[j][3] * v[j][3]); }
    const float rstd = 1.0f / sqrtf(wave_sum(q) * (1.0f / D_) + LN_EPS);
    load_row16(lng, lane, t);
#pragma unroll
    for (int j = 0; j < 4; ++j) v[j] = v[j] * rstd * t[j];
    load_row16(lnb, lane, t);
#pragma unroll
    for (int j = 0; j < 4; ++j) v[j] = v[j] + t[j];
    store_row16(xout, lane, v);
    if (mod_shift) {
        load_row16(mod_shift + 1024, lane, t);
#pragma unroll
        for (int j = 0; j < 4; ++j) v[j] = v[j] * (1.0f + t[j]);
        load_row16(mod_shift, lane, t);
#pragma unroll
        for (int j = 0; j < 4; ++j) v[j] = v[j] + t[j];
    }
}
DI void put_hilo(LAS unsigned char* lds, int p, int lane, const f32x4 (&v)[4]) {
#pragma unroll
    for (int j = 0; j < 4; ++j) {
        const int c = 4 * lane + 256 * j;
        const unsigned h0 = cvtpk(v[j][0], v[j][1]), h1 = cvtpk(v[j][2], v[j][3]);
        const unsigned l0 = cvtpk(v[j][0] - bf_lo(h0), v[j][1] - bf_hi(h0)), l1 = cvtpk(v[j][2] - bf_lo(h1), v[j][3] - bf_hi(h1));
        const int off = ((((p >> 4) * 32 + (c >> 5)) * 64 + ((c & 31) >> 3) * 16 + (p & 15)) * 16) + (c & 7) * 2;
        *(LAS u32x2*)(lds + off) = (u32x2){h0, h1}; *(LAS u32x2*)(lds + 65536 + off) = (u32x2){l0, l1};
    }
}
DI f32x4 small_proj(const LAS unsigned char* lds, int mt, int lane, const bf16* wf_hi, const bf16* wf_lo) {
    f32x4 a0 = (f32x4){0.f, 0.f, 0.f, 0.f}, a1 = a0, a2 = a0;
#pragma unroll 8
    for (int ks = 0; ks < 32; ++ks) {
        const bf16x8 ah = *(const LAS bf16x8*)(lds + ((mt * 32 + ks) * 64 + lane) * 16), al = *(const LAS bf16x8*)(lds + 65536 + ((mt * 32 + ks) * 64 + lane) * 16);
        const bf16x8 bh = *(const bf16x8*)(wf_hi + (ks * 64 + lane) * 8), bl = *(const bf16x8*)(wf_lo + (ks * 64 + lane) * 8);
        a0 = __builtin_amdgcn_mfma_f32_16x16x32_bf16(ah, bh, a0, 0, 0, 0); a1 = __builtin_amdgcn_mfma_f32_16x16x32_bf16(ah, bl, a1, 0, 0, 0); a2 = __builtin_amdgcn_mfma_f32_16x16x32_bf16(al, bh, a2, 0, 0, 0);
    }
    return a0 + (a1 + a2);
}
DI void small_proj2(const LAS unsigned char* lds, int kh, int lane, const bf16* wf_hi, const bf16* wf_lo, f32x4& o0, f32x4& o1) {
    f32x4 a[2][3];
#pragma unroll
    for (int mt = 0; mt < 2; ++mt)
#pragma unroll
        for (int e = 0; e < 3; ++e) a[mt][e] = (f32x4){0.f, 0.f, 0.f, 0.f};
#pragma unroll 8
    for (int k = 0; k < 16; ++k) {
        const int ks = 16 * kh + k;
        const bf16x8 bh = *(const bf16x8*)(wf_hi + (ks * 64 + lane) * 8), bl = *(const bf16x8*)(wf_lo + (ks * 64 + lane) * 8);
#pragma unroll
        for (int mt = 0; mt < 2; ++mt) {
            const bf16x8 ah = *(const LAS bf16x8*)(lds + ((mt * 32 + ks) * 64 + lane) * 16), al = *(const LAS bf16x8*)(lds + 65536 + ((mt * 32 + ks) * 64 + lane) * 16);
            a[mt][0] = __builtin_amdgcn_mfma_f32_16x16x32_bf16(ah, bh, a[mt][0], 0, 0, 0); a[mt][1] = __builtin_amdgcn_mfma_f32_16x16x32_bf16(ah, bl, a[mt][1], 0, 0, 0); a[mt][2] = __builtin_amdgcn_mfma_f32_16x16x32_bf16(al, bh, a[mt][2], 0, 0, 0);
        }
    }
    o0 = a[0][0] + (a[0][1] + a[0][2]); o1 = a[1][0] + (a[1][1] + a[1][2]);
}
DI void deepnorm_row_c(f32x4 (&v)[4], const f32x4 (&y)[4], const f32x4 (&cg)[4], const f32x4 (&cng)[4], const f32x4 (&cnb)[4]) {
#pragma unroll
    for (int j = 0; j < 4; ++j) v[j] = ALPHA_DN * v[j] + (1.0f + cg[j]) * y[j];
    float s = 0.f;
#pragma unroll
    for (int j = 0; j < 4; ++j) s += (v[j][0] + v[j][1]) + (v[j][2] + v[j][3]);
    const float mean = wave_sum(s) * (1.0f / D_);
    float q = 0.f;
#pragma unroll
    for (int j = 0; j < 4; ++j) { v[j] = v[j] - mean; q += (v[j][0] * v[j][0] + v[j][1] * v[j][1]) + (v[j][2] * v[j][2] + v[j][3] * v[j][3]); }
    const float rstd = 1.0f / sqrtf(wave_sum(q) * (1.0f / D_) + LN_EPS);
#pragma unroll
    for (int j = 0; j < 4; ++j) v[j] = v[j] * rstd * cng[j] + cnb[j];
}
template <bool L0> DI void ln_router_phase(const Frame& F, const Args& A, int layer, bool dry = false) {
    unsigned char* ws = opq(A.ws);
    const float* MOD = (const float*)(ws + WS_MOD); bf16* X = (bf16*)(ws + WS_X); const float* Y = (const float*)(ws + WS_Y); bf16* H = (bf16*)(ws + WS_H);
    int* asg_e = (int*)(ws + WS_ASG_E); int* asg_r = (int*)(ws + WS_ASG_R); int* etok = (int*)(ws + WS_ETOK); float* egate = (float*)(ws + WS_EW);
    unsigned* gcount = (unsigned*)(ws + WS_CTL) + CW_CNT + layer * 64;
    const int ls0 = layer * 2, ls1 = layer * 2 + 1;
    const bf16* wrf = (const bf16*)(ws + WS_WRF) + (size_t)layer * 2 * 65536 + (size_t)(F.wave & 3) * 32 * 512;
    const float rb = A.router_bias[layer * NEXP + F.lane];
    LAS float* lg = (LAS float*)(F.lds + LDS_LG);
    LAS int* lcnt = (LAS int*)(F.lds + LDS_LCNT); LAS int* lbase = (LAS int*)(F.lds + LDS_LBASE); LAS int* lasg = (LAS int*)(F.lds + LDS_LASG);
    const unsigned l8_ = (unsigned)F.lane * 8u, l16_ = (unsigned)F.lane * 16u;
    u32x2 yb[4][4], xb[L0 ? 1 : 4][4]; f32x4 xf[L0 ? 4 : 1][4];
#define LNR_LOAD(rb_) do { unsigned l8 = l8_, l16 = l16_; asm volatile("" : "+v"(l8), "+v"(l16)); \
        _Pragma("unroll") for (int t = 0; t < 4; ++t) { const int row = (rb_) + t; const char* py = pg8::rfl_ptr((const char*)Y + (size_t)row * (D_ * 2)); \
            if constexpr (L0) { const char* px = pg8::rfl_ptr((const char*)A.x + (size_t)row * (D_ * 4)); _Pragma("unroll") for (int j = 0; j < 4; ++j) xf[t][j] = *(const f32x4*)(px + l16 + 1024 * j); } \
            else { const char* px = pg8::rfl_ptr((const char*)X + (size_t)row * (D_ * 2)); _Pragma("unroll") for (int j = 0; j < 4; ++j) xb[t][j] = *(const u32x2*)(px + l8 + 512 * j); } \
            _Pragma("unroll") for (int j = 0; j < 4; ++j) yb[t][j] = *(const u32x2*)(py + l8 + 512 * j); } } while (0)
    for (int blk = F.bid; blk < T_ / 64; blk += F.G) {
        const int b = blk >> 6;
        const char* gate = pg8::rfl_ptr((const char*)(MOD + (size_t)(ls0 * 4 + b) * 3072 + 2048)); const char* modn = pg8::rfl_ptr((const char*)(MOD + (size_t)(ls1 * 4 + b) * 3072));
        const char* lng = pg8::rfl_ptr((const char*)(A.ln_g + (size_t)ls0 * D_)); const char* lnb = pg8::rfl_ptr((const char*)(A.ln_b + (size_t)ls0 * D_));
        f32x4 cg[4], cng[4], cnb[4], csc[4], csh[4];
#pragma unroll
        for (int j = 0; j < 4; ++j) { cg[j] = *(const f32x4*)(gate + l16_ + 1024 * j); cng[j] = *(const f32x4*)(lng + l16_ + 1024 * j); cnb[j] = *(const f32x4*)(lnb + l16_ + 1024 * j);
            csc[j] = *(const f32x4*)(modn + 4096 + l16_ + 1024 * j); csh[j] = *(const f32x4*)(modn + l16_ + 1024 * j); }
        if constexpr (!L0) { LNR_LOAD(blk * 64 + F.wave * 4); }
        __builtin_amdgcn_sched_barrier(0);
#pragma unroll 1
        for (int ps = 0; ps < 2; ++ps) {
            const int rbase = blk * 64 + ps * 32 + F.wave * 4;
            if constexpr (L0) { LNR_LOAD(rbase); }
            { unsigned l8 = l8_; asm volatile("" : "+v"(l8));
#pragma unroll
              for (int t = 0; t < 4; ++t) { const int row = rbase + t; f32x4 v[4], y[4];
#pragma unroll
                for (int j = 0; j < 4; ++j) { y[j] = (f32x4){bf_lo(yb[t][j].x), bf_hi(yb[t][j].x), bf_lo(yb[t][j].y), bf_hi(yb[t][j].y)};
                    if constexpr (L0) v[j] = xf[t][j]; else v[j] = (f32x4){bf_lo(xb[t][j].x), bf_hi(xb[t][j].x), bf_lo(xb[t][j].y), bf_hi(xb[t][j].y)}; }
                deepnorm_row_c(v, y, cg, cng, cnb);
                char* xp = (char*)pg8::rfl_ptr((const char*)(dry ? (const bf16*)(ws + WS_Y + 32 * MiB) : X) + (size_t)row * (D_ * 2));
                char* hp = (char*)pg8::rfl_ptr((const char*)H + (size_t)row * (D_ * 2));
#pragma unroll
                for (int j = 0; j < 4; ++j) { { u32x2 o; o.x = cvtpk(v[j][0], v[j][1]); o.y = cvtpk(v[j][2], v[j][3]); *(u32x2*)(xp + l8 + 512 * j) = o; }
                    v[j] = v[j] * (1.0f + csc[j]) + csh[j]; u32x2 o; o.x = cvtpk(v[j][0], v[j][1]); o.y = cvtpk(v[j][2], v[j][3]); *(u32x2*)(hp + l8 + 512 * j) = o; }
                put_hilo(F.lds, F.wave * 4 + t, F.lane, v); } }
            if constexpr (!L0) { if (ps == 0) { LNR_LOAD(blk * 64 + 32 + F.wave * 4); } }
            __syncthreads();
            { const int nt = F.wave & 3, kh = F.wave >> 2, r = F.lane & 15, q = F.lane >> 4;
              f32x4 acc0, acc1; small_proj2(F.lds, kh, F.lane, wrf, wrf + 65536, acc0, acc1);
              if (kh == 0) {
#pragma unroll
                  for (int reg = 0; reg < 4; ++reg) { lg[(4 * q + reg) * 64 + 16 * nt + r] = acc0[reg]; lg[(16 + 4 * q + reg) * 64 + 16 * nt + r] = acc1[reg]; } }
              __syncthreads();
              if (kh == 1) {
#pragma unroll
                  for (int reg = 0; reg < 4; ++reg) { lg[(4 * q + reg) * 64 + 16 * nt + r] += acc0[reg]; lg[(16 + 4 * q + reg) * 64 + 16 * nt + r] += acc1[reg]; } } }
            __syncthreads();
#pragma unroll 1
            for (int rr = 0; rr < 4; ++rr) {
                const int row = rbase + rr, rl = ps * 32 + F.wave * 4 + rr;
                int ln = F.lane; asm volatile("" : "+v"(ln));
                const float logit = lg[(F.wave * 4 + rr) * 64 + F.lane];
                const float s = 1.0f / (1.0f + __expf(-logit)); const float bi = s + rb;
                float m1 = bi; m1 = fmaxf(m1, dppmov<0xB1>(m1)); m1 = fmaxf(m1, dppmov<0x4E>(m1)); m1 = fmaxf(m1, dppmov<0x141>(m1));
                const unsigned long long eq = __ballot(bi == m1);
                const int first = __ffs((int)((eq >> (ln & ~7)) & 0xffull)) - 1;
                float m2 = ((ln & 7) == first) ? -INFINITY : bi; m2 = fmaxf(m2, dppmov<0xB1>(m2)); m2 = fmaxf(m2, dppmov<0x4E>(m2)); m2 = fmaxf(m2, dppmov<0x141>(m2));
                const float gs = m1 + m2; int grank = 0;
#pragma unroll
                for (int j = 0; j < 8; ++j) { const float gj = rdlane(gs, 8 * j); grank += ((gj > gs) || (gj == gs && j < (ln >> 3))) ? 1 : 0; }
                const bool gsel = grank < 4;
                float mv = gsel ? bi : -INFINITY; int cnt = -1;
#pragma unroll
                for (int it = 0; it < TOPK; ++it) { const float mx = wave_max(mv); const unsigned long long em = __ballot(mv == mx); const int fl = __ffsll((long long)em) - 1;
                    if (ln == fl) { cnt = it; mv = -INFINITY; } }
                const bool sel = cnt >= 0;
                const float gsum = wave_sum(sel ? s : 0.f);
                if (sel) { const int lr = __hip_atomic_fetch_add(&lcnt[F.lane], 1, __ATOMIC_RELAXED, __HIP_MEMORY_SCOPE_WORKGROUP); lasg[rl * 8 + cnt] = (F.lane << 16) | lr;
                    asg_e[(size_t)row * 8 + cnt] = F.lane; ((LAS float*)(F.lds + LDS_LW))[rl * 8 + cnt] = s / gsum * 2.5f; }
            }
        }
        __syncthreads();
        if (F.tid < NEXP) { const int cn = lcnt[F.tid]; lbase[F.tid] = (cn && !dry) ? (int)atomicAdd(&gcount[F.tid], (unsigned)cn) : 0; lcnt[F.tid] = 0; }
        __syncthreads();
        { const int v = lasg[F.tid], e = v >> 16, rank = lbase[e] + (v & 0xffff); asg_r[(size_t)blk * 512 + F.tid] = rank;
          etok[(size_t)e * ECAP + rank] = blk * 64 + (F.tid >> 3); egate[(size_t)e * ECAP + rank] = ((const LAS float*)(F.lds + LDS_LW))[F.tid];
          if (F.tid < 64) { etok[(size_t)NEXP * ECAP + blk * 64 + F.tid] = blk * 64 + F.tid; egate[(size_t)NEXP * ECAP + blk * 64 + F.tid] = 1.0f; } }
        __syncthreads();
    }
#undef LNR_LOAD
}

DI void moe_scatter_phase(const Frame& F, const Args& A, int layer) {
    unsigned char* ws = opq(A.ws);
    const int* asg_e = (const int*)(ws + WS_ASG_E); const int* asg_r = (const int*)(ws + WS_ASG_R); const float* asg_w = (const float*)(ws + WS_ASG_W); int* asg_row = (int*)(ws + WS_ASG_ROW);
    int* rowtok = (int*)(ws + WS_ROWTOK); float* roww = (float*)(ws + WS_ROWW);
    const unsigned* gcount = (const unsigned*)(ws + WS_CTL) + CW_CNT + layer * 64;
    build_tileoff(F, gcount);
    const LAS int* tileoff = (const LAS int*)(F.lds + LDS_TILEOFF);
    for (int idx = F.bid * NTHR + F.tid; idx < T_ * TOPK; idx += F.G * NTHR) {
        const int e = asg_e[idx], row = 256 * tileoff[e] + asg_r[idx];
        rowtok[row] = idx >> 3; roww[row] = asg_w[idx]; asg_row[idx] = row;
    }
    for (int e = F.bid; e < NEXP; e += F.G) {
        const int cnt = (int)__hip_atomic_load(gcount + e, __ATOMIC_RELAXED, __HIP_MEMORY_SCOPE_AGENT), end = 256 * tileoff[e + 1];
        for (int row = 256 * tileoff[e] + cnt + F.tid; row < end; row += NTHR) { rowtok[row] = T_; roww[row] = 0.f; }
    }
    const int s0 = 256 * tileoff[64];
    for (int t = F.bid * NTHR + F.tid; t < T_; t += F.G * NTHR) { rowtok[s0 + t] = t; roww[s0 + t] = 1.0f; }
}

DI void ln_moe_phase(const Frame& F, const Args& A, int layer, float* dry_out) {
    unsigned char* ws = opq(A.ws);
    const float* MOD = (const float*)(ws + WS_MOD); const char* YE = (const char*)(ws + WS_BIG);
    float* AB = (float*)(ws + WS_AB);
    int s0 = 0;
    { const unsigned* gcount = (const unsigned*)(ws + WS_CTL) + CW_CNT + layer * 64; build_tileoff(F, gcount); s0 = 256 * ((const LAS int*)(F.lds + LDS_TILEOFF))[64]; }
    const int* asg_e = (const int*)(ws + WS_ASG_E); const int* asg_r = (const int*)(ws + WS_ASG_R);
    const int ls0 = layer * 2 + 1, ls1 = layer * 2 + 2; const bool last = layer == 3, want_ab = (layer & 1) == 0;
    const bf16* wabf = (const bf16*)(ws + WS_WABF) + (size_t)(layer >> 1) * 2 * 16384;
    const unsigned l4_ = (unsigned)F.lane * 4u, l8_ = (unsigned)F.lane * 8u, l16_ = (unsigned)F.lane * 16u;
    for (int blk = F.bid; blk < T_ / 64; blk += F.G) {
        const int b = blk >> 6;
        const char* gate = pg8::rfl_ptr((const char*)(MOD + (size_t)(ls0 * 4 + b) * 3072 + 2048)); const char* modn = pg8::rfl_ptr((const char*)(MOD + (size_t)((last ? ls0 : ls1) * 4 + b) * 3072));
        const char* lng = pg8::rfl_ptr((const char*)(A.ln_g + (size_t)ls0 * D_)); const char* lnb = pg8::rfl_ptr((const char*)(A.ln_b + (size_t)ls0 * D_));
        f32x4 cg[4], cng[4], cnb[4], csc[4], csh[4];
#pragma unroll
        for (int j = 0; j < 4; ++j) { cg[j] = *(const f32x4*)(gate + l16_ + 1024 * j); cng[j] = *(const f32x4*)(lng + l16_ + 1024 * j); cnb[j] = *(const f32x4*)(lnb + l16_ + 1024 * j);
            csc[j] = *(const f32x4*)(modn + 4096 + l16_ + 1024 * j); csh[j] = *(const f32x4*)(modn + l16_ + 1024 * j); }
#pragma unroll 1
        for (int ps = 0; ps < 2; ++ps) {
            const int rbase = blk * 64 + ps * 32 + F.wave * 4;
            const int ev = *(const int*)(pg8::rfl_ptr((const char*)(asg_e + (size_t)rbase * 8)) + (l4_ & 127u)), rv = *(const int*)(pg8::rfl_ptr((const char*)(asg_r + (size_t)rbase * 8)) + (l4_ & 127u));
            const int idxv = 256 * ((const LAS int*)(F.lds + LDS_TILEOFF))[ev] + rv;
#pragma unroll 1
            for (int rr = 0; rr < 4; ++rr) {
                const int row = rbase + rr; f32x4 v[4], y[4]; int w[9][4]; u32x2 sh[4];
                unsigned l4 = l4_, l8 = l8_, l16 = l16_; asm volatile("" : "+v"(l4), "+v"(l8), "+v"(l16));
#pragma unroll
                for (int k = 0; k < TOPK; ++k) { const int src = __builtin_amdgcn_readlane(idxv, rr * 8 + k); const char* p = pg8::rfl_ptr(YE + (size_t)src * D_);
#pragma unroll
                    for (int j = 0; j < 4; ++j) w[k][j] = __builtin_nontemporal_load((const int*)(p + l4 + 256 * j)); }
                if (YS_BF16) { const char* p = pg8::rfl_ptr(YE + WS_YS_OFF + (size_t)row * (D_ * 2));
#pragma unroll
                    for (int j = 0; j < 4; ++j) sh[j] = *(const u32x2*)(p + l8 + 512 * j);
                } else { const char* p = pg8::rfl_ptr(YE + (size_t)(s0 + row) * D_);
#pragma unroll
                    for (int j = 0; j < 4; ++j) w[8][j] = *(const int*)(p + l4 + 256 * j);
                }
                u32x2 xb[4];
                { const char* p = pg8::rfl_ptr((const char*)(ws + WS_X) + (size_t)row * (D_ * 2));
#pragma unroll
                  for (int j = 0; j < 4; ++j) xb[j] = *(const u32x2*)(p + l8 + 512 * j); }
                __builtin_amdgcn_sched_barrier(0);
#pragma unroll
                for (int j = 0; j < 4; ++j) { y[j] = (f32x4){0.f, 0.f, 0.f, 0.f}; v[j] = (f32x4){bf_lo(xb[j].x), bf_hi(xb[j].x), bf_lo(xb[j].y), bf_hi(xb[j].y)}; }
#pragma unroll
                for (int k = 0; k < (YS_BF16 ? TOPK : TOPK + 1); ++k) {
                    asm volatile("" : "+v"(w[k][0]), "+v"(w[k][1]), "+v"(w[k][2]), "+v"(w[k][3]), "+v"(y[0]), "+v"(y[1]), "+v"(y[2]), "+v"(y[3]));
#pragma unroll
                    for (int j = 0; j < 4; ++j) { const f32x2 a = __builtin_amdgcn_cvt_pk_f32_fp8(w[k][j], false), c = __builtin_amdgcn_cvt_pk_f32_fp8(w[k][j], true);
                        y[j][0] += a[0]; y[j][1] += a[1]; y[j][2] += c[0]; y[j][3] += c[1]; }
                    __builtin_amdgcn_sched_barrier(0);
                }
#pragma unroll
                for (int j = 0; j < 4; ++j) y[j] = y[j] * (1.0f / YE_SCALE);
                if (YS_BF16) {
#pragma unroll
                    for (int j = 0; j < 4; ++j) { y[j][0] += bf_lo(sh[j].x); y[j][1] += bf_hi(sh[j].x); y[j][2] += bf_lo(sh[j].y); y[j][3] += bf_hi(sh[j].y); }
                }
                deepnorm_row_c(v, y, cg, cng, cnb);
                if (last || dry_out) { char* op = (char*)pg8::rfl_ptr((const char*)(dry_out ? dry_out : A.out) + (size_t)row * (D_ * 4));
#pragma unroll
                    for (int j = 0; j < 4; ++j) *(f32x4*)(op + l16 + 1024 * j) = v[j];
                } else { char* xp = (char*)pg8::rfl_ptr((const char*)(ws + WS_X) + (size_t)row * (D_ * 2));
#pragma unroll
                    for (int j = 0; j < 4; ++j) { u32x2 o; o.x = cvtpk(v[j][0], v[j][1]); o.y = cvtpk(v[j][2], v[j][3]); *(u32x2*)(xp + l8 + 512 * j) = o; } }
                if (!last) { char* hp = (char*)pg8::rfl_ptr((const char*)(ws + WS_H) + (size_t)row * (D_ * 2));
#pragma unroll
                    for (int j = 0; j < 4; ++j) { v[j] = v[j] * (1.0f + csc[j]) + csh[j]; u32x2 o; o.x = cvtpk(v[j][0], v[j][1]); o.y = cvtpk(v[j][2], v[j][3]); *(u32x2*)(hp + l8 + 512 * j) = o; }
                    if (want_ab) put_hilo(F.lds, F.wave * 4 + rr, F.lane, v);
                }
            }
            if (!last && want_ab) {
                __syncthreads();
                if (F.wave < 2) { const int mt = F.wave, r = F.lane & 15, q = F.lane >> 4;
                    const f32x4 acc = small_proj(F.lds, mt, F.lane, wabf, wabf + 16384);
#pragma unroll
                    for (int reg = 0; reg < 4; ++reg) AB[(size_t)(blk * 64 + ps * 32 + 16 * mt + 4 * q + reg) * 16 + r] = acc[reg]; }
                __syncthreads();
            }
        }
    }
}
DI int crow(int r, int h) { return (r & 3) + 8 * (r >> 2) + 4 * h; }
typedef short v4i16_t __attribute__((ext_vector_type(4)));
DI s16x4 vtr(const LAS unsigned char* p) { return __builtin_bit_cast(s16x4, __builtin_amdgcn_ds_read_tr16_b64_v4i16((LAS v4i16_t*)p)); }
#define MFMA32(a, b, c) __builtin_amdgcn_mfma_f32_32x32x16_bf16((a), (b), (c), 0, 0, 0)
constexpr int ATT_ORUN = 0, ATT_LRUN = 65536, ATT_VBUF = 65536 + 2048, ATT_VSTRIDE = 144, ATT_VBYTES = 32 * ATT_VSTRIDE;

#ifndef REP_A1
#define REP_A1 1
#define REP_A2 1
#endif
DI void attn_phase(const Frame& F, const Args& A) {
    unsigned char* ws = opq(A.ws);
    const bf16* QKV = (const bf16*)(ws + WS_BIG); bf16* O = (bf16*)(ws + WS_O);
    LAS unsigned char* orun = F.lds + ATT_ORUN;
    LAS float* lrun = (LAS float*)(F.lds + ATT_LRUN);
    LAS unsigned char* vbuf = F.lds + ATT_VBUF + F.wave * ATT_VBYTES;
    const int lane = F.lane, qi = lane & 31, h = lane >> 5;
    const int g16 = lane >> 4, q4 = (lane & 15) >> 2, p4 = lane & 3;
    for (int it = F.bid; it < NB_ * 16 * 8; it += F.G) {
        int item = it;
        if (F.G == 256) { const int w = it & 255, xcd = w & 7, j = w >> 3; item = (((it >> 8) * 32 + xcd * 4 + (j >> 3)) << 3) | (j & 7); }
        const int b = item >> 7, head = (item >> 3) & 15, ck = item & 7;
        for (int gi = 0; gi < 3; ++gi) {
            const int g = 2 - gi, ldil = 2 * g, Lg = S_ >> ldil;
            const size_t hb = (((size_t)g * NB_ + b) * 16 + head) * S_ * 64;
            const bf16* Qg = QKV + hb; const bf16* Kg = QKV + (size_t)3 * NB_ * 16 * S_ * 64 + hb; const bf16* Vg = QKV + (size_t)6 * NB_ * 16 * S_ * 64 + hb;
            for (int sub = F.wave; sub < 16; sub += NWAVES) {
                int r_, tile;
                if (g == 0) { r_ = 0; tile = sub; } else if (g == 1) { r_ = sub >> 2; tile = sub & 3; } else { r_ = sub; tile = 0; }
                const int m0 = ((512 * ck) >> ldil) + 32 * tile;
                const bf16* Kr = Kg + (size_t)r_ * Lg * 64; const bf16* Vr = Vg + (size_t)r_ * Lg * 64;
                f32x16 st[5]; u32x4 vv[5][4]; float mx, lsum;
#pragma unroll 1
                for (int rep1 = 0; rep1 < REP_A1; ++rep1) {
                unsigned lc = (unsigned)((lane >> 3) * 128 + (lane & 7) * 16); asm volatile("" : "+v"(lc));
                const int wofs = (lane >> 3) * ATT_VSTRIDE + (lane & 7) * 16, rofs = qi * ATT_VSTRIDE + 64 * h;
                u32x4 qv[4], kv[5][4];
                { const char* qp = pg8::rfl_ptr((const char*)(Qg + ((size_t)r_ * Lg + m0) * 64));
#pragma unroll
                  for (int i = 0; i < 4; ++i) qv[i] = *(const u32x4*)(qp + lc + 1024 * i); }
#pragma unroll
                for (int kt = 0; kt < 5; ++kt) { const int mk0 = m0 - 128 + 32 * kt; const char* kp = pg8::rfl_ptr((const char*)(Kr + (size_t)(mk0 < 0 ? 0 : mk0) * 64));
#pragma unroll
                    for (int i = 0; i < 4; ++i) kv[kt][i] = *(const u32x4*)(kp + lc + 1024 * i); }
                __builtin_amdgcn_sched_barrier(0);
                bf16x8 qf[4];
#pragma unroll
                for (int i = 0; i < 4; ++i) *(LAS u32x4*)(vbuf + wofs + 8 * i * ATT_VSTRIDE) = qv[i];
                LDS_WAIT(); asm volatile("" ::: "memory");
#pragma unroll
                for (int s = 0; s < 4; ++s) qf[s] = *(const LAS bf16x8*)(vbuf + rofs + 16 * s);
                LDS_WAIT(); asm volatile("" ::: "memory");
#pragma unroll
                for (int kt = 0; kt < 5; ++kt) {
                    const int mk0 = m0 - 128 + 32 * kt;
                    bf16x8 kf[4];
#pragma unroll
                    for (int i = 0; i < 4; ++i) *(LAS u32x4*)(vbuf + wofs + 8 * i * ATT_VSTRIDE) = kv[kt][i];
                    LDS_WAIT(); asm volatile("" ::: "memory");
#pragma unroll
                    for (int s = 0; s < 4; ++s) kf[s] = *(const LAS bf16x8*)(vbuf + rofs + 16 * s);
                    { const char* vp = pg8::rfl_ptr((const char*)(Vr + (size_t)(mk0 < 0 ? 0 : mk0) * 64));
#pragma unroll
                      for (int i = 0; i < 4; ++i) vv[kt][i] = *(const u32x4*)(vp + lc + 1024 * i); }
                    LDS_WAIT(); asm volatile("" ::: "memory");
#pragma unroll
                    for (int r = 0; r < 16; ++r) st[kt][r] = 0.f;
#pragma unroll
                    for (int s = 0; s < 4; ++s) st[kt] = MFMA32(kf[s], qf[s], st[kt]);
                    if (mk0 < 0) {
#pragma unroll
                        for (int r = 0; r < 16; ++r) st[kt][r] = -INFINITY;
                    }
                }
#pragma unroll
                for (int r = 0; r < 16; ++r) { const int kr = crow(r, h); if (kr < qi) st[0][r] = -INFINITY; if (kr > qi) st[4][r] = -INFINITY; }
                mx = -INFINITY;
#pragma unroll
                for (int kt = 0; kt < 5; ++kt)
#pragma unroll
                    for (int r = 0; r < 16; ++r) mx = fmaxf(mx, st[kt][r]);
                mx = fmaxf(mx, bperm(mx, F.lane ^ 32));
                lsum = 0.f;
#pragma unroll
                for (int kt = 0; kt < 5; ++kt)
#pragma unroll
                    for (int r = 0; r < 16; ++r) { const float p = __builtin_amdgcn_exp2f(st[kt][r] - mx); st[kt][r] = p; lsum += p; }
                lsum += bperm(lsum, F.lane ^ 32);
                }
                f32x16 oacc[2];
#pragma unroll 1
                for (int rep2 = 0; rep2 < REP_A2; ++rep2) {
#pragma unroll
                for (int r = 0; r < 16; ++r) { oacc[0][r] = 0.f; oacc[1][r] = 0.f; }
#pragma unroll
                for (int kt = 0; kt < 5; ++kt) {
                    const int mk0 = m0 - 128 + 32 * kt;
                    if (mk0 >= 0) {
#pragma unroll
                        for (int i = 0; i < 4; ++i) *(LAS u32x4*)(vbuf + ((lane >> 3) + 8 * i) * ATT_VSTRIDE + (lane & 7) * 16) = vv[kt][i];
                        LDS_WAIT(); asm volatile("" ::: "memory");
                        s16x4 flo[2][2], fhi[2][2];
#pragma unroll
                        for (int sp = 0; sp < 2; ++sp)
#pragma unroll
                            for (int dvt = 0; dvt < 2; ++dvt) {
                                const int colb = (32 * dvt + 16 * (g16 & 1) + 4 * p4) * 2;
                                flo[sp][dvt] = vtr(vbuf + (16 * sp + 4 * h + q4) * ATT_VSTRIDE + colb);
                                fhi[sp][dvt] = vtr(vbuf + (16 * sp + 8 + 4 * h + q4) * ATT_VSTRIDE + colb);
                            }
                        LDS_WAIT(); asm volatile("" ::: "memory");
#pragma unroll
                        for (int sp = 0; sp < 2; ++sp) {
                            bf16x8 pf; {
                                const unsigned w0 = cvtpk(st[kt][8 * sp + 0], st[kt][8 * sp + 1]), w1 = cvtpk(st[kt][8 * sp + 2], st[kt][8 * sp + 3]);
                                const unsigned w2 = cvtpk(st[kt][8 * sp + 4], st[kt][8 * sp + 5]), w3 = cvtpk(st[kt][8 * sp + 6], st[kt][8 * sp + 7]);
                                pf = __builtin_bit_cast(bf16x8, (u32x4){w0, w1, w2, w3}); }
#pragma unroll
                            for (int dvt = 0; dvt < 2; ++dvt) {
                                const bf16x8 vf = __builtin_shufflevector(flo[sp][dvt], fhi[sp][dvt], 0, 1, 2, 3, 4, 5, 6, 7);
                                oacc[dvt] = MFMA32(vf, pf, oacc[dvt]);
                            }
                        }
                    }
                }
                asm volatile("" : "+v"(oacc[0]), "+v"(oacc[1]));
                }
                const float inv = __builtin_amdgcn_rcpf(lsum), lse = mx + __builtin_amdgcn_logf(lsum);
                const int tl = ((32 * tile + qi) << ldil) + r_;
                float wa = 0.f, wb = 1.f;
                if (gi > 0) { const float L0 = lrun[tl]; const float M = fmaxf(L0, lse); const float ea = __builtin_amdgcn_exp2f(L0 - M), eb = __builtin_amdgcn_exp2f(lse - M);
                    const float isum = __builtin_amdgcn_rcpf(ea + eb); wa = ea * isum; wb = eb * isum; asm volatile("" ::: "memory");
                    if (h == 0) lrun[tl] = M + __builtin_amdgcn_logf(ea + eb); }
                else if (h == 0) lrun[tl] = lse;
                wb *= inv;
#pragma unroll
                for (int dvt = 0; dvt < 2; ++dvt)
#pragma unroll
                    for (int k4 = 0; k4 < 4; ++k4) {
                        const int dv = 32 * dvt + 8 * k4 + 4 * h;
                        float o0 = oacc[dvt][4 * k4 + 0] * wb, o1 = oacc[dvt][4 * k4 + 1] * wb, o2 = oacc[dvt][4 * k4 + 2] * wb, o3 = oacc[dvt][4 * k4 + 3] * wb;
                        LAS u32x2* op = (LAS u32x2*)(orun + tl * 128 + dv * 2);
                        if (gi > 0) { const u32x2 w = *op; o0 += wa * bf_lo(w.x); o1 += wa * bf_hi(w.x); o2 += wa * bf_lo(w.y); o3 += wa * bf_hi(w.y); }
                        u32x2 wo; wo.x = cvtpk(o0, o1); wo.y = cvtpk(o2, o3);
                        if (gi < 2) *op = wo;
                        else *(u32x2*)(O + ((size_t)b * S_ + 512 * ck + tl) * D_ + head * 64 + dv) = wo;
                    }
            }
            __syncthreads();
        }
    }
}

DI void gdn_post_phase(const Frame& F, const Args& A, int j) {
    unsigned char* ws = opq(A.ws); unsigned char* big = ws + WS_BIG;
    const bf16* Oraw = (const bf16*)(ws + WS_Y); const bf16* PROJ = (const bf16*)(big + BIG_PROJ); bf16* O = (bf16*)(ws + WS_O);
    const float* nw = A.gdn_norm_w + (size_t)j * 128;
    const int gw = F.bid * NWAVES + F.wave, NGW = F.G * NWAVES, lane = F.lane;
    const f32x4 nwv = *(const f32x4*)(nw + ((4 * lane) & 127));
    const unsigned l8_ = (unsigned)lane * 8u;
#pragma unroll 2
    for (int row = gw; row < T_; row += NGW) {
        unsigned l8 = l8_; asm volatile("" : "+v"(l8));
        const char* op = pg8::rfl_ptr((const char*)(Oraw + (size_t)row * D_)); const char* zp = pg8::rfl_ptr((const char*)(PROJ + (size_t)row * 4096 + 3072));
        u32x2 ow[4], zw[4];
#pragma unroll
        for (int jj = 0; jj < 4; ++jj) { ow[jj] = *(const u32x2*)(op + l8 + 512 * jj); zw[jj] = *(const u32x2*)(zp + l8 + 512 * jj); }
        f32x4 v[4];
#pragma unroll
        for (int jj = 0; jj < 4; ++jj) {
            v[jj] = (f32x4){bf_lo(ow[jj].x), bf_hi(ow[jj].x), bf_lo(ow[jj].y), bf_hi(ow[jj].y)};
            float ss = (v[jj][0] * v[jj][0] + v[jj][1] * v[jj][1]) + (v[jj][2] * v[jj][2] + v[jj][3] * v[jj][3]);
            ss += dppmov<0xB1>(ss); ss += dppmov<0x4E>(ss); ss += dppmov<0x141>(ss); ss += dppmov<0x140>(ss); ss += shx<16>(ss);
            const float rs = rsqrtf(ss * (1.0f / 128.0f) + RMS_EPS);
            const float z0 = bf_lo(zw[jj].x), z1 = bf_hi(zw[jj].x), z2 = bf_lo(zw[jj].y), z3 = bf_hi(zw[jj].y);
            v[jj][0] = v[jj][0] * rs * nwv[0] * silu_f(z0); v[jj][1] = v[jj][1] * rs * nwv[1] * silu_f(z1);
            v[jj][2] = v[jj][2] * rs * nwv[2] * silu_f(z2); v[jj][3] = v[jj][3] * rs * nwv[3] * silu_f(z3);
        }
        store_row16_bf16(O + (size_t)row * D_, lane, v);
    }
}
constexpr size_t GB_KR = 128 * MiB, GB_QR = 160 * MiB, GB_KT = 192 * MiB, GB_VT = 224 * MiB, GB_BLOB = 256 * MiB;
constexpr int BLOB_ELEMS = 28672, BLOB_W = 0, BLOB_QG = 8192, BLOB_QK = 16384, BLOB_KDT = 20480;
DI int frag_pos(int row, int k, int nks) { const int kk = k & 31; return ((((row >> 4) * nks + (k >> 5)) * 64 + ((kk >> 2) & 3) * 16 + (row & 15)) * 8) + 4 * (kk >> 4) + (kk & 3); }
#define MFMA16(a, b, c) __builtin_amdgcn_mfma_f32_16x16x32_bf16((a), (b), (c), 0, 0, 0)
DI u32x2 pk4(float a, float b, float c, float d) { u32x2 w; w.x = cvtpk(a, b); w.y = cvtpk(c, d); return w; }

DI int tile_off(int t, int c) { return t * 256 + ((((c >> 4) ^ (t & 7)) << 5) | ((c & 15) << 1)); }
template <int WH> DI void prep_conv_pass(const bf16* PROJ, const float* cw, int b, int hh, int t0, int lane, LAS unsigned char* tile, bf16* rowdst, const LAS float* escale, bool normalize, float nscale) {
    float w[4][2];
#pragma unroll
    for (int jj = 0; jj < 4; ++jj) { const f32x2 t = *(const f32x2*)(cw + (size_t)jj * 3072 + WH * 1024 + hh * 128 + 2 * lane); w[jj][0] = t.x; w[jj][1] = t.y; }
    float A0[35], A1[35];
#pragma unroll
    for (int jj = 0; jj < 3; ++jj) { const int t = t0 - 3 + jj; unsigned u = 0u;
        if (t >= 0) u = *(const unsigned*)(PROJ + ((size_t)b * S_ + t) * 4096 + WH * 1024 + hh * 128 + 2 * lane);
        A0[jj] = bf_lo(u); A1[jj] = bf_hi(u); }
#pragma unroll 1
    for (int hb = 0; hb < 2; ++hb) {
        { unsigned xin[32];
#pragma unroll
          for (int i = 0; i < 32; ++i) xin[i] = __builtin_nontemporal_load((const unsigned*)(PROJ + ((size_t)b * S_ + t0 + 32 * hb + i) * 4096 + WH * 1024 + hh * 128 + 2 * lane));
#pragma unroll
          for (int i = 0; i < 32; ++i) { A0[3 + i] = bf_lo(xin[i]); A1[3 + i] = bf_hi(xin[i]); } }
#pragma unroll
        for (int i = 0; i < 32; ++i) {
            A0[i] = w[0][0] * A0[i] + w[1][0] * A0[i + 1] + w[2][0] * A0[i + 2] + w[3][0] * A0[i + 3];
            A1[i] = w[0][1] * A1[i] + w[1][1] * A1[i + 1] + w[2][1] * A1[i + 2] + w[3][1] * A1[i + 3]; }
#pragma unroll
        for (int i = 0; i < 32; ++i) { A0[i] = silu_f(A0[i]); A1[i] = silu_f(A1[i]); }
        if (normalize) {
            float rs[32];
#pragma unroll
            for (int i = 0; i < 32; ++i) rs[i] = wave_sum(A0[i] * A0[i] + A1[i] * A1[i]);
#pragma unroll
            for (int i = 0; i < 32; ++i) { const float r = rsqrtf(rs[i] + RMS_EPS) * nscale; A0[i] *= r; A1[i] *= r; }
        }
#pragma unroll
        for (int i = 0; i < 32; ++i) {
            const int tt = 32 * hb + i;
            if (rowdst) *(unsigned*)(rowdst + (size_t)tt * 128 + 2 * lane) = cvtpk(A0[i], A1[i]);
            const float es = escale ? escale[tt] : 1.0f;
            *(LAS unsigned*)(tile + tile_off(tt, 2 * lane)) = cvtpk(A0[i] * es, A1[i] * es);
        }
#pragma unroll
        for (int jj = 0; jj < 3; ++jj) { A0[jj] = A0[32 + jj]; A1[jj] = A1[32 + jj]; }
    }
    LDS_WAIT(); asm volatile("" ::: "memory");
}
DI void tile_tr8(const LAS unsigned char* tile, int tb, int tb2, int cb, int lane, s16x4& lo, s16x4& hi) {
    const int q4 = (lane & 15) >> 2, p4 = lane & 3;
    lo = vtr(tile + tile_off(tb + q4, cb + 4 * p4)); hi = vtr(tile + tile_off(tb2 + q4, cb + 4 * p4));
}
DI void gdn_prep2_phase(const Frame& F, const Args& A, int j) {
    unsigned char* ws = opq(A.ws); unsigned char* big = ws + WS_BIG;
    const bf16* PROJ = (const bf16*)(big + BIG_PROJ);
    bf16* KR = (bf16*)(big + GB_KR); bf16* QR = (bf16*)(big + GB_QR); bf16* KT = (bf16*)(big + GB_KT); bf16* VT = (bf16*)(big + GB_VT); bf16* BLOB = (bf16*)(big + GB_BLOB);
    const float* AB = (const float*)(ws + WS_AB); float* GC = (float*)(ws + WS_GALPHA); float* GB = (float*)(ws + WS_GBETA);
    const float* cw = A.gdn_conv_w + (size_t)j * 4 * 3072;
    const int gw = F.bid * NWAVES + F.wave, NGW = F.G * NWAVES, lane = F.lane, g16 = lane >> 4, i16 = lane & 15;
    LAS unsigned char* tile = F.lds + F.wave * 16384;
    LAS float* egl = (LAS float*)(F.lds + LDS_LG + F.wave * 512); LAS float* ekl = egl + 64;
    for (int it = gw; it < NB_ * 8 * 64; it += NGW) {
        const int b = it >> 9, hh = (it >> 6) & 7, n = it & 63, t0 = 64 * n, bh = b * 8 + hh;
        { const int row = b * S_ + t0 + lane; const float a = AB[(size_t)row * 16 + hh], bl = AB[(size_t)row * 16 + 8 + hh];
          const float xs = a + A.gdn_dt_bias[j * 8 + hh]; const float ey = __expf(xs); const float sp = xs > 20.f ? xs : (ey < 1e-3f ? ey * (1.0f - 0.5f * ey) : __logf(1.0f + ey));
          float gc = -__expf(A.gdn_a_log[j * 8 + hh]) * sp;
#pragma unroll
          for (int o = 1; o < 64; o <<= 1) { const float t = bperm(gc, lane - o); if (lane >= o) gc += t; }
          const float gl = rdlane(gc, 63);
          GC[(size_t)bh * S_ + t0 + lane] = gc; GB[(size_t)bh * S_ + t0 + lane] = 1.0f / (1.0f + __expf(-bl));
          egl[lane] = __expf(gc); ekl[lane] = __expf(gl - gc); }
        LDS_WAIT(); asm volatile("" ::: "memory");
        bf16* blob = BLOB + (size_t)it * BLOB_ELEMS;
        bf16* ktc = KT + (size_t)it * 8192; bf16* vtc = VT + (size_t)it * 8192;
        const size_t rbase = ((size_t)bh * S_ + t0) * 128;
        prep_conv_pass<1>(PROJ, cw, b, hh, t0, lane, tile, KR + rbase, nullptr, true, 1.0f);
#pragma unroll 2
        for (int db = 0; db < 8; ++db)
#pragma unroll
            for (int half = 0; half < 2; ++half) { s16x4 lo, hi; const int tb = 32 * half + 8 * g16; tile_tr8(tile, tb, tb + 4, 16 * db, lane, lo, hi);
                *(bf16x8*)(ktc + (16 * db + i16) * 64 + tb) = __builtin_shufflevector(lo, hi, 0, 1, 2, 3, 4, 5, 6, 7); }
#pragma unroll 2
        for (int a = 0; a < 8; ++a)
#pragma unroll
            for (int ks = 0; ks < 2; ++ks) { s16x4 lo, hi; const int tb = 32 * ks + 4 * g16; tile_tr8(tile, tb, tb + 16, 16 * a, lane, lo, hi);
                const f32x4 e0 = *(const LAS f32x4*)(ekl + tb), e1 = *(const LAS f32x4*)(ekl + tb + 16);
                u32x4 wv;
                wv.x = cvtpk(bf_lo((unsigned)(unsigned short)lo[0]) * e0[0], bf_lo((unsigned)(unsigned short)lo[1]) * e0[1]); wv.y = cvtpk(bf_lo((unsigned)(unsigned short)lo[2]) * e0[2], bf_lo((unsigned)(unsigned short)lo[3]) * e0[3]);
                wv.z = cvtpk(bf_lo((unsigned)(unsigned short)hi[0]) * e1[0], bf_lo((unsigned)(unsigned short)hi[1]) * e1[1]); wv.w = cvtpk(bf_lo((unsigned)(unsigned short)hi[2]) * e1[2], bf_lo((unsigned)(unsigned short)hi[3]) * e1[3]);
                *(u32x4*)(blob + BLOB_KDT + ((a * 2 + ks) * 64 + lane) * 8) = wv; }
        LDS_WAIT(); asm volatile("" ::: "memory");
        prep_conv_pass<2>(PROJ, cw, b, hh, t0, lane, tile, nullptr, nullptr, false, 1.0f);
#pragma unroll 2
        for (int db = 0; db < 8; ++db)
#pragma unroll
            for (int half = 0; half < 2; ++half) { s16x4 lo, hi; const int tb = 32 * half + 8 * g16; tile_tr8(tile, tb, tb + 4, 16 * db, lane, lo, hi);
                *(bf16x8*)(vtc + (16 * db + i16) * 64 + tb) = __builtin_shufflevector(lo, hi, 0, 1, 2, 3, 4, 5, 6, 7); }
        LDS_WAIT(); asm volatile("" ::: "memory");
        prep_conv_pass<0>(PROJ, cw, b, hh, t0, lane, tile, QR + rbase, egl, true, 0.08838834764831845f);
#pragma unroll 2
        for (int tm = 0; tm < 4; ++tm)
#pragma unroll
            for (int ks = 0; ks < 4; ++ks) {
                const u32x2 p0 = *(const LAS u32x2*)(tile + tile_off(16 * tm + i16, 32 * ks + 4 * g16)), p1 = *(const LAS u32x2*)(tile + tile_off(16 * tm + i16, 32 * ks + 16 + 4 * g16));
                *(u32x4*)(blob + BLOB_QG + ((tm * 4 + ks) * 64 + lane) * 8) = (u32x4){p0.x, p0.y, p1.x, p1.y}; }
        LDS_WAIT(); asm volatile("" ::: "memory");
    }
}

DI void gdn_wy_phase(const Frame& F, const Args& A) {
    unsigned char* ws = opq(A.ws); unsigned char* big = ws + WS_BIG;
    const bf16* KR = (const bf16*)(big + GB_KR); const bf16* QR = (const bf16*)(big + GB_QR); const bf16* KT = (const bf16*)(big + GB_KT); const bf16* VT = (const bf16*)(big + GB_VT);
    bf16* BLOB = (bf16*)(big + GB_BLOB); float* U = (float*)(ws + WS_HID);
    const float* GC = (const float*)(ws + WS_GALPHA); const float* GB = (const float*)(ws + WS_GBETA);
    const int gw = F.bid * NWAVES + F.wave, NGW = F.G * NWAVES, lane = F.lane, r = lane & 15, q = lane >> 4;
    LAS float* Af = (LAS float*)(F.lds + F.wave * 16384);
    asm volatile("s_waitcnt vmcnt(0)" ::: "memory"); __builtin_amdgcn_fence(__ATOMIC_ACQUIRE, "agent");
    for (int it = gw; it < NB_ * 8 * 64; it += NGW) {
        const int bh = it >> 6, n = it & 63;
        const char* kr = pg8::rfl_ptr((const char*)(KR + ((size_t)bh * S_ + 64 * n) * 128)); const char* qr = pg8::rfl_ptr((const char*)(QR + ((size_t)bh * S_ + 64 * n) * 128));
        const char* kt = pg8::rfl_ptr((const char*)(KT + (size_t)it * 8192)); const char* vt = pg8::rfl_ptr((const char*)(VT + (size_t)it * 8192));
        char* blob = (char*)pg8::rfl_ptr((const char*)(BLOB + (size_t)it * BLOB_ELEMS)); char* ub = (char*)pg8::rfl_ptr((const char*)(U + (size_t)it * 8192));
        const unsigned lrow = (unsigned)(r * 128 + 8 * q) * 2u, ltr = (unsigned)(r * 64 + 8 * q) * 2u, lfrag = (unsigned)(q * 16 + r) * 16u;
        const float gcl = GC[(size_t)bh * S_ + 64 * n + lane], bel = GB[(size_t)bh * S_ + 64 * n + lane];
        __builtin_amdgcn_wave_barrier();
        bf16x8 kfr[4][4], qfr[4][4];
#pragma unroll
        for (int t4 = 0; t4 < 4; ++t4)
#pragma unroll
            for (int ks = 0; ks < 4; ++ks) { kfr[t4][ks] = *(const bf16x8*)(kr + lrow + (16 * t4 * 128 + 32 * ks) * 2); qfr[t4][ks] = *(const bf16x8*)(qr + lrow + (16 * t4 * 128 + 32 * ks) * 2); }
#pragma unroll
        for (int ti = 0; ti < 4; ++ti) {
            const float gi = bperm(gcl, 16 * ti + r), bi = bperm(bel, 16 * ti + r);
#pragma unroll
            for (int tj = 0; tj < 4; ++tj) {
                char* qkdst = blob + (BLOB_QK + ((ti * 2 + (tj >> 1)) * 64) * 8 + 4 * (tj & 1)) * 2 + lfrag;
                if (tj > ti) { *(u32x2*)qkdst = (u32x2){0u, 0u}; *(LAS f32x4*)(Af + (16 * ti + r) * 64 + 16 * tj + 4 * q) = (f32x4){0.f, 0.f, 0.f, 0.f}; continue; }
                f32x4 p1 = (f32x4){0.f, 0.f, 0.f, 0.f}, p2 = p1;
#pragma unroll
                for (int ks = 0; ks < 4; ++ks) { p1 = MFMA16(kfr[tj][ks], kfr[ti][ks], p1); p2 = MFMA16(kfr[tj][ks], qfr[ti][ks], p2); }
                const int i = 16 * ti + r; f32x4 av, qv;
#pragma unroll
                for (int reg = 0; reg < 4; ++reg) { const int jx = 16 * tj + 4 * q + reg; const float gj = bperm(gcl, jx);
                    const float dec = (jx <= i) ? __expf(gi - gj) : 0.f;
                    av[reg] = (jx < i) ? bi * p1[reg] * dec : 0.f; qv[reg] = p2[reg] * dec; }
                *(LAS f32x4*)(Af + i * 64 + 16 * tj + 4 * q) = av;
                *(u32x2*)qkdst = pk4(qv[0], qv[1], qv[2], qv[3]);
                asm volatile("" ::: "memory");
            }
        }
        LDS_WAIT(); asm volatile("" ::: "memory");
#pragma unroll 1
        for (int i0 = 0; i0 < 64; i0 += 4) {
            float a0 = (i0 + 0 == lane) ? 1.0f : 0.0f, a1 = (i0 + 1 == lane) ? 1.0f : 0.0f, a2 = (i0 + 2 == lane) ? 1.0f : 0.0f, a3 = (i0 + 3 == lane) ? 1.0f : 0.0f;
#pragma unroll 2
            for (int j4 = 0; j4 < (i0 >> 2); ++j4) {
                const float t0 = Af[(4 * j4 + 0) * 64 + lane], t1 = Af[(4 * j4 + 1) * 64 + lane], t2 = Af[(4 * j4 + 2) * 64 + lane], t3 = Af[(4 * j4 + 3) * 64 + lane];
                const f32x4 r0 = *(const LAS f32x4*)(Af + (i0 + 0) * 64 + 4 * j4), r1 = *(const LAS f32x4*)(Af + (i0 + 1) * 64 + 4 * j4);
                const f32x4 r2 = *(const LAS f32x4*)(Af + (i0 + 2) * 64 + 4 * j4), r3 = *(const LAS f32x4*)(Af + (i0 + 3) * 64 + 4 * j4);
                a0 -= r0[0] * t0 + r0[1] * t1 + r0[2] * t2 + r0[3] * t3; a1 -= r1[0] * t0 + r1[1] * t1 + r1[2] * t2 + r1[3] * t3;
                a2 -= r2[0] * t0 + r2[1] * t1 + r2[2] * t2 + r2[3] * t3; a3 -= r3[0] * t0 + r3[1] * t1 + r3[2] * t2 + r3[3] * t3;
            }
            const f32x4 d1 = *(const LAS f32x4*)(Af + (i0 + 1) * 64 + i0), d2 = *(const LAS f32x4*)(Af + (i0 + 2) * 64 + i0), d3 = *(const LAS f32x4*)(Af + (i0 + 3) * 64 + i0);
            a1 -= d1[0] * a0; a2 -= d2[0] * a0 + d2[1] * a1; a3 -= d3[0] * a0 + d3[1] * a1 + d3[2] * a2;
            LDS_WAIT(); asm volatile("" ::: "memory");
            Af[(i0 + 0) * 64 + lane] = a0; Af[(i0 + 1) * 64 + lane] = a1; Af[(i0 + 2) * 64 + lane] = a2; Af[(i0 + 3) * 64 + lane] = a3;
            LDS_WAIT(); asm volatile("" ::: "memory");
        }
        bf16x8 tuf[4][2], twf[4][2];
        {
            const float* gcp = GC + (size_t)bh * S_ + 64 * n; const float* gbp = GB + (size_t)bh * S_ + 64 * n;
#pragma unroll
            for (int ks = 0; ks < 2; ++ks) {
                float su[8], sw[8];
#pragma unroll
                for (int h4 = 0; h4 < 2; ++h4) { const f32x4 bv = *(const f32x4*)(gbp + 32 * ks + 8 * q + 4 * h4), gv = *(const f32x4*)(gcp + 32 * ks + 8 * q + 4 * h4);
#pragma unroll
                    for (int e = 0; e < 4; ++e) { su[4 * h4 + e] = bv[e]; sw[4 * h4 + e] = -bv[e] * __expf(gv[e]); } }
#pragma unroll
                for (int tm = 0; tm < 4; ++tm) {
                    const f32x4 x0 = *(const LAS f32x4*)(Af + (16 * tm + r) * 64 + 32 * ks + 8 * q), x1 = *(const LAS f32x4*)(Af + (16 * tm + r) * 64 + 32 * ks + 8 * q + 4);
                    tuf[tm][ks] = __builtin_bit_cast(bf16x8, (u32x4){cvtpk(x0[0] * su[0], x0[1] * su[1]), cvtpk(x0[2] * su[2], x0[3] * su[3]), cvtpk(x1[0] * su[4], x1[1] * su[5]), cvtpk(x1[2] * su[6], x1[3] * su[7])});
                    twf[tm][ks] = __builtin_bit_cast(bf16x8, (u32x4){cvtpk(x0[0] * sw[0], x0[1] * sw[1]), cvtpk(x0[2] * sw[2], x0[3] * sw[3]), cvtpk(x1[0] * sw[4], x1[1] * sw[5]), cvtpk(x1[2] * sw[6], x1[3] * sw[7])});
                }
            }
        }
        LDS_WAIT(); asm volatile("" ::: "memory");
        {
#pragma unroll
            for (int w8 = 0; w8 < 8; ++w8) {
                bf16x8 vb[2];
#pragma unroll
                for (int ks = 0; ks < 2; ++ks) vb[ks] = *(const bf16x8*)(vt + ltr + (16 * w8 * 64 + 32 * ks) * 2);
#pragma unroll
                for (int tm = 0; tm < 4; ++tm) { f32x4 acc = (f32x4){0.f, 0.f, 0.f, 0.f};
#pragma unroll
                    for (int ks = 0; ks < 2; ++ks) acc = MFMA16(tuf[tm][ks], vb[ks], acc);
                    *(f32x4*)(ub + (unsigned)lane * 16u + ((w8 * 4 + tm) * 64) * 16) = acc; }
            }
        }
        {
#pragma unroll
            for (int a = 0; a < 8; ++a) {
                bf16x8 ka[2];
#pragma unroll
                for (int ks = 0; ks < 2; ++ks) ka[ks] = *(const bf16x8*)(kt + ltr + (16 * a * 64 + 32 * ks) * 2);
#pragma unroll
                for (int ti = 0; ti < 4; ++ti) { f32x4 acc = (f32x4){0.f, 0.f, 0.f, 0.f};
#pragma unroll
                    for (int ks = 0; ks < 2; ++ks) acc = MFMA16(ka[ks], twf[ti][ks], acc);
                    *(u32x2*)(blob + (BLOB_W + ((ti * 4 + (a >> 1)) * 64) * 8 + 4 * (a & 1)) * 2 + lfrag) = pk4(acc[0], acc[1], acc[2], acc[3]); }
            }
        }
        LDS_WAIT(); asm volatile("" ::: "memory");
    }
}

constexpr int SCAN_BUF = BLOB_ELEMS * 2;
DI bf16x8 pack8(const f32x4& lo, const f32x4& hi) { return __builtin_bit_cast(bf16x8, (u32x4){cvtpk(lo[0], lo[1]), cvtpk(lo[2], lo[3]), cvtpk(hi[0], hi[1]), cvtpk(hi[2], hi[3])}); }
DI void ld16_asm(u32x4& dst, const char* sbase, unsigned voff) { asm volatile("global_load_dwordx4 %0, %1, %2" : "=v"(dst) : "v"(voff), "s"(sbase) : "memory"); }
#define SCAN_LOAD(RSET, chunk) do { const char* _cb = pg8::rfl_ptr(src + (size_t)(chunk) * SCAN_BUF); \
    _Pragma("unroll") for (int i = 0; i < 14; ++i) ld16_asm(RSET[i], pg8::rfl_ptr(_cb + i * 4096), ltid16); } while (0)
#define SCAN_PUT(RSET, BUF) do { _Pragma("unroll") for (int i = 0; i < 14; ++i) *(LAS u32x4*)(F.lds + (BUF) * SCAN_BUF + i * 4096 + ltid16) = RSET[i]; } while (0)
#define SCAN_LSTEP(n_, BUFN, RFREE, RNEXT) do { const int n = (n_); \
    if (n + 3 < 64) { SCAN_LOAD(RFREE, n + 3); asm volatile("s_waitcnt vmcnt(28)" ::: "memory"); } else { asm volatile("s_waitcnt vmcnt(0)" ::: "memory"); } \
    __builtin_amdgcn_sched_barrier(0); \
    if (n + 1 < 64) SCAN_PUT(RNEXT, BUFN); \
    asm volatile("s_waitcnt lgkmcnt(0)" ::: "memory"); __builtin_amdgcn_s_barrier(); asm volatile("" ::: "memory"); } while (0)
#define SCAN_CSTEP(n_, BUFC, UC) do { const int n = (n_); \
        const LAS unsigned char* buf = F.lds + (BUFC) * SCAN_BUF; \
        f32x4 vn[4]; \
        _Pragma("unroll") for (int tm = 0; tm < 4; ++tm) vn[tm] = UC[tm]; \
        if (n + 2 < 64) { const char* u2 = pg8::rfl_ptr(ubase + (size_t)(n + 2) * 8192 * 4); _Pragma("unroll") for (int tm = 0; tm < 4; ++tm) UC[tm] = *(const f32x4*)(u2 + lane16 + tm * 1024); } \
        if (n > 0) { char* op = (char*)pg8::rfl_ptr(obase + (size_t)(64 * (n - 1)) * D_ * 2); \
            _Pragma("unroll") for (int tm = 0; tm < 4; ++tm) _Pragma("unroll") for (int reg = 0; reg < 4; ++reg) *(bf16*)(op + olane + (16 * tm + reg) * D_ * 2) = (bf16)cvtpk(o[tm][reg], 0.f); } \
        const float glast = rdlane(gl_all, n); \
        bf16x8 sb[4]; \
        _Pragma("unroll") for (int ks = 0; ks < 4; ++ks) sb[ks] = pack8(S[2 * ks], S[2 * ks + 1]); \
          \
        bf16x8 fw[16], fq[16], fk[8], fd[16]; bf16x8 vb[2]; \
        _Pragma("unroll") for (int i = 0; i < 16; ++i) fw[i] = *(const LAS bf16x8*)(buf + BLOB_W * 2 + (i * 64 + lane) * 16); \
        __builtin_amdgcn_sched_barrier(0); \
        _Pragma("unroll") for (int i = 0; i < 16; ++i) fq[i] = *(const LAS bf16x8*)(buf + BLOB_QG * 2 + (i * 64 + lane) * 16); \
        __builtin_amdgcn_sched_barrier(0); \
        _Pragma("unroll") for (int tm = 0; tm < 4; ++tm) _Pragma("unroll") for (int ks = 0; ks < 4; ++ks) vn[tm] = MFMA16(fw[tm * 4 + ks], sb[ks], vn[tm]); \
        __builtin_amdgcn_sched_barrier(0); \
        _Pragma("unroll") for (int i = 0; i < 8; ++i) fk[i] = *(const LAS bf16x8*)(buf + BLOB_QK * 2 + (i * 64 + lane) * 16); \
        __builtin_amdgcn_sched_barrier(0); \
        _Pragma("unroll") for (int tm = 0; tm < 4; ++tm) { o[tm] = (f32x4){0.f, 0.f, 0.f, 0.f}; \
            _Pragma("unroll") for (int ks = 0; ks < 4; ++ks) o[tm] = MFMA16(fq[tm * 4 + ks], sb[ks], o[tm]); } \
        _Pragma("unroll") for (int k2 = 0; k2 < 2; ++k2) vb[k2] = pack8(vn[2 * k2], vn[2 * k2 + 1]); \
        __builtin_amdgcn_sched_barrier(0); \
        _Pragma("unroll") for (int i = 0; i < 16; ++i) fd[i] = *(const LAS bf16x8*)(buf + BLOB_KDT * 2 + (i * 64 + lane) * 16); \
        __builtin_amdgcn_sched_barrier(0); \
        _Pragma("unroll") for (int tm = 0; tm < 4; ++tm) _Pragma("unroll") for (int k2 = 0; k2 < 2; ++k2) o[tm] = MFMA16(fk[tm * 2 + k2], vb[k2], o[tm]); \
        __builtin_amdgcn_sched_barrier(0); \
        _Pragma("unroll") for (int a = 0; a < 8; ++a) { S[a] = S[a] * glast; \
            _Pragma("unroll") for (int k2 = 0; k2 < 2; ++k2) S[a] = MFMA16(fd[a * 2 + k2], vb[k2], S[a]); } \
    asm volatile("s_waitcnt lgkmcnt(0)" ::: "memory"); __builtin_amdgcn_s_barrier(); asm volatile("" ::: "memory"); } while (0)

DI void gdn_scan2_phase(const Frame& F, const Args& A) {
    unsigned char* ws = opq(A.ws); unsigned char* big = ws + WS_BIG;
    const bf16* BLOB = (const bf16*)(big + GB_BLOB); const float* U = (const float*)(ws + WS_HID); bf16* Oraw = (bf16*)(ws + WS_Y);
    const float* GC = (const float*)(ws + WS_GALPHA);
    const int lane = F.lane, r = lane & 15, q = lane >> 4, w = F.wave;
    for (int it2 = F.bid; it2 < NB_ * 8 * 2; it2 += F.G) {
        const int item = it2 >> 1, half = it2 & 1, b = item >> 3, hh = item & 7, dvw = 4 * half + (w & 3);
        const char* src = pg8::rfl_ptr((const char*)(BLOB + (size_t)item * 64 * BLOB_ELEMS));
        __syncthreads();
        if (w >= 4) {
            const unsigned ltid16 = (unsigned)((w & 3) * 64 + lane) * 16u;
            u32x4 r0[14], r1[14], r2[14];
            SCAN_LOAD(r0, 0); SCAN_LOAD(r1, 1); SCAN_LOAD(r2, 2); asm volatile("s_waitcnt vmcnt(28)" ::: "memory"); __builtin_amdgcn_sched_barrier(0); SCAN_PUT(r0, 0);
            asm volatile("s_waitcnt lgkmcnt(0)" ::: "memory"); __builtin_amdgcn_s_barrier(); asm volatile("" ::: "memory");
#pragma unroll 1
            for (int n6 = 0; n6 < 60; n6 += 6) {
                SCAN_LSTEP(n6 + 0, 1, r0, r1); SCAN_LSTEP(n6 + 1, 0, r1, r2); SCAN_LSTEP(n6 + 2, 1, r2, r0);
                SCAN_LSTEP(n6 + 3, 0, r0, r1); SCAN_LSTEP(n6 + 4, 1, r1, r2); SCAN_LSTEP(n6 + 5, 0, r2, r0);
            }
            SCAN_LSTEP(60, 1, r0, r1); SCAN_LSTEP(61, 0, r1, r2); SCAN_LSTEP(62, 1, r2, r0); SCAN_LSTEP(63, 0, r0, r1);
        } else {
            f32x4 S[8];
#pragma unroll
            for (int a = 0; a < 8; ++a) S[a] = (f32x4){0.f, 0.f, 0.f, 0.f};
            const char* ubase = pg8::rfl_ptr((const char*)(U + (size_t)item * 64 * 8192 + (size_t)(dvw * 4) * 256));
            const char* obase = pg8::rfl_ptr((const char*)(Oraw + (size_t)b * S_ * D_ + hh * 128 + 16 * dvw));
            const unsigned lane16 = (unsigned)lane * 16u, olane = (unsigned)((4 * q) * D_ + r) * 2u;
            const float gl_all = __expf(GC[(size_t)item * S_ + 64 * lane + 63]);
            f32x4 ua[4], ub[4], o[4];
#pragma unroll
            for (int tm = 0; tm < 4; ++tm) { ua[tm] = *(const f32x4*)(ubase + lane16 + tm * 1024); ub[tm] = *(const f32x4*)(ubase + 8192 * 4 + lane16 + tm * 1024); o[tm] = (f32x4){0.f, 0.f, 0.f, 0.f}; }
            asm volatile("s_waitcnt lgkmcnt(0)" ::: "memory"); __builtin_amdgcn_s_barrier(); asm volatile("" ::: "memory");
#pragma unroll 1
            for (int n2 = 0; n2 < 64; n2 += 2) { SCAN_CSTEP(n2, 0, ua); SCAN_CSTEP(n2 + 1, 1, ub); }
            { char* op = (char*)obase + (size_t)(64 * 63) * D_ * 2;
#pragma unroll
              for (int tm = 0; tm < 4; ++tm)
#pragma unroll
                  for (int reg = 0; reg < 4; ++reg) *(bf16*)(op + olane + (16 * tm + reg) * D_ * 2) = (bf16)cvtpk(o[tm][reg], 0.f); }
        }
    }
}
#undef SCAN_LSTEP
#undef SCAN_CSTEP
#undef SCAN_LOAD
#undef SCAN_PUT
constexpr int N_PHASES = 42;
#ifndef MK_FUSED
#define MK_FUSED 1
#endif

#if MK_FUSED
typedef const __attribute__((address_space(4))) Args* CArgsP;
DI Args fresh_args() {
#if defined(__HIP_DEVICE_COMPILE__)
    CArgsP kp = (CArgsP)__builtin_amdgcn_kernarg_segment_ptr(); asm volatile("" : "+s"(kp)); Args a = *kp;
    a.x = asg(a.x); a.c = asg(a.c); a.pos = asg(a.pos); a.ada_w = asg(a.ada_w); a.ada_b = asg(a.ada_b); a.ln_g = asg(a.ln_g); a.ln_b = asg(a.ln_b);
    a.attn_w_in = asg(a.attn_w_in); a.attn_w_out = asg(a.attn_w_out); a.gdn_w_in = asg(a.gdn_w_in); a.gdn_conv_w = asg(a.gdn_conv_w); a.gdn_a_log = asg(a.gdn_a_log); a.gdn_dt_bias = asg(a.gdn_dt_bias);
    a.gdn_norm_w = asg(a.gdn_norm_w); a.gdn_w_out = asg(a.gdn_w_out); a.router_w = asg(a.router_w); a.router_bias = asg(a.router_bias); a.ew1 = asg(a.ew1); a.ew3 = asg(a.ew3); a.ew2 = asg(a.ew2);
    a.sw1 = asg(a.sw1); a.sw3 = asg(a.sw3); a.sw2 = asg(a.sw2); a.out = asg(a.out); a.ws = asg(a.ws);
    return a;
#else
    return Args{};
#endif
}
DI Frame fresh_frame(int wave_s) { Frame F; int g = gridDim.x; asm volatile("" : "+s"(g)); int b = blockIdx.x; asm volatile("" : "+s"(b)); unsigned l = 0u; asm volatile("" : "+s"(l));
    int w = wave_s; asm volatile("" : "+s"(w)); int ln; asm volatile("v_mbcnt_lo_u32_b32 %0, -1, 0\n\tv_mbcnt_hi_u32_b32 %0, -1, %0" : "=&v"(ln));
    F.lds = (LAS unsigned char*)(size_t)l; F.tid = w * 64 + ln; F.lane = ln; F.wave = w; F.G = g; F.bid = b; return F; }
#define PHF() const Args A = fresh_args(); const Frame F = fresh_frame(wave_s); \
    unsigned char* ws = opq(A.ws); LAS int* idxlds = (LAS int*)(F.lds + LDS_IDX); const LAS int* tileoff = (const LAS int*)(F.lds + LDS_TILEOFF); (void)ws; (void)idxlds; (void)tileoff;
DI void ph_pro(const int wave_s) { PHF(); prologue_phase(F, A); convert_experts(F, A, 0, 0, 0, F.G); }
DI void ph_modx(const int wave_s) { PHF(); modx_phase(F, A); }
DI void ph_attn(const int wave_s) { PHF(); attn_phase(F, A); }
DI void ph_lnr(const int wave_s, int L) { PHF(); if (L == 0) ln_router_phase<true>(F, A, L); else ln_router_phase<false>(F, A, L); }
DI void ph_lnr_dry(const int wave_s, int L) { PHF(); if (L == 0) ln_router_phase<true>(F, A, L, true); else ln_router_phase<false>(F, A, L, true); }
DI void ph_scat(const int wave_s, int L) { PHF(); moe_scatter_phase(F, A, L); }
DI void ph_lnm(const int wave_s, int L) { PHF(); ln_moe_phase(F, A, L, nullptr); }
DI void ph_lnm_dry(const int wave_s, int L) { PHF(); ln_moe_phase(F, A, L, (float*)(ws + WS_Y)); }
DI void ph_gprep(const int wave_s, int lp) { PHF(); gdn_prep2_phase(F, A, lp); }
DI void ph_gwy(const int wave_s) { PHF(); gdn_wy_phase(F, A); }
DI void ph_gscan(const int wave_s, int L) { PHF(); gdn_scan2_phase(F, A); if (F.G > 128) { convert_experts(F, A, L, 0, 64, F.G - 64); if (L == 1) convert_experts(F, A, 2, 1, 64, F.G - 64); } else { convert_experts(F, A, L, 0, 0, F.G); if (L == 1) convert_experts(F, A, 2, 1, 0, F.G); } }
DI void ph_gpost(const int wave_s, int lp) { PHF(); gdn_post_phase(F, A, lp); }
DI void ph_gemm_qkv(const int wave_s, int lp) { PHF();
    pg8::DenseOrder S; S.init(WS_H, WS_WA_IN + (size_t)lp * 9216 * D_ * 2, T_, 9216, D_, F.G, F.bid);
    pg8::EpiQKV E{(bf16*)(ws + WS_BIG), (const float*)(ws + WS_COS), (const float*)(ws + WS_SIN)};
    pg8::gemm_phase<pg8::EpiQKV, pg8::DenseOrder, true, true>(F.tid, ws, F.lds, idxlds, D_, S, E); }
DI void ph_gemm_out(const int wave_s, int lp, int isg) { PHF();
    pg8::DenseOrder S; S.init(WS_O, (isg ? WS_WG_OUT : WS_WA_OUT) + (size_t)lp * D_ * D_ * 2, T_, D_, D_, F.G, F.bid);
    pg8::EpiBf16 E{(bf16*)(ws + WS_Y), D_};
    pg8::gemm_phase<pg8::EpiBf16, pg8::DenseOrder, true, true>(F.tid, ws, F.lds, idxlds, D_, S, E); }
DI void ph_gemm_gin(const int wave_s, int lp) { PHF();
    pg8::DenseOrder S; S.init(WS_H, WS_WG_IN + (size_t)lp * 4096 * D_ * 2, T_, 4096, D_, F.G, F.bid);
    pg8::EpiBf16 E{(bf16*)(ws + WS_BIG + BIG_PROJ), 4096};
    pg8::gemm_phase<pg8::EpiBf16, pg8::DenseOrder, true, true>(F.tid, ws, F.lds, idxlds, D_, S, E); }
DI void ph_moe1(const int wave_s, int L) { PHF();
    const unsigned* gcount = (const unsigned*)(ws + WS_CTL) + CW_CNT + L * 64;
    build_tileoff(F, gcount);
    pg8::MoeOrder<true> S; S.A = (unsigned)WS_H; S.Bt = (unsigned)(L == 2 ? WS_WEB : WS_WE1); S.K = D_; S.nct_log = 1; S.nunits = __builtin_amdgcn_readfirstlane(tileoff[65]) * 2; S.G = F.G; S.c = F.bid;
    S.idxoff = (unsigned)WS_ETOK; S.tileoff = tileoff; S.ecnt = (const LAS int*)(F.lds + LDS_ECNT); S.bstride = (unsigned)(512 * D_ * 2);
    pg8::EpiSwiGLU E{(bf16*)(ws + WS_HID)};
    pg8::gemm_phase<pg8::EpiSwiGLU, pg8::MoeOrder<true>, true, true>(F.tid, ws, F.lds, idxlds, D_, S, E); }
DI void ph_moe2(const int wave_s, int L) { PHF();
    const unsigned* gcount = (const unsigned*)(ws + WS_CTL) + CW_CNT + L * 64;
    build_tileoff(F, gcount);
    pg8::MoeOrder<false> S; S.A = (unsigned)WS_HID; S.Bt = (unsigned)(L == 2 ? WS_WEB + 65 * MiB : WS_WE2); S.K = 256; S.nct_log = 2; S.nunits = __builtin_amdgcn_readfirstlane(tileoff[(YS_BF16 && !YS_MERGED) ? 64 : 65]) * 4; S.G = F.G; S.c = F.bid;
    S.idxoff = (unsigned)WS_EW; S.tileoff = tileoff; S.ecnt = (const LAS int*)(F.lds + LDS_ECNT); S.bstride = (unsigned)(D_ * 256 * 2);
    pg8::EpiScale E{ws + WS_BIG, 256 * __builtin_amdgcn_readfirstlane(tileoff[64])};
    pg8::gemm_phase<pg8::EpiScale, pg8::MoeOrder<false>, false, false>(F.tid, ws, F.lds, idxlds, 256, S, E); }
DI void ph_moe2s(const int wave_s, int L) { PHF();
    __syncthreads();
    const size_t s0 = (size_t)(256 * __builtin_amdgcn_readfirstlane(((const LAS int*)(F.lds + LDS_TILEOFF))[64]));
    pg8::DenseOrder S; S.init(WS_HID + s0 * 256 * 2, (L == 2 ? WS_WEB + 65 * MiB : WS_WE2) + (size_t)NEXP * D_ * 256 * 2, T_, D_, 256, F.G, F.bid);
    pg8::EpiBf16 E{(bf16*)(ws + WS_BIG + WS_YS_OFF), D_};
    pg8::gemm_phase<pg8::EpiBf16, pg8::DenseOrder, false, false>(F.tid, ws, F.lds, idxlds, 256, S, E); }

DI void grid_bar(const int wave_s) { PHF(); XcdBarrier b; b.bar = (unsigned*)(ws + WS_CTL) + CW_BAR; volatile LAS unsigned* misc = (volatile LAS unsigned*)(F.lds + LDS_MISC); b.st = misc + 8;
    b.x = (unsigned)__builtin_amdgcn_readfirstlane((int)misc[10]); xcd_barrier(b, F.tid); }
__global__ void __launch_bounds__(NTHR, 2) mk_fwd(Args Ain) {
    extern __shared__ __attribute__((aligned(16))) unsigned char lds_raw[];
    LAS unsigned char* lds = (LAS unsigned char*)lds_raw;
    for (int u = threadIdx.x; u < (LDS_BYTES - RING_BYTES) / 4; u += NTHR) ((LAS unsigned*)(lds + RING_BYTES))[u] = 0u;
    __syncthreads();
    const int wave_s = __builtin_amdgcn_readfirstlane((int)threadIdx.x >> 6);
    { XcdBarrier bar = xcd_barrier_post((unsigned*)(Ain.ws + WS_CTL) + CW_BAR, (volatile LAS unsigned*)(lds + LDS_MISC) + 8);
      if (threadIdx.x == 0) ((volatile LAS unsigned*)(lds + LDS_MISC))[10] = bar.x; }
    __syncthreads();
#ifndef REP_BAR
#define REP_BAR 1
#define REP_PRO 1
#define REP_POST 1
#define REP_QKV 1
#define REP_OUT 1
#define REP_GIN 1
#define REP_M1 1
#define REP_M2 1
#define REP_LNM 1
#define REP_LNR 1
#endif
#define GBAR() do { for (int _b = 0; _b < REP_BAR; ++_b) grid_bar(wave_s); } while (0)
#ifndef REP_ATTN
#define REP_ATTN 1
#define REP_SCAN 1
#define REP_GEMM 1
#define REP_PREP 1
#define REP_CONV 1
#define REP_WY 1
#endif
    for (int r = 0; r < REP_PRO; ++r) { ph_pro(wave_s); GBAR(); }
    ph_modx(wave_s); GBAR();
#pragma unroll 1
    for (int L = 0; L < 4; ++L) {
        const int lp = L >> 1;
        if ((L & 1) == 0) { for (int r = 0; r < REP_QKV; ++r) { ph_gemm_qkv(wave_s, lp); GBAR(); } for (int r = 0; r < REP_ATTN; ++r) { ph_attn(wave_s); GBAR(); } for (int r = 0; r < REP_OUT; ++r) { ph_gemm_out(wave_s, lp, 0); GBAR(); } }
        else { for (int r = 0; r < REP_GIN; ++r) { ph_gemm_gin(wave_s, lp); GBAR(); } for (int r = 0; r < REP_PREP; ++r) { ph_gprep(wave_s, lp); GBAR(); } for (int r = 0; r < REP_WY; ++r) { ph_gwy(wave_s); GBAR(); } for (int r = 0; r < REP_SCAN; ++r) { ph_gscan(wave_s, L); GBAR(); } for (int r = 0; r < REP_POST; ++r) { ph_gpost(wave_s, lp); GBAR(); } for (int r = 0; r < REP_OUT; ++r) { ph_gemm_out(wave_s, lp, 1); GBAR(); } }
        for (int r = 1; r < REP_LNR; ++r) { ph_lnr_dry(wave_s, L); GBAR(); }
        ph_lnr(wave_s, L); GBAR();
        for (int r = 0; r < REP_M1; ++r) { ph_moe1(wave_s, L); GBAR(); }
        for (int r = 0; r < REP_M2; ++r) { ph_moe2(wave_s, L); if (YS_BF16 && !YS_MERGED) ph_moe2s(wave_s, L); GBAR(); }
        for (int r = 1; r < REP_LNM; ++r) { ph_lnm_dry(wave_s, L); GBAR(); }
        ph_lnm(wave_s, L); if (L < 3) GBAR();
    }
#undef GBAR
}
#else

#define MKF() extern __shared__ __attribute__((aligned(16))) unsigned char lds_raw[]; Frame F; F.lds = (LAS unsigned char*)lds_raw; F.tid = threadIdx.x; F.lane = F.tid & 63; \
    F.wave = __builtin_amdgcn_readfirstlane(F.tid >> 6); F.G = gridDim.x; F.bid = blockIdx.x; unsigned char* ws = opq(A.ws); LAS int* idxlds = (LAS int*)(F.lds + LDS_IDX); \
    const LAS int* tileoff = (const LAS int*)(F.lds + LDS_TILEOFF); (void)ws; (void)idxlds; (void)tileoff; \
    for (int u = F.tid; u < (LDS_BYTES - RING_BYTES) / 4; u += NTHR) ((LAS unsigned*)(F.lds + RING_BYTES))[u] = 0u; __syncthreads();
__global__ void __launch_bounds__(NTHR, 2) k_pro(Args A) { MKF(); prologue_phase(F, A); }
__global__ void __launch_bounds__(NTHR, 2) k_modx(Args A) { MKF(); modx_phase(F, A); }
__global__ void __launch_bounds__(NTHR, 2) k_attn(Args A) { MKF(); attn_phase(F, A); }
__global__ void __launch_bounds__(NTHR, 2) k_lnr(Args A) { MKF(); const int L = A.ph_lo; ln_router_phase<false>(F, A, L); }
__global__ void __launch_bounds__(NTHR, 2) k_scat(Args A) { MKF(); moe_scatter_phase(F, A, A.ph_lo); convert_experts(F, A, A.ph_lo); }
__global__ void __launch_bounds__(NTHR, 2) k_lnm(Args A) { MKF(); const int L = A.ph_lo; ln_moe_phase(F, A, L, nullptr); }
__global__ void __launch_bounds__(NTHR, 2) k_gprep(Args A) { MKF(); gdn_prep_phase(F, A, A.ph_lo); }
__global__ void __launch_bounds__(NTHR, 2) k_gscan(Args A) { MKF(); gdn_scan_phase(F, A); }
__global__ void __launch_bounds__(NTHR, 2) k_gpost(Args A) { MKF(); gdn_post_phase(F, A, A.ph_lo); }
__global__ void __launch_bounds__(NTHR, 2) k_gemm_qkv(Args A) { MKF(); const int lp = A.ph_lo;
    pg8::DenseOrder S; S.init(WS_H, WS_WA_IN + (size_t)lp * 9216 * D_ * 2, T_, 9216, D_, F.G, F.bid);
    pg8::EpiQKV E{(bf16*)(ws + WS_BIG), (const float*)(ws + WS_COS), (const float*)(ws + WS_SIN)};
    pg8::gemm_phase<pg8::EpiQKV, pg8::DenseOrder, true, true>(F.tid, ws, F.lds, idxlds, D_, S, E); }
__global__ void __launch_bounds__(NTHR, 2) k_gemm_out(Args A) { MKF(); const int lp = A.ph_lo >> 1, isg = A.ph_lo & 1;
    pg8::DenseOrder S; S.init(WS_O, (isg ? WS_WG_OUT : WS_WA_OUT) + (size_t)lp * D_ * D_ * 2, T_, D_, D_, F.G, F.bid);
    pg8::EpiF32 E{(float*)(ws + WS_Y), D_};
    pg8::gemm_phase<pg8::EpiF32, pg8::DenseOrder, true, true>(F.tid, ws, F.lds, idxlds, D_, S, E); }
__global__ void __launch_bounds__(NTHR, 2) k_gemm_gin(Args A) { MKF(); const int lp = A.ph_lo;
    pg8::DenseOrder S; S.init(WS_H, WS_WG_IN + (size_t)lp * 4096 * D_ * 2, T_, 4096, D_, F.G, F.bid);
    pg8::EpiBf16 E{(bf16*)(ws + WS_BIG + BIG_PROJ), 4096};
    pg8::gemm_phase<pg8::EpiBf16, pg8::DenseOrder, true, true>(F.tid, ws, F.lds, idxlds, D_, S, E); }
__global__ void __launch_bounds__(NTHR, 2) k_moe1(Args A) { MKF();
    const unsigned* gcount = (const unsigned*)(ws + WS_CTL) + CW_CNT + A.ph_lo * 64;
    build_tileoff(F, gcount);
    pg8::MoeOrder<true> S; S.A = (unsigned)WS_H; S.Bt = (unsigned)(L == 2 ? WS_WEB : WS_WE1); S.K = D_; S.nct_log = 1; S.nunits = __builtin_amdgcn_readfirstlane(tileoff[65]) * 2; S.G = F.G; S.c = F.bid;
    S.idxoff = (unsigned)WS_ETOK; S.tileoff = tileoff; S.ecnt = (const LAS int*)(F.lds + LDS_ECNT); S.bstride = (unsigned)(512 * D_ * 2);
    pg8::EpiSwiGLU E{(bf16*)(ws + WS_HID)};
    pg8::gemm_phase<pg8::EpiSwiGLU, pg8::MoeOrder<true>, true, true>(F.tid, ws, F.lds, idxlds, D_, S, E); }
__global__ void __launch_bounds__(NTHR, 2) k_moe2(Args A) { MKF();
    const unsigned* gcount = (const unsigned*)(ws + WS_CTL) + CW_CNT + A.ph_lo * 64;
    build_tileoff(F, gcount);
    pg8::MoeOrder<false> S; S.A = (unsigned)WS_HID; S.Bt = (unsigned)(L == 2 ? WS_WEB + 65 * MiB : WS_WE2); S.K = 256; S.nct_log = 2; S.nunits = __builtin_amdgcn_readfirstlane(tileoff[65]) * 4; S.G = F.G; S.c = F.bid;
    S.idxoff = (unsigned)WS_EW; S.tileoff = tileoff; S.ecnt = (const LAS int*)(F.lds + LDS_ECNT); S.bstride = (unsigned)(D_ * 256 * 2);
    pg8::EpiScale E{ws + WS_BIG, 256 * __builtin_amdgcn_readfirstlane(tileoff[64])};
    pg8::gemm_phase<pg8::EpiScale, pg8::MoeOrder<false>, false, false>(F.tid, ws, F.lds, idxlds, 256, S, E); }
#endif
extern "C" void kernel_launch(void* const* d_in, const int* in_sizes, int n_in, void* d_out, int out_size, void* d_ws, size_t ws_size, hipStream_t stream) {
    static int grid = 0;
    if (grid == 0) {
        if (n_in != 23 || in_sizes[0] != T_ * D_ || out_size != T_ * D_ || ws_size < WS_END) {
            fprintf(stderr, "kernel_launch: unexpected shapes (n_in %d, in0 %d, out %d, ws %zu < %zu); nothing launched\n", n_in, n_in > 0 ? in_sizes[0] : -1, out_size, ws_size, (size_t)WS_END); grid = -1; return; }
        int dev = 0, cus = 0, per_cu = 0;
        if (hipGetDevice(&dev) != hipSuccess || hipDeviceGetAttribute(&cus, hipDeviceAttributeMultiprocessorCount, dev) != hipSuccess) { grid = -1; return; }
#if MK_FUSED
        if (hipFuncSetAttribute((const void*)mk_fwd, hipFuncAttributeMaxDynamicSharedMemorySize, LDS_BYTES) != hipSuccess) { fprintf(stderr, "kernel_launch: hipFuncSetAttribute failed\n"); grid = -1; return; }
        if (hipOccupancyMaxActiveBlocksPerMultiprocessor(&per_cu, (const void*)mk_fwd, NTHR, LDS_BYTES) != hipSuccess || per_cu < 1)
            fprintf(stderr, "kernel_launch: note: occupancy query reports %d workgroups per CU\n", per_cu);
#else
        { const void* ks[] = {(const void*)k_pro, (const void*)k_modx, (const void*)k_attn, (const void*)k_lnr, (const void*)k_scat, (const void*)k_lnm, (const void*)k_gprep, (const void*)k_gscan, (const void*)k_gpost,
                              (const void*)k_gemm_qkv, (const void*)k_gemm_out, (const void*)k_gemm_gin, (const void*)k_moe1, (const void*)k_moe2};
          for (const void* k : ks) if (hipFuncSetAttribute(k, hipFuncAttributeMaxDynamicSharedMemorySize, LDS_BYTES) != hipSuccess) { fprintf(stderr, "kernel_launch: hipFuncSetAttribute failed\n"); grid = -1; return; } }
        (void)per_cu;
#endif
        (void)hipGetLastError();
        grid = cus;
    }
    if (grid < 0) return;
    (void)hipMemsetAsync((char*)d_ws + WS_CTL, 0, CTL_ZERO_BYTES, stream);
    Args a{};
    a.x = (const float*)d_in[0]; a.c = (const float*)d_in[1]; a.pos = (const int*)d_in[2]; a.ada_w = (const float*)d_in[3]; a.ada_b = (const float*)d_in[4];
    a.ln_g = (const float*)d_in[5]; a.ln_b = (const float*)d_in[6]; a.attn_w_in = (const float*)d_in[7]; a.attn_w_out = (const float*)d_in[8];
    a.gdn_w_in = (const float*)d_in[9]; a.gdn_conv_w = (const float*)d_in[10]; a.gdn_a_log = (const float*)d_in[11]; a.gdn_dt_bias = (const float*)d_in[12];
    a.gdn_norm_w = (const float*)d_in[13]; a.gdn_w_out = (const float*)d_in[14]; a.router_w = (const float*)d_in[15]; a.router_bias = (const float*)d_in[16];
    a.ew1 = (const float*)d_in[17]; a.ew3 = (const float*)d_in[18]; a.ew2 = (const float*)d_in[19]; a.sw1 = (const float*)d_in[20]; a.sw3 = (const float*)d_in[21]; a.sw2 = (const float*)d_in[22];
    a.out = (float*)d_out; a.ws = (unsigned char*)d_ws;
#if MK_FUSED
    a.ph_lo = 0; a.ph_hi = N_PHASES;
    hipLaunchKernelGGL(mk_fwd, dim3(grid), dim3(NTHR), LDS_BYTES, stream, a);
#else
#define LAUNCH(k, arg) do { a.ph_lo = (arg); a.ph_hi = (arg) + 1; hipLaunchKernelGGL(k, dim3(grid), dim3(NTHR), LDS_BYTES, stream, a); } while (0)
    LAUNCH(k_pro, 0); LAUNCH(k_modx, 0);
    for (int L = 0; L < 4; ++L) {
        const int lp = L >> 1;
        if ((L & 1) == 0) { LAUNCH(k_gemm_qkv, lp); LAUNCH(k_attn, 0); LAUNCH(k_gemm_out, 2 * lp); }
        else { LAUNCH(k_gemm_gin, lp); LAUNCH(k_gprep, lp); LAUNCH(k_gscan, 0); LAUNCH(k_gpost, lp); LAUNCH(k_gemm_out, 2 * lp + 1); }
        LAUNCH(k_lnr, L); LAUNCH(k_scat, L); LAUNCH(k_moe1, L); LAUNCH(k_moe2, L); LAUNCH(k_lnm, L);
    }
#undef LAUNCH
#endif
    const hipError_t le = hipPeekAtLastError();
    if (le != hipSuccess) fprintf(stderr, "kernel_launch: launch failed: %s\n", hipGetErrorName(le));
}
```

```cpp
#include <hip/hip_runtime.h>
#include <cstdio>
#include <cstdint>

#define GAS __attribute__((address_space(1)))
#define LAS __attribute__((address_space(3)))
typedef unsigned short bf16;
typedef unsigned u32x4 __attribute__((ext_vector_type(4)));
typedef unsigned u32x2 __attribute__((ext_vector_type(2)));
typedef float f32x2 __attribute__((ext_vector_type(2)));
typedef float f32x4 __attribute__((ext_vector_type(4)));
typedef float f32x16 __attribute__((ext_vector_type(16)));
typedef short bf16x8 __attribute__((ext_vector_type(8)));
typedef short s16x4 __attribute__((ext_vector_type(4)));
typedef __bf16 bf16x2_t __attribute__((ext_vector_type(2)));
#define DI __device__ __forceinline__

DI unsigned cvtpk(float lo, float hi) { f32x2 v = {lo, hi}; bf16x2_t b = __builtin_convertvector(v, bf16x2_t); return __builtin_bit_cast(unsigned, b); }
DI unsigned cvtpk_fp8(float a, float b, float c, float d) { int w = __builtin_amdgcn_cvt_pk_fp8_f32(a, b, 0, false); w = __builtin_amdgcn_cvt_pk_fp8_f32(c, d, w, true); return (unsigned)w; }
constexpr bool YS_BF16 = true;
constexpr bool YS_MERGED = true;
constexpr float YE_SCALE = 16.0f;
DI float silu_f(float a) { return a * __builtin_amdgcn_rcpf(1.0f + __expf(-a)); }
DI float bf_lo(unsigned u) { return __builtin_bit_cast(float, u << 16); }
DI float bf_hi(unsigned u) { return __builtin_bit_cast(float, u & 0xffff0000u); }
template <int M> DI float shx(float v) { return __builtin_bit_cast(float, __builtin_amdgcn_ds_swizzle(__builtin_bit_cast(int, v), (M << 10) | 0x1f)); }
DI float bperm(float v, int srclane) { return __builtin_bit_cast(float, __builtin_amdgcn_ds_bpermute(srclane << 2, __builtin_bit_cast(int, v))); }
DI float rdlane(float v, int l) { return __builtin_bit_cast(float, __builtin_amdgcn_readlane(__builtin_bit_cast(int, v), l)); }
template <int CTRL> DI float dppmov(float v) { return __builtin_bit_cast(float, __builtin_amdgcn_update_dpp(0, __builtin_bit_cast(int, v), CTRL, 0xf, 0xf, true)); }
DI float wave_sum(float v) { v += dppmov<0xB1>(v); v += dppmov<0x4E>(v); v += dppmov<0x141>(v); v += dppmov<0x140>(v); return (rdlane(v, 0) + rdlane(v, 16)) + (rdlane(v, 32) + rdlane(v, 48)); }
DI float wave_max(float v) { v = fmaxf(v, dppmov<0xB1>(v)); v = fmaxf(v, dppmov<0x4E>(v)); v = fmaxf(v, dppmov<0x141>(v)); v = fmaxf(v, dppmov<0x140>(v)); return fmaxf(fmaxf(rdlane(v, 0), rdlane(v, 16)), fmaxf(rdlane(v, 32), rdlane(v, 48))); }
#define LDS_WAIT() asm volatile("s_waitcnt lgkmcnt(0)" ::: "memory")
#define VM_WAIT() asm volatile("s_waitcnt vmcnt(0)" ::: "memory")

namespace pg8 {
constexpr int BM = 256, BK = 64, HALF = 128, HTB = HALF * BK * 2, STAGE_BYTES = 8 * HTB;
DI int lds_byte(int r, int c) { const int st = (r >> 4) * 2 + (c >> 5), rr = r & 15, cc = c & 31, ob = rr * 64 + cc * 2; return st * 1024 + (ob ^ (((ob >> 9) & 1) << 5)); }
DI void stage_rc(int b, int& R, int& C) { const int st = b / 1024, sb = b % 1024, swz = sb ^ (((sb >> 9) & 1) << 5); R = (st >> 1) * 16 + swz / 64; C = (st & 1) * 32 + (swz % 64) / 2; }
DI int perm32(int rho) { const int n = rho >> 4, i = rho & 15; return 8 * (i >> 2) + 4 * n + (i & 3); }

DI const char* rfl_ptr(const char* p) {
    const unsigned long long v = (unsigned long long)p; const unsigned lo = __builtin_amdgcn_readfirstlane((unsigned)v), hi = __builtin_amdgcn_readfirstlane((unsigned)(v >> 32));
    return (const char*)(const __attribute__((address_space(1))) char*)(((unsigned long long)hi << 32) | lo); }
struct Unit { unsigned a; unsigned b; int r0; int c0; int e; int rb; int nv; };

template <class Epi, class Sched, bool ALIGN_EPI, bool SP2>
DI void gemm_phase(const int tid, const void* wsbase, LAS unsigned char* lds, LAS int* idxlds, const int K, const Sched& S, const Epi& E) {
    const __amdgpu_buffer_rsrc_t rsrc = __builtin_amdgcn_make_buffer_rsrc((void*)wsbase, 0, 0xffffffff, 0x00020000);
    const int wid = __builtin_amdgcn_readfirstlane(tid >> 6), lane = tid & 63, wr = wid >> 2, wc = wid & 3, fr = lane & 15, fq = lane >> 4;
    const int nt = K / BK;
    unsigned voffB[2], voffA[2][2];
#pragma unroll
    for (int i = 0; i < 2; ++i) { int R, C; stage_rc(tid * 16 + i * 8192, R, C); const int Rb = Epi::PERM ? ((R & ~31) + perm32(R & 31)) : R;
        voffB[i] = (unsigned)(Rb * K + C) * 2u;
        voffA[0][i] = (unsigned)(R * K + C) * 2u; voffA[1][i] = (unsigned)((R + HALF) * K + C) * 2u; }
    const unsigned kstep = (unsigned)(BK * 2);
    const unsigned hstep = (unsigned)(HALF * K * 2);
    const unsigned ldsw = (unsigned)wid * 1024u;
    const int aoff = lds_byte(wr * 64 + fr, fq * 8), boff = lds_byte(wc * 32 + fr, fq * 8);
#define PG8_SA(b, h) (((b) * 2 + (h)) * HTB)
#define PG8_SB(b, h) ((4 + (b) * 2 + (h)) * HTB)
#define PG8_STAGE(bufoff, soff, voff) do { const int _so = __builtin_amdgcn_readfirstlane((int)(soff)); _Pragma("unroll") for (int _i = 0; _i < 2; ++_i) \
        __builtin_amdgcn_raw_ptr_buffer_load_lds(rsrc, (LAS void*)(lds + (bufoff) + ldsw + _i * 8192), 16, (int)(voff)[_i], _so, 0, 0); } while (0)
#define PG8_LDA(dst, b, h) do { _Pragma("unroll") for (int m = 0; m < 4; ++m) _Pragma("unroll") for (int k = 0; k < 2; ++k) dst[m][k] = *(const LAS bf16x8*)(lds + PG8_SA(b, h) + aoff + m * 2048 + k * 1024); } while (0)
#define PG8_LDB(dst, b, h) do { _Pragma("unroll") for (int n = 0; n < 2; ++n) _Pragma("unroll") for (int k = 0; k < 2; ++k) dst[n][k] = *(const LAS bf16x8*)(lds + PG8_SB(b, h) + boff + n * 2048 + k * 1024); } while (0)
#define PG8_MMA(ai, bj, At, Bt) do { __builtin_amdgcn_s_setprio(1); _Pragma("unroll") for (int m = 0; m < 4; ++m) _Pragma("unroll") for (int n = 0; n < 2; ++n) _Pragma("unroll") for (int k = 0; k < 2; ++k) \
        acc[ai][bj][m][n] = __builtin_amdgcn_mfma_f32_16x16x32_bf16(Bt[n][k], At[m][k], acc[ai][bj][m][n], 0, 0, 0); __builtin_amdgcn_s_setprio(0); } while (0)
#define PG8_WAIT_V(n) asm volatile("s_waitcnt vmcnt(" #n ")" ::: "memory")
#define PG8_WAIT_L(n) asm volatile("s_waitcnt lgkmcnt(" #n ")" ::: "memory")
#define PG8_BAR __builtin_amdgcn_s_barrier()
#define PG8_SCHED __builtin_amdgcn_sched_barrier(0)
#define PG8_IDX_ISSUE(u, slot) __builtin_amdgcn_raw_ptr_buffer_load_lds(rsrc, (LAS void*)(idxlds + (slot) * 256 + (wid & 3) * 64), 4, lane * 4, \
        __builtin_amdgcn_readfirstlane((int)(S.idxoff + (unsigned)((u).rb + (wid & 3) * 64) * 4u)), 0, 0)
#define PG8_IDX_READ(dst, h_, slot, nv_) do { int _t = tid; asm volatile("" : "+v"(_t));   \
        _Pragma("unroll") for (int _i = 0; _i < 2; ++_i) { int _R, _C; stage_rc(_t * 16 + _i * 8192, _R, _C); \
        const int _ix = ((h_) * HALF + _R) < (nv_) ? idxlds[(slot) * 256 + (h_) * HALF + _R] : S.padrow;        \
        dst[_i] = (unsigned)_ix * (unsigned)(K * 2) + (unsigned)(_C * 2); } } while (0)
    Unit cur, nxt; int ui = 0;
    if (!S.next(0, cur)) return;
    f32x4 acc[2][2][4][2];
#pragma unroll
    for (int a = 0; a < 2; ++a)
#pragma unroll
        for (int b = 0; b < 2; ++b)
#pragma unroll
            for (int m = 0; m < 4; ++m)
#pragma unroll
                for (int n = 0; n < 2; ++n) acc[a][b][m][n] = (f32x4){0.f, 0.f, 0.f, 0.f};
    bf16x8 At[4][2], B0[2][2], B1[2][2];
    unsigned cA = cur.a, cB = cur.b;
    if constexpr (Sched::GATHER || Epi::ROWAUX) {
        PG8_IDX_ISSUE(cur, 0); PG8_WAIT_V(0); PG8_BAR;     asm volatile("" ::: "memory");
        if constexpr (Sched::GATHER) { PG8_IDX_READ(voffA[0], 0, 0, cur.nv); PG8_IDX_READ(voffA[1], 1, 0, cur.nv); }
    }
    if constexpr (SP2) {
        PG8_STAGE(PG8_SB(0, 0), cB, voffB); PG8_STAGE(PG8_SB(0, 1), cB + hstep, voffB); PG8_STAGE(PG8_SA(0, 0), cA, voffA[0]); PG8_STAGE(PG8_SA(0, 1), cA, voffA[1]);
        if (wr == 1) PG8_BAR;
        PG8_WAIT_V(2); PG8_BAR;
        PG8_STAGE(PG8_SB(1, 0), cB + kstep, voffB); PG8_STAGE(PG8_SA(1, 0), cA + kstep, voffA[0]); PG8_STAGE(PG8_SB(1, 1), cB + hstep + kstep, voffB);
        PG8_WAIT_V(6); PG8_BAR;
    } else {
        PG8_STAGE(PG8_SB(0, 0), cB, voffB); PG8_STAGE(PG8_SA(0, 0), cA, voffA[0]); PG8_STAGE(PG8_SB(0, 1), cB + hstep, voffB); PG8_STAGE(PG8_SA(0, 1), cA, voffA[1]);
        if (wr == 1) PG8_BAR;
        PG8_WAIT_V(4); PG8_BAR;
        PG8_STAGE(PG8_SB(1, 0), cB + kstep, voffB); PG8_STAGE(PG8_SA(1, 0), cA + kstep, voffA[0]); PG8_STAGE(PG8_SB(1, 1), cB + hstep + kstep, voffB);
        PG8_WAIT_V(6); PG8_BAR;
    }
    for (;;) {
        const bool has_next = S.next(ui + 1, nxt);
        const unsigned nA = has_next ? nxt.a : cA, nB = has_next ? nxt.b : cB;
        for (int t = 0; t < nt; t += 2) {
            const bool last = (t == nt - 2);
            const unsigned a1 = cA + (unsigned)(t + 1) * kstep;
            const unsigned a2 = last ? nA : cA + (unsigned)(t + 2) * kstep, b2 = last ? nB : cB + (unsigned)(t + 2) * kstep;
            const unsigned a3 = a2 + kstep, b3 = b2 + kstep;
            if constexpr (Sched::GATHER || Epi::ROWAUX) { if (t == 0 && has_next) PG8_IDX_ISSUE(nxt, (ui + 1) % 3); }
            if constexpr (Sched::GATHER) { if (last && has_next) PG8_IDX_READ(voffA[0], 0, (ui + 1) % 3, nxt.nv); }
#define PG8_NEXT_H1() do { if constexpr (Sched::GATHER) { if (last && has_next) PG8_IDX_READ(voffA[1], 1, (ui + 1) % 3, nxt.nv); } } while (0)
            if constexpr (SP2) {
            PG8_LDB(B0, 0, 0); PG8_LDB(B1, 0, 1); PG8_SCHED; PG8_LDA(At, 0, 0); PG8_STAGE(PG8_SA(1, 1), a1, voffA[1]); PG8_NEXT_H1();
            PG8_WAIT_V(8); PG8_WAIT_L(0); PG8_BAR; PG8_MMA(0, 0, At, B0); PG8_MMA(0, 1, At, B1); PG8_BAR; PG8_SCHED;
            PG8_LDA(At, 0, 1); PG8_STAGE(PG8_SB(0, 0), b2, voffB); PG8_STAGE(PG8_SB(0, 1), b2 + hstep, voffB); PG8_STAGE(PG8_SA(0, 0), a2, voffA[0]);
            PG8_WAIT_V(8); PG8_WAIT_L(0); PG8_BAR; PG8_MMA(1, 0, At, B0); PG8_MMA(1, 1, At, B1); PG8_BAR; PG8_SCHED;
            PG8_LDB(B0, 1, 0); PG8_LDB(B1, 1, 1); PG8_SCHED; PG8_LDA(At, 1, 0); PG8_STAGE(PG8_SA(0, 1), a2, voffA[1]);
            PG8_WAIT_V(8); PG8_WAIT_L(0); PG8_BAR; PG8_MMA(0, 0, At, B0); PG8_MMA(0, 1, At, B1); PG8_BAR; PG8_SCHED;
            PG8_LDA(At, 1, 1); PG8_STAGE(PG8_SB(1, 0), b3, voffB); PG8_STAGE(PG8_SB(1, 1), b3 + hstep, voffB); PG8_STAGE(PG8_SA(1, 0), a3, voffA[0]);
            PG8_WAIT_V(8); PG8_WAIT_L(0); PG8_BAR; PG8_MMA(1, 0, At, B0); PG8_MMA(1, 1, At, B1); PG8_BAR; PG8_SCHED;
            } else {
            PG8_LDB(B0, 0, 0); PG8_SCHED; PG8_LDA(At, 0, 0); PG8_STAGE(PG8_SA(1, 1), a1, voffA[1]); PG8_NEXT_H1();
            PG8_WAIT_L(8); PG8_BAR; PG8_WAIT_L(0); PG8_MMA(0, 0, At, B0); PG8_BAR; PG8_SCHED;
            PG8_LDB(B1, 0, 1); PG8_STAGE(PG8_SB(0, 0), b2, voffB);
            PG8_BAR; PG8_WAIT_L(0); PG8_MMA(0, 1, At, B1); PG8_BAR;
            PG8_LDA(At, 0, 1); PG8_STAGE(PG8_SA(0, 0), a2, voffA[0]);
            PG8_BAR; PG8_WAIT_L(0); PG8_MMA(1, 0, At, B0); PG8_BAR; PG8_SCHED;
            PG8_STAGE(PG8_SB(0, 1), b2 + hstep, voffB);
            PG8_WAIT_V(6); PG8_BAR; PG8_MMA(1, 1, At, B1); PG8_BAR;
            PG8_LDB(B0, 1, 0); PG8_SCHED; PG8_LDA(At, 1, 0); PG8_STAGE(PG8_SA(0, 1), a2, voffA[1]);
            PG8_WAIT_L(8); PG8_BAR; PG8_WAIT_L(0); PG8_MMA(0, 0, At, B0); PG8_BAR; PG8_SCHED;
            PG8_LDB(B1, 1, 1); PG8_STAGE(PG8_SB(1, 0), b3, voffB);
            PG8_BAR; PG8_WAIT_L(0); PG8_MMA(0, 1, At, B1); PG8_BAR;
            PG8_LDA(At, 1, 1); PG8_STAGE(PG8_SA(1, 0), a3, voffA[0]);
            PG8_BAR; PG8_WAIT_L(0); PG8_MMA(1, 0, At, B0); PG8_BAR; PG8_SCHED;
            PG8_STAGE(PG8_SB(1, 1), b3 + hstep, voffB);
            PG8_WAIT_V(6); PG8_BAR; PG8_MMA(1, 1, At, B1); PG8_BAR;
            }
        }
        if constexpr (ALIGN_EPI) { if (wr == 0) PG8_BAR; }
        if constexpr (Epi::ROWAUX) E(acc, cur, wr, wc, fr, fq, idxlds + (ui % 3) * 256); else E(acc, cur, wr, wc, fr, fq);
        if (!has_next) break;
#pragma unroll
        for (int a = 0; a < 2; ++a)
#pragma unroll
            for (int b = 0; b < 2; ++b)
#pragma unroll
                for (int m = 0; m < 4; ++m)
#pragma unroll
                    for (int n = 0; n < 2; ++n) acc[a][b][m][n] = (f32x4){0.f, 0.f, 0.f, 0.f};
        cur = nxt; cA = nA; cB = nB; ++ui;
        if constexpr (ALIGN_EPI) { if (wr == 1) PG8_BAR; }
    }
    PG8_WAIT_V(0);
    if constexpr (!ALIGN_EPI) { if (wr == 0) PG8_BAR; }
    PG8_BAR;
#undef PG8_SA
#undef PG8_SB
#undef PG8_STAGE
#undef PG8_LDA
#undef PG8_LDB
#undef PG8_MMA
#undef PG8_WAIT_V
#undef PG8_WAIT_L
#undef PG8_BAR
#undef PG8_SCHED
#undef PG8_IDX_ISSUE
#undef PG8_IDX_READ
#undef PG8_NEXT_H1
}
}
constexpr int T_ = 16384, D_ = 1024, NB_ = 4, S_ = 4096, NEXP = 64, TOPK = 8;
constexpr int ECAP = 16384;
constexpr int PMAX = 163840;
constexpr float LN_EPS = 1e-5f, RMS_EPS = 1e-6f;
constexpr float ALPHA_DN = 1.6817928305074290f;
constexpr float QSCALE = 0.125f * 1.4426950408889634f;

namespace pg8 {
constexpr int NXCD = 8, WGM = 8;
struct DenseOrder {
    static constexpr bool GATHER = false;
    unsigned A, Bt; int K; int nM, nN, nwg, G, c; unsigned idxoff; static constexpr int padrow = 0;
    DI void init(size_t A_, size_t Bt_, int M, int N, int K_, int G_, int c_) { A = (unsigned)A_; Bt = (unsigned)Bt_; K = K_; nM = M / BM; nN = N / BM; nwg = nM * nN; G = G_; c = c_; idxoff = 0u; }
    DI bool next(int i, Unit& u) const {
        const long L = (long)i * G + c; if (L >= nwg) return false;
        int wgid = (int)L; { const int q = nwg / NXCD, r = nwg % NXCD, xcd = wgid % NXCD, off = wgid / NXCD; wgid = (xcd < r ? xcd * (q + 1) : r * (q + 1) + (xcd - r) * q) + off; }
        const int nig = WGM * nN, gid = wgid / nig, fm = gid * WGM, gsz = (nM - fm) < WGM ? (nM - fm) : WGM;
        const int pm = fm + ((wgid % nig) % gsz), pn = (wgid % nig) / gsz;
        u.a = A + (unsigned)(pm * BM * K * 2); u.b = Bt + (unsigned)(pn * BM * K * 2); u.r0 = pm * BM; u.c0 = pn * BM; u.e = 0; u.rb = 0; u.nv = BM; return true;
    }
};
template <bool GATH> struct MoeOrder {
    static constexpr bool GATHER = GATH;
    unsigned A, Bt; int K; int nct_log, nunits, G, c; unsigned idxoff; const LAS int* tileoff; const LAS int* ecnt; unsigned bstride; static constexpr int padrow = T_;
    DI bool next(int i, Unit& u) const {
        const long L = (long)i * G + c; if (L >= nunits) return false;
        int wgid = (int)L; { const int q = nunits / NXCD, r = nunits % NXCD, xcd = wgid % NXCD, off = wgid / NXCD; wgid = (xcd < r ? xcd * (q + 1) : r * (q + 1) + (xcd - r) * q) + off; }
        const int tile = wgid >> nct_log, pn = wgid & ((1 << nct_log) - 1);
        int e = 0;
#pragma unroll 1
        for (int j = 32; j >= 1; j >>= 1) { const int cand = e + j; if (tileoff[cand] <= tile) e = cand; }
        if (e < NEXP && tileoff[e + 1] <= tile) e += 1;
        e = __builtin_amdgcn_readfirstlane(e);
        u.e = e; u.r0 = tile * BM; u.c0 = pn * BM;
        { const int ti = tile - __builtin_amdgcn_readfirstlane(tileoff[e]); u.rb = e * ECAP + ti * BM; u.nv = __builtin_amdgcn_readfirstlane(ecnt[e]) - ti * BM; }
        u.a = GATH ? A : A + (unsigned)(tile * BM * K * 2);
        u.b = Bt + (unsigned)e * bstride + (unsigned)(pn * BM * K * 2);
        return true;
    }
};

struct EpiF32 {
    static constexpr bool PERM = false, ROWAUX = false;
    float* C; int ldc;
    DI void operator()(const f32x4 (&acc)[2][2][4][2], const Unit& u, int wr, int wc, int fr, int fq) const {
        const int row0 = u.r0 + wr * 64 + fr, col0 = u.c0 + wc * 32 + 4 * fq;
#pragma unroll
        for (int ai = 0; ai < 2; ++ai)
#pragma unroll
            for (int m = 0; m < 4; ++m) { float* rowp = C + (size_t)(row0 + ai * HALF + m * 16) * ldc + col0;
#pragma unroll
                for (int bj = 0; bj < 2; ++bj)
#pragma unroll
                    for (int n = 0; n < 2; ++n) *(f32x4*)(rowp + bj * HALF + n * 16) = acc[ai][bj][m][n]; }
    }
};
struct EpiBf16 {
    static constexpr bool PERM = true, ROWAUX = false;
    bf16* O; int ldc;
    DI void operator()(const f32x4 (&acc)[2][2][4][2], const Unit& u, int wr, int wc, int fr, int fq) const {
        const int row0 = u.r0 + wr * 64 + fr, col0 = u.c0 + wc * 32 + 8 * fq;
#pragma unroll
        for (int ai = 0; ai < 2; ++ai)
#pragma unroll
            for (int m = 0; m < 4; ++m) { bf16* rowp = O + (size_t)(row0 + ai * HALF + m * 16) * ldc + col0;
#pragma unroll
                for (int bj = 0; bj < 2; ++bj) { const f32x4 v0 = acc[ai][bj][m][0], v1 = acc[ai][bj][m][1];
                    u32x4 w; w.x = cvtpk(v0[0], v0[1]); w.y = cvtpk(v0[2], v0[3]); w.z = cvtpk(v1[0], v1[1]); w.w = cvtpk(v1[2], v1[3]);
                    *(u32x4*)(rowp + bj * HALF) = w; } }
    }
};
struct EpiQKV {
    static constexpr bool PERM = true, ROWAUX = false;
    bf16* QKV; const float* COS; const float* SIN;
    DI void operator()(const f32x4 (&acc)[2][2][4][2], const Unit& u, int wr, int wc, int fr, int fq) const {
        const int pn = u.c0 >> 8, g = pn / 12, which = (pn >> 2) % 3, hq = pn & 3;
        const int ldil = 2 * g, dil = 1 << ldil;
        const int idx = 4 * (wc & 1) + fq, b = u.r0 >> 12;
        const int row0 = u.r0 + wr * 64 + fr;
#pragma unroll
        for (int ai = 0; ai < 2; ++ai)
#pragma unroll
            for (int m = 0; m < 4; ++m) {
                const int r = row0 + ai * HALF + m * 16, t = r & (S_ - 1);
                const int prow = (t & (dil - 1)) * (S_ >> ldil) + (t >> ldil);
                f32x4 c4 = (f32x4){1.f, 1.f, 1.f, 1.f}, s4 = (f32x4){0.f, 0.f, 0.f, 0.f};
                if (which < 2) { c4 = *(const f32x4*)(COS + (size_t)r * 32 + 4 * idx); s4 = *(const f32x4*)(SIN + (size_t)r * 32 + 4 * idx); }
#pragma unroll
                for (int bj = 0; bj < 2; ++bj) {
                    const int head = 4 * hq + 2 * bj + (wc >> 1);
                    const f32x4 v0 = acc[ai][bj][m][0], v1 = acc[ai][bj][m][1];
                    f32x4 o0 = v0 * c4 - v1 * s4, o1 = v1 * c4 + v0 * s4;
                    if (which == 0) { o0 = o0 * QSCALE; o1 = o1 * QSCALE; }
                    u32x4 w; w.x = cvtpk(o0[0], o0[1]); w.y = cvtpk(o0[2], o0[3]); w.z = cvtpk(o1[0], o1[1]); w.w = cvtpk(o1[2], o1[3]);
                    bf16* dst = QKV + ((((size_t)(which * 3 + g) * NB_ + b) * 16 + head) * S_ + prow) * 64 + 8 * idx;
                    *(u32x4*)dst = w;
                }
            }
    }
};
struct EpiSwiGLU {
    static constexpr bool PERM = true, ROWAUX = false;
    bf16* HID;
    DI void operator()(const f32x4 (&acc)[2][2][4][2], const Unit& u, int wr, int wc, int fr, int fq) const {
        const int row0 = u.r0 + wr * 64 + fr, col0 = (u.c0 >> 1) + wc * 32 + 8 * fq;
#pragma unroll
        for (int ai = 0; ai < 2; ++ai)
#pragma unroll
            for (int m = 0; m < 4; ++m) {
                float hv[8];
#pragma unroll
                for (int n = 0; n < 2; ++n)
#pragma unroll
                    for (int j = 0; j < 4; ++j) { const float a = acc[ai][0][m][n][j], bb = acc[ai][1][m][n][j]; hv[4 * n + j] = silu_f(a) * bb; }
                u32x4 w; w.x = cvtpk(hv[0], hv[1]); w.y = cvtpk(hv[2], hv[3]); w.z = cvtpk(hv[4], hv[5]); w.w = cvtpk(hv[6], hv[7]);
                *(u32x4*)(HID + (size_t)(row0 + ai * HALF + m * 16) * 256 + col0) = w;
            }
    }
};
constexpr size_t YS_OFF = (size_t)160 << 20;
struct EpiScale {
    static constexpr bool PERM = true, ROWAUX = true;
    unsigned char* YE;
    int s0;
    DI void operator()(const f32x4 (&acc)[2][2][4][2], const Unit& u, int wr, int wc, int fr, int fq, const LAS int* aux) const {
        const int row0 = wr * 64 + fr, col0 = u.c0 + wc * 32 + 8 * fq;
        if (u.e == NEXP) {
            bf16* base = (bf16*)pg8::rfl_ptr((const char*)(YE + YS_OFF) + (size_t)(u.r0 - s0) * (D_ * 2));
#pragma unroll
            for (int ai = 0; ai < 2; ++ai)
#pragma unroll
                for (int m = 0; m < 4; ++m) { const unsigned ro = (unsigned)((row0 + ai * HALF + m * 16) * D_ + col0) * 2u;
#pragma unroll
                    for (int bj = 0; bj < 2; ++bj) { const f32x4 v0 = acc[ai][bj][m][0], v1 = acc[ai][bj][m][1];
                        u32x4 w; w.x = cvtpk(v0[0], v0[1]); w.y = cvtpk(v0[2], v0[3]); w.z = cvtpk(v1[0], v1[1]); w.w = cvtpk(v1[2], v1[3]);
                        *(u32x4*)((char*)base + ro + bj * HALF * 2) = w; } }
        } else {
            unsigned char* base = (unsigned char*)pg8::rfl_ptr((const char*)YE + (size_t)u.r0 * D_);
#pragma unroll
            for (int ai = 0; ai < 2; ++ai)
#pragma unroll
                for (int m = 0; m < 4; ++m) { const int rl = row0 + ai * HALF + m * 16; const float wgt = __builtin_bit_cast(float, aux[rl]) * YE_SCALE; const unsigned ro = (unsigned)(rl * D_ + col0);
#pragma unroll
                    for (int bj = 0; bj < 2; ++bj) { const f32x4 v0 = acc[ai][bj][m][0] * wgt, v1 = acc[ai][bj][m][1] * wgt;
                        u32x2 w; w.x = cvtpk_fp8(v0[0], v0[1], v0[2], v0[3]); w.y = cvtpk_fp8(v1[0], v1[1], v1[2], v1[3]);
                        *(u32x2*)(base + ro + bj * HALF) = w; } }
        }
    }
};
}
constexpr size_t MiB = 1u << 20;
constexpr size_t WS_CTL = 0, CTL_ZERO_BYTES = 1 * MiB;
constexpr size_t WS_MOD = 1 * MiB;
constexpr size_t WS_COS = 2 * MiB;
constexpr size_t WS_SIN = 4 * MiB;
constexpr size_t WS_ASG_E = 6 * MiB;
constexpr size_t WS_ASG_R = 6 * MiB + 512 * 1024;
constexpr size_t WS_ASG_W = 7 * MiB;
constexpr size_t WS_ASG_ROW = 7 * MiB + 512 * 1024;
constexpr size_t WS_ROWTOK = 8 * MiB;
constexpr size_t WS_ROWW = 9 * MiB;
constexpr size_t WS_AB = 10 * MiB;
constexpr size_t WS_GALPHA = 11 * MiB;
constexpr size_t WS_GBETA = 11 * MiB + 512 * 1024;
constexpr size_t WS_X = 12 * MiB;
constexpr size_t WS_Y = 76 * MiB;
constexpr size_t WS_H = 140 * MiB;
constexpr size_t WS_O = 173 * MiB;
constexpr size_t WS_WA_IN = 205 * MiB;
constexpr size_t WS_WA_OUT = 241 * MiB;
constexpr size_t WS_WG_IN = 245 * MiB;
constexpr size_t WS_WG_OUT = 261 * MiB;
constexpr size_t WS_WE1 = 265 * MiB;
constexpr size_t WS_WE2 = 330 * MiB;
constexpr size_t WS_HID = 363 * MiB;
constexpr size_t WS_BIG = 443 * MiB;
constexpr size_t WS_YS_OFF = pg8::YS_OFF;
constexpr size_t WS_WEB = WS_BIG + 368 * MiB;
constexpr size_t WS_WRF = WS_BIG + 466 * MiB;
constexpr size_t WS_WABF = WS_WRF + 1 * MiB;
constexpr size_t WS_ETOK = WS_WABF + 1 * MiB;
constexpr size_t WS_EW = WS_ETOK + 5 * MiB;
constexpr size_t WS_END = WS_EW + 5 * MiB;
constexpr size_t BIG_PROJ = 0, BIG_QN = 128 * MiB, BIG_KN = 192 * MiB, BIG_VV = 256 * MiB, BIG_ORAW = 320 * MiB;
constexpr int CW_BAR = 4096;
constexpr int CW_CNT = 16384;
constexpr int RING_BYTES = 131072;
constexpr int LDS_IDX = RING_BYTES;
constexpr int LDS_TILEOFF = LDS_IDX + 3072;
constexpr int LDS_LCNT = LDS_TILEOFF + 512;
constexpr int LDS_LBASE = LDS_LCNT + 256;
constexpr int LDS_LASG = LDS_LBASE + 256;
constexpr int LDS_ECNT = LDS_LASG;
constexpr int LDS_LW = LDS_IDX;
constexpr int LDS_MISC = LDS_LASG + 2048;
constexpr int LDS_LG = LDS_MISC + 128;
constexpr int LDS_BYTES = 147456;
static_assert(LDS_LG + 8192 <= LDS_BYTES, "LDS map");
constexpr int NWAVES = 8, NTHR = 512;

#define XB_TMO      128
#define XB_XCNT(j)  (256  + 64 * (j))
#define XB_XSUB(j)  (1280 + 64 * (j))
#define XB_XGEN(j)  (2304 + 64 * (j))
#define XB_TOP      3328
#define XB_TOPGEN   3392
#define XCD_BAR_WORDS 3456
#define XB_SPIN_CAP (1u << 18)
__device__ __forceinline__ unsigned xb_ld(unsigned* p)              { return __hip_atomic_load(p, __ATOMIC_RELAXED, __HIP_MEMORY_SCOPE_AGENT); }
__device__ __forceinline__ unsigned xb_add(unsigned* p, unsigned v) { return __hip_atomic_fetch_add(p, v, __ATOMIC_RELAXED, __HIP_MEMORY_SCOPE_AGENT); }
__device__ __forceinline__ unsigned xb_xcc_id() { return (unsigned)__builtin_amdgcn_s_getreg((3 << 11) | 20) & 0xFu; }
#define XB_SPIN(cond, bar) do { unsigned _sp = 0; while (cond) { __builtin_amdgcn_s_sleep(1); \
    if ((++_sp & 255u) == 0u) { if (xb_ld(&(bar)[XB_TMO])) break; if (_sp > XB_SPIN_CAP) { atomicAdd(&(bar)[XB_TMO], 1u); break; } } } } while (0)
struct XcdBarrier { unsigned* bar; unsigned x; volatile LAS unsigned* st; };
__device__ __forceinline__ XcdBarrier xcd_barrier_post(unsigned* bar, volatile LAS unsigned* st) {
    XcdBarrier b; b.bar = bar; b.x = xb_xcc_id(); b.st = st;
    if (threadIdx.x == 0) (void)xb_add(&bar[XB_XCNT(b.x)], 1u);
    return b;
}
__device__ __forceinline__ void xcd_barrier_complete(unsigned* bar, unsigned x, unsigned& nloc, unsigned& nx) {
    const unsigned G = gridDim.x * gridDim.y * gridDim.z;
    unsigned sum, cnt, mine, sp = 0u;
    for (;;) {
        sum = 0u; cnt = 0u; mine = 0u;
#pragma unroll
        for (unsigned j = 0; j < 16; ++j) { const unsigned c = xb_ld(&bar[XB_XCNT(j)]); sum += c; cnt += (c > 0u) ? 1u : 0u; mine = (j == x) ? c : mine; }
        if (sum == G) break;
        __builtin_amdgcn_s_sleep(1);
        if ((++sp & 255u) == 0u) { if (xb_ld(&bar[XB_TMO])) break; if (sp > XB_SPIN_CAP) { atomicAdd(&bar[XB_TMO], 1u); break; } }
    }
    nloc = mine > 0u ? mine : 1u; nx = cnt > 0u ? cnt : 1u;
}
__device__ __forceinline__ void xcd_barrier(const XcdBarrier& b, const int tid) {
    asm volatile("s_waitcnt vmcnt(0)" ::: "memory");
    __syncthreads();
    if (tid == 0) {
        unsigned* bar = b.bar;
        __builtin_amdgcn_s_waitcnt(0);
        unsigned nloc = b.st[0], nx = b.st[1];
        if (nloc == 0u) { xcd_barrier_complete(bar, b.x, nloc, nx); b.st[0] = nloc; b.st[1] = nx; }
        const unsigned old = xb_add(&bar[XB_XSUB(b.x)], 1u);
        const unsigned gen = old / nloc;
        if (old + 1u == (gen + 1u) * nloc) {
            __builtin_amdgcn_fence(__ATOMIC_RELEASE, "agent");
            asm volatile("s_waitcnt vmcnt(0)" ::: "memory");
            const unsigned og = xb_add(&bar[XB_TOP], 1u);
            const unsigned tg = og / nx;
            if (og + 1u == (tg + 1u) * nx) xb_add(&bar[XB_TOPGEN], 1u);
            else XB_SPIN(xb_ld(&bar[XB_TOPGEN]) == tg, bar);
            __builtin_amdgcn_fence(__ATOMIC_ACQUIRE, "agent");
            xb_add(&bar[XB_XGEN(b.x)], 1u);
            asm volatile("s_waitcnt vmcnt(0)" ::: "memory");
        } else {
            XB_SPIN(xb_ld(&bar[XB_XGEN(b.x)]) == gen, bar);
            __builtin_amdgcn_fence(__ATOMIC_ACQUIRE, "agent");
            asm volatile("s_waitcnt vmcnt(0)" ::: "memory");
        }
    }
    __syncthreads();
}

struct Args {
    const float* x; const float* c; const int* pos; const float* ada_w; const float* ada_b; const float* ln_g; const float* ln_b;
    const float* attn_w_in; const float* attn_w_out; const float* gdn_w_in; const float* gdn_conv_w; const float* gdn_a_log; const float* gdn_dt_bias;
    const float* gdn_norm_w; const float* gdn_w_out; const float* router_w; const float* router_bias; const float* ew1; const float* ew3; const float* ew2;
    const float* sw1; const float* sw3; const float* sw2;
    float* out; unsigned char* ws; int ph_lo, ph_hi;
};
typedef __attribute__((address_space(1))) unsigned char gas_u8;
DI unsigned char* opq(unsigned char* p) { gas_u8* g = (gas_u8*)p; asm volatile("" : "+s"(g)); return (unsigned char*)g; }
template <class T> DI T* asg(T* p) { typedef __attribute__((address_space(1))) T gT; return (T*)(gT*)p; }
struct Frame {
    LAS unsigned char* lds;
    int tid, lane, wave, G, bid;
};
template <class Map> DI void transpose_item(const float* W, int ldn, int K, bf16* WT, const Map& map, LAS float* scr, int kb, int nb, int lane) {
    const int k0 = 64 * kb, n0 = 32 * nb;
    float tv[32];
#pragma unroll
    for (int i = 0; i < 32; ++i) tv[i] = __builtin_nontemporal_load(&W[(size_t)(k0 + 2 * i + (lane >> 5)) * ldn + n0 + (lane & 31)]);
#pragma unroll
    for (int i = 0; i < 32; ++i) scr[(2 * i + (lane >> 5)) * 33 + (lane & 31)] = tv[i];
    LDS_WAIT(); asm volatile("" ::: "memory");
    const int c = lane & 7;
#pragma unroll
    for (int j = 0; j < 4; ++j) { const int n = (lane >> 3) + 8 * j; const LAS float* s = scr + (8 * c) * 33 + n;
        u32x4 o; o.x = cvtpk(s[0 * 33], s[1 * 33]); o.y = cvtpk(s[2 * 33], s[3 * 33]); o.z = cvtpk(s[4 * 33], s[5 * 33]); o.w = cvtpk(s[6 * 33], s[7 * 33]);
        *(u32x4*)(WT + (size_t)map(n0 + n) * K + k0 + 8 * c) = o; }
    LDS_WAIT(); asm volatile("" ::: "memory");
}
struct MapId { int off; DI int operator()(int n) const { return off + n; } };
struct MapQKV { DI int operator()(int n) const {
    const int which = (n >> 10) % 3; if (which == 2) return n;
    const int d = n & 63, idx = (d & 31) >> 2, lo = d & 3, hi = d >> 5; return (n & ~63) + 8 * idx + 4 * hi + lo; } };
struct MapW13 { int second; DI int operator()(int n) const { return (n >> 7) * 256 + second * 128 + (n & 127); } };
template <class Map> DI void convert_matrix(const Frame& F, const float* W, int ldn, int K, int N, bf16* WT, const Map& map) {
    LAS float* scr = (LAS float*)(F.lds + F.wave * 16384);
    const int gw = F.bid * NWAVES + F.wave, NGW = F.G * NWAVES, nblk = N / 32, nitems = (K / 64) * nblk;
    for (int it = gw; it < nitems; it += NGW) transpose_item(W, ldn, K, WT, map, scr, it / nblk, it % nblk, F.lane);
}

DI void prologue_phase(const Frame& F, const Args& A) {
    unsigned char* ws = opq(A.ws);
    {
        LAS float* red = (LAS float*)F.lds;
        float* MOD = (float*)(ws + WS_MOD);
        for (int item = F.bid; item < 8 * 48; item += F.G) {
            const int ls = item / 48, n = (item % 48) * 64 + F.lane;
            const float* w = A.ada_w + ((size_t)ls * D_ + F.wave * 128) * 3072 + n;
            const float* cc = A.c + F.wave * 128;
            float a0 = 0.f, a1 = 0.f, a2 = 0.f, a3 = 0.f;
#pragma unroll 8
            for (int k = 0; k < 128; ++k) { const float wv = __builtin_nontemporal_load(&w[(size_t)k * 3072]); a0 += cc[k] * wv; a1 += cc[D_ + k] * wv; a2 += cc[2 * D_ + k] * wv; a3 += cc[3 * D_ + k] * wv; }
            red[(F.wave * 4 + 0) * 64 + F.lane] = a0; red[(F.wave * 4 + 1) * 64 + F.lane] = a1; red[(F.wave * 4 + 2) * 64 + F.lane] = a2; red[(F.wave * 4 + 3) * 64 + F.lane] = a3;
            __syncthreads();
            if (F.wave < 4) { float s = A.ada_b[ls * 3072 + n];
#pragma unroll
                for (int w8 = 0; w8 < 8; ++w8) s += red[(w8 * 4 + F.wave) * 64 + F.lane];
                MOD[((size_t)ls * 4 + F.wave) * 3072 + n] = s; }
            __syncthreads();
        }
    }
    {
        float* COS = (float*)(ws + WS_COS); float* SIN = (float*)(ws + WS_SIN);
        for (int idx = F.bid * NTHR + F.tid; idx < T_ * 32; idx += F.G * NTHR) {
            const int t = idx >> 5, i = idx & 31;
            const float inv = powf(10000.0f, -(float)i / 32.0f);
            const float ang = (float)A.pos[t] * inv;
            COS[idx] = cosf(ang); SIN[idx] = sinf(ang);
        }
    }
    {
        bf16* WRF = (bf16*)(ws + WS_WRF); bf16* WABF = (bf16*)(ws + WS_WABF);
        for (int idx = F.bid * NTHR + F.tid; idx < 4 * 4 * 32 * 64 * 8; idx += F.G * NTHR) {
            const int jx = idx & 7, ln = (idx >> 3) & 63, ks = (idx >> 9) & 31, nt = (idx >> 14) & 3, layer = idx >> 16;
            const int d = 32 * ks + 8 * (ln >> 4) + jx, e = 16 * nt + (ln & 15);
            const float wv = A.router_w[((size_t)layer * D_ + d) * NEXP + e];
            const unsigned hi = cvtpk(wv, 0.f) & 0xffffu; const float res = wv - bf_lo(hi);
            const size_t o = (size_t)layer * 2 * 65536 + (idx & 65535);
            WRF[o] = (bf16)hi; WRF[o + 65536] = (bf16)(cvtpk(res, 0.f) & 0xffffu);
        }
        for (int idx = F.bid * NTHR + F.tid; idx < 2 * 32 * 64 * 8; idx += F.G * NTHR) {
            const int jx = idx & 7, ln = (idx >> 3) & 63, ks = (idx >> 9) & 31, jl = idx >> 14;
            const int d = 32 * ks + 8 * (ln >> 4) + jx, e = ln & 15;
            const float wv = A.gdn_w_in[((size_t)jl * D_ + d) * 4112 + 4096 + e];
            const unsigned hi = cvtpk(wv, 0.f) & 0xffffu; const float res = wv - bf_lo(hi);
            const size_t o = (size_t)jl * 2 * 16384 + (idx & 16383);
            WABF[o] = (bf16)hi; WABF[o + 16384] = (bf16)(cvtpk(res, 0.f) & 0xffffu);
        }
    }
    if (F.bid == 0) { bf16* H = (bf16*)(ws + WS_H); for (int cidx = F.tid; cidx < D_; cidx += NTHR) H[(size_t)T_ * D_ + cidx] = 0; }
    for (int j = 0; j < 2; ++j) {
        convert_matrix(F, A.attn_w_in + (size_t)j * D_ * 9216, 9216, D_, 9216, (bf16*)(ws + WS_WA_IN) + (size_t)j * 9216 * D_, MapQKV{});
        convert_matrix(F, A.attn_w_out + (size_t)j * D_ * D_, D_, D_, D_, (bf16*)(ws + WS_WA_OUT) + (size_t)j * D_ * D_, MapId{0});
        convert_matrix(F, A.gdn_w_in + (size_t)j * D_ * 4112, 4112, D_, 4096, (bf16*)(ws + WS_WG_IN) + (size_t)j * 4096 * D_, MapId{0});
        convert_matrix(F, A.gdn_w_out + (size_t)j * D_ * D_, D_, D_, D_, (bf16*)(ws + WS_WG_OUT) + (size_t)j * D_ * D_, MapId{0});
    }
}
struct XItem { const float* src; bf16* dst; int ldn, K, mode, n0; };
DI XItem xi_decode(const Args& A, int layer, bf16* WE1, bf16* WE2, int it) {
    constexpr int I13 = (D_ / 64) * (256 / 32), I2 = (256 / 64) * (D_ / 32), IPE = 2 * I13 + I2;
    const int e = it / IPE; int r = it % IPE; XItem x;
    if (r < 2 * I13) { const int second = r >= I13 ? 1 : 0; r -= second * I13; const int kb = r >> 3, nb = r & 7;
        const float* w = second ? (e < 64 ? A.ew3 + ((size_t)layer * 64 + e) * D_ * 256 : A.sw3 + (size_t)layer * D_ * 256) : (e < 64 ? A.ew1 + ((size_t)layer * 64 + e) * D_ * 256 : A.sw1 + (size_t)layer * D_ * 256);
        x.src = w + (size_t)(64 * kb) * 256 + 32 * nb; x.ldn = 256; x.K = D_; x.mode = 1 + second; x.n0 = 32 * nb; x.dst = WE1 + (size_t)e * 512 * D_ + 64 * kb;
    } else { r -= 2 * I13; const int kb = r >> 5, nb = r & 31;
        const float* w = e < 64 ? A.ew2 + ((size_t)layer * 64 + e) * 256 * D_ : A.sw2 + (size_t)layer * 256 * D_;
        x.src = w + (size_t)(64 * kb) * D_ + 32 * nb; x.ldn = D_; x.K = 256; x.mode = 0; x.n0 = 32 * nb; x.dst = WE2 + (size_t)e * D_ * 256 + 64 * kb; }
    return x;
}
#define XI_LOAD(buf, XT) do { const char* _b = pg8::rfl_ptr((const char*)(XT).src); const unsigned _ro = (unsigned)((XT).ldn * 4); \
    _Pragma("unroll") for (int _i = 0; _i < 8; ++_i) buf[_i] = __builtin_nontemporal_load((const f32x4*)(_b + ((unsigned)(8 * _i + (lane >> 3)) * _ro + (unsigned)(lane & 7) * 16u))); } while (0)
#define XI_PUT(buf, XT) do { \
    _Pragma("unroll") for (int _i = 0; _i < 8; ++_i) _Pragma("unroll") for (int _e = 0; _e < 4; ++_e) scr[(8 * _i + (lane >> 3)) * 33 + 4 * (lane & 7) + _e] = buf[_i][_e]; \
    LDS_WAIT(); asm volatile("" ::: "memory"); \
    const int _c = lane & 7; \
    _Pragma("unroll") for (int _j = 0; _j < 4; ++_j) { const int _n = (XT).n0 + (lane >> 3) + 8 * _j; const LAS float* _s = scr + (8 * _c) * 33 + (lane >> 3) + 8 * _j; \
        const int _row = (XT).mode == 0 ? _n : (_n >> 7) * 256 + ((XT).mode - 1) * 128 + (_n & 127); \
        u32x4 _o; _o.x = cvtpk(_s[0 * 33], _s[1 * 33]); _o.y = cvtpk(_s[2 * 33], _s[3 * 33]); _o.z = cvtpk(_s[4 * 33], _s[5 * 33]); _o.w = cvtpk(_s[6 * 33], _s[7 * 33]); \
        *(u32x4*)((XT).dst + (size_t)_row * (XT).K + 8 * _c) = _o; } \
    LDS_WAIT(); asm volatile("" ::: "memory"); } while (0)
DI void convert_experts(const Frame& F, const Args& A, int layer, int set, int wg0, int nwg) {
    if (F.bid < wg0 || F.bid >= wg0 + nwg) return;
    unsigned char* ws = opq(A.ws);
    LAS float* scr = (LAS float*)(F.lds + F.wave * 16384);
    bf16* WE1 = (bf16*)(ws + (set ? WS_WEB : WS_WE1)); bf16* WE2 = (bf16*)(ws + (set ? WS_WEB + 65 * MiB : WS_WE2));
    const int gw = (F.bid - wg0) * NWAVES + F.wave, NGW = nwg * NWAVES, lane = F.lane;
    constexpr int NIT = 65 * 384;
    f32x4 ba[8], bb[8];
    int it = gw;
    if (it >= NIT) return;
    XItem xa = xi_decode(A, layer, WE1, WE2, it), xb = xa;
    XI_LOAD(ba, xa);
#pragma unroll 1
    for (;;) {
        const bool hb = it + NGW < NIT;
        if (hb) { xb = xi_decode(A, layer, WE1, WE2, it + NGW); XI_LOAD(bb, xb); }
        __builtin_amdgcn_sched_barrier(0);
        XI_PUT(ba, xa);
        if (!hb) break;
        it += NGW;
        const bool ha = it + NGW < NIT;
        if (ha) { xa = xi_decode(A, layer, WE1, WE2, it + NGW); XI_LOAD(ba, xa); }
        __builtin_amdgcn_sched_barrier(0);
        XI_PUT(bb, xb);
        if (!ha) break;
        it += NGW;
    }
}
#undef XI_LOAD
#undef XI_PUT

DI void load_row16(const float* p, int lane, f32x4 (&v)[4]) {
#pragma unroll
    for (int j = 0; j < 4; ++j) v[j] = *(const f32x4*)(p + 4 * lane + 256 * j);
}
DI void store_row16(float* p, int lane, const f32x4 (&v)[4]) {
#pragma unroll
    for (int j = 0; j < 4; ++j) *(f32x4*)(p + 4 * lane + 256 * j) = v[j];
}
DI void store_row16_bf16(bf16* p, int lane, const f32x4 (&v)[4]) {
#pragma unroll
    for (int j = 0; j < 4; ++j) { u32x2 w; w.x = cvtpk(v[j][0], v[j][1]); w.y = cvtpk(v[j][2], v[j][3]); *(u32x2*)(p + 4 * lane + 256 * j) = w; }
}
DI void add_row16_bf16(const bf16* p, int lane, f32x4 (&v)[4]) {
#pragma unroll
    for (int j = 0; j < 4; ++j) { const u32x2 w = *(const u32x2*)(p + 4 * lane + 256 * j); v[j][0] += bf_lo(w.x); v[j][1] += bf_hi(w.x); v[j][2] += bf_lo(w.y); v[j][3] += bf_hi(w.y); }
}
DI void add_row16_fp8(const unsigned char* p, int lane, f32x4 (&v)[4]) {
#pragma unroll
    for (int j = 0; j < 4; ++j) { const int w = *(const int*)(p + 4 * lane + 256 * j);
        const f32x2 a = __builtin_amdgcn_cvt_pk_f32_fp8(w, false), b = __builtin_amdgcn_cvt_pk_f32_fp8(w, true);
        v[j][0] += a[0]; v[j][1] += a[1]; v[j][2] += b[0]; v[j][3] += b[1]; }
}
DI void layer_norm16(f32x4 (&v)[4], const f32x4 (&g)[4], const f32x4 (&b)[4]) {
    float s = 0.f;
#pragma unroll
    for (int j = 0; j < 4; ++j) s += (v[j][0] + v[j][1]) + (v[j][2] + v[j][3]);
    const float mean = wave_sum(s) * (1.0f / D_);
    float q = 0.f;
#pragma unroll
    for (int j = 0; j < 4; ++j) { v[j] = v[j] - mean; q += (v[j][0] * v[j][0] + v[j][1] * v[j][1]) + (v[j][2] * v[j][2] + v[j][3] * v[j][3]); }
    const float rstd = 1.0f / sqrtf(wave_sum(q) * (1.0f / D_) + LN_EPS);
#pragma unroll
    for (int j = 0; j < 4; ++j) v[j] = v[j] * rstd * g[j] + b[j];
}

DI void modx_phase(const Frame& F, const Args& A) {
    unsigned char* ws = opq(A.ws);
    const float* MOD = (const float*)(ws + WS_MOD); bf16* H = (bf16*)(ws + WS_H);
    const int gw = F.bid * NWAVES + F.wave, NGW = F.G * NWAVES;
    for (int row = gw; row < T_; row += NGW) {
        const int b = row >> 12; f32x4 v[4], sc[4], sh[4];
        load_row16(A.x + (size_t)row * D_, F.lane, v); load_row16(MOD + (size_t)(0 * 4 + b) * 3072 + 1024, F.lane, sc); load_row16(MOD + (size_t)(0 * 4 + b) * 3072, F.lane, sh);
#pragma unroll
        for (int j = 0; j < 4; ++j) v[j] = v[j] * (1.0f + sc[j]) + sh[j];
        store_row16_bf16(H + (size_t)row * D_, F.lane, v);
    }
}

DI void build_tileoff(const Frame& F, const unsigned* gcount) {
    LAS int* tileoff = (LAS int*)(F.lds + LDS_TILEOFF);
    __syncthreads();
    if (F.wave == 0) {
        const unsigned cn = __hip_atomic_load(gcount + F.lane, __ATOMIC_RELAXED, __HIP_MEMORY_SCOPE_AGENT);
        const int nt = (int)((cn + 255u) >> 8); int inc = nt;
#pragma unroll
        for (int o = 1; o < 64; o <<= 1) { const int t = __builtin_amdgcn_ds_bpermute((F.lane - o) << 2, inc); if (F.lane >= o) inc += t; }
        tileoff[F.lane] = inc - nt; ((LAS int*)(F.lds + LDS_ECNT))[F.lane] = (int)cn;
        if (F.lane == 63) { tileoff[64] = inc; tileoff[65] = inc + T_ / 256; ((LAS int*)(F.lds + LDS_ECNT))[NEXP] = T_; }
    }
    __syncthreads();
}

DI void deepnorm_row(f32x4 (&v)[4], const f32x4 (&y)[4], const float* gate, const float* lng, const float* lnb, float* xout, const float* mod_shift, int lane) {
    f32x4 t[4];
    load_row16(gate, lane, t);
#pragma unroll
    for (int j = 0; j < 4; ++j) v[j] = ALPHA_DN * v[j] + (1.0f + t[j]) * y[j];
    float s = 0.f;
#pragma unroll
    for (int j = 0; j < 4; ++j) s += (v[j][0] + v[j][1]) + (v[j][2] + v[j][3]);
    const float mean = wave_sum(s) * (1.0f / D_);
    float q = 0.f;
#pragma unroll
    for (int j = 0; j < 4; ++j) { v[j] = v[j] - mean; q += (v[j][0] * v[j][0] + v[j][1] * v[j][1]) + (v[j][2] * v[j][2] + v[j][3] * v[j][3]); }
    const float rstd = 1.0f / sqrtf(wave_sum(q) * (1.0f / D_) + LN_EPS);
    load_row16(lng, lane, t);
#pragma unroll
    for (int j = 0; j < 4; ++j) v[j] = v[j] * rstd * t[j];
    load_row16(lnb, lane, t);
#pragma unroll
    for (int j = 0; j < 4; ++j) v[j] = v[j] + t[j];
    store_row16(xout, lane, v);
    if (mod_shift) {
        load_row16(mod_shift + 1024, lane, t);
#pragma unroll
        for (int j = 0; j < 4; ++j) v[j] = v[j] * (1.0f + t[j]);
        load_row16(mod_shift, lane, t);
#pragma unroll
        for (int j = 0; j < 4; ++j) v[j] = v[j] + t[j];
    }
}
DI void put_hilo(LAS unsigned char* lds, int p, int lane, const f32x4 (&v)[4]) {
#pragma unroll
    for (int j = 0; j < 4; ++j) {
        const int c = 4 * lane + 256 * j;
        const unsigned h0 = cvtpk(v[j][0], v[j][1]), h1 = cvtpk(v[j][2], v[j][3]);
        const unsigned l0 = cvtpk(v[j][0] - bf_lo(h0), v[j][1] - bf_hi(h0)), l1 = cvtpk(v[j][2] - bf_lo(h1), v[j][3] - bf_hi(h1));
        const int off = ((((p >> 4) * 32 + (c >> 5)) * 64 + ((c & 31) >> 3) * 16 + (p & 15)) * 16) + (c & 7) * 2;
        *(LAS u32x2*)(lds + off) = (u32x2){h0, h1}; *(LAS u32x2*)(lds + 65536 + off) = (u32x2){l0, l1};
    }
}
DI f32x4 small_proj(const LAS unsigned char* lds, int mt, int lane, const bf16* wf_hi, const bf16* wf_lo) {
    f32x4 a0 = (f32x4){0.f, 0.f, 0.f, 0.f}, a1 = a0, a2 = a0;
#pragma unroll 8
    for (int ks = 0; ks < 32; ++ks) {
        const bf16x8 ah = *(const LAS bf16x8*)(lds + ((mt * 32 + ks) * 64 + lane) * 16), al = *(const LAS bf16x8*)(lds + 65536 + ((mt * 32 + ks) * 64 + lane) * 16);
        const bf16x8 bh = *(const bf16x8*)(wf_hi + (ks * 64 + lane) * 8), bl = *(const bf16x8*)(wf_lo + (ks * 64 + lane) * 8);
        a0 = __builtin_amdgcn_mfma_f32_16x16x32_bf16(ah, bh, a0, 0, 0, 0); a1 = __builtin_amdgcn_mfma_f32_16x16x32_bf16(ah, bl, a1, 0, 0, 0); a2 = __builtin_amdgcn_mfma_f32_16x16x32_bf16(al, bh, a2, 0, 0, 0);
    }
    return a0 + (a1 + a2);
}
DI void small_proj2(const LAS unsigned char* lds, int kh, int lane, const bf16* wf_hi, const bf16* wf_lo, f32x4& o0, f32x4& o1) {
    f32x4 a[2][3];
#pragma unroll
    for (int mt = 0; mt < 2; ++mt)
#pragma unroll
        for (int e = 0; e < 3; ++e) a[mt][e] = (f32x4){0.f, 0.f, 0.f, 0.f};
#pragma unroll 8
    for (int k = 0; k < 16; ++k) {
        const int ks = 16 * kh + k;
        const bf16x8 bh = *(const bf16x8*)(wf_hi + (ks * 64 + lane) * 8), bl = *(const bf16x8*)(wf_lo + (ks * 64 + lane) * 8);
#pragma unroll
        for (int mt = 0; mt < 2; ++mt) {
            const bf16x8 ah = *(const LAS bf16x8*)(lds + ((mt * 32 + ks) * 64 + lane) * 16), al = *(const LAS bf16x8*)(lds + 65536 + ((mt * 32 + ks) * 64 + lane) * 16);
            a[mt][0] = __builtin_amdgcn_mfma_f32_16x16x32_bf16(ah, bh, a[mt][0], 0, 0, 0); a[mt][1] = __builtin_amdgcn_mfma_f32_16x16x32_bf16(ah, bl, a[mt][1], 0, 0, 0); a[mt][2] = __builtin_amdgcn_mfma_f32_16x16x32_bf16(al, bh, a[mt][2], 0, 0, 0);
        }
    }
    o0 = a[0][0] + (a[0][1] + a[0][2]); o1 = a[1][0] + (a[1][1] + a[1][2]);
}
DI void deepnorm_row_c(f32x4 (&v)[4], const f32x4 (&y)[4], const f32x4 (&cg)[4], const f32x4 (&cng)[4], const f32x4 (&cnb)[4]) {
#pragma unroll
    for (int j = 0; j < 4; ++j) v[j] = ALPHA_DN * v[j] + (1.0f + cg[j]) * y[j];
    float s = 0.f;
#pragma unroll
    for (int j = 0; j < 4; ++j) s += (v[j][0] + v[j][1]) + (v[j][2] + v[j][3]);
    const float mean = wave_sum(s) * (1.0f / D_);
    float q = 0.f;
#pragma unroll
    for (int j = 0; j < 4; ++j) { v[j] = v[j] - mean; q += (v[j][0] * v[j][0] + v[j][1] * v[j][1]) + (v[j][2] * v[j][2] + v[j][3] * v[j][3]); }
    const float rstd = 1.0f / sqrtf(wave_sum(q) * (1.0f / D_) + LN_EPS);
#pragma unroll
    for (int j = 0; j < 4; ++j) v[j] = v[j] * rstd * cng[j] + cnb[j];
}
template <bool L0> DI void ln_router_phase(const Frame& F, const Args& A, int layer, bool dry = false) {
    unsigned char* ws = opq(A.ws);
    const float* MOD = (const float*)(ws + WS_MOD); bf16* X = (bf16*)(ws + WS_X); const float* Y = (const float*)(ws + WS_Y); bf16* H = (bf16*)(ws + WS_H);
    int* asg_e = (int*)(ws + WS_ASG_E); int* asg_r = (int*)(ws + WS_ASG_R); int* etok = (int*)(ws + WS_ETOK); float* egate = (float*)(ws + WS_EW);
    unsigned* gcount = (unsigned*)(ws + WS_CTL) + CW_CNT + layer * 64;
    const int ls0 = layer * 2, ls1 = layer * 2 + 1;
    const bf16* wrf = (const bf16*)(ws + WS_WRF) + (size_t)layer * 2 * 65536 + (size_t)(F.wave & 3) * 32 * 512;
    const float rb = A.router_bias[layer * NEXP + F.lane];
    LAS float* lg = (LAS float*)(F.lds + LDS_LG);
    LAS int* lcnt = (LAS int*)(F.lds + LDS_LCNT); LAS int* lbase = (LAS int*)(F.lds + LDS_LBASE); LAS int* lasg = (LAS int*)(F.lds + LDS_LASG);
    const unsigned l8_ = (unsigned)F.lane * 8u, l16_ = (unsigned)F.lane * 16u;
    u32x2 yb[4][4], xb[L0 ? 1 : 4][4]; f32x4 xf[L0 ? 4 : 1][4];
#define LNR_LOAD(rb_) do { unsigned l8 = l8_, l16 = l16_; asm volatile("" : "+v"(l8), "+v"(l16)); \
        _Pragma("unroll") for (int t = 0; t < 4; ++t) { const int row = (rb_) + t; const char* py = pg8::rfl_ptr((const char*)Y + (size_t)row * (D_ * 2)); \
            if constexpr (L0) { const char* px = pg8::rfl_ptr((const char*)A.x + (size_t)row * (D_ * 4)); _Pragma("unroll") for (int j = 0; j < 4; ++j) xf[t][j] = *(const f32x4*)(px + l16 + 1024 * j); } \
            else { const char* px = pg8::rfl_ptr((const char*)X + (size_t)row * (D_ * 2)); _Pragma("unroll") for (int j = 0; j < 4; ++j) xb[t][j] = *(const u32x2*)(px + l8 + 512 * j); } \
            _Pragma("unroll") for (int j = 0; j < 4; ++j) yb[t][j] = *(const u32x2*)(py + l8 + 512 * j); } } while (0)
    for (int blk = F.bid; blk < T_ / 64; blk += F.G) {
        const int b = blk >> 6;
        const char* gate = pg8::rfl_ptr((const char*)(MOD + (size_t)(ls0 * 4 + b) * 3072 + 2048)); const char* modn = pg8::rfl_ptr((const char*)(MOD + (size_t)(ls1 * 4 + b) * 3072));
        const char* lng = pg8::rfl_ptr((const char*)(A.ln_g + (size_t)ls0 * D_)); const char* lnb = pg8::rfl_ptr((const char*)(A.ln_b + (size_t)ls0 * D_));
        f32x4 cg[4], cng[4], cnb[4], csc[4], csh[4];
#pragma unroll
        for (int j = 0; j < 4; ++j) { cg[j] = *(const f32x4*)(gate + l16_ + 1024 * j); cng[j] = *(const f32x4*)(lng + l16_ + 1024 * j); cnb[j] = *(const f32x4*)(lnb + l16_ + 1024 * j);
            csc[j] = *(const f32x4*)(modn + 4096 + l16_ + 1024 * j); csh[j] = *(const f32x4*)(modn + l16_ + 1024 * j); }
        if constexpr (!L0) { LNR_LOAD(blk * 64 + F.wave * 4); }
        __builtin_amdgcn_sched_barrier(0);
#pragma unroll 1
        for (int ps = 0; ps < 2; ++ps) {
            const int rbase = blk * 64 + ps * 32 + F.wave * 4;
            if constexpr (L0) { LNR_LOAD(rbase); }
            { unsigned l8 = l8_; asm volatile("" : "+v"(l8));
#pragma unroll
              for (int t = 0; t < 4; ++t) { const int row = rbase + t; f32x4 v[4], y[4];
#pragma unroll
                for (int j = 0; j < 4; ++j) { y[j] = (f32x4){bf_lo(yb[t][j].x), bf_hi(yb[t][j].x), bf_lo(yb[t][j].y), bf_hi(yb[t][j].y)};
                    if constexpr (L0) v[j] = xf[t][j]; else v[j] = (f32x4){bf_lo(xb[t][j].x), bf_hi(xb[t][j].x), bf_lo(xb[t][j].y), bf_hi(xb[t][j].y)}; }
                deepnorm_row_c(v, y, cg, cng, cnb);
                char* xp = (char*)pg8::rfl_ptr((const char*)(dry ? (const bf16*)(ws + WS_Y + 32 * MiB) : X) + (size_t)row * (D_ * 2));
                char* hp = (char*)pg8::rfl_ptr((const char*)H + (size_t)row * (D_ * 2));
#pragma unroll
                for (int j = 0; j < 4; ++j) { { u32x2 o; o.x = cvtpk(v[j][0], v[j][1]); o.y = cvtpk(v[j][2], v[j][3]); *(u32x2*)(xp + l8 + 512 * j) = o; }
                    v[j] = v[j] * (1.0f + csc[j]) + csh[j]; u32x2 o; o.x = cvtpk(v[j][0], v[j][1]); o.y = cvtpk(v[j][2], v[j][3]); *(u32x2*)(hp + l8 + 512 * j) = o; }
                put_hilo(F.lds, F.wave * 4 + t, F.lane, v); } }
            if constexpr (!L0) { if (ps == 0) { LNR_LOAD(blk * 64 + 32 + F.wave * 4); } }
            __syncthreads();
            { const int nt = F.wave & 3, kh = F.wave >> 2, r = F.lane & 15, q = F.lane >> 4;
              f32x4 acc0, acc1; small_proj2(F.lds, kh, F.lane, wrf, wrf + 65536, acc0, acc1);
              if (kh == 0) {
#pragma unroll
                  for (int reg = 0; reg < 4; ++reg) { lg[(4 * q + reg) * 64 + 16 * nt + r] = acc0[reg]; lg[(16 + 4 * q + reg) * 64 + 16 * nt + r] = acc1[reg]; } }
              __syncthreads();
              if (kh == 1) {
#pragma unroll
                  for (int reg = 0; reg < 4; ++reg) { lg[(4 * q + reg) * 64 + 16 * nt + r] += acc0[reg]; lg[(16 + 4 * q + reg) * 64 + 16 * nt + r] += acc1[reg]; } } }
            __syncthreads();
#pragma unroll 2
            for (int rr = 0; rr < 4; ++rr) {
                const int row = rbase + rr, rl = ps * 32 + F.wave * 4 + rr;
                int ln = F.lane; asm volatile("" : "+v"(ln));
                const float logit = lg[(F.wave * 4 + rr) * 64 + F.lane];
                const float s = 1.0f / (1.0f + __expf(-logit)); const float bi = s + rb;
                float m1 = bi; m1 = fmaxf(m1, dppmov<0xB1>(m1)); m1 = fmaxf(m1, dppmov<0x4E>(m1)); m1 = fmaxf(m1, dppmov<0x141>(m1));
                const unsigned long long eq = __ballot(bi == m1);
                const int first = __ffs((int)((eq >> (ln & ~7)) & 0xffull)) - 1;
                float m2 = ((ln & 7) == first) ? -INFINITY : bi; m2 = fmaxf(m2, dppmov<0xB1>(m2)); m2 = fmaxf(m2, dppmov<0x4E>(m2)); m2 = fmaxf(m2, dppmov<0x141>(m2));
                const float gs = m1 + m2; int grank = 0;
#pragma unroll
                for (int j = 0; j < 8; ++j) { const float gj = rdlane(gs, 8 * j); grank += ((gj > gs) || (gj == gs && j < (ln >> 3))) ? 1 : 0; }
                const bool gsel = grank < 4;
                float mv = gsel ? bi : -INFINITY; int cnt = -1;
#pragma unroll
                for (int it = 0; it < TOPK; ++it) { const float mx = wave_max(mv); const unsigned long long em = __ballot(mv == mx); const int fl = __ffsll((long long)em) - 1;
                    if (ln == fl) { cnt = it; mv = -INFINITY; } }
                const bool sel = cnt >= 0;
                const float gsum = wave_sum(sel ? s : 0.f);
                if (sel) { const int lr = __hip_atomic_fetch_add(&lcnt[F.lane], 1, __ATOMIC_RELAXED, __HIP_MEMORY_SCOPE_WORKGROUP); lasg[rl * 8 + cnt] = (F.lane << 16) | lr;
                    asg_e[(size_t)row * 8 + cnt] = F.lane; ((LAS float*)(F.lds + LDS_LW))[rl * 8 + cnt] = s / gsum * 2.5f; }
            }
        }
        __syncthreads();
        if (F.tid < NEXP) { const int cn = lcnt[F.tid]; lbase[F.tid] = (cn && !dry) ? (int)atomicAdd(&gcount[F.tid], (unsigned)cn) : 0; lcnt[F.tid] = 0; }
        __syncthreads();
        { const int v = lasg[F.tid], e = v >> 16, rank = lbase[e] + (v & 0xffff); asg_r[(size_t)blk * 512 + F.tid] = rank;
          etok[(size_t)e * ECAP + rank] = blk * 64 + (F.tid >> 3); egate[(size_t)e * ECAP + rank] = ((const LAS float*)(F.lds + LDS_LW))[F.tid];
          if (F.tid < 64) { etok[(size_t)NEXP * ECAP + blk * 64 + F.tid] = blk * 64 + F.tid; egate[(size_t)NEXP * ECAP + blk * 64 + F.tid] = 1.0f; } }
        __syncthreads();
    }
#undef LNR_LOAD
}

DI void moe_scatter_phase(const Frame& F, const Args& A, int layer) {
    unsigned char* ws = opq(A.ws);
    const int* asg_e = (const int*)(ws + WS_ASG_E); const int* asg_r = (const int*)(ws + WS_ASG_R); const float* asg_w = (const float*)(ws + WS_ASG_W); int* asg_row = (int*)(ws + WS_ASG_ROW);
    int* rowtok = (int*)(ws + WS_ROWTOK); float* roww = (float*)(ws + WS_ROWW);
    const unsigned* gcount = (const unsigned*)(ws + WS_CTL) + CW_CNT + layer * 64;
    build_tileoff(F, gcount);
    const LAS int* tileoff = (const LAS int*)(F.lds + LDS_TILEOFF);
    for (int idx = F.bid * NTHR + F.tid; idx < T_ * TOPK; idx += F.G * NTHR) {
        const int e = asg_e[idx], row = 256 * tileoff[e] + asg_r[idx];
        rowtok[row] = idx >> 3; roww[row] = asg_w[idx]; asg_row[idx] = row;
    }
    for (int e = F.bid; e < NEXP; e += F.G) {
        const int cnt = (int)__hip_atomic_load(gcount + e, __ATOMIC_RELAXED, __HIP_MEMORY_SCOPE_AGENT), end = 256 * tileoff[e + 1];
        for (int row = 256 * tileoff[e] + cnt + F.tid; row < end; row += NTHR) { rowtok[row] = T_; roww[row] = 0.f; }
    }
    const int s0 = 256 * tileoff[64];
    for (int t = F.bid * NTHR + F.tid; t < T_; t += F.G * NTHR) { rowtok[s0 + t] = t; roww[s0 + t] = 1.0f; }
}

DI void ln_moe_phase(const Frame& F, const Args& A, int layer, float* dry_out) {
    unsigned char* ws = opq(A.ws);
    const float* MOD = (const float*)(ws + WS_MOD); const char* YE = (const char*)(ws + WS_BIG);
    float* AB = (float*)(ws + WS_AB);
    int s0 = 0;
    { const unsigned* gcount = (const unsigned*)(ws + WS_CTL) + CW_CNT + layer * 64; build_tileoff(F, gcount); s0 = 256 * ((const LAS int*)(F.lds + LDS_TILEOFF))[64]; }
    const int* asg_e = (const int*)(ws + WS_ASG_E); const int* asg_r = (const int*)(ws + WS_ASG_R);
    const int ls0 = layer * 2 + 1, ls1 = layer * 2 + 2; const bool last = layer == 3, want_ab = (layer & 1) == 0;
    const bf16* wabf = (const bf16*)(ws + WS_WABF) + (size_t)(layer >> 1) * 2 * 16384;
    const unsigned l4_ = (unsigned)F.lane * 4u, l8_ = (unsigned)F.lane * 8u, l16_ = (unsigned)F.lane * 16u;
    for (int blk = F.bid; blk < T_ / 64; blk += F.G) {
        const int b = blk >> 6;
        const char* gate = pg8::rfl_ptr((const char*)(MOD + (size_t)(ls0 * 4 + b) * 3072 + 2048)); const char* modn = pg8::rfl_ptr((const char*)(MOD + (size_t)((last ? ls0 : ls1) * 4 + b) * 3072));
        const char* lng = pg8::rfl_ptr((const char*)(A.ln_g + (size_t)ls0 * D_)); const char* lnb = pg8::rfl_ptr((const char*)(A.ln_b + (size_t)ls0 * D_));
        f32x4 cg[4], cng[4], cnb[4], csc[4], csh[4];
#pragma unroll
        for (int j = 0; j < 4; ++j) { cg[j] = *(const f32x4*)(gate + l16_ + 1024 * j); cng[j] = *(const f32x4*)(lng + l16_ + 1024 * j); cnb[j] = *(const f32x4*)(lnb + l16_ + 1024 * j);
            csc[j] = *(const f32x4*)(modn + 4096 + l16_ + 1024 * j); csh[j] = *(const f32x4*)(modn + l16_ + 1024 * j); }
#pragma unroll 1
        for (int ps = 0; ps < 2; ++ps) {
            const int rbase = blk * 64 + ps * 32 + F.wave * 4;
            const int ev = *(const int*)(pg8::rfl_ptr((const char*)(asg_e + (size_t)rbase * 8)) + (l4_ & 127u)), rv = *(const int*)(pg8::rfl_ptr((const char*)(asg_r + (size_t)rbase * 8)) + (l4_ & 127u));
            const int idxv = 256 * ((const LAS int*)(F.lds + LDS_TILEOFF))[ev] + rv;
#pragma unroll 1
            for (int rr = 0; rr < 4; ++rr) {
                const int row = rbase + rr; f32x4 v[4], y[4]; int w[9][4]; u32x2 sh[4];
                unsigned l4 = l4_, l8 = l8_, l16 = l16_; asm volatile("" : "+v"(l4), "+v"(l8), "+v"(l16));
#pragma unroll
                for (int k = 0; k < TOPK; ++k) { const int src = __builtin_amdgcn_readlane(idxv, rr * 8 + k); const char* p = pg8::rfl_ptr(YE + (size_t)src * D_);
#pragma unroll
                    for (int j = 0; j < 4; ++j) w[k][j] = __builtin_nontemporal_load((const int*)(p + l4 + 256 * j)); }
                if (YS_BF16) { const char* p = pg8::rfl_ptr(YE + WS_YS_OFF + (size_t)row * (D_ * 2));
#pragma unroll
                    for (int j = 0; j < 4; ++j) sh[j] = *(const u32x2*)(p + l8 + 512 * j);
                } else { const char* p = pg8::rfl_ptr(YE + (size_t)(s0 + row) * D_);
#pragma unroll
                    for (int j = 0; j < 4; ++j) w[8][j] = *(const int*)(p + l4 + 256 * j);
                }
                u32x2 xb[4];
                { const char* p = pg8::rfl_ptr((const char*)(ws + WS_X) + (size_t)row * (D_ * 2));
#pragma unroll
                  for (int j = 0; j < 4; ++j) xb[j] = *(const u32x2*)(p + l8 + 512 * j); }
                __builtin_amdgcn_sched_barrier(0);
#pragma unroll
                for (int j = 0; j < 4; ++j) { y[j] = (f32x4){0.f, 0.f, 0.f, 0.f}; v[j] = (f32x4){bf_lo(xb[j].x), bf_hi(xb[j].x), bf_lo(xb[j].y), bf_hi(xb[j].y)}; }
#pragma unroll
                for (int k = 0; k < (YS_BF16 ? TOPK : TOPK + 1); ++k) {
                    asm volatile("" : "+v"(w[k][0]), "+v"(w[k][1]), "+v"(w[k][2]), "+v"(w[k][3]), "+v"(y[0]), "+v"(y[1]), "+v"(y[2]), "+v"(y[3]));
#pragma unroll
                    for (int j = 0; j < 4; ++j) { const f32x2 a = __builtin_amdgcn_cvt_pk_f32_fp8(w[k][j], false), c = __builtin_amdgcn_cvt_pk_f32_fp8(w[k][j], true);
                        y[j][0] += a[0]; y[j][1] += a[1]; y[j][2] += c[0]; y[j][3] += c[1]; }
                    __builtin_amdgcn_sched_barrier(0);
                }
#pragma unroll
                for (int j = 0; j < 4; ++j) y[j] = y[j] * (1.0f / YE_SCALE);
                if (YS_BF16) {
#pragma unroll
                    for (int j = 0; j < 4; ++j) { y[j][0] += bf_lo(sh[j].x); y[j][1] += bf_hi(sh[j].x); y[j][2] += bf_lo(sh[j].y); y[j][3] += bf_hi(sh[j].y); }
                }
                deepnorm_row_c(v, y, cg, cng, cnb);
                if (last || dry_out) { char* op = (char*)pg8::rfl_ptr((const char*)(dry_out ? dry_out : A.out) + (size_t)row * (D_ * 4));
#pragma unroll
                    for (int j = 0; j < 4; ++j) *(f32x4*)(op + l16 + 1024 * j) = v[j];
                } else { char* xp = (char*)pg8::rfl_ptr((const char*)(ws + WS_X) + (size_t)row * (D_ * 2));
#pragma unroll
                    for (int j = 0; j < 4; ++j) { u32x2 o; o.x = cvtpk(v[j][0], v[j][1]); o.y = cvtpk(v[j][2], v[j][3]); *(u32x2*)(xp + l8 + 512 * j) = o; } }
                if (!last) { char* hp = (char*)pg8::rfl_ptr((const char*)(ws + WS_H) + (size_t)row * (D_ * 2));
#pragma unroll
                    for (int j = 0; j < 4; ++j) { v[j] = v[j] * (1.0f + csc[j]) + csh[j]; u32x2 o; o.x = cvtpk(v[j][0], v[j][1]); o.y = cvtpk(v[j][2], v[j][3]); *(u32x2*)(hp + l8 + 512 * j) = o; }
                    if (want_ab) put_hilo(F.lds, F.wave * 4 + rr, F.lane, v);
                }
            }
            if (!last && want_ab) {
                __syncthreads();
                if (F.wave < 2) { const int mt = F.wave, r = F.lane & 15, q = F.lane >> 4;
                    const f32x4 acc = small_proj(F.lds, mt, F.lane, wabf, wabf + 16384);
#pragma unroll
                    for (int reg = 0; reg < 4; ++reg) AB[(size_t)(blk * 64 + ps * 32 + 16 * mt + 4 * q + reg) * 16 + r] = acc[reg]; }
                __syncthreads();
            }
        }
    }
}
DI int crow(int r, int h) { return (r & 3) + 8 * (r >> 2) + 4 * h; }
typedef short v4i16_t __attribute__((ext_vector_type(4)));
DI s16x4 vtr(const LAS unsigned char* p) { return __builtin_bit_cast(s16x4, __builtin_amdgcn_ds_read_tr16_b64_v4i16((LAS v4i16_t*)p)); }
#define MFMA32(a, b, c) __builtin_amdgcn_mfma_f32_32x32x16_bf16((a), (b), (c), 0, 0, 0)
constexpr int ATT_ORUN = 0, ATT_LRUN = 65536, ATT_VBUF = 65536 + 2048, ATT_VSTRIDE = 144, ATT_VBYTES = 32 * ATT_VSTRIDE;

#ifndef REP_A1
#define REP_A1 1
#define REP_A2 1
#endif
DI void attn_phase(const Frame& F, const Args& A) {
    unsigned char* ws = opq(A.ws);
    const bf16* QKV = (const bf16*)(ws + WS_BIG); bf16* O = (bf16*)(ws + WS_O);
    LAS unsigned char* orun = F.lds + ATT_ORUN;
    LAS float* lrun = (LAS float*)(F.lds + ATT_LRUN);
    LAS unsigned char* vbuf = F.lds + ATT_VBUF + F.wave * ATT_VBYTES;
    const int lane = F.lane, qi = lane & 31, h = lane >> 5;
    const int g16 = lane >> 4, q4 = (lane & 15) >> 2, p4 = lane & 3;
    for (int it = F.bid; it < NB_ * 16 * 8; it += F.G) {
        int item = it;
        if (F.G == 256) { const int w = it & 255, xcd = w & 7, j = w >> 3; item = (((it >> 8) * 32 + xcd * 4 + (j >> 3)) << 3) | (j & 7); }
        const int b = item >> 7, head = (item >> 3) & 15, ck = item & 7;
        for (int gi = 0; gi < 3; ++gi) {
            const int g = 2 - gi, ldil = 2 * g, Lg = S_ >> ldil;
            const size_t hb = (((size_t)g * NB_ + b) * 16 + head) * S_ * 64;
            const bf16* Qg = QKV + hb; const bf16* Kg = QKV + (size_t)3 * NB_ * 16 * S_ * 64 + hb; const bf16* Vg = QKV + (size_t)6 * NB_ * 16 * S_ * 64 + hb;
            for (int sub = F.wave; sub < 16; sub += NWAVES) {
                int r_, tile;
                if (g == 0) { r_ = 0; tile = sub; } else if (g == 1) { r_ = sub >> 2; tile = sub & 3; } else { r_ = sub; tile = 0; }
                const int m0 = ((512 * ck) >> ldil) + 32 * tile;
                const bf16* Kr = Kg + (size_t)r_ * Lg * 64; const bf16* Vr = Vg + (size_t)r_ * Lg * 64;
                f32x16 st[5]; u32x4 vv[5][4]; float mx, lsum;
#pragma unroll 1
                for (int rep1 = 0; rep1 < REP_A1; ++rep1) {
                unsigned lc = (unsigned)((lane >> 3) * 128 + (lane & 7) * 16); asm volatile("" : "+v"(lc));
                const int wofs = (lane >> 3) * ATT_VSTRIDE + (lane & 7) * 16, rofs = qi * ATT_VSTRIDE + 64 * h;
                u32x4 qv[4], kv[5][4];
                { const char* qp = pg8::rfl_ptr((const char*)(Qg + ((size_t)r_ * Lg + m0) * 64));
#pragma unroll
                  for (int i = 0; i < 4; ++i) qv[i] = *(const u32x4*)(qp + lc + 1024 * i); }
#pragma unroll
                for (int kt = 0; kt < 5; ++kt) { const int mk0 = m0 - 128 + 32 * kt; const char* kp = pg8::rfl_ptr((const char*)(Kr + (size_t)(mk0 < 0 ? 0 : mk0) * 64));
#pragma unroll
                    for (int i = 0; i < 4; ++i) kv[kt][i] = *(const u32x4*)(kp + lc + 1024 * i); }
                __builtin_amdgcn_sched_barrier(0);
                bf16x8 qf[4];
#pragma unroll
                for (int i = 0; i < 4; ++i) *(LAS u32x4*)(vbuf + wofs + 8 * i * ATT_VSTRIDE) = qv[i];
                LDS_WAIT(); asm volatile("" ::: "memory");
#pragma unroll
                for (int s = 0; s < 4; ++s) qf[s] = *(const LAS bf16x8*)(vbuf + rofs + 16 * s);
                LDS_WAIT(); asm volatile("" ::: "memory");
#pragma unroll
                for (int kt = 0; kt < 5; ++kt) {
                    const int mk0 = m0 - 128 + 32 * kt;
                    bf16x8 kf[4];
#pragma unroll
                    for (int i = 0; i < 4; ++i) *(LAS u32x4*)(vbuf + wofs + 8 * i * ATT_VSTRIDE) = kv[kt][i];
                    LDS_WAIT(); asm volatile("" ::: "memory");
#pragma unroll
                    for (int s = 0; s < 4; ++s) kf[s] = *(const LAS bf16x8*)(vbuf + rofs + 16 * s);
                    { const char* vp = pg8::rfl_ptr((const char*)(Vr + (size_t)(mk0 < 0 ? 0 : mk0) * 64));
#pragma unroll
                      for (int i = 0; i < 4; ++i) vv[kt][i] = *(const u32x4*)(vp + lc + 1024 * i); }
                    LDS_WAIT(); asm volatile("" ::: "memory");
#pragma unroll
                    for (int r = 0; r < 16; ++r) st[kt][r] = 0.f;
#pragma unroll
                    for (int s = 0; s < 4; ++s) st[kt] = MFMA32(kf[s], qf[s], st[kt]);
                    if (mk0 < 0) {
#pragma unroll
                        for (int r = 0; r < 16; ++r) st[kt][r] = -INFINITY;
                    }
                }
#pragma unroll
                for (int r = 0; r < 16; ++r) { const int kr = crow(r, h); if (kr < qi) st[0][r] = -INFINITY; if (kr > qi) st[4][r] = -INFINITY; }
                mx = -INFINITY;
#pragma unroll
                for (int kt = 0; kt < 5; ++kt)
#pragma unroll
                    for (int r = 0; r < 16; ++r) mx = fmaxf(mx, st[kt][r]);
                mx = fmaxf(mx, bperm(mx, F.lane ^ 32));
                lsum = 0.f;
#pragma unroll
                for (int kt = 0; kt < 5; ++kt)
#pragma unroll
                    for (int r = 0; r < 16; ++r) { const float p = __builtin_amdgcn_exp2f(st[kt][r] - mx); st[kt][r] = p; lsum += p; }
                lsum += bperm(lsum, F.lane ^ 32);
                }
                f32x16 oacc[2];
#pragma unroll 1
                for (int rep2 = 0; rep2 < REP_A2; ++rep2) {
#pragma unroll
                for (int r = 0; r < 16; ++r) { oacc[0][r] = 0.f; oacc[1][r] = 0.f; }
#pragma unroll
                for (int kt = 0; kt < 5; ++kt) {
                    const int mk0 = m0 - 128 + 32 * kt;
                    if (mk0 >= 0) {
#pragma unroll
                        for (int i = 0; i < 4; ++i) *(LAS u32x4*)(vbuf + ((lane >> 3) + 8 * i) * ATT_VSTRIDE + (lane & 7) * 16) = vv[kt][i];
                        LDS_WAIT(); asm volatile("" ::: "memory");
                        s16x4 flo[2][2], fhi[2][2];
#pragma unroll
                        for (int sp = 0; sp < 2; ++sp)
#pragma unroll
                            for (int dvt = 0; dvt < 2; ++dvt) {
                                const int colb = (32 * dvt + 16 * (g16 & 1) + 4 * p4) * 2;
                                flo[sp][dvt] = vtr(vbuf + (16 * sp + 4 * h + q4) * ATT_VSTRIDE + colb);
                                fhi[sp][dvt] = vtr(vbuf + (16 * sp + 8 + 4 * h + q4) * ATT_VSTRIDE + colb);
                            }
                        LDS_WAIT(); asm volatile("" ::: "memory");
#pragma unroll
                        for (int sp = 0; sp < 2; ++sp) {
                            bf16x8 pf; {
                                const unsigned w0 = cvtpk(st[kt][8 * sp + 0], st[kt][8 * sp + 1]), w1 = cvtpk(st[kt][8 * sp + 2], st[kt][8 * sp + 3]);
                                const unsigned w2 = cvtpk(st[kt][8 * sp + 4], st[kt][8 * sp + 5]), w3 = cvtpk(st[kt][8 * sp + 6], st[kt][8 * sp + 7]);
                                pf = __builtin_bit_cast(bf16x8, (u32x4){w0, w1, w2, w3}); }
#pragma unroll
                            for (int dvt = 0; dvt < 2; ++dvt) {
                                const bf16x8 vf = __builtin_shufflevector(flo[sp][dvt], fhi[sp][dvt], 0, 1, 2, 3, 4, 5, 6, 7);
                                oacc[dvt] = MFMA32(vf, pf, oacc[dvt]);
                            }
                        }
                    }
                }
                asm volatile("" : "+v"(oacc[0]), "+v"(oacc[1]));
                }
                const float inv = __builtin_amdgcn_rcpf(lsum), lse = mx + __builtin_amdgcn_logf(lsum);
                const int tl = ((32 * tile + qi) << ldil) + r_;
                float wa = 0.f, wb = 1.f;
                if (gi > 0) { const float L0 = lrun[tl]; const float M = fmaxf(L0, lse); const float ea = __builtin_amdgcn_exp2f(L0 - M), eb = __builtin_amdgcn_exp2f(lse - M);
                    const float isum = __builtin_amdgcn_rcpf(ea + eb); wa = ea * isum; wb = eb * isum; asm volatile("" ::: "memory");
                    if (h == 0) lrun[tl] = M + __builtin_amdgcn_logf(ea + eb); }
                else if (h == 0) lrun[tl] = lse;
                wb *= inv;
#pragma unroll
                for (int dvt = 0; dvt < 2; ++dvt)
#pragma unroll
                    for (int k4 = 0; k4 < 4; ++k4) {
                        const int dv = 32 * dvt + 8 * k4 + 4 * h;
                        float o0 = oacc[dvt][4 * k4 + 0] * wb, o1 = oacc[dvt][4 * k4 + 1] * wb, o2 = oacc[dvt][4 * k4 + 2] * wb, o3 = oacc[dvt][4 * k4 + 3] * wb;
                        LAS u32x2* op = (LAS u32x2*)(orun + tl * 128 + dv * 2);
                        if (gi > 0) { const u32x2 w = *op; o0 += wa * bf_lo(w.x); o1 += wa * bf_hi(w.x); o2 += wa * bf_lo(w.y); o3 += wa * bf_hi(w.y); }
                        u32x2 wo; wo.x = cvtpk(o0, o1); wo.y = cvtpk(o2, o3);
                        if (gi < 2) *op = wo;
                        else *(u32x2*)(O + ((size_t)b * S_ + 512 * ck + tl) * D_ + head * 64 + dv) = wo;
                    }
            }
            __syncthreads();
        }
    }
}

DI void gdn_post_phase(const Frame& F, const Args& A, int j) {
    unsigned char* ws = opq(A.ws); unsigned char* big = ws + WS_BIG;
    const bf16* Oraw = (const bf16*)(ws + WS_Y); const bf16* PROJ = (const bf16*)(big + BIG_PROJ); bf16* O = (bf16*)(ws + WS_O);
    const float* nw = A.gdn_norm_w + (size_t)j * 128;
    const int gw = F.bid * NWAVES + F.wave, NGW = F.G * NWAVES, lane = F.lane;
    const f32x4 nwv = *(const f32x4*)(nw + ((4 * lane) & 127));
    const unsigned l8_ = (unsigned)lane * 8u;
#pragma unroll 2
    for (int row = gw; row < T_; row += NGW) {
        unsigned l8 = l8_; asm volatile("" : "+v"(l8));
        const char* op = pg8::rfl_ptr((const char*)(Oraw + (size_t)row * D_)); const char* zp = pg8::rfl_ptr((const char*)(PROJ + (size_t)row * 4096 + 3072));
        u32x2 ow[4], zw[4];
#pragma unroll
        for (int jj = 0; jj < 4; ++jj) { ow[jj] = *(const u32x2*)(op + l8 + 512 * jj); zw[jj] = *(const u32x2*)(zp + l8 + 512 * jj); }
        f32x4 v[4];
#pragma unroll
        for (int jj = 0; jj < 4; ++jj) {
            v[jj] = (f32x4){bf_lo(ow[jj].x), bf_hi(ow[jj].x), bf_lo(ow[jj].y), bf_hi(ow[jj].y)};
            float ss = (v[jj][0] * v[jj][0] + v[jj][1] * v[jj][1]) + (v[jj][2] * v[jj][2] + v[jj][3] * v[jj][3]);
            ss += dppmov<0xB1>(ss); ss += dppmov<0x4E>(ss); ss += dppmov<0x141>(ss); ss += dppmov<0x140>(ss); ss += shx<16>(ss);
            const float rs = rsqrtf(ss * (1.0f / 128.0f) + RMS_EPS);
            const float z0 = bf_lo(zw[jj].x), z1 = bf_hi(zw[jj].x), z2 = bf_lo(zw[jj].y), z3 = bf_hi(zw[jj].y);
            v[jj][0] = v[jj][0] * rs * nwv[0] * silu_f(z0); v[jj][1] = v[jj][1] * rs * nwv[1] * silu_f(z1);
            v[jj][2] = v[jj][2] * rs * nwv[2] * silu_f(z2); v[jj][3] = v[jj][3] * rs * nwv[3] * silu_f(z3);
        }
        store_row16_bf16(O + (size_t)row * D_, lane, v);
    }
}
constexpr size_t GB_KR = 128 * MiB, GB_QR = 160 * MiB, GB_KT = 192 * MiB, GB_VT = 224 * MiB, GB_BLOB = 256 * MiB;
constexpr int BLOB_ELEMS = 28672, BLOB_W = 0, BLOB_QG = 8192, BLOB_QK = 16384, BLOB_KDT = 20480;
DI int frag_pos(int row, int k, int nks) { const int kk = k & 31; return ((((row >> 4) * nks + (k >> 5)) * 64 + ((kk >> 2) & 3) * 16 + (row & 15)) * 8) + 4 * (kk >> 4) + (kk & 3); }
#define MFMA16(a, b, c) __builtin_amdgcn_mfma_f32_16x16x32_bf16((a), (b), (c), 0, 0, 0)
DI u32x2 pk4(float a, float b, float c, float d) { u32x2 w; w.x = cvtpk(a, b); w.y = cvtpk(c, d); return w; }

DI int tile_off(int t, int c) { return t * 256 + ((((c >> 4) ^ (t & 7)) << 5) | ((c & 15) << 1)); }
template <int WH> DI void prep_conv_pass(const bf16* PROJ, const float* cw, int b, int hh, int t0, int lane, LAS unsigned char* tile, bf16* rowdst, const LAS float* escale, bool normalize, float nscale) {
    float w[4][2];
#pragma unroll
    for (int jj = 0; jj < 4; ++jj) { const f32x2 t = *(const f32x2*)(cw + (size_t)jj * 3072 + WH * 1024 + hh * 128 + 2 * lane); w[jj][0] = t.x; w[jj][1] = t.y; }
    float A0[35], A1[35];
#pragma unroll
    for (int jj = 0; jj < 3; ++jj) { const int t = t0 - 3 + jj; unsigned u = 0u;
        if (t >= 0) u = *(const unsigned*)(PROJ + ((size_t)b * S_ + t) * 4096 + WH * 1024 + hh * 128 + 2 * lane);
        A0[jj] = bf_lo(u); A1[jj] = bf_hi(u); }
#pragma unroll 1
    for (int hb = 0; hb < 2; ++hb) {
        { unsigned xin[32];
#pragma unroll
          for (int i = 0; i < 32; ++i) xin[i] = __builtin_nontemporal_load((const unsigned*)(PROJ + ((size_t)b * S_ + t0 + 32 * hb + i) * 4096 + WH * 1024 + hh * 128 + 2 * lane));
#pragma unroll
          for (int i = 0; i < 32; ++i) { A0[3 + i] = bf_lo(xin[i]); A1[3 + i] = bf_hi(xin[i]); } }
#pragma unroll
        for (int i = 0; i < 32; ++i) {
            A0[i] = w[0][0] * A0[i] + w[1][0] * A0[i + 1] + w[2][0] * A0[i + 2] + w[3][0] * A0[i + 3];
            A1[i] = w[0][1] * A1[i] + w[1][1] * A1[i + 1] + w[2][1] * A1[i + 2] + w[3][1] * A1[i + 3]; }
#pragma unroll
        for (int i = 0; i < 32; ++i) { A0[i] = silu_f(A0[i]); A1[i] = silu_f(A1[i]); }
        if (normalize) {
            float rs[32];
#pragma unroll
            for (int i = 0; i < 32; ++i) rs[i] = wave_sum(A0[i] * A0[i] + A1[i] * A1[i]);
#pragma unroll
            for (int i = 0; i < 32; ++i) { const float r = rsqrtf(rs[i] + RMS_EPS) * nscale; A0[i] *= r; A1[i] *= r; }
        }
#pragma unroll
        for (int i = 0; i < 32; ++i) {
            const int tt = 32 * hb + i;
            if (rowdst) *(unsigned*)(rowdst + (size_t)tt * 128 + 2 * lane) = cvtpk(A0[i], A1[i]);
            const float es = escale ? escale[tt] : 1.0f;
            *(LAS unsigned*)(tile + tile_off(tt, 2 * lane)) = cvtpk(A0[i] * es, A1[i] * es);
        }
#pragma unroll
        for (int jj = 0; jj < 3; ++jj) { A0[jj] = A0[32 + jj]; A1[jj] = A1[32 + jj]; }
    }
    LDS_WAIT(); asm volatile("" ::: "memory");
}
DI void tile_tr8(const LAS unsigned char* tile, int tb, int tb2, int cb, int lane, s16x4& lo, s16x4& hi) {
    const int q4 = (lane & 15) >> 2, p4 = lane & 3;
    lo = vtr(tile + tile_off(tb + q4, cb + 4 * p4)); hi = vtr(tile + tile_off(tb2 + q4, cb + 4 * p4));
}
DI void gdn_prep2_phase(const Frame& F, const Args& A, int j) {
    unsigned char* ws = opq(A.ws); unsigned char* big = ws + WS_BIG;
    const bf16* PROJ = (const bf16*)(big + BIG_PROJ);
    bf16* KR = (bf16*)(big + GB_KR); bf16* QR = (bf16*)(big + GB_QR); bf16* KT = (bf16*)(big + GB_KT); bf16* VT = (bf16*)(big + GB_VT); bf16* BLOB = (bf16*)(big + GB_BLOB);
    const float* AB = (const float*)(ws + WS_AB); float* GC = (float*)(ws + WS_GALPHA); float* GB = (float*)(ws + WS_GBETA);
    const float* cw = A.gdn_conv_w + (size_t)j * 4 * 3072;
    const int gw = F.bid * NWAVES + F.wave, NGW = F.G * NWAVES, lane = F.lane, g16 = lane >> 4, i16 = lane & 15;
    LAS unsigned char* tile = F.lds + F.wave * 16384;
    LAS float* egl = (LAS float*)(F.lds + LDS_LG + F.wave * 512); LAS float* ekl = egl + 64;
    for (int it = gw; it < NB_ * 8 * 64; it += NGW) {
        const int b = it >> 9, hh = (it >> 6) & 7, n = it & 63, t0 = 64 * n, bh = b * 8 + hh;
        { const int row = b * S_ + t0 + lane; const float a = AB[(size_t)row * 16 + hh], bl = AB[(size_t)row * 16 + 8 + hh];
          const float xs = a + A.gdn_dt_bias[j * 8 + hh]; const float ey = __expf(xs); const float sp = xs > 20.f ? xs : (ey < 1e-3f ? ey * (1.0f - 0.5f * ey) : __logf(1.0f + ey));
          float gc = -__expf(A.gdn_a_log[j * 8 + hh]) * sp;
#pragma unroll
          for (int o = 1; o < 64; o <<= 1) { const float t = bperm(gc, lane - o); if (lane >= o) gc += t; }
          const float gl = rdlane(gc, 63);
          GC[(size_t)bh * S_ + t0 + lane] = gc; GB[(size_t)bh * S_ + t0 + lane] = 1.0f / (1.0f + __expf(-bl));
          egl[lane] = __expf(gc); ekl[lane] = __expf(gl - gc); }
        LDS_WAIT(); asm volatile("" ::: "memory");
        bf16* blob = BLOB + (size_t)it * BLOB_ELEMS;
        bf16* ktc = KT + (size_t)it * 8192; bf16* vtc = VT + (size_t)it * 8192;
        const size_t rbase = ((size_t)bh * S_ + t0) * 128;
        prep_conv_pass<1>(PROJ, cw, b, hh, t0, lane, tile, KR + rbase, nullptr, true, 1.0f);
#pragma unroll 2
        for (int db = 0; db < 8; ++db)
#pragma unroll
            for (int half = 0; half < 2; ++half) { s16x4 lo, hi; const int tb = 32 * half + 8 * g16; tile_tr8(tile, tb, tb + 4, 16 * db, lane, lo, hi);
                *(bf16x8*)(ktc + (16 * db + i16) * 64 + tb) = __builtin_shufflevector(lo, hi, 0, 1, 2, 3, 4, 5, 6, 7); }
#pragma unroll 2
        for (int a = 0; a < 8; ++a)
#pragma unroll
            for (int ks = 0; ks < 2; ++ks) { s16x4 lo, hi; const int tb = 32 * ks + 4 * g16; tile_tr8(tile, tb, tb + 16, 16 * a, lane, lo, hi);
                const f32x4 e0 = *(const LAS f32x4*)(ekl + tb), e1 = *(const LAS f32x4*)(ekl + tb + 16);
                u32x4 wv;
                wv.x = cvtpk(bf_lo((unsigned)(unsigned short)lo[0]) * e0[0], bf_lo((unsigned)(unsigned short)lo[1]) * e0[1]); wv.y = cvtpk(bf_lo((unsigned)(unsigned short)lo[2]) * e0[2], bf_lo((unsigned)(unsigned short)lo[3]) * e0[3]);
                wv.z = cvtpk(bf_lo((unsigned)(unsigned short)hi[0]) * e1[0], bf_lo((unsigned)(unsigned short)hi[1]) * e1[1]); wv.w = cvtpk(bf_lo((unsigned)(unsigned short)hi[2]) * e1[2], bf_lo((unsigned)(unsigned short)hi[3]) * e1[3]);
                *(u32x4*)(blob + BLOB_KDT + ((a * 2 + ks) * 64 + lane) * 8) = wv; }
        LDS_WAIT(); asm volatile("" ::: "memory");
        prep_conv_pass<2>(PROJ, cw, b, hh, t0, lane, tile, nullptr, nullptr, false, 1.0f);
#pragma unroll 2
        for (int db = 0; db < 8; ++db)
#pragma unroll
            for (int half = 0; half < 2; ++half) { s16x4 lo, hi; const int tb = 32 * half + 8 * g16; tile_tr8(tile, tb, tb + 4, 16 * db, lane, lo, hi);
                *(bf16x8*)(vtc + (16 * db + i16) * 64 + tb) = __builtin_shufflevector(lo, hi, 0, 1, 2, 3, 4, 5, 6, 7); }
        LDS_WAIT(); asm volatile("" ::: "memory");
        prep_conv_pass<0>(PROJ, cw, b, hh, t0, lane, tile, QR + rbase, egl, true, 0.08838834764831845f);
#pragma unroll 2
        for (int tm = 0; tm < 4; ++tm)
#pragma unroll
            for (int ks = 0; ks < 4; ++ks) {
                const u32x2 p0 = *(const LAS u32x2*)(tile + tile_off(16 * tm + i16, 32 * ks + 4 * g16)), p1 = *(const LAS u32x2*)(tile + tile_off(16 * tm + i16, 32 * ks + 16 + 4 * g16));
                *(u32x4*)(blob + BLOB_QG + ((tm * 4 + ks) * 64 + lane) * 8) = (u32x4){p0.x, p0.y, p1.x, p1.y}; }
        LDS_WAIT(); asm volatile("" ::: "memory");
    }
}

DI void gdn_wy_phase(const Frame& F, const Args& A) {
    unsigned char* ws = opq(A.ws); unsigned char* big = ws + WS_BIG;
    const bf16* KR = (const bf16*)(big + GB_KR); const bf16* QR = (const bf16*)(big + GB_QR); const bf16* KT = (const bf16*)(big + GB_KT); const bf16* VT = (const bf16*)(big + GB_VT);
    bf16* BLOB = (bf16*)(big + GB_BLOB); float* U = (float*)(ws + WS_HID);
    const float* GC = (const float*)(ws + WS_GALPHA); const float* GB = (const float*)(ws + WS_GBETA);
    const int gw = F.bid * NWAVES + F.wave, NGW = F.G * NWAVES, lane = F.lane, r = lane & 15, q = lane >> 4;
    LAS float* Af = (LAS float*)(F.lds + F.wave * 16384);
    asm volatile("s_waitcnt vmcnt(0)" ::: "memory"); __builtin_amdgcn_fence(__ATOMIC_ACQUIRE, "agent");
    for (int it = gw; it < NB_ * 8 * 64; it += NGW) {
        const int bh = it >> 6, n = it & 63;
        const char* kr = pg8::rfl_ptr((const char*)(KR + ((size_t)bh * S_ + 64 * n) * 128)); const char* qr = pg8::rfl_ptr((const char*)(QR + ((size_t)bh * S_ + 64 * n) * 128));
        const char* kt = pg8::rfl_ptr((const char*)(KT + (size_t)it * 8192)); const char* vt = pg8::rfl_ptr((const char*)(VT + (size_t)it * 8192));
        char* blob = (char*)pg8::rfl_ptr((const char*)(BLOB + (size_t)it * BLOB_ELEMS)); char* ub = (char*)pg8::rfl_ptr((const char*)(U + (size_t)it * 8192));
        const unsigned lrow = (unsigned)(r * 128 + 8 * q) * 2u, ltr = (unsigned)(r * 64 + 8 * q) * 2u, lfrag = (unsigned)(q * 16 + r) * 16u;
        const float gcl = GC[(size_t)bh * S_ + 64 * n + lane], bel = GB[(size_t)bh * S_ + 64 * n + lane];
        __builtin_amdgcn_wave_barrier();
        bf16x8 kfr[4][4], qfr[4][4];
#pragma unroll
        for (int t4 = 0; t4 < 4; ++t4)
#pragma unroll
            for (int ks = 0; ks < 4; ++ks) { kfr[t4][ks] = *(const bf16x8*)(kr + lrow + (16 * t4 * 128 + 32 * ks) * 2); qfr[t4][ks] = *(const bf16x8*)(qr + lrow + (16 * t4 * 128 + 32 * ks) * 2); }
#pragma unroll
        for (int ti = 0; ti < 4; ++ti) {
            const float gi = bperm(gcl, 16 * ti + r), bi = bperm(bel, 16 * ti + r);
#pragma unroll
            for (int tj = 0; tj < 4; ++tj) {
                char* qkdst = blob + (BLOB_QK + ((ti * 2 + (tj >> 1)) * 64) * 8 + 4 * (tj & 1)) * 2 + lfrag;
                if (tj > ti) { *(u32x2*)qkdst = (u32x2){0u, 0u}; *(LAS f32x4*)(Af + (16 * ti + r) * 64 + 16 * tj + 4 * q) = (f32x4){0.f, 0.f, 0.f, 0.f}; continue; }
                f32x4 p1 = (f32x4){0.f, 0.f, 0.f, 0.f}, p2 = p1;
#pragma unroll
                for (int ks = 0; ks < 4; ++ks) { p1 = MFMA16(kfr[tj][ks], kfr[ti][ks], p1); p2 = MFMA16(kfr[tj][ks], qfr[ti][ks], p2); }
                const int i = 16 * ti + r; f32x4 av, qv;
#pragma unroll
                for (int reg = 0; reg < 4; ++reg) { const int jx = 16 * tj + 4 * q + reg; const float gj = bperm(gcl, jx);
                    const float dec = (jx <= i) ? __expf(gi - gj) : 0.f;
                    av[reg] = (jx < i) ? bi * p1[reg] * dec : 0.f; qv[reg] = p2[reg] * dec; }
                *(LAS f32x4*)(Af + i * 64 + 16 * tj + 4 * q) = av;
                *(u32x2*)qkdst = pk4(qv[0], qv[1], qv[2], qv[3]);
                asm volatile("" ::: "memory");
            }
        }
        LDS_WAIT(); asm volatile("" ::: "memory");
#pragma unroll 1
        for (int i0 = 0; i0 < 64; i0 += 4) {
            float a0 = (i0 + 0 == lane) ? 1.0f : 0.0f, a1 = (i0 + 1 == lane) ? 1.0f : 0.0f, a2 = (i0 + 2 == lane) ? 1.0f : 0.0f, a3 = (i0 + 3 == lane) ? 1.0f : 0.0f;
#pragma unroll 2
            for (int j4 = 0; j4 < (i0 >> 2); ++j4) {
                const float t0 = Af[(4 * j4 + 0) * 64 + lane], t1 = Af[(4 * j4 + 1) * 64 + lane], t2 = Af[(4 * j4 + 2) * 64 + lane], t3 = Af[(4 * j4 + 3) * 64 + lane];
                const f32x4 r0 = *(const LAS f32x4*)(Af + (i0 + 0) * 64 + 4 * j4), r1 = *(const LAS f32x4*)(Af + (i0 + 1) * 64 + 4 * j4);
                const f32x4 r2 = *(const LAS f32x4*)(Af + (i0 + 2) * 64 + 4 * j4), r3 = *(const LAS f32x4*)(Af + (i0 + 3) * 64 + 4 * j4);
                a0 -= r0[0] * t0 + r0[1] * t1 + r0[2] * t2 + r0[3] * t3; a1 -= r1[0] * t0 + r1[1] * t1 + r1[2] * t2 + r1[3] * t3;
                a2 -= r2[0] * t0 + r2[1] * t1 + r2[2] * t2 + r2[3] * t3; a3 -= r3[0] * t0 + r3[1] * t1 + r3[2] * t2 + r3[3] * t3;
            }
            const f32x4 d1 = *(const LAS f32x4*)(Af + (i0 + 1) * 64 + i0), d2 = *(const LAS f32x4*)(Af + (i0 + 2) * 64 + i0), d3 = *(const LAS f32x4*)(Af + (i0 + 3) * 64 + i0);
            a1 -= d1[0] * a0; a2 -= d2[0] * a0 + d2[1] * a1; a3 -= d3[0] * a0 + d3[1] * a1 + d3[2] * a2;
            LDS_WAIT(); asm volatile("" ::: "memory");
            Af[(i0 + 0) * 64 + lane] = a0; Af[(i0 + 1) * 64 + lane] = a1; Af[(i0 + 2) * 64 + lane] = a2; Af[(i0 + 3) * 64 + lane] = a3;
            LDS_WAIT(); asm volatile("" ::: "memory");
        }
        bf16x8 tuf[4][2], twf[4][2];
        {
            const float* gcp = GC + (size_t)bh * S_ + 64 * n; const float* gbp = GB + (size_t)bh * S_ + 64 * n;
#pragma unroll
            for (int ks = 0; ks < 2; ++ks) {
                float su[8], sw[8];
#pragma unroll
                for (int h4 = 0; h4 < 2; ++h4) { const f32x4 bv = *(const f32x4*)(gbp + 32 * ks + 8 * q + 4 * h4), gv = *(const f32x4*)(gcp + 32 * ks + 8 * q + 4 * h4);
#pragma unroll
                    for (int e = 0; e < 4; ++e) { su[4 * h4 + e] = bv[e]; sw[4 * h4 + e] = -bv[e] * __expf(gv[e]); } }
#pragma unroll
                for (int tm = 0; tm < 4; ++tm) {
                    const f32x4 x0 = *(const LAS f32x4*)(Af + (16 * tm + r) * 64 + 32 * ks + 8 * q), x1 = *(const LAS f32x4*)(Af + (16 * tm + r) * 64 + 32 * ks + 8 * q + 4);
                    tuf[tm][ks] = __builtin_bit_cast(bf16x8, (u32x4){cvtpk(x0[0] * su[0], x0[1] * su[1]), cvtpk(x0[2] * su[2], x0[3] * su[3]), cvtpk(x1[0] * su[4], x1[1] * su[5]), cvtpk(x1[2] * su[6], x1[3] * su[7])});
                    twf[tm][ks] = __builtin_bit_cast(bf16x8, (u32x4){cvtpk(x0[0] * sw[0], x0[1] * sw[1]), cvtpk(x0[2] * sw[2], x0[3] * sw[3]), cvtpk(x1[0] * sw[4], x1[1] * sw[5]), cvtpk(x1[2] * sw[6], x1[3] * sw[7])});
                }
            }
        }
        LDS_WAIT(); asm volatile("" ::: "memory");
        {
#pragma unroll
            for (int w8 = 0; w8 < 8; ++w8) {
                bf16x8 vb[2];
#pragma unroll
                for (int ks = 0; ks < 2; ++ks) vb[ks] = *(const bf16x8*)(vt + ltr + (16 * w8 * 64 + 32 * ks) * 2);
#pragma unroll
                for (int tm = 0; tm < 4; ++tm) { f32x4 acc = (f32x4){0.f, 0.f, 0.f, 0.f};
#pragma unroll
                    for (int ks = 0; ks < 2; ++ks) acc = MFMA16(tuf[tm][ks], vb[ks], acc);
                    *(f32x4*)(ub + (unsigned)lane * 16u + ((w8 * 4 + tm) * 64) * 16) = acc; }
            }
        }
        {
#pragma unroll
            for (int a = 0; a < 8; ++a) {
                bf16x8 ka[2];
#pragma unroll
                for (int ks = 0; ks < 2; ++ks) ka[ks] = *(const bf16x8*)(kt + ltr + (16 * a * 64 + 32 * ks) * 2);
#pragma unroll
                for (int ti = 0; ti < 4; ++ti) { f32x4 acc = (f32x4){0.f, 0.f, 0.f, 0.f};
#pragma unroll
                    for (int ks = 0; ks < 2; ++ks) acc = MFMA16(ka[ks], twf[ti][ks], acc);
                    *(u32x2*)(blob + (BLOB_W + ((ti * 4 + (a >> 1)) * 64) * 8 + 4 * (a & 1)) * 2 + lfrag) = pk4(acc[0], acc[1], acc[2], acc[3]); }
            }
        }
        LDS_WAIT(); asm volatile("" ::: "memory");
    }
}

constexpr int SCAN_BUF = BLOB_ELEMS * 2;
DI bf16x8 pack8(const f32x4& lo, const f32x4& hi) { return __builtin_bit_cast(bf16x8, (u32x4){cvtpk(lo[0], lo[1]), cvtpk(lo[2], lo[3]), cvtpk(hi[0], hi[1]), cvtpk(hi[2], hi[3])}); }
DI void ld16_asm(u32x4& dst, const char* sbase, unsigned voff) { asm volatile("global_load_dwordx4 %0, %1, %2" : "=v"(dst) : "v"(voff), "s"(sbase) : "memory"); }
#define SCAN_LOAD(RSET, chunk) do { const char* _cb = pg8::rfl_ptr(src + (size_t)(chunk) * SCAN_BUF); \
    _Pragma("unroll") for (int i = 0; i < 14; ++i) ld16_asm(RSET[i], pg8::rfl_ptr(_cb + i * 4096), ltid16); } while (0)
#define SCAN_PUT(RSET, BUF) do { _Pragma("unroll") for (int i = 0; i < 14; ++i) *(LAS u32x4*)(F.lds + (BUF) * SCAN_BUF + i * 4096 + ltid16) = RSET[i]; } while (0)
#define SCAN_LSTEP(n_, BUFN, RFREE, RNEXT) do { const int n = (n_); \
    if (n + 3 < 64) { SCAN_LOAD(RFREE, n + 3); asm volatile("s_waitcnt vmcnt(28)" ::: "memory"); } else { asm volatile("s_waitcnt vmcnt(0)" ::: "memory"); } \
    __builtin_amdgcn_sched_barrier(0); \
    if (n + 1 < 64) SCAN_PUT(RNEXT, BUFN); \
    asm volatile("s_waitcnt lgkmcnt(0)" ::: "memory"); __builtin_amdgcn_s_barrier(); asm volatile("" ::: "memory"); } while (0)
#define SCAN_CSTEP(n_, BUFC, UC) do { const int n = (n_); \
        const LAS unsigned char* buf = F.lds + (BUFC) * SCAN_BUF; \
        f32x4 vn[4]; \
        _Pragma("unroll") for (int tm = 0; tm < 4; ++tm) vn[tm] = UC[tm]; \
        if (n + 2 < 64) { const char* u2 = pg8::rfl_ptr(ubase + (size_t)(n + 2) * 8192 * 4); _Pragma("unroll") for (int tm = 0; tm < 4; ++tm) UC[tm] = *(const f32x4*)(u2 + lane16 + tm * 1024); } \
        if (n > 0) { char* op = (char*)pg8::rfl_ptr(obase + (size_t)(64 * (n - 1)) * D_ * 2); \
            _Pragma("unroll") for (int tm = 0; tm < 4; ++tm) _Pragma("unroll") for (int reg = 0; reg < 4; ++reg) *(bf16*)(op + olane + (16 * tm + reg) * D_ * 2) = (bf16)cvtpk(o[tm][reg], 0.f); } \
        const float glast = rdlane(gl_all, n); \
        bf16x8 sb[4]; \
        _Pragma("unroll") for (int ks = 0; ks < 4; ++ks) sb[ks] = pack8(S[2 * ks], S[2 * ks + 1]); \
          \
        bf16x8 fw[16], fq[16], fk[8], fd[16]; bf16x8 vb[2]; \
        _Pragma("unroll") for (int i = 0; i < 16; ++i) fw[i] = *(const LAS bf16x8*)(buf + BLOB_W * 2 + (i * 64 + lane) * 16); \
        __builtin_amdgcn_sched_barrier(0); \
        _Pragma("unroll") for (int i = 0; i < 16; ++i) fq[i] = *(const LAS bf16x8*)(buf + BLOB_QG * 2 + (i * 64 + lane) * 16); \
        __builtin_amdgcn_sched_barrier(0); \
        _Pragma("unroll") for (int tm = 0; tm < 4; ++tm) _Pragma("unroll") for (int ks = 0; ks < 4; ++ks) vn[tm] = MFMA16(fw[tm * 4 + ks], sb[ks], vn[tm]); \
        __builtin_amdgcn_sched_barrier(0); \
        _Pragma("unroll") for (int i = 0; i < 8; ++i) fk[i] = *(const LAS bf16x8*)(buf + BLOB_QK * 2 + (i * 64 + lane) * 16); \
        __builtin_amdgcn_sched_barrier(0); \
        _Pragma("unroll") for (int tm = 0; tm < 4; ++tm) { o[tm] = (f32x4){0.f, 0.f, 0.f, 0.f}; \
            _Pragma("unroll") for (int ks = 0; ks < 4; ++ks) o[tm] = MFMA16(fq[tm * 4 + ks], sb[ks], o[tm]); } \
        _Pragma("unroll") for (int k2 = 0; k2 < 2; ++k2) vb[k2] = pack8(vn[2 * k2], vn[2 * k2 + 1]); \
        __builtin_amdgcn_sched_barrier(0); \
        _Pragma("unroll") for (int i = 0; i < 16; ++i) fd[i] = *(const LAS bf16x8*)(buf + BLOB_KDT * 2 + (i * 64 + lane) * 16); \
        __builtin_amdgcn_sched_barrier(0); \
        _Pragma("unroll") for (int tm = 0; tm < 4; ++tm) _Pragma("unroll") for (int k2 = 0; k2 < 2; ++k2) o[tm] = MFMA16(fk[tm * 2 + k2], vb[k2], o[tm]); \
        __builtin_amdgcn_sched_barrier(0); \
        _Pragma("unroll") for (int a = 0; a < 8; ++a) { S[a] = S[a] * glast; \
            _Pragma("unroll") for (int k2 = 0; k2 < 2; ++k2) S[a] = MFMA16(fd[a * 2 + k2], vb[k2], S[a]); } \
    asm volatile("s_waitcnt lgkmcnt(0)" ::: "memory"); __builtin_amdgcn_s_barrier(); asm volatile("" ::: "memory"); } while (0)

DI void gdn_scan2_phase(const Frame& F, const Args& A) {
    unsigned char* ws = opq(A.ws); unsigned char* big = ws + WS_BIG;
    const bf16* BLOB = (const bf16*)(big + GB_BLOB); const float* U = (const float*)(ws + WS_HID); bf16* Oraw = (bf16*)(ws + WS_Y);
    const float* GC = (const float*)(ws + WS_GALPHA);
    const int lane = F.lane, r = lane & 15, q = lane >> 4, w = F.wave;
    for (int it2 = F.bid; it2 < NB_ * 8 * 2; it2 += F.G) {
        const int item = it2 >> 1, half = it2 & 1, b = item >> 3, hh = item & 7, dvw = 4 * half + (w & 3);
        const char* src = pg8::rfl_ptr((const char*)(BLOB + (size_t)item * 64 * BLOB_ELEMS));
        __syncthreads();
        if (w >= 4) {
            const unsigned ltid16 = (unsigned)((w & 3) * 64 + lane) * 16u;
            u32x4 r0[14], r1[14], r2[14];
            SCAN_LOAD(r0, 0); SCAN_LOAD(r1, 1); SCAN_LOAD(r2, 2); asm volatile("s_waitcnt vmcnt(28)" ::: "memory"); __builtin_amdgcn_sched_barrier(0); SCAN_PUT(r0, 0);
            asm volatile("s_waitcnt lgkmcnt(0)" ::: "memory"); __builtin_amdgcn_s_barrier(); asm volatile("" ::: "memory");
#pragma unroll 1
            for (int n6 = 0; n6 < 60; n6 += 6) {
                SCAN_LSTEP(n6 + 0, 1, r0, r1); SCAN_LSTEP(n6 + 1, 0, r1, r2); SCAN_LSTEP(n6 + 2, 1, r2, r0);
                SCAN_LSTEP(n6 + 3, 0, r0, r1); SCAN_LSTEP(n6 + 4, 1, r1, r2); SCAN_LSTEP(n6 + 5, 0, r2, r0);
            }
            SCAN_LSTEP(60, 1, r0, r1); SCAN_LSTEP(61, 0, r1, r2); SCAN_LSTEP(62, 1, r2, r0); SCAN_LSTEP(63, 0, r0, r1);
        } else {
            f32x4 S[8];
#pragma unroll
            for (int a = 0; a < 8; ++a) S[a] = (f32x4){0.f, 0.f, 0.f, 0.f};
            const char* ubase = pg8::rfl_ptr((const char*)(U + (size_t)item * 64 * 8192 + (size_t)(dvw * 4) * 256));
            const char* obase = pg8::rfl_ptr((const char*)(Oraw + (size_t)b * S_ * D_ + hh * 128 + 16 * dvw));
            const unsigned lane16 = (unsigned)lane * 16u, olane = (unsigned)((4 * q) * D_ + r) * 2u;
            const float gl_all = __expf(GC[(size_t)item * S_ + 64 * lane + 63]);
            f32x4 ua[4], ub[4], o[4];
#pragma unroll
            for (int tm = 0; tm < 4; ++tm) { ua[tm] = *(const f32x4*)(ubase + lane16 + tm * 1024); ub[tm] = *(const f32x4*)(ubase + 8192 * 4 + lane16 + tm * 1024); o[tm] = (f32x4){0.f, 0.f, 0.f, 0.f}; }
            asm volatile("s_waitcnt lgkmcnt(0)" ::: "memory"); __builtin_amdgcn_s_barrier(); asm volatile("" ::: "memory");
#pragma unroll 1
            for (int n2 = 0; n2 < 64; n2 += 2) { SCAN_CSTEP(n2, 0, ua); SCAN_CSTEP(n2 + 1, 1, ub); }
            { char* op = (char*)obase + (size_t)(64 * 63) * D_ * 2;
#pragma unroll
              for (int tm = 0; tm < 4; ++tm)
#pragma unroll
                  for (int reg = 0; reg < 4; ++reg) *(bf16*)(op + olane + (16 * tm + reg) * D_ * 2) = (bf16)cvtpk(o[tm][reg], 0.f); }
        }
    }
}
#undef SCAN_LSTEP
#undef SCAN_CSTEP
#undef SCAN_LOAD
#undef SCAN_PUT
constexpr int N_PHASES = 42;
#ifndef MK_FUSED
#define MK_FUSED 1
#endif

#if MK_FUSED
typedef const __attribute__((address_space(4))) Args* CArgsP;
DI Args fresh_args() {
#if defined(__HIP_DEVICE_COMPILE__)
    CArgsP kp = (CArgsP)__builtin_amdgcn_kernarg_segment_ptr(); asm volatile("" : "+s"(kp)); Args a = *kp;
    a.x = asg(a.x); a.c = asg(a.c); a.pos = asg(a.pos); a.ada_w = asg(a.ada_w); a.ada_b = asg(a.ada_b); a.ln_g = asg(a.ln_g); a.ln_b = asg(a.ln_b);
    a.attn_w_in = asg(a.attn_w_in); a.attn_w_out = asg(a.attn_w_out); a.gdn_w_in = asg(a.gdn_w_in); a.gdn_conv_w = asg(a.gdn_conv_w); a.gdn_a_log = asg(a.gdn_a_log); a.gdn_dt_bias = asg(a.gdn_dt_bias);
    a.gdn_norm_w = asg(a.gdn_norm_w); a.gdn_w_out = asg(a.gdn_w_out); a.router_w = asg(a.router_w); a.router_bias = asg(a.router_bias); a.ew1 = asg(a.ew1); a.ew3 = asg(a.ew3); a.ew2 = asg(a.ew2);
    a.sw1 = asg(a.sw1); a.sw3 = asg(a.sw3); a.sw2 = asg(a.sw2); a.out = asg(a.out); a.ws = asg(a.ws);
    return a;
#else
    return Args{};
#endif
}
DI Frame fresh_frame(int wave_s) { Frame F; int g = gridDim.x; asm volatile("" : "+s"(g)); int b = blockIdx.x; asm volatile("" : "+s"(b)); unsigned l = 0u; asm volatile("" : "+s"(l));
    int w = wave_s; asm volatile("" : "+s"(w)); int ln; asm volatile("v_mbcnt_lo_u32_b32 %0, -1, 0\n\tv_mbcnt_hi_u32_b32 %0, -1, %0" : "=&v"(ln));
    F.lds = (LAS unsigned char*)(size_t)l; F.tid = w * 64 + ln; F.lane = ln; F.wave = w; F.G = g; F.bid = b; return F; }
#define PHF() const Args A = fresh_args(); const Frame F = fresh_frame(wave_s); \
    unsigned char* ws = opq(A.ws); LAS int* idxlds = (LAS int*)(F.lds + LDS_IDX); const LAS int* tileoff = (const LAS int*)(F.lds + LDS_TILEOFF); (void)ws; (void)idxlds; (void)tileoff;
DI void ph_pro(const int wave_s) { PHF(); prologue_phase(F, A); convert_experts(F, A, 0, 0, 0, F.G); }
DI void ph_modx(const int wave_s) { PHF(); modx_phase(F, A); }
DI void ph_attn(const int wave_s) { PHF(); attn_phase(F, A); }
DI void ph_lnr(const int wave_s, int L) { PHF(); if (L == 0) ln_router_phase<true>(F, A, L); else ln_router_phase<false>(F, A, L); }
DI void ph_lnr_dry(const int wave_s, int L) { PHF(); if (L == 0) ln_router_phase<true>(F, A, L, true); else ln_router_phase<false>(F, A, L, true); }
DI void ph_scat(const int wave_s, int L) { PHF(); moe_scatter_phase(F, A, L); }
DI void ph_lnm(const int wave_s, int L) { PHF(); ln_moe_phase(F, A, L, nullptr); }
DI void ph_lnm_dry(const int wave_s, int L) { PHF(); ln_moe_phase(F, A, L, (float*)(ws + WS_Y)); }
DI void ph_gprep(const int wave_s, int lp) { PHF(); gdn_prep2_phase(F, A, lp); }
DI void ph_gwy(const int wave_s) { PHF(); gdn_wy_phase(F, A); }
DI void ph_gscan(const int wave_s, int L) { PHF(); gdn_scan2_phase(F, A); if (F.G > 128) { convert_experts(F, A, L, 0, 64, F.G - 64); if (L == 1) convert_experts(F, A, 2, 1, 64, F.G - 64); } else { convert_experts(F, A, L, 0, 0, F.G); if (L == 1) convert_experts(F, A, 2, 1, 0, F.G); } }
DI void ph_gpost(const int wave_s, int lp) { PHF(); gdn_post_phase(F, A, lp); }
DI void ph_gemm_qkv(const int wave_s, int lp) { PHF();
    pg8::DenseOrder S; S.init(WS_H, WS_WA_IN + (size_t)lp * 9216 * D_ * 2, T_, 9216, D_, F.G, F.bid);
    pg8::EpiQKV E{(bf16*)(ws + WS_BIG), (const float*)(ws + WS_COS), (const float*)(ws + WS_SIN)};
    pg8::gemm_phase<pg8::EpiQKV, pg8::DenseOrder, true, true>(F.tid, ws, F.lds, idxlds, D_, S, E); }
DI void ph_gemm_out(const int wave_s, int lp, int isg) { PHF();
    pg8::DenseOrder S; S.init(WS_O, (isg ? WS_WG_OUT : WS_WA_OUT) + (size_t)lp * D_ * D_ * 2, T_, D_, D_, F.G, F.bid);
    pg8::EpiBf16 E{(bf16*)(ws + WS_Y), D_};
    pg8::gemm_phase<pg8::EpiBf16, pg8::DenseOrder, true, true>(F.tid, ws, F.lds, idxlds, D_, S, E); }
DI void ph_gemm_gin(const int wave_s, int lp) { PHF();
    pg8::DenseOrder S; S.init(WS_H, WS_WG_IN + (size_t)lp * 4096 * D_ * 2, T_, 4096, D_, F.G, F.bid);
    pg8::EpiBf16 E{(bf16*)(ws + WS_BIG + BIG_PROJ), 4096};
    pg8::gemm_phase<pg8::EpiBf16, pg8::DenseOrder, true, true>(F.tid, ws, F.lds, idxlds, D_, S, E); }
DI void ph_moe1(const int wave_s, int L) { PHF();
    const unsigned* gcount = (const unsigned*)(ws + WS_CTL) + CW_CNT + L * 64;
    build_tileoff(F, gcount);
    pg8::MoeOrder<true> S; S.A = (unsigned)WS_H; S.Bt = (unsigned)(L == 2 ? WS_WEB : WS_WE1); S.K = D_; S.nct_log = 1; S.nunits = __builtin_amdgcn_readfirstlane(tileoff[65]) * 2; S.G = F.G; S.c = F.bid;
    S.idxoff = (unsigned)WS_ETOK; S.tileoff = tileoff; S.ecnt = (const LAS int*)(F.lds + LDS_ECNT); S.bstride = (unsigned)(512 * D_ * 2);
    pg8::EpiSwiGLU E{(bf16*)(ws + WS_HID)};
    pg8::gemm_phase<pg8::EpiSwiGLU, pg8::MoeOrder<true>, true, true>(F.tid, ws, F.lds, idxlds, D_, S, E); }
DI void ph_moe2(const int wave_s, int L) { PHF();
    const unsigned* gcount = (const unsigned*)(ws + WS_CTL) + CW_CNT + L * 64;
    build_tileoff(F, gcount);
    pg8::MoeOrder<false> S; S.A = (unsigned)WS_HID; S.Bt = (unsigned)(L == 2 ? WS_WEB + 65 * MiB : WS_WE2); S.K = 256; S.nct_log = 2; S.nunits = __builtin_amdgcn_readfirstlane(tileoff[(YS_BF16 && !YS_MERGED) ? 64 : 65]) * 4; S.G = F.G; S.c = F.bid;
    S.idxoff = (unsigned)WS_EW; S.tileoff = tileoff; S.ecnt = (const LAS int*)(F.lds + LDS_ECNT); S.bstride = (unsigned)(D_ * 256 * 2);
    pg8::EpiScale E{ws + WS_BIG, 256 * __builtin_amdgcn_readfirstlane(tileoff[64])};
    pg8::gemm_phase<pg8::EpiScale, pg8::MoeOrder<false>, false, false>(F.tid, ws, F.lds, idxlds, 256, S, E); }
DI void ph_moe2s(const int wave_s, int L) { PHF();
    __syncthreads();
    const size_t s0 = (size_t)(256 * __builtin_amdgcn_readfirstlane(((const LAS int*)(F.lds + LDS_TILEOFF))[64]));
    pg8::DenseOrder S; S.init(WS_HID + s0 * 256 * 2, (L == 2 ? WS_WEB + 65 * MiB : WS_WE2) + (size_t)NEXP * D_ * 256 * 2, T_, D_, 256, F.G, F.bid);
    pg8::EpiBf16 E{(bf16*)(ws + WS_BIG + WS_YS_OFF), D_};
    pg8::gemm_phase<pg8::EpiBf16, pg8::DenseOrder, false, false>(F.tid, ws, F.lds, idxlds, 256, S, E); }

DI void grid_bar(const int wave_s) { PHF(); XcdBarrier b; b.bar = (unsigned*)(ws + WS_CTL) + CW_BAR; volatile LAS unsigned* misc = (volatile LAS unsigned*)(F.lds + LDS_MISC); b.st = misc + 8;
    b.x = (unsigned)__builtin_amdgcn_readfirstlane((int)misc[10]); xcd_barrier(b, F.tid); }
__global__ void __launch_bounds__(NTHR, 2) mk_fwd(Args Ain) {
    extern __shared__ __attribute__((aligned(16))) unsigned char lds_raw[];
    LAS unsigned char* lds = (LAS unsigned char*)lds_raw;
    for (int u = threadIdx.x; u < (LDS_BYTES - RING_BYTES) / 4; u += NTHR) ((LAS unsigned*)(lds + RING_BYTES))[u] = 0u;
    __syncthreads();
    const int wave_s = __builtin_amdgcn_readfirstlane((int)threadIdx.x >> 6);
    { XcdBarrier bar = xcd_barrier_post((unsigned*)(Ain.ws + WS_CTL) + CW_BAR, (volatile LAS unsigned*)(lds + LDS_MISC) + 8);
      if (threadIdx.x == 0) ((volatile LAS unsigned*)(lds + LDS_MISC))[10] = bar.x; }
    __syncthreads();
#ifndef REP_BAR
#define REP_BAR 1
#define REP_PRO 1
#define REP_POST 1
#define REP_QKV 1
#define REP_OUT 1
#define REP_GIN 1
#define REP_M1 1
#define REP_M2 1
#define REP_LNM 1
#define REP_LNR 1
#endif
#define GBAR() do { for (int _b = 0; _b < REP_BAR; ++_b) grid_bar(wave_s); } while (0)
#ifndef REP_ATTN
#define REP_ATTN 1
#define REP_SCAN 1
#define REP_GEMM 1
#define REP_PREP 1
#define REP_CONV 1
#define REP_WY 1
#endif
    for (int r = 0; r < REP_PRO; ++r) { ph_pro(wave_s); GBAR(); }
    ph_modx(wave_s); GBAR();
#pragma unroll 1
    for (int L = 0; L < 4; ++L) {
        const int lp = L >> 1;
        if ((L & 1) == 0) { for (int r = 0; r < REP_QKV; ++r) { ph_gemm_qkv(wave_s, lp); GBAR(); } for (int r = 0; r < REP_ATTN; ++r) { ph_attn(wave_s); GBAR(); } for (int r = 0; r < REP_OUT; ++r) { ph_gemm_out(wave_s, lp, 0); GBAR(); } }
        else { for (int r = 0; r < REP_GIN; ++r) { ph_gemm_gin(wave_s, lp); GBAR(); } for (int r = 0; r < REP_PREP; ++r) { ph_gprep(wave_s, lp); GBAR(); } for (int r = 0; r < REP_WY; ++r) { ph_gwy(wave_s); GBAR(); } for (int r = 0; r < REP_SCAN; ++r) { ph_gscan(wave_s, L); GBAR(); } for (int r = 0; r < REP_POST; ++r) { ph_gpost(wave_s, lp); GBAR(); } for (int r = 0; r < REP_OUT; ++r) { ph_gemm_out(wave_s, lp, 1); GBAR(); } }
        for (int r = 1; r < REP_LNR; ++r) { ph_lnr_dry(wave_s, L); GBAR(); }
        ph_lnr(wave_s, L); GBAR();
        for (int r = 0; r < REP_M1; ++r) { ph_moe1(wave_s, L); GBAR(); }
        for (int r = 0; r < REP_M2; ++r) { ph_moe2(wave_s, L); if (YS_BF16 && !YS_MERGED) ph_moe2s(wave_s, L); GBAR(); }
        for (int r = 1; r < REP_LNM; ++r) { ph_lnm_dry(wave_s, L); GBAR(); }
        ph_lnm(wave_s, L); if (L < 3) GBAR();
    }
#undef GBAR
}
#else

#define MKF() extern __shared__ __attribute__((aligned(16))) unsigned char lds_raw[]; Frame F; F.lds = (LAS unsigned char*)lds_raw; F.tid = threadIdx.x; F.lane = F.tid & 63; \
    F.wave = __builtin_amdgcn_readfirstlane(F.tid >> 6); F.G = gridDim.x; F.bid = blockIdx.x; unsigned char* ws = opq(A.ws); LAS int* idxlds = (LAS int*)(F.lds + LDS_IDX); \
    const LAS int* tileoff = (const LAS int*)(F.lds + LDS_TILEOFF); (void)ws; (void)idxlds; (void)tileoff; \
    for (int u = F.tid; u < (LDS_BYTES - RING_BYTES) / 4; u += NTHR) ((LAS unsigned*)(F.lds + RING_BYTES))[u] = 0u; __syncthreads();
__global__ void __launch_bounds__(NTHR, 2) k_pro(Args A) { MKF(); prologue_phase(F, A); }
__global__ void __launch_bounds__(NTHR, 2) k_modx(Args A) { MKF(); modx_phase(F, A); }
__global__ void __launch_bounds__(NTHR, 2) k_attn(Args A) { MKF(); attn_phase(F, A); }
__global__ void __launch_bounds__(NTHR, 2) k_lnr(Args A) { MKF(); const int L = A.ph_lo; ln_router_phase<false>(F, A, L); }
__global__ void __launch_bounds__(NTHR, 2) k_scat(Args A) { MKF(); moe_scatter_phase(F, A, A.ph_lo); convert_experts(F, A, A.ph_lo); }
__global__ void __launch_bounds__(NTHR, 2) k_lnm(Args A) { MKF(); const int L = A.ph_lo; ln_moe_phase(F, A, L, nullptr); }
__global__ void __launch_bounds__(NTHR, 2) k_gprep(Args A) { MKF(); gdn_prep_phase(F, A, A.ph_lo); }
__global__ void __launch_bounds__(NTHR, 2) k_gscan(Args A) { MKF(); gdn_scan_phase(F, A); }
__global__ void __launch_bounds__(NTHR, 2) k_gpost(Args A) { MKF(); gdn_post_phase(F, A, A.ph_lo); }
__global__ void __launch_bounds__(NTHR, 2) k_gemm_qkv(Args A) { MKF(); const int lp = A.ph_lo;
    pg8::DenseOrder S; S.init(WS_H, WS_WA_IN + (size_t)lp * 9216 * D_ * 2, T_, 9216, D_, F.G, F.bid);
    pg8::EpiQKV E{(bf16*)(ws + WS_BIG), (const float*)(ws + WS_COS), (const float*)(ws + WS_SIN)};
    pg8::gemm_phase<pg8::EpiQKV, pg8::DenseOrder, true, true>(F.tid, ws, F.lds, idxlds, D_, S, E); }
__global__ void __launch_bounds__(NTHR, 2) k_gemm_out(Args A) { MKF(); const int lp = A.ph_lo >> 1, isg = A.ph_lo & 1;
    pg8::DenseOrder S; S.init(WS_O, (isg ? WS_WG_OUT : WS_WA_OUT) + (size_t)lp * D_ * D_ * 2, T_, D_, D_, F.G, F.bid);
    pg8::EpiF32 E{(float*)(ws + WS_Y), D_};
    pg8::gemm_phase<pg8::EpiF32, pg8::DenseOrder, true, true>(F.tid, ws, F.lds, idxlds, D_, S, E); }
__global__ void __launch_bounds__(NTHR, 2) k_gemm_gin(Args A) { MKF(); const int lp = A.ph_lo;
    pg8::DenseOrder S; S.init(WS_H, WS_WG_IN + (size_t)lp * 4096 * D_ * 2, T_, 4096, D_, F.G, F.bid);
    pg8::EpiBf16 E{(bf16*)(ws + WS_BIG + BIG_PROJ), 4096};
    pg8::gemm_phase<pg8::EpiBf16, pg8::DenseOrder, true, true>(F.tid, ws, F.lds, idxlds, D_, S, E); }
__global__ void __launch_bounds__(NTHR, 2) k_moe1(Args A) { MKF();
    const unsigned* gcount = (const unsigned*)(ws + WS_CTL) + CW_CNT + A.ph_lo * 64;
    build_tileoff(F, gcount);
    pg8::MoeOrder<true> S; S.A = (unsigned)WS_H; S.Bt = (unsigned)(L == 2 ? WS_WEB : WS_WE1); S.K = D_; S.nct_log = 1; S.nunits = __builtin_amdgcn_readfirstlane(tileoff[65]) * 2; S.G = F.G; S.c = F.bid;
    S.idxoff = (unsigned)WS_ETOK; S.tileoff = tileoff; S.ecnt = (const LAS int*)(F.lds + LDS_ECNT); S.bstride = (unsigned)(512 * D_ * 2);
    pg8::EpiSwiGLU E{(bf16*)(ws + WS_HID)};
    pg8::gemm_phase<pg8::EpiSwiGLU, pg8::MoeOrder<true>, true, true>(F.tid, ws, F.lds, idxlds, D_, S, E); }
__global__ void __launch_bounds__(NTHR, 2) k_moe2(Args A) { MKF();
    const unsigned* gcount = (const unsigned*)(ws + WS_CTL) + CW_CNT + A.ph_lo * 64;
    build_tileoff(F, gcount);
    pg8::MoeOrder<false> S; S.A = (unsigned)WS_HID; S.Bt = (unsigned)(L == 2 ? WS_WEB + 65 * MiB : WS_WE2); S.K = 256; S.nct_log = 2; S.nunits = __builtin_amdgcn_readfirstlane(tileoff[65]) * 4; S.G = F.G; S.c = F.bid;
    S.idxoff = (unsigned)WS_EW; S.tileoff = tileoff; S.ecnt = (const LAS int*)(F.lds + LDS_ECNT); S.bstride = (unsigned)(D_ * 256 * 2);
    pg8::EpiScale E{ws + WS_BIG, 256 * __builtin_amdgcn_readfirstlane(tileoff[64])};
    pg8::gemm_phase<pg8::EpiScale, pg8::MoeOrder<false>, false, false>(F.tid, ws, F.lds, idxlds, 256, S, E); }
#endif
extern "C" void kernel_launch(void* const* d_in, const int* in_sizes, int n_in, void* d_out, int out_size, void* d_ws, size_t ws_size, hipStream_t stream) {
    static int grid = 0;
    if (grid == 0) {
        if (n_in != 23 || in_sizes[0] != T_ * D_ || out_size != T_ * D_ || ws_size < WS_END) {
            fprintf(stderr, "kernel_launch: unexpected shapes (n_in %d, in0 %d, out %d, ws %zu < %zu); nothing launched\n", n_in, n_in > 0 ? in_sizes[0] : -1, out_size, ws_size, (size_t)WS_END); grid = -1; return; }
        int dev = 0, cus = 0, per_cu = 0;
        if (hipGetDevice(&dev) != hipSuccess || hipDeviceGetAttribute(&cus, hipDeviceAttributeMultiprocessorCount, dev) != hipSuccess) { grid = -1; return; }
#if MK_FUSED
        if (hipFuncSetAttribute((const void*)mk_fwd, hipFuncAttributeMaxDynamicSharedMemorySize, LDS_BYTES) != hipSuccess) { fprintf(stderr, "kernel_launch: hipFuncSetAttribute failed\n"); grid = -1; return; }
        if (hipOccupancyMaxActiveBlocksPerMultiprocessor(&per_cu, (const void*)mk_fwd, NTHR, LDS_BYTES) != hipSuccess || per_cu < 1)
            fprintf(stderr, "kernel_launch: note: occupancy query reports %d workgroups per CU\n", per_cu);
#else
        { const void* ks[] = {(const void*)k_pro, (const void*)k_modx, (const void*)k_attn, (const void*)k_lnr, (const void*)k_scat, (const void*)k_lnm, (const void*)k_gprep, (const void*)k_gscan, (const void*)k_gpost,
                              (const void*)k_gemm_qkv, (const void*)k_gemm_out, (const void*)k_gemm_gin, (const void*)k_moe1, (const void*)k_moe2};
          for (const void* k : ks) if (hipFuncSetAttribute(k, hipFuncAttributeMaxDynamicSharedMemorySize, LDS_BYTES) != hipSuccess) { fprintf(stderr, "kernel_launch: hipFuncSetAttribute failed\n"); grid = -1; return; } }
        (void)per_cu;
#endif
        (void)hipGetLastError();
        grid = cus;
    }
    if (grid < 0) return;
    (void)hipMemsetAsync((char*)d_ws + WS_CTL, 0, CTL_ZERO_BYTES, stream);
    Args a{};
    a.x = (const float*)d_in[0]; a.c = (const float*)d_in[1]; a.pos = (const int*)d_in[2]; a.ada_w = (const float*)d_in[3]; a.ada_b = (const float*)d_in[4];
    a.ln_g = (const float*)d_in[5]; a.ln_b = (const float*)d_in[6]; a.attn_w_in = (const float*)d_in[7]; a.attn_w_out = (const float*)d_in[8];
    a.gdn_w_in = (const float*)d_in[9]; a.gdn_conv_w = (const float*)d_in[10]; a.gdn_a_log = (const float*)d_in[11]; a.gdn_dt_bias = (const float*)d_in[12];
    a.gdn_norm_w = (const float*)d_in[13]; a.gdn_w_out = (const float*)d_in[14]; a.router_w = (const float*)d_in[15]; a.router_bias = (const float*)d_in[16];
    a.ew1 = (const float*)d_in[17]; a.ew3 = (const float*)d_in[18]; a.ew2 = (const float*)d_in[19]; a.sw1 = (const float*)d_in[20]; a.sw3 = (const float*)d_in[21]; a.sw2 = (const float*)d_in[22];
    a.out = (float*)d_out; a.ws = (unsigned char*)d_ws;
#if MK_FUSED
    a.ph_lo = 0; a.ph_hi = N_PHASES;
    hipLaunchKernelGGL(mk_fwd, dim3(grid), dim3(NTHR), LDS_BYTES, stream, a);
#else
#define LAUNCH(k, arg) do { a.ph_lo = (arg); a.ph_hi = (arg) + 1; hipLaunchKernelGGL(k, dim3(grid), dim3(NTHR), LDS_BYTES, stream, a); } while (0)
    LAUNCH(k_pro, 0); LAUNCH(k_modx, 0);
    for (int L = 0; L < 4; ++L) {
        const int lp = L >> 1;
        if ((L & 1) == 0) { LAUNCH(k_gemm_qkv, lp); LAUNCH(k_attn, 0); LAUNCH(k_gemm_out, 2 * lp); }
        else { LAUNCH(k_gemm_gin, lp); LAUNCH(k_gprep, lp); LAUNCH(k_gscan, 0); LAUNCH(k_gpost, lp); LAUNCH(k_gemm_out, 2 * lp + 1); }
        LAUNCH(k_lnr, L); LAUNCH(k_scat, L); LAUNCH(k_moe1, L); LAUNCH(k_moe2, L); LAUNCH(k_lnm, L);
    }
#undef LAUNCH
#endif
    const hipError_t le = hipPeekAtLastError();
    if (le != hipSuccess) fprintf(stderr, "kernel_launch: launch failed: %s\n", hipGetErrorName(le));
}
```

```cpp
#include <hip/hip_runtime.h>
#include <cstdio>
#include <cstdint>

#define GAS __attribute__((address_space(1)))
#define LAS __attribute__((address_space(3)))
typedef unsigned short bf16;
typedef unsigned u32x4 __attribute__((ext_vector_type(4)));
typedef unsigned u32x2 __attribute__((ext_vector_type(2)));
typedef float f32x2 __attribute__((ext_vector_type(2)));
typedef float f32x4 __attribute__((ext_vector_type(4)));
typedef float f32x16 __attribute__((ext_vector_type(16)));
typedef short bf16x8 __attribute__((ext_vector_type(8)));
typedef short s16x4 __attribute__((ext_vector_type(4)));
typedef __bf16 bf16x2_t __attribute__((ext_vector_type(2)));
#define DI __device__ __forceinline__

DI unsigned cvtpk(float lo, float hi) { f32x2 v = {lo, hi}; bf16x2_t b = __builtin_convertvector(v, bf16x2_t); return __builtin_bit_cast(unsigned, b); }
DI unsigned cvtpk_fp8(float a, float b, float c, float d) { int w = __builtin_amdgcn_cvt_pk_fp8_f32(a, b, 0, false); w = __builtin_amdgcn_cvt_pk_fp8_f32(c, d, w, true); return (unsigned)w; }
constexpr bool YS_BF16 = true;
constexpr bool YS_MERGED = true;
constexpr float YE_SCALE = 16.0f;
DI float silu_f(float a) { return a * __builtin_amdgcn_rcpf(1.0f + __expf(-a)); }
DI float bf_lo(unsigned u) { return __builtin_bit_cast(float, u << 16); }
DI float bf_hi(unsigned u) { return __builtin_bit_cast(float, u & 0xffff0000u); }
template <int M> DI float shx(float v) { return __builtin_bit_cast(float, __builtin_amdgcn_ds_swizzle(__builtin_bit_cast(int, v), (M << 10) | 0x1f)); }
DI float bperm(float v, int srclane) { return __builtin_bit_cast(float, __builtin_amdgcn_ds_bpermute(srclane << 2, __builtin_bit_cast(int, v))); }
DI float rdlane(float v, int l) { return __builtin_bit_cast(float, __builtin_amdgcn_readlane(__builtin_bit_cast(int, v), l)); }
template <int CTRL> DI float dppmov(float v) { return __builtin_bit_cast(float, __builtin_amdgcn_update_dpp(0, __builtin_bit_cast(int, v), CTRL, 0xf, 0xf, true)); }
DI float wave_sum(float v) { v += dppmov<0xB1>(v); v += dppmov<0x4E>(v); v += dppmov<0x141>(v); v += dppmov<0x140>(v); return (rdlane(v, 0) + rdlane(v, 16)) + (rdlane(v, 32) + rdlane(v, 48)); }
DI float wave_max(float v) { v = fmaxf(v, dppmov<0xB1>(v)); v = fmaxf(v, dppmov<0x4E>(v)); v = fmaxf(v, dppmov<0x141>(v)); v = fmaxf(v, dppmov<0x140>(v)); return fmaxf(fmaxf(rdlane(v, 0), rdlane(v, 16)), fmaxf(rdlane(v, 32), rdlane(v, 48))); }
#define LDS_WAIT() asm volatile("s_waitcnt lgkmcnt(0)" ::: "memory")
#define VM_WAIT() asm volatile("s_waitcnt vmcnt(0)" ::: "memory")

namespace pg8 {
constexpr int BM = 256, BK = 64, HALF = 128, HTB = HALF * BK * 2, STAGE_BYTES = 8 * HTB;
DI int lds_byte(int r, int c) { const int st = (r >> 4) * 2 + (c >> 5), rr = r & 15, cc = c & 31, ob = rr * 64 + cc * 2; return st * 1024 + (ob ^ (((ob >> 9) & 1) << 5)); }
DI void stage_rc(int b, int& R, int& C) { const int st = b / 1024, sb = b % 1024, swz = sb ^ (((sb >> 9) & 1) << 5); R = (st >> 1) * 16 + swz / 64; C = (st & 1) * 32 + (swz % 64) / 2; }
DI int perm32(int rho) { const int n = rho >> 4, i = rho & 15; return 8 * (i >> 2) + 4 * n + (i & 3); }

DI const char* rfl_ptr(const char* p) {
    const unsigned long long v = (unsigned long long)p; const unsigned lo = __builtin_amdgcn_readfirstlane((unsigned)v), hi = __builtin_amdgcn_readfirstlane((unsigned)(v >> 32));
    return (const char*)(const __attribute__((address_space(1))) char*)(((unsigned long long)hi << 32) | lo); }
struct Unit { unsigned a; unsigned b; int r0; int c0; int e; int rb; int nv; };

template <class Epi, class Sched, bool ALIGN_EPI, bool SP2>
DI void gemm_phase(const int tid, const void* wsbase, LAS unsigned char* lds, LAS int* idxlds, const int K, const Sched& S, const Epi& E) {
    const __amdgpu_buffer_rsrc_t rsrc = __builtin_amdgcn_make_buffer_rsrc((void*)wsbase, 0, 0xffffffff, 0x00020000);
    const int wid = __builtin_amdgcn_readfirstlane(tid >> 6), lane = tid & 63, wr = wid >> 2, wc = wid & 3, fr = lane & 15, fq = lane >> 4;
    const int nt = K / BK;
    unsigned voffB[2], voffA[2][2];
#pragma unroll
    for (int i = 0; i < 2; ++i) { int R, C; stage_rc(tid * 16 + i * 8192, R, C); const int Rb = Epi::PERM ? ((R & ~31) + perm32(R & 31)) : R;
        voffB[i] = (unsigned)(Rb * K + C) * 2u;
        voffA[0][i] = (unsigned)(R * K + C) * 2u; voffA[1][i] = (unsigned)((R + HALF) * K + C) * 2u; }
    const unsigned kstep = (unsigned)(BK * 2);
    const unsigned hstep = (unsigned)(HALF * K * 2);
    const unsigned ldsw = (unsigned)wid * 1024u;
    const int aoff = lds_byte(wr * 64 + fr, fq * 8), boff = lds_byte(wc * 32 + fr, fq * 8);
#define PG8_SA(b, h) (((b) * 2 + (h)) * HTB)
#define PG8_SB(b, h) ((4 + (b) * 2 + (h)) * HTB)
#define PG8_STAGE(bufoff, soff, voff) do { const int _so = __builtin_amdgcn_readfirstlane((int)(soff)); _Pragma("unroll") for (int _i = 0; _i < 2; ++_i) \
        __builtin_amdgcn_raw_ptr_buffer_load_lds(rsrc, (LAS void*)(lds + (bufoff) + ldsw + _i * 8192), 16, (int)(voff)[_i], _so, 0, 0); } while (0)
#define PG8_LDA(dst, b, h) do { _Pragma("unroll") for (int m = 0; m < 4; ++m) _Pragma("unroll") for (int k = 0; k < 2; ++k) dst[m][k] = *(const LAS bf16x8*)(lds + PG8_SA(b, h) + aoff + m * 2048 + k * 1024); } while (0)
#define PG8_LDB(dst, b, h) do { _Pragma("unroll") for (int n = 0; n < 2; ++n) _Pragma("unroll") for (int k = 0; k < 2; ++k) dst[n][k] = *(const LAS bf16x8*)(lds + PG8_SB(b, h) + boff + n * 2048 + k * 1024); } while (0)
#define PG8_MMA(ai, bj, At, Bt) do { __builtin_amdgcn_s_setprio(1); _Pragma("unroll") for (int m = 0; m < 4; ++m) _Pragma("unroll") for (int n = 0; n < 2; ++n) _Pragma("unroll") for (int k = 0; k < 2; ++k) \
        acc[ai][bj][m][n] = __builtin_amdgcn_mfma_f32_16x16x32_bf16(Bt[n][k], At[m][k], acc[ai][bj][m][n], 0, 0, 0); __builtin_amdgcn_s_setprio(0); } while (0)
#define PG8_WAIT_V(n) asm volatile("s_waitcnt vmcnt(" #n ")" ::: "memory")
#define PG8_WAIT_L(n) asm volatile("s_waitcnt lgkmcnt(" #n ")" ::: "memory")
#define PG8_BAR __builtin_amdgcn_s_barrier()
#define PG8_SCHED __builtin_amdgcn_sched_barrier(0)
#define PG8_IDX_ISSUE(u, slot) __builtin_amdgcn_raw_ptr_buffer_load_lds(rsrc, (LAS void*)(idxlds + (slot) * 256 + (wid & 3) * 64), 4, lane * 4, \
        __builtin_amdgcn_readfirstlane((int)(S.idxoff + (unsigned)((u).rb + (wid & 3) * 64) * 4u)), 0, 0)
#define PG8_IDX_READ(dst, h_, slot, nv_) do { int _t = tid; asm volatile("" : "+v"(_t));   \
        _Pragma("unroll") for (int _i = 0; _i < 2; ++_i) { int _R, _C; stage_rc(_t * 16 + _i * 8192, _R, _C); \
        const int _ix = ((h_) * HALF + _R) < (nv_) ? idxlds[(slot) * 256 + (h_) * HALF + _R] : S.padrow;        \
        dst[_i] = (unsigned)_ix * (unsigned)(K * 2) + (unsigned)(_C * 2); } } while (0)
    Unit cur, nxt; int ui = 0;
    if (!S.next(0, cur)) return;
    f32x4 acc[2][2][4][2];
#pragma unroll
    for (int a = 0; a < 2; ++a)
#pragma unroll
        for (int b = 0; b < 2; ++b)
#pragma unroll
            for (int m = 0; m < 4; ++m)
#pragma unroll
                for (int n = 0; n < 2; ++n) acc[a][b][m][n] = (f32x4){0.f, 0.f, 0.f, 0.f};
    bf16x8 At[4][2], B0[2][2], B1[2][2];
    unsigned cA = cur.a, cB = cur.b;
    if constexpr (Sched::GATHER || Epi::ROWAUX) {
        PG8_IDX_ISSUE(cur, 0); PG8_WAIT_V(0); PG8_BAR;     asm volatile("" ::: "memory");
        if constexpr (Sched::GATHER) { PG8_IDX_READ(voffA[0], 0, 0, cur.nv); PG8_IDX_READ(voffA[1], 1, 0, cur.nv); }
    }
    if constexpr (SP2) {
        PG8_STAGE(PG8_SB(0, 0), cB, voffB); PG8_STAGE(PG8_SB(0, 1), cB + hstep, voffB); PG8_STAGE(PG8_SA(0, 0), cA, voffA[0]); PG8_STAGE(PG8_SA(0, 1), cA, voffA[1]);
        if (wr == 1) PG8_BAR;
        PG8_WAIT_V(2); PG8_BAR;
        PG8_STAGE(PG8_SB(1, 0), cB + kstep, voffB); PG8_STAGE(PG8_SA(1, 0), cA + kstep, voffA[0]); PG8_STAGE(PG8_SB(1, 1), cB + hstep + kstep, voffB);
        PG8_WAIT_V(6); PG8_BAR;
    } else {
        PG8_STAGE(PG8_SB(0, 0), cB, voffB); PG8_STAGE(PG8_SA(0, 0), cA, voffA[0]); PG8_STAGE(PG8_SB(0, 1), cB + hstep, voffB); PG8_STAGE(PG8_SA(0, 1), cA, voffA[1]);
        if (wr == 1) PG8_BAR;
        PG8_WAIT_V(4); PG8_BAR;
        PG8_STAGE(PG8_SB(1, 0), cB + kstep, voffB); PG8_STAGE(PG8_SA(1, 0), cA + kstep, voffA[0]); PG8_STAGE(PG8_SB(1, 1), cB + hstep + kstep, voffB);
        PG8_WAIT_V(6); PG8_BAR;
    }
    for (;;) {
        const bool has_next = S.next(ui + 1, nxt);
        const unsigned nA = has_next ? nxt.a : cA, nB = has_next ? nxt.b : cB;
        for (int t = 0; t < nt; t += 2) {
            const bool last = (t == nt - 2);
            const unsigned a1 = cA + (unsigned)(t + 1) * kstep;
            const unsigned a2 = last ? nA : cA + (unsigned)(t + 2) * kstep, b2 = last ? nB : cB + (unsigned)(t + 2) * kstep;
            const unsigned a3 = a2 + kstep, b3 = b2 + kstep;
            if constexpr (Sched::GATHER || Epi::ROWAUX) { if (t == 0 && has_next) PG8_IDX_ISSUE(nxt, (ui + 1) % 3); }
            if constexpr (Sched::GATHER) { if (last && has_next) PG8_IDX_READ(voffA[0], 0, (ui + 1) % 3, nxt.nv); }
#define PG8_NEXT_H1() do { if constexpr (Sched::GATHER) { if (last && has_next) PG8_IDX_READ(voffA[1], 1, (ui + 1) % 3, nxt.nv); } } while (0)
            if constexpr (SP2) {
            PG8_LDB(B0, 0, 0); PG8_LDB(B1, 0, 1); PG8_SCHED; PG8_LDA(At, 0, 0); PG8_STAGE(PG8_SA(1, 1), a1, voffA[1]); PG8_NEXT_H1();
            PG8_WAIT_V(8); PG8_WAIT_L(0); PG8_BAR; PG8_MMA(0, 0, At, B0); PG8_MMA(0, 1, At, B1); PG8_BAR; PG8_SCHED;
            PG8_LDA(At, 0, 1); PG8_STAGE(PG8_SB(0, 0), b2, voffB); PG8_STAGE(PG8_SB(0, 1), b2 + hstep, voffB); PG8_STAGE(PG8_SA(0, 0), a2, voffA[0]);
            PG8_WAIT_V(8); PG8_WAIT_L(0); PG8_BAR; PG8_MMA(1, 0, At, B0); PG8_MMA(1, 1, At, B1); PG8_BAR; PG8_SCHED;
            PG8_LDB(B0, 1, 0); PG8_LDB(B1, 1, 1); PG8_SCHED; PG8_LDA(At, 1, 0); PG8_STAGE(PG8_SA(0, 1), a2, voffA[1]);
            PG8_WAIT_V(8); PG8_WAIT_L(0); PG8_BAR; PG8_MMA(0, 0, At, B0); PG8_MMA(0, 1, At, B1); PG8_BAR; PG8_SCHED;
            PG8_LDA(At, 1, 1); PG8_STAGE(PG8_SB(1, 0), b3, voffB); PG8_STAGE(PG8_SB(1, 1), b3 + hstep, voffB); PG8_STAGE(PG8_SA(1, 0), a3, voffA[0]);
            PG8_WAIT_V(8); PG8_WAIT_L(0); PG8_BAR; PG8_MMA(1, 0, At, B0); PG8_MMA(1, 1, At, B1); PG8_BAR; PG8_SCHED;
            } else {
            PG8_LDB(B0, 0, 0); PG8_SCHED; PG8_LDA(At, 0, 0); PG8_STAGE(PG8_SA(1, 1), a1, voffA[1]); PG8_NEXT_H1();
            PG8_WAIT_L(8); PG8_BAR; PG8_WAIT_L(0); PG8_MMA(0, 0, At, B0); PG8_BAR; PG8_SCHED;
            PG8_LDB(B1, 0, 1); PG8_STAGE(PG8_SB(0, 0), b2, voffB);
            PG8_BAR; PG8_WAIT_L(0); PG8_MMA(0, 1, At, B1); PG8_BAR;
            PG8_LDA(At, 0, 1); PG8_STAGE(PG8_SA(0, 0), a2, voffA[0]);
            PG8_BAR; PG8_WAIT_L(0); PG8_MMA(1, 0, At, B0); PG8_BAR; PG8_SCHED;
            PG8_STAGE(PG8_SB(0, 1), b2 + hstep, voffB);
            PG8_WAIT_V(6); PG8_BAR; PG8_MMA(1, 1, At, B1); PG8_BAR;
            PG8_LDB(B0, 1, 0); PG8_SCHED; PG8_LDA(At, 1, 0); PG8_STAGE(PG8_SA(0, 1), a2, voffA[1]);
            PG8_WAIT_L(8); PG8_BAR; PG8_WAIT_L(0); PG8_MMA(0, 0, At, B0); PG8_BAR; PG8_SCHED;
            PG8_LDB(B1, 1, 1); PG8_STAGE(PG8_SB(1, 0), b3, voffB);
            PG8_BAR; PG8_WAIT_L(0); PG8_MMA(0, 1, At, B1); PG8_BAR;
            PG8_LDA(At, 1, 1); PG8_STAGE(PG8_SA(1, 0), a3, voffA[0]);
            PG8_BAR; PG8_WAIT_L(0); PG8_MMA(1, 0, At, B0); PG8_BAR; PG8_SCHED;
            PG8_STAGE(PG8_SB(1, 1), b3 + hstep, voffB);
            PG8_WAIT_V(6); PG8_BAR; PG8_MMA(1, 1, At, B1); PG8_BAR;
            }
        }
        if constexpr (ALIGN_EPI) { if (wr == 0) PG8_BAR; }
        if constexpr (Epi::ROWAUX) E(acc, cur, wr, wc, fr, fq, idxlds + (ui % 3) * 256); else E(acc, cur, wr, wc, fr, fq);
        if (!has_next) break;
#pragma unroll
        for (int a = 0; a < 2; ++a)
#pragma unroll
            for (int b = 0; b < 2; ++b)
#pragma unroll
                for (int m = 0; m < 4; ++m)
#pragma unroll
                    for (int n = 0; n < 2; ++n) acc[a][b][m][n] = (f32x4){0.f, 0.f, 0.f, 0.f};
        cur = nxt; cA = nA; cB = nB; ++ui;
        if constexpr (ALIGN_EPI) { if (wr == 1) PG8_BAR; }
    }
    PG8_WAIT_V(0);
    if constexpr (!ALIGN_EPI) { if (wr == 0) PG8_BAR; }
    PG8_BAR;
#undef PG8_SA
#undef PG8_SB
#undef PG8_STAGE
#undef PG8_LDA
#undef PG8_LDB
#undef PG8_MMA
#undef PG8_WAIT_V
#undef PG8_WAIT_L
#undef PG8_BAR
#undef PG8_SCHED
#undef PG8_IDX_ISSUE
#undef PG8_IDX_READ
#undef PG8_NEXT_H1
}
}
constexpr int T_ = 16384, D_ = 1024, NB_ = 4, S_ = 4096, NEXP = 64, TOPK = 8;
constexpr int ECAP = 16384;
constexpr int PMAX = 163840;
constexpr float LN_EPS = 1e-5f, RMS_EPS = 1e-6f;
constexpr float ALPHA_DN = 1.6817928305074290f;
constexpr float QSCALE = 0.125f * 1.4426950408889634f;

namespace pg8 {
constexpr int NXCD = 8, WGM = 8;
struct DenseOrder {
    static constexpr bool GATHER = false;
    unsigned A, Bt; int K; int nM, nN, nwg, G, c; unsigned idxoff; static constexpr int padrow = 0;
    DI void init(size_t A_, size_t Bt_, int M, int N, int K_, int G_, int c_) { A = (unsigned)A_; Bt = (unsigned)Bt_; K = K_; nM = M / BM; nN = N / BM; nwg = nM * nN; G = G_; c = c_; idxoff = 0u; }
    DI bool next(int i, Unit& u) const {
        const long L = (long)i * G + c; if (L >= nwg) return false;
        int wgid = (int)L; { const int q = nwg / NXCD, r = nwg % NXCD, xcd = wgid % NXCD, off = wgid / NXCD; wgid = (xcd < r ? xcd * (q + 1) : r * (q + 1) + (xcd - r) * q) + off; }
        const int nig = WGM * nN, gid = wgid / nig, fm = gid * WGM, gsz = (nM - fm) < WGM ? (nM - fm) : WGM;
        const int pm = fm + ((wgid % nig) % gsz), pn = (wgid % nig) / gsz;
        u.a = A + (unsigned)(pm * BM * K * 2); u.b = Bt + (unsigned)(pn * BM * K * 2); u.r0 = pm * BM; u.c0 = pn * BM; u.e = 0; u.rb = 0; u.nv = BM; return true;
    }
};
template <bool GATH> struct MoeOrder {
    static constexpr bool GATHER = GATH;
    unsigned A, Bt; int K; int nct_log, nunits, G, c; unsigned idxoff; const LAS int* tileoff; const LAS int* ecnt; unsigned bstride; static constexpr int padrow = T_;
    DI bool next(int i, Unit& u) const {
        const long L = (long)i * G + c; if (L >= nunits) return false;
        int wgid = (int)L; { const int q = nunits / NXCD, r = nunits % NXCD, xcd = wgid % NXCD, off = wgid / NXCD; wgid = (xcd < r ? xcd * (q + 1) : r * (q + 1) + (xcd - r) * q) + off; }
        const int tile = wgid >> nct_log, pn = wgid & ((1 << nct_log) - 1);
        int e = 0;
#pragma unroll 1
        for (int j = 32; j >= 1; j >>= 1) { const int cand = e + j; if (tileoff[cand] <= tile) e = cand; }
        if (e < NEXP && tileoff[e + 1] <= tile) e += 1;
        e = __builtin_amdgcn_readfirstlane(e);
        u.e = e; u.r0 = tile * BM; u.c0 = pn * BM;
        { const int ti = tile - __builtin_amdgcn_readfirstlane(tileoff[e]); u.rb = e * ECAP + ti * BM; u.nv = __builtin_amdgcn_readfirstlane(ecnt[e]) - ti * BM; }
        u.a = GATH ? A : A + (unsigned)(tile * BM * K * 2);
        u.b = Bt + (unsigned)e * bstride + (unsigned)(pn * BM * K * 2);
        return true;
    }
};

struct EpiF32 {
    static constexpr bool PERM = false, ROWAUX = false;
    float* C; int ldc;
    DI void operator()(const f32x4 (&acc)[2][2][4][2], const Unit& u, int wr, int wc, int fr, int fq) const {
        const int row0 = u.r0 + wr * 64 + fr, col0 = u.c0 + wc * 32 + 4 * fq;
#pragma unroll
        for (int ai = 0; ai < 2; ++ai)
#pragma unroll
            for (int m = 0; m < 4; ++m) { float* rowp = C + (size_t)(row0 + ai * HALF + m * 16) * ldc + col0;
#pragma unroll
                for (int bj = 0; bj < 2; ++bj)
#pragma unroll
                    for (int n = 0; n < 2; ++n) *(f32x4*)(rowp + bj * HALF + n * 16) = acc[ai][bj][m][n]; }
    }
};
struct EpiBf16 {
    static constexpr bool PERM = true, ROWAUX = false;
    bf16* O; int ldc;
    DI void operator()(const f32x4 (&acc)[2][2][4][2], const Unit& u, int wr, int wc, int fr, int fq) const {
        const int row0 = u.r0 + wr * 64 + fr, col0 = u.c0 + wc * 32 + 8 * fq;
#pragma unroll
        for (int ai = 0; ai < 2; ++ai)
#pragma unroll
            for (int m = 0; m < 4; ++m) { bf16* rowp = O + (size_t)(row0 + ai * HALF + m * 16) * ldc + col0;
#pragma unroll
                for (int bj = 0; bj < 2; ++bj) { const f32x4 v0 = acc[ai][bj][m][0], v1 = acc[ai][bj][m][1];
                    u32x4 w; w.x = cvtpk(v0[0], v0[1]); w.y = cvtpk(v0[2], v0[3]); w.z = cvtpk(v1[0], v1[1]); w.w = cvtpk(v1[2], v1[3]);
                    *(u32x4*)(rowp + bj * HALF) = w; } }
    }
};
struct EpiQKV {
    static constexpr bool PERM = true, ROWAUX = false;
    bf16* QKV; const float* COS; const float* SIN;
    DI void operator()(const f32x4 (&acc)[2][2][4][2], const Unit& u, int wr, int wc, int fr, int fq) const {
        const int pn = u.c0 >> 8, g = pn / 12, which = (pn >> 2) % 3, hq = pn & 3;
        const int ldil = 2 * g, dil = 1 << ldil;
        const int idx = 4 * (wc & 1) + fq, b = u.r0 >> 12;
        const int row0 = u.r0 + wr * 64 + fr;
#pragma unroll
        for (int ai = 0; ai < 2; ++ai)
#pragma unroll
            for (int m = 0; m < 4; ++m) {
                const int r = row0 + ai * HALF + m * 16, t = r & (S_ - 1);
                const int prow = (t & (dil - 1)) * (S_ >> ldil) + (t >> ldil);
                f32x4 c4 = (f32x4){1.f, 1.f, 1.f, 1.f}, s4 = (f32x4){0.f, 0.f, 0.f, 0.f};
                if (which < 2) { c4 = *(const f32x4*)(COS + (size_t)r * 32 + 4 * idx); s4 = *(const f32x4*)(SIN + (size_t)r * 32 + 4 * idx); }
#pragma unroll
                for (int bj = 0; bj < 2; ++bj) {
                    const int head = 4 * hq + 2 * bj + (wc >> 1);
                    const f32x4 v0 = acc[ai][bj][m][0], v1 = acc[ai][bj][m][1];
                    f32x4 o0 = v0 * c4 - v1 * s4, o1 = v1 * c4 + v0 * s4;
                    if (which == 0) { o0 = o0 * QSCALE; o1 = o1 * QSCALE; }
                    u32x4 w; w.x = cvtpk(o0[0], o0[1]); w.y = cvtpk(o0[2], o0[3]); w.z = cvtpk(o1[0], o1[1]); w.w = cvtpk(o1[2], o1[3]);
                    bf16* dst = QKV + ((((size_t)(which * 3 + g) * NB_ + b) * 16 + head) * S_ + prow) * 64 + 8 * idx;
                    *(u32x4*)dst = w;
                }
            }
    }
};
struct EpiSwiGLU {
    static constexpr bool PERM = true, ROWAUX = false;
    bf16* HID;
    DI void operator()(const f32x4 (&acc)[2][2][4][2], const Unit& u, int wr, int wc, int fr, int fq) const {
        const int row0 = u.r0 + wr * 64 + fr, col0 = (u.c0 >> 1) + wc * 32 + 8 * fq;
#pragma unroll
        for (int ai = 0; ai < 2; ++ai)
#pragma unroll
            for (int m = 0; m < 4; ++m) {
                float hv[8];
#pragma unroll
                for (int n = 0; n < 2; ++n)
#pragma unroll
                    for (int j = 0; j < 4; ++j) { const float a = acc[ai][0][m][n][j], bb = acc[ai][1][m][n][j]; hv[4 * n + j] = silu_f(a) * bb; }
                u32x4 w; w.x = cvtpk(hv[0], hv[1]); w.y = cvtpk(hv[2], hv[3]); w.z = cvtpk(hv[4], hv[5]); w.w = cvtpk(hv[6], hv[7]);
                *(u32x4*)(HID + (size_t)(row0 + ai * HALF + m * 16) * 256 + col0) = w;
            }
    }
};
constexpr size_t YS_OFF = (size_t)160 << 20;
struct EpiScale {
    static constexpr bool PERM = true, ROWAUX = true;
    unsigned char* YE;
    int s0;
    DI void operator()(const f32x4 (&acc)[2][2][4][2], const Unit& u, int wr, int wc, int fr, int fq, const LAS int* aux) const {
        const int row0 = wr * 64 + fr, col0 = u.c0 + wc * 32 + 8 * fq;
        if (u.e == NEXP) {
            bf16* base = (bf16*)pg8::rfl_ptr((const char*)(YE + YS_OFF) + (size_t)(u.r0 - s0) * (D_ * 2));
#pragma unroll
            for (int ai = 0; ai < 2; ++ai)
#pragma unroll
                for (int m = 0; m < 4; ++m) { const unsigned ro = (unsigned)((row0 + ai * HALF + m * 16) * D_ + col0) * 2u;
#pragma unroll
                    for (int bj = 0; bj < 2; ++bj) { const f32x4 v0 = acc[ai][bj][m][0], v1 = acc[ai][bj][m][1];
                        u32x4 w; w.x = cvtpk(v0[0], v0[1]); w.y = cvtpk(v0[2], v0[3]); w.z = cvtpk(v1[0], v1[1]); w.w = cvtpk(v1[2], v1[3]);
                        *(u32x4*)((char*)base + ro + bj * HALF * 2) = w; } }
        } else {
            unsigned char* base = (unsigned char*)pg8::rfl_ptr((const char*)YE + (size_t)u.r0 * D_);
#pragma unroll
            for (int ai = 0; ai < 2; ++ai)
#pragma unroll
                for (int m = 0; m < 4; ++m) { const int rl = row0 + ai * HALF + m * 16; const float wgt = __builtin_bit_cast(float, aux[rl]) * YE_SCALE; const unsigned ro = (unsigned)(rl * D_ + col0);
#pragma unroll
                    for (int bj = 0; bj < 2; ++bj) { const f32x4 v0 = acc[ai][bj][m][0] * wgt, v1 = acc[ai][bj][m][1] * wgt;
                        u32x2 w; w.x = cvtpk_fp8(v0[0], v0[1], v0[2], v0[3]); w.y = cvtpk_fp8(v1[0], v1[1], v1[2], v1[3]);
                        *(u32x2*)(base + ro + bj * HALF) = w; } }
        }
    }
};
}
constexpr size_t MiB = 1u << 20;
constexpr size_t WS_CTL = 0, CTL_ZERO_BYTES = 1 * MiB;
constexpr size_t WS_MOD = 1 * MiB;
constexpr size_t WS_COS = 2 * MiB;
constexpr size_t WS_SIN = 4 * MiB;
constexpr size_t WS_ASG_E = 6 * MiB;
constexpr size_t WS_ASG_R = 6 * MiB + 512 * 1024;
constexpr size_t WS_ASG_W = 7 * MiB;
constexpr size_t WS_ASG_ROW = 7 * MiB + 512 * 1024;
constexpr size_t WS_ROWTOK = 8 * MiB;
constexpr size_t WS_ROWW = 9 * MiB;
constexpr size_t WS_AB = 10 * MiB;
constexpr size_t WS_GALPHA = 11 * MiB;
constexpr size_t WS_GBETA = 11 * MiB + 512 * 1024;
constexpr size_t WS_X = 12 * MiB;
constexpr size_t WS_Y = 76 * MiB;
constexpr size_t WS_H = 140 * MiB;
constexpr size_t WS_O = 173 * MiB;
constexpr size_t WS_WA_IN = 205 * MiB;
constexpr size_t WS_WA_OUT = 241 * MiB;
constexpr size_t WS_WG_IN = 245 * MiB;
constexpr size_t WS_WG_OUT = 261 * MiB;
constexpr size_t WS_WE1 = 265 * MiB;
constexpr size_t WS_WE2 = 330 * MiB;
constexpr size_t WS_HID = 363 * MiB;
constexpr size_t WS_BIG = 443 * MiB;
constexpr size_t WS_YS_OFF = pg8::YS_OFF;
constexpr size_t WS_WEB = WS_BIG + 368 * MiB;
constexpr size_t WS_WRF = WS_BIG + 466 * MiB;
constexpr size_t WS_WABF = WS_WRF + 1 * MiB;
constexpr size_t WS_ETOK = WS_WABF + 1 * MiB;
constexpr size_t WS_EW = WS_ETOK + 5 * MiB;
constexpr size_t WS_END = WS_EW + 5 * MiB;
constexpr size_t BIG_PROJ = 0, BIG_QN = 128 * MiB, BIG_KN = 192 * MiB, BIG_VV = 256 * MiB, BIG_ORAW = 320 * MiB;
constexpr int CW_BAR = 4096;
constexpr int CW_CNT = 16384;
constexpr int RING_BYTES = 131072;
constexpr int LDS_IDX = RING_BYTES;
constexpr int LDS_TILEOFF = LDS_IDX + 3072;
constexpr int LDS_LCNT = LDS_TILEOFF + 512;
constexpr int LDS_LBASE = LDS_LCNT + 256;
constexpr int LDS_LASG = LDS_LBASE + 256;
constexpr int LDS_ECNT = LDS_LASG;
constexpr int LDS_LW = LDS_IDX;
constexpr int LDS_MISC = LDS_LASG + 2048;
constexpr int LDS_LG = LDS_MISC + 128;
constexpr int LDS_BYTES = 147456;
static_assert(LDS_LG + 8192 <= LDS_BYTES, "LDS map");
constexpr int NWAVES = 8, NTHR = 512;

#define XB_TMO      128
#define XB_XCNT(j)  (256  + 64 * (j))
#define XB_XSUB(j)  (1280 + 64 * (j))
#define XB_XGEN(j)  (2304 + 64 * (j))
#define XB_TOP      3328
#define XB_TOPGEN   3392
#define XCD_BAR_WORDS 3456
#define XB_SPIN_CAP (1u << 18)
__device__ __forceinline__ unsigned xb_ld(unsigned* p)              { return __hip_atomic_load(p, __ATOMIC_RELAXED, __HIP_MEMORY_SCOPE_AGENT); }
__device__ __forceinline__ unsigned xb_add(unsigned* p, unsigned v) { return __hip_atomic_fetch_add(p, v, __ATOMIC_RELAXED, __HIP_MEMORY_SCOPE_AGENT); }
__device__ __forceinline__ unsigned xb_xcc_id() { return (unsigned)__builtin_amdgcn_s_getreg((3 << 11) | 20) & 0xFu; }
#define XB_SPIN(cond, bar) do { unsigned _sp = 0; while (cond) { __builtin_amdgcn_s_sleep(1); \
    if ((++_sp & 255u) == 0u) { if (xb_ld(&(bar)[XB_TMO])) break; if (_sp > XB_SPIN_CAP) { atomicAdd(&(bar)[XB_TMO], 1u); break; } } } } while (0)
struct XcdBarrier { unsigned* bar; unsigned x; volatile LAS unsigned* st; };
__device__ __forceinline__ XcdBarrier xcd_barrier_post(unsigned* bar, volatile LAS unsigned* st) {
    XcdBarrier b; b.bar = bar; b.x = xb_xcc_id(); b.st = st;
    if (threadIdx.x == 0) (void)xb_add(&bar[XB_XCNT(b.x)], 1u);
    return b;
}
__device__ __forceinline__ void xcd_barrier_complete(unsigned* bar, unsigned x, unsigned& nloc, unsigned& nx) {
    const unsigned G = gridDim.x * gridDim.y * gridDim.z;
    unsigned sum, cnt, mine, sp = 0u;
    for (;;) {
        sum = 0u; cnt = 0u; mine = 0u;
#pragma unroll
        for (unsigned j = 0; j < 16; ++j) { const unsigned c = xb_ld(&bar[XB_XCNT(j)]); sum += c; cnt += (c > 0u) ? 1u : 0u; mine = (j == x) ? c : mine; }
        if (sum == G) break;
        __builtin_amdgcn_s_sleep(1);
        if ((++sp & 255u) == 0u) { if (xb_ld(&bar[XB_TMO])) break; if (sp > XB_SPIN_CAP) { atomicAdd(&bar[XB_TMO], 1u); break; } }
    }
    nloc = mine > 0u ? mine : 1u; nx = cnt > 0u ? cnt : 1u;
}
__device__ __forceinline__ void xcd_barrier(const XcdBarrier& b, const int tid) {
    asm volatile("s_waitcnt vmcnt(0)" ::: "memory");
    __syncthreads();
    if (tid == 0) {
        unsigned* bar = b.bar;
        __builtin_amdgcn_s_waitcnt(0);
        unsigned nloc = b.st[0], nx = b.st[1];
        if (nloc == 0u) { xcd_barrier_complete(bar, b.x, nloc, nx); b.st[0] = nloc; b.st[1] = nx; }
        const unsigned old = xb_add(&bar[XB_XSUB(b.x)], 1u);
        const unsigned gen = old / nloc;
        if (old + 1u == (gen + 1u) * nloc) {
            __builtin_amdgcn_fence(__ATOMIC_RELEASE, "agent");
            asm volatile("s_waitcnt vmcnt(0)" ::: "memory");
            const unsigned og = xb_add(&bar[XB_TOP], 1u);
            const unsigned tg = og / nx;
            if (og + 1u == (tg + 1u) * nx) xb_add(&bar[XB_TOPGEN], 1u);
            else XB_SPIN(xb_ld(&bar[XB_TOPGEN]) == tg, bar);
            __builtin_amdgcn_fence(__ATOMIC_ACQUIRE, "agent");
            xb_add(&bar[XB_XGEN(b.x)], 1u);
            asm volatile("s_waitcnt vmcnt(0)" ::: "memory");
        } else {
            XB_SPIN(xb_ld(&bar[XB_XGEN(b.x)]) == gen, bar);
            __builtin_amdgcn_fence(__ATOMIC_ACQUIRE, "agent");
            asm volatile("s_waitcnt vmcnt(0)" ::: "memory");
        }
    }
    __syncthreads();
}

struct Args {
    const float* x; const float* c; const int* pos; const float* ada_w; const float* ada_b; const float* ln_g; const float* ln_b;
    const float* attn_w_in; const float* attn_w_out; const float* gdn_w_in; const float* gdn_conv_w; const float* gdn_a_log; const float* gdn_dt_bias;
    const float* gdn_norm_w; const float* gdn_w_out; const float* router_w; const float* router_bias; const float* ew1; const float* ew3; const float* ew2;
    const float* sw1; const float* sw3; const float* sw2;
    float* out; unsigned char* ws; int ph_lo, ph_hi;
};
typedef __attribute__((address_space(1))) unsigned char gas_u8;
DI unsigned char* opq(unsigned char* p) { gas_u8* g = (gas_u8*)p; asm volatile("" : "+s"(g)); return (unsigned char*)g; }
template <class T> DI T* asg(T* p) { typedef __attribute__((address_space(1))) T gT; return (T*)(gT*)p; }
struct Frame {
    LAS unsigned char* lds;
    int tid, lane, wave, G, bid;
};
template <class Map> DI void transpose_item(const float* W, int ldn, int K, bf16* WT, const Map& map, LAS float* scr, int kb, int nb, int lane) {
    const int k0 = 64 * kb, n0 = 32 * nb;
    float tv[32];
#pragma unroll
    for (int i = 0; i < 32; ++i) tv[i] = __builtin_nontemporal_load(&W[(size_t)(k0 + 2 * i + (lane >> 5)) * ldn + n0 + (lane & 31)]);
#pragma unroll
    for (int i = 0; i < 32; ++i) scr[(2 * i + (lane >> 5)) * 33 + (lane & 31)] = tv[i];
    LDS_WAIT(); asm volatile("" ::: "memory");
    const int c = lane & 7;
#pragma unroll
    for (int j = 0; j < 4; ++j) { const int n = (lane >> 3) + 8 * j; const LAS float* s = scr + (8 * c) * 33 + n;
        u32x4 o; o.x = cvtpk(s[0 * 33], s[1 * 33]); o.y = cvtpk(s[2 * 33], s[3 * 33]); o.z = cvtpk(s[4 * 33], s[5 * 33]); o.w = cvtpk(s[6 * 33], s[7 * 33]);
        *(u32x4*)(WT + (size_t)map(n0 + n) * K + k0 + 8 * c) = o; }
    LDS_WAIT(); asm volatile("" ::: "memory");
}
struct MapId { int off; DI int operator()(int n) const { return off + n; } };
struct MapQKV { DI int operator()(int n) const {
    const int which = (n >> 10) % 3; if (which == 2) return n;
    const int d = n & 63, idx = (d & 31) >> 2, lo = d & 3, hi = d >> 5; return (n & ~63) + 8 * idx + 4 * hi + lo; } };
struct MapW13 { int second; DI int operator()(int n) const { return (n >> 7) * 256 + second * 128 + (n & 127); } };
template <class Map> DI void convert_matrix(const Frame& F, const float* W, int ldn, int K, int N, bf16* WT, const Map& map) {
    LAS float* scr = (LAS float*)(F.lds + F.wave * 16384);
    const int gw = F.bid * NWAVES + F.wave, NGW = F.G * NWAVES, nblk = N / 32, nitems = (K / 64) * nblk;
    for (int it = gw; it < nitems; it += NGW) transpose_item(W, ldn, K, WT, map, scr, it / nblk, it % nblk, F.lane);
}

DI void prologue_phase(const Frame& F, const Args& A) {
    unsigned char* ws = opq(A.ws);
    {
        LAS float* red = (LAS float*)F.lds;
        float* MOD = (float*)(ws + WS_MOD);
        for (int item = F.bid; item < 8 * 48; item += F.G) {
            const int ls = item / 48, n = (item % 48) * 64 + F.lane;
            const float* w = A.ada_w + ((size_t)ls * D_ + F.wave * 128) * 3072 + n;
            const float* cc = A.c + F.wave * 128;
            float a0 = 0.f, a1 = 0.f, a2 = 0.f, a3 = 0.f;
#pragma unroll 8
            for (int k = 0; k < 128; ++k) { const float wv = __builtin_nontemporal_load(&w[(size_t)k * 3072]); a0 += cc[k] * wv; a1 += cc[D_ + k] * wv; a2 += cc[2 * D_ + k] * wv; a3 += cc[3 * D_ + k] * wv; }
            red[(F.wave * 4 + 0) * 64 + F.lane] = a0; red[(F.wave * 4 + 1) * 64 + F.lane] = a1; red[(F.wave * 4 + 2) * 64 + F.lane] = a2; red[(F.wave * 4 + 3) * 64 + F.lane] = a3;
            __syncthreads();
            if (F.wave < 4) { float s = A.ada_b[ls * 3072 + n];
#pragma unroll
                for (int w8 = 0; w8 < 8; ++w8) s += red[(w8 * 4 + F.wave) * 64 + F.lane];
                MOD[((size_t)ls * 4 + F.wave) * 3072 + n] = s; }
            __syncthreads();
        }
    }
    {
        float* COS = (float*)(ws + WS_COS); float* SIN = (float*)(ws + WS_SIN);
        for (int idx = F.bid * NTHR + F.tid; idx < T_ * 32; idx += F.G * NTHR) {
            const int t = idx >> 5, i = idx & 31;
            const float inv = powf(10000.0f, -(float)i / 32.0f);
            const float ang = (float)A.pos[t] * inv;
            COS[idx] = cosf(ang); SIN[idx] = sinf(ang);
        }
    }
    {
        bf16* WRF = (bf16*)(ws + WS_WRF); bf16* WABF = (bf16*)(ws + WS_WABF);
        for (int idx = F.bid * NTHR + F.tid; idx < 4 * 4 * 32 * 64 * 8; idx += F.G * NTHR) {
            const int jx = idx & 7, ln = (idx >> 3) & 63, ks = (idx >> 9) & 31, nt = (idx >> 14) & 3, layer = idx >> 16;
            const int d = 32 * ks + 8 * (ln >> 4) + jx, e = 16 * nt + (ln & 15);
            const float wv = A.router_w[((size_t)layer * D_ + d) * NEXP + e];
            const unsigned hi = cvtpk(wv, 0.f) & 0xffffu; const float res = wv - bf_lo(hi);
            const size_t o = (size_t)layer * 2 * 65536 + (idx & 65535);
            WRF[o] = (bf16)hi; WRF[o + 65536] = (bf16)(cvtpk(res, 0.f) & 0xffffu);
        }
        for (int idx = F.bid * NTHR + F.tid; idx < 2 * 32 * 64 * 8; idx += F.G * NTHR) {
            const int jx = idx & 7, ln = (idx >> 3) & 63, ks = (idx >> 9) & 31, jl = idx >> 14;
            const int d = 32 * ks + 8 * (ln >> 4) + jx, e = ln & 15;
            const float wv = A.gdn_w_in[((size_t)jl * D_ + d) * 4112 + 4096 + e];
            const unsigned hi = cvtpk(wv, 0.f) & 0xffffu; const float res = wv - bf_lo(hi);
            const size_t o = (size_t)jl * 2 * 16384 + (idx & 16383);
            WABF[o] = (bf16)hi; WABF[o + 16384] = (bf16)(cvtpk(res, 0.f) & 0xffffu);
        }
    }
    if (F.bid == 0) { bf16* H = (bf16*)(ws + WS_H); for (int cidx = F.tid; cidx < D_; cidx += NTHR) H[(size_t)T_ * D_ + cidx] = 0; }
    for (int j = 0; j < 2; ++j) {
        convert_matrix(F, A.attn_w_in + (size_t)j * D_ * 9216, 9216, D_, 9216, (bf16*)(ws + WS_WA_IN) + (size_t)j * 9216 * D_, MapQKV{});
        convert_matrix(F, A.attn_w_out + (size_t)j * D_ * D_, D_, D_, D_, (bf16*)(ws + WS_WA_OUT) + (size_t)j * D_ * D_, MapId{0});
        convert_matrix(F, A.gdn_w_in + (size_t)j * D_ * 4112, 4112, D_, 4096, (bf16*)(ws + WS_WG_IN) + (size_t)j * 4096 * D_, MapId{0});
        convert_matrix(F, A.gdn_w_out + (size_t)j * D_ * D_, D_, D_, D_, (bf16*)(ws + WS_WG_OUT) + (size_t)j * D_ * D_, MapId{0});
    }
}
struct XItem { const float* src; bf16* dst; int ldn, K, mode, n0; };
DI XItem xi_decode(const Args& A, int layer, bf16* WE1, bf16* WE2, int it) {
    constexpr int I13 = (D_ / 64) * (256 / 32), I2 = (256 / 64) * (D_ / 32), IPE = 2 * I13 + I2;
    const int e = it / IPE; int r = it % IPE; XItem x;
    if (r < 2 * I13) { const int second = r >= I13 ? 1 : 0; r -= second * I13; const int kb = r >> 3, nb = r & 7;
        const float* w = second ? (e < 64 ? A.ew3 + ((size_t)layer * 64 + e) * D_ * 256 : A.sw3 + (size_t)layer * D_ * 256) : (e < 64 ? A.ew1 + ((size_t)layer * 64 + e) * D_ * 256 : A.sw1 + (size_t)layer * D_ * 256);
        x.src = w + (size_t)(64 * kb) * 256 + 32 * nb; x.ldn = 256; x.K = D_; x.mode = 1 + second; x.n0 = 32 * nb; x.dst = WE1 + (size_t)e * 512 * D_ + 64 * kb;
    } else { r -= 2 * I13; const int kb = r >> 5, nb = r & 31;
        const float* w = e < 64 ? A.ew2 + ((size_t)layer * 64 + e) * 256 * D_ : A.sw2 + (size_t)layer * 256 * D_;
        x.src = w + (size_t)(64 * kb) * D_ + 32 * nb; x.ldn = D_; x.K = 256; x.mode = 0; x.n0 = 32 * nb; x.dst = WE2 + (size_t)e * D_ * 256 + 64 * kb; }
    return x;
}
#define XI_LOAD(buf, XT) do { const char* _b = pg8::rfl_ptr((const char*)(XT).src); const unsigned _ro = (unsigned)((XT).ldn * 4); \
    _Pragma("unroll") for (int _i = 0; _i < 8; ++_i) buf[_i] = __builtin_nontemporal_load((const f32x4*)(_b + ((unsigned)(8 * _i + (lane >> 3)) * _ro + (unsigned)(lane & 7) * 16u))); } while (0)
#define XI_PUT(buf, XT) do { \
    _Pragma("unroll") for (int _i = 0; _i < 8; ++_i) _Pragma("unroll") for (int _e = 0; _e < 4; ++_e) scr[(8 * _i + (lane >> 3)) * 33 + 4 * (lane & 7) + _e] = buf[_i][_e]; \
    LDS_WAIT(); asm volatile("" ::: "memory"); \
    const int _c = lane & 7; \
    _Pragma("unroll") for (int _j = 0; _j < 4; ++_j) { const int _n = (XT).n0 + (lane >> 3) + 8 * _j; const LAS float* _s = scr + (8 * _c) * 33 + (lane >> 3) + 8 * _j; \
        const int _row = (XT).mode == 0 ? _n : (_n >> 7) * 256 + ((XT).mode - 1) * 128 + (_n & 127); \
        u32x4 _o; _o.x = cvtpk(_s[0 * 33], _s[1 * 33]); _o.y = cvtpk(_s[2 * 33], _s[3 * 33]); _o.z = cvtpk(_s[4 * 33], _s[5 * 33]); _o.w = cvtpk(_s[6 * 33], _s[7 * 33]); \
        __builtin_nontemporal_store(_o, (u32x4*)((XT).dst + (size_t)_row * (XT).K + 8 * _c)); } \
    LDS_WAIT(); asm volatile("" ::: "memory"); } while (0)
DI void convert_experts(const Frame& F, const Args& A, int layer, int set, int wg0, int nwg) {
    if (F.bid < wg0 || F.bid >= wg0 + nwg) return;
    unsigned char* ws = opq(A.ws);
    LAS float* scr = (LAS float*)(F.lds + F.wave * 16384);
    bf16* WE1 = (bf16*)(ws + (set ? WS_WEB : WS_WE1)); bf16* WE2 = (bf16*)(ws + (set ? WS_WEB + 65 * MiB : WS_WE2));
    const int gw = (F.bid - wg0) * NWAVES + F.wave, NGW = nwg * NWAVES, lane = F.lane;
    constexpr int NIT = 65 * 384;
    f32x4 ba[8], bb[8];
    int it = gw;
    if (it >= NIT) return;
    XItem xa = xi_decode(A, layer, WE1, WE2, it), xb = xa;
    XI_LOAD(ba, xa);
#pragma unroll 1
    for (;;) {
        const bool hb = it + NGW < NIT;
        if (hb) { xb = xi_decode(A, layer, WE1, WE2, it + NGW); XI_LOAD(bb, xb); }
        __builtin_amdgcn_sched_barrier(0);
        XI_PUT(ba, xa);
        if (!hb) break;
        it += NGW;
        const bool ha = it + NGW < NIT;
        if (ha) { xa = xi_decode(A, layer, WE1, WE2, it + NGW); XI_LOAD(ba, xa); }
        __builtin_amdgcn_sched_barrier(0);
        XI_PUT(bb, xb);
        if (!ha) break;
        it += NGW;
    }
}
#undef XI_LOAD
#undef XI_PUT

DI void load_row16(const float* p, int lane, f32x4 (&v)[4]) {
#pragma unroll
    for (int j = 0; j < 4; ++j) v[j] = *(const f32x4*)(p + 4 * lane + 256 * j);
}
DI void store_row16(float* p, int lane, const f32x4 (&v)[4]) {
#pragma unroll
    for (int j = 0; j < 4; ++j) *(f32x4*)(p + 4 * lane + 256 * j) = v[j];
}
DI void store_row16_bf16(bf16* p, int lane, const f32x4 (&v)[4]) {
#pragma unroll
    for (int j = 0; j < 4; ++j) { u32x2 w; w.x = cvtpk(v[j][0], v[j][1]); w.y = cvtpk(v[j][2], v[j][3]); *(u32x2*)(p + 4 * lane + 256 * j) = w; }
}
DI void add_row16_bf16(const bf16* p, int lane, f32x4 (&v)[4]) {
#pragma unroll
    for (int j = 0; j < 4; ++j) { const u32x2 w = *(const u32x2*)(p + 4 * lane + 256 * j); v[j][0] += bf_lo(w.x); v[j][1] += bf_hi(w.x); v[j][2] += bf_lo(w.y); v[j][3] += bf_hi(w.y); }
}
DI void add_row16_fp8(const unsigned char* p, int lane, f32x4 (&v)[4]) {
#pragma unroll
    for (int j = 0; j < 4; ++j) { const int w = *(const int*)(p + 4 * lane + 256 * j);
        const f32x2 a = __builtin_amdgcn_cvt_pk_f32_fp8(w, false), b = __builtin_amdgcn_cvt_pk_f32_fp8(w, true);
        v[j][0] += a[0]; v[j][1] += a[1]; v[j][2] += b[0]; v[j][3] += b[1]; }
}
DI void layer_norm16(f32x4 (&v)[4], const f32x4 (&g)[4], const f32x4 (&b)[4]) {
    float s = 0.f;
#pragma unroll
    for (int j = 0; j < 4; ++j) s += (v[j][0] + v[j][1]) + (v[j][2] + v[j][3]);
    const float mean = wave_sum(s) * (1.0f / D_);
    float q = 0.f;
#pragma unroll
    for (int j = 0; j < 4; ++j) { v[j] = v[j] - mean; q += (v[j][0] * v[j][0] + v[j][1] * v[j][1]) + (v[j][2] * v[j][2] + v[j][3] * v[j][3]); }
    const float rstd = 1.0f / sqrtf(wave_sum(q) * (1.0f / D_) + LN_EPS);
#pragma unroll
    for (int j = 0; j < 4; ++j) v[j] = v[j] * rstd * g[j] + b[j];
}

DI void modx_phase(const Frame& F, const Args& A) {
    unsigned char* ws = opq(A.ws);
    const float* MOD = (const float*)(ws + WS_MOD); bf16* H = (bf16*)(ws + WS_H);
    const int gw = F.bid * NWAVES + F.wave, NGW = F.G * NWAVES;
    for (int row = gw; row < T_; row += NGW) {
        const int b = row >> 12; f32x4 v[4], sc[4], sh[4];
        load_row16(A.x + (size_t)row * D_, F.lane, v); load_row16(MOD + (size_t)(0 * 4 + b) * 3072 + 1024, F.lane, sc); load_row16(MOD + (size_t)(0 * 4 + b) * 3072, F.lane, sh);
#pragma unroll
        for (int j = 0; j < 4; ++j) v[j] = v[j] * (1.0f + sc[j]) + sh[j];
        store_row16_bf16(H + (size_t)row * D_, F.lane, v);
    }
}

DI void build_tileoff(const Frame& F, const unsigned* gcount) {
    LAS int* tileoff = (LAS int*)(F.lds + LDS_TILEOFF);
    __syncthreads();
    if (F.wave == 0) {
        const unsigned cn = __hip_atomic_load(gcount + F.lane, __ATOMIC_RELAXED, __HIP_MEMORY_SCOPE_AGENT);
        const int nt = (int)((cn + 255u) >> 8); int inc = nt;
#pragma unroll
        for (int o = 1; o < 64; o <<= 1) { const int t = __builtin_amdgcn_ds_bpermute((F.lane - o) << 2, inc); if (F.lane >= o) inc += t; }
        tileoff[F.lane] = inc - nt; ((LAS int*)(F.lds + LDS_ECNT))[F.lane] = (int)cn;
        if (F.lane == 63) { tileoff[64] = inc; tileoff[65] = inc + T_ / 256; ((LAS int*)(F.lds + LDS_ECNT))[NEXP] = T_; }
    }
    __syncthreads();
}

DI void deepnorm_row(f32x4 (&v)[4], const f32x4 (&y)[4], const float* gate, const float* lng, const float* lnb, float* xout, const float* mod_shift, int lane) {
    f32x4 t[4];
    load_row16(gate, lane, t);
#pragma unroll
    for (int j = 0; j < 4; ++j) v[j] = ALPHA_DN * v[j] + (1.0f + t[j]) * y[j];
    float s = 0.f;
#pragma unroll
    for (int j = 0; j < 4; ++j) s += (v[j][0] + v[j][1]) + (v[j][2] + v[j][3]);
    const float mean = wave_sum(s) * (1.0f / D_);
    float q = 0.f;
#pragma unroll
    for (int j = 0; j < 4; ++j) { v[j] = v[j] - mean; q += (v[j][0] * v[j][0] + v[j][1] * v[j][1]) + (v[j][2] * v[j][2] + v[j][3] * v[j][3]); }
    const float rstd = 1.0f / sqrtf(wave_sum(q) * (1.0f / D_) + LN_EPS);
    load_row16(lng, lane, t);
#pragma unroll
    for (int j = 0; j < 4; ++j) v[j] = v[j] * rstd * t[j];
    load_row16(lnb, lane, t);
#pragma unroll
    for (int j = 0; j < 4; ++j) v[j] = v[j] + t[j];
    store_row16(xout, lane, v);
    if (mod_shift) {
        load_row16(mod_shift + 1024, lane, t);
#pragma unroll
        for (int j = 0; j < 4; ++j) v[j] = v[j] * (1.0f + t[j]);
        load_row16(mod_shift, lane, t);
#pragma unroll
        for (int j = 0; j < 4; ++j) v[j] = v[j] + t[j];
    }
}
DI void put_hilo(LAS unsigned char* lds, int p, int lane, const f32x4 (&v)[4]) {
#pragma unroll
    for (int j = 0; j < 4; ++j) {
        const int c = 4 * lane + 256 * j;
        const unsigned h0 = cvtpk(v[j][0], v[j][1]), h1 = cvtpk(v[j][2], v[j][3]);
        const unsigned l0 = cvtpk(v[j][0] - bf_lo(h0), v[j][1] - bf_hi(h0)), l1 = cvtpk(v[j][2] - bf_lo(h1), v[j][3] - bf_hi(h1));
        const int off = ((((p >> 4) * 32 + (c >> 5)) * 64 + ((c & 31) >> 3) * 16 + (p & 15)) * 16) + (c & 7) * 2;
        *(LAS u32x2*)(lds + off) = (u32x2){h0, h1}; *(LAS u32x2*)(lds + 65536 + off) = (u32x2){l0, l1};
    }
}
DI f32x4 small_proj(const LAS unsigned char* lds, int mt, int lane, const bf16* wf_hi, const bf16* wf_lo) {
    f32x4 a0 = (f32x4){0.f, 0.f, 0.f, 0.f}, a1 = a0, a2 = a0;
#pragma unroll 8
    for (int ks = 0; ks < 32; ++ks) {
        const bf16x8 ah = *(const LAS bf16x8*)(lds + ((mt * 32 + ks) * 64 + lane) * 16), al = *(const LAS bf16x8*)(lds + 65536 + ((mt * 32 + ks) * 64 + lane) * 16);
        const bf16x8 bh = *(const bf16x8*)(wf_hi + (ks * 64 + lane) * 8), bl = *(const bf16x8*)(wf_lo + (ks * 64 + lane) * 8);
        a0 = __builtin_amdgcn_mfma_f32_16x16x32_bf16(ah, bh, a0, 0, 0, 0); a1 = __builtin_amdgcn_mfma_f32_16x16x32_bf16(ah, bl, a1, 0, 0, 0); a2 = __builtin_amdgcn_mfma_f32_16x16x32_bf16(al, bh, a2, 0, 0, 0);
    }
    return a0 + (a1 + a2);
}
DI void small_proj2(const LAS unsigned char* lds, int kh, int lane, const bf16* wf_hi, const bf16* wf_lo, f32x4& o0, f32x4& o1) {
    f32x4 a[2][3];
#pragma unroll
    for (int mt = 0; mt < 2; ++mt)
#pragma unroll
        for (int e = 0; e < 3; ++e) a[mt][e] = (f32x4){0.f, 0.f, 0.f, 0.f};
#pragma unroll 8
    for (int k = 0; k < 16; ++k) {
        const int ks = 16 * kh + k;
        const bf16x8 bh = *(const bf16x8*)(wf_hi + (ks * 64 + lane) * 8), bl = *(const bf16x8*)(wf_lo + (ks * 64 + lane) * 8);
#pragma unroll
        for (int mt = 0; mt < 2; ++mt) {
            const bf16x8 ah = *(const LAS bf16x8*)(lds + ((mt * 32 + ks) * 64 + lane) * 16), al = *(const LAS bf16x8*)(lds + 65536 + ((mt * 32 + ks) * 64 + lane) * 16);
            a[mt][0] = __builtin_amdgcn_mfma_f32_16x16x32_bf16(ah, bh, a[mt][0], 0, 0, 0); a[mt][1] = __builtin_amdgcn_mfma_f32_16x16x32_bf16(ah, bl, a[mt][1], 0, 0, 0); a[mt][2] = __builtin_amdgcn_mfma_f32_16x16x32_bf16(al, bh, a[mt][2], 0, 0, 0);
        }
    }
    o0 = a[0][0] + (a[0][1] + a[0][2]); o1 = a[1][0] + (a[1][1] + a[1][2]);
}
DI void deepnorm_row_c(f32x4 (&v)[4], const f32x4 (&y)[4], const f32x4 (&cg)[4], const f32x4 (&cng)[4], const f32x4 (&cnb)[4]) {
#pragma unroll
    for (int j = 0; j < 4; ++j) v[j] = ALPHA_DN * v[j] + (1.0f + cg[j]) * y[j];
    float s = 0.f;
#pragma unroll
    for (int j = 0; j < 4; ++j) s += (v[j][0] + v[j][1]) + (v[j][2] + v[j][3]);
    const float mean = wave_sum(s) * (1.0f / D_);
    float q = 0.f;
#pragma unroll
    for (int j = 0; j < 4; ++j) { v[j] = v[j] - mean; q += (v[j][0] * v[j][0] + v[j][1] * v[j][1]) + (v[j][2] * v[j][2] + v[j][3] * v[j][3]); }
    const float rstd = 1.0f / sqrtf(wave_sum(q) * (1.0f / D_) + LN_EPS);
#pragma unroll
    for (int j = 0; j < 4; ++j) v[j] = v[j] * rstd * cng[j] + cnb[j];
}
template <bool L0> DI void ln_router_phase(const Frame& F, const Args& A, int layer, bool dry = false) {
    unsigned char* ws = opq(A.ws);
    const float* MOD = (const float*)(ws + WS_MOD); bf16* X = (bf16*)(ws + WS_X); const float* Y = (const float*)(ws + WS_Y); bf16* H = (bf16*)(ws + WS_H);
    int* asg_e = (int*)(ws + WS_ASG_E); int* asg_r = (int*)(ws + WS_ASG_R); int* etok = (int*)(ws + WS_ETOK); float* egate = (float*)(ws + WS_EW);
    unsigned* gcount = (unsigned*)(ws + WS_CTL) + CW_CNT + layer * 64;
    const int ls0 = layer * 2, ls1 = layer * 2 + 1;
    const bf16* wrf = (const bf16*)(ws + WS_WRF) + (size_t)layer * 2 * 65536 + (size_t)(F.wave & 3) * 32 * 512;
    const float rb = A.router_bias[layer * NEXP + F.lane];
    LAS float* lg = (LAS float*)(F.lds + LDS_LG);
    LAS int* lcnt = (LAS int*)(F.lds + LDS_LCNT); LAS int* lbase = (LAS int*)(F.lds + LDS_LBASE); LAS int* lasg = (LAS int*)(F.lds + LDS_LASG);
    const unsigned l8_ = (unsigned)F.lane * 8u, l16_ = (unsigned)F.lane * 16u;
    u32x2 yb[4][4], xb[L0 ? 1 : 4][4]; f32x4 xf[L0 ? 4 : 1][4];
#define LNR_LOAD(rb_) do { unsigned l8 = l8_, l16 = l16_; asm volatile("" : "+v"(l8), "+v"(l16)); \
        _Pragma("unroll") for (int t = 0; t < 4; ++t) { const int row = (rb_) + t; const char* py = pg8::rfl_ptr((const char*)Y + (size_t)row * (D_ * 2)); \
            if constexpr (L0) { const char* px = pg8::rfl_ptr((const char*)A.x + (size_t)row * (D_ * 4)); _Pragma("unroll") for (int j = 0; j < 4; ++j) xf[t][j] = *(const f32x4*)(px + l16 + 1024 * j); } \
            else { const char* px = pg8::rfl_ptr((const char*)X + (size_t)row * (D_ * 2)); _Pragma("unroll") for (int j = 0; j < 4; ++j) xb[t][j] = *(const u32x2*)(px + l8 + 512 * j); } \
            _Pragma("unroll") for (int j = 0; j < 4; ++j) yb[t][j] = *(const u32x2*)(py + l8 + 512 * j); } } while (0)
    for (int blk = F.bid; blk < T_ / 64; blk += F.G) {
        const int b = blk >> 6;
        const char* gate = pg8::rfl_ptr((const char*)(MOD + (size_t)(ls0 * 4 + b) * 3072 + 2048)); const char* modn = pg8::rfl_ptr((const char*)(MOD + (size_t)(ls1 * 4 + b) * 3072));
        const char* lng = pg8::rfl_ptr((const char*)(A.ln_g + (size_t)ls0 * D_)); const char* lnb = pg8::rfl_ptr((const char*)(A.ln_b + (size_t)ls0 * D_));
        f32x4 cg[4], cng[4], cnb[4], csc[4], csh[4];
#pragma unroll
        for (int j = 0; j < 4; ++j) { cg[j] = *(const f32x4*)(gate + l16_ + 1024 * j); cng[j] = *(const f32x4*)(lng + l16_ + 1024 * j); cnb[j] = *(const f32x4*)(lnb + l16_ + 1024 * j);
            csc[j] = *(const f32x4*)(modn + 4096 + l16_ + 1024 * j); csh[j] = *(const f32x4*)(modn + l16_ + 1024 * j); }
        if constexpr (!L0) { LNR_LOAD(blk * 64 + F.wave * 4); }
        __builtin_amdgcn_sched_barrier(0);
#pragma unroll 1
        for (int ps = 0; ps < 2; ++ps) {
            const int rbase = blk * 64 + ps * 32 + F.wave * 4;
            if constexpr (L0) { LNR_LOAD(rbase); }
            { unsigned l8 = l8_; asm volatile("" : "+v"(l8));
#pragma unroll
              for (int t = 0; t < 4; ++t) { const int row = rbase + t; f32x4 v[4], y[4];
#pragma unroll
                for (int j = 0; j < 4; ++j) { y[j] = (f32x4){bf_lo(yb[t][j].x), bf_hi(yb[t][j].x), bf_lo(yb[t][j].y), bf_hi(yb[t][j].y)};
                    if constexpr (L0) v[j] = xf[t][j]; else v[j] = (f32x4){bf_lo(xb[t][j].x), bf_hi(xb[t][j].x), bf_lo(xb[t][j].y), bf_hi(xb[t][j].y)}; }
                deepnorm_row_c(v, y, cg, cng, cnb);
                char* xp = (char*)pg8::rfl_ptr((const char*)(dry ? (const bf16*)(ws + WS_Y + 32 * MiB) : X) + (size_t)row * (D_ * 2));
                char* hp = (char*)pg8::rfl_ptr((const char*)H + (size_t)row * (D_ * 2));
#pragma unroll
                for (int j = 0; j < 4; ++j) { { u32x2 o; o.x = cvtpk(v[j][0], v[j][1]); o.y = cvtpk(v[j][2], v[j][3]); *(u32x2*)(xp + l8 + 512 * j) = o; }
                    v[j] = v[j] * (1.0f + csc[j]) + csh[j]; u32x2 o; o.x = cvtpk(v[j][0], v[j][1]); o.y = cvtpk(v[j][2], v[j][3]); *(u32x2*)(hp + l8 + 512 * j) = o; }
                put_hilo(F.lds, F.wave * 4 + t, F.lane, v); } }
            if constexpr (!L0) { if (ps == 0) { LNR_LOAD(blk * 64 + 32 + F.wave * 4); } }
            __syncthreads();
            { const int nt = F.wave & 3, kh = F.wave >> 2, r = F.lane & 15, q = F.lane >> 4;
              f32x4 acc0, acc1; small_proj2(F.lds, kh, F.lane, wrf, wrf + 65536, acc0, acc1);
              if (kh == 0) {
#pragma unroll
                  for (int reg = 0; reg < 4; ++reg) { lg[(4 * q + reg) * 64 + 16 * nt + r] = acc0[reg]; lg[(16 + 4 * q + reg) * 64 + 16 * nt + r] = acc1[reg]; } }
              __syncthreads();
              if (kh == 1) {
#pragma unroll
                  for (int reg = 0; reg < 4; ++reg) { lg[(4 * q + reg) * 64 + 16 * nt + r] += acc0[reg]; lg[(16 + 4 * q + reg) * 64 + 16 * nt + r] += acc1[reg]; } } }
            __syncthreads();
#pragma unroll 2
            for (int rr = 0; rr < 4; ++rr) {
                const int row = rbase + rr, rl = ps * 32 + F.wave * 4 + rr;
                int ln = F.lane; asm volatile("" : "+v"(ln));
                const float logit = lg[(F.wave * 4 + rr) * 64 + F.lane];
                const float s = 1.0f / (1.0f + __expf(-logit)); const float bi = s + rb;
                float m1 = bi; m1 = fmaxf(m1, dppmov<0xB1>(m1)); m1 = fmaxf(m1, dppmov<0x4E>(m1)); m1 = fmaxf(m1, dppmov<0x141>(m1));
                const unsigned long long eq = __ballot(bi == m1);
                const int first = __ffs((int)((eq >> (ln & ~7)) & 0xffull)) - 1;
                float m2 = ((ln & 7) == first) ? -INFINITY : bi; m2 = fmaxf(m2, dppmov<0xB1>(m2)); m2 = fmaxf(m2, dppmov<0x4E>(m2)); m2 = fmaxf(m2, dppmov<0x141>(m2));
                const float gs = m1 + m2; int grank = 0;
#pragma unroll
                for (int j = 0; j < 8; ++j) { const float gj = rdlane(gs, 8 * j); grank += ((gj > gs) || (gj == gs && j < (ln >> 3))) ? 1 : 0; }
                const bool gsel = grank < 4;
                float mv = gsel ? bi : -INFINITY; int cnt = -1;
#pragma unroll
                for (int it = 0; it < TOPK; ++it) { const float mx = wave_max(mv); const unsigned long long em = __ballot(mv == mx); const int fl = __ffsll((long long)em) - 1;
                    if (ln == fl) { cnt = it; mv = -INFINITY; } }
                const bool sel = cnt >= 0;
                const float gsum = wave_sum(sel ? s : 0.f);
                if (sel) { const int lr = __hip_atomic_fetch_add(&lcnt[F.lane], 1, __ATOMIC_RELAXED, __HIP_MEMORY_SCOPE_WORKGROUP); lasg[rl * 8 + cnt] = (F.lane << 16) | lr;
                    asg_e[(size_t)row * 8 + cnt] = F.lane; ((LAS float*)(F.lds + LDS_LW))[rl * 8 + cnt] = s / gsum * 2.5f; }
            }
        }
        __syncthreads();
        if (F.tid < NEXP) { const int cn = lcnt[F.tid]; lbase[F.tid] = (cn && !dry) ? (int)atomicAdd(&gcount[F.tid], (unsigned)cn) : 0; lcnt[F.tid] = 0; }
        __syncthreads();
        { const int v = lasg[F.tid], e = v >> 16, rank = lbase[e] + (v & 0xffff); asg_r[(size_t)blk * 512 + F.tid] = rank;
          etok[(size_t)e * ECAP + rank] = blk * 64 + (F.tid >> 3); egate[(size_t)e * ECAP + rank] = ((const LAS float*)(F.lds + LDS_LW))[F.tid];
          if (F.tid < 64) { etok[(size_t)NEXP * ECAP + blk * 64 + F.tid] = blk * 64 + F.tid; egate[(size_t)NEXP * ECAP + blk * 64 + F.tid] = 1.0f; } }
        __syncthreads();
    }
#undef LNR_LOAD
}

DI void moe_scatter_phase(const Frame& F, const Args& A, int layer) {
    unsigned char* ws = opq(A.ws);
    const int* asg_e = (const int*)(ws + WS_ASG_E); const int* asg_r = (const int*)(ws + WS_ASG_R); const float* asg_w = (const float*)(ws + WS_ASG_W); int* asg_row = (int*)(ws + WS_ASG_ROW);
    int* rowtok = (int*)(ws + WS_ROWTOK); float* roww = (float*)(ws + WS_ROWW);
    const unsigned* gcount = (const unsigned*)(ws + WS_CTL) + CW_CNT + layer * 64;
    build_tileoff(F, gcount);
    const LAS int* tileoff = (const LAS int*)(F.lds + LDS_TILEOFF);
    for (int idx = F.bid * NTHR + F.tid; idx < T_ * TOPK; idx += F.G * NTHR) {
        const int e = asg_e[idx], row = 256 * tileoff[e] + asg_r[idx];
        rowtok[row] = idx >> 3; roww[row] = asg_w[idx]; asg_row[idx] = row;
    }
    for (int e = F.bid; e < NEXP; e += F.G) {
        const int cnt = (int)__hip_atomic_load(gcount + e, __ATOMIC_RELAXED, __HIP_MEMORY_SCOPE_AGENT), end = 256 * tileoff[e + 1];
        for (int row = 256 * tileoff[e] + cnt + F.tid; row < end; row += NTHR) { rowtok[row] = T_; roww[row] = 0.f; }
    }
    const int s0 = 256 * tileoff[64];
    for (int t = F.bid * NTHR + F.tid; t < T_; t += F.G * NTHR) { rowtok[s0 + t] = t; roww[s0 + t] = 1.0f; }
}

DI void ln_moe_phase(const Frame& F, const Args& A, int layer, float* dry_out) {
    unsigned char* ws = opq(A.ws);
    const float* MOD = (const float*)(ws + WS_MOD); const char* YE = (const char*)(ws + WS_BIG);
    float* AB = (float*)(ws + WS_AB);
    int s0 = 0;
    { const unsigned* gcount = (const unsigned*)(ws + WS_CTL) + CW_CNT + layer * 64; build_tileoff(F, gcount); s0 = 256 * ((const LAS int*)(F.lds + LDS_TILEOFF))[64]; }
    const int* asg_e = (const int*)(ws + WS_ASG_E); const int* asg_r = (const int*)(ws + WS_ASG_R);
    const int ls0 = layer * 2 + 1, ls1 = layer * 2 + 2; const bool last = layer == 3, want_ab = (layer & 1) == 0;
    const bf16* wabf = (const bf16*)(ws + WS_WABF) + (size_t)(layer >> 1) * 2 * 16384;
    const unsigned l4_ = (unsigned)F.lane * 4u, l8_ = (unsigned)F.lane * 8u, l16_ = (unsigned)F.lane * 16u;
    for (int blk = F.bid; blk < T_ / 64; blk += F.G) {
        const int b = blk >> 6;
        const char* gate = pg8::rfl_ptr((const char*)(MOD + (size_t)(ls0 * 4 + b) * 3072 + 2048)); const char* modn = pg8::rfl_ptr((const char*)(MOD + (size_t)((last ? ls0 : ls1) * 4 + b) * 3072));
        const char* lng = pg8::rfl_ptr((const char*)(A.ln_g + (size_t)ls0 * D_)); const char* lnb = pg8::rfl_ptr((const char*)(A.ln_b + (size_t)ls0 * D_));
        f32x4 cg[4], cng[4], cnb[4], csc[4], csh[4];
#pragma unroll
        for (int j = 0; j < 4; ++j) { cg[j] = *(const f32x4*)(gate + l16_ + 1024 * j); cng[j] = *(const f32x4*)(lng + l16_ + 1024 * j); cnb[j] = *(const f32x4*)(lnb + l16_ + 1024 * j);
            csc[j] = *(const f32x4*)(modn + 4096 + l16_ + 1024 * j); csh[j] = *(const f32x4*)(modn + l16_ + 1024 * j); }
#pragma unroll 1
        for (int ps = 0; ps < 2; ++ps) {
            const int rbase = blk * 64 + ps * 32 + F.wave * 4;
            const int ev = *(const int*)(pg8::rfl_ptr((const char*)(asg_e + (size_t)rbase * 8)) + (l4_ & 127u)), rv = *(const int*)(pg8::rfl_ptr((const char*)(asg_r + (size_t)rbase * 8)) + (l4_ & 127u));
            const int idxv = 256 * ((const LAS int*)(F.lds + LDS_TILEOFF))[ev] + rv;
#pragma unroll 1
            for (int rr = 0; rr < 4; ++rr) {
                const int row = rbase + rr; f32x4 v[4], y[4]; int w[9][4]; u32x2 sh[4];
                unsigned l4 = l4_, l8 = l8_, l16 = l16_; asm volatile("" : "+v"(l4), "+v"(l8), "+v"(l16));
#pragma unroll
                for (int k = 0; k < TOPK; ++k) { const int src = __builtin_amdgcn_readlane(idxv, rr * 8 + k); const char* p = pg8::rfl_ptr(YE + (size_t)src * D_);
#pragma unroll
                    for (int j = 0; j < 4; ++j) w[k][j] = __builtin_nontemporal_load((const int*)(p + l4 + 256 * j)); }
                if (YS_BF16) { const char* p = pg8::rfl_ptr(YE + WS_YS_OFF + (size_t)row * (D_ * 2));
#pragma unroll
                    for (int j = 0; j < 4; ++j) sh[j] = *(const u32x2*)(p + l8 + 512 * j);
                } else { const char* p = pg8::rfl_ptr(YE + (size_t)(s0 + row) * D_);
#pragma unroll
                    for (int j = 0; j < 4; ++j) w[8][j] = *(const int*)(p + l4 + 256 * j);
                }
                u32x2 xb[4];
                { const char* p = pg8::rfl_ptr((const char*)(ws + WS_X) + (size_t)row * (D_ * 2));
#pragma unroll
                  for (int j = 0; j < 4; ++j) xb[j] = *(const u32x2*)(p + l8 + 512 * j); }
                __builtin_amdgcn_sched_barrier(0);
#pragma unroll
                for (int j = 0; j < 4; ++j) { y[j] = (f32x4){0.f, 0.f, 0.f, 0.f}; v[j] = (f32x4){bf_lo(xb[j].x), bf_hi(xb[j].x), bf_lo(xb[j].y), bf_hi(xb[j].y)}; }
#pragma unroll
                for (int k = 0; k < (YS_BF16 ? TOPK : TOPK + 1); ++k) {
                    asm volatile("" : "+v"(w[k][0]), "+v"(w[k][1]), "+v"(w[k][2]), "+v"(w[k][3]), "+v"(y[0]), "+v"(y[1]), "+v"(y[2]), "+v"(y[3]));
#pragma unroll
                    for (int j = 0; j < 4; ++j) { const f32x2 a = __builtin_amdgcn_cvt_pk_f32_fp8(w[k][j], false), c = __builtin_amdgcn_cvt_pk_f32_fp8(w[k][j], true);
                        y[j][0] += a[0]; y[j][1] += a[1]; y[j][2] += c[0]; y[j][3] += c[1]; }
                    __builtin_amdgcn_sched_barrier(0);
                }
#pragma unroll
                for (int j = 0; j < 4; ++j) y[j] = y[j] * (1.0f / YE_SCALE);
                if (YS_BF16) {
#pragma unroll
                    for (int j = 0; j < 4; ++j) { y[j][0] += bf_lo(sh[j].x); y[j][1] += bf_hi(sh[j].x); y[j][2] += bf_lo(sh[j].y); y[j][3] += bf_hi(sh[j].y); }
                }
                deepnorm_row_c(v, y, cg, cng, cnb);
                if (last || dry_out) { char* op = (char*)pg8::rfl_ptr((const char*)(dry_out ? dry_out : A.out) + (size_t)row * (D_ * 4));
#pragma unroll
                    for (int j = 0; j < 4; ++j) *(f32x4*)(op + l16 + 1024 * j) = v[j];
                } else { char* xp = (char*)pg8::rfl_ptr((const char*)(ws + WS_X) + (size_t)row * (D_ * 2));
#pragma unroll
                    for (int j = 0; j < 4; ++j) { u32x2 o; o.x = cvtpk(v[j][0], v[j][1]); o.y = cvtpk(v[j][2], v[j][3]); *(u32x2*)(xp + l8 + 512 * j) = o; } }
                if (!last) { char* hp = (char*)pg8::rfl_ptr((const char*)(ws + WS_H) + (size_t)row * (D_ * 2));
#pragma unroll
                    for (int j = 0; j < 4; ++j) { v[j] = v[j] * (1.0f + csc[j]) + csh[j]; u32x2 o; o.x = cvtpk(v[j][0], v[j][1]); o.y = cvtpk(v[j][2], v[j][3]); *(u32x2*)(hp + l8 + 512 * j) = o; }
                    if (want_ab) put_hilo(F.lds, F.wave * 4 + rr, F.lane, v);
                }
            }
            if (!last && want_ab) {
                __syncthreads();
                if (F.wave < 2) { const int mt = F.wave, r = F.lane & 15, q = F.lane >> 4;
                    const f32x4 acc = small_proj(F.lds, mt, F.lane, wabf, wabf + 16384);
#pragma unroll
                    for (int reg = 0; reg < 4; ++reg) AB[(size_t)(blk * 64 + ps * 32 + 16 * mt + 4 * q + reg) * 16 + r] = acc[reg]; }
                __syncthreads();
            }
        }
    }
}
DI int crow(int r, int h) { return (r & 3) + 8 * (r >> 2) + 4 * h; }
typedef short v4i16_t __attribute__((ext_vector_type(4)));
DI s16x4 vtr(const LAS unsigned char* p) { return __builtin_bit_cast(s16x4, __builtin_amdgcn_ds_read_tr16_b64_v4i16((LAS v4i16_t*)p)); }
#define MFMA32(a, b, c) __builtin_amdgcn_mfma_f32_32x32x16_bf16((a), (b), (c), 0, 0, 0)
constexpr int ATT_ORUN = 0, ATT_LRUN = 65536, ATT_VBUF = 65536 + 2048, ATT_VSTRIDE = 144, ATT_VBYTES = 32 * ATT_VSTRIDE;

#ifndef REP_A1
#define REP_A1 1
#define REP_A2 1
#endif
DI void attn_phase(const Frame& F, const Args& A) {
    unsigned char* ws = opq(A.ws);
    const bf16* QKV = (const bf16*)(ws + WS_BIG); bf16* O = (bf16*)(ws + WS_O);
    LAS unsigned char* orun = F.lds + ATT_ORUN;
    LAS float* lrun = (LAS float*)(F.lds + ATT_LRUN);
    LAS unsigned char* vbuf = F.lds + ATT_VBUF + F.wave * ATT_VBYTES;
    const int lane = F.lane, qi = lane & 31, h = lane >> 5;
    const int g16 = lane >> 4, q4 = (lane & 15) >> 2, p4 = lane & 3;
    for (int it = F.bid; it < NB_ * 16 * 8; it += F.G) {
        int item = it;
        if (F.G == 256) { const int w = it & 255, xcd = w & 7, j = w >> 3; item = (((it >> 8) * 32 + xcd * 4 + (j >> 3)) << 3) | (j & 7); }
        const int b = item >> 7, head = (item >> 3) & 15, ck = item & 7;
        for (int gi = 0; gi < 3; ++gi) {
            const int g = 2 - gi, ldil = 2 * g, Lg = S_ >> ldil;
            const size_t hb = (((size_t)g * NB_ + b) * 16 + head) * S_ * 64;
            const bf16* Qg = QKV + hb; const bf16* Kg = QKV + (size_t)3 * NB_ * 16 * S_ * 64 + hb; const bf16* Vg = QKV + (size_t)6 * NB_ * 16 * S_ * 64 + hb;
            for (int sub = F.wave; sub < 16; sub += NWAVES) {
                int r_, tile;
                if (g == 0) { r_ = 0; tile = sub; } else if (g == 1) { r_ = sub >> 2; tile = sub & 3; } else { r_ = sub; tile = 0; }
                const int m0 = ((512 * ck) >> ldil) + 32 * tile;
                const bf16* Kr = Kg + (size_t)r_ * Lg * 64; const bf16* Vr = Vg + (size_t)r_ * Lg * 64;
                f32x16 st[5]; u32x4 vv[5][4]; float mx, lsum;
#pragma unroll 1
                for (int rep1 = 0; rep1 < REP_A1; ++rep1) {
                unsigned lc = (unsigned)((lane >> 3) * 128 + (lane & 7) * 16); asm volatile("" : "+v"(lc));
                const int wofs = (lane >> 3) * ATT_VSTRIDE + (lane & 7) * 16, rofs = qi * ATT_VSTRIDE + 64 * h;
                u32x4 qv[4], kv[5][4];
                { const char* qp = pg8::rfl_ptr((const char*)(Qg + ((size_t)r_ * Lg + m0) * 64));
#pragma unroll
                  for (int i = 0; i < 4; ++i) qv[i] = *(const u32x4*)(qp + lc + 1024 * i); }
#pragma unroll
                for (int kt = 0; kt < 5; ++kt) { const int mk0 = m0 - 128 + 32 * kt; const char* kp = pg8::rfl_ptr((const char*)(Kr + (size_t)(mk0 < 0 ? 0 : mk0) * 64));
#pragma unroll
                    for (int i = 0; i < 4; ++i) kv[kt][i] = *(const u32x4*)(kp + lc + 1024 * i); }
                __builtin_amdgcn_sched_barrier(0);
                bf16x8 qf[4];
#pragma unroll
                for (int i = 0; i < 4; ++i) *(LAS u32x4*)(vbuf + wofs + 8 * i * ATT_VSTRIDE) = qv[i];
                LDS_WAIT(); asm volatile("" ::: "memory");
#pragma unroll
                for (int s = 0; s < 4; ++s) qf[s] = *(const LAS bf16x8*)(vbuf + rofs + 16 * s);
                LDS_WAIT(); asm volatile("" ::: "memory");
#pragma unroll
                for (int kt = 0; kt < 5; ++kt) {
                    const int mk0 = m0 - 128 + 32 * kt;
                    bf16x8 kf[4];
#pragma unroll
                    for (int i = 0; i < 4; ++i) *(LAS u32x4*)(vbuf + wofs + 8 * i * ATT_VSTRIDE) = kv[kt][i];
                    LDS_WAIT(); asm volatile("" ::: "memory");
#pragma unroll
                    for (int s = 0; s < 4; ++s) kf[s] = *(const LAS bf16x8*)(vbuf + rofs + 16 * s);
                    { const char* vp = pg8::rfl_ptr((const char*)(Vr + (size_t)(mk0 < 0 ? 0 : mk0) * 64));
#pragma unroll
                      for (int i = 0; i < 4; ++i) vv[kt][i] = *(const u32x4*)(vp + lc + 1024 * i); }
                    LDS_WAIT(); asm volatile("" ::: "memory");
#pragma unroll
                    for (int r = 0; r < 16; ++r) st[kt][r] = 0.f;
#pragma unroll
                    for (int s = 0; s < 4; ++s) st[kt] = MFMA32(kf[s], qf[s], st[kt]);
                    if (mk0 < 0) {
#pragma unroll
                        for (int r = 0; r < 16; ++r) st[kt][r] = -INFINITY;
                    }
                }
#pragma unroll
                for (int r = 0; r < 16; ++r) { const int kr = crow(r, h); if (kr < qi) st[0][r] = -INFINITY; if (kr > qi) st[4][r] = -INFINITY; }
                mx = -INFINITY;
#pragma unroll
                for (int kt = 0; kt < 5; ++kt)
#pragma unroll
                    for (int r = 0; r < 16; ++r) mx = fmaxf(mx, st[kt][r]);
                mx = fmaxf(mx, bperm(mx, F.lane ^ 32));
                lsum = 0.f;
#pragma unroll
                for (int kt = 0; kt < 5; ++kt)
#pragma unroll
                    for (int r = 0; r < 16; ++r) { const float p = __builtin_amdgcn_exp2f(st[kt][r] - mx); st[kt][r] = p; lsum += p; }
                lsum += bperm(lsum, F.lane ^ 32);
                }
                f32x16 oacc[2];
#pragma unroll 1
                for (int rep2 = 0; rep2 < REP_A2; ++rep2) {
#pragma unroll
                for (int r = 0; r < 16; ++r) { oacc[0][r] = 0.f; oacc[1][r] = 0.f; }
#pragma unroll
                for (int kt = 0; kt < 5; ++kt) {
                    const int mk0 = m0 - 128 + 32 * kt;
                    if (mk0 >= 0) {
#pragma unroll
                        for (int i = 0; i < 4; ++i) *(LAS u32x4*)(vbuf + ((lane >> 3) + 8 * i) * ATT_VSTRIDE + (lane & 7) * 16) = vv[kt][i];
                        LDS_WAIT(); asm volatile("" ::: "memory");
                        s16x4 flo[2][2], fhi[2][2];
#pragma unroll
                        for (int sp = 0; sp < 2; ++sp)
#pragma unroll
                            for (int dvt = 0; dvt < 2; ++dvt) {
                                const int colb = (32 * dvt + 16 * (g16 & 1) + 4 * p4) * 2;
                                flo[sp][dvt] = vtr(vbuf + (16 * sp + 4 * h + q4) * ATT_VSTRIDE + colb);
                                fhi[sp][dvt] = vtr(vbuf + (16 * sp + 8 + 4 * h + q4) * ATT_VSTRIDE + colb);
                            }
                        LDS_WAIT(); asm volatile("" ::: "memory");
#pragma unroll
                        for (int sp = 0; sp < 2; ++sp) {
                            bf16x8 pf; {
                                const unsigned w0 = cvtpk(st[kt][8 * sp + 0], st[kt][8 * sp + 1]), w1 = cvtpk(st[kt][8 * sp + 2], st[kt][8 * sp + 3]);
                                const unsigned w2 = cvtpk(st[kt][8 * sp + 4], st[kt][8 * sp + 5]), w3 = cvtpk(st[kt][8 * sp + 6], st[kt][8 * sp + 7]);
                                pf = __builtin_bit_cast(bf16x8, (u32x4){w0, w1, w2, w3}); }
#pragma unroll
                            for (int dvt = 0; dvt < 2; ++dvt) {
                                const bf16x8 vf = __builtin_shufflevector(flo[sp][dvt], fhi[sp][dvt], 0, 1, 2, 3, 4, 5, 6, 7);
                                oacc[dvt] = MFMA32(vf, pf, oacc[dvt]);
                            }
                        }
                    }
                }
                asm volatile("" : "+v"(oacc[0]), "+v"(oacc[1]));
                }
                const float inv = __builtin_amdgcn_rcpf(lsum), lse = mx + __builtin_amdgcn_logf(lsum);
                const int tl = ((32 * tile + qi) << ldil) + r_;
                float wa = 0.f, wb = 1.f;
                if (gi > 0) { const float L0 = lrun[tl]; const float M = fmaxf(L0, lse); const float ea = __builtin_amdgcn_exp2f(L0 - M), eb = __builtin_amdgcn_exp2f(lse - M);
                    const float isum = __builtin_amdgcn_rcpf(ea + eb); wa = ea * isum; wb = eb * isum; asm volatile("" ::: "memory");
                    if (h == 0) lrun[tl] = M + __builtin_amdgcn_logf(ea + eb); }
                else if (h == 0) lrun[tl] = lse;
                wb *= inv;
#pragma unroll
                for (int dvt = 0; dvt < 2; ++dvt)
#pragma unroll
                    for (int k4 = 0; k4 < 4; ++k4) {
                        const int dv = 32 * dvt + 8 * k4 + 4 * h;
                        float o0 = oacc[dvt][4 * k4 + 0] * wb, o1 = oacc[dvt][4 * k4 + 1] * wb, o2 = oacc[dvt][4 * k4 + 2] * wb, o3 = oacc[dvt][4 * k4 + 3] * wb;
                        LAS u32x2* op = (LAS u32x2*)(orun + tl * 128 + dv * 2);
                        if (gi > 0) { const u32x2 w = *op; o0 += wa * bf_lo(w.x); o1 += wa * bf_hi(w.x); o2 += wa * bf_lo(w.y); o3 += wa * bf_hi(w.y); }
                        u32x2 wo; wo.x = cvtpk(o0, o1); wo.y = cvtpk(o2, o3);
                        if (gi < 2) *op = wo;
                        else *(u32x2*)(O + ((size_t)b * S_ + 512 * ck + tl) * D_ + head * 64 + dv) = wo;
                    }
            }
            __syncthreads();
        }
    }
}

DI void gdn_post_phase(const Frame& F, const Args& A, int j) {
    unsigned char* ws = opq(A.ws); unsigned char* big = ws + WS_BIG;
    const bf16* Oraw = (const bf16*)(ws + WS_Y); const bf16* PROJ = (const bf16*)(big + BIG_PROJ); bf16* O = (bf16*)(ws + WS_O);
    const float* nw = A.gdn_norm_w + (size_t)j * 128;
    const int gw = F.bid * NWAVES + F.wave, NGW = F.G * NWAVES, lane = F.lane;
    const f32x4 nwv = *(const f32x4*)(nw + ((4 * lane) & 127));
    const unsigned l8_ = (unsigned)lane * 8u;
#pragma unroll 2
    for (int row = gw; row < T_; row += NGW) {
        unsigned l8 = l8_; asm volatile("" : "+v"(l8));
        const char* op = pg8::rfl_ptr((const char*)(Oraw + (size_t)row * D_)); const char* zp = pg8::rfl_ptr((const char*)(PROJ + (size_t)row * 4096 + 3072));
        u32x2 ow[4], zw[4];
#pragma unroll
        for (int jj = 0; jj < 4; ++jj) { ow[jj] = *(const u32x2*)(op + l8 + 512 * jj); zw[jj] = *(const u32x2*)(zp + l8 + 512 * jj); }
        f32x4 v[4];
#pragma unroll
        for (int jj = 0; jj < 4; ++jj) {
            v[jj] = (f32x4){bf_lo(ow[jj].x), bf_hi(ow[jj].x), bf_lo(ow[jj].y), bf_hi(ow[jj].y)};
            float ss = (v[jj][0] * v[jj][0] + v[jj][1] * v[jj][1]) + (v[jj][2] * v[jj][2] + v[jj][3] * v[jj][3]);
            ss += dppmov<0xB1>(ss); ss += dppmov<0x4E>(ss); ss += dppmov<0x141>(ss); ss += dppmov<0x140>(ss); ss += shx<16>(ss);
            const float rs = rsqrtf(ss * (1.0f / 128.0f) + RMS_EPS);
            const float z0 = bf_lo(zw[jj].x), z1 = bf_hi(zw[jj].x), z2 = bf_lo(zw[jj].y), z3 = bf_hi(zw[jj].y);
            v[jj][0] = v[jj][0] * rs * nwv[0] * silu_f(z0); v[jj][1] = v[jj][1] * rs * nwv[1] * silu_f(z1);
            v[jj][2] = v[jj][2] * rs * nwv[2] * silu_f(z2); v[jj][3] = v[jj][3] * rs * nwv[3] * silu_f(z3);
        }
        store_row16_bf16(O + (size_t)row * D_, lane, v);
    }
}
constexpr size_t GB_KR = 128 * MiB, GB_QR = 160 * MiB, GB_KT = 192 * MiB, GB_VT = 224 * MiB, GB_BLOB = 256 * MiB;
constexpr int BLOB_ELEMS = 28672, BLOB_W = 0, BLOB_QG = 8192, BLOB_QK = 16384, BLOB_KDT = 20480;
DI int frag_pos(int row, int k, int nks) { const int kk = k & 31; return ((((row >> 4) * nks + (k >> 5)) * 64 + ((kk >> 2) & 3) * 16 + (row & 15)) * 8) + 4 * (kk >> 4) + (kk & 3); }
#define MFMA16(a, b, c) __builtin_amdgcn_mfma_f32_16x16x32_bf16((a), (b), (c), 0, 0, 0)
DI u32x2 pk4(float a, float b, float c, float d) { u32x2 w; w.x = cvtpk(a, b); w.y = cvtpk(c, d); return w; }

DI int tile_off(int t, int c) { return t * 256 + ((((c >> 4) ^ (t & 7)) << 5) | ((c & 15) << 1)); }
template <int WH> DI void prep_conv_pass(const bf16* PROJ, const float* cw, int b, int hh, int t0, int lane, LAS unsigned char* tile, bf16* rowdst, const LAS float* escale, bool normalize, float nscale) {
    float w[4][2];
#pragma unroll
    for (int jj = 0; jj < 4; ++jj) { const f32x2 t = *(const f32x2*)(cw + (size_t)jj * 3072 + WH * 1024 + hh * 128 + 2 * lane); w[jj][0] = t.x; w[jj][1] = t.y; }
    float A0[35], A1[35];
#pragma unroll
    for (int jj = 0; jj < 3; ++jj) { const int t = t0 - 3 + jj; unsigned u = 0u;
        if (t >= 0) u = *(const unsigned*)(PROJ + ((size_t)b * S_ + t) * 4096 + WH * 1024 + hh * 128 + 2 * lane);
        A0[jj] = bf_lo(u); A1[jj] = bf_hi(u); }
#pragma unroll 1
    for (int hb = 0; hb < 2; ++hb) {
        { unsigned xin[32];
#pragma unroll
          for (int i = 0; i < 32; ++i) xin[i] = __builtin_nontemporal_load((const unsigned*)(PROJ + ((size_t)b * S_ + t0 + 32 * hb + i) * 4096 + WH * 1024 + hh * 128 + 2 * lane));
#pragma unroll
          for (int i = 0; i < 32; ++i) { A0[3 + i] = bf_lo(xin[i]); A1[3 + i] = bf_hi(xin[i]); } }
#pragma unroll
        for (int i = 0; i < 32; ++i) {
            A0[i] = w[0][0] * A0[i] + w[1][0] * A0[i + 1] + w[2][0] * A0[i + 2] + w[3][0] * A0[i + 3];
            A1[i] = w[0][1] * A1[i] + w[1][1] * A1[i + 1] + w[2][1] * A1[i + 2] + w[3][1] * A1[i + 3]; }
#pragma unroll
        for (int i = 0; i < 32; ++i) { A0[i] = silu_f(A0[i]); A1[i] = silu_f(A1[i]); }
        if (normalize) {
            float rs[32];
#pragma unroll
            for (int i = 0; i < 32; ++i) rs[i] = wave_sum(A0[i] * A0[i] + A1[i] * A1[i]);
#pragma unroll
            for (int i = 0; i < 32; ++i) { const float r = rsqrtf(rs[i] + RMS_EPS) * nscale; A0[i] *= r; A1[i] *= r; }
        }
#pragma unroll
        for (int i = 0; i < 32; ++i) {
            const int tt = 32 * hb + i;
            if (rowdst) *(unsigned*)(rowdst + (size_t)tt * 128 + 2 * lane) = cvtpk(A0[i], A1[i]);
            const float es = escale ? escale[tt] : 1.0f;
            *(LAS unsigned*)(tile + tile_off(tt, 2 * lane)) = cvtpk(A0[i] * es, A1[i] * es);
        }
#pragma unroll
        for (int jj = 0; jj < 3; ++jj) { A0[jj] = A0[32 + jj]; A1[jj] = A1[32 + jj]; }
    }
    LDS_WAIT(); asm volatile("" ::: "memory");
}
DI void tile_tr8(const LAS unsigned char* tile, int tb, int tb2, int cb, int lane, s16x4& lo, s16x4& hi) {
    const int q4 = (lane & 15) >> 2, p4 = lane & 3;
    lo = vtr(tile + tile_off(tb + q4, cb + 4 * p4)); hi = vtr(tile + tile_off(tb2 + q4, cb + 4 * p4));
}
DI void gdn_prep2_phase(const Frame& F, const Args& A, int j) {
    unsigned char* ws = opq(A.ws); unsigned char* big = ws + WS_BIG;
    const bf16* PROJ = (const bf16*)(big + BIG_PROJ);
    bf16* KR = (bf16*)(big + GB_KR); bf16* QR = (bf16*)(big + GB_QR); bf16* KT = (bf16*)(big + GB_KT); bf16* VT = (bf16*)(big + GB_VT); bf16* BLOB = (bf16*)(big + GB_BLOB);
    const float* AB = (const float*)(ws + WS_AB); float* GC = (float*)(ws + WS_GALPHA); float* GB = (float*)(ws + WS_GBETA);
    const float* cw = A.gdn_conv_w + (size_t)j * 4 * 3072;
    const int gw = F.bid * NWAVES + F.wave, NGW = F.G * NWAVES, lane = F.lane, g16 = lane >> 4, i16 = lane & 15;
    LAS unsigned char* tile = F.lds + F.wave * 16384;
    LAS float* egl = (LAS float*)(F.lds + LDS_LG + F.wave * 512); LAS float* ekl = egl + 64;
    for (int it = gw; it < NB_ * 8 * 64; it += NGW) {
        const int b = it >> 9, hh = (it >> 6) & 7, n = it & 63, t0 = 64 * n, bh = b * 8 + hh;
        { const int row = b * S_ + t0 + lane; const float a = AB[(size_t)row * 16 + hh], bl = AB[(size_t)row * 16 + 8 + hh];
          const float xs = a + A.gdn_dt_bias[j * 8 + hh]; const float ey = __expf(xs); const float sp = xs > 20.f ? xs : (ey < 1e-3f ? ey * (1.0f - 0.5f * ey) : __logf(1.0f + ey));
          float gc = -__expf(A.gdn_a_log[j * 8 + hh]) * sp;
#pragma unroll
          for (int o = 1; o < 64; o <<= 1) { const float t = bperm(gc, lane - o); if (lane >= o) gc += t; }
          const float gl = rdlane(gc, 63);
          GC[(size_t)bh * S_ + t0 + lane] = gc; GB[(size_t)bh * S_ + t0 + lane] = 1.0f / (1.0f + __expf(-bl));
          egl[lane] = __expf(gc); ekl[lane] = __expf(gl - gc); }
        LDS_WAIT(); asm volatile("" ::: "memory");
        bf16* blob = BLOB + (size_t)it * BLOB_ELEMS;
        bf16* ktc = KT + (size_t)it * 8192; bf16* vtc = VT + (size_t)it * 8192;
        const size_t rbase = ((size_t)bh * S_ + t0) * 128;
        prep_conv_pass<1>(PROJ, cw, b, hh, t0, lane, tile, KR + rbase, nullptr, true, 1.0f);
#pragma unroll 2
        for (int db = 0; db < 8; ++db)
#pragma unroll
            for (int half = 0; half < 2; ++half) { s16x4 lo, hi; const int tb = 32 * half + 8 * g16; tile_tr8(tile, tb, tb + 4, 16 * db, lane, lo, hi);
                *(bf16x8*)(ktc + (16 * db + i16) * 64 + tb) = __builtin_shufflevector(lo, hi, 0, 1, 2, 3, 4, 5, 6, 7); }
#pragma unroll 2
        for (int a = 0; a < 8; ++a)
#pragma unroll
            for (int ks = 0; ks < 2; ++ks) { s16x4 lo, hi; const int tb = 32 * ks + 4 * g16; tile_tr8(tile, tb, tb + 16, 16 * a, lane, lo, hi);
                const f32x4 e0 = *(const LAS f32x4*)(ekl + tb), e1 = *(const LAS f32x4*)(ekl + tb + 16);
                u32x4 wv;
                wv.x = cvtpk(bf_lo((unsigned)(unsigned short)lo[0]) * e0[0], bf_lo((unsigned)(unsigned short)lo[1]) * e0[1]); wv.y = cvtpk(bf_lo((unsigned)(unsigned short)lo[2]) * e0[2], bf_lo((unsigned)(unsigned short)lo[3]) * e0[3]);
                wv.z = cvtpk(bf_lo((unsigned)(unsigned short)hi[0]) * e1[0], bf_lo((unsigned)(unsigned short)hi[1]) * e1[1]); wv.w = cvtpk(bf_lo((unsigned)(unsigned short)hi[2]) * e1[2], bf_lo((unsigned)(unsigned short)hi[3]) * e1[3]);
                *(u32x4*)(blob + BLOB_KDT + ((a * 2 + ks) * 64 + lane) * 8) = wv; }
        LDS_WAIT(); asm volatile("" ::: "memory");
        prep_conv_pass<2>(PROJ, cw, b, hh, t0, lane, tile, nullptr, nullptr, false, 1.0f);
#pragma unroll 2
        for (int db = 0; db < 8; ++db)
#pragma unroll
            for (int half = 0; half < 2; ++half) { s16x4 lo, hi; const int tb = 32 * half + 8 * g16; tile_tr8(tile, tb, tb + 4, 16 * db, lane, lo, hi);
                *(bf16x8*)(vtc + (16 * db + i16) * 64 + tb) = __builtin_shufflevector(lo, hi, 0, 1, 2, 3, 4, 5, 6, 7); }
        LDS_WAIT(); asm volatile("" ::: "memory");
        prep_conv_pass<0>(PROJ, cw, b, hh, t0, lane, tile, QR + rbase, egl, true, 0.08838834764831845f);
#pragma unroll 2
        for (int tm = 0; tm < 4; ++tm)
#pragma unroll
            for (int ks = 0; ks < 4; ++ks) {
                const u32x2 p0 = *(const LAS u32x2*)(tile + tile_off(16 * tm + i16, 32 * ks + 4 * g16)), p1 = *(const LAS u32x2*)(tile + tile_off(16 * tm + i16, 32 * ks + 16 + 4 * g16));
                *(u32x4*)(blob + BLOB_QG + ((tm * 4 + ks) * 64 + lane) * 8) = (u32x4){p0.x, p0.y, p1.x, p1.y}; }
        LDS_WAIT(); asm volatile("" ::: "memory");
    }
}

DI void gdn_wy_phase(const Frame& F, const Args& A) {
    unsigned char* ws = opq(A.ws); unsigned char* big = ws + WS_BIG;
    const bf16* KR = (const bf16*)(big + GB_KR); const bf16* QR = (const bf16*)(big + GB_QR); const bf16* KT = (const bf16*)(big + GB_KT); const bf16* VT = (const bf16*)(big + GB_VT);
    bf16* BLOB = (bf16*)(big + GB_BLOB); float* U = (float*)(ws + WS_HID);
    const float* GC = (const float*)(ws + WS_GALPHA); const float* GB = (const float*)(ws + WS_GBETA);
    const int gw = F.bid * NWAVES + F.wave, NGW = F.G * NWAVES, lane = F.lane, r = lane & 15, q = lane >> 4;
    LAS float* Af = (LAS float*)(F.lds + F.wave * 16384);
    asm volatile("s_waitcnt vmcnt(0)" ::: "memory"); __builtin_amdgcn_fence(__ATOMIC_ACQUIRE, "agent");
    for (int it = gw; it < NB_ * 8 * 64; it += NGW) {
        const int bh = it >> 6, n = it & 63;
        const char* kr = pg8::rfl_ptr((const char*)(KR + ((size_t)bh * S_ + 64 * n) * 128)); const char* qr = pg8::rfl_ptr((const char*)(QR + ((size_t)bh * S_ + 64 * n) * 128));
        const char* kt = pg8::rfl_ptr((const char*)(KT + (size_t)it * 8192)); const char* vt = pg8::rfl_ptr((const char*)(VT + (size_t)it * 8192));
        char* blob = (char*)pg8::rfl_ptr((const char*)(BLOB + (size_t)it * BLOB_ELEMS)); char* ub = (char*)pg8::rfl_ptr((const char*)(U + (size_t)it * 8192));
        const unsigned lrow = (unsigned)(r * 128 + 8 * q) * 2u, ltr = (unsigned)(r * 64 + 8 * q) * 2u, lfrag = (unsigned)(q * 16 + r) * 16u;
        const float gcl = GC[(size_t)bh * S_ + 64 * n + lane], bel = GB[(size_t)bh * S_ + 64 * n + lane];
        __builtin_amdgcn_wave_barrier();
        bf16x8 kfr[4][4], qfr[4][4];
#pragma unroll
        for (int t4 = 0; t4 < 4; ++t4)
#pragma unroll
            for (int ks = 0; ks < 4; ++ks) { kfr[t4][ks] = *(const bf16x8*)(kr + lrow + (16 * t4 * 128 + 32 * ks) * 2); qfr[t4][ks] = *(const bf16x8*)(qr + lrow + (16 * t4 * 128 + 32 * ks) * 2); }
#pragma unroll
        for (int ti = 0; ti < 4; ++ti) {
            const float gi = bperm(gcl, 16 * ti + r), bi = bperm(bel, 16 * ti + r);
#pragma unroll
            for (int tj = 0; tj < 4; ++tj) {
                char* qkdst = blob + (BLOB_QK + ((ti * 2 + (tj >> 1)) * 64) * 8 + 4 * (tj & 1)) * 2 + lfrag;
                if (tj > ti) { *(u32x2*)qkdst = (u32x2){0u, 0u}; *(LAS f32x4*)(Af + (16 * ti + r) * 64 + 16 * tj + 4 * q) = (f32x4){0.f, 0.f, 0.f, 0.f}; continue; }
                f32x4 p1 = (f32x4){0.f, 0.f, 0.f, 0.f}, p2 = p1;
#pragma unroll
                for (int ks = 0; ks < 4; ++ks) { p1 = MFMA16(kfr[tj][ks], kfr[ti][ks], p1); p2 = MFMA16(kfr[tj][ks], qfr[ti][ks], p2); }
                const int i = 16 * ti + r; f32x4 av, qv;
#pragma unroll
                for (int reg = 0; reg < 4; ++reg) { const int jx = 16 * tj + 4 * q + reg; const float gj = bperm(gcl, jx);
                    const float dec = (jx <= i) ? __expf(gi - gj) : 0.f;
                    av[reg] = (jx < i) ? bi * p1[reg] * dec : 0.f; qv[reg] = p2[reg] * dec; }
                *(LAS f32x4*)(Af + i * 64 + 16 * tj + 4 * q) = av;
                *(u32x2*)qkdst = pk4(qv[0], qv[1], qv[2], qv[3]);
                asm volatile("" ::: "memory");
            }
        }
        LDS_WAIT(); asm volatile("" ::: "memory");
#pragma unroll 1
        for (int i0 = 0; i0 < 64; i0 += 4) {
            float a0 = (i0 + 0 == lane) ? 1.0f : 0.0f, a1 = (i0 + 1 == lane) ? 1.0f : 0.0f, a2 = (i0 + 2 == lane) ? 1.0f : 0.0f, a3 = (i0 + 3 == lane) ? 1.0f : 0.0f;
#pragma unroll 2
            for (int j4 = 0; j4 < (i0 >> 2); ++j4) {
                const float t0 = Af[(4 * j4 + 0) * 64 + lane], t1 = Af[(4 * j4 + 1) * 64 + lane], t2 = Af[(4 * j4 + 2) * 64 + lane], t3 = Af[(4 * j4 + 3) * 64 + lane];
                const f32x4 r0 = *(const LAS f32x4*)(Af + (i0 + 0) * 64 + 4 * j4), r1 = *(const LAS f32x4*)(Af + (i0 + 1) * 64 + 4 * j4);
                const f32x4 r2 = *(const LAS f32x4*)(Af + (i0 + 2) * 64 + 4 * j4), r3 = *(const LAS f32x4*)(Af + (i0 + 3) * 64 + 4 * j4);
                a0 -= r0[0] * t0 + r0[1] * t1 + r0[2] * t2 + r0[3] * t3; a1 -= r1[0] * t0 + r1[1] * t1 + r1[2] * t2 + r1[3] * t3;
                a2 -= r2[0] * t0 + r2[1] * t1 + r2[2] * t2 + r2[3] * t3; a3 -= r3[0] * t0 + r3[1] * t1 + r3[2] * t2 + r3[3] * t3;
            }
            const f32x4 d1 = *(const LAS f32x4*)(Af + (i0 + 1) * 64 + i0), d2 = *(const LAS f32x4*)(Af + (i0 + 2) * 64 + i0), d3 = *(const LAS f32x4*)(Af + (i0 + 3) * 64 + i0);
            a1 -= d1[0] * a0; a2 -= d2[0] * a0 + d2[1] * a1; a3 -= d3[0] * a0 + d3[1] * a1 + d3[2] * a2;
            LDS_WAIT(); asm volatile("" ::: "memory");
            Af[(i0 + 0) * 64 + lane] = a0; Af[(i0 + 1) * 64 + lane] = a1; Af[(i0 + 2) * 64 + lane] = a2; Af[(i0 + 3) * 64 + lane] = a3;
            LDS_WAIT(); asm volatile("" ::: "memory");
        }
        bf16x8 tuf[4][2], twf[4][2];
        {
            const float* gcp = GC + (size_t)bh * S_ + 64 * n; const float* gbp = GB + (size_t)bh * S_ + 64 * n;
#pragma unroll
            for (int ks = 0; ks < 2; ++ks) {
                float su[8], sw[8];
#pragma unroll
                for (int h4 = 0; h4 < 2; ++h4) { const f32x4 bv = *(const f32x4*)(gbp + 32 * ks + 8 * q + 4 * h4), gv = *(const f32x4*)(gcp + 32 * ks + 8 * q + 4 * h4);
#pragma unroll
                    for (int e = 0; e < 4; ++e) { su[4 * h4 + e] = bv[e]; sw[4 * h4 + e] = -bv[e] * __expf(gv[e]); } }
#pragma unroll
                for (int tm = 0; tm < 4; ++tm) {
                    const f32x4 x0 = *(const LAS f32x4*)(Af + (16 * tm + r) * 64 + 32 * ks + 8 * q), x1 = *(const LAS f32x4*)(Af + (16 * tm + r) * 64 + 32 * ks + 8 * q + 4);
                    tuf[tm][ks] = __builtin_bit_cast(bf16x8, (u32x4){cvtpk(x0[0] * su[0], x0[1] * su[1]), cvtpk(x0[2] * su[2], x0[3] * su[3]), cvtpk(x1[0] * su[4], x1[1] * su[5]), cvtpk(x1[2] * su[6], x1[3] * su[7])});
                    twf[tm][ks] = __builtin_bit_cast(bf16x8, (u32x4){cvtpk(x0[0] * sw[0], x0[1] * sw[1]), cvtpk(x0[2] * sw[2], x0[3] * sw[3]), cvtpk(x1[0] * sw[4], x1[1] * sw[5]), cvtpk(x1[2] * sw[6], x1[3] * sw[7])});
                }
            }
        }
        LDS_WAIT(); asm volatile("" ::: "memory");
        {
#pragma unroll
            for (int w8 = 0; w8 < 8; ++w8) {
                bf16x8 vb[2];
#pragma unroll
                for (int ks = 0; ks < 2; ++ks) vb[ks] = *(const bf16x8*)(vt + ltr + (16 * w8 * 64 + 32 * ks) * 2);
#pragma unroll
                for (int tm = 0; tm < 4; ++tm) { f32x4 acc = (f32x4){0.f, 0.f, 0.f, 0.f};
#pragma unroll
                    for (int ks = 0; ks < 2; ++ks) acc = MFMA16(tuf[tm][ks], vb[ks], acc);
                    *(f32x4*)(ub + (unsigned)lane * 16u + ((w8 * 4 + tm) * 64) * 16) = acc; }
            }
        }
        {
#pragma unroll
            for (int a = 0; a < 8; ++a) {
                bf16x8 ka[2];
#pragma unroll
                for (int ks = 0; ks < 2; ++ks) ka[ks] = *(const bf16x8*)(kt + ltr + (16 * a * 64 + 32 * ks) * 2);
#pragma unroll
                for (int ti = 0; ti < 4; ++ti) { f32x4 acc = (f32x4){0.f, 0.f, 0.f, 0.f};
#pragma unroll
                    for (int ks = 0; ks < 2; ++ks) acc = MFMA16(ka[ks], twf[ti][ks], acc);
                    *(u32x2*)(blob + (BLOB_W + ((ti * 4 + (a >> 1)) * 64) * 8 + 4 * (a & 1)) * 2 + lfrag) = pk4(acc[0], acc[1], acc[2], acc[3]); }
            }
        }
        LDS_WAIT(); asm volatile("" ::: "memory");
    }
}

constexpr int SCAN_BUF = BLOB_ELEMS * 2;
DI bf16x8 pack8(const f32x4& lo, const f32x4& hi) { return __builtin_bit_cast(bf16x8, (u32x4){cvtpk(lo[0], lo[1]), cvtpk(lo[2], lo[3]), cvtpk(hi[0], hi[1]), cvtpk(hi[2], hi[3])}); }
DI void ld16_asm(u32x4& dst, const char* sbase, unsigned voff) { asm volatile("global_load_dwordx4 %0, %1, %2" : "=v"(dst) : "v"(voff), "s"(sbase) : "memory"); }
#define SCAN_LOAD(RSET, chunk) do { const char* _cb = pg8::rfl_ptr(src + (size_t)(chunk) * SCAN_BUF); \
    _Pragma("unroll") for (int i = 0; i < 14; ++i) ld16_asm(RSET[i], pg8::rfl_ptr(_cb + i * 4096), ltid16); } while (0)
#define SCAN_PUT(RSET, BUF) do { _Pragma("unroll") for (int i = 0; i < 14; ++i) *(LAS u32x4*)(F.lds + (BUF) * SCAN_BUF + i * 4096 + ltid16) = RSET[i]; } while (0)
#define SCAN_LSTEP(n_, BUFN, RFREE, RNEXT) do { const int n = (n_); \
    if (n + 3 < 64) { SCAN_LOAD(RFREE, n + 3); asm volatile("s_waitcnt vmcnt(28)" ::: "memory"); } else { asm volatile("s_waitcnt vmcnt(0)" ::: "memory"); } \
    __builtin_amdgcn_sched_barrier(0); \
    if (n + 1 < 64) SCAN_PUT(RNEXT, BUFN); \
    asm volatile("s_waitcnt lgkmcnt(0)" ::: "memory"); __builtin_amdgcn_s_barrier(); asm volatile("" ::: "memory"); } while (0)
#define SCAN_CSTEP(n_, BUFC, UC) do { const int n = (n_); \
        const LAS unsigned char* buf = F.lds + (BUFC) * SCAN_BUF; \
        f32x4 vn[4]; \
        _Pragma("unroll") for (int tm = 0; tm < 4; ++tm) vn[tm] = UC[tm]; \
        if (n + 2 < 64) { const char* u2 = pg8::rfl_ptr(ubase + (size_t)(n + 2) * 8192 * 4); _Pragma("unroll") for (int tm = 0; tm < 4; ++tm) UC[tm] = *(const f32x4*)(u2 + lane16 + tm * 1024); } \
        if (n > 0) { char* op = (char*)pg8::rfl_ptr(obase + (size_t)(64 * (n - 1)) * D_ * 2); \
            _Pragma("unroll") for (int tm = 0; tm < 4; ++tm) _Pragma("unroll") for (int reg = 0; reg < 4; ++reg) *(bf16*)(op + olane + (16 * tm + reg) * D_ * 2) = (bf16)cvtpk(o[tm][reg], 0.f); } \
        const float glast = rdlane(gl_all, n); \
        bf16x8 sb[4]; \
        _Pragma("unroll") for (int ks = 0; ks < 4; ++ks) sb[ks] = pack8(S[2 * ks], S[2 * ks + 1]); \
          \
        bf16x8 fw[16], fq[16], fk[8], fd[16]; bf16x8 vb[2]; \
        _Pragma("unroll") for (int i = 0; i < 16; ++i) fw[i] = *(const LAS bf16x8*)(buf + BLOB_W * 2 + (i * 64 + lane) * 16); \
        __builtin_amdgcn_sched_barrier(0); \
        _Pragma("unroll") for (int i = 0; i < 16; ++i) fq[i] = *(const LAS bf16x8*)(buf + BLOB_QG * 2 + (i * 64 + lane) * 16); \
        __builtin_amdgcn_sched_barrier(0); \
        _Pragma("unroll") for (int tm = 0; tm < 4; ++tm) _Pragma("unroll") for (int ks = 0; ks < 4; ++ks) vn[tm] = MFMA16(fw[tm * 4 + ks], sb[ks], vn[tm]); \
        __builtin_amdgcn_sched_barrier(0); \
        _Pragma("unroll") for (int i = 0; i < 8; ++i) fk[i] = *(const LAS bf16x8*)(buf + BLOB_QK * 2 + (i * 64 + lane) * 16); \
        __builtin_amdgcn_sched_barrier(0); \
        _Pragma("unroll") for (int tm = 0; tm < 4; ++tm) { o[tm] = (f32x4){0.f, 0.f, 0.f, 0.f}; \
            _Pragma("unroll") for (int ks = 0; ks < 4; ++ks) o[tm] = MFMA16(fq[tm * 4 + ks], sb[ks], o[tm]); } \
        _Pragma("unroll") for (int k2 = 0; k2 < 2; ++k2) vb[k2] = pack8(vn[2 * k2], vn[2 * k2 + 1]); \
        __builtin_amdgcn_sched_barrier(0); \
        _Pragma("unroll") for (int i = 0; i < 16; ++i) fd[i] = *(const LAS bf16x8*)(buf + BLOB_KDT * 2 + (i * 64 + lane) * 16); \
        __builtin_amdgcn_sched_barrier(0); \
        _Pragma("unroll") for (int tm = 0; tm < 4; ++tm) _Pragma("unroll") for (int k2 = 0; k2 < 2; ++k2) o[tm] = MFMA16(fk[tm * 2 + k2], vb[k2], o[tm]); \
        __builtin_amdgcn_sched_barrier(0); \
        _Pragma("unroll") for (int a = 0; a < 8; ++a) { S[a] = S[a] * glast; \
            _Pragma("unroll") for (int k2 = 0; k2 < 2; ++k2) S[a] = MFMA16(fd[a * 2 + k2], vb[k2], S[a]); } \
    asm volatile("s_waitcnt lgkmcnt(0)" ::: "memory"); __builtin_amdgcn_s_barrier(); asm volatile("" ::: "memory"); } while (0)

DI void gdn_scan2_phase(const Frame& F, const Args& A) {
    unsigned char* ws = opq(A.ws); unsigned char* big = ws + WS_BIG;
    const bf16* BLOB = (const bf16*)(big + GB_BLOB); const float* U = (const float*)(ws + WS_HID); bf16* Oraw = (bf16*)(ws + WS_Y);
    const float* GC = (const float*)(ws + WS_GALPHA);
    const int lane = F.lane, r = lane & 15, q = lane >> 4, w = F.wave;
    for (int it2 = F.bid; it2 < NB_ * 8 * 2; it2 += F.G) {
        const int item = it2 >> 1, half = it2 & 1, b = item >> 3, hh = item & 7, dvw = 4 * half + (w & 3);
        const char* src = pg8::rfl_ptr((const char*)(BLOB + (size_t)item * 64 * BLOB_ELEMS));
        __syncthreads();
        if (w >= 4) {
            const unsigned ltid16 = (unsigned)((w & 3) * 64 + lane) * 16u;
            u32x4 r0[14], r1[14], r2[14];
            SCAN_LOAD(r0, 0); SCAN_LOAD(r1, 1); SCAN_LOAD(r2, 2); asm volatile("s_waitcnt vmcnt(28)" ::: "memory"); __builtin_amdgcn_sched_barrier(0); SCAN_PUT(r0, 0);
            asm volatile("s_waitcnt lgkmcnt(0)" ::: "memory"); __builtin_amdgcn_s_barrier(); asm volatile("" ::: "memory");
#pragma unroll 1
            for (int n6 = 0; n6 < 60; n6 += 6) {
                SCAN_LSTEP(n6 + 0, 1, r0, r1); SCAN_LSTEP(n6 + 1, 0, r1, r2); SCAN_LSTEP(n6 + 2, 1, r2, r0);
                SCAN_LSTEP(n6 + 3, 0, r0, r1); SCAN_LSTEP(n6 + 4, 1, r1, r2); SCAN_LSTEP(n6 + 5, 0, r2, r0);
            }
            SCAN_LSTEP(60, 1, r0, r1); SCAN_LSTEP(61, 0, r1, r2); SCAN_LSTEP(62, 1, r2, r0); SCAN_LSTEP(63, 0, r0, r1);
        } else {
            f32x4 S[8];
#pragma unroll
            for (int a = 0; a < 8; ++a) S[a] = (f32x4){0.f, 0.f, 0.f, 0.f};
            const char* ubase = pg8::rfl_ptr((const char*)(U + (size_t)item * 64 * 8192 + (size_t)(dvw * 4) * 256));
            const char* obase = pg8::rfl_ptr((const char*)(Oraw + (size_t)b * S_ * D_ + hh * 128 + 16 * dvw));
            const unsigned lane16 = (unsigned)lane * 16u, olane = (unsigned)((4 * q) * D_ + r) * 2u;
            const float gl_all = __expf(GC[(size_t)item * S_ + 64 * lane + 63]);
            f32x4 ua[4], ub[4], o[4];
#pragma unroll
            for (int tm = 0; tm < 4; ++tm) { ua[tm] = *(const f32x4*)(ubase + lane16 + tm * 1024); ub[tm] = *(const f32x4*)(ubase + 8192 * 4 + lane16 + tm * 1024); o[tm] = (f32x4){0.f, 0.f, 0.f, 0.f}; }
            asm volatile("s_waitcnt lgkmcnt(0)" ::: "memory"); __builtin_amdgcn_s_barrier(); asm volatile("" ::: "memory");
#pragma unroll 1
            for (int n2 = 0; n2 < 64; n2 += 2) { SCAN_CSTEP(n2, 0, ua); SCAN_CSTEP(n2 + 1, 1, ub); }
            { char* op = (char*)obase + (size_t)(64 * 63) * D_ * 2;
#pragma unroll
              for (int tm = 0; tm < 4; ++tm)
#pragma unroll
                  for (int reg = 0; reg < 4; ++reg) *(bf16*)(op + olane + (16 * tm + reg) * D_ * 2) = (bf16)cvtpk(o[tm][reg], 0.f); }
        }
    }
}
#undef SCAN_LSTEP
#undef SCAN_CSTEP
#undef SCAN_LOAD
#undef SCAN_PUT
constexpr int N_PHASES = 42;
#ifndef MK_FUSED
#define MK_FUSED 1
#endif

#if MK_FUSED
typedef const __attribute__((address_space(4))) Args* CArgsP;
DI Args fresh_args() {
#if defined(__HIP_DEVICE_COMPILE__)
    CArgsP kp = (CArgsP)__builtin_amdgcn_kernarg_segment_ptr(); asm volatile("" : "+s"(kp)); Args a = *kp;
    a.x = asg(a.x); a.c = asg(a.c); a.pos = asg(a.pos); a.ada_w = asg(a.ada_w); a.ada_b = asg(a.ada_b); a.ln_g = asg(a.ln_g); a.ln_b = asg(a.ln_b);
    a.attn_w_in = asg(a.attn_w_in); a.attn_w_out = asg(a.attn_w_out); a.gdn_w_in = asg(a.gdn_w_in); a.gdn_conv_w = asg(a.gdn_conv_w); a.gdn_a_log = asg(a.gdn_a_log); a.gdn_dt_bias = asg(a.gdn_dt_bias);
    a.gdn_norm_w = asg(a.gdn_norm_w); a.gdn_w_out = asg(a.gdn_w_out); a.router_w = asg(a.router_w); a.router_bias = asg(a.router_bias); a.ew1 = asg(a.ew1); a.ew3 = asg(a.ew3); a.ew2 = asg(a.ew2);
    a.sw1 = asg(a.sw1); a.sw3 = asg(a.sw3); a.sw2 = asg(a.sw2); a.out = asg(a.out); a.ws = asg(a.ws);
    return a;
#else
    return Args{};
#endif
}
DI Frame fresh_frame(int wave_s) { Frame F; int g = gridDim.x; asm volatile("" : "+s"(g)); int b = blockIdx.x; asm volatile("" : "+s"(b)); unsigned l = 0u; asm volatile("" : "+s"(l));
    int w = wave_s; asm volatile("" : "+s"(w)); int ln; asm volatile("v_mbcnt_lo_u32_b32 %0, -1, 0\n\tv_mbcnt_hi_u32_b32 %0, -1, %0" : "=&v"(ln));
    F.lds = (LAS unsigned char*)(size_t)l; F.tid = w * 64 + ln; F.lane = ln; F.wave = w; F.G = g; F.bid = b; return F; }
#define PHF() const Args A = fresh_args(); const Frame F = fresh_frame(wave_s); \
    unsigned char* ws = opq(A.ws); LAS int* idxlds = (LAS int*)(F.lds + LDS_IDX); const LAS int* tileoff = (const LAS int*)(F.lds + LDS_TILEOFF); (void)ws; (void)idxlds; (void)tileoff;
DI void ph_pro(const int wave_s) { PHF(); prologue_phase(F, A); convert_experts(F, A, 0, 0, 0, F.G); }
DI void ph_modx(const int wave_s) { PHF(); modx_phase(F, A); }
DI void ph_attn(const int wave_s) { PHF(); attn_phase(F, A); }
DI void ph_lnr(const int wave_s, int L) { PHF(); if (L == 0) ln_router_phase<true>(F, A, L); else ln_router_phase<false>(F, A, L); }
DI void ph_lnr_dry(const int wave_s, int L) { PHF(); if (L == 0) ln_router_phase<true>(F, A, L, true); else ln_router_phase<false>(F, A, L, true); }
DI void ph_scat(const int wave_s, int L) { PHF(); moe_scatter_phase(F, A, L); }
DI void ph_lnm(const int wave_s, int L) { PHF(); ln_moe_phase(F, A, L, nullptr); }
DI void ph_lnm_dry(const int wave_s, int L) { PHF(); ln_moe_phase(F, A, L, (float*)(ws + WS_Y)); }
DI void ph_gprep(const int wave_s, int lp) { PHF(); gdn_prep2_phase(F, A, lp); }
DI void ph_gwy(const int wave_s) { PHF(); gdn_wy_phase(F, A); }
DI void ph_gscan(const int wave_s, int L) { PHF(); gdn_scan2_phase(F, A); if (F.G > 128) { convert_experts(F, A, L, 0, 64, F.G - 64); if (L == 1) convert_experts(F, A, 2, 1, 64, F.G - 64); } else { convert_experts(F, A, L, 0, 0, F.G); if (L == 1) convert_experts(F, A, 2, 1, 0, F.G); } }
DI void ph_gpost(const int wave_s, int lp) { PHF(); gdn_post_phase(F, A, lp); }
DI void ph_gemm_qkv(const int wave_s, int lp) { PHF();
    pg8::DenseOrder S; S.init(WS_H, WS_WA_IN + (size_t)lp * 9216 * D_ * 2, T_, 9216, D_, F.G, F.bid);
    pg8::EpiQKV E{(bf16*)(ws + WS_BIG), (const float*)(ws + WS_COS), (const float*)(ws + WS_SIN)};
    pg8::gemm_phase<pg8::EpiQKV, pg8::DenseOrder, true, true>(F.tid, ws, F.lds, idxlds, D_, S, E); }
DI void ph_gemm_out(const int wave_s, int lp, int isg) { PHF();
    pg8::DenseOrder S; S.init(WS_O, (isg ? WS_WG_OUT : WS_WA_OUT) + (size_t)lp * D_ * D_ * 2, T_, D_, D_, F.G, F.bid);
    pg8::EpiBf16 E{(bf16*)(ws + WS_Y), D_};
    pg8::gemm_phase<pg8::EpiBf16, pg8::DenseOrder, true, true>(F.tid, ws, F.lds, idxlds, D_, S, E); }
DI void ph_gemm_gin(const int wave_s, int lp) { PHF();
    pg8::DenseOrder S; S.init(WS_H, WS_WG_IN + (size_t)lp * 4096 * D_ * 2, T_, 4096, D_, F.G, F.bid);
    pg8::EpiBf16 E{(bf16*)(ws + WS_BIG + BIG_PROJ), 4096};
    pg8::gemm_phase<pg8::EpiBf16, pg8::DenseOrder, true, true>(F.tid, ws, F.lds, idxlds, D_, S, E); }
DI void ph_moe1(const int wave_s, int L) { PHF();
    const unsigned* gcount = (const unsigned*)(ws + WS_CTL) + CW_CNT + L * 64;
    build_tileoff(F, gcount);
    pg8::MoeOrder<true> S; S.A = (unsigned)WS_H; S.Bt = (unsigned)(L == 2 ? WS_WEB : WS_WE1); S.K = D_; S.nct_log = 1; S.nunits = __builtin_amdgcn_readfirstlane(tileoff[65]) * 2; S.G = F.G; S.c = F.bid;
    S.idxoff = (unsigned)WS_ETOK; S.tileoff = tileoff; S.ecnt = (const LAS int*)(F.lds + LDS_ECNT); S.bstride = (unsigned)(512 * D_ * 2);
    pg8::EpiSwiGLU E{(bf16*)(ws + WS_HID)};
    pg8::gemm_phase<pg8::EpiSwiGLU, pg8::MoeOrder<true>, true, true>(F.tid, ws, F.lds, idxlds, D_, S, E); }
DI void ph_moe2(const int wave_s, int L) { PHF();
    const unsigned* gcount = (const unsigned*)(ws + WS_CTL) + CW_CNT + L * 64;
    build_tileoff(F, gcount);
    pg8::MoeOrder<false> S; S.A = (unsigned)WS_HID; S.Bt = (unsigned)(L == 2 ? WS_WEB + 65 * MiB : WS_WE2); S.K = 256; S.nct_log = 2; S.nunits = __builtin_amdgcn_readfirstlane(tileoff[(YS_BF16 && !YS_MERGED) ? 64 : 65]) * 4; S.G = F.G; S.c = F.bid;
    S.idxoff = (unsigned)WS_EW; S.tileoff = tileoff; S.ecnt = (const LAS int*)(F.lds + LDS_ECNT); S.bstride = (unsigned)(D_ * 256 * 2);
    pg8::EpiScale E{ws + WS_BIG, 256 * __builtin_amdgcn_readfirstlane(tileoff[64])};
    pg8::gemm_phase<pg8::EpiScale, pg8::MoeOrder<false>, false, false>(F.tid, ws, F.lds, idxlds, 256, S, E); }
DI void ph_moe2s(const int wave_s, int L) { PHF();
    __syncthreads();
    const size_t s0 = (size_t)(256 * __builtin_amdgcn_readfirstlane(((const LAS int*)(F.lds + LDS_TILEOFF))[64]));
    pg8::DenseOrder S; S.init(WS_HID + s0 * 256 * 2, (L == 2 ? WS_WEB + 65 * MiB : WS_WE2) + (size_t)NEXP * D_ * 256 * 2, T_, D_, 256, F.G, F.bid);
    pg8::EpiBf16 E{(bf16*)(ws + WS_BIG + WS_YS_OFF), D_};
    pg8::gemm_phase<pg8::EpiBf16, pg8::DenseOrder, false, false>(F.tid, ws, F.lds, idxlds, 256, S, E); }

DI void grid_bar(const int wave_s) { PHF(); XcdBarrier b; b.bar = (unsigned*)(ws + WS_CTL) + CW_BAR; volatile LAS unsigned* misc = (volatile LAS unsigned*)(F.lds + LDS_MISC); b.st = misc + 8;
    b.x = (unsigned)__builtin_amdgcn_readfirstlane((int)misc[10]); xcd_barrier(b, F.tid); }
__global__ void __launch_bounds__(NTHR, 2) mk_fwd(Args Ain) {
    extern __shared__ __attribute__((aligned(16))) unsigned char lds_raw[];
    LAS unsigned char* lds = (LAS unsigned char*)lds_raw;
    for (int u = threadIdx.x; u < (LDS_BYTES - RING_BYTES) / 4; u += NTHR) ((LAS unsigned*)(lds + RING_BYTES))[u] = 0u;
    __syncthreads();
    const int wave_s = __builtin_amdgcn_readfirstlane((int)threadIdx.x >> 6);
    { XcdBarrier bar = xcd_barrier_post((unsigned*)(Ain.ws + WS_CTL) + CW_BAR, (volatile LAS unsigned*)(lds + LDS_MISC) + 8);
      if (threadIdx.x == 0) ((volatile LAS unsigned*)(lds + LDS_MISC))[10] = bar.x; }
    __syncthreads();
#ifndef REP_BAR
#define REP_BAR 1
#define REP_PRO 1
#define REP_POST 1
#define REP_QKV 1
#define REP_OUT 1
#define REP_GIN 1
#define REP_M1 1
#define REP_M2 1
#define REP_LNM 1
#define REP_LNR 1
#endif
#define GBAR() do { for (int _b = 0; _b < REP_BAR; ++_b) grid_bar(wave_s); } while (0)
#ifndef REP_ATTN
#define REP_ATTN 1
#define REP_SCAN 1
#define REP_GEMM 1
#define REP_PREP 1
#define REP_CONV 1
#define REP_WY 1
#endif
    for (int r = 0; r < REP_PRO; ++r) { ph_pro(wave_s); GBAR(); }
    ph_modx(wave_s); GBAR();
#pragma unroll 1
    for (int L = 0; L < 4; ++L) {
        const int lp = L >> 1;
        if ((L & 1) == 0) { for (int r = 0; r < REP_QKV; ++r) { ph_gemm_qkv(wave_s, lp); GBAR(); } for (int r = 0; r < REP_ATTN; ++r) { ph_attn(wave_s); GBAR(); } for (int r = 0; r < REP_OUT; ++r) { ph_gemm_out(wave_s, lp, 0); GBAR(); } }
        else { for (int r = 0; r < REP_GIN; ++r) { ph_gemm_gin(wave_s, lp); GBAR(); } for (int r = 0; r < REP_PREP; ++r) { ph_gprep(wave_s, lp); GBAR(); } for (int r = 0; r < REP_WY; ++r) { ph_gwy(wave_s); GBAR(); } for (int r = 0; r < REP_SCAN; ++r) { ph_gscan(wave_s, L); GBAR(); } for (int r = 0; r < REP_POST; ++r) { ph_gpost(wave_s, lp); GBAR(); } for (int r = 0; r < REP_OUT; ++r) { ph_gemm_out(wave_s, lp, 1); GBAR(); } }
        for (int r = 1; r < REP_LNR; ++r) { ph_lnr_dry(wave_s, L); GBAR(); }
        ph_lnr(wave_s, L); GBAR();
        for (int r = 0; r < REP_M1; ++r) { ph_moe1(wave_s, L); GBAR(); }
        for (int r = 0; r < REP_M2; ++r) { ph_moe2(wave_s, L); if (YS_BF16 && !YS_MERGED) ph_moe2s(wave_s, L); GBAR(); }
        for (int r = 1; r < REP_LNM; ++r) { ph_lnm_dry(wave_s, L); GBAR(); }
        ph_lnm(wave_s, L); if (L < 3) GBAR();
    }
#undef GBAR
}
#else

#define MKF() extern __shared__ __attribute__((aligned(16))) unsigned char lds_raw[]; Frame F; F.lds = (LAS unsigned char*)lds_raw; F.tid = threadIdx.x; F.lane = F.tid & 63; \
    F.wave = __builtin_amdgcn_readfirstlane(F.tid >> 6); F.G = gridDim.x; F.bid = blockIdx.x; unsigned char* ws = opq(A.ws); LAS int* idxlds = (LAS int*)(F.lds + LDS_IDX); \
    const LAS int* tileoff = (const LAS int*)(F.lds + LDS_TILEOFF); (void)ws; (void)idxlds; (void)tileoff; \
    for (int u = F.tid; u < (LDS_BYTES - RING_BYTES) / 4; u += NTHR) ((LAS unsigned*)(F.lds + RING_BYTES))[u] = 0u; __syncthreads();
__global__ void __launch_bounds__(NTHR, 2) k_pro(Args A) { MKF(); prologue_phase(F, A); }
__global__ void __launch_bounds__(NTHR, 2) k_modx(Args A) { MKF(); modx_phase(F, A); }
__global__ void __launch_bounds__(NTHR, 2) k_attn(Args A) { MKF(); attn_phase(F, A); }
__global__ void __launch_bounds__(NTHR, 2) k_lnr(Args A) { MKF(); const int L = A.ph_lo; ln_router_phase<false>(F, A, L); }
__global__ void __launch_bounds__(NTHR, 2) k_scat(Args A) { MKF(); moe_scatter_phase(F, A, A.ph_lo); convert_experts(F, A, A.ph_lo); }
__global__ void __launch_bounds__(NTHR, 2) k_lnm(Args A) { MKF(); const int L = A.ph_lo; ln_moe_phase(F, A, L, nullptr); }
__global__ void __launch_bounds__(NTHR, 2) k_gprep(Args A) { MKF(); gdn_prep_phase(F, A, A.ph_lo); }
__global__ void __launch_bounds__(NTHR, 2) k_gscan(Args A) { MKF(); gdn_scan_phase(F, A); }
__global__ void __launch_bounds__(NTHR, 2) k_gpost(Args A) { MKF(); gdn_post_phase(F, A, A.ph_lo); }
__global__ void __launch_bounds__(NTHR, 2) k_gemm_qkv(Args A) { MKF(); const int lp = A.ph_lo;
    pg8::DenseOrder S; S.init(WS_H, WS_WA_IN + (size_t)lp * 9216 * D_ * 2, T_, 9216, D_, F.G, F.bid);
    pg8::EpiQKV E{(bf16*)(ws + WS_BIG), (const float*)(ws + WS_COS), (const float*)(ws + WS_SIN)};
    pg8::gemm_phase<pg8::EpiQKV, pg8::DenseOrder, true, true>(F.tid, ws, F.lds, idxlds, D_, S, E); }
__global__ void __launch_bounds__(NTHR, 2) k_gemm_out(Args A) { MKF(); const int lp = A.ph_lo >> 1, isg = A.ph_lo & 1;
    pg8::DenseOrder S; S.init(WS_O, (isg ? WS_WG_OUT : WS_WA_OUT) + (size_t)lp * D_ * D_ * 2, T_, D_, D_, F.G, F.bid);
    pg8::EpiF32 E{(float*)(ws + WS_Y), D_};
    pg8::gemm_phase<pg8::EpiF32, pg8::DenseOrder, true, true>(F.tid, ws, F.lds, idxlds, D_, S, E); }
__global__ void __launch_bounds__(NTHR, 2) k_gemm_gin(Args A) { MKF(); const int lp = A.ph_lo;
    pg8::DenseOrder S; S.init(WS_H, WS_WG_IN + (size_t)lp * 4096 * D_ * 2, T_, 4096, D_, F.G, F.bid);
    pg8::EpiBf16 E{(bf16*)(ws + WS_BIG + BIG_PROJ), 4096};
    pg8::gemm_phase<pg8::EpiBf16, pg8::DenseOrder, true, true>(F.tid, ws, F.lds, idxlds, D_, S, E); }
__global__ void __launch_bounds__(NTHR, 2) k_moe1(Args A) { MKF();
    const unsigned* gcount = (const unsigned*)(ws + WS_CTL) + CW_CNT + A.ph_lo * 64;
    build_tileoff(F, gcount);
    pg8::MoeOrder<true> S; S.A = (unsigned)WS_H; S.Bt = (unsigned)(L == 2 ? WS_WEB : WS_WE1); S.K = D_; S.nct_log = 1; S.nunits = __builtin_amdgcn_readfirstlane(tileoff[65]) * 2; S.G = F.G; S.c = F.bid;
    S.idxoff = (unsigned)WS_ETOK; S.tileoff = tileoff; S.ecnt = (const LAS int*)(F.lds + LDS_ECNT); S.bstride = (unsigned)(512 * D_ * 2);
    pg8::EpiSwiGLU E{(bf16*)(ws + WS_HID)};
    pg8::gemm_phase<pg8::EpiSwiGLU, pg8::MoeOrder<true>, true, true>(F.tid, ws, F.lds, idxlds, D_, S, E); }
__global__ void __launch_bounds__(NTHR, 2) k_moe2(Args A) { MKF();
    const unsigned* gcount = (const unsigned*)(ws + WS_CTL) + CW_CNT + A.ph_lo * 64;
    build_tileoff(F, gcount);
    pg8::MoeOrder<false> S; S.A = (unsigned)WS_HID; S.Bt = (unsigned)(L == 2 ? WS_WEB + 65 * MiB : WS_WE2); S.K = 256; S.nct_log = 2; S.nunits = __builtin_amdgcn_readfirstlane(tileoff[65]) * 4; S.G = F.G; S.c = F.bid;
    S.idxoff = (unsigned)WS_EW; S.tileoff = tileoff; S.ecnt = (const LAS int*)(F.lds + LDS_ECNT); S.bstride = (unsigned)(D_ * 256 * 2);
    pg8::EpiScale E{ws + WS_BIG, 256 * __builtin_amdgcn_readfirstlane(tileoff[64])};
    pg8::gemm_phase<pg8::EpiScale, pg8::MoeOrder<false>, false, false>(F.tid, ws, F.lds, idxlds, 256, S, E); }
#endif
extern "C" void kernel_launch(void* const* d_in, const int* in_sizes, int n_in, void* d_out, int out_size, void* d_ws, size_t ws_size, hipStream_t stream) {
    static int grid = 0;
    if (grid == 0) {
        if (n_in != 23 || in_sizes[0] != T_ * D_ || out_size != T_ * D_ || ws_size < WS_END) {
            fprintf(stderr, "kernel_launch: unexpected shapes (n_in %d, in0 %d, out %d, ws %zu < %zu); nothing launched\n", n_in, n_in > 0 ? in_sizes[0] : -1, out_size, ws_size, (size_t)WS_END); grid = -1; return; }
        int dev = 0, cus = 0, per_cu = 0;
        if (hipGetDevice(&dev) != hipSuccess || hipDeviceGetAttribute(&cus, hipDeviceAttributeMultiprocessorCount, dev) != hipSuccess) { grid = -1; return; }
#if MK_FUSED
        if (hipFuncSetAttribute((const void*)mk_fwd, hipFuncAttributeMaxDynamicSharedMemorySize, LDS_BYTES) != hipSuccess) { fprintf(stderr, "kernel_launch: hipFuncSetAttribute failed\n"); grid = -1; return; }
        if (hipOccupancyMaxActiveBlocksPerMultiprocessor(&per_cu, (const void*)mk_fwd, NTHR, LDS_BYTES) != hipSuccess || per_cu < 1)
            fprintf(stderr, "kernel_launch: note: occupancy query reports %d workgroups per CU\n", per_cu);
#else
        { const void* ks[] = {(const void*)k_pro, (const void*)k_modx, (const void*)k_attn, (const void*)k_lnr, (const void*)k_scat, (const void*)k_lnm, (const void*)k_gprep, (const void*)k_gscan, (const void*)k_gpost,
                              (const void*)k_gemm_qkv, (const void*)k_gemm_out, (const void*)k_gemm_gin, (const void*)k_moe1, (const void*)k_moe2};
          for (const void* k : ks) if (hipFuncSetAttribute(k, hipFuncAttributeMaxDynamicSharedMemorySize, LDS_BYTES) != hipSuccess) { fprintf(stderr, "kernel_launch: hipFuncSetAttribute failed\n"); grid = -1; return; } }
        (void)per_cu;
#endif
        (void)hipGetLastError();
        grid = cus;
    }
    if (grid < 0) return;
    (void)hipMemsetAsync((char*)d_ws + WS_CTL, 0, CTL_ZERO_BYTES, stream);
    Args a{};
    a.x = (const float*)d_in[0]; a.c = (const float*)d_in[1]; a.pos = (const int*)d_in[2]; a.ada_w = (const float*)d_in[3]; a.ada_b = (const float*)d_in[4];
    a.ln_g = (const float*)d_in[5]; a.ln_b = (const float*)d_in[6]; a.attn_w_in = (const float*)d_in[7]; a.attn_w_out = (const float*)d_in[8];
    a.gdn_w_in = (const float*)d_in[9]; a.gdn_conv_w = (const float*)d_in[10]; a.gdn_a_log = (const float*)d_in[11]; a.gdn_dt_bias = (const float*)d_in[12];
    a.gdn_norm_w = (const float*)d_in[13]; a.gdn_w_out = (const float*)d_in[14]; a.router_w = (const float*)d_in[15]; a.router_bias = (const float*)d_in[16];
    a.ew1 = (const float*)d_in[17]; a.ew3 = (const float*)d_in[18]; a.ew2 = (const float*)d_in[19]; a.sw1 = (const float*)d_in[20]; a.sw3 = (const float*)d_in[21]; a.sw2 = (const float*)d_in[22];
    a.out = (float*)d_out; a.ws = (unsigned char*)d_ws;
#if MK_FUSED
    a.ph_lo = 0; a.ph_hi = N_PHASES;
    hipLaunchKernelGGL(mk_fwd, dim3(grid), dim3(NTHR), LDS_BYTES, stream, a);
#else
#define LAUNCH(k, arg) do { a.ph_lo = (arg); a.ph_hi = (arg) + 1; hipLaunchKernelGGL(k, dim3(grid), dim3(NTHR), LDS_BYTES, stream, a); } while (0)
    LAUNCH(k_pro, 0); LAUNCH(k_modx, 0);
    for (int L = 0; L < 4; ++L) {
        const int lp = L >> 1;
        if ((L & 1) == 0) { LAUNCH(k_gemm_qkv, lp); LAUNCH(k_attn, 0); LAUNCH(k_gemm_out, 2 * lp); }
        else { LAUNCH(k_gemm_gin, lp); LAUNCH(k_gprep, lp); LAUNCH(k_gscan, 0); LAUNCH(k_gpost, lp); LAUNCH(k_gemm_out, 2 * lp + 1); }
        LAUNCH(k_lnr, L); LAUNCH(k_scat, L); LAUNCH(k_moe1, L); LAUNCH(k_moe2, L); LAUNCH(k_lnm, L);
    }
#undef LAUNCH
#endif
    const hipError_t le = hipPeekAtLastError();
    if (le != hipSuccess) fprintf(stderr, "kernel_launch: launch failed: %s\n", hipGetErrorName(le));
}
```

```cpp
#include <hip/hip_runtime.h>
#include <cstdio>
#include <cstdint>

#define GAS __attribute__((address_space(1)))
#define LAS __attribute__((address_space(3)))
typedef unsigned short bf16;
typedef unsigned u32x4 __attribute__((ext_vector_type(4)));
typedef unsigned u32x2 __attribute__((ext_vector_type(2)));
typedef float f32x2 __attribute__((ext_vector_type(2)));
typedef float f32x4 __attribute__((ext_vector_type(4)));
typedef float f32x16 __attribute__((ext_vector_type(16)));
typedef short bf16x8 __attribute__((ext_vector_type(8)));
typedef short s16x4 __attribute__((ext_vector_type(4)));
typedef __bf16 bf16x2_t __attribute__((ext_vector_type(2)));
#define DI __device__ __forceinline__

DI unsigned cvtpk(float lo, float hi) { f32x2 v = {lo, hi}; bf16x2_t b = __builtin_convertvector(v, bf16x2_t); return __builtin_bit_cast(unsigned, b); }
DI unsigned cvtpk_fp8(float a, float b, float c, float d) { int w = __builtin_amdgcn_cvt_pk_fp8_f32(a, b, 0, false); w = __builtin_amdgcn_cvt_pk_fp8_f32(c, d, w, true); return (unsigned)w; }
constexpr bool YS_BF16 = true;
constexpr bool YS_MERGED = true;
constexpr float YE_SCALE = 16.0f;
DI float silu_f(float a) { return a * __builtin_amdgcn_rcpf(1.0f + __expf(-a)); }
DI float bf_lo(unsigned u) { return __builtin_bit_cast(float, u << 16); }
DI float bf_hi(unsigned u) { return __builtin_bit_cast(float, u & 0xffff0000u); }
template <int M> DI float shx(float v) { return __builtin_bit_cast(float, __builtin_amdgcn_ds_swizzle(__builtin_bit_cast(int, v), (M << 10) | 0x1f)); }
DI float bperm(float v, int srclane) { return __builtin_bit_cast(float, __builtin_amdgcn_ds_bpermute(srclane << 2, __builtin_bit_cast(int, v))); }
DI float rdlane(float v, int l) { return __builtin_bit_cast(float, __builtin_amdgcn_readlane(__builtin_bit_cast(int, v), l)); }
template <int CTRL> DI float dppmov(float v) { return __builtin_bit_cast(float, __builtin_amdgcn_update_dpp(0, __builtin_bit_cast(int, v), CTRL, 0xf, 0xf, true)); }
DI float wave_sum(float v) { v += dppmov<0xB1>(v); v += dppmov<0x4E>(v); v += dppmov<0x141>(v); v += dppmov<0x140>(v); return (rdlane(v, 0) + rdlane(v, 16)) + (rdlane(v, 32) + rdlane(v, 48)); }
DI float wave_max(float v) { v = fmaxf(v, dppmov<0xB1>(v)); v = fmaxf(v, dppmov<0x4E>(v)); v = fmaxf(v, dppmov<0x141>(v)); v = fmaxf(v, dppmov<0x140>(v)); return fmaxf(fmaxf(rdlane(v, 0), rdlane(v, 16)), fmaxf(rdlane(v, 32), rdlane(v, 48))); }
#define LDS_WAIT() asm volatile("s_waitcnt lgkmcnt(0)" ::: "memory")
#define VM_WAIT() asm volatile("s_waitcnt vmcnt(0)" ::: "memory")

namespace pg8 {
constexpr int BM = 256, BK = 64, HALF = 128, HTB = HALF * BK * 2, STAGE_BYTES = 8 * HTB;
DI int lds_byte(int r, int c) { const int st = (r >> 4) * 2 + (c >> 5), rr = r & 15, cc = c & 31, ob = rr * 64 + cc * 2; return st * 1024 + (ob ^ (((ob >> 9) & 1) << 5)); }
DI void stage_rc(int b, int& R, int& C) { const int st = b / 1024, sb = b % 1024, swz = sb ^ (((sb >> 9) & 1) << 5); R = (st >> 1) * 16 + swz / 64; C = (st & 1) * 32 + (swz % 64) / 2; }
DI int perm32(int rho) { const int n = rho >> 4, i = rho & 15; return 8 * (i >> 2) + 4 * n + (i & 3); }

DI const char* rfl_ptr(const char* p) {
    const unsigned long long v = (unsigned long long)p; const unsigned lo = __builtin_amdgcn_readfirstlane((unsigned)v), hi = __builtin_amdgcn_readfirstlane((unsigned)(v >> 32));
    return (const char*)(const __attribute__((address_space(1))) char*)(((unsigned long long)hi << 32) | lo); }
struct Unit { unsigned a; unsigned b; int r0; int c0; int e; int rb; int nv; };

template <class Epi, class Sched, bool ALIGN_EPI, bool SP2>
DI void gemm_phase(const int tid, const void* wsbase, LAS unsigned char* lds, LAS int* idxlds, const int K, const Sched& S, const Epi& E) {
    const __amdgpu_buffer_rsrc_t rsrc = __builtin_amdgcn_make_buffer_rsrc((void*)wsbase, 0, 0xffffffff, 0x00020000);
    const int wid = __builtin_amdgcn_readfirstlane(tid >> 6), lane = tid & 63, wr = wid >> 2, wc = wid & 3, fr = lane & 15, fq = lane >> 4;
    const int nt = K / BK;
    unsigned voffB[2], voffA[2][2];
#pragma unroll
    for (int i = 0; i < 2; ++i) { int R, C; stage_rc(tid * 16 + i * 8192, R, C); const int Rb = Epi::PERM ? ((R & ~31) + perm32(R & 31)) : R;
        voffB[i] = (unsigned)(Rb * K + C) * 2u;
        voffA[0][i] = (unsigned)(R * K + C) * 2u; voffA[1][i] = (unsigned)((R + HALF) * K + C) * 2u; }
    const unsigned kstep = (unsigned)(BK * 2);
    const unsigned hstep = (unsigned)(HALF * K * 2);
    const unsigned ldsw = (unsigned)wid * 1024u;
    const int aoff = lds_byte(wr * 64 + fr, fq * 8), boff = lds_byte(wc * 32 + fr, fq * 8);
#define PG8_SA(b, h) (((b) * 2 + (h)) * HTB)
#define PG8_SB(b, h) ((4 + (b) * 2 + (h)) * HTB)
#define PG8_STAGE(bufoff, soff, voff) do { const int _so = __builtin_amdgcn_readfirstlane((int)(soff)); _Pragma("unroll") for (int _i = 0; _i < 2; ++_i) \
        __builtin_amdgcn_raw_ptr_buffer_load_lds(rsrc, (LAS void*)(lds + (bufoff) + ldsw + _i * 8192), 16, (int)(voff)[_i], _so, 0, 0); } while (0)
#define PG8_LDA(dst, b, h) do { _Pragma("unroll") for (int m = 0; m < 4; ++m) _Pragma("unroll") for (int k = 0; k < 2; ++k) dst[m][k] = *(const LAS bf16x8*)(lds + PG8_SA(b, h) + aoff + m * 2048 + k * 1024); } while (0)
#define PG8_LDB(dst, b, h) do { _Pragma("unroll") for (int n = 0; n < 2; ++n) _Pragma("unroll") for (int k = 0; k < 2; ++k) dst[n][k] = *(const LAS bf16x8*)(lds + PG8_SB(b, h) + boff + n * 2048 + k * 1024); } while (0)
#define PG8_MMA(ai, bj, At, Bt) do { __builtin_amdgcn_s_setprio(1); _Pragma("unroll") for (int m = 0; m < 4; ++m) _Pragma("unroll") for (int n = 0; n < 2; ++n) _Pragma("unroll") for (int k = 0; k < 2; ++k) \
        acc[ai][bj][m][n] = __builtin_amdgcn_mfma_f32_16x16x32_bf16(Bt[n][k], At[m][k], acc[ai][bj][m][n], 0, 0, 0); __builtin_amdgcn_s_setprio(0); } while (0)
#define PG8_WAIT_V(n) asm volatile("s_waitcnt vmcnt(" #n ")" ::: "memory")
#define PG8_WAIT_L(n) asm volatile("s_waitcnt lgkmcnt(" #n ")" ::: "memory")
#define PG8_BAR __builtin_amdgcn_s_barrier()
#define PG8_SCHED __builtin_amdgcn_sched_barrier(0)
#define PG8_IDX_ISSUE(u, slot) __builtin_amdgcn_raw_ptr_buffer_load_lds(rsrc, (LAS void*)(idxlds + (slot) * 256 + (wid & 3) * 64), 4, lane * 4, \
        __builtin_amdgcn_readfirstlane((int)(S.idxoff + (unsigned)((u).rb + (wid & 3) * 64) * 4u)), 0, 0)
#define PG8_IDX_READ(dst, h_, slot, nv_) do { int _t = tid; asm volatile("" : "+v"(_t));   \
        _Pragma("unroll") for (int _i = 0; _i < 2; ++_i) { int _R, _C; stage_rc(_t * 16 + _i * 8192, _R, _C); \
        const int _ix = ((h_) * HALF + _R) < (nv_) ? idxlds[(slot) * 256 + (h_) * HALF + _R] : S.padrow;        \
        dst[_i] = (unsigned)_ix * (unsigned)(K * 2) + (unsigned)(_C * 2); } } while (0)
    Unit cur, nxt; int ui = 0;
    if (!S.next(0, cur)) return;
    f32x4 acc[2][2][4][2];
#pragma unroll
    for (int a = 0; a < 2; ++a)
#pragma unroll
        for (int b = 0; b < 2; ++b)
#pragma unroll
            for (int m = 0; m < 4; ++m)
#pragma unroll
                for (int n = 0; n < 2; ++n) acc[a][b][m][n] = (f32x4){0.f, 0.f, 0.f, 0.f};
    bf16x8 At[4][2], B0[2][2], B1[2][2];
    unsigned cA = cur.a, cB = cur.b;
    if constexpr (Sched::GATHER || Epi::ROWAUX) {
        PG8_IDX_ISSUE(cur, 0); PG8_WAIT_V(0); PG8_BAR;     asm volatile("" ::: "memory");
        if constexpr (Sched::GATHER) { PG8_IDX_READ(voffA[0], 0, 0, cur.nv); PG8_IDX_READ(voffA[1], 1, 0, cur.nv); }
    }
    if constexpr (SP2) {
        PG8_STAGE(PG8_SB(0, 0), cB, voffB); PG8_STAGE(PG8_SB(0, 1), cB + hstep, voffB); PG8_STAGE(PG8_SA(0, 0), cA, voffA[0]); PG8_STAGE(PG8_SA(0, 1), cA, voffA[1]);
        if (wr == 1) PG8_BAR;
        PG8_WAIT_V(2); PG8_BAR;
        PG8_STAGE(PG8_SB(1, 0), cB + kstep, voffB); PG8_STAGE(PG8_SA(1, 0), cA + kstep, voffA[0]); PG8_STAGE(PG8_SB(1, 1), cB + hstep + kstep, voffB);
        PG8_WAIT_V(6); PG8_BAR;
    } else {
        PG8_STAGE(PG8_SB(0, 0), cB, voffB); PG8_STAGE(PG8_SA(0, 0), cA, voffA[0]); PG8_STAGE(PG8_SB(0, 1), cB + hstep, voffB); PG8_STAGE(PG8_SA(0, 1), cA, voffA[1]);
        if (wr == 1) PG8_BAR;
        PG8_WAIT_V(4); PG8_BAR;
        PG8_STAGE(PG8_SB(1, 0), cB + kstep, voffB); PG8_STAGE(PG8_SA(1, 0), cA + kstep, voffA[0]); PG8_STAGE(PG8_SB(1, 1), cB + hstep + kstep, voffB);
        PG8_WAIT_V(6); PG8_BAR;
    }
    for (;;) {
        const bool has_next = S.next(ui + 1, nxt);
        const unsigned nA = has_next ? nxt.a : cA, nB = has_next ? nxt.b : cB;
        for (int t = 0; t < nt; t += 2) {
            const bool last = (t == nt - 2);
            const unsigned a1 = cA + (unsigned)(t + 1) * kstep;
            const unsigned a2 = last ? nA : cA + (unsigned)(t + 2) * kstep, b2 = last ? nB : cB + (unsigned)(t + 2) * kstep;
            const unsigned a3 = a2 + kstep, b3 = b2 + kstep;
            if constexpr (Sched::GATHER || Epi::ROWAUX) { if (t == 0 && has_next) PG8_IDX_ISSUE(nxt, (ui + 1) % 3); }
            if constexpr (Sched::GATHER) { if (last && has_next) PG8_IDX_READ(voffA[0], 0, (ui + 1) % 3, nxt.nv); }
#define PG8_NEXT_H1() do { if constexpr (Sched::GATHER) { if (last && has_next) PG8_IDX_READ(voffA[1], 1, (ui + 1) % 3, nxt.nv); } } while (0)
            if constexpr (SP2) {
            PG8_LDB(B0, 0, 0); PG8_LDB(B1, 0, 1); PG8_SCHED; PG8_LDA(At, 0, 0); PG8_STAGE(PG8_SA(1, 1), a1, voffA[1]); PG8_NEXT_H1();
            PG8_WAIT_V(8); PG8_WAIT_L(0); PG8_BAR; PG8_MMA(0, 0, At, B0); PG8_MMA(0, 1, At, B1); PG8_BAR; PG8_SCHED;
            PG8_LDA(At, 0, 1); PG8_STAGE(PG8_SB(0, 0), b2, voffB); PG8_STAGE(PG8_SB(0, 1), b2 + hstep, voffB); PG8_STAGE(PG8_SA(0, 0), a2, voffA[0]);
            PG8_WAIT_V(8); PG8_WAIT_L(0); PG8_BAR; PG8_MMA(1, 0, At, B0); PG8_MMA(1, 1, At, B1); PG8_BAR; PG8_SCHED;
            PG8_LDB(B0, 1, 0); PG8_LDB(B1, 1, 1); PG8_SCHED; PG8_LDA(At, 1, 0); PG8_STAGE(PG8_SA(0, 1), a2, voffA[1]);
            PG8_WAIT_V(8); PG8_WAIT_L(0); PG8_BAR; PG8_MMA(0, 0, At, B0); PG8_MMA(0, 1, At, B1); PG8_BAR; PG8_SCHED;
            PG8_LDA(At, 1, 1); PG8_STAGE(PG8_SB(1, 0), b3, voffB); PG8_STAGE(PG8_SB(1, 1), b3 + hstep, voffB); PG8_STAGE(PG8_SA(1, 0), a3, voffA[0]);
            PG8_WAIT_V(8); PG8_WAIT_L(0); PG8_BAR; PG8_MMA(1, 0, At, B0); PG8_MMA(1, 1, At, B1); PG8_BAR; PG8_SCHED;
            } else {
            PG8_LDB(B0, 0, 0); PG8_SCHED; PG8_LDA(At, 0, 0); PG8_STAGE(PG8_SA(1, 1), a1, voffA[1]); PG8_NEXT_H1();
            PG8_WAIT_L(8); PG8_BAR; PG8_WAIT_L(0); PG8_MMA(0, 0, At, B0); PG8_BAR; PG8_SCHED;
            PG8_LDB(B1, 0, 1); PG8_STAGE(PG8_SB(0, 0), b2, voffB);
            PG8_BAR; PG8_WAIT_L(0); PG8_MMA(0, 1, At, B1); PG8_BAR;
            PG8_LDA(At, 0, 1); PG8_STAGE(PG8_SA(0, 0), a2, voffA[0]);
            PG8_BAR; PG8_WAIT_L(0); PG8_MMA(1, 0, At, B0); PG8_BAR; PG8_SCHED;
            PG8_STAGE(PG8_SB(0, 1), b2 + hstep, voffB);
            PG8_WAIT_V(6); PG8_BAR; PG8_MMA(1, 1, At, B1); PG8_BAR;
            PG8_LDB(B0, 1, 0); PG8_SCHED; PG8_LDA(At, 1, 0); PG8_STAGE(PG8_SA(0, 1), a2, voffA[1]);
            PG8_WAIT_L(8); PG8_BAR; PG8_WAIT_L(0); PG8_MMA(0, 0, At, B0); PG8_BAR; PG8_SCHED;
            PG8_LDB(B1, 1, 1); PG8_STAGE(PG8_SB(1, 0), b3, voffB);
            PG8_BAR; PG8_WAIT_L(0); PG8_MMA(0, 1, At, B1); PG8_BAR;
            PG8_LDA(At, 1, 1); PG8_STAGE(PG8_SA(1, 0), a3, voffA[0]);
            PG8_BAR; PG8_WAIT_L(0); PG8_MMA(1, 0, At, B0); PG8_BAR; PG8_SCHED;
            PG8_STAGE(PG8_SB(1, 1), b3 + hstep, voffB);
            PG8_WAIT_V(6); PG8_BAR; PG8_MMA(1, 1, At, B1); PG8_BAR;
            }
        }
        if constexpr (ALIGN_EPI) { if (wr == 0) PG8_BAR; }
        if constexpr (Epi::ROWAUX) E(acc, cur, wr, wc, fr, fq, idxlds + (ui % 3) * 256); else E(acc, cur, wr, wc, fr, fq);
        if (!has_next) break;
#pragma unroll
        for (int a = 0; a < 2; ++a)
#pragma unroll
            for (int b = 0; b < 2; ++b)
#pragma unroll
                for (int m = 0; m < 4; ++m)
#pragma unroll
                    for (int n = 0; n < 2; ++n) acc[a][b][m][n] = (f32x4){0.f, 0.f, 0.f, 0.f};
        cur = nxt; cA = nA; cB = nB; ++ui;
        if constexpr (ALIGN_EPI) { if (wr == 1) PG8_BAR; }
    }
    PG8_WAIT_V(0);
    if constexpr (!ALIGN_EPI) { if (wr == 0) PG8_BAR; }
    PG8_BAR;
#undef PG8_SA
#undef PG8_SB
#undef PG8_STAGE
#undef PG8_LDA
#undef PG8_LDB
#undef PG8_MMA
#undef PG8_WAIT_V
#undef PG8_WAIT_L
#undef PG8_BAR
#undef PG8_SCHED
#undef PG8_IDX_ISSUE
#undef PG8_IDX_READ
#undef PG8_NEXT_H1
}
}
constexpr int T_ = 16384, D_ = 1024, NB_ = 4, S_ = 4096, NEXP = 64, TOPK = 8;
constexpr int ECAP = 16384;
constexpr int PMAX = 163840;
constexpr float LN_EPS = 1e-5f, RMS_EPS = 1e-6f;
constexpr float ALPHA_DN = 1.6817928305074290f;
constexpr float QSCALE = 0.125f * 1.4426950408889634f;

namespace pg8 {
constexpr int NXCD = 8, WGM = 8;
struct DenseOrder {
    static constexpr bool GATHER = false;
    unsigned A, Bt; int K; int nM, nN, nwg, G, c; unsigned idxoff; static constexpr int padrow = 0;
    DI void init(size_t A_, size_t Bt_, int M, int N, int K_, int G_, int c_) { A = (unsigned)A_; Bt = (unsigned)Bt_; K = K_; nM = M / BM; nN = N / BM; nwg = nM * nN; G = G_; c = c_; idxoff = 0u; }
    DI bool next(int i, Unit& u) const {
        const long L = (long)i * G + c; if (L >= nwg) return false;
        int wgid = (int)L; { const int q = nwg / NXCD, r = nwg % NXCD, xcd = wgid % NXCD, off = wgid / NXCD; wgid = (xcd < r ? xcd * (q + 1) : r * (q + 1) + (xcd - r) * q) + off; }
        const int nig = WGM * nN, gid = wgid / nig, fm = gid * WGM, gsz = (nM - fm) < WGM ? (nM - fm) : WGM;
        const int pm = fm + ((wgid % nig) % gsz), pn = (wgid % nig) / gsz;
        u.a = A + (unsigned)(pm * BM * K * 2); u.b = Bt + (unsigned)(pn * BM * K * 2); u.r0 = pm * BM; u.c0 = pn * BM; u.e = 0; u.rb = 0; u.nv = BM; return true;
    }
};
template <bool GATH> struct MoeOrder {
    static constexpr bool GATHER = GATH;
    unsigned A, Bt; int K; int nct_log, nunits, G, c; unsigned idxoff; const LAS int* tileoff; const LAS int* ecnt; unsigned bstride; static constexpr int padrow = T_;
    DI bool next(int i, Unit& u) const {
        const long L = (long)i * G + c; if (L >= nunits) return false;
        int wgid = (int)L; { const int q = nunits / NXCD, r = nunits % NXCD, xcd = wgid % NXCD, off = wgid / NXCD; wgid = (xcd < r ? xcd * (q + 1) : r * (q + 1) + (xcd - r) * q) + off; }
        const int tile = wgid >> nct_log, pn = wgid & ((1 << nct_log) - 1);
        int e = 0;
#pragma unroll 1
        for (int j = 32; j >= 1; j >>= 1) { const int cand = e + j; if (tileoff[cand] <= tile) e = cand; }
        if (e < NEXP && tileoff[e + 1] <= tile) e += 1;
        e = __builtin_amdgcn_readfirstlane(e);
        u.e = e; u.r0 = tile * BM; u.c0 = pn * BM;
        { const int ti = tile - __builtin_amdgcn_readfirstlane(tileoff[e]); u.rb = e * ECAP + ti * BM; u.nv = __builtin_amdgcn_readfirstlane(ecnt[e]) - ti * BM; }
        u.a = GATH ? A : A + (unsigned)(tile * BM * K * 2);
        u.b = Bt + (unsigned)e * bstride + (unsigned)(pn * BM * K * 2);
        return true;
    }
};

struct EpiF32 {
    static constexpr bool PERM = false, ROWAUX = false;
    float* C; int ldc;
    DI void operator()(const f32x4 (&acc)[2][2][4][2], const Unit& u, int wr, int wc, int fr, int fq) const {
        const int row0 = u.r0 + wr * 64 + fr, col0 = u.c0 + wc * 32 + 4 * fq;
#pragma unroll
        for (int ai = 0; ai < 2; ++ai)
#pragma unroll
            for (int m = 0; m < 4; ++m) { float* rowp = C + (size_t)(row0 + ai * HALF + m * 16) * ldc + col0;
#pragma unroll
                for (int bj = 0; bj < 2; ++bj)
#pragma unroll
                    for (int n = 0; n < 2; ++n) *(f32x4*)(rowp + bj * HALF + n * 16) = acc[ai][bj][m][n]; }
    }
};
struct EpiBf16 {
    static constexpr bool PERM = true, ROWAUX = false;
    bf16* O; int ldc;
    DI void operator()(const f32x4 (&acc)[2][2][4][2], const Unit& u, int wr, int wc, int fr, int fq) const {
        const int row0 = u.r0 + wr * 64 + fr, col0 = u.c0 + wc * 32 + 8 * fq;
#pragma unroll
        for (int ai = 0; ai < 2; ++ai)
#pragma unroll
            for (int m = 0; m < 4; ++m) { bf16* rowp = O + (size_t)(row0 + ai * HALF + m * 16) * ldc + col0;
#pragma unroll
                for (int bj = 0; bj < 2; ++bj) { const f32x4 v0 = acc[ai][bj][m][0], v1 = acc[ai][bj][m][1];
                    u32x4 w; w.x = cvtpk(v0[0], v0[1]); w.y = cvtpk(v0[2], v0[3]); w.z = cvtpk(v1[0], v1[1]); w.w = cvtpk(v1[2], v1[3]);
                    *(u32x4*)(rowp + bj * HALF) = w; } }
    }
};
struct EpiQKV {
    static constexpr bool PERM = true, ROWAUX = false;
    bf16* QKV; const float* COS; const float* SIN;
    DI void operator()(const f32x4 (&acc)[2][2][4][2], const Unit& u, int wr, int wc, int fr, int fq) const {
        const int pn = u.c0 >> 8, g = pn / 12, which = (pn >> 2) % 3, hq = pn & 3;
        const int ldil = 2 * g, dil = 1 << ldil;
        const int idx = 4 * (wc & 1) + fq, b = u.r0 >> 12;
        const int row0 = u.r0 + wr * 64 + fr;
#pragma unroll
        for (int ai = 0; ai < 2; ++ai)
#pragma unroll
            for (int m = 0; m < 4; ++m) {
                const int r = row0 + ai * HALF + m * 16, t = r & (S_ - 1);
                const int prow = (t & (dil - 1)) * (S_ >> ldil) + (t >> ldil);
                f32x4 c4 = (f32x4){1.f, 1.f, 1.f, 1.f}, s4 = (f32x4){0.f, 0.f, 0.f, 0.f};
                if (which < 2) { c4 = *(const f32x4*)(COS + (size_t)r * 32 + 4 * idx); s4 = *(const f32x4*)(SIN + (size_t)r * 32 + 4 * idx); }
#pragma unroll
                for (int bj = 0; bj < 2; ++bj) {
                    const int head = 4 * hq + 2 * bj + (wc >> 1);
                    const f32x4 v0 = acc[ai][bj][m][0], v1 = acc[ai][bj][m][1];
                    f32x4 o0 = v0 * c4 - v1 * s4, o1 = v1 * c4 + v0 * s4;
                    if (which == 0) { o0 = o0 * QSCALE; o1 = o1 * QSCALE; }
                    u32x4 w; w.x = cvtpk(o0[0], o0[1]); w.y = cvtpk(o0[2], o0[3]); w.z = cvtpk(o1[0], o1[1]); w.w = cvtpk(o1[2], o1[3]);
                    bf16* dst = QKV + ((((size_t)(which * 3 + g) * NB_ + b) * 16 + head) * S_ + prow) * 64 + 8 * idx;
                    *(u32x4*)dst = w;
                }
            }
    }
};
struct EpiSwiGLU {
    static constexpr bool PERM = true, ROWAUX = false;
    bf16* HID;
    DI void operator()(const f32x4 (&acc)[2][2][4][2], const Unit& u, int wr, int wc, int fr, int fq) const {
        const int row0 = u.r0 + wr * 64 + fr, col0 = (u.c0 >> 1) + wc * 32 + 8 * fq;
#pragma unroll
        for (int ai = 0; ai < 2; ++ai)
#pragma unroll
            for (int m = 0; m < 4; ++m) {
                float hv[8];
#pragma unroll
                for (int n = 0; n < 2; ++n)
#pragma unroll
                    for (int j = 0; j < 4; ++j) { const float a = acc[ai][0][m][n][j], bb = acc[ai][1][m][n][j]; hv[4 * n + j] = silu_f(a) * bb; }
                u32x4 w; w.x = cvtpk(hv[0], hv[1]); w.y = cvtpk(hv[2], hv[3]); w.z = cvtpk(hv[4], hv[5]); w.w = cvtpk(hv[6], hv[7]);
                *(u32x4*)(HID + (size_t)(row0 + ai * HALF + m * 16) * 256 + col0) = w;
            }
    }
};
constexpr size_t YS_OFF = (size_t)160 << 20;
struct EpiScale {
    static constexpr bool PERM = true, ROWAUX = true;
    unsigned char* YE;
    int s0;
    DI void operator()(const f32x4 (&acc)[2][2][4][2], const Unit& u, int wr, int wc, int fr, int fq, const LAS int* aux) const {
        const int row0 = wr * 64 + fr, col0 = u.c0 + wc * 32 + 8 * fq;
        if (u.e == NEXP) {
            bf16* base = (bf16*)pg8::rfl_ptr((const char*)(YE + YS_OFF) + (size_t)(u.r0 - s0) * (D_ * 2));
#pragma unroll
            for (int ai = 0; ai < 2; ++ai)
#pragma unroll
                for (int m = 0; m < 4; ++m) { const unsigned ro = (unsigned)((row0 + ai * HALF + m * 16) * D_ + col0) * 2u;
#pragma unroll
                    for (int bj = 0; bj < 2; ++bj) { const f32x4 v0 = acc[ai][bj][m][0], v1 = acc[ai][bj][m][1];
                        u32x4 w; w.x = cvtpk(v0[0], v0[1]); w.y = cvtpk(v0[2], v0[3]); w.z = cvtpk(v1[0], v1[1]); w.w = cvtpk(v1[2], v1[3]);
                        *(u32x4*)((char*)base + ro + bj * HALF * 2) = w; } }
        } else {
            unsigned char* base = (unsigned char*)pg8::rfl_ptr((const char*)YE + (size_t)u.r0 * D_);
#pragma unroll
            for (int ai = 0; ai < 2; ++ai)
#pragma unroll
                for (int m = 0; m < 4; ++m) { const int rl = row0 + ai * HALF + m * 16; const float wgt = __builtin_bit_cast(float, aux[rl]) * YE_SCALE; const unsigned ro = (unsigned)(rl * D_ + col0);
#pragma unroll
                    for (int bj = 0; bj < 2; ++bj) { const f32x4 v0 = acc[ai][bj][m][0] * wgt, v1 = acc[ai][bj][m][1] * wgt;
                        u32x2 w; w.x = cvtpk_fp8(v0[0], v0[1], v0[2], v0[3]); w.y = cvtpk_fp8(v1[0], v1[1], v1[2], v1[3]);
                        *(u32x2*)(base + ro + bj * HALF) = w; } }
        }
    }
};
}
constexpr size_t MiB = 1u << 20;
constexpr size_t WS_CTL = 0, CTL_ZERO_BYTES = 1 * MiB;
constexpr size_t WS_MOD = 1 * MiB;
constexpr size_t WS_COS = 2 * MiB;
constexpr size_t WS_SIN = 4 * MiB;
constexpr size_t WS_ASG_E = 6 * MiB;
constexpr size_t WS_ASG_R = 6 * MiB + 512 * 1024;
constexpr size_t WS_ASG_W = 7 * MiB;
constexpr size_t WS_ASG_ROW = 7 * MiB + 512 * 1024;
constexpr size_t WS_ROWTOK = 8 * MiB;
constexpr size_t WS_ROWW = 9 * MiB;
constexpr size_t WS_AB = 10 * MiB;
constexpr size_t WS_GALPHA = 11 * MiB;
constexpr size_t WS_GBETA = 11 * MiB + 512 * 1024;
constexpr size_t WS_X = 12 * MiB;
constexpr size_t WS_Y = 76 * MiB;
constexpr size_t WS_H = 140 * MiB;
constexpr size_t WS_O = 173 * MiB;
constexpr size_t WS_WA_IN = 205 * MiB;
constexpr size_t WS_WA_OUT = 241 * MiB;
constexpr size_t WS_WG_IN = 245 * MiB;
constexpr size_t WS_WG_OUT = 261 * MiB;
constexpr size_t WS_WE1 = 265 * MiB;
constexpr size_t WS_WE2 = 330 * MiB;
constexpr size_t WS_HID = 363 * MiB;
constexpr size_t WS_BIG = 443 * MiB;
constexpr size_t WS_YS_OFF = pg8::YS_OFF;
constexpr size_t WS_WEB = WS_BIG + 368 * MiB;
constexpr size_t WS_WRF = WS_BIG + 466 * MiB;
constexpr size_t WS_WABF = WS_WRF + 1 * MiB;
constexpr size_t WS_ETOK = WS_WABF + 1 * MiB;
constexpr size_t WS_EW = WS_ETOK + 5 * MiB;
constexpr size_t WS_END = WS_EW + 5 * MiB;
constexpr size_t BIG_PROJ = 0, BIG_QN = 128 * MiB, BIG_KN = 192 * MiB, BIG_VV = 256 * MiB, BIG_ORAW = 320 * MiB;
constexpr int CW_BAR = 4096;
constexpr int CW_CNT = 16384;
constexpr int RING_BYTES = 131072;
constexpr int LDS_IDX = RING_BYTES;
constexpr int LDS_TILEOFF = LDS_IDX + 3072;
constexpr int LDS_LCNT = LDS_TILEOFF + 512;
constexpr int LDS_LBASE = LDS_LCNT + 256;
constexpr int LDS_LASG = LDS_LBASE + 256;
constexpr int LDS_ECNT = LDS_LASG;
constexpr int LDS_LW = LDS_IDX;
constexpr int LDS_MISC = LDS_LASG + 2048;
constexpr int LDS_LG = LDS_MISC + 128;
constexpr int LDS_BYTES = 147456;
static_assert(LDS_LG + 8192 <= LDS_BYTES, "LDS map");
constexpr int NWAVES = 8, NTHR = 512;

#define XB_TMO      128
#define XB_XCNT(j)  (256  + 64 * (j))
#define XB_XSUB(j)  (1280 + 64 * (j))
#define XB_XGEN(j)  (2304 + 64 * (j))
#define XB_TOP      3328
#define XB_TOPGEN   3392
#define XCD_BAR_WORDS 3456
#define XB_SPIN_CAP (1u << 18)
__device__ __forceinline__ unsigned xb_ld(unsigned* p)              { return __hip_atomic_load(p, __ATOMIC_RELAXED, __HIP_MEMORY_SCOPE_AGENT); }
__device__ __forceinline__ unsigned xb_add(unsigned* p, unsigned v) { return __hip_atomic_fetch_add(p, v, __ATOMIC_RELAXED, __HIP_MEMORY_SCOPE_AGENT); }
__device__ __forceinline__ unsigned xb_xcc_id() { return (unsigned)__builtin_amdgcn_s_getreg((3 << 11) | 20) & 0xFu; }
#define XB_SPIN(cond, bar) do { unsigned _sp = 0; while (cond) { __builtin_amdgcn_s_sleep(1); \
    if ((++_sp & 255u) == 0u) { if (xb_ld(&(bar)[XB_TMO])) break; if (_sp > XB_SPIN_CAP) { atomicAdd(&(bar)[XB_TMO], 1u); break; } } } } while (0)
struct XcdBarrier { unsigned* bar; unsigned x; volatile LAS unsigned* st; };
__device__ __forceinline__ XcdBarrier xcd_barrier_post(unsigned* bar, volatile LAS unsigned* st) {
    XcdBarrier b; b.bar = bar; b.x = xb_xcc_id(); b.st = st;
    if (threadIdx.x == 0) (void)xb_add(&bar[XB_XCNT(b.x)], 1u);
    return b;
}
__device__ __forceinline__ void xcd_barrier_complete(unsigned* bar, unsigned x, unsigned& nloc, unsigned& nx) {
    const unsigned G = gridDim.x * gridDim.y * gridDim.z;
    unsigned sum, cnt, mine, sp = 0u;
    for (;;) {
        sum = 0u; cnt = 0u; mine = 0u;
#pragma unroll
        for (unsigned j = 0; j < 16; ++j) { const unsigned c = xb_ld(&bar[XB_XCNT(j)]); sum += c; cnt += (c > 0u) ? 1u : 0u; mine = (j == x) ? c : mine; }
        if (sum == G) break;
        __builtin_amdgcn_s_sleep(1);
        if ((++sp & 255u) == 0u) { if (xb_ld(&bar[XB_TMO])) break; if (sp > XB_SPIN_CAP) { atomicAdd(&bar[XB_TMO], 1u); break; } }
    }
    nloc = mine > 0u ? mine : 1u; nx = cnt > 0u ? cnt : 1u;
}
__device__ __forceinline__ void xcd_barrier(const XcdBarrier& b, const int tid) {
    asm volatile("s_waitcnt vmcnt(0)" ::: "memory");
    __syncthreads();
    if (tid == 0) {
        unsigned* bar = b.bar;
        __builtin_amdgcn_s_waitcnt(0);
        unsigned nloc = b.st[0], nx = b.st[1];
        if (nloc == 0u) { xcd_barrier_complete(bar, b.x, nloc, nx); b.st[0] = nloc; b.st[1] = nx; }
        const unsigned old = xb_add(&bar[XB_XSUB(b.x)], 1u);
        const unsigned gen = old / nloc;
        if (old + 1u == (gen + 1u) * nloc) {
            __builtin_amdgcn_fence(__ATOMIC_RELEASE, "agent");
            asm volatile("s_waitcnt vmcnt(0)" ::: "memory");
            const unsigned og = xb_add(&bar[XB_TOP], 1u);
            const unsigned tg = og / nx;
            if (og + 1u == (tg + 1u) * nx) xb_add(&bar[XB_TOPGEN], 1u);
            else XB_SPIN(xb_ld(&bar[XB_TOPGEN]) == tg, bar);
            __builtin_amdgcn_fence(__ATOMIC_ACQUIRE, "agent");
            xb_add(&bar[XB_XGEN(b.x)], 1u);
            asm volatile("s_waitcnt vmcnt(0)" ::: "memory");
        } else {
            XB_SPIN(xb_ld(&bar[XB_XGEN(b.x)]) == gen, bar);
            __builtin_amdgcn_fence(__ATOMIC_ACQUIRE, "agent");
            asm volatile("s_waitcnt vmcnt(0)" ::: "memory");
        }
    }
    __syncthreads();
}

struct Args {
    const float* x; const float* c; const int* pos; const float* ada_w; const float* ada_b; const float* ln_g; const float* ln_b;
    const float* attn_w_in; const float* attn_w_out; const float* gdn_w_in; const float* gdn_conv_w; const float* gdn_a_log; const float* gdn_dt_bias;
    const float* gdn_norm_w; const float* gdn_w_out; const float* router_w; const float* router_bias; const float* ew1; const float* ew3; const float* ew2;
    const float* sw1; const float* sw3; const float* sw2;
    float* out; unsigned char* ws; int ph_lo, ph_hi;
};
typedef __attribute__((address_space(1))) unsigned char gas_u8;
DI unsigned char* opq(unsigned char* p) { gas_u8* g = (gas_u8*)p; asm volatile("" : "+s"(g)); return (unsigned char*)g; }
template <class T> DI T* asg(T* p) { typedef __attribute__((address_space(1))) T gT; return (T*)(gT*)p; }
struct Frame {
    LAS unsigned char* lds;
    int tid, lane, wave, G, bid;
};
template <class Map> DI void transpose_item(const float* W, int ldn, int K, bf16* WT, const Map& map, LAS float* scr, int kb, int nb, int lane) {
    const int k0 = 64 * kb, n0 = 32 * nb;
    float tv[32];
#pragma unroll
    for (int i = 0; i < 32; ++i) tv[i] = __builtin_nontemporal_load(&W[(size_t)(k0 + 2 * i + (lane >> 5)) * ldn + n0 + (lane & 31)]);
#pragma unroll
    for (int i = 0; i < 32; ++i) scr[(2 * i + (lane >> 5)) * 33 + (lane & 31)] = tv[i];
    LDS_WAIT(); asm volatile("" ::: "memory");
    const int c = lane & 7;
#pragma unroll
    for (int j = 0; j < 4; ++j) { const int n = (lane >> 3) + 8 * j; const LAS float* s = scr + (8 * c) * 33 + n;
        u32x4 o; o.x = cvtpk(s[0 * 33], s[1 * 33]); o.y = cvtpk(s[2 * 33], s[3 * 33]); o.z = cvtpk(s[4 * 33], s[5 * 33]); o.w = cvtpk(s[6 * 33], s[7 * 33]);
        *(u32x4*)(WT + (size_t)map(n0 + n) * K + k0 + 8 * c) = o; }
    LDS_WAIT(); asm volatile("" ::: "memory");
}
struct MapId { int off; DI int operator()(int n) const { return off + n; } };
struct MapQKV { DI int operator()(int n) const {
    const int which = (n >> 10) % 3; if (which == 2) return n;
    const int d = n & 63, idx = (d & 31) >> 2, lo = d & 3, hi = d >> 5; return (n & ~63) + 8 * idx + 4 * hi + lo; } };
struct MapW13 { int second; DI int operator()(int n) const { return (n >> 7) * 256 + second * 128 + (n & 127); } };
template <class Map> DI void convert_matrix(const Frame& F, const float* W, int ldn, int K, int N, bf16* WT, const Map& map) {
    LAS float* scr = (LAS float*)(F.lds + F.wave * 16384);
    const int gw = F.bid * NWAVES + F.wave, NGW = F.G * NWAVES, nblk = N / 32, nitems = (K / 64) * nblk;
    for (int it = gw; it < nitems; it += NGW) transpose_item(W, ldn, K, WT, map, scr, it / nblk, it % nblk, F.lane);
}

DI void prologue_phase(const Frame& F, const Args& A) {
    unsigned char* ws = opq(A.ws);
    {
        LAS float* red = (LAS float*)F.lds;
        float* MOD = (float*)(ws + WS_MOD);
        for (int item = F.bid; item < 8 * 48; item += F.G) {
            const int ls = item / 48, n = (item % 48) * 64 + F.lane;
            const float* w = A.ada_w + ((size_t)ls * D_ + F.wave * 128) * 3072 + n;
            const float* cc = A.c + F.wave * 128;
            float a0 = 0.f, a1 = 0.f, a2 = 0.f, a3 = 0.f;
#pragma unroll 8
            for (int k = 0; k < 128; ++k) { const float wv = __builtin_nontemporal_load(&w[(size_t)k * 3072]); a0 += cc[k] * wv; a1 += cc[D_ + k] * wv; a2 += cc[2 * D_ + k] * wv; a3 += cc[3 * D_ + k] * wv; }
            red[(F.wave * 4 + 0) * 64 + F.lane] = a0; red[(F.wave * 4 + 1) * 64 + F.lane] = a1; red[(F.wave * 4 + 2) * 64 + F.lane] = a2; red[(F.wave * 4 + 3) * 64 + F.lane] = a3;
            __syncthreads();
            if (F.wave < 4) { float s = A.ada_b[ls * 3072 + n];
#pragma unroll
                for (int w8 = 0; w8 < 8; ++w8) s += red[(w8 * 4 + F.wave) * 64 + F.lane];
                MOD[((size_t)ls * 4 + F.wave) * 3072 + n] = s; }
            __syncthreads();
        }
    }
    {
        float* COS = (float*)(ws + WS_COS); float* SIN = (float*)(ws + WS_SIN);
        for (int idx = F.bid * NTHR + F.tid; idx < T_ * 32; idx += F.G * NTHR) {
            const int t = idx >> 5, i = idx & 31;
            const float inv = powf(10000.0f, -(float)i / 32.0f);
            const float ang = (float)A.pos[t] * inv;
            COS[idx] = cosf(ang); SIN[idx] = sinf(ang);
        }
    }
    {
        bf16* WRF = (bf16*)(ws + WS_WRF); bf16* WABF = (bf16*)(ws + WS_WABF);
        for (int idx = F.bid * NTHR + F.tid; idx < 4 * 4 * 32 * 64 * 8; idx += F.G * NTHR) {
            const int jx = idx & 7, ln = (idx >> 3) & 63, ks = (idx >> 9) & 31, nt = (idx >> 14) & 3, layer = idx >> 16;
            const int d = 32 * ks + 8 * (ln >> 4) + jx, e = 16 * nt + (ln & 15);
            const float wv = A.router_w[((size_t)layer * D_ + d) * NEXP + e];
            const unsigned hi = cvtpk(wv, 0.f) & 0xffffu; const float res = wv - bf_lo(hi);
            const size_t o = (size_t)layer * 2 * 65536 + (idx & 65535);
            WRF[o] = (bf16)hi; WRF[o + 65536] = (bf16)(cvtpk(res, 0.f) & 0xffffu);
        }
        for (int idx = F.bid * NTHR + F.tid; idx < 2 * 32 * 64 * 8; idx += F.G * NTHR) {
            const int jx = idx & 7, ln = (idx >> 3) & 63, ks = (idx >> 9) & 31, jl = idx >> 14;
            const int d = 32 * ks + 8 * (ln >> 4) + jx, e = ln & 15;
            const float wv = A.gdn_w_in[((size_t)jl * D_ + d) * 4112 + 4096 + e];
            const unsigned hi = cvtpk(wv, 0.f) & 0xffffu; const float res = wv - bf_lo(hi);
            const size_t o = (size_t)jl * 2 * 16384 + (idx & 16383);
            WABF[o] = (bf16)hi; WABF[o + 16384] = (bf16)(cvtpk(res, 0.f) & 0xffffu);
        }
    }
    if (F.bid == 0) { bf16* H = (bf16*)(ws + WS_H); for (int cidx = F.tid; cidx < D_; cidx += NTHR) H[(size_t)T_ * D_ + cidx] = 0; }
    for (int j = 0; j < 2; ++j) {
        convert_matrix(F, A.attn_w_in + (size_t)j * D_ * 9216, 9216, D_, 9216, (bf16*)(ws + WS_WA_IN) + (size_t)j * 9216 * D_, MapQKV{});
        convert_matrix(F, A.attn_w_out + (size_t)j * D_ * D_, D_, D_, D_, (bf16*)(ws + WS_WA_OUT) + (size_t)j * D_ * D_, MapId{0});
        convert_matrix(F, A.gdn_w_in + (size_t)j * D_ * 4112, 4112, D_, 4096, (bf16*)(ws + WS_WG_IN) + (size_t)j * 4096 * D_, MapId{0});
        convert_matrix(F, A.gdn_w_out + (size_t)j * D_ * D_, D_, D_, D_, (bf16*)(ws + WS_WG_OUT) + (size_t)j * D_ * D_, MapId{0});
    }
}
struct XItem { const float* src; bf16* dst; int ldn, K, mode, n0; };
DI XItem xi_decode(const Args& A, int layer, bf16* WE1, bf16* WE2, int it) {
    constexpr int I13 = (D_ / 64) * (256 / 32), I2 = (256 / 64) * (D_ / 32), IPE = 2 * I13 + I2;
    const int e = it / IPE; int r = it % IPE; XItem x;
    if (r < 2 * I13) { const int second = r >= I13 ? 1 : 0; r -= second * I13; const int kb = r >> 3, nb = r & 7;
        const float* w = second ? (e < 64 ? A.ew3 + ((size_t)layer * 64 + e) * D_ * 256 : A.sw3 + (size_t)layer * D_ * 256) : (e < 64 ? A.ew1 + ((size_t)layer * 64 + e) * D_ * 256 : A.sw1 + (size_t)layer * D_ * 256);
        x.src = w + (size_t)(64 * kb) * 256 + 32 * nb; x.ldn = 256; x.K = D_; x.mode = 1 + second; x.n0 = 32 * nb; x.dst = WE1 + (size_t)e * 512 * D_ + 64 * kb;
    } else { r -= 2 * I13; const int kb = r >> 5, nb = r & 31;
        const float* w = e < 64 ? A.ew2 + ((size_t)layer * 64 + e) * 256 * D_ : A.sw2 + (size_t)layer * 256 * D_;
        x.src = w + (size_t)(64 * kb) * D_ + 32 * nb; x.ldn = D_; x.K = 256; x.mode = 0; x.n0 = 32 * nb; x.dst = WE2 + (size_t)e * D_ * 256 + 64 * kb; }
    return x;
}
#define XI_LOAD(buf, XT) do { const char* _b = pg8::rfl_ptr((const char*)(XT).src); const unsigned _ro = (unsigned)((XT).ldn * 4); \
    _Pragma("unroll") for (int _i = 0; _i < 8; ++_i) buf[_i] = __builtin_nontemporal_load((const f32x4*)(_b + ((unsigned)(8 * _i + (lane >> 3)) * _ro + (unsigned)(lane & 7) * 16u))); } while (0)
#define XI_PUT(buf, XT) do { \
    _Pragma("unroll") for (int _i = 0; _i < 8; ++_i) _Pragma("unroll") for (int _e = 0; _e < 4; ++_e) scr[(8 * _i + (lane >> 3)) * 33 + 4 * (lane & 7) + _e] = buf[_i][_e]; \
    LDS_WAIT(); asm volatile("" ::: "memory"); \
    const int _c = lane & 7; \
    _Pragma("unroll") for (int _j = 0; _j < 4; ++_j) { const int _n = (XT).n0 + (lane >> 3) + 8 * _j; const LAS float* _s = scr + (8 * _c) * 33 + (lane >> 3) + 8 * _j; \
        const int _row = (XT).mode == 0 ? _n : (_n >> 7) * 256 + ((XT).mode - 1) * 128 + (_n & 127); \
        u32x4 _o; _o.x = cvtpk(_s[0 * 33], _s[1 * 33]); _o.y = cvtpk(_s[2 * 33], _s[3 * 33]); _o.z = cvtpk(_s[4 * 33], _s[5 * 33]); _o.w = cvtpk(_s[6 * 33], _s[7 * 33]); \
        __builtin_nontemporal_store(_o, (u32x4*)((XT).dst + (size_t)_row * (XT).K + 8 * _c)); } \
    LDS_WAIT(); asm volatile("" ::: "memory"); } while (0)
DI void convert_experts(const Frame& F, const Args& A, int layer, int set, int wg0, int nwg) {
    if (F.bid < wg0 || F.bid >= wg0 + nwg) return;
    unsigned char* ws = opq(A.ws);
    LAS float* scr = (LAS float*)(F.lds + F.wave * 16384);
    bf16* WE1 = (bf16*)(ws + (set ? WS_WEB : WS_WE1)); bf16* WE2 = (bf16*)(ws + (set ? WS_WEB + 65 * MiB : WS_WE2));
    const int gw = (F.bid - wg0) * NWAVES + F.wave, NGW = nwg * NWAVES, lane = F.lane;
    constexpr int NIT = 65 * 384;
    f32x4 ba[8], bb[8];
    int it = gw;
    if (it >= NIT) return;
    XItem xa = xi_decode(A, layer, WE1, WE2, it), xb = xa;
    XI_LOAD(ba, xa);
#pragma unroll 1
    for (;;) {
        const bool hb = it + NGW < NIT;
        if (hb) { xb = xi_decode(A, layer, WE1, WE2, it + NGW); XI_LOAD(bb, xb); }
        __builtin_amdgcn_sched_barrier(0);
        XI_PUT(ba, xa);
        if (!hb) break;
        it += NGW;
        const bool ha = it + NGW < NIT;
        if (ha) { xa = xi_decode(A, layer, WE1, WE2, it + NGW); XI_LOAD(ba, xa); }
        __builtin_amdgcn_sched_barrier(0);
        XI_PUT(bb, xb);
        if (!ha) break;
        it += NGW;
    }
}
#undef XI_LOAD
#undef XI_PUT

DI void load_row16(const float* p, int lane, f32x4 (&v)[4]) {
#pragma unroll
    for (int j = 0; j < 4; ++j) v[j] = *(const f32x4*)(p + 4 * lane + 256 * j);
}
DI void store_row16(float* p, int lane, const f32x4 (&v)[4]) {
#pragma unroll
    for (int j = 0; j < 4; ++j) *(f32x4*)(p + 4 * lane + 256 * j) = v[j];
}
DI void store_row16_bf16(bf16* p, int lane, const f32x4 (&v)[4]) {
#pragma unroll
    for (int j = 0; j < 4; ++j) { u32x2 w; w.x = cvtpk(v[j][0], v[j][1]); w.y = cvtpk(v[j][2], v[j][3]); *(u32x2*)(p + 4 * lane + 256 * j) = w; }
}
DI void add_row16_bf16(const bf16* p, int lane, f32x4 (&v)[4]) {
#pragma unroll
    for (int j = 0; j < 4; ++j) { const u32x2 w = *(const u32x2*)(p + 4 * lane + 256 * j); v[j][0] += bf_lo(w.x); v[j][1] += bf_hi(w.x); v[j][2] += bf_lo(w.y); v[j][3] += bf_hi(w.y); }
}
DI void add_row16_fp8(const unsigned char* p, int lane, f32x4 (&v)[4]) {
#pragma unroll
    for (int j = 0; j < 4; ++j) { const int w = *(const int*)(p + 4 * lane + 256 * j);
        const f32x2 a = __builtin_amdgcn_cvt_pk_f32_fp8(w, false), b = __builtin_amdgcn_cvt_pk_f32_fp8(w, true);
        v[j][0] += a[0]; v[j][1] += a[1]; v[j][2] += b[0]; v[j][3] += b[1]; }
}
DI void layer_norm16(f32x4 (&v)[4], const f32x4 (&g)[4], const f32x4 (&b)[4]) {
    float s = 0.f;
#pragma unroll
    for (int j = 0; j < 4; ++j) s += (v[j][0] + v[j][1]) + (v[j][2] + v[j][3]);
    const float mean = wave_sum(s) * (1.0f / D_);
    float q = 0.f;
#pragma unroll
    for (int j = 0; j < 4; ++j) { v[j] = v[j] - mean; q += (v[j][0] * v[j][0] + v[j][1] * v[j][1]) + (v[j][2] * v[j][2] + v[j][3] * v[j][3]); }
    const float rstd = 1.0f / sqrtf(wave_sum(q) * (1.0f / D_) + LN_EPS);
#pragma unroll
    for (int j = 0; j < 4; ++j) v[j] = v[j] * rstd * g[j] + b[j];
}

DI void modx_phase(const Frame& F, const Args& A) {
    unsigned char* ws = opq(A.ws);
    const float* MOD = (const float*)(ws + WS_MOD); bf16* H = (bf16*)(ws + WS_H);
    const int gw = F.bid * NWAVES + F.wave, NGW = F.G * NWAVES;
    for (int row = gw; row < T_; row += NGW) {
        const int b = row >> 12; f32x4 v[4], sc[4], sh[4];
        load_row16(A.x + (size_t)row * D_, F.lane, v); load_row16(MOD + (size_t)(0 * 4 + b) * 3072 + 1024, F.lane, sc); load_row16(MOD + (size_t)(0 * 4 + b) * 3072, F.lane, sh);
#pragma unroll
        for (int j = 0; j < 4; ++j) v[j] = v[j] * (1.0f + sc[j]) + sh[j];
        store_row16_bf16(H + (size_t)row * D_, F.lane, v);
    }
}

DI void build_tileoff(const Frame& F, const unsigned* gcount) {
    LAS int* tileoff = (LAS int*)(F.lds + LDS_TILEOFF);
    __syncthreads();
    if (F.wave == 0) {
        const unsigned cn = __hip_atomic_load(gcount + F.lane, __ATOMIC_RELAXED, __HIP_MEMORY_SCOPE_AGENT);
        const int nt = (int)((cn + 255u) >> 8); int inc = nt;
#pragma unroll
        for (int o = 1; o < 64; o <<= 1) { const int t = __builtin_amdgcn_ds_bpermute((F.lane - o) << 2, inc); if (F.lane >= o) inc += t; }
        tileoff[F.lane] = inc - nt; ((LAS int*)(F.lds + LDS_ECNT))[F.lane] = (int)cn;
        if (F.lane == 63) { tileoff[64] = inc; tileoff[65] = inc + T_ / 256; ((LAS int*)(F.lds + LDS_ECNT))[NEXP] = T_; }
    }
    __syncthreads();
}

DI void deepnorm_row(f32x4 (&v)[4], const f32x4 (&y)[4], const float* gate, const float* lng, const float* lnb, float* xout, const float* mod_shift, int lane) {
    f32x4 t[4];
    load_row16(gate, lane, t);
#pragma unroll
    for (int j = 0; j < 4; ++j) v[j] = ALPHA_DN * v[j] + (1.0f + t[j]) * y[j];
    float s = 0.f;
#pragma unroll
    for (int j = 0; j < 4; ++j) s += (v[j][0] + v[j][1]) + (v[j][2] + v[j][3]);
    const float mean = wave_sum(s) * (1.0f / D_);
    float q = 0.f;
#pragma unroll
    for (int j = 0; j < 4; ++j) { v[j] = v[j] - mean; q += (v[j][0] * v[j][0] + v[j][1] * v[j][1]) + (v[j][2] * v[j][2] + v[j][3] * v[j][3]); }
    const float rstd = 1.0f / sqrtf(wave_sum(q) * (1.0f / D_) + LN_EPS);
    load_row16(lng, lane, t);
#pragma unroll
    for (int j = 0; j < 4; ++j) v[j] = v[j] * rstd * t[j];
    load_row16(lnb, lane, t);
#pragma unroll
    for (int j = 0; j < 4; ++j) v[j] = v[j] + t[j];
    store_row16(xout, lane, v);
    if (mod_shift) {
        load_row16(mod_shift + 1024, lane, t);
#pragma unroll
        for (int j = 0; j < 4; ++j) v[j] = v[j] * (1.0f + t[j]);
        load_row16(mod_shift, lane, t);
#pragma unroll
        for (int j = 0; j < 4; ++j) v[j] = v[j] + t[j];
    }
}
DI void put_hilo(LAS unsigned char* lds, int p, int lane, const f32x4 (&v)[4]) {
#pragma unroll
    for (int j = 0; j < 4; ++j) {
        const int c = 4 * lane + 256 * j;
        const unsigned h0 = cvtpk(v[j][0], v[j][1]), h1 = cvtpk(v[j][2], v[j][3]);
        const unsigned l0 = cvtpk(v[j][0] - bf_lo(h0), v[j][1] - bf_hi(h0)), l1 = cvtpk(v[j][2] - bf_lo(h1), v[j][3] - bf_hi(h1));
        const int off = ((((p >> 4) * 32 + (c >> 5)) * 64 + ((c & 31) >> 3) * 16 + (p & 15)) * 16) + (c & 7) * 2;
        *(LAS u32x2*)(lds + off) = (u32x2){h0, h1}; *(LAS u32x2*)(lds + 65536 + off) = (u32x2){l0, l1};
    }
}
DI f32x4 small_proj(const LAS unsigned char* lds, int mt, int lane, const bf16* wf_hi, const bf16* wf_lo) {
    f32x4 a0 = (f32x4){0.f, 0.f, 0.f, 0.f}, a1 = a0, a2 = a0;
#pragma unroll 8
    for (int ks = 0; ks < 32; ++ks) {
        const bf16x8 ah = *(const LAS bf16x8*)(lds + ((mt * 32 + ks) * 64 + lane) * 16), al = *(const LAS bf16x8*)(lds + 65536 + ((mt * 32 + ks) * 64 + lane) * 16);
        const bf16x8 bh = *(const bf16x8*)(wf_hi + (ks * 64 + lane) * 8), bl = *(const bf16x8*)(wf_lo + (ks * 64 + lane) * 8);
        a0 = __builtin_amdgcn_mfma_f32_16x16x32_bf16(ah, bh, a0, 0, 0, 0); a1 = __builtin_amdgcn_mfma_f32_16x16x32_bf16(ah, bl, a1, 0, 0, 0); a2 = __builtin_amdgcn_mfma_f32_16x16x32_bf16(al, bh, a2, 0, 0, 0);
    }
    return a0 + (a1 + a2);
}
DI void small_proj2(const LAS unsigned char* lds, int kh, int lane, const bf16* wf_hi, const bf16* wf_lo, f32x4& o0, f32x4& o1) {
    f32x4 a[2][3];
#pragma unroll
    for (int mt = 0; mt < 2; ++mt)
#pragma unroll
        for (int e = 0; e < 3; ++e) a[mt][e] = (f32x4){0.f, 0.f, 0.f, 0.f};
#pragma unroll 8
    for (int k = 0; k < 16; ++k) {
        const int ks = 16 * kh + k;
        const bf16x8 bh = *(const bf16x8*)(wf_hi + (ks * 64 + lane) * 8), bl = *(const bf16x8*)(wf_lo + (ks * 64 + lane) * 8);
#pragma unroll
        for (int mt = 0; mt < 2; ++mt) {
            const bf16x8 ah = *(const LAS bf16x8*)(lds + ((mt * 32 + ks) * 64 + lane) * 16), al = *(const LAS bf16x8*)(lds + 65536 + ((mt * 32 + ks) * 64 + lane) * 16);
            a[mt][0] = __builtin_amdgcn_mfma_f32_16x16x32_bf16(ah, bh, a[mt][0], 0, 0, 0); a[mt][1] = __builtin_amdgcn_mfma_f32_16x16x32_bf16(ah, bl, a[mt][1], 0, 0, 0); a[mt][2] = __builtin_amdgcn_mfma_f32_16x16x32_bf16(al, bh, a[mt][2], 0, 0, 0);
        }
    }
    o0 = a[0][0] + (a[0][1] + a[0][2]); o1 = a[1][0] + (a[1][1] + a[1][2]);
}
DI void deepnorm_row_c(f32x4 (&v)[4], const f32x4 (&y)[4], const f32x4 (&cg)[4], const f32x4 (&cng)[4], const f32x4 (&cnb)[4]) {
#pragma unroll
    for (int j = 0; j < 4; ++j) v[j] = ALPHA_DN * v[j] + (1.0f + cg[j]) * y[j];
    float s = 0.f;
#pragma unroll
    for (int j = 0; j < 4; ++j) s += (v[j][0] + v[j][1]) + (v[j][2] + v[j][3]);
    const float mean = wave_sum(s) * (1.0f / D_);
    float q = 0.f;
#pragma unroll
    for (int j = 0; j < 4; ++j) { v[j] = v[j] - mean; q += (v[j][0] * v[j][0] + v[j][1] * v[j][1]) + (v[j][2] * v[j][2] + v[j][3] * v[j][3]); }
    const float rstd = 1.0f / sqrtf(wave_sum(q) * (1.0f / D_) + LN_EPS);
#pragma unroll
    for (int j = 0; j < 4; ++j) v[j] = v[j] * rstd * cng[j] + cnb[j];
}
template <bool L0> DI void ln_router_phase(const Frame& F, const Args& A, int layer, bool dry = false) {
    unsigned char* ws = opq(A.ws);
    const float* MOD = (const float*)(ws + WS_MOD); bf16* X = (bf16*)(ws + WS_X); const float* Y = (const float*)(ws + WS_Y); bf16* H = (bf16*)(ws + WS_H);
    int* asg_e = (int*)(ws + WS_ASG_E); int* asg_r = (int*)(ws + WS_ASG_R); int* etok = (int*)(ws + WS_ETOK); float* egate = (float*)(ws + WS_EW);
    unsigned* gcount = (unsigned*)(ws + WS_CTL) + CW_CNT + layer * 64;
    const int ls0 = layer * 2, ls1 = layer * 2 + 1;
    const bf16* wrf = (const bf16*)(ws + WS_WRF) + (size_t)layer * 2 * 65536 + (size_t)(F.wave & 3) * 32 * 512;
    const float rb = A.router_bias[layer * NEXP + F.lane];
    LAS float* lg = (LAS float*)(F.lds + LDS_LG);
    LAS int* lcnt = (LAS int*)(F.lds + LDS_LCNT); LAS int* lbase = (LAS int*)(F.lds + LDS_LBASE); LAS int* lasg = (LAS int*)(F.lds + LDS_LASG);
    const unsigned l8_ = (unsigned)F.lane * 8u, l16_ = (unsigned)F.lane * 16u;
    u32x2 yb[4][4], xb[L0 ? 1 : 4][4]; f32x4 xf[L0 ? 4 : 1][4];
#define LNR_LOAD(rb_) do { unsigned l8 = l8_, l16 = l16_; asm volatile("" : "+v"(l8), "+v"(l16)); \
        _Pragma("unroll") for (int t = 0; t < 4; ++t) { const int row = (rb_) + t; const char* py = pg8::rfl_ptr((const char*)Y + (size_t)row * (D_ * 2)); \
            if constexpr (L0) { const char* px = pg8::rfl_ptr((const char*)A.x + (size_t)row * (D_ * 4)); _Pragma("unroll") for (int j = 0; j < 4; ++j) xf[t][j] = __builtin_nontemporal_load((const f32x4*)(px + l16 + 1024 * j)); } \
            else { const char* px = pg8::rfl_ptr((const char*)X + (size_t)row * (D_ * 2)); _Pragma("unroll") for (int j = 0; j < 4; ++j) xb[t][j] = __builtin_nontemporal_load((const u32x2*)(px + l8 + 512 * j)); } \
            _Pragma("unroll") for (int j = 0; j < 4; ++j) yb[t][j] = __builtin_nontemporal_load((const u32x2*)(py + l8 + 512 * j)); } } while (0)
    for (int blk = F.bid; blk < T_ / 64; blk += F.G) {
        const int b = blk >> 6;
        const char* gate = pg8::rfl_ptr((const char*)(MOD + (size_t)(ls0 * 4 + b) * 3072 + 2048)); const char* modn = pg8::rfl_ptr((const char*)(MOD + (size_t)(ls1 * 4 + b) * 3072));
        const char* lng = pg8::rfl_ptr((const char*)(A.ln_g + (size_t)ls0 * D_)); const char* lnb = pg8::rfl_ptr((const char*)(A.ln_b + (size_t)ls0 * D_));
        f32x4 cg[4], cng[4], cnb[4], csc[4], csh[4];
#pragma unroll
        for (int j = 0; j < 4; ++j) { cg[j] = *(const f32x4*)(gate + l16_ + 1024 * j); cng[j] = *(const f32x4*)(lng + l16_ + 1024 * j); cnb[j] = *(const f32x4*)(lnb + l16_ + 1024 * j);
            csc[j] = *(const f32x4*)(modn + 4096 + l16_ + 1024 * j); csh[j] = *(const f32x4*)(modn + l16_ + 1024 * j); }
        if constexpr (!L0) { LNR_LOAD(blk * 64 + F.wave * 4); }
        __builtin_amdgcn_sched_barrier(0);
#pragma unroll 1
        for (int ps = 0; ps < 2; ++ps) {
            const int rbase = blk * 64 + ps * 32 + F.wave * 4;
            if constexpr (L0) { LNR_LOAD(rbase); }
            { unsigned l8 = l8_; asm volatile("" : "+v"(l8));
#pragma unroll
              for (int t = 0; t < 4; ++t) { const int row = rbase + t; f32x4 v[4], y[4];
#pragma unroll
                for (int j = 0; j < 4; ++j) { y[j] = (f32x4){bf_lo(yb[t][j].x), bf_hi(yb[t][j].x), bf_lo(yb[t][j].y), bf_hi(yb[t][j].y)};
                    if constexpr (L0) v[j] = xf[t][j]; else v[j] = (f32x4){bf_lo(xb[t][j].x), bf_hi(xb[t][j].x), bf_lo(xb[t][j].y), bf_hi(xb[t][j].y)}; }
                deepnorm_row_c(v, y, cg, cng, cnb);
                char* xp = (char*)pg8::rfl_ptr((const char*)(dry ? (const bf16*)(ws + WS_Y + 32 * MiB) : X) + (size_t)row * (D_ * 2));
                char* hp = (char*)pg8::rfl_ptr((const char*)H + (size_t)row * (D_ * 2));
#pragma unroll
                for (int j = 0; j < 4; ++j) { { u32x2 o; o.x = cvtpk(v[j][0], v[j][1]); o.y = cvtpk(v[j][2], v[j][3]); *(u32x2*)(xp + l8 + 512 * j) = o; }
                    v[j] = v[j] * (1.0f + csc[j]) + csh[j]; u32x2 o; o.x = cvtpk(v[j][0], v[j][1]); o.y = cvtpk(v[j][2], v[j][3]); *(u32x2*)(hp + l8 + 512 * j) = o; }
                put_hilo(F.lds, F.wave * 4 + t, F.lane, v); } }
            if constexpr (!L0) { if (ps == 0) { LNR_LOAD(blk * 64 + 32 + F.wave * 4); } }
            __syncthreads();
            { const int nt = F.wave & 3, kh = F.wave >> 2, r = F.lane & 15, q = F.lane >> 4;
              f32x4 acc0, acc1; small_proj2(F.lds, kh, F.lane, wrf, wrf + 65536, acc0, acc1);
              if (kh == 0) {
#pragma unroll
                  for (int reg = 0; reg < 4; ++reg) { lg[(4 * q + reg) * 64 + 16 * nt + r] = acc0[reg]; lg[(16 + 4 * q + reg) * 64 + 16 * nt + r] = acc1[reg]; } }
              __syncthreads();
              if (kh == 1) {
#pragma unroll
                  for (int reg = 0; reg < 4; ++reg) { lg[(4 * q + reg) * 64 + 16 * nt + r] += acc0[reg]; lg[(16 + 4 * q + reg) * 64 + 16 * nt + r] += acc1[reg]; } } }
            __syncthreads();
#pragma unroll 2
            for (int rr = 0; rr < 4; ++rr) {
                const int row = rbase + rr, rl = ps * 32 + F.wave * 4 + rr;
                int ln = F.lane; asm volatile("" : "+v"(ln));
                const float logit = lg[(F.wave * 4 + rr) * 64 + F.lane];
                const float s = 1.0f / (1.0f + __expf(-logit)); const float bi = s + rb;
                float m1 = bi; m1 = fmaxf(m1, dppmov<0xB1>(m1)); m1 = fmaxf(m1, dppmov<0x4E>(m1)); m1 = fmaxf(m1, dppmov<0x141>(m1));
                const unsigned long long eq = __ballot(bi == m1);
                const int first = __ffs((int)((eq >> (ln & ~7)) & 0xffull)) - 1;
                float m2 = ((ln & 7) == first) ? -INFINITY : bi; m2 = fmaxf(m2, dppmov<0xB1>(m2)); m2 = fmaxf(m2, dppmov<0x4E>(m2)); m2 = fmaxf(m2, dppmov<0x141>(m2));
                const float gs = m1 + m2; int grank = 0;
#pragma unroll
                for (int j = 0; j < 8; ++j) { const float gj = rdlane(gs, 8 * j); grank += ((gj > gs) || (gj == gs && j < (ln >> 3))) ? 1 : 0; }
                const bool gsel = grank < 4;
                float mv = gsel ? bi : -INFINITY; int cnt = -1;
#pragma unroll
                for (int it = 0; it < TOPK; ++it) { const float mx = wave_max(mv); const unsigned long long em = __ballot(mv == mx); const int fl = __ffsll((long long)em) - 1;
                    if (ln == fl) { cnt = it; mv = -INFINITY; } }
                const bool sel = cnt >= 0;
                const float gsum = wave_sum(sel ? s : 0.f);
                if (sel) { const int lr = __hip_atomic_fetch_add(&lcnt[F.lane], 1, __ATOMIC_RELAXED, __HIP_MEMORY_SCOPE_WORKGROUP); lasg[rl * 8 + cnt] = (F.lane << 16) | lr;
                    asg_e[(size_t)row * 8 + cnt] = F.lane; ((LAS float*)(F.lds + LDS_LW))[rl * 8 + cnt] = s / gsum * 2.5f; }
            }
        }
        __syncthreads();
        if (F.tid < NEXP) { const int cn = lcnt[F.tid]; lbase[F.tid] = (cn && !dry) ? (int)atomicAdd(&gcount[F.tid], (unsigned)cn) : 0; lcnt[F.tid] = 0; }
        __syncthreads();
        { const int v = lasg[F.tid], e = v >> 16, rank = lbase[e] + (v & 0xffff); asg_r[(size_t)blk * 512 + F.tid] = rank;
          etok[(size_t)e * ECAP + rank] = blk * 64 + (F.tid >> 3); egate[(size_t)e * ECAP + rank] = ((const LAS float*)(F.lds + LDS_LW))[F.tid];
          if (F.tid < 64) { etok[(size_t)NEXP * ECAP + blk * 64 + F.tid] = blk * 64 + F.tid; egate[(size_t)NEXP * ECAP + blk * 64 + F.tid] = 1.0f; } }
        __syncthreads();
    }
#undef LNR_LOAD
}

DI void moe_scatter_phase(const Frame& F, const Args& A, int layer) {
    unsigned char* ws = opq(A.ws);
    const int* asg_e = (const int*)(ws + WS_ASG_E); const int* asg_r = (const int*)(ws + WS_ASG_R); const float* asg_w = (const float*)(ws + WS_ASG_W); int* asg_row = (int*)(ws + WS_ASG_ROW);
    int* rowtok = (int*)(ws + WS_ROWTOK); float* roww = (float*)(ws + WS_ROWW);
    const unsigned* gcount = (const unsigned*)(ws + WS_CTL) + CW_CNT + layer * 64;
    build_tileoff(F, gcount);
    const LAS int* tileoff = (const LAS int*)(F.lds + LDS_TILEOFF);
    for (int idx = F.bid * NTHR + F.tid; idx < T_ * TOPK; idx += F.G * NTHR) {
        const int e = asg_e[idx], row = 256 * tileoff[e] + asg_r[idx];
        rowtok[row] = idx >> 3; roww[row] = asg_w[idx]; asg_row[idx] = row;
    }
    for (int e = F.bid; e < NEXP; e += F.G) {
        const int cnt = (int)__hip_atomic_load(gcount + e, __ATOMIC_RELAXED, __HIP_MEMORY_SCOPE_AGENT), end = 256 * tileoff[e + 1];
        for (int row = 256 * tileoff[e] + cnt + F.tid; row < end; row += NTHR) { rowtok[row] = T_; roww[row] = 0.f; }
    }
    const int s0 = 256 * tileoff[64];
    for (int t = F.bid * NTHR + F.tid; t < T_; t += F.G * NTHR) { rowtok[s0 + t] = t; roww[s0 + t] = 1.0f; }
}

DI void ln_moe_phase(const Frame& F, const Args& A, int layer, float* dry_out) {
    unsigned char* ws = opq(A.ws);
    const float* MOD = (const float*)(ws + WS_MOD); const char* YE = (const char*)(ws + WS_BIG);
    float* AB = (float*)(ws + WS_AB);
    int s0 = 0;
    { const unsigned* gcount = (const unsigned*)(ws + WS_CTL) + CW_CNT + layer * 64; build_tileoff(F, gcount); s0 = 256 * ((const LAS int*)(F.lds + LDS_TILEOFF))[64]; }
    const int* asg_e = (const int*)(ws + WS_ASG_E); const int* asg_r = (const int*)(ws + WS_ASG_R);
    const int ls0 = layer * 2 + 1, ls1 = layer * 2 + 2; const bool last = layer == 3, want_ab = (layer & 1) == 0;
    const bf16* wabf = (const bf16*)(ws + WS_WABF) + (size_t)(layer >> 1) * 2 * 16384;
    const unsigned l4_ = (unsigned)F.lane * 4u, l8_ = (unsigned)F.lane * 8u, l16_ = (unsigned)F.lane * 16u;
    for (int blk = F.bid; blk < T_ / 64; blk += F.G) {
        const int b = blk >> 6;
        const char* gate = pg8::rfl_ptr((const char*)(MOD + (size_t)(ls0 * 4 + b) * 3072 + 2048)); const char* modn = pg8::rfl_ptr((const char*)(MOD + (size_t)((last ? ls0 : ls1) * 4 + b) * 3072));
        const char* lng = pg8::rfl_ptr((const char*)(A.ln_g + (size_t)ls0 * D_)); const char* lnb = pg8::rfl_ptr((const char*)(A.ln_b + (size_t)ls0 * D_));
        f32x4 cg[4], cng[4], cnb[4], csc[4], csh[4];
#pragma unroll
        for (int j = 0; j < 4; ++j) { cg[j] = *(const f32x4*)(gate + l16_ + 1024 * j); cng[j] = *(const f32x4*)(lng + l16_ + 1024 * j); cnb[j] = *(const f32x4*)(lnb + l16_ + 1024 * j);
            csc[j] = *(const f32x4*)(modn + 4096 + l16_ + 1024 * j); csh[j] = *(const f32x4*)(modn + l16_ + 1024 * j); }
#pragma unroll 1
        for (int ps = 0; ps < 2; ++ps) {
            const int rbase = blk * 64 + ps * 32 + F.wave * 4;
            const int ev = *(const int*)(pg8::rfl_ptr((const char*)(asg_e + (size_t)rbase * 8)) + (l4_ & 127u)), rv = *(const int*)(pg8::rfl_ptr((const char*)(asg_r + (size_t)rbase * 8)) + (l4_ & 127u));
            const int idxv = 256 * ((const LAS int*)(F.lds + LDS_TILEOFF))[ev] + rv;
#pragma unroll 1
            for (int rr = 0; rr < 4; ++rr) {
                const int row = rbase + rr; f32x4 v[4], y[4]; int w[9][4]; u32x2 sh[4];
                unsigned l4 = l4_, l8 = l8_, l16 = l16_; asm volatile("" : "+v"(l4), "+v"(l8), "+v"(l16));
#pragma unroll
                for (int k = 0; k < TOPK; ++k) { const int src = __builtin_amdgcn_readlane(idxv, rr * 8 + k); const char* p = pg8::rfl_ptr(YE + (size_t)src * D_);
#pragma unroll
                    for (int j = 0; j < 4; ++j) w[k][j] = __builtin_nontemporal_load((const int*)(p + l4 + 256 * j)); }
                if (YS_BF16) { const char* p = pg8::rfl_ptr(YE + WS_YS_OFF + (size_t)row * (D_ * 2));
#pragma unroll
                    for (int j = 0; j < 4; ++j) sh[j] = __builtin_nontemporal_load((const u32x2*)(p + l8 + 512 * j));
                } else { const char* p = pg8::rfl_ptr(YE + (size_t)(s0 + row) * D_);
#pragma unroll
                    for (int j = 0; j < 4; ++j) w[8][j] = *(const int*)(p + l4 + 256 * j);
                }
                u32x2 xb[4];
                { const char* p = pg8::rfl_ptr((const char*)(ws + WS_X) + (size_t)row * (D_ * 2));
#pragma unroll
                  for (int j = 0; j < 4; ++j) xb[j] = __builtin_nontemporal_load((const u32x2*)(p + l8 + 512 * j)); }
                __builtin_amdgcn_sched_barrier(0);
#pragma unroll
                for (int j = 0; j < 4; ++j) { y[j] = (f32x4){0.f, 0.f, 0.f, 0.f}; v[j] = (f32x4){bf_lo(xb[j].x), bf_hi(xb[j].x), bf_lo(xb[j].y), bf_hi(xb[j].y)}; }
#pragma unroll
                for (int k = 0; k < (YS_BF16 ? TOPK : TOPK + 1); ++k) {
                    asm volatile("" : "+v"(w[k][0]), "+v"(w[k][1]), "+v"(w[k][2]), "+v"(w[k][3]), "+v"(y[0]), "+v"(y[1]), "+v"(y[2]), "+v"(y[3]));
#pragma unroll
                    for (int j = 0; j < 4; ++j) { const f32x2 a = __builtin_amdgcn_cvt_pk_f32_fp8(w[k][j], false), c = __builtin_amdgcn_cvt_pk_f32_fp8(w[k][j], true);
                        y[j][0] += a[0]; y[j][1] += a[1]; y[j][2] += c[0]; y[j][3] += c[1]; }
                    __builtin_amdgcn_sched_barrier(0);
                }
#pragma unroll
                for (int j = 0; j < 4; ++j) y[j] = y[j] * (1.0f / YE_SCALE);
                if (YS_BF16) {
#pragma unroll
                    for (int j = 0; j < 4; ++j) { y[j][0] += bf_lo(sh[j].x); y[j][1] += bf_hi(sh[j].x); y[j][2] += bf_lo(sh[j].y); y[j][3] += bf_hi(sh[j].y); }
                }
                deepnorm_row_c(v, y, cg, cng, cnb);
                if (last || dry_out) { char* op = (char*)pg8::rfl_ptr((const char*)(dry_out ? dry_out : A.out) + (size_t)row * (D_ * 4));
#pragma unroll
                    for (int j = 0; j < 4; ++j) *(f32x4*)(op + l16 + 1024 * j) = v[j];
                } else { char* xp = (char*)pg8::rfl_ptr((const char*)(ws + WS_X) + (size_t)row * (D_ * 2));
#pragma unroll
                    for (int j = 0; j < 4; ++j) { u32x2 o; o.x = cvtpk(v[j][0], v[j][1]); o.y = cvtpk(v[j][2], v[j][3]); *(u32x2*)(xp + l8 + 512 * j) = o; } }
                if (!last) { char* hp = (char*)pg8::rfl_ptr((const char*)(ws + WS_H) + (size_t)row * (D_ * 2));
#pragma unroll
                    for (int j = 0; j < 4; ++j) { v[j] = v[j] * (1.0f + csc[j]) + csh[j]; u32x2 o; o.x = cvtpk(v[j][0], v[j][1]); o.y = cvtpk(v[j][2], v[j][3]); *(u32x2*)(hp + l8 + 512 * j) = o; }
                    if (want_ab) put_hilo(F.lds, F.wave * 4 + rr, F.lane, v);
                }
            }
            if (!last && want_ab) {
                __syncthreads();
                if (F.wave < 2) { const int mt = F.wave, r = F.lane & 15, q = F.lane >> 4;
                    const f32x4 acc = small_proj(F.lds, mt, F.lane, wabf, wabf + 16384);
#pragma unroll
                    for (int reg = 0; reg < 4; ++reg) AB[(size_t)(blk * 64 + ps * 32 + 16 * mt + 4 * q + reg) * 16 + r] = acc[reg]; }
                __syncthreads();
            }
        }
    }
}
DI int crow(int r, int h) { return (r & 3) + 8 * (r >> 2) + 4 * h; }
typedef short v4i16_t __attribute__((ext_vector_type(4)));
DI s16x4 vtr(const LAS unsigned char* p) { return __builtin_bit_cast(s16x4, __builtin_amdgcn_ds_read_tr16_b64_v4i16((LAS v4i16_t*)p)); }
#define MFMA32(a, b, c) __builtin_amdgcn_mfma_f32_32x32x16_bf16((a), (b), (c), 0, 0, 0)
constexpr int ATT_ORUN = 0, ATT_LRUN = 65536, ATT_VBUF = 65536 + 2048, ATT_VSTRIDE = 144, ATT_VBYTES = 32 * ATT_VSTRIDE;

#ifndef REP_A1
#define REP_A1 1
#define REP_A2 1
#endif
DI void attn_phase(const Frame& F, const Args& A) {
    unsigned char* ws = opq(A.ws);
    const bf16* QKV = (const bf16*)(ws + WS_BIG); bf16* O = (bf16*)(ws + WS_O);
    LAS unsigned char* orun = F.lds + ATT_ORUN;
    LAS float* lrun = (LAS float*)(F.lds + ATT_LRUN);
    LAS unsigned char* vbuf = F.lds + ATT_VBUF + F.wave * ATT_VBYTES;
    const int lane = F.lane, qi = lane & 31, h = lane >> 5;
    const int g16 = lane >> 4, q4 = (lane & 15) >> 2, p4 = lane & 3;
    for (int it = F.bid; it < NB_ * 16 * 8; it += F.G) {
        int item = it;
        if (F.G == 256) { const int w = it & 255, xcd = w & 7, j = w >> 3; item = (((it >> 8) * 32 + xcd * 4 + (j >> 3)) << 3) | (j & 7); }
        const int b = item >> 7, head = (item >> 3) & 15, ck = item & 7;
        for (int gi = 0; gi < 3; ++gi) {
            const int g = 2 - gi, ldil = 2 * g, Lg = S_ >> ldil;
            const size_t hb = (((size_t)g * NB_ + b) * 16 + head) * S_ * 64;
            const bf16* Qg = QKV + hb; const bf16* Kg = QKV + (size_t)3 * NB_ * 16 * S_ * 64 + hb; const bf16* Vg = QKV + (size_t)6 * NB_ * 16 * S_ * 64 + hb;
            for (int sub = F.wave; sub < 16; sub += NWAVES) {
                int r_, tile;
                if (g == 0) { r_ = 0; tile = sub; } else if (g == 1) { r_ = sub >> 2; tile = sub & 3; } else { r_ = sub; tile = 0; }
                const int m0 = ((512 * ck) >> ldil) + 32 * tile;
                const bf16* Kr = Kg + (size_t)r_ * Lg * 64; const bf16* Vr = Vg + (size_t)r_ * Lg * 64;
                f32x16 st[5]; u32x4 vv[5][4]; float mx, lsum;
#pragma unroll 1
                for (int rep1 = 0; rep1 < REP_A1; ++rep1) {
                unsigned lc = (unsigned)((lane >> 3) * 128 + (lane & 7) * 16); asm volatile("" : "+v"(lc));
                const int wofs = (lane >> 3) * ATT_VSTRIDE + (lane & 7) * 16, rofs = qi * ATT_VSTRIDE + 64 * h;
                u32x4 qv[4], kv[5][4];
                { const char* qp = pg8::rfl_ptr((const char*)(Qg + ((size_t)r_ * Lg + m0) * 64));
#pragma unroll
                  for (int i = 0; i < 4; ++i) qv[i] = __builtin_nontemporal_load((const u32x4*)(qp + lc + 1024 * i)); }
#pragma unroll
                for (int kt = 0; kt < 5; ++kt) { const int mk0 = m0 - 128 + 32 * kt; const char* kp = pg8::rfl_ptr((const char*)(Kr + (size_t)(mk0 < 0 ? 0 : mk0) * 64));
#pragma unroll
                    for (int i = 0; i < 4; ++i) kv[kt][i] = *(const u32x4*)(kp + lc + 1024 * i); }
                __builtin_amdgcn_sched_barrier(0);
                bf16x8 qf[4];
#pragma unroll
                for (int i = 0; i < 4; ++i) *(LAS u32x4*)(vbuf + wofs + 8 * i * ATT_VSTRIDE) = qv[i];
                LDS_WAIT(); asm volatile("" ::: "memory");
#pragma unroll
                for (int s = 0; s < 4; ++s) qf[s] = *(const LAS bf16x8*)(vbuf + rofs + 16 * s);
                LDS_WAIT(); asm volatile("" ::: "memory");
#pragma unroll
                for (int kt = 0; kt < 5; ++kt) {
                    const int mk0 = m0 - 128 + 32 * kt;
                    bf16x8 kf[4];
#pragma unroll
                    for (int i = 0; i < 4; ++i) *(LAS u32x4*)(vbuf + wofs + 8 * i * ATT_VSTRIDE) = kv[kt][i];
                    LDS_WAIT(); asm volatile("" ::: "memory");
#pragma unroll
                    for (int s = 0; s < 4; ++s) kf[s] = *(const LAS bf16x8*)(vbuf + rofs + 16 * s);
                    { const char* vp = pg8::rfl_ptr((const char*)(Vr + (size_t)(mk0 < 0 ? 0 : mk0) * 64));
#pragma unroll
                      for (int i = 0; i < 4; ++i) vv[kt][i] = *(const u32x4*)(vp + lc + 1024 * i); }
                    LDS_WAIT(); asm volatile("" ::: "memory");
#pragma unroll
                    for (int r = 0; r < 16; ++r) st[kt][r] = 0.f;
#pragma unroll
                    for (int s = 0; s < 4; ++s) st[kt] = MFMA32(kf[s], qf[s], st[kt]);
                    if (mk0 < 0) {
#pragma unroll
                        for (int r = 0; r < 16; ++r) st[kt][r] = -INFINITY;
                    }
                }
#pragma unroll
                for (int r = 0; r < 16; ++r) { const int kr = crow(r, h); if (kr < qi) st[0][r] = -INFINITY; if (kr > qi) st[4][r] = -INFINITY; }
                mx = -INFINITY;
#pragma unroll
                for (int kt = 0; kt < 5; ++kt)
#pragma unroll
                    for (int r = 0; r < 16; ++r) mx = fmaxf(mx, st[kt][r]);
                mx = fmaxf(mx, bperm(mx, F.lane ^ 32));
                lsum = 0.f;
#pragma unroll
                for (int kt = 0; kt < 5; ++kt)
#pragma unroll
                    for (int r = 0; r < 16; ++r) { const float p = __builtin_amdgcn_exp2f(st[kt][r] - mx); st[kt][r] = p; lsum += p; }
                lsum += bperm(lsum, F.lane ^ 32);
                }
                f32x16 oacc[2];
#pragma unroll 1
                for (int rep2 = 0; rep2 < REP_A2; ++rep2) {
#pragma unroll
                for (int r = 0; r < 16; ++r) { oacc[0][r] = 0.f; oacc[1][r] = 0.f; }
#pragma unroll
                for (int kt = 0; kt < 5; ++kt) {
                    const int mk0 = m0 - 128 + 32 * kt;
                    if (mk0 >= 0) {
#pragma unroll
                        for (int i = 0; i < 4; ++i) *(LAS u32x4*)(vbuf + ((lane >> 3) + 8 * i) * ATT_VSTRIDE + (lane & 7) * 16) = vv[kt][i];
                        LDS_WAIT(); asm volatile("" ::: "memory");
                        s16x4 flo[2][2], fhi[2][2];
#pragma unroll
                        for (int sp = 0; sp < 2; ++sp)
#pragma unroll
                            for (int dvt = 0; dvt < 2; ++dvt) {
                                const int colb = (32 * dvt + 16 * (g16 & 1) + 4 * p4) * 2;
                                flo[sp][dvt] = vtr(vbuf + (16 * sp + 4 * h + q4) * ATT_VSTRIDE + colb);
                                fhi[sp][dvt] = vtr(vbuf + (16 * sp + 8 + 4 * h + q4) * ATT_VSTRIDE + colb);
                            }
                        LDS_WAIT(); asm volatile("" ::: "memory");
#pragma unroll
                        for (int sp = 0; sp < 2; ++sp) {
                            bf16x8 pf; {
                                const unsigned w0 = cvtpk(st[kt][8 * sp + 0], st[kt][8 * sp + 1]), w1 = cvtpk(st[kt][8 * sp + 2], st[kt][8 * sp + 3]);
                                const unsigned w2 = cvtpk(st[kt][8 * sp + 4], st[kt][8 * sp + 5]), w3 = cvtpk(st[kt][8 * sp + 6], st[kt][8 * sp + 7]);
                                pf = __builtin_bit_cast(bf16x8, (u32x4){w0, w1, w2, w3}); }
#pragma unroll
                            for (int dvt = 0; dvt < 2; ++dvt) {
                                const bf16x8 vf = __builtin_shufflevector(flo[sp][dvt], fhi[sp][dvt], 0, 1, 2, 3, 4, 5, 6, 7);
                                oacc[dvt] = MFMA32(vf, pf, oacc[dvt]);
                            }
                        }
                    }
                }
                asm volatile("" : "+v"(oacc[0]), "+v"(oacc[1]));
                }
                const float inv = __builtin_amdgcn_rcpf(lsum), lse = mx + __builtin_amdgcn_logf(lsum);
                const int tl = ((32 * tile + qi) << ldil) + r_;
                float wa = 0.f, wb = 1.f;
                if (gi > 0) { const float L0 = lrun[tl]; const float M = fmaxf(L0, lse); const float ea = __builtin_amdgcn_exp2f(L0 - M), eb = __builtin_amdgcn_exp2f(lse - M);
                    const float isum = __builtin_amdgcn_rcpf(ea + eb); wa = ea * isum; wb = eb * isum; asm volatile("" ::: "memory");
                    if (h == 0) lrun[tl] = M + __builtin_amdgcn_logf(ea + eb); }
                else if (h == 0) lrun[tl] = lse;
                wb *= inv;
#pragma unroll
                for (int dvt = 0; dvt < 2; ++dvt)
#pragma unroll
                    for (int k4 = 0; k4 < 4; ++k4) {
                        const int dv = 32 * dvt + 8 * k4 + 4 * h;
                        float o0 = oacc[dvt][4 * k4 + 0] * wb, o1 = oacc[dvt][4 * k4 + 1] * wb, o2 = oacc[dvt][4 * k4 + 2] * wb, o3 = oacc[dvt][4 * k4 + 3] * wb;
                        LAS u32x2* op = (LAS u32x2*)(orun + tl * 128 + dv * 2);
                        if (gi > 0) { const u32x2 w = *op; o0 += wa * bf_lo(w.x); o1 += wa * bf_hi(w.x); o2 += wa * bf_lo(w.y); o3 += wa * bf_hi(w.y); }
                        u32x2 wo; wo.x = cvtpk(o0, o1); wo.y = cvtpk(o2, o3);
                        if (gi < 2) *op = wo;
                        else *(u32x2*)(O + ((size_t)b * S_ + 512 * ck + tl) * D_ + head * 64 + dv) = wo;
                    }
            }
            __syncthreads();
        }
    }
}

DI void gdn_post_phase(const Frame& F, const Args& A, int j) {
    unsigned char* ws = opq(A.ws); unsigned char* big = ws + WS_BIG;
    const bf16* Oraw = (const bf16*)(ws + WS_Y); const bf16* PROJ = (const bf16*)(big + BIG_PROJ); bf16* O = (bf16*)(ws + WS_O);
    const float* nw = A.gdn_norm_w + (size_t)j * 128;
    const int gw = F.bid * NWAVES + F.wave, NGW = F.G * NWAVES, lane = F.lane;
    const f32x4 nwv = *(const f32x4*)(nw + ((4 * lane) & 127));
    const unsigned l8_ = (unsigned)lane * 8u;
#pragma unroll 2
    for (int row = gw; row < T_; row += NGW) {
        unsigned l8 = l8_; asm volatile("" : "+v"(l8));
        const char* op = pg8::rfl_ptr((const char*)(Oraw + (size_t)row * D_)); const char* zp = pg8::rfl_ptr((const char*)(PROJ + (size_t)row * 4096 + 3072));
        u32x2 ow[4], zw[4];
#pragma unroll
        for (int jj = 0; jj < 4; ++jj) { ow[jj] = __builtin_nontemporal_load((const u32x2*)(op + l8 + 512 * jj)); zw[jj] = __builtin_nontemporal_load((const u32x2*)(zp + l8 + 512 * jj)); }
        f32x4 v[4];
#pragma unroll
        for (int jj = 0; jj < 4; ++jj) {
            v[jj] = (f32x4){bf_lo(ow[jj].x), bf_hi(ow[jj].x), bf_lo(ow[jj].y), bf_hi(ow[jj].y)};
            float ss = (v[jj][0] * v[jj][0] + v[jj][1] * v[jj][1]) + (v[jj][2] * v[jj][2] + v[jj][3] * v[jj][3]);
            ss += dppmov<0xB1>(ss); ss += dppmov<0x4E>(ss); ss += dppmov<0x141>(ss); ss += dppmov<0x140>(ss); ss += shx<16>(ss);
            const float rs = rsqrtf(ss * (1.0f / 128.0f) + RMS_EPS);
            const float z0 = bf_lo(zw[jj].x), z1 = bf_hi(zw[jj].x), z2 = bf_lo(zw[jj].y), z3 = bf_hi(zw[jj].y);
            v[jj][0] = v[jj][0] * rs * nwv[0] * silu_f(z0); v[jj][1] = v[jj][1] * rs * nwv[1] * silu_f(z1);
            v[jj][2] = v[jj][2] * rs * nwv[2] * silu_f(z2); v[jj][3] = v[jj][3] * rs * nwv[3] * silu_f(z3);
        }
        store_row16_bf16(O + (size_t)row * D_, lane, v);
    }
}
constexpr size_t GB_KR = 128 * MiB, GB_QR = 160 * MiB, GB_KT = 192 * MiB, GB_VT = 224 * MiB, GB_BLOB = 256 * MiB;
constexpr int BLOB_ELEMS = 28672, BLOB_W = 0, BLOB_QG = 8192, BLOB_QK = 16384, BLOB_KDT = 20480;
DI int frag_pos(int row, int k, int nks) { const int kk = k & 31; return ((((row >> 4) * nks + (k >> 5)) * 64 + ((kk >> 2) & 3) * 16 + (row & 15)) * 8) + 4 * (kk >> 4) + (kk & 3); }
#define MFMA16(a, b, c) __builtin_amdgcn_mfma_f32_16x16x32_bf16((a), (b), (c), 0, 0, 0)
DI u32x2 pk4(float a, float b, float c, float d) { u32x2 w; w.x = cvtpk(a, b); w.y = cvtpk(c, d); return w; }

DI int tile_off(int t, int c) { return t * 256 + ((((c >> 4) ^ (t & 7)) << 5) | ((c & 15) << 1)); }
template <int WH> DI void prep_conv_pass(const bf16* PROJ, const float* cw, int b, int hh, int t0, int lane, LAS unsigned char* tile, bf16* rowdst, const LAS float* escale, bool normalize, float nscale) {
    float w[4][2];
#pragma unroll
    for (int jj = 0; jj < 4; ++jj) { const f32x2 t = *(const f32x2*)(cw + (size_t)jj * 3072 + WH * 1024 + hh * 128 + 2 * lane); w[jj][0] = t.x; w[jj][1] = t.y; }
    float A0[35], A1[35];
#pragma unroll
    for (int jj = 0; jj < 3; ++jj) { const int t = t0 - 3 + jj; unsigned u = 0u;
        if (t >= 0) u = *(const unsigned*)(PROJ + ((size_t)b * S_ + t) * 4096 + WH * 1024 + hh * 128 + 2 * lane);
        A0[jj] = bf_lo(u); A1[jj] = bf_hi(u); }
#pragma unroll 1
    for (int hb = 0; hb < 2; ++hb) {
        { unsigned xin[32];
#pragma unroll
          for (int i = 0; i < 32; ++i) xin[i] = __builtin_nontemporal_load((const unsigned*)(PROJ + ((size_t)b * S_ + t0 + 32 * hb + i) * 4096 + WH * 1024 + hh * 128 + 2 * lane));
#pragma unroll
          for (int i = 0; i < 32; ++i) { A0[3 + i] = bf_lo(xin[i]); A1[3 + i] = bf_hi(xin[i]); } }
#pragma unroll
        for (int i = 0; i < 32; ++i) {
            A0[i] = w[0][0] * A0[i] + w[1][0] * A0[i + 1] + w[2][0] * A0[i + 2] + w[3][0] * A0[i + 3];
            A1[i] = w[0][1] * A1[i] + w[1][1] * A1[i + 1] + w[2][1] * A1[i + 2] + w[3][1] * A1[i + 3]; }
#pragma unroll
        for (int i = 0; i < 32; ++i) { A0[i] = silu_f(A0[i]); A1[i] = silu_f(A1[i]); }
        if (normalize) {
            float rs[32];
#pragma unroll
            for (int i = 0; i < 32; ++i) rs[i] = wave_sum(A0[i] * A0[i] + A1[i] * A1[i]);
#pragma unroll
            for (int i = 0; i < 32; ++i) { const float r = rsqrtf(rs[i] + RMS_EPS) * nscale; A0[i] *= r; A1[i] *= r; }
        }
#pragma unroll
        for (int i = 0; i < 32; ++i) {
            const int tt = 32 * hb + i;
            if (rowdst) *(unsigned*)(rowdst + (size_t)tt * 128 + 2 * lane) = cvtpk(A0[i], A1[i]);
            const float es = escale ? escale[tt] : 1.0f;
            *(LAS unsigned*)(tile + tile_off(tt, 2 * lane)) = cvtpk(A0[i] * es, A1[i] * es);
        }
#pragma unroll
        for (int jj = 0; jj < 3; ++jj) { A0[jj] = A0[32 + jj]; A1[jj] = A1[32 + jj]; }
    }
    LDS_WAIT(); asm volatile("" ::: "memory");
}
DI void tile_tr8(const LAS unsigned char* tile, int tb, int tb2, int cb, int lane, s16x4& lo, s16x4& hi) {
    const int q4 = (lane & 15) >> 2, p4 = lane & 3;
    lo = vtr(tile + tile_off(tb + q4, cb + 4 * p4)); hi = vtr(tile + tile_off(tb2 + q4, cb + 4 * p4));
}
DI void gdn_prep2_phase(const Frame& F, const Args& A, int j) {
    unsigned char* ws = opq(A.ws); unsigned char* big = ws + WS_BIG;
    const bf16* PROJ = (const bf16*)(big + BIG_PROJ);
    bf16* KR = (bf16*)(big + GB_KR); bf16* QR = (bf16*)(big + GB_QR); bf16* KT = (bf16*)(big + GB_KT); bf16* VT = (bf16*)(big + GB_VT); bf16* BLOB = (bf16*)(big + GB_BLOB);
    const float* AB = (const float*)(ws + WS_AB); float* GC = (float*)(ws + WS_GALPHA); float* GB = (float*)(ws + WS_GBETA);
    const float* cw = A.gdn_conv_w + (size_t)j * 4 * 3072;
    const int gw = F.bid * NWAVES + F.wave, NGW = F.G * NWAVES, lane = F.lane, g16 = lane >> 4, i16 = lane & 15;
    LAS unsigned char* tile = F.lds + F.wave * 16384;
    LAS float* egl = (LAS float*)(F.lds + LDS_LG + F.wave * 512); LAS float* ekl = egl + 64;
    for (int it = gw; it < NB_ * 8 * 64; it += NGW) {
        const int b = it >> 9, hh = (it >> 6) & 7, n = it & 63, t0 = 64 * n, bh = b * 8 + hh;
        { const int row = b * S_ + t0 + lane; const float a = AB[(size_t)row * 16 + hh], bl = AB[(size_t)row * 16 + 8 + hh];
          const float xs = a + A.gdn_dt_bias[j * 8 + hh]; const float ey = __expf(xs); const float sp = xs > 20.f ? xs : (ey < 1e-3f ? ey * (1.0f - 0.5f * ey) : __logf(1.0f + ey));
          float gc = -__expf(A.gdn_a_log[j * 8 + hh]) * sp;
#pragma unroll
          for (int o = 1; o < 64; o <<= 1) { const float t = bperm(gc, lane - o); if (lane >= o) gc += t; }
          const float gl = rdlane(gc, 63);
          GC[(size_t)bh * S_ + t0 + lane] = gc; GB[(size_t)bh * S_ + t0 + lane] = 1.0f / (1.0f + __expf(-bl));
          egl[lane] = __expf(gc); ekl[lane] = __expf(gl - gc); }
        LDS_WAIT(); asm volatile("" ::: "memory");
        bf16* blob = BLOB + (size_t)it * BLOB_ELEMS;
        bf16* ktc = KT + (size_t)it * 8192; bf16* vtc = VT + (size_t)it * 8192;
        const size_t rbase = ((size_t)bh * S_ + t0) * 128;
        prep_conv_pass<1>(PROJ, cw, b, hh, t0, lane, tile, KR + rbase, nullptr, true, 1.0f);
#pragma unroll 2
        for (int db = 0; db < 8; ++db)
#pragma unroll
            for (int half = 0; half < 2; ++half) { s16x4 lo, hi; const int tb = 32 * half + 8 * g16; tile_tr8(tile, tb, tb + 4, 16 * db, lane, lo, hi);
                *(bf16x8*)(ktc + (16 * db + i16) * 64 + tb) = __builtin_shufflevector(lo, hi, 0, 1, 2, 3, 4, 5, 6, 7); }
#pragma unroll 2
        for (int a = 0; a < 8; ++a)
#pragma unroll
            for (int ks = 0; ks < 2; ++ks) { s16x4 lo, hi; const int tb = 32 * ks + 4 * g16; tile_tr8(tile, tb, tb + 16, 16 * a, lane, lo, hi);
                const f32x4 e0 = *(const LAS f32x4*)(ekl + tb), e1 = *(const LAS f32x4*)(ekl + tb + 16);
                u32x4 wv;
                wv.x = cvtpk(bf_lo((unsigned)(unsigned short)lo[0]) * e0[0], bf_lo((unsigned)(unsigned short)lo[1]) * e0[1]); wv.y = cvtpk(bf_lo((unsigned)(unsigned short)lo[2]) * e0[2], bf_lo((unsigned)(unsigned short)lo[3]) * e0[3]);
                wv.z = cvtpk(bf_lo((unsigned)(unsigned short)hi[0]) * e1[0], bf_lo((unsigned)(unsigned short)hi[1]) * e1[1]); wv.w = cvtpk(bf_lo((unsigned)(unsigned short)hi[2]) * e1[2], bf_lo((unsigned)(unsigned short)hi[3]) * e1[3]);
                *(u32x4*)(blob + BLOB_KDT + ((a * 2 + ks) * 64 + lane) * 8) = wv; }
        LDS_WAIT(); asm volatile("" ::: "memory");
        prep_conv_pass<2>(PROJ, cw, b, hh, t0, lane, tile, nullptr, nullptr, false, 1.0f);
#pragma unroll 2
        for (int db = 0; db < 8; ++db)
#pragma unroll
            for (int half = 0; half < 2; ++half) { s16x4 lo, hi; const int tb = 32 * half + 8 * g16; tile_tr8(tile, tb, tb + 4, 16 * db, lane, lo, hi);
                *(bf16x8*)(vtc + (16 * db + i16) * 64 + tb) = __builtin_shufflevector(lo, hi, 0, 1, 2, 3, 4, 5, 6, 7); }
        LDS_WAIT(); asm volatile("" ::: "memory");
        prep_conv_pass<0>(PROJ, cw, b, hh, t0, lane, tile, QR + rbase, egl, true, 0.08838834764831845f);
#pragma unroll 2
        for (int tm = 0; tm < 4; ++tm)
#pragma unroll
            for (int ks = 0; ks < 4; ++ks) {
                const u32x2 p0 = *(const LAS u32x2*)(tile + tile_off(16 * tm + i16, 32 * ks + 4 * g16)), p1 = *(const LAS u32x2*)(tile + tile_off(16 * tm + i16, 32 * ks + 16 + 4 * g16));
                *(u32x4*)(blob + BLOB_QG + ((tm * 4 + ks) * 64 + lane) * 8) = (u32x4){p0.x, p0.y, p1.x, p1.y}; }
        LDS_WAIT(); asm volatile("" ::: "memory");
    }
}

DI void gdn_wy_phase(const Frame& F, const Args& A) {
    unsigned char* ws = opq(A.ws); unsigned char* big = ws + WS_BIG;
    const bf16* KR = (const bf16*)(big + GB_KR); const bf16* QR = (const bf16*)(big + GB_QR); const bf16* KT = (const bf16*)(big + GB_KT); const bf16* VT = (const bf16*)(big + GB_VT);
    bf16* BLOB = (bf16*)(big + GB_BLOB); float* U = (float*)(ws + WS_HID);
    const float* GC = (const float*)(ws + WS_GALPHA); const float* GB = (const float*)(ws + WS_GBETA);
    const int gw = F.bid * NWAVES + F.wave, NGW = F.G * NWAVES, lane = F.lane, r = lane & 15, q = lane >> 4;
    LAS float* Af = (LAS float*)(F.lds + F.wave * 16384);
    asm volatile("s_waitcnt vmcnt(0)" ::: "memory"); __builtin_amdgcn_fence(__ATOMIC_ACQUIRE, "agent");
    for (int it = gw; it < NB_ * 8 * 64; it += NGW) {
        const int bh = it >> 6, n = it & 63;
        const char* kr = pg8::rfl_ptr((const char*)(KR + ((size_t)bh * S_ + 64 * n) * 128)); const char* qr = pg8::rfl_ptr((const char*)(QR + ((size_t)bh * S_ + 64 * n) * 128));
        const char* kt = pg8::rfl_ptr((const char*)(KT + (size_t)it * 8192)); const char* vt = pg8::rfl_ptr((const char*)(VT + (size_t)it * 8192));
        char* blob = (char*)pg8::rfl_ptr((const char*)(BLOB + (size_t)it * BLOB_ELEMS)); char* ub = (char*)pg8::rfl_ptr((const char*)(U + (size_t)it * 8192));
        const unsigned lrow = (unsigned)(r * 128 + 8 * q) * 2u, ltr = (unsigned)(r * 64 + 8 * q) * 2u, lfrag = (unsigned)(q * 16 + r) * 16u;
        const float gcl = GC[(size_t)bh * S_ + 64 * n + lane], bel = GB[(size_t)bh * S_ + 64 * n + lane];
        __builtin_amdgcn_wave_barrier();
        bf16x8 kfr[4][4], qfr[4][4];
#pragma unroll
        for (int t4 = 0; t4 < 4; ++t4)
#pragma unroll
            for (int ks = 0; ks < 4; ++ks) { kfr[t4][ks] = *(const bf16x8*)(kr + lrow + (16 * t4 * 128 + 32 * ks) * 2); qfr[t4][ks] = *(const bf16x8*)(qr + lrow + (16 * t4 * 128 + 32 * ks) * 2); }
#pragma unroll
        for (int ti = 0; ti < 4; ++ti) {
            const float gi = bperm(gcl, 16 * ti + r), bi = bperm(bel, 16 * ti + r);
#pragma unroll
            for (int tj = 0; tj < 4; ++tj) {
                char* qkdst = blob + (BLOB_QK + ((ti * 2 + (tj >> 1)) * 64) * 8 + 4 * (tj & 1)) * 2 + lfrag;
                if (tj > ti) { *(u32x2*)qkdst = (u32x2){0u, 0u}; *(LAS f32x4*)(Af + (16 * ti + r) * 64 + 16 * tj + 4 * q) = (f32x4){0.f, 0.f, 0.f, 0.f}; continue; }
                f32x4 p1 = (f32x4){0.f, 0.f, 0.f, 0.f}, p2 = p1;
#pragma unroll
                for (int ks = 0; ks < 4; ++ks) { p1 = MFMA16(kfr[tj][ks], kfr[ti][ks], p1); p2 = MFMA16(kfr[tj][ks], qfr[ti][ks], p2); }
                const int i = 16 * ti + r; f32x4 av, qv;
#pragma unroll
                for (int reg = 0; reg < 4; ++reg) { const int jx = 16 * tj + 4 * q + reg; const float gj = bperm(gcl, jx);
                    const float dec = (jx <= i) ? __expf(gi - gj) : 0.f;
                    av[reg] = (jx < i) ? bi * p1[reg] * dec : 0.f; qv[reg] = p2[reg] * dec; }
                *(LAS f32x4*)(Af + i * 64 + 16 * tj + 4 * q) = av;
                *(u32x2*)qkdst = pk4(qv[0], qv[1], qv[2], qv[3]);
                asm volatile("" ::: "memory");
            }
        }
        LDS_WAIT(); asm volatile("" ::: "memory");
#pragma unroll 1
        for (int i0 = 0; i0 < 64; i0 += 4) {
            float a0 = (i0 + 0 == lane) ? 1.0f : 0.0f, a1 = (i0 + 1 == lane) ? 1.0f : 0.0f, a2 = (i0 + 2 == lane) ? 1.0f : 0.0f, a3 = (i0 + 3 == lane) ? 1.0f : 0.0f;
#pragma unroll 2
            for (int j4 = 0; j4 < (i0 >> 2); ++j4) {
                const float t0 = Af[(4 * j4 + 0) * 64 + lane], t1 = Af[(4 * j4 + 1) * 64 + lane], t2 = Af[(4 * j4 + 2) * 64 + lane], t3 = Af[(4 * j4 + 3) * 64 + lane];
                const f32x4 r0 = *(const LAS f32x4*)(Af + (i0 + 0) * 64 + 4 * j4), r1 = *(const LAS f32x4*)(Af + (i0 + 1) * 64 + 4 * j4);
                const f32x4 r2 = *(const LAS f32x4*)(Af + (i0 + 2) * 64 + 4 * j4), r3 = *(const LAS f32x4*)(Af + (i0 + 3) * 64 + 4 * j4);
                a0 -= r0[0] * t0 + r0[1] * t1 + r0[2] * t2 + r0[3] * t3; a1 -= r1[0] * t0 + r1[1] * t1 + r1[2] * t2 + r1[3] * t3;
                a2 -= r2[0] * t0 + r2[1] * t1 + r2[2] * t2 + r2[3] * t3; a3 -= r3[0] * t0 + r3[1] * t1 + r3[2] * t2 + r3[3] * t3;
            }
            const f32x4 d1 = *(const LAS f32x4*)(Af + (i0 + 1) * 64 + i0), d2 = *(const LAS f32x4*)(Af + (i0 + 2) * 64 + i0), d3 = *(const LAS f32x4*)(Af + (i0 + 3) * 64 + i0);
            a1 -= d1[0] * a0; a2 -= d2[0] * a0 + d2[1] * a1; a3 -= d3[0] * a0 + d3[1] * a1 + d3[2] * a2;
            LDS_WAIT(); asm volatile("" ::: "memory");
            Af[(i0 + 0) * 64 + lane] = a0; Af[(i0 + 1) * 64 + lane] = a1; Af[(i0 + 2) * 64 + lane] = a2; Af[(i0 + 3) * 64 + lane] = a3;
            LDS_WAIT(); asm volatile("" ::: "memory");
        }
        bf16x8 tuf[4][2], twf[4][2];
        {
            const float* gcp = GC + (size_t)bh * S_ + 64 * n; const float* gbp = GB + (size_t)bh * S_ + 64 * n;
#pragma unroll
            for (int ks = 0; ks < 2; ++ks) {
                float su[8], sw[8];
#pragma unroll
                for (int h4 = 0; h4 < 2; ++h4) { const f32x4 bv = *(const f32x4*)(gbp + 32 * ks + 8 * q + 4 * h4), gv = *(const f32x4*)(gcp + 32 * ks + 8 * q + 4 * h4);
#pragma unroll
                    for (int e = 0; e < 4; ++e) { su[4 * h4 + e] = bv[e]; sw[4 * h4 + e] = -bv[e] * __expf(gv[e]); } }
#pragma unroll
                for (int tm = 0; tm < 4; ++tm) {
                    const f32x4 x0 = *(const LAS f32x4*)(Af + (16 * tm + r) * 64 + 32 * ks + 8 * q), x1 = *(const LAS f32x4*)(Af + (16 * tm + r) * 64 + 32 * ks + 8 * q + 4);
                    tuf[tm][ks] = __builtin_bit_cast(bf16x8, (u32x4){cvtpk(x0[0] * su[0], x0[1] * su[1]), cvtpk(x0[2] * su[2], x0[3] * su[3]), cvtpk(x1[0] * su[4], x1[1] * su[5]), cvtpk(x1[2] * su[6], x1[3] * su[7])});
                    twf[tm][ks] = __builtin_bit_cast(bf16x8, (u32x4){cvtpk(x0[0] * sw[0], x0[1] * sw[1]), cvtpk(x0[2] * sw[2], x0[3] * sw[3]), cvtpk(x1[0] * sw[4], x1[1] * sw[5]), cvtpk(x1[2] * sw[6], x1[3] * sw[7])});
                }
            }
        }
        LDS_WAIT(); asm volatile("" ::: "memory");
        {
#pragma unroll
            for (int w8 = 0; w8 < 8; ++w8) {
                bf16x8 vb[2];
#pragma unroll
                for (int ks = 0; ks < 2; ++ks) vb[ks] = *(const bf16x8*)(vt + ltr + (16 * w8 * 64 + 32 * ks) * 2);
#pragma unroll
                for (int tm = 0; tm < 4; ++tm) { f32x4 acc = (f32x4){0.f, 0.f, 0.f, 0.f};
#pragma unroll
                    for (int ks = 0; ks < 2; ++ks) acc = MFMA16(tuf[tm][ks], vb[ks], acc);
                    *(f32x4*)(ub + (unsigned)lane * 16u + ((w8 * 4 + tm) * 64) * 16) = acc; }
            }
        }
        {
#pragma unroll
            for (int a = 0; a < 8; ++a) {
                bf16x8 ka[2];
#pragma unroll
                for (int ks = 0; ks < 2; ++ks) ka[ks] = *(const bf16x8*)(kt + ltr + (16 * a * 64 + 32 * ks) * 2);
#pragma unroll
                for (int ti = 0; ti < 4; ++ti) { f32x4 acc = (f32x4){0.f, 0.f, 0.f, 0.f};
#pragma unroll
                    for (int ks = 0; ks < 2; ++ks) acc = MFMA16(ka[ks], twf[ti][ks], acc);
                    *(u32x2*)(blob + (BLOB_W + ((ti * 4 + (a >> 1)) * 64) * 8 + 4 * (a & 1)) * 2 + lfrag) = pk4(acc[0], acc[1], acc[2], acc[3]); }
            }
        }
        LDS_WAIT(); asm volatile("" ::: "memory");
    }
}

constexpr int SCAN_BUF = BLOB_ELEMS * 2;
DI bf16x8 pack8(const f32x4& lo, const f32x4& hi) { return __builtin_bit_cast(bf16x8, (u32x4){cvtpk(lo[0], lo[1]), cvtpk(lo[2], lo[3]), cvtpk(hi[0], hi[1]), cvtpk(hi[2], hi[3])}); }
DI void ld16_asm(u32x4& dst, const char* sbase, unsigned voff) { asm volatile("global_load_dwordx4 %0, %1, %2" : "=v"(dst) : "v"(voff), "s"(sbase) : "memory"); }
#define SCAN_LOAD(RSET, chunk) do { const char* _cb = pg8::rfl_ptr(src + (size_t)(chunk) * SCAN_BUF); \
    _Pragma("unroll") for (int i = 0; i < 14; ++i) ld16_asm(RSET[i], pg8::rfl_ptr(_cb + i * 4096), ltid16); } while (0)
#define SCAN_PUT(RSET, BUF) do { _Pragma("unroll") for (int i = 0; i < 14; ++i) *(LAS u32x4*)(F.lds + (BUF) * SCAN_BUF + i * 4096 + ltid16) = RSET[i]; } while (0)
#define SCAN_LSTEP(n_, BUFN, RFREE, RNEXT) do { const int n = (n_); \
    if (n + 3 < 64) { SCAN_LOAD(RFREE, n + 3); asm volatile("s_waitcnt vmcnt(28)" ::: "memory"); } else { asm volatile("s_waitcnt vmcnt(0)" ::: "memory"); } \
    __builtin_amdgcn_sched_barrier(0); \
    if (n + 1 < 64) SCAN_PUT(RNEXT, BUFN); \
    asm volatile("s_waitcnt lgkmcnt(0)" ::: "memory"); __builtin_amdgcn_s_barrier(); asm volatile("" ::: "memory"); } while (0)
#define SCAN_CSTEP(n_, BUFC, UC) do { const int n = (n_); \
        const LAS unsigned char* buf = F.lds + (BUFC) * SCAN_BUF; \
        f32x4 vn[4]; \
        _Pragma("unroll") for (int tm = 0; tm < 4; ++tm) vn[tm] = UC[tm]; \
        if (n + 2 < 64) { const char* u2 = pg8::rfl_ptr(ubase + (size_t)(n + 2) * 8192 * 4); _Pragma("unroll") for (int tm = 0; tm < 4; ++tm) UC[tm] = __builtin_nontemporal_load((const f32x4*)(u2 + lane16 + tm * 1024)); } \
        if (n > 0) { char* op = (char*)pg8::rfl_ptr(obase + (size_t)(64 * (n - 1)) * D_ * 2); \
            _Pragma("unroll") for (int tm = 0; tm < 4; ++tm) _Pragma("unroll") for (int reg = 0; reg < 4; ++reg) *(bf16*)(op + olane + (16 * tm + reg) * D_ * 2) = (bf16)cvtpk(o[tm][reg], 0.f); } \
        const float glast = rdlane(gl_all, n); \
        bf16x8 sb[4]; \
        _Pragma("unroll") for (int ks = 0; ks < 4; ++ks) sb[ks] = pack8(S[2 * ks], S[2 * ks + 1]); \
          \
        bf16x8 fw[16], fq[16], fk[8], fd[16]; bf16x8 vb[2]; \
        _Pragma("unroll") for (int i = 0; i < 16; ++i) fw[i] = *(const LAS bf16x8*)(buf + BLOB_W * 2 + (i * 64 + lane) * 16); \
        __builtin_amdgcn_sched_barrier(0); \
        _Pragma("unroll") for (int i = 0; i < 16; ++i) fq[i] = *(const LAS bf16x8*)(buf + BLOB_QG * 2 + (i * 64 + lane) * 16); \
        __builtin_amdgcn_sched_barrier(0); \
        _Pragma("unroll") for (int tm = 0; tm < 4; ++tm) _Pragma("unroll") for (int ks = 0; ks < 4; ++ks) vn[tm] = MFMA16(fw[tm * 4 + ks], sb[ks], vn[tm]); \
        __builtin_amdgcn_sched_barrier(0); \
        _Pragma("unroll") for (int i = 0; i < 8; ++i) fk[i] = *(const LAS bf16x8*)(buf + BLOB_QK * 2 + (i * 64 + lane) * 16); \
        __builtin_amdgcn_sched_barrier(0); \
        _Pragma("unroll") for (int tm = 0; tm < 4; ++tm) { o[tm] = (f32x4){0.f, 0.f, 0.f, 0.f}; \
            _Pragma("unroll") for (int ks = 0; ks < 4; ++ks) o[tm] = MFMA16(fq[tm * 4 + ks], sb[ks], o[tm]); } \
        _Pragma("unroll") for (int k2 = 0; k2 < 2; ++k2) vb[k2] = pack8(vn[2 * k2], vn[2 * k2 + 1]); \
        __builtin_amdgcn_sched_barrier(0); \
        _Pragma("unroll") for (int i = 0; i < 16; ++i) fd[i] = *(const LAS bf16x8*)(buf + BLOB_KDT * 2 + (i * 64 + lane) * 16); \
        __builtin_amdgcn_sched_barrier(0); \
        _Pragma("unroll") for (int tm = 0; tm < 4; ++tm) _Pragma("unroll") for (int k2 = 0; k2 < 2; ++k2) o[tm] = MFMA16(fk[tm * 2 + k2], vb[k2], o[tm]); \
        __builtin_amdgcn_sched_barrier(0); \
        _Pragma("unroll") for (int a = 0; a < 8; ++a) { S[a] = S[a] * glast; \
            _Pragma("unroll") for (int k2 = 0; k2 < 2; ++k2) S[a] = MFMA16(fd[a * 2 + k2], vb[k2], S[a]); } \
    asm volatile("s_waitcnt lgkmcnt(0)" ::: "memory"); __builtin_amdgcn_s_barrier(); asm volatile("" ::: "memory"); } while (0)

DI void gdn_scan2_phase(const Frame& F, const Args& A) {
    unsigned char* ws = opq(A.ws); unsigned char* big = ws + WS_BIG;
    const bf16* BLOB = (const bf16*)(big + GB_BLOB); const float* U = (const float*)(ws + WS_HID); bf16* Oraw = (bf16*)(ws + WS_Y);
    const float* GC = (const float*)(ws + WS_GALPHA);
    const int lane = F.lane, r = lane & 15, q = lane >> 4, w = F.wave;
    for (int it2 = F.bid; it2 < NB_ * 8 * 2; it2 += F.G) {
        const int item = it2 >> 1, half = it2 & 1, b = item >> 3, hh = item & 7, dvw = 4 * half + (w & 3);
        const char* src = pg8::rfl_ptr((const char*)(BLOB + (size_t)item * 64 * BLOB_ELEMS));
        __syncthreads();
        if (w >= 4) {
            const unsigned ltid16 = (unsigned)((w & 3) * 64 + lane) * 16u;
            u32x4 r0[14], r1[14], r2[14];
            SCAN_LOAD(r0, 0); SCAN_LOAD(r1, 1); SCAN_LOAD(r2, 2); asm volatile("s_waitcnt vmcnt(28)" ::: "memory"); __builtin_amdgcn_sched_barrier(0); SCAN_PUT(r0, 0);
            asm volatile("s_waitcnt lgkmcnt(0)" ::: "memory"); __builtin_amdgcn_s_barrier(); asm volatile("" ::: "memory");
#pragma unroll 1
            for (int n6 = 0; n6 < 60; n6 += 6) {
                SCAN_LSTEP(n6 + 0, 1, r0, r1); SCAN_LSTEP(n6 + 1, 0, r1, r2); SCAN_LSTEP(n6 + 2, 1, r2, r0);
                SCAN_LSTEP(n6 + 3, 0, r0, r1); SCAN_LSTEP(n6 + 4, 1, r1, r2); SCAN_LSTEP(n6 + 5, 0, r2, r0);
            }
            SCAN_LSTEP(60, 1, r0, r1); SCAN_LSTEP(61, 0, r1, r2); SCAN_LSTEP(62, 1, r2, r0); SCAN_LSTEP(63, 0, r0, r1);
        } else {
            f32x4 S[8];
#pragma unroll
            for (int a = 0; a < 8; ++a) S[a] = (f32x4){0.f, 0.f, 0.f, 0.f};
            const char* ubase = pg8::rfl_ptr((const char*)(U + (size_t)item * 64 * 8192 + (size_t)(dvw * 4) * 256));
            const char* obase = pg8::rfl_ptr((const char*)(Oraw + (size_t)b * S_ * D_ + hh * 128 + 16 * dvw));
            const unsigned lane16 = (unsigned)lane * 16u, olane = (unsigned)((4 * q) * D_ + r) * 2u;
            const float gl_all = __expf(GC[(size_t)item * S_ + 64 * lane + 63]);
            f32x4 ua[4], ub[4], o[4];
#pragma unroll
            for (int tm = 0; tm < 4; ++tm) { ua[tm] = __builtin_nontemporal_load((const f32x4*)(ubase + lane16 + tm * 1024)); ub[tm] = __builtin_nontemporal_load((const f32x4*)(ubase + 8192 * 4 + lane16 + tm * 1024)); o[tm] = (f32x4){0.f, 0.f, 0.f, 0.f}; }
            asm volatile("s_waitcnt lgkmcnt(0)" ::: "memory"); __builtin_amdgcn_s_barrier(); asm volatile("" ::: "memory");
#pragma unroll 1
            for (int n2 = 0; n2 < 64; n2 += 2) { SCAN_CSTEP(n2, 0, ua); SCAN_CSTEP(n2 + 1, 1, ub); }
            { char* op = (char*)obase + (size_t)(64 * 63) * D_ * 2;
#pragma unroll
              for (int tm = 0; tm < 4; ++tm)
#pragma unroll
                  for (int reg = 0; reg < 4; ++reg) *(bf16*)(op + olane + (16 * tm + reg) * D_ * 2) = (bf16)cvtpk(o[tm][reg], 0.f); }
        }
    }
}
#undef SCAN_LSTEP
#undef SCAN_CSTEP
#undef SCAN_LOAD
#undef SCAN_PUT
constexpr int N_PHASES = 42;
#ifndef MK_FUSED
#define MK_FUSED 1
#endif

#if MK_FUSED
typedef const __attribute__((address_space(4))) Args* CArgsP;
DI Args fresh_args() {
#if defined(__HIP_DEVICE_COMPILE__)
    CArgsP kp = (CArgsP)__builtin_amdgcn_kernarg_segment_ptr(); asm volatile("" : "+s"(kp)); Args a = *kp;
    a.x = asg(a.x); a.c = asg(a.c); a.pos = asg(a.pos); a.ada_w = asg(a.ada_w); a.ada_b = asg(a.ada_b); a.ln_g = asg(a.ln_g); a.ln_b = asg(a.ln_b);
    a.attn_w_in = asg(a.attn_w_in); a.attn_w_out = asg(a.attn_w_out); a.gdn_w_in = asg(a.gdn_w_in); a.gdn_conv_w = asg(a.gdn_conv_w); a.gdn_a_log = asg(a.gdn_a_log); a.gdn_dt_bias = asg(a.gdn_dt_bias);
    a.gdn_norm_w = asg(a.gdn_norm_w); a.gdn_w_out = asg(a.gdn_w_out); a.router_w = asg(a.router_w); a.router_bias = asg(a.router_bias); a.ew1 = asg(a.ew1); a.ew3 = asg(a.ew3); a.ew2 = asg(a.ew2);
    a.sw1 = asg(a.sw1); a.sw3 = asg(a.sw3); a.sw2 = asg(a.sw2); a.out = asg(a.out); a.ws = asg(a.ws);
    return a;
#else
    return Args{};
#endif
}
DI Frame fresh_frame(int wave_s) { Frame F; int g = gridDim.x; asm volatile("" : "+s"(g)); int b = blockIdx.x; asm volatile("" : "+s"(b)); unsigned l = 0u; asm volatile("" : "+s"(l));
    int w = wave_s; asm volatile("" : "+s"(w)); int ln; asm volatile("v_mbcnt_lo_u32_b32 %0, -1, 0\n\tv_mbcnt_hi_u32_b32 %0, -1, %0" : "=&v"(ln));
    F.lds = (LAS unsigned char*)(size_t)l; F.tid = w * 64 + ln; F.lane = ln; F.wave = w; F.G = g; F.bid = b; return F; }
#define PHF() const Args A = fresh_args(); const Frame F = fresh_frame(wave_s); \
    unsigned char* ws = opq(A.ws); LAS int* idxlds = (LAS int*)(F.lds + LDS_IDX); const LAS int* tileoff = (const LAS int*)(F.lds + LDS_TILEOFF); (void)ws; (void)idxlds; (void)tileoff;
DI void ph_pro(const int wave_s) { PHF(); prologue_phase(F, A); convert_experts(F, A, 0, 0, 0, F.G); }
DI void ph_modx(const int wave_s) { PHF(); modx_phase(F, A); }
DI void ph_attn(const int wave_s) { PHF(); attn_phase(F, A); }
DI void ph_lnr(const int wave_s, int L) { PHF(); if (L == 0) ln_router_phase<true>(F, A, L); else ln_router_phase<false>(F, A, L); }
DI void ph_lnr_dry(const int wave_s, int L) { PHF(); if (L == 0) ln_router_phase<true>(F, A, L, true); else ln_router_phase<false>(F, A, L, true); }
DI void ph_scat(const int wave_s, int L) { PHF(); moe_scatter_phase(F, A, L); }
DI void ph_lnm(const int wave_s, int L) { PHF(); ln_moe_phase(F, A, L, nullptr); }
DI void ph_lnm_dry(const int wave_s, int L) { PHF(); ln_moe_phase(F, A, L, (float*)(ws + WS_Y)); }
DI void ph_gprep(const int wave_s, int lp) { PHF(); gdn_prep2_phase(F, A, lp); }
DI void ph_gwy(const int wave_s) { PHF(); gdn_wy_phase(F, A); }
DI void ph_gscan(const int wave_s, int L) { PHF(); gdn_scan2_phase(F, A); if (F.G > 128) { convert_experts(F, A, L, 0, 64, F.G - 64); if (L == 1) convert_experts(F, A, 2, 1, 64, F.G - 64); } else { convert_experts(F, A, L, 0, 0, F.G); if (L == 1) convert_experts(F, A, 2, 1, 0, F.G); } }
DI void ph_gpost(const int wave_s, int lp) { PHF(); gdn_post_phase(F, A, lp); }
DI void ph_gemm_qkv(const int wave_s, int lp) { PHF();
    pg8::DenseOrder S; S.init(WS_H, WS_WA_IN + (size_t)lp * 9216 * D_ * 2, T_, 9216, D_, F.G, F.bid);
    pg8::EpiQKV E{(bf16*)(ws + WS_BIG), (const float*)(ws + WS_COS), (const float*)(ws + WS_SIN)};
    pg8::gemm_phase<pg8::EpiQKV, pg8::DenseOrder, true, true>(F.tid, ws, F.lds, idxlds, D_, S, E); }
DI void ph_gemm_out(const int wave_s, int lp, int isg) { PHF();
    pg8::DenseOrder S; S.init(WS_O, (isg ? WS_WG_OUT : WS_WA_OUT) + (size_t)lp * D_ * D_ * 2, T_, D_, D_, F.G, F.bid);
    pg8::EpiBf16 E{(bf16*)(ws + WS_Y), D_};
    pg8::gemm_phase<pg8::EpiBf16, pg8::DenseOrder, true, true>(F.tid, ws, F.lds, idxlds, D_, S, E); }
DI void ph_gemm_gin(const int wave_s, int lp) { PHF();
    pg8::DenseOrder S; S.init(WS_H, WS_WG_IN + (size_t)lp * 4096 * D_ * 2, T_, 4096, D_, F.G, F.bid);
    pg8::EpiBf16 E{(bf16*)(ws + WS_BIG + BIG_PROJ), 4096};
    pg8::gemm_phase<pg8::EpiBf16, pg8::DenseOrder, true, true>(F.tid, ws, F.lds, idxlds, D_, S, E); }
DI void ph_moe1(const int wave_s, int L) { PHF();
    const unsigned* gcount = (const unsigned*)(ws + WS_CTL) + CW_CNT + L * 64;
    build_tileoff(F, gcount);
    pg8::MoeOrder<true> S; S.A = (unsigned)WS_H; S.Bt = (unsigned)(L == 2 ? WS_WEB : WS_WE1); S.K = D_; S.nct_log = 1; S.nunits = __builtin_amdgcn_readfirstlane(tileoff[65]) * 2; S.G = F.G; S.c = F.bid;
    S.idxoff = (unsigned)WS_ETOK; S.tileoff = tileoff; S.ecnt = (const LAS int*)(F.lds + LDS_ECNT); S.bstride = (unsigned)(512 * D_ * 2);
    pg8::EpiSwiGLU E{(bf16*)(ws + WS_HID)};
    pg8::gemm_phase<pg8::EpiSwiGLU, pg8::MoeOrder<true>, true, true>(F.tid, ws, F.lds, idxlds, D_, S, E); }
DI void ph_moe2(const int wave_s, int L) { PHF();
    const unsigned* gcount = (const unsigned*)(ws + WS_CTL) + CW_CNT + L * 64;
    build_tileoff(F, gcount);
    pg8::MoeOrder<false> S; S.A = (unsigned)WS_HID; S.Bt = (unsigned)(L == 2 ? WS_WEB + 65 * MiB : WS_WE2); S.K = 256; S.nct_log = 2; S.nunits = __builtin_amdgcn_readfirstlane(tileoff[(YS_BF16 && !YS_MERGED) ? 64 : 65]) * 4; S.G = F.G; S.c = F.bid;
    S.idxoff = (unsigned)WS_EW; S.tileoff = tileoff; S.ecnt = (const LAS int*)(F.lds + LDS_ECNT); S.bstride = (unsigned)(D_ * 256 * 2);
    pg8::EpiScale E{ws + WS_BIG, 256 * __builtin_amdgcn_readfirstlane(tileoff[64])};
    pg8::gemm_phase<pg8::EpiScale, pg8::MoeOrder<false>, false, false>(F.tid, ws, F.lds, idxlds, 256, S, E); }
DI void ph_moe2s(const int wave_s, int L) { PHF();
    __syncthreads();
    const size_t s0 = (size_t)(256 * __builtin_amdgcn_readfirstlane(((const LAS int*)(F.lds + LDS_TILEOFF))[64]));
    pg8::DenseOrder S; S.init(WS_HID + s0 * 256 * 2, (L == 2 ? WS_WEB + 65 * MiB : WS_WE2) + (size_t)NEXP * D_ * 256 * 2, T_, D_, 256, F.G, F.bid);
    pg8::EpiBf16 E{(bf16*)(ws + WS_BIG + WS_YS_OFF), D_};
    pg8::gemm_phase<pg8::EpiBf16, pg8::DenseOrder, false, false>(F.tid, ws, F.lds, idxlds, 256, S, E); }

DI void grid_bar(const int wave_s) { PHF(); XcdBarrier b; b.bar = (unsigned*)(ws + WS_CTL) + CW_BAR; volatile LAS unsigned* misc = (volatile LAS unsigned*)(F.lds + LDS_MISC); b.st = misc + 8;
    b.x = (unsigned)__builtin_amdgcn_readfirstlane((int)misc[10]); xcd_barrier(b, F.tid); }
__global__ void __launch_bounds__(NTHR, 2) mk_fwd(Args Ain) {
    extern __shared__ __attribute__((aligned(16))) unsigned char lds_raw[];
    LAS unsigned char* lds = (LAS unsigned char*)lds_raw;
    for (int u = threadIdx.x; u < (LDS_BYTES - RING_BYTES) / 4; u += NTHR) ((LAS unsigned*)(lds + RING_BYTES))[u] = 0u;
    __syncthreads();
    const int wave_s = __builtin_amdgcn_readfirstlane((int)threadIdx.x >> 6);
    { XcdBarrier bar = xcd_barrier_post((unsigned*)(Ain.ws + WS_CTL) + CW_BAR, (volatile LAS unsigned*)(lds + LDS_MISC) + 8);
      if (threadIdx.x == 0) ((volatile LAS unsigned*)(lds + LDS_MISC))[10] = bar.x; }
    __syncthreads();
#ifndef REP_BAR
#define REP_BAR 1
#define REP_PRO 1
#define REP_POST 1
#define REP_QKV 1
#define REP_OUT 1
#define REP_GIN 1
#define REP_M1 1
#define REP_M2 1
#define REP_LNM 1
#define REP_LNR 1
#endif
#define GBAR() do { for (int _b = 0; _b < REP_BAR; ++_b) grid_bar(wave_s); } while (0)
#ifndef REP_ATTN
#define REP_ATTN 1
#define REP_SCAN 1
#define REP_GEMM 1
#define REP_PREP 1
#define REP_CONV 1
#define REP_WY 1
#endif
    for (int r = 0; r < REP_PRO; ++r) { ph_pro(wave_s); GBAR(); }
    ph_modx(wave_s); GBAR();
#pragma unroll 1
    for (int L = 0; L < 4; ++L) {
        const int lp = L >> 1;
        if ((L & 1) == 0) { for (int r = 0; r < REP_QKV; ++r) { ph_gemm_qkv(wave_s, lp); GBAR(); } for (int r = 0; r < REP_ATTN; ++r) { ph_attn(wave_s); GBAR(); } for (int r = 0; r < REP_OUT; ++r) { ph_gemm_out(wave_s, lp, 0); GBAR(); } }
        else { for (int r = 0; r < REP_GIN; ++r) { ph_gemm_gin(wave_s, lp); GBAR(); } for (int r = 0; r < REP_PREP; ++r) { ph_gprep(wave_s, lp); GBAR(); } for (int r = 0; r < REP_WY; ++r) { ph_gwy(wave_s); GBAR(); } for (int r = 0; r < REP_SCAN; ++r) { ph_gscan(wave_s, L); GBAR(); } for (int r = 0; r < REP_POST; ++r) { ph_gpost(wave_s, lp); GBAR(); } for (int r = 0; r < REP_OUT; ++r) { ph_gemm_out(wave_s, lp, 1); GBAR(); } }
        for (int r = 1; r < REP_LNR; ++r) { ph_lnr_dry(wave_s, L); GBAR(); }
        ph_lnr(wave_s, L); GBAR();
        for (int r = 0; r < REP_M1; ++r) { ph_moe1(wave_s, L); GBAR(); }
        for (int r = 0; r < REP_M2; ++r) { ph_moe2(wave_s, L); if (YS_BF16 && !YS_MERGED) ph_moe2s(wave_s, L); GBAR(); }
        for (int r = 1; r < REP_LNM; ++r) { ph_lnm_dry(wave_s, L); GBAR(); }
        ph_lnm(wave_s, L); if (L < 3) GBAR();
    }
#undef GBAR
}
#else

#define MKF() extern __shared__ __attribute__((aligned(16))) unsigned char lds_raw[]; Frame F; F.lds = (LAS unsigned char*)lds_raw; F.tid = threadIdx.x; F.lane = F.tid & 63; \
    F.wave = __builtin_amdgcn_readfirstlane(F.tid >> 6); F.G = gridDim.x; F.bid = blockIdx.x; unsigned char* ws = opq(A.ws); LAS int* idxlds = (LAS int*)(F.lds + LDS_IDX); \
    const LAS int* tileoff = (const LAS int*)(F.lds + LDS_TILEOFF); (void)ws; (void)idxlds; (void)tileoff; \
    for (int u = F.tid; u < (LDS_BYTES - RING_BYTES) / 4; u += NTHR) ((LAS unsigned*)(F.lds + RING_BYTES))[u] = 0u; __syncthreads();
__global__ void __launch_bounds__(NTHR, 2) k_pro(Args A) { MKF(); prologue_phase(F, A); }
__global__ void __launch_bounds__(NTHR, 2) k_modx(Args A) { MKF(); modx_phase(F, A); }
__global__ void __launch_bounds__(NTHR, 2) k_attn(Args A) { MKF(); attn_phase(F, A); }
__global__ void __launch_bounds__(NTHR, 2) k_lnr(Args A) { MKF(); const int L = A.ph_lo; ln_router_phase<false>(F, A, L); }
__global__ void __launch_bounds__(NTHR, 2) k_scat(Args A) { MKF(); moe_scatter_phase(F, A, A.ph_lo); convert_experts(F, A, A.ph_lo); }
__global__ void __launch_bounds__(NTHR, 2) k_lnm(Args A) { MKF(); const int L = A.ph_lo; ln_moe_phase(F, A, L, nullptr); }
__global__ void __launch_bounds__(NTHR, 2) k_gprep(Args A) { MKF(); gdn_prep_phase(F, A, A.ph_lo); }
__global__ void __launch_bounds__(NTHR, 2) k_gscan(Args A) { MKF(); gdn_scan_phase(F, A); }
__global__ void __launch_bounds__(NTHR, 2) k_gpost(Args A) { MKF(); gdn_post_phase(F, A, A.ph_lo); }
__global__ void __launch_bounds__(NTHR, 2) k_gemm_qkv(Args A) { MKF(); const int lp = A.ph_lo;
    pg8::DenseOrder S; S.init(WS_H, WS_WA_IN + (size_t)lp * 9216 * D_ * 2, T_, 9216, D_, F.G, F.bid);
    pg8::EpiQKV E{(bf16*)(ws + WS_BIG), (const float*)(ws + WS_COS), (const float*)(ws + WS_SIN)};
    pg8::gemm_phase<pg8::EpiQKV, pg8::DenseOrder, true, true>(F.tid, ws, F.lds, idxlds, D_, S, E); }
__global__ void __launch_bounds__(NTHR, 2) k_gemm_out(Args A) { MKF(); const int lp = A.ph_lo >> 1, isg = A.ph_lo & 1;
    pg8::DenseOrder S; S.init(WS_O, (isg ? WS_WG_OUT : WS_WA_OUT) + (size_t)lp * D_ * D_ * 2, T_, D_, D_, F.G, F.bid);
    pg8::EpiF32 E{(float*)(ws + WS_Y), D_};
    pg8::gemm_phase<pg8::EpiF32, pg8::DenseOrder, true, true>(F.tid, ws, F.lds, idxlds, D_, S, E); }
__global__ void __launch_bounds__(NTHR, 2) k_gemm_gin(Args A) { MKF(); const int lp = A.ph_lo;
    pg8::DenseOrder S; S.init(WS_H, WS_WG_IN + (size_t)lp * 4096 * D_ * 2, T_, 4096, D_, F.G, F.bid);
    pg8::EpiBf16 E{(bf16*)(ws + WS_BIG + BIG_PROJ), 4096};
    pg8::gemm_phase<pg8::EpiBf16, pg8::DenseOrder, true, true>(F.tid, ws, F.lds, idxlds, D_, S, E); }
__global__ void __launch_bounds__(NTHR, 2) k_moe1(Args A) { MKF();
    const unsigned* gcount = (const unsigned*)(ws + WS_CTL) + CW_CNT + A.ph_lo * 64;
    build_tileoff(F, gcount);
    pg8::MoeOrder<true> S; S.A = (unsigned)WS_H; S.Bt = (unsigned)(L == 2 ? WS_WEB : WS_WE1); S.K = D_; S.nct_log = 1; S.nunits = __builtin_amdgcn_readfirstlane(tileoff[65]) * 2; S.G = F.G; S.c = F.bid;
    S.idxoff = (unsigned)WS_ETOK; S.tileoff = tileoff; S.ecnt = (const LAS int*)(F.lds + LDS_ECNT); S.bstride = (unsigned)(512 * D_ * 2);
    pg8::EpiSwiGLU E{(bf16*)(ws + WS_HID)};
    pg8::gemm_phase<pg8::EpiSwiGLU, pg8::MoeOrder<true>, true, true>(F.tid, ws, F.lds, idxlds, D_, S, E); }
__global__ void __launch_bounds__(NTHR, 2) k_moe2(Args A) { MKF();
    const unsigned* gcount = (const unsigned*)(ws + WS_CTL) + CW_CNT + A.ph_lo * 64;
    build_tileoff(F, gcount);
    pg8::MoeOrder<false> S; S.A = (unsigned)WS_HID; S.Bt = (unsigned)(L == 2 ? WS_WEB + 65 * MiB : WS_WE2); S.K = 256; S.nct_log = 2; S.nunits = __builtin_amdgcn_readfirstlane(tileoff[65]) * 4; S.G = F.G; S.c = F.bid;
    S.idxoff = (unsigned)WS_EW; S.tileoff = tileoff; S.ecnt = (const LAS int*)(F.lds + LDS_ECNT); S.bstride = (unsigned)(D_ * 256 * 2);
    pg8::EpiScale E{ws + WS_BIG, 256 * __builtin_amdgcn_readfirstlane(tileoff[64])};
    pg8::gemm_phase<pg8::EpiScale, pg8::MoeOrder<false>, false, false>(F.tid, ws, F.lds, idxlds, 256, S, E); }
#endif
extern "C" void kernel_launch(void* const* d_in, const int* in_sizes, int n_in, void* d_out, int out_size, void* d_ws, size_t ws_size, hipStream_t stream) {
    static int grid = 0;
    if (grid == 0) {
        if (n_in != 23 || in_sizes[0] != T_ * D_ || out_size != T_ * D_ || ws_size < WS_END) {
            fprintf(stderr, "kernel_launch: unexpected shapes (n_in %d, in0 %d, out %d, ws %zu < %zu); nothing launched\n", n_in, n_in > 0 ? in_sizes[0] : -1, out_size, ws_size, (size_t)WS_END); grid = -1; return; }
        int dev = 0, cus = 0, per_cu = 0;
        if (hipGetDevice(&dev) != hipSuccess || hipDeviceGetAttribute(&cus, hipDeviceAttributeMultiprocessorCount, dev) != hipSuccess) { grid = -1; return; }
#if MK_FUSED
        if (hipFuncSetAttribute((const void*)mk_fwd, hipFuncAttributeMaxDynamicSharedMemorySize, LDS_BYTES) != hipSuccess) { fprintf(stderr, "kernel_launch: hipFuncSetAttribute failed\n"); grid = -1; return; }
        if (hipOccupancyMaxActiveBlocksPerMultiprocessor(&per_cu, (const void*)mk_fwd, NTHR, LDS_BYTES) != hipSuccess || per_cu < 1)
            fprintf(stderr, "kernel_launch: note: occupancy query reports %d workgroups per CU\n", per_cu);
#else
        { const void* ks[] = {(const void*)k_pro, (const void*)k_modx, (const void*)k_attn, (const void*)k_lnr, (const void*)k_scat, (const void*)k_lnm, (const void*)k_gprep, (const void*)k_gscan, (const void*)k_gpost,
                              (const void*)k_gemm_qkv, (const void*)k_gemm_out, (const void*)k_gemm_gin, (const void*)k_moe1, (const void*)k_moe2};
          for (const void* k : ks) if (hipFuncSetAttribute(k, hipFuncAttributeMaxDynamicSharedMemorySize, LDS_BYTES) != hipSuccess) { fprintf(stderr, "kernel_launch: hipFuncSetAttribute failed\n"); grid = -1; return; } }
        (void)per_cu;
#endif
        (void)hipGetLastError();
        grid = cus;
    }
    if (grid < 0) return;
    (void)hipMemsetAsync((char*)d_ws + WS_CTL, 0, CTL_ZERO_BYTES, stream);
    Args a{};
    a.x = (const float*)d_in[0]; a.c = (const float*)d_in[1]; a.pos = (const int*)d_in[2]; a.ada_w = (const float*)d_in[3]; a.ada_b = (const float*)d_in[4];
    a.ln_g = (const float*)d_in[5]; a.ln_b = (const float*)d_in[6]; a.attn_w_in = (const float*)d_in[7]; a.attn_w_out = (const float*)d_in[8];
    a.gdn_w_in = (const float*)d_in[9]; a.gdn_conv_w = (const float*)d_in[10]; a.gdn_a_log = (const float*)d_in[11]; a.gdn_dt_bias = (const float*)d_in[12];
    a.gdn_norm_w = (const float*)d_in[13]; a.gdn_w_out = (const float*)d_in[14]; a.router_w = (const float*)d_in[15]; a.router_bias = (const float*)d_in[16];
    a.ew1 = (const float*)d_in[17]; a.ew3 = (const float*)d_in[18]; a.ew2 = (const float*)d_in[19]; a.sw1 = (const float*)d_in[20]; a.sw3 = (const float*)d_in[21]; a.sw2 = (const float*)d_in[22];
    a.out = (float*)d_out; a.ws = (unsigned char*)d_ws;
#if MK_FUSED
    a.ph_lo = 0; a.ph_hi = N_PHASES;
    hipLaunchKernelGGL(mk_fwd, dim3(grid), dim3(NTHR), LDS_BYTES, stream, a);
#else
#define LAUNCH(k, arg) do { a.ph_lo = (arg); a.ph_hi = (arg) + 1; hipLaunchKernelGGL(k, dim3(grid), dim3(NTHR), LDS_BYTES, stream, a); } while (0)
    LAUNCH(k_pro, 0); LAUNCH(k_modx, 0);
    for (int L = 0; L < 4; ++L) {
        const int lp = L >> 1;
        if ((L & 1) == 0) { LAUNCH(k_gemm_qkv, lp); LAUNCH(k_attn, 0); LAUNCH(k_gemm_out, 2 * lp); }
        else { LAUNCH(k_gemm_gin, lp); LAUNCH(k_gprep, lp); LAUNCH(k_gscan, 0); LAUNCH(k_gpost, lp); LAUNCH(k_gemm_out, 2 * lp + 1); }
        LAUNCH(k_lnr, L); LAUNCH(k_scat, L); LAUNCH(k_moe1, L); LAUNCH(k_moe2, L); LAUNCH(k_lnm, L);
    }
#undef LAUNCH
#endif
    const hipError_t le = hipPeekAtLastError();
    if (le != hipSuccess) fprintf(stderr, "kernel_launch: launch failed: %s\n", hipGetErrorName(le));
}
```

```cpp
#include <hip/hip_runtime.h>
#include <cstdio>
#include <cstdint>

#define GAS __attribute__((address_space(1)))
#define LAS __attribute__((address_space(3)))
typedef unsigned short bf16;
typedef unsigned u32x4 __attribute__((ext_vector_type(4)));
typedef unsigned u32x2 __attribute__((ext_vector_type(2)));
typedef float f32x2 __attribute__((ext_vector_type(2)));
typedef float f32x4 __attribute__((ext_vector_type(4)));
typedef float f32x16 __attribute__((ext_vector_type(16)));
typedef short bf16x8 __attribute__((ext_vector_type(8)));
typedef short s16x4 __attribute__((ext_vector_type(4)));
typedef __bf16 bf16x2_t __attribute__((ext_vector_type(2)));
#define DI __device__ __forceinline__

DI unsigned cvtpk(float lo, float hi) { f32x2 v = {lo, hi}; bf16x2_t b = __builtin_convertvector(v, bf16x2_t); return __builtin_bit_cast(unsigned, b); }
DI unsigned cvtpk_fp8(float a, float b, float c, float d) { int w = __builtin_amdgcn_cvt_pk_fp8_f32(a, b, 0, false); w = __builtin_amdgcn_cvt_pk_fp8_f32(c, d, w, true); return (unsigned)w; }
constexpr bool YS_BF16 = true;
constexpr bool YS_MERGED = true;
constexpr float YE_SCALE = 16.0f;
DI float silu_f(float a) { return a * __builtin_amdgcn_rcpf(1.0f + __expf(-a)); }
DI float bf_lo(unsigned u) { return __builtin_bit_cast(float, u << 16); }
DI float bf_hi(unsigned u) { return __builtin_bit_cast(float, u & 0xffff0000u); }
template <int M> DI float shx(float v) { return __builtin_bit_cast(float, __builtin_amdgcn_ds_swizzle(__builtin_bit_cast(int, v), (M << 10) | 0x1f)); }
DI float bperm(float v, int srclane) { return __builtin_bit_cast(float, __builtin_amdgcn_ds_bpermute(srclane << 2, __builtin_bit_cast(int, v))); }
DI float rdlane(float v, int l) { return __builtin_bit_cast(float, __builtin_amdgcn_readlane(__builtin_bit_cast(int, v), l)); }
template <int CTRL> DI float dppmov(float v) { return __builtin_bit_cast(float, __builtin_amdgcn_update_dpp(0, __builtin_bit_cast(int, v), CTRL, 0xf, 0xf, true)); }
DI float wave_sum(float v) { v += dppmov<0xB1>(v); v += dppmov<0x4E>(v); v += dppmov<0x141>(v); v += dppmov<0x140>(v); return (rdlane(v, 0) + rdlane(v, 16)) + (rdlane(v, 32) + rdlane(v, 48)); }
DI float wave_max(float v) { v = fmaxf(v, dppmov<0xB1>(v)); v = fmaxf(v, dppmov<0x4E>(v)); v = fmaxf(v, dppmov<0x141>(v)); v = fmaxf(v, dppmov<0x140>(v)); return fmaxf(fmaxf(rdlane(v, 0), rdlane(v, 16)), fmaxf(rdlane(v, 32), rdlane(v, 48))); }
#define LDS_WAIT() asm volatile("s_waitcnt lgkmcnt(0)" ::: "memory")
#define VM_WAIT() asm volatile("s_waitcnt vmcnt(0)" ::: "memory")

namespace pg8 {
constexpr int BM = 256, BK = 64, HALF = 128, HTB = HALF * BK * 2, STAGE_BYTES = 8 * HTB;
DI int lds_byte(int r, int c) { const int st = (r >> 4) * 2 + (c >> 5), rr = r & 15, cc = c & 31, ob = rr * 64 + cc * 2; return st * 1024 + (ob ^ (((ob >> 9) & 1) << 5)); }
DI void stage_rc(int b, int& R, int& C) { const int st = b / 1024, sb = b % 1024, swz = sb ^ (((sb >> 9) & 1) << 5); R = (st >> 1) * 16 + swz / 64; C = (st & 1) * 32 + (swz % 64) / 2; }
DI int perm32(int rho) { const int n = rho >> 4, i = rho & 15; return 8 * (i >> 2) + 4 * n + (i & 3); }

DI const char* rfl_ptr(const char* p) {
    const unsigned long long v = (unsigned long long)p; const unsigned lo = __builtin_amdgcn_readfirstlane((unsigned)v), hi = __builtin_amdgcn_readfirstlane((unsigned)(v >> 32));
    return (const char*)(const __attribute__((address_space(1))) char*)(((unsigned long long)hi << 32) | lo); }
struct Unit { unsigned a; unsigned b; int r0; int c0; int e; int rb; int nv; };

template <class Epi, class Sched, bool ALIGN_EPI, bool SP2>
DI void gemm_phase(const int tid, const void* wsbase, LAS unsigned char* lds, LAS int* idxlds, const int K, const Sched& S, const Epi& E) {
    const __amdgpu_buffer_rsrc_t rsrc = __builtin_amdgcn_make_buffer_rsrc((void*)wsbase, 0, 0xffffffff, 0x00020000);
    const int wid = __builtin_amdgcn_readfirstlane(tid >> 6), lane = tid & 63, wr = wid >> 2, wc = wid & 3, fr = lane & 15, fq = lane >> 4;
    const int nt = K / BK;
    unsigned voffB[2], voffA[2][2];
#pragma unroll
    for (int i = 0; i < 2; ++i) { int R, C; stage_rc(tid * 16 + i * 8192, R, C); const int Rb = Epi::PERM ? ((R & ~31) + perm32(R & 31)) : R;
        voffB[i] = (unsigned)(Rb * K + C) * 2u;
        voffA[0][i] = (unsigned)(R * K + C) * 2u; voffA[1][i] = (unsigned)((R + HALF) * K + C) * 2u; }
    const unsigned kstep = (unsigned)(BK * 2);
    const unsigned hstep = (unsigned)(HALF * K * 2);
    const unsigned ldsw = (unsigned)wid * 1024u;
    const int aoff = lds_byte(wr * 64 + fr, fq * 8), boff = lds_byte(wc * 32 + fr, fq * 8);
#define PG8_SA(b, h) (((b) * 2 + (h)) * HTB)
#define PG8_SB(b, h) ((4 + (b) * 2 + (h)) * HTB)
#define PG8_STAGE(bufoff, soff, voff) do { const int _so = __builtin_amdgcn_readfirstlane((int)(soff)); _Pragma("unroll") for (int _i = 0; _i < 2; ++_i) \
        __builtin_amdgcn_raw_ptr_buffer_load_lds(rsrc, (LAS void*)(lds + (bufoff) + ldsw + _i * 8192), 16, (int)(voff)[_i], _so, 0, 0); } while (0)
#define PG8_LDA(dst, b, h) do { _Pragma("unroll") for (int m = 0; m < 4; ++m) _Pragma("unroll") for (int k = 0; k < 2; ++k) dst[m][k] = *(const LAS bf16x8*)(lds + PG8_SA(b, h) + aoff + m * 2048 + k * 1024); } while (0)
#define PG8_LDB(dst, b, h) do { _Pragma("unroll") for (int n = 0; n < 2; ++n) _Pragma("unroll") for (int k = 0; k < 2; ++k) dst[n][k] = *(const LAS bf16x8*)(lds + PG8_SB(b, h) + boff + n * 2048 + k * 1024); } while (0)
#define PG8_MMA(ai, bj, At, Bt) do { __builtin_amdgcn_s_setprio(1); _Pragma("unroll") for (int m = 0; m < 4; ++m) _Pragma("unroll") for (int n = 0; n < 2; ++n) _Pragma("unroll") for (int k = 0; k < 2; ++k) \
        acc[ai][bj][m][n] = __builtin_amdgcn_mfma_f32_16x16x32_bf16(Bt[n][k], At[m][k], acc[ai][bj][m][n], 0, 0, 0); __builtin_amdgcn_s_setprio(0); } while (0)
#define PG8_WAIT_V(n) asm volatile("s_waitcnt vmcnt(" #n ")" ::: "memory")
#define PG8_WAIT_L(n) asm volatile("s_waitcnt lgkmcnt(" #n ")" ::: "memory")
#define PG8_BAR __builtin_amdgcn_s_barrier()
#define PG8_SCHED __builtin_amdgcn_sched_barrier(0)
#define PG8_IDX_ISSUE(u, slot) __builtin_amdgcn_raw_ptr_buffer_load_lds(rsrc, (LAS void*)(idxlds + (slot) * 256 + (wid & 3) * 64), 4, lane * 4, \
        __builtin_amdgcn_readfirstlane((int)(S.idxoff + (unsigned)((u).rb + (wid & 3) * 64) * 4u)), 0, 0)
#define PG8_IDX_READ(dst, h_, slot, nv_) do { int _t = tid; asm volatile("" : "+v"(_t));   \
        _Pragma("unroll") for (int _i = 0; _i < 2; ++_i) { int _R, _C; stage_rc(_t * 16 + _i * 8192, _R, _C); \
        const int _ix = ((h_) * HALF + _R) < (nv_) ? idxlds[(slot) * 256 + (h_) * HALF + _R] : S.padrow;        \
        dst[_i] = (unsigned)_ix * (unsigned)(K * 2) + (unsigned)(_C * 2); } } while (0)
    Unit cur, nxt; int ui = 0;
    if (!S.next(0, cur)) return;
    f32x4 acc[2][2][4][2];
#pragma unroll
    for (int a = 0; a < 2; ++a)
#pragma unroll
        for (int b = 0; b < 2; ++b)
#pragma unroll
            for (int m = 0; m < 4; ++m)
#pragma unroll
                for (int n = 0; n < 2; ++n) acc[a][b][m][n] = (f32x4){0.f, 0.f, 0.f, 0.f};
    bf16x8 At[4][2], B0[2][2], B1[2][2];
    unsigned cA = cur.a, cB = cur.b;
    if constexpr (Sched::GATHER || Epi::ROWAUX) {
        PG8_IDX_ISSUE(cur, 0); PG8_WAIT_V(0); PG8_BAR;     asm volatile("" ::: "memory");
        if constexpr (Sched::GATHER) { PG8_IDX_READ(voffA[0], 0, 0, cur.nv); PG8_IDX_READ(voffA[1], 1, 0, cur.nv); }
    }
    if constexpr (SP2) {
        PG8_STAGE(PG8_SB(0, 0), cB, voffB); PG8_STAGE(PG8_SB(0, 1), cB + hstep, voffB); PG8_STAGE(PG8_SA(0, 0), cA, voffA[0]); PG8_STAGE(PG8_SA(0, 1), cA, voffA[1]);
        if (wr == 1) PG8_BAR;
        PG8_WAIT_V(2); PG8_BAR;
        PG8_STAGE(PG8_SB(1, 0), cB + kstep, voffB); PG8_STAGE(PG8_SA(1, 0), cA + kstep, voffA[0]); PG8_STAGE(PG8_SB(1, 1), cB + hstep + kstep, voffB);
        PG8_WAIT_V(6); PG8_BAR;
    } else {
        PG8_STAGE(PG8_SB(0, 0), cB, voffB); PG8_STAGE(PG8_SA(0, 0), cA, voffA[0]); PG8_STAGE(PG8_SB(0, 1), cB + hstep, voffB); PG8_STAGE(PG8_SA(0, 1), cA, voffA[1]);
        if (wr == 1) PG8_BAR;
        PG8_WAIT_V(4); PG8_BAR;
        PG8_STAGE(PG8_SB(1, 0), cB + kstep, voffB); PG8_STAGE(PG8_SA(1, 0), cA + kstep, voffA[0]); PG8_STAGE(PG8_SB(1, 1), cB + hstep + kstep, voffB);
        PG8_WAIT_V(6); PG8_BAR;
    }
    for (;;) {
        const bool has_next = S.next(ui + 1, nxt);
        const unsigned nA = has_next ? nxt.a : cA, nB = has_next ? nxt.b : cB;
        for (int t = 0; t < nt; t += 2) {
            const bool last = (t == nt - 2);
            const unsigned a1 = cA + (unsigned)(t + 1) * kstep;
            const unsigned a2 = last ? nA : cA + (unsigned)(t + 2) * kstep, b2 = last ? nB : cB + (unsigned)(t + 2) * kstep;
            const unsigned a3 = a2 + kstep, b3 = b2 + kstep;
            if constexpr (Sched::GATHER || Epi::ROWAUX) { if (t == 0 && has_next) PG8_IDX_ISSUE(nxt, (ui + 1) % 3); }
            if constexpr (Sched::GATHER) { if (last && has_next) PG8_IDX_READ(voffA[0], 0, (ui + 1) % 3, nxt.nv); }
#define PG8_NEXT_H1() do { if constexpr (Sched::GATHER) { if (last && has_next) PG8_IDX_READ(voffA[1], 1, (ui + 1) % 3, nxt.nv); } } while (0)
            if constexpr (SP2) {
            PG8_LDB(B0, 0, 0); PG8_LDB(B1, 0, 1); PG8_SCHED; PG8_LDA(At, 0, 0); PG8_STAGE(PG8_SA(1, 1), a1, voffA[1]); PG8_NEXT_H1();
            PG8_WAIT_V(8); PG8_WAIT_L(0); PG8_BAR; PG8_MMA(0, 0, At, B0); PG8_MMA(0, 1, At, B1); PG8_BAR; PG8_SCHED;
            PG8_LDA(At, 0, 1); PG8_STAGE(PG8_SB(0, 0), b2, voffB); PG8_STAGE(PG8_SB(0, 1), b2 + hstep, voffB); PG8_STAGE(PG8_SA(0, 0), a2, voffA[0]);
            PG8_WAIT_V(8); PG8_WAIT_L(0); PG8_BAR; PG8_MMA(1, 0, At, B0); PG8_MMA(1, 1, At, B1); PG8_BAR; PG8_SCHED;
            PG8_LDB(B0, 1, 0); PG8_LDB(B1, 1, 1); PG8_SCHED; PG8_LDA(At, 1, 0); PG8_STAGE(PG8_SA(0, 1), a2, voffA[1]);
            PG8_WAIT_V(8); PG8_WAIT_L(0); PG8_BAR; PG8_MMA(0, 0, At, B0); PG8_MMA(0, 1, At, B1); PG8_BAR; PG8_SCHED;
            PG8_LDA(At, 1, 1); PG8_STAGE(PG8_SB(1, 0), b3, voffB); PG8_STAGE(PG8_SB(1, 1), b3 + hstep, voffB); PG8_STAGE(PG8_SA(1, 0), a3, voffA[0]);
            PG8_WAIT_V(8); PG8_WAIT_L(0); PG8_BAR; PG8_MMA(1, 0, At, B0); PG8_MMA(1, 1, At, B1); PG8_BAR; PG8_SCHED;
            } else {
            PG8_LDB(B0, 0, 0); PG8_SCHED; PG8_LDA(At, 0, 0); PG8_STAGE(PG8_SA(1, 1), a1, voffA[1]); PG8_NEXT_H1();
            PG8_WAIT_L(8); PG8_BAR; PG8_WAIT_L(0); PG8_MMA(0, 0, At, B0); PG8_BAR; PG8_SCHED;
            PG8_LDB(B1, 0, 1); PG8_STAGE(PG8_SB(0, 0), b2, voffB);
            PG8_BAR; PG8_WAIT_L(0); PG8_MMA(0, 1, At, B1); PG8_BAR;
            PG8_LDA(At, 0, 1); PG8_STAGE(PG8_SA(0, 0), a2, voffA[0]);
            PG8_BAR; PG8_WAIT_L(0); PG8_MMA(1, 0, At, B0); PG8_BAR; PG8_SCHED;
            PG8_STAGE(PG8_SB(0, 1), b2 + hstep, voffB);
            PG8_WAIT_V(6); PG8_BAR; PG8_MMA(1, 1, At, B1); PG8_BAR;
            PG8_LDB(B0, 1, 0); PG8_SCHED; PG8_LDA(At, 1, 0); PG8_STAGE(PG8_SA(0, 1), a2, voffA[1]);
            PG8_WAIT_L(8); PG8_BAR; PG8_WAIT_L(0); PG8_MMA(0, 0, At, B0); PG8_BAR; PG8_SCHED;
            PG8_LDB(B1, 1, 1); PG8_STAGE(PG8_SB(1, 0), b3, voffB);
            PG8_BAR; PG8_WAIT_L(0); PG8_MMA(0, 1, At, B1); PG8_BAR;
            PG8_LDA(At, 1, 1); PG8_STAGE(PG8_SA(1, 0), a3, voffA[0]);
            PG8_BAR; PG8_WAIT_L(0); PG8_MMA(1, 0, At, B0); PG8_BAR; PG8_SCHED;
            PG8_STAGE(PG8_SB(1, 1), b3 + hstep, voffB);
            PG8_WAIT_V(6); PG8_BAR; PG8_MMA(1, 1, At, B1); PG8_BAR;
            }
        }
        if constexpr (ALIGN_EPI) { if (wr == 0) PG8_BAR; }
        if constexpr (Epi::ROWAUX) E(acc, cur, wr, wc, fr, fq, idxlds + (ui % 3) * 256); else E(acc, cur, wr, wc, fr, fq);
        if (!has_next) break;
#pragma unroll
        for (int a = 0; a < 2; ++a)
#pragma unroll
            for (int b = 0; b < 2; ++b)
#pragma unroll
                for (int m = 0; m < 4; ++m)
#pragma unroll
                    for (int n = 0; n < 2; ++n) acc[a][b][m][n] = (f32x4){0.f, 0.f, 0.f, 0.f};
        cur = nxt; cA = nA; cB = nB; ++ui;
        if constexpr (ALIGN_EPI) { if (wr == 1) PG8_BAR; }
    }
    PG8_WAIT_V(0);
    if constexpr (!ALIGN_EPI) { if (wr == 0) PG8_BAR; }
    PG8_BAR;
#undef PG8_SA
#undef PG8_SB
#undef PG8_STAGE
#undef PG8_LDA
#undef PG8_LDB
#undef PG8_MMA
#undef PG8_WAIT_V
#undef PG8_WAIT_L
#undef PG8_BAR
#undef PG8_SCHED
#undef PG8_IDX_ISSUE
#undef PG8_IDX_READ
#undef PG8_NEXT_H1
}
}
constexpr int T_ = 16384, D_ = 1024, NB_ = 4, S_ = 4096, NEXP = 64, TOPK = 8;
constexpr int ECAP = 16384;
constexpr int PMAX = 163840;
constexpr float LN_EPS = 1e-5f, RMS_EPS = 1e-6f;
constexpr float ALPHA_DN = 1.6817928305074290f;
constexpr float QSCALE = 0.125f * 1.4426950408889634f;

namespace pg8 {
constexpr int NXCD = 8, WGM = 8;
struct DenseOrder {
    static constexpr bool GATHER = false;
    unsigned A, Bt; int K; int nM, nN, nwg, G, c; unsigned idxoff; static constexpr int padrow = 0;
    DI void init(size_t A_, size_t Bt_, int M, int N, int K_, int G_, int c_) { A = (unsigned)A_; Bt = (unsigned)Bt_; K = K_; nM = M / BM; nN = N / BM; nwg = nM * nN; G = G_; c = c_; idxoff = 0u; }
    DI bool next(int i, Unit& u) const {
        const long L = (long)i * G + c; if (L >= nwg) return false;
        int wgid = (int)L; { const int q = nwg / NXCD, r = nwg % NXCD, xcd = wgid % NXCD, off = wgid / NXCD; wgid = (xcd < r ? xcd * (q + 1) : r * (q + 1) + (xcd - r) * q) + off; }
        const int nig = WGM * nN, gid = wgid / nig, fm = gid * WGM, gsz = (nM - fm) < WGM ? (nM - fm) : WGM;
        const int pm = fm + ((wgid % nig) % gsz), pn = (wgid % nig) / gsz;
        u.a = A + (unsigned)(pm * BM * K * 2); u.b = Bt + (unsigned)(pn * BM * K * 2); u.r0 = pm * BM; u.c0 = pn * BM; u.e = 0; u.rb = 0; u.nv = BM; return true;
    }
};
template <bool GATH> struct MoeOrder {
    static constexpr bool GATHER = GATH;
    unsigned A, Bt; int K; int nct_log, nunits, G, c; unsigned idxoff; const LAS int* tileoff; const LAS int* ecnt; unsigned bstride; static constexpr int padrow = T_;
    DI bool next(int i, Unit& u) const {
        const long L = (long)i * G + c; if (L >= nunits) return false;
        int wgid = (int)L; { const int q = nunits / NXCD, r = nunits % NXCD, xcd = wgid % NXCD, off = wgid / NXCD; wgid = (xcd < r ? xcd * (q + 1) : r * (q + 1) + (xcd - r) * q) + off; }
        const int tile = wgid >> nct_log, pn = wgid & ((1 << nct_log) - 1);
        int e = 0;
#pragma unroll 1
        for (int j = 32; j >= 1; j >>= 1) { const int cand = e + j; if (tileoff[cand] <= tile) e = cand; }
        if (e < NEXP && tileoff[e + 1] <= tile) e += 1;
        e = __builtin_amdgcn_readfirstlane(e);
        u.e = e; u.r0 = tile * BM; u.c0 = pn * BM;
        { const int ti = tile - __builtin_amdgcn_readfirstlane(tileoff[e]); u.rb = e * ECAP + ti * BM; u.nv = __builtin_amdgcn_readfirstlane(ecnt[e]) - ti * BM; }
        u.a = GATH ? A : A + (unsigned)(tile * BM * K * 2);
        u.b = Bt + (unsigned)e * bstride + (unsigned)(pn * BM * K * 2);
        return true;
    }
};

struct EpiF32 {
    static constexpr bool PERM = false, ROWAUX = false;
    float* C; int ldc;
    DI void operator()(const f32x4 (&acc)[2][2][4][2], const Unit& u, int wr, int wc, int fr, int fq) const {
        const int row0 = u.r0 + wr * 64 + fr, col0 = u.c0 + wc * 32 + 4 * fq;
#pragma unroll
        for (int ai = 0; ai < 2; ++ai)
#pragma unroll
            for (int m = 0; m < 4; ++m) { float* rowp = C + (size_t)(row0 + ai * HALF + m * 16) * ldc + col0;
#pragma unroll
                for (int bj = 0; bj < 2; ++bj)
#pragma unroll
                    for (int n = 0; n < 2; ++n) *(f32x4*)(rowp + bj * HALF + n * 16) = acc[ai][bj][m][n]; }
    }
};
struct EpiBf16 {
    static constexpr bool PERM = true, ROWAUX = false;
    bf16* O; int ldc;
    DI void operator()(const f32x4 (&acc)[2][2][4][2], const Unit& u, int wr, int wc, int fr, int fq) const {
        const int row0 = u.r0 + wr * 64 + fr, col0 = u.c0 + wc * 32 + 8 * fq;
#pragma unroll
        for (int ai = 0; ai < 2; ++ai)
#pragma unroll
            for (int m = 0; m < 4; ++m) { bf16* rowp = O + (size_t)(row0 + ai * HALF + m * 16) * ldc + col0;
#pragma unroll
                for (int bj = 0; bj < 2; ++bj) { const f32x4 v0 = acc[ai][bj][m][0], v1 = acc[ai][bj][m][1];
                    u32x4 w; w.x = cvtpk(v0[0], v0[1]); w.y = cvtpk(v0[2], v0[3]); w.z = cvtpk(v1[0], v1[1]); w.w = cvtpk(v1[2], v1[3]);
                    *(u32x4*)(rowp + bj * HALF) = w; } }
    }
};
struct EpiQKV {
    static constexpr bool PERM = true, ROWAUX = false;
    bf16* QKV; const float* COS; const float* SIN;
    DI void operator()(const f32x4 (&acc)[2][2][4][2], const Unit& u, int wr, int wc, int fr, int fq) const {
        const int pn = u.c0 >> 8, g = pn / 12, which = (pn >> 2) % 3, hq = pn & 3;
        const int ldil = 2 * g, dil = 1 << ldil;
        const int idx = 4 * (wc & 1) + fq, b = u.r0 >> 12;
        const int row0 = u.r0 + wr * 64 + fr;
#pragma unroll
        for (int ai = 0; ai < 2; ++ai)
#pragma unroll
            for (int m = 0; m < 4; ++m) {
                const int r = row0 + ai * HALF + m * 16, t = r & (S_ - 1);
                const int prow = (t & (dil - 1)) * (S_ >> ldil) + (t >> ldil);
                f32x4 c4 = (f32x4){1.f, 1.f, 1.f, 1.f}, s4 = (f32x4){0.f, 0.f, 0.f, 0.f};
                if (which < 2) { c4 = *(const f32x4*)(COS + (size_t)r * 32 + 4 * idx); s4 = *(const f32x4*)(SIN + (size_t)r * 32 + 4 * idx); }
#pragma unroll
                for (int bj = 0; bj < 2; ++bj) {
                    const int head = 4 * hq + 2 * bj + (wc >> 1);
                    const f32x4 v0 = acc[ai][bj][m][0], v1 = acc[ai][bj][m][1];
                    f32x4 o0 = v0 * c4 - v1 * s4, o1 = v1 * c4 + v0 * s4;
                    if (which == 0) { o0 = o0 * QSCALE; o1 = o1 * QSCALE; }
                    u32x4 w; w.x = cvtpk(o0[0], o0[1]); w.y = cvtpk(o0[2], o0[3]); w.z = cvtpk(o1[0], o1[1]); w.w = cvtpk(o1[2], o1[3]);
                    bf16* dst = QKV + ((((size_t)(which * 3 + g) * NB_ + b) * 16 + head) * S_ + prow) * 64 + 8 * idx;
                    *(u32x4*)dst = w;
                }
            }
    }
};
struct EpiSwiGLU {
    static constexpr bool PERM = true, ROWAUX = false;
    bf16* HID;
    DI void operator()(const f32x4 (&acc)[2][2][4][2], const Unit& u, int wr, int wc, int fr, int fq) const {
        const int row0 = u.r0 + wr * 64 + fr, col0 = (u.c0 >> 1) + wc * 32 + 8 * fq;
#pragma unroll
        for (int ai = 0; ai < 2; ++ai)
#pragma unroll
            for (int m = 0; m < 4; ++m) {
                float hv[8];
#pragma unroll
                for (int n = 0; n < 2; ++n)
#pragma unroll
                    for (int j = 0; j < 4; ++j) { const float a = acc[ai][0][m][n][j], bb = acc[ai][1][m][n][j]; hv[4 * n + j] = silu_f(a) * bb; }
                u32x4 w; w.x = cvtpk(hv[0], hv[1]); w.y = cvtpk(hv[2], hv[3]); w.z = cvtpk(hv[4], hv[5]); w.w = cvtpk(hv[6], hv[7]);
                *(u32x4*)(HID + (size_t)(row0 + ai * HALF + m * 16) * 256 + col0) = w;
            }
    }
};
constexpr size_t YS_OFF = (size_t)160 << 20;
struct EpiScale {
    static constexpr bool PERM = true, ROWAUX = true;
    unsigned char* YE;
    int s0;
    DI void operator()(const f32x4 (&acc)[2][2][4][2], const Unit& u, int wr, int wc, int fr, int fq, const LAS int* aux) const {
        const int row0 = wr * 64 + fr, col0 = u.c0 + wc * 32 + 8 * fq;
        if (u.e == NEXP) {
            bf16* base = (bf16*)pg8::rfl_ptr((const char*)(YE + YS_OFF) + (size_t)(u.r0 - s0) * (D_ * 2));
#pragma unroll
            for (int ai = 0; ai < 2; ++ai)
#pragma unroll
                for (int m = 0; m < 4; ++m) { const unsigned ro = (unsigned)((row0 + ai * HALF + m * 16) * D_ + col0) * 2u;
#pragma unroll
                    for (int bj = 0; bj < 2; ++bj) { const f32x4 v0 = acc[ai][bj][m][0], v1 = acc[ai][bj][m][1];
                        u32x4 w; w.x = cvtpk(v0[0], v0[1]); w.y = cvtpk(v0[2], v0[3]); w.z = cvtpk(v1[0], v1[1]); w.w = cvtpk(v1[2], v1[3]);
                        *(u32x4*)((char*)base + ro + bj * HALF * 2) = w; } }
        } else {
            unsigned char* base = (unsigned char*)pg8::rfl_ptr((const char*)YE + (size_t)u.r0 * D_);
#pragma unroll
            for (int ai = 0; ai < 2; ++ai)
#pragma unroll
                for (int m = 0; m < 4; ++m) { const int rl = row0 + ai * HALF + m * 16; const float wgt = __builtin_bit_cast(float, aux[rl]) * YE_SCALE; const unsigned ro = (unsigned)(rl * D_ + col0);
#pragma unroll
                    for (int bj = 0; bj < 2; ++bj) { const f32x4 v0 = acc[ai][bj][m][0] * wgt, v1 = acc[ai][bj][m][1] * wgt;
                        u32x2 w; w.x = cvtpk_fp8(v0[0], v0[1], v0[2], v0[3]); w.y = cvtpk_fp8(v1[0], v1[1], v1[2], v1[3]);
                        *(u32x2*)(base + ro + bj * HALF) = w; } }
        }
    }
};
}
constexpr size_t MiB = 1u << 20;
constexpr size_t WS_CTL = 0, CTL_ZERO_BYTES = 1 * MiB;
constexpr size_t WS_MOD = 1 * MiB;
constexpr size_t WS_COS = 2 * MiB;
constexpr size_t WS_SIN = 4 * MiB;
constexpr size_t WS_ASG_E = 6 * MiB;
constexpr size_t WS_ASG_R = 6 * MiB + 512 * 1024;
constexpr size_t WS_ASG_W = 7 * MiB;
constexpr size_t WS_ASG_ROW = 7 * MiB + 512 * 1024;
constexpr size_t WS_ROWTOK = 8 * MiB;
constexpr size_t WS_ROWW = 9 * MiB;
constexpr size_t WS_AB = 10 * MiB;
constexpr size_t WS_GALPHA = 11 * MiB;
constexpr size_t WS_GBETA = 11 * MiB + 512 * 1024;
constexpr size_t WS_X = 12 * MiB;
constexpr size_t WS_Y = 76 * MiB;
constexpr size_t WS_H = 140 * MiB;
constexpr size_t WS_O = 173 * MiB;
constexpr size_t WS_WA_IN = 205 * MiB;
constexpr size_t WS_WA_OUT = 241 * MiB;
constexpr size_t WS_WG_IN = 245 * MiB;
constexpr size_t WS_WG_OUT = 261 * MiB;
constexpr size_t WS_WE1 = 265 * MiB;
constexpr size_t WS_WE2 = 330 * MiB;
constexpr size_t WS_HID = 363 * MiB;
constexpr size_t WS_BIG = 443 * MiB;
constexpr size_t WS_YS_OFF = pg8::YS_OFF;
constexpr size_t WS_WEB = WS_BIG + 368 * MiB;
constexpr size_t WS_WRF = WS_BIG + 466 * MiB;
constexpr size_t WS_WABF = WS_WRF + 1 * MiB;
constexpr size_t WS_ETOK = WS_WABF + 1 * MiB;
constexpr size_t WS_EW = WS_ETOK + 5 * MiB;
constexpr size_t WS_END = WS_EW + 5 * MiB;
constexpr size_t BIG_PROJ = 0, BIG_QN = 128 * MiB, BIG_KN = 192 * MiB, BIG_VV = 256 * MiB, BIG_ORAW = 320 * MiB;
constexpr int CW_BAR = 4096;
constexpr int CW_CNT = 16384;
constexpr int RING_BYTES = 131072;
constexpr int LDS_IDX = RING_BYTES;
constexpr int LDS_TILEOFF = LDS_IDX + 3072;
constexpr int LDS_LCNT = LDS_TILEOFF + 512;
constexpr int LDS_LBASE = LDS_LCNT + 256;
constexpr int LDS_LASG = LDS_LBASE + 256;
constexpr int LDS_ECNT = LDS_LASG;
constexpr int LDS_LW = LDS_IDX;
constexpr int LDS_MISC = LDS_LASG + 2048;
constexpr int LDS_LG = LDS_MISC + 128;
constexpr int LDS_BYTES = 147456;
static_assert(LDS_LG + 8192 <= LDS_BYTES, "LDS map");
constexpr int NWAVES = 8, NTHR = 512;

#define XB_TMO      128
#define XB_XCNT(j)  (256  + 64 * (j))
#define XB_XSUB(j)  (1280 + 64 * (j))
#define XB_XGEN(j)  (2304 + 64 * (j))
#define XB_TOP      3328
#define XB_TOPGEN   3392
#define XCD_BAR_WORDS 3456
#define XB_SPIN_CAP (1u << 18)
__device__ __forceinline__ unsigned xb_ld(unsigned* p)              { return __hip_atomic_load(p, __ATOMIC_RELAXED, __HIP_MEMORY_SCOPE_AGENT); }
__device__ __forceinline__ unsigned xb_add(unsigned* p, unsigned v) { return __hip_atomic_fetch_add(p, v, __ATOMIC_RELAXED, __HIP_MEMORY_SCOPE_AGENT); }
__device__ __forceinline__ unsigned xb_xcc_id() { return (unsigned)__builtin_amdgcn_s_getreg((3 << 11) | 20) & 0xFu; }
#define XB_SPIN(cond, bar) do { unsigned _sp = 0; while (cond) { __builtin_amdgcn_s_sleep(1); \
    if ((++_sp & 255u) == 0u) { if (xb_ld(&(bar)[XB_TMO])) break; if (_sp > XB_SPIN_CAP) { atomicAdd(&(bar)[XB_TMO], 1u); break; } } } } while (0)
struct XcdBarrier { unsigned* bar; unsigned x; volatile LAS unsigned* st; };
__device__ __forceinline__ XcdBarrier xcd_barrier_post(unsigned* bar, volatile LAS unsigned* st) {
    XcdBarrier b; b.bar = bar; b.x = xb_xcc_id(); b.st = st;
    if (threadIdx.x == 0) (void)xb_add(&bar[XB_XCNT(b.x)], 1u);
    return b;
}
__device__ __forceinline__ void xcd_barrier_complete(unsigned* bar, unsigned x, unsigned& nloc, unsigned& nx) {
    const unsigned G = gridDim.x * gridDim.y * gridDim.z;
    unsigned sum, cnt, mine, sp = 0u;
    for (;;) {
        sum = 0u; cnt = 0u; mine = 0u;
#pragma unroll
        for (unsigned j = 0; j < 16; ++j) { const unsigned c = xb_ld(&bar[XB_XCNT(j)]); sum += c; cnt += (c > 0u) ? 1u : 0u; mine = (j == x) ? c : mine; }
        if (sum == G) break;
        __builtin_amdgcn_s_sleep(1);
        if ((++sp & 255u) == 0u) { if (xb_ld(&bar[XB_TMO])) break; if (sp > XB_SPIN_CAP) { atomicAdd(&bar[XB_TMO], 1u); break; } }
    }
    nloc = mine > 0u ? mine : 1u; nx = cnt > 0u ? cnt : 1u;
}
__device__ __forceinline__ void xcd_barrier(const XcdBarrier& b, const int tid) {
    asm volatile("s_waitcnt vmcnt(0)" ::: "memory");
    __syncthreads();
    if (tid == 0) {
        unsigned* bar = b.bar;
        __builtin_amdgcn_s_waitcnt(0);
        unsigned nloc = b.st[0], nx = b.st[1];
        if (nloc == 0u) { xcd_barrier_complete(bar, b.x, nloc, nx); b.st[0] = nloc; b.st[1] = nx; }
        const unsigned old = xb_add(&bar[XB_XSUB(b.x)], 1u);
        const unsigned gen = old / nloc;
        if (old + 1u == (gen + 1u) * nloc) {
            __builtin_amdgcn_fence(__ATOMIC_RELEASE, "agent");
            asm volatile("s_waitcnt vmcnt(0)" ::: "memory");
            const unsigned og = xb_add(&bar[XB_TOP], 1u);
            const unsigned tg = og / nx;
            if (og + 1u == (tg + 1u) * nx) xb_add(&bar[XB_TOPGEN], 1u);
            else XB_SPIN(xb_ld(&bar[XB_TOPGEN]) == tg, bar);
            __builtin_amdgcn_fence(__ATOMIC_ACQUIRE, "agent");
            xb_add(&bar[XB_XGEN(b.x)], 1u);
            asm volatile("s_waitcnt vmcnt(0)" ::: "memory");
        } else {
            XB_SPIN(xb_ld(&bar[XB_XGEN(b.x)]) == gen, bar);
            __builtin_amdgcn_fence(__ATOMIC_ACQUIRE, "agent");
            asm volatile("s_waitcnt vmcnt(0)" ::: "memory");
        }
    }
    __syncthreads();
}

struct Args {
    const float* x; const float* c; const int* pos; const float* ada_w; const float* ada_b; const float* ln_g; const float* ln_b;
    const float* attn_w_in; const float* attn_w_out; const float* gdn_w_in; const float* gdn_conv_w; const float* gdn_a_log; const float* gdn_dt_bias;
    const float* gdn_norm_w; const float* gdn_w_out; const float* router_w; const float* router_bias; const float* ew1; const float* ew3; const float* ew2;
    const float* sw1; const float* sw3; const float* sw2;
    float* out; unsigned char* ws; int ph_lo, ph_hi;
};
typedef __attribute__((address_space(1))) unsigned char gas_u8;
DI unsigned char* opq(unsigned char* p) { gas_u8* g = (gas_u8*)p; asm volatile("" : "+s"(g)); return (unsigned char*)g; }
template <class T> DI T* asg(T* p) { typedef __attribute__((address_space(1))) T gT; return (T*)(gT*)p; }
struct Frame {
    LAS unsigned char* lds;
    int tid, lane, wave, G, bid;
};
template <class Map> DI void transpose_item(const float* W, int ldn, int K, bf16* WT, const Map& map, LAS float* scr, int kb, int nb, int lane) {
    const int k0 = 64 * kb, n0 = 32 * nb;
    float tv[32];
#pragma unroll
    for (int i = 0; i < 32; ++i) tv[i] = __builtin_nontemporal_load(&W[(size_t)(k0 + 2 * i + (lane >> 5)) * ldn + n0 + (lane & 31)]);
#pragma unroll
    for (int i = 0; i < 32; ++i) scr[(2 * i + (lane >> 5)) * 33 + (lane & 31)] = tv[i];
    LDS_WAIT(); asm volatile("" ::: "memory");
    const int c = lane & 7;
#pragma unroll
    for (int j = 0; j < 4; ++j) { const int n = (lane >> 3) + 8 * j; const LAS float* s = scr + (8 * c) * 33 + n;
        u32x4 o; o.x = cvtpk(s[0 * 33], s[1 * 33]); o.y = cvtpk(s[2 * 33], s[3 * 33]); o.z = cvtpk(s[4 * 33], s[5 * 33]); o.w = cvtpk(s[6 * 33], s[7 * 33]);
        __builtin_nontemporal_store(o, (u32x4*)(WT + (size_t)map(n0 + n) * K + k0 + 8 * c)); }
    LDS_WAIT(); asm volatile("" ::: "memory");
}
struct MapId { int off; DI int operator()(int n) const { return off + n; } };
struct MapQKV { DI int operator()(int n) const {
    const int which = (n >> 10) % 3; if (which == 2) return n;
    const int d = n & 63, idx = (d & 31) >> 2, lo = d & 3, hi = d >> 5; return (n & ~63) + 8 * idx + 4 * hi + lo; } };
struct MapW13 { int second; DI int operator()(int n) const { return (n >> 7) * 256 + second * 128 + (n & 127); } };
template <class Map> DI void convert_matrix(const Frame& F, const float* W, int ldn, int K, int N, bf16* WT, const Map& map) {
    LAS float* scr = (LAS float*)(F.lds + F.wave * 16384);
    const int gw = F.bid * NWAVES + F.wave, NGW = F.G * NWAVES, nblk = N / 32, nitems = (K / 64) * nblk;
    for (int it = gw; it < nitems; it += NGW) transpose_item(W, ldn, K, WT, map, scr, it / nblk, it % nblk, F.lane);
}

DI void prologue_phase(const Frame& F, const Args& A) {
    unsigned char* ws = opq(A.ws);
    {
        LAS float* red = (LAS float*)F.lds;
        float* MOD = (float*)(ws + WS_MOD);
        for (int item = F.bid; item < 8 * 48; item += F.G) {
            const int ls = item / 48, n = (item % 48) * 64 + F.lane;
            const float* w = A.ada_w + ((size_t)ls * D_ + F.wave * 128) * 3072 + n;
            const float* cc = A.c + F.wave * 128;
            float a0 = 0.f, a1 = 0.f, a2 = 0.f, a3 = 0.f;
#pragma unroll 8
            for (int k = 0; k < 128; ++k) { const float wv = __builtin_nontemporal_load(&w[(size_t)k * 3072]); a0 += cc[k] * wv; a1 += cc[D_ + k] * wv; a2 += cc[2 * D_ + k] * wv; a3 += cc[3 * D_ + k] * wv; }
            red[(F.wave * 4 + 0) * 64 + F.lane] = a0; red[(F.wave * 4 + 1) * 64 + F.lane] = a1; red[(F.wave * 4 + 2) * 64 + F.lane] = a2; red[(F.wave * 4 + 3) * 64 + F.lane] = a3;
            __syncthreads();
            if (F.wave < 4) { float s = A.ada_b[ls * 3072 + n];
#pragma unroll
                for (int w8 = 0; w8 < 8; ++w8) s += red[(w8 * 4 + F.wave) * 64 + F.lane];
                MOD[((size_t)ls * 4 + F.wave) * 3072 + n] = s; }
            __syncthreads();
        }
    }
    {
        float* COS = (float*)(ws + WS_COS); float* SIN = (float*)(ws + WS_SIN);
        for (int idx = F.bid * NTHR + F.tid; idx < T_ * 32; idx += F.G * NTHR) {
            const int t = idx >> 5, i = idx & 31;
            const float inv = powf(10000.0f, -(float)i / 32.0f);
            const float ang = (float)A.pos[t] * inv;
            COS[idx] = cosf(ang); SIN[idx] = sinf(ang);
        }
    }
    {
        bf16* WRF = (bf16*)(ws + WS_WRF); bf16* WABF = (bf16*)(ws + WS_WABF);
        for (int idx = F.bid * NTHR + F.tid; idx < 4 * 4 * 32 * 64 * 8; idx += F.G * NTHR) {
            const int jx = idx & 7, ln = (idx >> 3) & 63, ks = (idx >> 9) & 31, nt = (idx >> 14) & 3, layer = idx >> 16;
            const int d = 32 * ks + 8 * (ln >> 4) + jx, e = 16 * nt + (ln & 15);
            const float wv = A.router_w[((size_t)layer * D_ + d) * NEXP + e];
            const unsigned hi = cvtpk(wv, 0.f) & 0xffffu; const float res = wv - bf_lo(hi);
            const size_t o = (size_t)layer * 2 * 65536 + (idx & 65535);
            WRF[o] = (bf16)hi; WRF[o + 65536] = (bf16)(cvtpk(res, 0.f) & 0xffffu);
        }
        for (int idx = F.bid * NTHR + F.tid; idx < 2 * 32 * 64 * 8; idx += F.G * NTHR) {
            const int jx = idx & 7, ln = (idx >> 3) & 63, ks = (idx >> 9) & 31, jl = idx >> 14;
            const int d = 32 * ks + 8 * (ln >> 4) + jx, e = ln & 15;
            const float wv = A.gdn_w_in[((size_t)jl * D_ + d) * 4112 + 4096 + e];
            const unsigned hi = cvtpk(wv, 0.f) & 0xffffu; const float res = wv - bf_lo(hi);
            const size_t o = (size_t)jl * 2 * 16384 + (idx & 16383);
            WABF[o] = (bf16)hi; WABF[o + 16384] = (bf16)(cvtpk(res, 0.f) & 0xffffu);
        }
    }
    if (F.bid == 0) { bf16* H = (bf16*)(ws + WS_H); for (int cidx = F.tid; cidx < D_; cidx += NTHR) H[(size_t)T_ * D_ + cidx] = 0; }
    for (int j = 0; j < 2; ++j) {
        convert_matrix(F, A.attn_w_in + (size_t)j * D_ * 9216, 9216, D_, 9216, (bf16*)(ws + WS_WA_IN) + (size_t)j * 9216 * D_, MapQKV{});
        convert_matrix(F, A.attn_w_out + (size_t)j * D_ * D_, D_, D_, D_, (bf16*)(ws + WS_WA_OUT) + (size_t)j * D_ * D_, MapId{0});
        convert_matrix(F, A.gdn_w_in + (size_t)j * D_ * 4112, 4112, D_, 4096, (bf16*)(ws + WS_WG_IN) + (size_t)j * 4096 * D_, MapId{0});
        convert_matrix(F, A.gdn_w_out + (size_t)j * D_ * D_, D_, D_, D_, (bf16*)(ws + WS_WG_OUT) + (size_t)j * D_ * D_, MapId{0});
    }
}
struct XItem { const float* src; bf16* dst; int ldn, K, mode, n0; };
DI XItem xi_decode(const Args& A, int layer, bf16* WE1, bf16* WE2, int it) {
    constexpr int I13 = (D_ / 64) * (256 / 32), I2 = (256 / 64) * (D_ / 32), IPE = 2 * I13 + I2;
    const int e = it / IPE; int r = it % IPE; XItem x;
    if (r < 2 * I13) { const int second = r >= I13 ? 1 : 0; r -= second * I13; const int kb = r >> 3, nb = r & 7;
        const float* w = second ? (e < 64 ? A.ew3 + ((size_t)layer * 64 + e) * D_ * 256 : A.sw3 + (size_t)layer * D_ * 256) : (e < 64 ? A.ew1 + ((size_t)layer * 64 + e) * D_ * 256 : A.sw1 + (size_t)layer * D_ * 256);
        x.src = w + (size_t)(64 * kb) * 256 + 32 * nb; x.ldn = 256; x.K = D_; x.mode = 1 + second; x.n0 = 32 * nb; x.dst = WE1 + (size_t)e * 512 * D_ + 64 * kb;
    } else { r -= 2 * I13; const int kb = r >> 5, nb = r & 31;
        const float* w = e < 64 ? A.ew2 + ((size_t)layer * 64 + e) * 256 * D_ : A.sw2 + (size_t)layer * 256 * D_;
        x.src = w + (size_t)(64 * kb) * D_ + 32 * nb; x.ldn = D_; x.K = 256; x.mode = 0; x.n0 = 32 * nb; x.dst = WE2 + (size_t)e * D_ * 256 + 64 * kb; }
    return x;
}
#define XI_LOAD(buf, XT) do { const char* _b = pg8::rfl_ptr((const char*)(XT).src); const unsigned _ro = (unsigned)((XT).ldn * 4); \
    _Pragma("unroll") for (int _i = 0; _i < 8; ++_i) buf[_i] = __builtin_nontemporal_load((const f32x4*)(_b + ((unsigned)(8 * _i + (lane >> 3)) * _ro + (unsigned)(lane & 7) * 16u))); } while (0)
#define XI_PUT(buf, XT) do { \
    _Pragma("unroll") for (int _i = 0; _i < 8; ++_i) _Pragma("unroll") for (int _e = 0; _e < 4; ++_e) scr[(8 * _i + (lane >> 3)) * 33 + 4 * (lane & 7) + _e] = buf[_i][_e]; \
    LDS_WAIT(); asm volatile("" ::: "memory"); \
    const int _c = lane & 7; \
    _Pragma("unroll") for (int _j = 0; _j < 4; ++_j) { const int _n = (XT).n0 + (lane >> 3) + 8 * _j; const LAS float* _s = scr + (8 * _c) * 33 + (lane >> 3) + 8 * _j; \
        const int _row = (XT).mode == 0 ? _n : (_n >> 7) * 256 + ((XT).mode - 1) * 128 + (_n & 127); \
        u32x4 _o; _o.x = cvtpk(_s[0 * 33], _s[1 * 33]); _o.y = cvtpk(_s[2 * 33], _s[3 * 33]); _o.z = cvtpk(_s[4 * 33], _s[5 * 33]); _o.w = cvtpk(_s[6 * 33], _s[7 * 33]); \
        __builtin_nontemporal_store(_o, (u32x4*)((XT).dst + (size_t)_row * (XT).K + 8 * _c)); } \
    LDS_WAIT(); asm volatile("" ::: "memory"); } while (0)
DI void convert_experts(const Frame& F, const Args& A, int layer, int set, int wg0, int nwg) {
    if (F.bid < wg0 || F.bid >= wg0 + nwg) return;
    unsigned char* ws = opq(A.ws);
    LAS float* scr = (LAS float*)(F.lds + F.wave * 16384);
    bf16* WE1 = (bf16*)(ws + (set ? WS_WEB : WS_WE1)); bf16* WE2 = (bf16*)(ws + (set ? WS_WEB + 65 * MiB : WS_WE2));
    const int gw = (F.bid - wg0) * NWAVES + F.wave, NGW = nwg * NWAVES, lane = F.lane;
    constexpr int NIT = 65 * 384;
    f32x4 ba[8], bb[8];
    int it = gw;
    if (it >= NIT) return;
    XItem xa = xi_decode(A, layer, WE1, WE2, it), xb = xa;
    XI_LOAD(ba, xa);
#pragma unroll 1
    for (;;) {
        const bool hb = it + NGW < NIT;
        if (hb) { xb = xi_decode(A, layer, WE1, WE2, it + NGW); XI_LOAD(bb, xb); }
        __builtin_amdgcn_sched_barrier(0);
        XI_PUT(ba, xa);
        if (!hb) break;
        it += NGW;
        const bool ha = it + NGW < NIT;
        if (ha) { xa = xi_decode(A, layer, WE1, WE2, it + NGW); XI_LOAD(ba, xa); }
        __builtin_amdgcn_sched_barrier(0);
        XI_PUT(bb, xb);
        if (!ha) break;
        it += NGW;
    }
}
#undef XI_LOAD
#undef XI_PUT

DI void load_row16(const float* p, int lane, f32x4 (&v)[4]) {
#pragma unroll
    for (int j = 0; j < 4; ++j) v[j] = *(const f32x4*)(p + 4 * lane + 256 * j);
}
DI void store_row16(float* p, int lane, const f32x4 (&v)[4]) {
#pragma unroll
    for (int j = 0; j < 4; ++j) *(f32x4*)(p + 4 * lane + 256 * j) = v[j];
}
DI void store_row16_bf16(bf16* p, int lane, const f32x4 (&v)[4]) {
#pragma unroll
    for (int j = 0; j < 4; ++j) { u32x2 w; w.x = cvtpk(v[j][0], v[j][1]); w.y = cvtpk(v[j][2], v[j][3]); *(u32x2*)(p + 4 * lane + 256 * j) = w; }
}
DI void add_row16_bf16(const bf16* p, int lane, f32x4 (&v)[4]) {
#pragma unroll
    for (int j = 0; j < 4; ++j) { const u32x2 w = *(const u32x2*)(p + 4 * lane + 256 * j); v[j][0] += bf_lo(w.x); v[j][1] += bf_hi(w.x); v[j][2] += bf_lo(w.y); v[j][3] += bf_hi(w.y); }
}
DI void add_row16_fp8(const unsigned char* p, int lane, f32x4 (&v)[4]) {
#pragma unroll
    for (int j = 0; j < 4; ++j) { const int w = *(const int*)(p + 4 * lane + 256 * j);
        const f32x2 a = __builtin_amdgcn_cvt_pk_f32_fp8(w, false), b = __builtin_amdgcn_cvt_pk_f32_fp8(w, true);
        v[j][0] += a[0]; v[j][1] += a[1]; v[j][2] += b[0]; v[j][3] += b[1]; }
}
DI void layer_norm16(f32x4 (&v)[4], const f32x4 (&g)[4], const f32x4 (&b)[4]) {
    float s = 0.f;
#pragma unroll
    for (int j = 0; j < 4; ++j) s += (v[j][0] + v[j][1]) + (v[j][2] + v[j][3]);
    const float mean = wave_sum(s) * (1.0f / D_);
    float q = 0.f;
#pragma unroll
    for (int j = 0; j < 4; ++j) { v[j] = v[j] - mean; q += (v[j][0] * v[j][0] + v[j][1] * v[j][1]) + (v[j][2] * v[j][2] + v[j][3] * v[j][3]); }
    const float rstd = 1.0f / sqrtf(wave_sum(q) * (1.0f / D_) + LN_EPS);
#pragma unroll
    for (int j = 0; j < 4; ++j) v[j] = v[j] * rstd * g[j] + b[j];
}

DI void modx_phase(const Frame& F, const Args& A) {
    unsigned char* ws = opq(A.ws);
    const float* MOD = (const float*)(ws + WS_MOD); bf16* H = (bf16*)(ws + WS_H);
    const int gw = F.bid * NWAVES + F.wave, NGW = F.G * NWAVES;
    for (int row = gw; row < T_; row += NGW) {
        const int b = row >> 12; f32x4 v[4], sc[4], sh[4];
        load_row16(A.x + (size_t)row * D_, F.lane, v); load_row16(MOD + (size_t)(0 * 4 + b) * 3072 + 1024, F.lane, sc); load_row16(MOD + (size_t)(0 * 4 + b) * 3072, F.lane, sh);
#pragma unroll
        for (int j = 0; j < 4; ++j) v[j] = v[j] * (1.0f + sc[j]) + sh[j];
        store_row16_bf16(H + (size_t)row * D_, F.lane, v);
    }
}

DI void build_tileoff(const Frame& F, const unsigned* gcount) {
    LAS int* tileoff = (LAS int*)(F.lds + LDS_TILEOFF);
    __syncthreads();
    if (F.wave == 0) {
        const unsigned cn = __hip_atomic_load(gcount + F.lane, __ATOMIC_RELAXED, __HIP_MEMORY_SCOPE_AGENT);
        const int nt = (int)((cn + 255u) >> 8); int inc = nt;
#pragma unroll
        for (int o = 1; o < 64; o <<= 1) { const int t = __builtin_amdgcn_ds_bpermute((F.lane - o) << 2, inc); if (F.lane >= o) inc += t; }
        tileoff[F.lane] = inc - nt; ((LAS int*)(F.lds + LDS_ECNT))[F.lane] = (int)cn;
        if (F.lane == 63) { tileoff[64] = inc; tileoff[65] = inc + T_ / 256; ((LAS int*)(F.lds + LDS_ECNT))[NEXP] = T_; }
    }
    __syncthreads();
}

DI void deepnorm_row(f32x4 (&v)[4], const f32x4 (&y)[4], const float* gate, const float* lng, const float* lnb, float* xout, const float* mod_shift, int lane) {
    f32x4 t[4];
    load_row16(gate, lane, t);
#pragma unroll
    for (int j = 0; j < 4; ++j) v[j] = ALPHA_DN * v[j] + (1.0f + t[j]) * y[j];
    float s = 0.f;
#pragma unroll
    for (int j = 0; j < 4; ++j) s += (v[j][0] + v[j][1]) + (v[j][2] + v[j][3]);
    const float mean = wave_sum(s) * (1.0f / D_);
    float q = 0.f;
#pragma unroll
    for (int j = 0; j < 4; ++j) { v[j] = v[j] - mean; q += (v[j][0] * v[j][0] + v[j][1] * v[j][1]) + (v[j][2] * v[j][2] + v[j][3] * v[j][3]); }
    const float rstd = 1.0f / sqrtf(wave_sum(q) * (1.0f / D_) + LN_EPS);
    load_row16(lng, lane, t);
#pragma unroll
    for (int j = 0; j < 4; ++j) v[j] = v[j] * rstd * t[j];
    load_row16(lnb, lane, t);
#pragma unroll
    for (int j = 0; j < 4; ++j) v[j] = v[j] + t[j];
    store_row16(xout, lane, v);
    if (mod_shift) {
        load_row16(mod_shift + 1024, lane, t);
#pragma unroll
        for (int j = 0; j < 4; ++j) v[j] = v[j] * (1.0f + t[j]);
        load_row16(mod_shift, lane, t);
#pragma unroll
        for (int j = 0; j < 4; ++j) v[j] = v[j] + t[j];
    }
}
DI void put_hilo(LAS unsigned char* lds, int p, int lane, const f32x4 (&v)[4]) {
#pragma unroll
    for (int j = 0; j < 4; ++j) {
        const int c = 4 * lane + 256 * j;
        const unsigned h0 = cvtpk(v[j][0], v[j][1]), h1 = cvtpk(v[j][2], v[j][3]);
        const unsigned l0 = cvtpk(v[j][0] - bf_lo(h0), v[j][1] - bf_hi(h0)), l1 = cvtpk(v[j][2] - bf_lo(h1), v[j][3] - bf_hi(h1));
        const int off = ((((p >> 4) * 32 + (c >> 5)) * 64 + ((c & 31) >> 3) * 16 + (p & 15)) * 16) + (c & 7) * 2;
        *(LAS u32x2*)(lds + off) = (u32x2){h0, h1}; *(LAS u32x2*)(lds + 65536 + off) = (u32x2){l0, l1};
    }
}
DI f32x4 small_proj(const LAS unsigned char* lds, int mt, int lane, const bf16* wf_hi, const bf16* wf_lo) {
    f32x4 a0 = (f32x4){0.f, 0.f, 0.f, 0.f}, a1 = a0, a2 = a0;
#pragma unroll 8
    for (int ks = 0; ks < 32; ++ks) {
        const bf16x8 ah = *(const LAS bf16x8*)(lds + ((mt * 32 + ks) * 64 + lane) * 16), al = *(const LAS bf16x8*)(lds + 65536 + ((mt * 32 + ks) * 64 + lane) * 16);
        const bf16x8 bh = *(const bf16x8*)(wf_hi + (ks * 64 + lane) * 8), bl = *(const bf16x8*)(wf_lo + (ks * 64 + lane) * 8);
        a0 = __builtin_amdgcn_mfma_f32_16x16x32_bf16(ah, bh, a0, 0, 0, 0); a1 = __builtin_amdgcn_mfma_f32_16x16x32_bf16(ah, bl, a1, 0, 0, 0); a2 = __builtin_amdgcn_mfma_f32_16x16x32_bf16(al, bh, a2, 0, 0, 0);
    }
    return a0 + (a1 + a2);
}
DI void small_proj2(const LAS unsigned char* lds, int kh, int lane, const bf16* wf_hi, const bf16* wf_lo, f32x4& o0, f32x4& o1) {
    f32x4 a[2][3];
#pragma unroll
    for (int mt = 0; mt < 2; ++mt)
#pragma unroll
        for (int e = 0; e < 3; ++e) a[mt][e] = (f32x4){0.f, 0.f, 0.f, 0.f};
#pragma unroll 8
    for (int k = 0; k < 16; ++k) {
        const int ks = 16 * kh + k;
        const bf16x8 bh = *(const bf16x8*)(wf_hi + (ks * 64 + lane) * 8), bl = *(const bf16x8*)(wf_lo + (ks * 64 + lane) * 8);
#pragma unroll
        for (int mt = 0; mt < 2; ++mt) {
            const bf16x8 ah = *(const LAS bf16x8*)(lds + ((mt * 32 + ks) * 64 + lane) * 16), al = *(const LAS bf16x8*)(lds + 65536 + ((mt * 32 + ks) * 64 + lane) * 16);
            a[mt][0] = __builtin_amdgcn_mfma_f32_16x16x32_bf16(ah, bh, a[mt][0], 0, 0, 0); a[mt][1] = __builtin_amdgcn_mfma_f32_16x16x32_bf16(ah, bl, a[mt][1], 0, 0, 0); a[mt][2] = __builtin_amdgcn_mfma_f32_16x16x32_bf16(al, bh, a[mt][2], 0, 0, 0);
        }
    }
    o0 = a[0][0] + (a[0][1] + a[0][2]); o1 = a[1][0] + (a[1][1] + a[1][2]);
}
DI void deepnorm_row_c(f32x4 (&v)[4], const f32x4 (&y)[4], const f32x4 (&cg)[4], const f32x4 (&cng)[4], const f32x4 (&cnb)[4]) {
#pragma unroll
    for (int j = 0; j < 4; ++j) v[j] = ALPHA_DN * v[j] + (1.0f + cg[j]) * y[j];
    float s = 0.f;
#pragma unroll
    for (int j = 0; j < 4; ++j) s += (v[j][0] + v[j][1]) + (v[j][2] + v[j][3]);
    const float mean = wave_sum(s) * (1.0f / D_);
    float q = 0.f;
#pragma unroll
    for (int j = 0; j < 4; ++j) { v[j] = v[j] - mean; q += (v[j][0] * v[j][0] + v[j][1] * v[j][1]) + (v[j][2] * v[j][2] + v[j][3] * v[j][3]); }
    const float rstd = 1.0f / sqrtf(wave_sum(q) * (1.0f / D_) + LN_EPS);
#pragma unroll
    for (int j = 0; j < 4; ++j) v[j] = v[j] * rstd * cng[j] + cnb[j];
}
template <bool L0> DI void ln_router_phase(const Frame& F, const Args& A, int layer, bool dry = false) {
    unsigned char* ws = opq(A.ws);
    const float* MOD = (const float*)(ws + WS_MOD); bf16* X = (bf16*)(ws + WS_X); const float* Y = (const float*)(ws + WS_Y); bf16* H = (bf16*)(ws + WS_H);
    int* asg_e = (int*)(ws + WS_ASG_E); int* asg_r = (int*)(ws + WS_ASG_R); int* etok = (int*)(ws + WS_ETOK); float* egate = (float*)(ws + WS_EW);
    unsigned* gcount = (unsigned*)(ws + WS_CTL) + CW_CNT + layer * 64;
    const int ls0 = layer * 2, ls1 = layer * 2 + 1;
    const bf16* wrf = (const bf16*)(ws + WS_WRF) + (size_t)layer * 2 * 65536 + (size_t)(F.wave & 3) * 32 * 512;
    const float rb = A.router_bias[layer * NEXP + F.lane];
    LAS float* lg = (LAS float*)(F.lds + LDS_LG);
    LAS int* lcnt = (LAS int*)(F.lds + LDS_LCNT); LAS int* lbase = (LAS int*)(F.lds + LDS_LBASE); LAS int* lasg = (LAS int*)(F.lds + LDS_LASG);
    const unsigned l8_ = (unsigned)F.lane * 8u, l16_ = (unsigned)F.lane * 16u;
    u32x2 yb[4][4], xb[L0 ? 1 : 4][4]; f32x4 xf[L0 ? 4 : 1][4];
#define LNR_LOAD(rb_) do { unsigned l8 = l8_, l16 = l16_; asm volatile("" : "+v"(l8), "+v"(l16)); \
        _Pragma("unroll") for (int t = 0; t < 4; ++t) { const int row = (rb_) + t; const char* py = pg8::rfl_ptr((const char*)Y + (size_t)row * (D_ * 2)); \
            if constexpr (L0) { const char* px = pg8::rfl_ptr((const char*)A.x + (size_t)row * (D_ * 4)); _Pragma("unroll") for (int j = 0; j < 4; ++j) xf[t][j] = __builtin_nontemporal_load((const f32x4*)(px + l16 + 1024 * j)); } \
            else { const char* px = pg8::rfl_ptr((const char*)X + (size_t)row * (D_ * 2)); _Pragma("unroll") for (int j = 0; j < 4; ++j) xb[t][j] = __builtin_nontemporal_load((const u32x2*)(px + l8 + 512 * j)); } \
            _Pragma("unroll") for (int j = 0; j < 4; ++j) yb[t][j] = __builtin_nontemporal_load((const u32x2*)(py + l8 + 512 * j)); } } while (0)
    for (int blk = F.bid; blk < T_ / 64; blk += F.G) {
        const int b = blk >> 6;
        const char* gate = pg8::rfl_ptr((const char*)(MOD + (size_t)(ls0 * 4 + b) * 3072 + 2048)); const char* modn = pg8::rfl_ptr((const char*)(MOD + (size_t)(ls1 * 4 + b) * 3072));
        const char* lng = pg8::rfl_ptr((const char*)(A.ln_g + (size_t)ls0 * D_)); const char* lnb = pg8::rfl_ptr((const char*)(A.ln_b + (size_t)ls0 * D_));
        f32x4 cg[4], cng[4], cnb[4], csc[4], csh[4];
#pragma unroll
        for (int j = 0; j < 4; ++j) { cg[j] = *(const f32x4*)(gate + l16_ + 1024 * j); cng[j] = *(const f32x4*)(lng + l16_ + 1024 * j); cnb[j] = *(const f32x4*)(lnb + l16_ + 1024 * j);
            csc[j] = *(const f32x4*)(modn + 4096 + l16_ + 1024 * j); csh[j] = *(const f32x4*)(modn + l16_ + 1024 * j); }
        if constexpr (!L0) { LNR_LOAD(blk * 64 + F.wave * 4); }
        __builtin_amdgcn_sched_barrier(0);
#pragma unroll 1
        for (int ps = 0; ps < 2; ++ps) {
            const int rbase = blk * 64 + ps * 32 + F.wave * 4;
            if constexpr (L0) { LNR_LOAD(rbase); }
            { unsigned l8 = l8_; asm volatile("" : "+v"(l8));
#pragma unroll
              for (int t = 0; t < 4; ++t) { const int row = rbase + t; f32x4 v[4], y[4];
#pragma unroll
                for (int j = 0; j < 4; ++j) { y[j] = (f32x4){bf_lo(yb[t][j].x), bf_hi(yb[t][j].x), bf_lo(yb[t][j].y), bf_hi(yb[t][j].y)};
                    if constexpr (L0) v[j] = xf[t][j]; else v[j] = (f32x4){bf_lo(xb[t][j].x), bf_hi(xb[t][j].x), bf_lo(xb[t][j].y), bf_hi(xb[t][j].y)}; }
                deepnorm_row_c(v, y, cg, cng, cnb);
                char* xp = (char*)pg8::rfl_ptr((const char*)(dry ? (const bf16*)(ws + WS_Y + 32 * MiB) : X) + (size_t)row * (D_ * 2));
                char* hp = (char*)pg8::rfl_ptr((const char*)H + (size_t)row * (D_ * 2));
#pragma unroll
                for (int j = 0; j < 4; ++j) { { u32x2 o; o.x = cvtpk(v[j][0], v[j][1]); o.y = cvtpk(v[j][2], v[j][3]); __builtin_nontemporal_store(o, (u32x2*)(xp + l8 + 512 * j)); }
                    v[j] = v[j] * (1.0f + csc[j]) + csh[j]; u32x2 o; o.x = cvtpk(v[j][0], v[j][1]); o.y = cvtpk(v[j][2], v[j][3]); *(u32x2*)(hp + l8 + 512 * j) = o; }
                put_hilo(F.lds, F.wave * 4 + t, F.lane, v); } }
            if constexpr (!L0) { if (ps == 0) { LNR_LOAD(blk * 64 + 32 + F.wave * 4); } }
            __syncthreads();
            { const int nt = F.wave & 3, kh = F.wave >> 2, r = F.lane & 15, q = F.lane >> 4;
              f32x4 acc0, acc1; small_proj2(F.lds, kh, F.lane, wrf, wrf + 65536, acc0, acc1);
              if (kh == 0) {
#pragma unroll
                  for (int reg = 0; reg < 4; ++reg) { lg[(4 * q + reg) * 64 + 16 * nt + r] = acc0[reg]; lg[(16 + 4 * q + reg) * 64 + 16 * nt + r] = acc1[reg]; } }
              __syncthreads();
              if (kh == 1) {
#pragma unroll
                  for (int reg = 0; reg < 4; ++reg) { lg[(4 * q + reg) * 64 + 16 * nt + r] += acc0[reg]; lg[(16 + 4 * q + reg) * 64 + 16 * nt + r] += acc1[reg]; } } }
            __syncthreads();
#pragma unroll 2
            for (int rr = 0; rr < 4; ++rr) {
                const int row = rbase + rr, rl = ps * 32 + F.wave * 4 + rr;
                int ln = F.lane; asm volatile("" : "+v"(ln));
                const float logit = lg[(F.wave * 4 + rr) * 64 + F.lane];
                const float s = 1.0f / (1.0f + __expf(-logit)); const float bi = s + rb;
                float m1 = bi; m1 = fmaxf(m1, dppmov<0xB1>(m1)); m1 = fmaxf(m1, dppmov<0x4E>(m1)); m1 = fmaxf(m1, dppmov<0x141>(m1));
                const unsigned long long eq = __ballot(bi == m1);
                const int first = __ffs((int)((eq >> (ln & ~7)) & 0xffull)) - 1;
                float m2 = ((ln & 7) == first) ? -INFINITY : bi; m2 = fmaxf(m2, dppmov<0xB1>(m2)); m2 = fmaxf(m2, dppmov<0x4E>(m2)); m2 = fmaxf(m2, dppmov<0x141>(m2));
                const float gs = m1 + m2; int grank = 0;
#pragma unroll
                for (int j = 0; j < 8; ++j) { const float gj = rdlane(gs, 8 * j); grank += ((gj > gs) || (gj == gs && j < (ln >> 3))) ? 1 : 0; }
                const bool gsel = grank < 4;
                float mv = gsel ? bi : -INFINITY; int cnt = -1;
#pragma unroll
                for (int it = 0; it < TOPK; ++it) { const float mx = wave_max(mv); const unsigned long long em = __ballot(mv == mx); const int fl = __ffsll((long long)em) - 1;
                    if (ln == fl) { cnt = it; mv = -INFINITY; } }
                const bool sel = cnt >= 0;
                const float gsum = wave_sum(sel ? s : 0.f);
                if (sel) { const int lr = __hip_atomic_fetch_add(&lcnt[F.lane], 1, __ATOMIC_RELAXED, __HIP_MEMORY_SCOPE_WORKGROUP); lasg[rl * 8 + cnt] = (F.lane << 16) | lr;
                    asg_e[(size_t)row * 8 + cnt] = F.lane; ((LAS float*)(F.lds + LDS_LW))[rl * 8 + cnt] = s / gsum * 2.5f; }
            }
        }
        __syncthreads();
        if (F.tid < NEXP) { const int cn = lcnt[F.tid]; lbase[F.tid] = (cn && !dry) ? (int)atomicAdd(&gcount[F.tid], (unsigned)cn) : 0; lcnt[F.tid] = 0; }
        __syncthreads();
        { const int v = lasg[F.tid], e = v >> 16, rank = lbase[e] + (v & 0xffff); asg_r[(size_t)blk * 512 + F.tid] = rank;
          etok[(size_t)e * ECAP + rank] = blk * 64 + (F.tid >> 3); egate[(size_t)e * ECAP + rank] = ((const LAS float*)(F.lds + LDS_LW))[F.tid];
          if (F.tid < 64) { etok[(size_t)NEXP * ECAP + blk * 64 + F.tid] = blk * 64 + F.tid; egate[(size_t)NEXP * ECAP + blk * 64 + F.tid] = 1.0f; } }
        __syncthreads();
    }
#undef LNR_LOAD
}

DI void moe_scatter_phase(const Frame& F, const Args& A, int layer) {
    unsigned char* ws = opq(A.ws);
    const int* asg_e = (const int*)(ws + WS_ASG_E); const int* asg_r = (const int*)(ws + WS_ASG_R); const float* asg_w = (const float*)(ws + WS_ASG_W); int* asg_row = (int*)(ws + WS_ASG_ROW);
    int* rowtok = (int*)(ws + WS_ROWTOK); float* roww = (float*)(ws + WS_ROWW);
    const unsigned* gcount = (const unsigned*)(ws + WS_CTL) + CW_CNT + layer * 64;
    build_tileoff(F, gcount);
    const LAS int* tileoff = (const LAS int*)(F.lds + LDS_TILEOFF);
    for (int idx = F.bid * NTHR + F.tid; idx < T_ * TOPK; idx += F.G * NTHR) {
        const int e = asg_e[idx], row = 256 * tileoff[e] + asg_r[idx];
        rowtok[row] = idx >> 3; roww[row] = asg_w[idx]; asg_row[idx] = row;
    }
    for (int e = F.bid; e < NEXP; e += F.G) {
        const int cnt = (int)__hip_atomic_load(gcount + e, __ATOMIC_RELAXED, __HIP_MEMORY_SCOPE_AGENT), end = 256 * tileoff[e + 1];
        for (int row = 256 * tileoff[e] + cnt + F.tid; row < end; row += NTHR) { rowtok[row] = T_; roww[row] = 0.f; }
    }
    const int s0 = 256 * tileoff[64];
    for (int t = F.bid * NTHR + F.tid; t < T_; t += F.G * NTHR) { rowtok[s0 + t] = t; roww[s0 + t] = 1.0f; }
}

DI void ln_moe_phase(const Frame& F, const Args& A, int layer, float* dry_out) {
    unsigned char* ws = opq(A.ws);
    const float* MOD = (const float*)(ws + WS_MOD); const char* YE = (const char*)(ws + WS_BIG);
    float* AB = (float*)(ws + WS_AB);
    int s0 = 0;
    { const unsigned* gcount = (const unsigned*)(ws + WS_CTL) + CW_CNT + layer * 64; build_tileoff(F, gcount); s0 = 256 * ((const LAS int*)(F.lds + LDS_TILEOFF))[64]; }
    const int* asg_e = (const int*)(ws + WS_ASG_E); const int* asg_r = (const int*)(ws + WS_ASG_R);
    const int ls0 = layer * 2 + 1, ls1 = layer * 2 + 2; const bool last = layer == 3, want_ab = (layer & 1) == 0;
    const bf16* wabf = (const bf16*)(ws + WS_WABF) + (size_t)(layer >> 1) * 2 * 16384;
    const unsigned l4_ = (unsigned)F.lane * 4u, l8_ = (unsigned)F.lane * 8u, l16_ = (unsigned)F.lane * 16u;
    for (int blk = F.bid; blk < T_ / 64; blk += F.G) {
        const int b = blk >> 6;
        const char* gate = pg8::rfl_ptr((const char*)(MOD + (size_t)(ls0 * 4 + b) * 3072 + 2048)); const char* modn = pg8::rfl_ptr((const char*)(MOD + (size_t)((last ? ls0 : ls1) * 4 + b) * 3072));
        const char* lng = pg8::rfl_ptr((const char*)(A.ln_g + (size_t)ls0 * D_)); const char* lnb = pg8::rfl_ptr((const char*)(A.ln_b + (size_t)ls0 * D_));
        f32x4 cg[4], cng[4], cnb[4], csc[4], csh[4];
#pragma unroll
        for (int j = 0; j < 4; ++j) { cg[j] = *(const f32x4*)(gate + l16_ + 1024 * j); cng[j] = *(const f32x4*)(lng + l16_ + 1024 * j); cnb[j] = *(const f32x4*)(lnb + l16_ + 1024 * j);
            csc[j] = *(const f32x4*)(modn + 4096 + l16_ + 1024 * j); csh[j] = *(const f32x4*)(modn + l16_ + 1024 * j); }
#pragma unroll 1
        for (int ps = 0; ps < 2; ++ps) {
            const int rbase = blk * 64 + ps * 32 + F.wave * 4;
            const int ev = *(const int*)(pg8::rfl_ptr((const char*)(asg_e + (size_t)rbase * 8)) + (l4_ & 127u)), rv = *(const int*)(pg8::rfl_ptr((const char*)(asg_r + (size_t)rbase * 8)) + (l4_ & 127u));
            const int idxv = 256 * ((const LAS int*)(F.lds + LDS_TILEOFF))[ev] + rv;
#pragma unroll 1
            for (int rr = 0; rr < 4; ++rr) {
                const int row = rbase + rr; f32x4 v[4], y[4]; int w[9][4]; u32x2 sh[4];
                unsigned l4 = l4_, l8 = l8_, l16 = l16_; asm volatile("" : "+v"(l4), "+v"(l8), "+v"(l16));
#pragma unroll
                for (int k = 0; k < TOPK; ++k) { const int src = __builtin_amdgcn_readlane(idxv, rr * 8 + k); const char* p = pg8::rfl_ptr(YE + (size_t)src * D_);
#pragma unroll
                    for (int j = 0; j < 4; ++j) w[k][j] = __builtin_nontemporal_load((const int*)(p + l4 + 256 * j)); }
                if (YS_BF16) { const char* p = pg8::rfl_ptr(YE + WS_YS_OFF + (size_t)row * (D_ * 2));
#pragma unroll
                    for (int j = 0; j < 4; ++j) sh[j] = __builtin_nontemporal_load((const u32x2*)(p + l8 + 512 * j));
                } else { const char* p = pg8::rfl_ptr(YE + (size_t)(s0 + row) * D_);
#pragma unroll
                    for (int j = 0; j < 4; ++j) w[8][j] = *(const int*)(p + l4 + 256 * j);
                }
                u32x2 xb[4];
                { const char* p = pg8::rfl_ptr((const char*)(ws + WS_X) + (size_t)row * (D_ * 2));
#pragma unroll
                  for (int j = 0; j < 4; ++j) xb[j] = __builtin_nontemporal_load((const u32x2*)(p + l8 + 512 * j)); }
                __builtin_amdgcn_sched_barrier(0);
#pragma unroll
                for (int j = 0; j < 4; ++j) { y[j] = (f32x4){0.f, 0.f, 0.f, 0.f}; v[j] = (f32x4){bf_lo(xb[j].x), bf_hi(xb[j].x), bf_lo(xb[j].y), bf_hi(xb[j].y)}; }
#pragma unroll
                for (int k = 0; k < (YS_BF16 ? TOPK : TOPK + 1); ++k) {
                    asm volatile("" : "+v"(w[k][0]), "+v"(w[k][1]), "+v"(w[k][2]), "+v"(w[k][3]), "+v"(y[0]), "+v"(y[1]), "+v"(y[2]), "+v"(y[3]));
#pragma unroll
                    for (int j = 0; j < 4; ++j) { const f32x2 a = __builtin_amdgcn_cvt_pk_f32_fp8(w[k][j], false), c = __builtin_amdgcn_cvt_pk_f32_fp8(w[k][j], true);
                        y[j][0] += a[0]; y[j][1] += a[1]; y[j][2] += c[0]; y[j][3] += c[1]; }
                    __builtin_amdgcn_sched_barrier(0);
                }
#pragma unroll
                for (int j = 0; j < 4; ++j) y[j] = y[j] * (1.0f / YE_SCALE);
                if (YS_BF16) {
#pragma unroll
                    for (int j = 0; j < 4; ++j) { y[j][0] += bf_lo(sh[j].x); y[j][1] += bf_hi(sh[j].x); y[j][2] += bf_lo(sh[j].y); y[j][3] += bf_hi(sh[j].y); }
                }
                deepnorm_row_c(v, y, cg, cng, cnb);
                if (last || dry_out) { char* op = (char*)pg8::rfl_ptr((const char*)(dry_out ? dry_out : A.out) + (size_t)row * (D_ * 4));
#pragma unroll
                    for (int j = 0; j < 4; ++j) __builtin_nontemporal_store(v[j], (f32x4*)(op + l16 + 1024 * j));
                } else { char* xp = (char*)pg8::rfl_ptr((const char*)(ws + WS_X) + (size_t)row * (D_ * 2));
#pragma unroll
                    for (int j = 0; j < 4; ++j) { u32x2 o; o.x = cvtpk(v[j][0], v[j][1]); o.y = cvtpk(v[j][2], v[j][3]); __builtin_nontemporal_store(o, (u32x2*)(xp + l8 + 512 * j)); } }
                if (!last) { char* hp = (char*)pg8::rfl_ptr((const char*)(ws + WS_H) + (size_t)row * (D_ * 2));
#pragma unroll
                    for (int j = 0; j < 4; ++j) { v[j] = v[j] * (1.0f + csc[j]) + csh[j]; u32x2 o; o.x = cvtpk(v[j][0], v[j][1]); o.y = cvtpk(v[j][2], v[j][3]); *(u32x2*)(hp + l8 + 512 * j) = o; }
                    if (want_ab) put_hilo(F.lds, F.wave * 4 + rr, F.lane, v);
                }
            }
            if (!last && want_ab) {
                __syncthreads();
                if (F.wave < 2) { const int mt = F.wave, r = F.lane & 15, q = F.lane >> 4;
                    const f32x4 acc = small_proj(F.lds, mt, F.lane, wabf, wabf + 16384);
#pragma unroll
                    for (int reg = 0; reg < 4; ++reg) AB[(size_t)(blk * 64 + ps * 32 + 16 * mt + 4 * q + reg) * 16 + r] = acc[reg]; }
                __syncthreads();
            }
        }
    }
}
DI int crow(int r, int h) { return (r & 3) + 8 * (r >> 2) + 4 * h; }
typedef short v4i16_t __attribute__((ext_vector_type(4)));
DI s16x4 vtr(const LAS unsigned char* p) { return __builtin_bit_cast(s16x4, __builtin_amdgcn_ds_read_tr16_b64_v4i16((LAS v4i16_t*)p)); }
#define MFMA32(a, b, c) __builtin_amdgcn_mfma_f32_32x32x16_bf16((a), (b), (c), 0, 0, 0)
constexpr int ATT_ORUN = 0, ATT_LRUN = 65536, ATT_VBUF = 65536 + 2048, ATT_VSTRIDE = 144, ATT_VBYTES = 32 * ATT_VSTRIDE;

#ifndef REP_A1
#define REP_A1 1
#define REP_A2 1
#endif
DI void attn_phase(const Frame& F, const Args& A) {
    unsigned char* ws = opq(A.ws);
    const bf16* QKV = (const bf16*)(ws + WS_BIG); bf16* O = (bf16*)(ws + WS_O);
    LAS unsigned char* orun = F.lds + ATT_ORUN;
    LAS float* lrun = (LAS float*)(F.lds + ATT_LRUN);
    LAS unsigned char* vbuf = F.lds + ATT_VBUF + F.wave * ATT_VBYTES;
    const int lane = F.lane, qi = lane & 31, h = lane >> 5;
    const int g16 = lane >> 4, q4 = (lane & 15) >> 2, p4 = lane & 3;
    for (int it = F.bid; it < NB_ * 16 * 8; it += F.G) {
        int item = it;
        if (F.G == 256) { const int w = it & 255, xcd = w & 7, j = w >> 3; item = (((it >> 8) * 32 + xcd * 4 + (j >> 3)) << 3) | (j & 7); }
        const int b = item >> 7, head = (item >> 3) & 15, ck = item & 7;
        for (int gi = 0; gi < 3; ++gi) {
            const int g = 2 - gi, ldil = 2 * g, Lg = S_ >> ldil;
            const size_t hb = (((size_t)g * NB_ + b) * 16 + head) * S_ * 64;
            const bf16* Qg = QKV + hb; const bf16* Kg = QKV + (size_t)3 * NB_ * 16 * S_ * 64 + hb; const bf16* Vg = QKV + (size_t)6 * NB_ * 16 * S_ * 64 + hb;
            for (int sub = F.wave; sub < 16; sub += NWAVES) {
                int r_, tile;
                if (g == 0) { r_ = 0; tile = sub; } else if (g == 1) { r_ = sub >> 2; tile = sub & 3; } else { r_ = sub; tile = 0; }
                const int m0 = ((512 * ck) >> ldil) + 32 * tile;
                const bf16* Kr = Kg + (size_t)r_ * Lg * 64; const bf16* Vr = Vg + (size_t)r_ * Lg * 64;
                f32x16 st[5]; u32x4 vv[5][4]; float mx, lsum;
#pragma unroll 1
                for (int rep1 = 0; rep1 < REP_A1; ++rep1) {
                unsigned lc = (unsigned)((lane >> 3) * 128 + (lane & 7) * 16); asm volatile("" : "+v"(lc));
                const int wofs = (lane >> 3) * ATT_VSTRIDE + (lane & 7) * 16, rofs = qi * ATT_VSTRIDE + 64 * h;
                u32x4 qv[4], kv[5][4];
                { const char* qp = pg8::rfl_ptr((const char*)(Qg + ((size_t)r_ * Lg + m0) * 64));
#pragma unroll
                  for (int i = 0; i < 4; ++i) qv[i] = __builtin_nontemporal_load((const u32x4*)(qp + lc + 1024 * i)); }
#pragma unroll
                for (int kt = 0; kt < 5; ++kt) { const int mk0 = m0 - 128 + 32 * kt; const char* kp = pg8::rfl_ptr((const char*)(Kr + (size_t)(mk0 < 0 ? 0 : mk0) * 64));
#pragma unroll
                    for (int i = 0; i < 4; ++i) kv[kt][i] = *(const u32x4*)(kp + lc + 1024 * i); }
                __builtin_amdgcn_sched_barrier(0);
                bf16x8 qf[4];
#pragma unroll
                for (int i = 0; i < 4; ++i) *(LAS u32x4*)(vbuf + wofs + 8 * i * ATT_VSTRIDE) = qv[i];
                LDS_WAIT(); asm volatile("" ::: "memory");
#pragma unroll
                for (int s = 0; s < 4; ++s) qf[s] = *(const LAS bf16x8*)(vbuf + rofs + 16 * s);
                LDS_WAIT(); asm volatile("" ::: "memory");
#pragma unroll
                for (int kt = 0; kt < 5; ++kt) {
                    const int mk0 = m0 - 128 + 32 * kt;
                    bf16x8 kf[4];
#pragma unroll
                    for (int i = 0; i < 4; ++i) *(LAS u32x4*)(vbuf + wofs + 8 * i * ATT_VSTRIDE) = kv[kt][i];
                    LDS_WAIT(); asm volatile("" ::: "memory");
#pragma unroll
                    for (int s = 0; s < 4; ++s) kf[s] = *(const LAS bf16x8*)(vbuf + rofs + 16 * s);
                    { const char* vp = pg8::rfl_ptr((const char*)(Vr + (size_t)(mk0 < 0 ? 0 : mk0) * 64));
#pragma unroll
                      for (int i = 0; i < 4; ++i) vv[kt][i] = *(const u32x4*)(vp + lc + 1024 * i); }
                    LDS_WAIT(); asm volatile("" ::: "memory");
#pragma unroll
                    for (int r = 0; r < 16; ++r) st[kt][r] = 0.f;
#pragma unroll
                    for (int s = 0; s < 4; ++s) st[kt] = MFMA32(kf[s], qf[s], st[kt]);
                    if (mk0 < 0) {
#pragma unroll
                        for (int r = 0; r < 16; ++r) st[kt][r] = -INFINITY;
                    }
                }
#pragma unroll
                for (int r = 0; r < 16; ++r) { const int kr = crow(r, h); if (kr < qi) st[0][r] = -INFINITY; if (kr > qi) st[4][r] = -INFINITY; }
                mx = -INFINITY;
#pragma unroll
                for (int kt = 0; kt < 5; ++kt)
#pragma unroll
                    for (int r = 0; r < 16; ++r) mx = fmaxf(mx, st[kt][r]);
                mx = fmaxf(mx, bperm(mx, F.lane ^ 32));
                lsum = 0.f;
#pragma unroll
                for (int kt = 0; kt < 5; ++kt)
#pragma unroll
                    for (int r = 0; r < 16; ++r) { const float p = __builtin_amdgcn_exp2f(st[kt][r] - mx); st[kt][r] = p; lsum += p; }
                lsum += bperm(lsum, F.lane ^ 32);
                }
                f32x16 oacc[2];
#pragma unroll 1
                for (int rep2 = 0; rep2 < REP_A2; ++rep2) {
#pragma unroll
                for (int r = 0; r < 16; ++r) { oacc[0][r] = 0.f; oacc[1][r] = 0.f; }
#pragma unroll
                for (int kt = 0; kt < 5; ++kt) {
                    const int mk0 = m0 - 128 + 32 * kt;
                    if (mk0 >= 0) {
#pragma unroll
                        for (int i = 0; i < 4; ++i) *(LAS u32x4*)(vbuf + ((lane >> 3) + 8 * i) * ATT_VSTRIDE + (lane & 7) * 16) = vv[kt][i];
                        LDS_WAIT(); asm volatile("" ::: "memory");
                        s16x4 flo[2][2], fhi[2][2];
#pragma unroll
                        for (int sp = 0; sp < 2; ++sp)
#pragma unroll
                            for (int dvt = 0; dvt < 2; ++dvt) {
                                const int colb = (32 * dvt + 16 * (g16 & 1) + 4 * p4) * 2;
                                flo[sp][dvt] = vtr(vbuf + (16 * sp + 4 * h + q4) * ATT_VSTRIDE + colb);
                                fhi[sp][dvt] = vtr(vbuf + (16 * sp + 8 + 4 * h + q4) * ATT_VSTRIDE + colb);
                            }
                        LDS_WAIT(); asm volatile("" ::: "memory");
#pragma unroll
                        for (int sp = 0; sp < 2; ++sp) {
                            bf16x8 pf; {
                                const unsigned w0 = cvtpk(st[kt][8 * sp + 0], st[kt][8 * sp + 1]), w1 = cvtpk(st[kt][8 * sp + 2], st[kt][8 * sp + 3]);
                                const unsigned w2 = cvtpk(st[kt][8 * sp + 4], st[kt][8 * sp + 5]), w3 = cvtpk(st[kt][8 * sp + 6], st[kt][8 * sp + 7]);
                                pf = __builtin_bit_cast(bf16x8, (u32x4){w0, w1, w2, w3}); }
#pragma unroll
                            for (int dvt = 0; dvt < 2; ++dvt) {
                                const bf16x8 vf = __builtin_shufflevector(flo[sp][dvt], fhi[sp][dvt], 0, 1, 2, 3, 4, 5, 6, 7);
                                oacc[dvt] = MFMA32(vf, pf, oacc[dvt]);
                            }
                        }
                    }
                }
                asm volatile("" : "+v"(oacc[0]), "+v"(oacc[1]));
                }
                const float inv = __builtin_amdgcn_rcpf(lsum), lse = mx + __builtin_amdgcn_logf(lsum);
                const int tl = ((32 * tile + qi) << ldil) + r_;
                float wa = 0.f, wb = 1.f;
                if (gi > 0) { const float L0 = lrun[tl]; const float M = fmaxf(L0, lse); const float ea = __builtin_amdgcn_exp2f(L0 - M), eb = __builtin_amdgcn_exp2f(lse - M);
                    const float isum = __builtin_amdgcn_rcpf(ea + eb); wa = ea * isum; wb = eb * isum; asm volatile("" ::: "memory");
                    if (h == 0) lrun[tl] = M + __builtin_amdgcn_logf(ea + eb); }
                else if (h == 0) lrun[tl] = lse;
                wb *= inv;
#pragma unroll
                for (int dvt = 0; dvt < 2; ++dvt)
#pragma unroll
                    for (int k4 = 0; k4 < 4; ++k4) {
                        const int dv = 32 * dvt + 8 * k4 + 4 * h;
                        float o0 = oacc[dvt][4 * k4 + 0] * wb, o1 = oacc[dvt][4 * k4 + 1] * wb, o2 = oacc[dvt][4 * k4 + 2] * wb, o3 = oacc[dvt][4 * k4 + 3] * wb;
                        LAS u32x2* op = (LAS u32x2*)(orun + tl * 128 + dv * 2);
                        if (gi > 0) { const u32x2 w = *op; o0 += wa * bf_lo(w.x); o1 += wa * bf_hi(w.x); o2 += wa * bf_lo(w.y); o3 += wa * bf_hi(w.y); }
                        u32x2 wo; wo.x = cvtpk(o0, o1); wo.y = cvtpk(o2, o3);
                        if (gi < 2) *op = wo;
                        else *(u32x2*)(O + ((size_t)b * S_ + 512 * ck + tl) * D_ + head * 64 + dv) = wo;
                    }
            }
            __syncthreads();
        }
    }
}

DI void gdn_post_phase(const Frame& F, const Args& A, int j) {
    unsigned char* ws = opq(A.ws); unsigned char* big = ws + WS_BIG;
    const bf16* Oraw = (const bf16*)(ws + WS_Y); const bf16* PROJ = (const bf16*)(big + BIG_PROJ); bf16* O = (bf16*)(ws + WS_O);
    const float* nw = A.gdn_norm_w + (size_t)j * 128;
    const int gw = F.bid * NWAVES + F.wave, NGW = F.G * NWAVES, lane = F.lane;
    const f32x4 nwv = *(const f32x4*)(nw + ((4 * lane) & 127));
    const unsigned l8_ = (unsigned)lane * 8u;
#pragma unroll 2
    for (int row = gw; row < T_; row += NGW) {
        unsigned l8 = l8_; asm volatile("" : "+v"(l8));
        const char* op = pg8::rfl_ptr((const char*)(Oraw + (size_t)row * D_)); const char* zp = pg8::rfl_ptr((const char*)(PROJ + (size_t)row * 4096 + 3072));
        u32x2 ow[4], zw[4];
#pragma unroll
        for (int jj = 0; jj < 4; ++jj) { ow[jj] = __builtin_nontemporal_load((const u32x2*)(op + l8 + 512 * jj)); zw[jj] = __builtin_nontemporal_load((const u32x2*)(zp + l8 + 512 * jj)); }
        f32x4 v[4];
#pragma unroll
        for (int jj = 0; jj < 4; ++jj) {
            v[jj] = (f32x4){bf_lo(ow[jj].x), bf_hi(ow[jj].x), bf_lo(ow[jj].y), bf_hi(ow[jj].y)};
            float ss = (v[jj][0] * v[jj][0] + v[jj][1] * v[jj][1]) + (v[jj][2] * v[jj][2] + v[jj][3] * v[jj][3]);
            ss += dppmov<0xB1>(ss); ss += dppmov<0x4E>(ss); ss += dppmov<0x141>(ss); ss += dppmov<0x140>(ss); ss += shx<16>(ss);
            const float rs = rsqrtf(ss * (1.0f / 128.0f) + RMS_EPS);
            const float z0 = bf_lo(zw[jj].x), z1 = bf_hi(zw[jj].x), z2 = bf_lo(zw[jj].y), z3 = bf_hi(zw[jj].y);
            v[jj][0] = v[jj][0] * rs * nwv[0] * silu_f(z0); v[jj][1] = v[jj][1] * rs * nwv[1] * silu_f(z1);
            v[jj][2] = v[jj][2] * rs * nwv[2] * silu_f(z2); v[jj][3] = v[jj][3] * rs * nwv[3] * silu_f(z3);
        }
        store_row16_bf16(O + (size_t)row * D_, lane, v);
    }
}
constexpr size_t GB_KR = 128 * MiB, GB_QR = 160 * MiB, GB_KT = 192 * MiB, GB_VT = 224 * MiB, GB_BLOB = 256 * MiB;
constexpr int BLOB_ELEMS = 28672, BLOB_W = 0, BLOB_QG = 8192, BLOB_QK = 16384, BLOB_KDT = 20480;
DI int frag_pos(int row, int k, int nks) { const int kk = k & 31; return ((((row >> 4) * nks + (k >> 5)) * 64 + ((kk >> 2) & 3) * 16 + (row & 15)) * 8) + 4 * (kk >> 4) + (kk & 3); }
#define MFMA16(a, b, c) __builtin_amdgcn_mfma_f32_16x16x32_bf16((a), (b), (c), 0, 0, 0)
DI u32x2 pk4(float a, float b, float c, float d) { u32x2 w; w.x = cvtpk(a, b); w.y = cvtpk(c, d); return w; }

DI int tile_off(int t, int c) { return t * 256 + ((((c >> 4) ^ (t & 7)) << 5) | ((c & 15) << 1)); }
template <int WH> DI void prep_conv_pass(const bf16* PROJ, const float* cw, int b, int hh, int t0, int lane, LAS unsigned char* tile, bf16* rowdst, const LAS float* escale, bool normalize, float nscale) {
    float w[4][2];
#pragma unroll
    for (int jj = 0; jj < 4; ++jj) { const f32x2 t = *(const f32x2*)(cw + (size_t)jj * 3072 + WH * 1024 + hh * 128 + 2 * lane); w[jj][0] = t.x; w[jj][1] = t.y; }
    float A0[35], A1[35];
#pragma unroll
    for (int jj = 0; jj < 3; ++jj) { const int t = t0 - 3 + jj; unsigned u = 0u;
        if (t >= 0) u = *(const unsigned*)(PROJ + ((size_t)b * S_ + t) * 4096 + WH * 1024 + hh * 128 + 2 * lane);
        A0[jj] = bf_lo(u); A1[jj] = bf_hi(u); }
#pragma unroll 1
    for (int hb = 0; hb < 2; ++hb) {
        { unsigned xin[32];
#pragma unroll
          for (int i = 0; i < 32; ++i) xin[i] = __builtin_nontemporal_load((const unsigned*)(PROJ + ((size_t)b * S_ + t0 + 32 * hb + i) * 4096 + WH * 1024 + hh * 128 + 2 * lane));
#pragma unroll
          for (int i = 0; i < 32; ++i) { A0[3 + i] = bf_lo(xin[i]); A1[3 + i] = bf_hi(xin[i]); } }
#pragma unroll
        for (int i = 0; i < 32; ++i) {
            A0[i] = w[0][0] * A0[i] + w[1][0] * A0[i + 1] + w[2][0] * A0[i + 2] + w[3][0] * A0[i + 3];
            A1[i] = w[0][1] * A1[i] + w[1][1] * A1[i + 1] + w[2][1] * A1[i + 2] + w[3][1] * A1[i + 3]; }
#pragma unroll
        for (int i = 0; i < 32; ++i) { A0[i] = silu_f(A0[i]); A1[i] = silu_f(A1[i]); }
        if (normalize) {
            float rs[32];
#pragma unroll
            for (int i = 0; i < 32; ++i) rs[i] = wave_sum(A0[i] * A0[i] + A1[i] * A1[i]);
#pragma unroll
            for (int i = 0; i < 32; ++i) { const float r = rsqrtf(rs[i] + RMS_EPS) * nscale; A0[i] *= r; A1[i] *= r; }
        }
#pragma unroll
        for (int i = 0; i < 32; ++i) {
            const int tt = 32 * hb + i;
            if (rowdst) *(unsigned*)(rowdst + (size_t)tt * 128 + 2 * lane) = cvtpk(A0[i], A1[i]);
            const float es = escale ? escale[tt] : 1.0f;
            *(LAS unsigned*)(tile + tile_off(tt, 2 * lane)) = cvtpk(A0[i] * es, A1[i] * es);
        }
#pragma unroll
        for (int jj = 0; jj < 3; ++jj) { A0[jj] = A0[32 + jj]; A1[jj] = A1[32 + jj]; }
    }
    LDS_WAIT(); asm volatile("" ::: "memory");
}
DI void tile_tr8(const LAS unsigned char* tile, int tb, int tb2, int cb, int lane, s16x4& lo, s16x4& hi) {
    const int q4 = (lane & 15) >> 2, p4 = lane & 3;
    lo = vtr(tile + tile_off(tb + q4, cb + 4 * p4)); hi = vtr(tile + tile_off(tb2 + q4, cb + 4 * p4));
}
DI void gdn_prep2_phase(const Frame& F, const Args& A, int j) {
    unsigned char* ws = opq(A.ws); unsigned char* big = ws + WS_BIG;
    const bf16* PROJ = (const bf16*)(big + BIG_PROJ);
    bf16* KR = (bf16*)(big + GB_KR); bf16* QR = (bf16*)(big + GB_QR); bf16* KT = (bf16*)(big + GB_KT); bf16* VT = (bf16*)(big + GB_VT); bf16* BLOB = (bf16*)(big + GB_BLOB);
    const float* AB = (const float*)(ws + WS_AB); float* GC = (float*)(ws + WS_GALPHA); float* GB = (float*)(ws + WS_GBETA);
    const float* cw = A.gdn_conv_w + (size_t)j * 4 * 3072;
    const int gw = F.bid * NWAVES + F.wave, NGW = F.G * NWAVES, lane = F.lane, g16 = lane >> 4, i16 = lane & 15;
    LAS unsigned char* tile = F.lds + F.wave * 16384;
    LAS float* egl = (LAS float*)(F.lds + LDS_LG + F.wave * 512); LAS float* ekl = egl + 64;
    for (int it = gw; it < NB_ * 8 * 64; it += NGW) {
        const int b = it >> 9, hh = (it >> 6) & 7, n = it & 63, t0 = 64 * n, bh = b * 8 + hh;
        { const int row = b * S_ + t0 + lane; const float a = AB[(size_t)row * 16 + hh], bl = AB[(size_t)row * 16 + 8 + hh];
          const float xs = a + A.gdn_dt_bias[j * 8 + hh]; const float ey = __expf(xs); const float sp = xs > 20.f ? xs : (ey < 1e-3f ? ey * (1.0f - 0.5f * ey) : __logf(1.0f + ey));
          float gc = -__expf(A.gdn_a_log[j * 8 + hh]) * sp;
#pragma unroll
          for (int o = 1; o < 64; o <<= 1) { const float t = bperm(gc, lane - o); if (lane >= o) gc += t; }
          const float gl = rdlane(gc, 63);
          GC[(size_t)bh * S_ + t0 + lane] = gc; GB[(size_t)bh * S_ + t0 + lane] = 1.0f / (1.0f + __expf(-bl));
          egl[lane] = __expf(gc); ekl[lane] = __expf(gl - gc); }
        LDS_WAIT(); asm volatile("" ::: "memory");
        bf16* blob = BLOB + (size_t)it * BLOB_ELEMS;
        bf16* ktc = KT + (size_t)it * 8192; bf16* vtc = VT + (size_t)it * 8192;
        const size_t rbase = ((size_t)bh * S_ + t0) * 128;
        prep_conv_pass<1>(PROJ, cw, b, hh, t0, lane, tile, KR + rbase, nullptr, true, 1.0f);
#pragma unroll 2
        for (int db = 0; db < 8; ++db)
#pragma unroll
            for (int half = 0; half < 2; ++half) { s16x4 lo, hi; const int tb = 32 * half + 8 * g16; tile_tr8(tile, tb, tb + 4, 16 * db, lane, lo, hi);
                *(bf16x8*)(ktc + (16 * db + i16) * 64 + tb) = __builtin_shufflevector(lo, hi, 0, 1, 2, 3, 4, 5, 6, 7); }
#pragma unroll 2
        for (int a = 0; a < 8; ++a)
#pragma unroll
            for (int ks = 0; ks < 2; ++ks) { s16x4 lo, hi; const int tb = 32 * ks + 4 * g16; tile_tr8(tile, tb, tb + 16, 16 * a, lane, lo, hi);
                const f32x4 e0 = *(const LAS f32x4*)(ekl + tb), e1 = *(const LAS f32x4*)(ekl + tb + 16);
                u32x4 wv;
                wv.x = cvtpk(bf_lo((unsigned)(unsigned short)lo[0]) * e0[0], bf_lo((unsigned)(unsigned short)lo[1]) * e0[1]); wv.y = cvtpk(bf_lo((unsigned)(unsigned short)lo[2]) * e0[2], bf_lo((unsigned)(unsigned short)lo[3]) * e0[3]);
                wv.z = cvtpk(bf_lo((unsigned)(unsigned short)hi[0]) * e1[0], bf_lo((unsigned)(unsigned short)hi[1]) * e1[1]); wv.w = cvtpk(bf_lo((unsigned)(unsigned short)hi[2]) * e1[2], bf_lo((unsigned)(unsigned short)hi[3]) * e1[3]);
                *(u32x4*)(blob + BLOB_KDT + ((a * 2 + ks) * 64 + lane) * 8) = wv; }
        LDS_WAIT(); asm volatile("" ::: "memory");
        prep_conv_pass<2>(PROJ, cw, b, hh, t0, lane, tile, nullptr, nullptr, false, 1.0f);
#pragma unroll 2
        for (int db = 0; db < 8; ++db)
#pragma unroll
            for (int half = 0; half < 2; ++half) { s16x4 lo, hi; const int tb = 32 * half + 8 * g16; tile_tr8(tile, tb, tb + 4, 16 * db, lane, lo, hi);
                *(bf16x8*)(vtc + (16 * db + i16) * 64 + tb) = __builtin_shufflevector(lo, hi, 0, 1, 2, 3, 4, 5, 6, 7); }
        LDS_WAIT(); asm volatile("" ::: "memory");
        prep_conv_pass<0>(PROJ, cw, b, hh, t0, lane, tile, QR + rbase, egl, true, 0.08838834764831845f);
#pragma unroll 2
        for (int tm = 0; tm < 4; ++tm)
#pragma unroll
            for (int ks = 0; ks < 4; ++ks) {
                const u32x2 p0 = *(const LAS u32x2*)(tile + tile_off(16 * tm + i16, 32 * ks + 4 * g16)), p1 = *(const LAS u32x2*)(tile + tile_off(16 * tm + i16, 32 * ks + 16 + 4 * g16));
                *(u32x4*)(blob + BLOB_QG + ((tm * 4 + ks) * 64 + lane) * 8) = (u32x4){p0.x, p0.y, p1.x, p1.y}; }
        LDS_WAIT(); asm volatile("" ::: "memory");
    }
}

DI void gdn_wy_phase(const Frame& F, const Args& A) {
    unsigned char* ws = opq(A.ws); unsigned char* big = ws + WS_BIG;
    const bf16* KR = (const bf16*)(big + GB_KR); const bf16* QR = (const bf16*)(big + GB_QR); const bf16* KT = (const bf16*)(big + GB_KT); const bf16* VT = (const bf16*)(big + GB_VT);
    bf16* BLOB = (bf16*)(big + GB_BLOB); float* U = (float*)(ws + WS_HID);
    const float* GC = (const float*)(ws + WS_GALPHA); const float* GB = (const float*)(ws + WS_GBETA);
    const int gw = F.bid * NWAVES + F.wave, NGW = F.G * NWAVES, lane = F.lane, r = lane & 15, q = lane >> 4;
    LAS float* Af = (LAS float*)(F.lds + F.wave * 16384);
    asm volatile("s_waitcnt vmcnt(0)" ::: "memory"); __builtin_amdgcn_fence(__ATOMIC_ACQUIRE, "agent");
    for (int it = gw; it < NB_ * 8 * 64; it += NGW) {
        const int bh = it >> 6, n = it & 63;
        const char* kr = pg8::rfl_ptr((const char*)(KR + ((size_t)bh * S_ + 64 * n) * 128)); const char* qr = pg8::rfl_ptr((const char*)(QR + ((size_t)bh * S_ + 64 * n) * 128));
        const char* kt = pg8::rfl_ptr((const char*)(KT + (size_t)it * 8192)); const char* vt = pg8::rfl_ptr((const char*)(VT + (size_t)it * 8192));
        char* blob = (char*)pg8::rfl_ptr((const char*)(BLOB + (size_t)it * BLOB_ELEMS)); char* ub = (char*)pg8::rfl_ptr((const char*)(U + (size_t)it * 8192));
        const unsigned lrow = (unsigned)(r * 128 + 8 * q) * 2u, ltr = (unsigned)(r * 64 + 8 * q) * 2u, lfrag = (unsigned)(q * 16 + r) * 16u;
        const float gcl = GC[(size_t)bh * S_ + 64 * n + lane], bel = GB[(size_t)bh * S_ + 64 * n + lane];
        __builtin_amdgcn_wave_barrier();
        bf16x8 kfr[4][4], qfr[4][4];
#pragma unroll
        for (int t4 = 0; t4 < 4; ++t4)
#pragma unroll
            for (int ks = 0; ks < 4; ++ks) { kfr[t4][ks] = *(const bf16x8*)(kr + lrow + (16 * t4 * 128 + 32 * ks) * 2); qfr[t4][ks] = *(const bf16x8*)(qr + lrow + (16 * t4 * 128 + 32 * ks) * 2); }
#pragma unroll
        for (int ti = 0; ti < 4; ++ti) {
            const float gi = bperm(gcl, 16 * ti + r), bi = bperm(bel, 16 * ti + r);
#pragma unroll
            for (int tj = 0; tj < 4; ++tj) {
                char* qkdst = blob + (BLOB_QK + ((ti * 2 + (tj >> 1)) * 64) * 8 + 4 * (tj & 1)) * 2 + lfrag;
                if (tj > ti) { *(u32x2*)qkdst = (u32x2){0u, 0u}; *(LAS f32x4*)(Af + (16 * ti + r) * 64 + 16 * tj + 4 * q) = (f32x4){0.f, 0.f, 0.f, 0.f}; continue; }
                f32x4 p1 = (f32x4){0.f, 0.f, 0.f, 0.f}, p2 = p1;
#pragma unroll
                for (int ks = 0; ks < 4; ++ks) { p1 = MFMA16(kfr[tj][ks], kfr[ti][ks], p1); p2 = MFMA16(kfr[tj][ks], qfr[ti][ks], p2); }
                const int i = 16 * ti + r; f32x4 av, qv;
#pragma unroll
                for (int reg = 0; reg < 4; ++reg) { const int jx = 16 * tj + 4 * q + reg; const float gj = bperm(gcl, jx);
                    const float dec = (jx <= i) ? __expf(gi - gj) : 0.f;
                    av[reg] = (jx < i) ? bi * p1[reg] * dec : 0.f; qv[reg] = p2[reg] * dec; }
                *(LAS f32x4*)(Af + i * 64 + 16 * tj + 4 * q) = av;
                *(u32x2*)qkdst = pk4(qv[0], qv[1], qv[2], qv[3]);
                asm volatile("" ::: "memory");
            }
        }
        LDS_WAIT(); asm volatile("" ::: "memory");
#pragma unroll 1
        for (int i0 = 0; i0 < 64; i0 += 4) {
            float a0 = (i0 + 0 == lane) ? 1.0f : 0.0f, a1 = (i0 + 1 == lane) ? 1.0f : 0.0f, a2 = (i0 + 2 == lane) ? 1.0f : 0.0f, a3 = (i0 + 3 == lane) ? 1.0f : 0.0f;
#pragma unroll 2
            for (int j4 = 0; j4 < (i0 >> 2); ++j4) {
                const float t0 = Af[(4 * j4 + 0) * 64 + lane], t1 = Af[(4 * j4 + 1) * 64 + lane], t2 = Af[(4 * j4 + 2) * 64 + lane], t3 = Af[(4 * j4 + 3) * 64 + lane];
                const f32x4 r0 = *(const LAS f32x4*)(Af + (i0 + 0) * 64 + 4 * j4), r1 = *(const LAS f32x4*)(Af + (i0 + 1) * 64 + 4 * j4);
                const f32x4 r2 = *(const LAS f32x4*)(Af + (i0 + 2) * 64 + 4 * j4), r3 = *(const LAS f32x4*)(Af + (i0 + 3) * 64 + 4 * j4);
                a0 -= r0[0] * t0 + r0[1] * t1 + r0[2] * t2 + r0[3] * t3; a1 -= r1[0] * t0 + r1[1] * t1 + r1[2] * t2 + r1[3] * t3;
                a2 -= r2[0] * t0 + r2[1] * t1 + r2[2] * t2 + r2[3] * t3; a3 -= r3[0] * t0 + r3[1] * t1 + r3[2] * t2 + r3[3] * t3;
            }
            const f32x4 d1 = *(const LAS f32x4*)(Af + (i0 + 1) * 64 + i0), d2 = *(const LAS f32x4*)(Af + (i0 + 2) * 64 + i0), d3 = *(const LAS f32x4*)(Af + (i0 + 3) * 64 + i0);
            a1 -= d1[0] * a0; a2 -= d2[0] * a0 + d2[1] * a1; a3 -= d3[0] * a0 + d3[1] * a1 + d3[2] * a2;
            LDS_WAIT(); asm volatile("" ::: "memory");
            Af[(i0 + 0) * 64 + lane] = a0; Af[(i0 + 1) * 64 + lane] = a1; Af[(i0 + 2) * 64 + lane] = a2; Af[(i0 + 3) * 64 + lane] = a3;
            LDS_WAIT(); asm volatile("" ::: "memory");
        }
        bf16x8 tuf[4][2], twf[4][2];
        {
            const float* gcp = GC + (size_t)bh * S_ + 64 * n; const float* gbp = GB + (size_t)bh * S_ + 64 * n;
#pragma unroll
            for (int ks = 0; ks < 2; ++ks) {
                float su[8], sw[8];
#pragma unroll
                for (int h4 = 0; h4 < 2; ++h4) { const f32x4 bv = *(const f32x4*)(gbp + 32 * ks + 8 * q + 4 * h4), gv = *(const f32x4*)(gcp + 32 * ks + 8 * q + 4 * h4);
#pragma unroll
                    for (int e = 0; e < 4; ++e) { su[4 * h4 + e] = bv[e]; sw[4 * h4 + e] = -bv[e] * __expf(gv[e]); } }
#pragma unroll
                for (int tm = 0; tm < 4; ++tm) {
                    const f32x4 x0 = *(const LAS f32x4*)(Af + (16 * tm + r) * 64 + 32 * ks + 8 * q), x1 = *(const LAS f32x4*)(Af + (16 * tm + r) * 64 + 32 * ks + 8 * q + 4);
                    tuf[tm][ks] = __builtin_bit_cast(bf16x8, (u32x4){cvtpk(x0[0] * su[0], x0[1] * su[1]), cvtpk(x0[2] * su[2], x0[3] * su[3]), cvtpk(x1[0] * su[4], x1[1] * su[5]), cvtpk(x1[2] * su[6], x1[3] * su[7])});
                    twf[tm][ks] = __builtin_bit_cast(bf16x8, (u32x4){cvtpk(x0[0] * sw[0], x0[1] * sw[1]), cvtpk(x0[2] * sw[2], x0[3] * sw[3]), cvtpk(x1[0] * sw[4], x1[1] * sw[5]), cvtpk(x1[2] * sw[6], x1[3] * sw[7])});
                }
            }
        }
        LDS_WAIT(); asm volatile("" ::: "memory");
        {
#pragma unroll
            for (int w8 = 0; w8 < 8; ++w8) {
                bf16x8 vb[2];
#pragma unroll
                for (int ks = 0; ks < 2; ++ks) vb[ks] = *(const bf16x8*)(vt + ltr + (16 * w8 * 64 + 32 * ks) * 2);
#pragma unroll
                for (int tm = 0; tm < 4; ++tm) { f32x4 acc = (f32x4){0.f, 0.f, 0.f, 0.f};
#pragma unroll
                    for (int ks = 0; ks < 2; ++ks) acc = MFMA16(tuf[tm][ks], vb[ks], acc);
                    *(f32x4*)(ub + (unsigned)lane * 16u + ((w8 * 4 + tm) * 64) * 16) = acc; }
            }
        }
        {
#pragma unroll
            for (int a = 0; a < 8; ++a) {
                bf16x8 ka[2];
#pragma unroll
                for (int ks = 0; ks < 2; ++ks) ka[ks] = *(const bf16x8*)(kt + ltr + (16 * a * 64 + 32 * ks) * 2);
#pragma unroll
                for (int ti = 0; ti < 4; ++ti) { f32x4 acc = (f32x4){0.f, 0.f, 0.f, 0.f};
#pragma unroll
                    for (int ks = 0; ks < 2; ++ks) acc = MFMA16(ka[ks], twf[ti][ks], acc);
                    *(u32x2*)(blob + (BLOB_W + ((ti * 4 + (a >> 1)) * 64) * 8 + 4 * (a & 1)) * 2 + lfrag) = pk4(acc[0], acc[1], acc[2], acc[3]); }
            }
        }
        LDS_WAIT(); asm volatile("" ::: "memory");
    }
}

constexpr int SCAN_BUF = BLOB_ELEMS * 2;
DI bf16x8 pack8(const f32x4& lo, const f32x4& hi) { return __builtin_bit_cast(bf16x8, (u32x4){cvtpk(lo[0], lo[1]), cvtpk(lo[2], lo[3]), cvtpk(hi[0], hi[1]), cvtpk(hi[2], hi[3])}); }
DI void ld16_asm(u32x4& dst, const char* sbase, unsigned voff) { asm volatile("global_load_dwordx4 %0, %1, %2" : "=v"(dst) : "v"(voff), "s"(sbase) : "memory"); }
#define SCAN_LOAD(RSET, chunk) do { const char* _cb = pg8::rfl_ptr(src + (size_t)(chunk) * SCAN_BUF); \
    _Pragma("unroll") for (int i = 0; i < 14; ++i) ld16_asm(RSET[i], pg8::rfl_ptr(_cb + i * 4096), ltid16); } while (0)
#define SCAN_PUT(RSET, BUF) do { _Pragma("unroll") for (int i = 0; i < 14; ++i) *(LAS u32x4*)(F.lds + (BUF) * SCAN_BUF + i * 4096 + ltid16) = RSET[i]; } while (0)
#define SCAN_LSTEP(n_, BUFN, RFREE, RNEXT) do { const int n = (n_); \
    if (n + 3 < 64) { SCAN_LOAD(RFREE, n + 3); asm volatile("s_waitcnt vmcnt(28)" ::: "memory"); } else { asm volatile("s_waitcnt vmcnt(0)" ::: "memory"); } \
    __builtin_amdgcn_sched_barrier(0); \
    if (n + 1 < 64) SCAN_PUT(RNEXT, BUFN); \
    asm volatile("s_waitcnt lgkmcnt(0)" ::: "memory"); __builtin_amdgcn_s_barrier(); asm volatile("" ::: "memory"); } while (0)
#define SCAN_CSTEP(n_, BUFC, UC) do { const int n = (n_); \
        const LAS unsigned char* buf = F.lds + (BUFC) * SCAN_BUF; \
        f32x4 vn[4]; \
        _Pragma("unroll") for (int tm = 0; tm < 4; ++tm) vn[tm] = UC[tm]; \
        if (n + 2 < 64) { const char* u2 = pg8::rfl_ptr(ubase + (size_t)(n + 2) * 8192 * 4); _Pragma("unroll") for (int tm = 0; tm < 4; ++tm) UC[tm] = __builtin_nontemporal_load((const f32x4*)(u2 + lane16 + tm * 1024)); } \
        if (n > 0) { char* op = (char*)pg8::rfl_ptr(obase + (size_t)(64 * (n - 1)) * D_ * 2); \
            _Pragma("unroll") for (int tm = 0; tm < 4; ++tm) _Pragma("unroll") for (int reg = 0; reg < 4; ++reg) *(bf16*)(op + olane + (16 * tm + reg) * D_ * 2) = (bf16)cvtpk(o[tm][reg], 0.f); } \
        const float glast = rdlane(gl_all, n); \
        bf16x8 sb[4]; \
        _Pragma("unroll") for (int ks = 0; ks < 4; ++ks) sb[ks] = pack8(S[2 * ks], S[2 * ks + 1]); \
          \
        bf16x8 fw[16], fq[16], fk[8], fd[16]; bf16x8 vb[2]; \
        _Pragma("unroll") for (int i = 0; i < 16; ++i) fw[i] = *(const LAS bf16x8*)(buf + BLOB_W * 2 + (i * 64 + lane) * 16); \
        __builtin_amdgcn_sched_barrier(0); \
        _Pragma("unroll") for (int i = 0; i < 16; ++i) fq[i] = *(const LAS bf16x8*)(buf + BLOB_QG * 2 + (i * 64 + lane) * 16); \
        __builtin_amdgcn_sched_barrier(0); \
        _Pragma("unroll") for (int tm = 0; tm < 4; ++tm) _Pragma("unroll") for (int ks = 0; ks < 4; ++ks) vn[tm] = MFMA16(fw[tm * 4 + ks], sb[ks], vn[tm]); \
        __builtin_amdgcn_sched_barrier(0); \
        _Pragma("unroll") for (int i = 0; i < 8; ++i) fk[i] = *(const LAS bf16x8*)(buf + BLOB_QK * 2 + (i * 64 + lane) * 16); \
        __builtin_amdgcn_sched_barrier(0); \
        _Pragma("unroll") for (int tm = 0; tm < 4; ++tm) { o[tm] = (f32x4){0.f, 0.f, 0.f, 0.f}; \
            _Pragma("unroll") for (int ks = 0; ks < 4; ++ks) o[tm] = MFMA16(fq[tm * 4 + ks], sb[ks], o[tm]); } \
        _Pragma("unroll") for (int k2 = 0; k2 < 2; ++k2) vb[k2] = pack8(vn[2 * k2], vn[2 * k2 + 1]); \
        __builtin_amdgcn_sched_barrier(0); \
        _Pragma("unroll") for (int i = 0; i < 16; ++i) fd[i] = *(const LAS bf16x8*)(buf + BLOB_KDT * 2 + (i * 64 + lane) * 16); \
        __builtin_amdgcn_sched_barrier(0); \
        _Pragma("unroll") for (int tm = 0; tm < 4; ++tm) _Pragma("unroll") for (int k2 = 0; k2 < 2; ++k2) o[tm] = MFMA16(fk[tm * 2 + k2], vb[k2], o[tm]); \
        __builtin_amdgcn_sched_barrier(0); \
        _Pragma("unroll") for (int a = 0; a < 8; ++a) { S[a] = S[a] * glast; \
            _Pragma("unroll") for (int k2 = 0; k2 < 2; ++k2) S[a] = MFMA16(fd[a * 2 + k2], vb[k2], S[a]); } \
    asm volatile("s_waitcnt lgkmcnt(0)" ::: "memory"); __builtin_amdgcn_s_barrier(); asm volatile("" ::: "memory"); } while (0)

DI void gdn_scan2_phase(const Frame& F, const Args& A) {
    unsigned char* ws = opq(A.ws); unsigned char* big = ws + WS_BIG;
    const bf16* BLOB = (const bf16*)(big + GB_BLOB); const float* U = (const float*)(ws + WS_HID); bf16* Oraw = (bf16*)(ws + WS_Y);
    const float* GC = (const float*)(ws + WS_GALPHA);
    const int lane = F.lane, r = lane & 15, q = lane >> 4, w = F.wave;
    for (int it2 = F.bid; it2 < NB_ * 8 * 2; it2 += F.G) {
        const int item = it2 >> 1, half = it2 & 1, b = item >> 3, hh = item & 7, dvw = 4 * half + (w & 3);
        const char* src = pg8::rfl_ptr((const char*)(BLOB + (size_t)item * 64 * BLOB_ELEMS));
        __syncthreads();
        if (w >= 4) {
            const unsigned ltid16 = (unsigned)((w & 3) * 64 + lane) * 16u;
            u32x4 r0[14], r1[14], r2[14];
            SCAN_LOAD(r0, 0); SCAN_LOAD(r1, 1); SCAN_LOAD(r2, 2); asm volatile("s_waitcnt vmcnt(28)" ::: "memory"); __builtin_amdgcn_sched_barrier(0); SCAN_PUT(r0, 0);
            asm volatile("s_waitcnt lgkmcnt(0)" ::: "memory"); __builtin_amdgcn_s_barrier(); asm volatile("" ::: "memory");
#pragma unroll 1
            for (int n6 = 0; n6 < 60; n6 += 6) {
                SCAN_LSTEP(n6 + 0, 1, r0, r1); SCAN_LSTEP(n6 + 1, 0, r1, r2); SCAN_LSTEP(n6 + 2, 1, r2, r0);
                SCAN_LSTEP(n6 + 3, 0, r0, r1); SCAN_LSTEP(n6 + 4, 1, r1, r2); SCAN_LSTEP(n6 + 5, 0, r2, r0);
            }
            SCAN_LSTEP(60, 1, r0, r1); SCAN_LSTEP(61, 0, r1, r2); SCAN_LSTEP(62, 1, r2, r0); SCAN_LSTEP(63, 0, r0, r1);
        } else {
            f32x4 S[8];
#pragma unroll
            for (int a = 0; a < 8; ++a) S[a] = (f32x4){0.f, 0.f, 0.f, 0.f};
            const char* ubase = pg8::rfl_ptr((const char*)(U + (size_t)item * 64 * 8192 + (size_t)(dvw * 4) * 256));
            const char* obase = pg8::rfl_ptr((const char*)(Oraw + (size_t)b * S_ * D_ + hh * 128 + 16 * dvw));
            const unsigned lane16 = (unsigned)lane * 16u, olane = (unsigned)((4 * q) * D_ + r) * 2u;
            const float gl_all = __expf(GC[(size_t)item * S_ + 64 * lane + 63]);
            f32x4 ua[4], ub[4], o[4];
#pragma unroll
            for (int tm = 0; tm < 4; ++tm) { ua[tm] = __builtin_nontemporal_load((const f32x4*)(ubase + lane16 + tm * 1024)); ub[tm] = __builtin_nontemporal_load((const f32x4*)(ubase + 8192 * 4 + lane16 + tm * 1024)); o[tm] = (f32x4){0.f, 0.f, 0.f, 0.f}; }
            asm volatile("s_waitcnt lgkmcnt(0)" ::: "memory"); __builtin_amdgcn_s_barrier(); asm volatile("" ::: "memory");
#pragma unroll 1
            for (int n2 = 0; n2 < 64; n2 += 2) { SCAN_CSTEP(n2, 0, ua); SCAN_CSTEP(n2 + 1, 1, ub); }
            { char* op = (char*)obase + (size_t)(64 * 63) * D_ * 2;
#pragma unroll
              for (int tm = 0; tm < 4; ++tm)
#pragma unroll
                  for (int reg = 0; reg < 4; ++reg) *(bf16*)(op + olane + (16 * tm + reg) * D_ * 2) = (bf16)cvtpk(o[tm][reg], 0.f); }
        }
    }
}
#undef SCAN_LSTEP
#undef SCAN_CSTEP
#undef SCAN_LOAD
#undef SCAN_PUT
constexpr int N_PHASES = 42;
#ifndef MK_FUSED
#define MK_FUSED 1
#endif

#if MK_FUSED
typedef const __attribute__((address_space(4))) Args* CArgsP;
DI Args fresh_args() {
#if defined(__HIP_DEVICE_COMPILE__)
    CArgsP kp = (CArgsP)__builtin_amdgcn_kernarg_segment_ptr(); asm volatile("" : "+s"(kp)); Args a = *kp;
    a.x = asg(a.x); a.c = asg(a.c); a.pos = asg(a.pos); a.ada_w = asg(a.ada_w); a.ada_b = asg(a.ada_b); a.ln_g = asg(a.ln_g); a.ln_b = asg(a.ln_b);
    a.attn_w_in = asg(a.attn_w_in); a.attn_w_out = asg(a.attn_w_out); a.gdn_w_in = asg(a.gdn_w_in); a.gdn_conv_w = asg(a.gdn_conv_w); a.gdn_a_log = asg(a.gdn_a_log); a.gdn_dt_bias = asg(a.gdn_dt_bias);
    a.gdn_norm_w = asg(a.gdn_norm_w); a.gdn_w_out = asg(a.gdn_w_out); a.router_w = asg(a.router_w); a.router_bias = asg(a.router_bias); a.ew1 = asg(a.ew1); a.ew3 = asg(a.ew3); a.ew2 = asg(a.ew2);
    a.sw1 = asg(a.sw1); a.sw3 = asg(a.sw3); a.sw2 = asg(a.sw2); a.out = asg(a.out); a.ws = asg(a.ws);
    return a;
#else
    return Args{};
#endif
}
DI Frame fresh_frame(int wave_s) { Frame F; int g = gridDim.x; asm volatile("" : "+s"(g)); int b = blockIdx.x; asm volatile("" : "+s"(b)); unsigned l = 0u; asm volatile("" : "+s"(l));
    int w = wave_s; asm volatile("" : "+s"(w)); int ln; asm volatile("v_mbcnt_lo_u32_b32 %0, -1, 0\n\tv_mbcnt_hi_u32_b32 %0, -1, %0" : "=&v"(ln));
    F.lds = (LAS unsigned char*)(size_t)l; F.tid = w * 64 + ln; F.lane = ln; F.wave = w; F.G = g; F.bid = b; return F; }
#define PHF() const Args A = fresh_args(); const Frame F = fresh_frame(wave_s); \
    unsigned char* ws = opq(A.ws); LAS int* idxlds = (LAS int*)(F.lds + LDS_IDX); const LAS int* tileoff = (const LAS int*)(F.lds + LDS_TILEOFF); (void)ws; (void)idxlds; (void)tileoff;
DI void ph_pro(const int wave_s) { PHF(); prologue_phase(F, A); convert_experts(F, A, 0, 0, 0, F.G); }
DI void ph_modx(const int wave_s) { PHF(); modx_phase(F, A); }
DI void ph_attn(const int wave_s) { PHF(); attn_phase(F, A); }
DI void ph_lnr(const int wave_s, int L) { PHF(); if (L == 0) ln_router_phase<true>(F, A, L); else ln_router_phase<false>(F, A, L); }
DI void ph_lnr_dry(const int wave_s, int L) { PHF(); if (L == 0) ln_router_phase<true>(F, A, L, true); else ln_router_phase<false>(F, A, L, true); }
DI void ph_scat(const int wave_s, int L) { PHF(); moe_scatter_phase(F, A, L); }
DI void ph_lnm(const int wave_s, int L) { PHF(); ln_moe_phase(F, A, L, nullptr); }
DI void ph_lnm_dry(const int wave_s, int L) { PHF(); ln_moe_phase(F, A, L, (float*)(ws + WS_Y)); }
DI void ph_gprep(const int wave_s, int lp) { PHF(); gdn_prep2_phase(F, A, lp); }
DI void ph_gwy(const int wave_s) { PHF(); gdn_wy_phase(F, A); }
DI void ph_gscan(const int wave_s, int L) { PHF(); gdn_scan2_phase(F, A); if (F.G > 128) { convert_experts(F, A, L, 0, 64, F.G - 64); if (L == 1) convert_experts(F, A, 2, 1, 64, F.G - 64); } else { convert_experts(F, A, L, 0, 0, F.G); if (L == 1) convert_experts(F, A, 2, 1, 0, F.G); } }
DI void ph_gpost(const int wave_s, int lp) { PHF(); gdn_post_phase(F, A, lp); }
DI void ph_gemm_qkv(const int wave_s, int lp) { PHF();
    pg8::DenseOrder S; S.init(WS_H, WS_WA_IN + (size_t)lp * 9216 * D_ * 2, T_, 9216, D_, F.G, F.bid);
    pg8::EpiQKV E{(bf16*)(ws + WS_BIG), (const float*)(ws + WS_COS), (const float*)(ws + WS_SIN)};
    pg8::gemm_phase<pg8::EpiQKV, pg8::DenseOrder, true, true>(F.tid, ws, F.lds, idxlds, D_, S, E); }
DI void ph_gemm_out(const int wave_s, int lp, int isg) { PHF();
    pg8::DenseOrder S; S.init(WS_O, (isg ? WS_WG_OUT : WS_WA_OUT) + (size_t)lp * D_ * D_ * 2, T_, D_, D_, F.G, F.bid);
    pg8::EpiBf16 E{(bf16*)(ws + WS_Y), D_};
    pg8::gemm_phase<pg8::EpiBf16, pg8::DenseOrder, true, true>(F.tid, ws, F.lds, idxlds, D_, S, E); }
DI void ph_gemm_gin(const int wave_s, int lp) { PHF();
    pg8::DenseOrder S; S.init(WS_H, WS_WG_IN + (size_t)lp * 4096 * D_ * 2, T_, 4096, D_, F.G, F.bid);
    pg8::EpiBf16 E{(bf16*)(ws + WS_BIG + BIG_PROJ), 4096};
    pg8::gemm_phase<pg8::EpiBf16, pg8::DenseOrder, true, true>(F.tid, ws, F.lds, idxlds, D_, S, E); }
DI void ph_moe1(const int wave_s, int L) { PHF();
    const unsigned* gcount = (const unsigned*)(ws + WS_CTL) + CW_CNT + L * 64;
    build_tileoff(F, gcount);
    pg8::MoeOrder<true> S; S.A = (unsigned)WS_H; S.Bt = (unsigned)(L == 2 ? WS_WEB : WS_WE1); S.K = D_; S.nct_log = 1; S.nunits = __builtin_amdgcn_readfirstlane(tileoff[65]) * 2; S.G = F.G; S.c = F.bid;
    S.idxoff = (unsigned)WS_ETOK; S.tileoff = tileoff; S.ecnt = (const LAS int*)(F.lds + LDS_ECNT); S.bstride = (unsigned)(512 * D_ * 2);
    pg8::EpiSwiGLU E{(bf16*)(ws + WS_HID)};
    pg8::gemm_phase<pg8::EpiSwiGLU, pg8::MoeOrder<true>, true, true>(F.tid, ws, F.lds, idxlds, D_, S, E); }
DI void ph_moe2(const int wave_s, int L) { PHF();
    const unsigned* gcount = (const unsigned*)(ws + WS_CTL) + CW_CNT + L * 64;
    build_tileoff(F, gcount);
    pg8::MoeOrder<false> S; S.A = (unsigned)WS_HID; S.Bt = (unsigned)(L == 2 ? WS_WEB + 65 * MiB : WS_WE2); S.K = 256; S.nct_log = 2; S.nunits = __builtin_amdgcn_readfirstlane(tileoff[(YS_BF16 && !YS_MERGED) ? 64 : 65]) * 4; S.G = F.G; S.c = F.bid;
    S.idxoff = (unsigned)WS_EW; S.tileoff = tileoff; S.ecnt = (const LAS int*)(F.lds + LDS_ECNT); S.bstride = (unsigned)(D_ * 256 * 2);
    pg8::EpiScale E{ws + WS_BIG, 256 * __builtin_amdgcn_readfirstlane(tileoff[64])};
    pg8::gemm_phase<pg8::EpiScale, pg8::MoeOrder<false>, false, false>(F.tid, ws, F.lds, idxlds, 256, S, E); }
DI void ph_moe2s(const int wave_s, int L) { PHF();
    __syncthreads();
    const size_t s0 = (size_t)(256 * __builtin_amdgcn_readfirstlane(((const LAS int*)(F.lds + LDS_TILEOFF))[64]));
    pg8::DenseOrder S; S.init(WS_HID + s0 * 256 * 2, (L == 2 ? WS_WEB + 65 * MiB : WS_WE2) + (size_t)NEXP * D_ * 256 * 2, T_, D_, 256, F.G, F.bid);
    pg8::EpiBf16 E{(bf16*)(ws + WS_BIG + WS_YS_OFF), D_};
    pg8::gemm_phase<pg8::EpiBf16, pg8::DenseOrder, false, false>(F.tid, ws, F.lds, idxlds, 256, S, E); }

DI void grid_bar(const int wave_s) { PHF(); XcdBarrier b; b.bar = (unsigned*)(ws + WS_CTL) + CW_BAR; volatile LAS unsigned* misc = (volatile LAS unsigned*)(F.lds + LDS_MISC); b.st = misc + 8;
    b.x = (unsigned)__builtin_amdgcn_readfirstlane((int)misc[10]); xcd_barrier(b, F.tid); }
__global__ void __launch_bounds__(NTHR, 2) mk_fwd(Args Ain) {
    extern __shared__ __attribute__((aligned(16))) unsigned char lds_raw[];
    LAS unsigned char* lds = (LAS unsigned char*)lds_raw;
    for (int u = threadIdx.x; u < (LDS_BYTES - RING_BYTES) / 4; u += NTHR) ((LAS unsigned*)(lds + RING_BYTES))[u] = 0u;
    __syncthreads();
    const int wave_s = __builtin_amdgcn_readfirstlane((int)threadIdx.x >> 6);
    { XcdBarrier bar = xcd_barrier_post((unsigned*)(Ain.ws + WS_CTL) + CW_BAR, (volatile LAS unsigned*)(lds + LDS_MISC) + 8);
      if (threadIdx.x == 0) ((volatile LAS unsigned*)(lds + LDS_MISC))[10] = bar.x; }
    __syncthreads();
#ifndef REP_BAR
#define REP_BAR 1
#define REP_PRO 1
#define REP_POST 1
#define REP_QKV 1
#define REP_OUT 1
#define REP_GIN 1
#define REP_M1 1
#define REP_M2 1
#define REP_LNM 1
#define REP_LNR 1
#endif
#define GBAR() do { for (int _b = 0; _b < REP_BAR; ++_b) grid_bar(wave_s); } while (0)
#ifndef REP_ATTN
#define REP_ATTN 1
#define REP_SCAN 1
#define REP_GEMM 1
#define REP_PREP 1
#define REP_CONV 1
#define REP_WY 1
#endif
    for (int r = 0; r < REP_PRO; ++r) { ph_pro(wave_s); GBAR(); }
    ph_modx(wave_s); GBAR();
#pragma unroll 1
    for (int L = 0; L < 4; ++L) {
        const int lp = L >> 1;
        if ((L & 1) == 0) { for (int r = 0; r < REP_QKV; ++r) { ph_gemm_qkv(wave_s, lp); GBAR(); } for (int r = 0; r < REP_ATTN; ++r) { ph_attn(wave_s); GBAR(); } for (int r = 0; r < REP_OUT; ++r) { ph_gemm_out(wave_s, lp, 0); GBAR(); } }
        else { for (int r = 0; r < REP_GIN; ++r) { ph_gemm_gin(wave_s, lp); GBAR(); } for (int r = 0; r < REP_PREP; ++r) { ph_gprep(wave_s, lp); GBAR(); } for (int r = 0; r < REP_WY; ++r) { ph_gwy(wave_s); GBAR(); } for (int r = 0; r < REP_SCAN; ++r) { ph_gscan(wave_s, L); GBAR(); } for (int r = 0; r < REP_POST; ++r) { ph_gpost(wave_s, lp); GBAR(); } for (int r = 0; r < REP_OUT; ++r) { ph_gemm_out(wave_s, lp, 1); GBAR(); } }
        for (int r = 1; r < REP_LNR; ++r) { ph_lnr_dry(wave_s, L); GBAR(); }
        ph_lnr(wave_s, L); GBAR();
        for (int r = 0; r < REP_M1; ++r) { ph_moe1(wave_s, L); GBAR(); }
        for (int r = 0; r < REP_M2; ++r) { ph_moe2(wave_s, L); if (YS_BF16 && !YS_MERGED) ph_moe2s(wave_s, L); GBAR(); }
        for (int r = 1; r < REP_LNM; ++r) { ph_lnm_dry(wave_s, L); GBAR(); }
        ph_lnm(wave_s, L); if (L < 3) GBAR();
    }
#undef GBAR
}
#else

#define MKF() extern __shared__ __attribute__((aligned(16))) unsigned char lds_raw[]; Frame F; F.lds = (LAS unsigned char*)lds_raw; F.tid = threadIdx.x; F.lane = F.tid & 63; \
    F.wave = __builtin_amdgcn_readfirstlane(F.tid >> 6); F.G = gridDim.x; F.bid = blockIdx.x; unsigned char* ws = opq(A.ws); LAS int* idxlds = (LAS int*)(F.lds + LDS_IDX); \
    const LAS int* tileoff = (const LAS int*)(F.lds + LDS_TILEOFF); (void)ws; (void)idxlds; (void)tileoff; \
    for (int u = F.tid; u < (LDS_BYTES - RING_BYTES) / 4; u += NTHR) ((LAS unsigned*)(F.lds + RING_BYTES))[u] = 0u; __syncthreads();
__global__ void __launch_bounds__(NTHR, 2) k_pro(Args A) { MKF(); prologue_phase(F, A); }
__global__ void __launch_bounds__(NTHR, 2) k_modx(Args A) { MKF(); modx_phase(F, A); }
__global__ void __launch_bounds__(NTHR, 2) k_attn(Args A) { MKF(); attn_phase(F, A); }
__global__ void __launch_bounds__(NTHR, 2) k_lnr(Args A) { MKF(); const int L = A.ph_lo; ln_router_phase<false>(F, A, L); }
__global__ void __launch_bounds__(NTHR, 2) k_scat(Args A) { MKF(); moe_scatter_phase(F, A, A.ph_lo); convert_experts(F, A, A.ph_lo); }
__global__ void __launch_bounds__(NTHR, 2) k_lnm(Args A) { MKF(); const int L = A.ph_lo; ln_moe_phase(F, A, L, nullptr); }
__global__ void __launch_bounds__(NTHR, 2) k_gprep(Args A) { MKF(); gdn_prep_phase(F, A, A.ph_lo); }
__global__ void __launch_bounds__(NTHR, 2) k_gscan(Args A) { MKF(); gdn_scan_phase(F, A); }
__global__ void __launch_bounds__(NTHR, 2) k_gpost(Args A) { MKF(); gdn_post_phase(F, A, A.ph_lo); }
__global__ void __launch_bounds__(NTHR, 2) k_gemm_qkv(Args A) { MKF(); const int lp = A.ph_lo;
    pg8::DenseOrder S; S.init(WS_H, WS_WA_IN + (size_t)lp * 9216 * D_ * 2, T_, 9216, D_, F.G, F.bid);
    pg8::EpiQKV E{(bf16*)(ws + WS_BIG), (const float*)(ws + WS_COS), (const float*)(ws + WS_SIN)};
    pg8::gemm_phase<pg8::EpiQKV, pg8::DenseOrder, true, true>(F.tid, ws, F.lds, idxlds, D_, S, E); }
__global__ void __launch_bounds__(NTHR, 2) k_gemm_out(Args A) { MKF(); const int lp = A.ph_lo >> 1, isg = A.ph_lo & 1;
    pg8::DenseOrder S; S.init(WS_O, (isg ? WS_WG_OUT : WS_WA_OUT) + (size_t)lp * D_ * D_ * 2, T_, D_, D_, F.G, F.bid);
    pg8::EpiF32 E{(float*)(ws + WS_Y), D_};
    pg8::gemm_phase<pg8::EpiF32, pg8::DenseOrder, true, true>(F.tid, ws, F.lds, idxlds, D_, S, E); }
__global__ void __launch_bounds__(NTHR, 2) k_gemm_gin(Args A) { MKF(); const int lp = A.ph_lo;
    pg8::DenseOrder S; S.init(WS_H, WS_WG_IN + (size_t)lp * 4096 * D_ * 2, T_, 4096, D_, F.G, F.bid);
    pg8::EpiBf16 E{(bf16*)(ws + WS_BIG + BIG_PROJ), 4096};
    pg8::gemm_phase<pg8::EpiBf16, pg8::DenseOrder, true, true>(F.tid, ws, F.lds, idxlds, D_, S, E); }
__global__ void __launch_bounds__(NTHR, 2) k_moe1(Args A) { MKF();
    const unsigned* gcount = (const unsigned*)(ws + WS_CTL) + CW_CNT + A.ph_lo * 64;
    build_tileoff(F, gcount);
    pg8::MoeOrder<true> S; S.A = (unsigned)WS_H; S.Bt = (unsigned)(L == 2 ? WS_WEB : WS_WE1); S.K = D_; S.nct_log = 1; S.nunits = __builtin_amdgcn_readfirstlane(tileoff[65]) * 2; S.G = F.G; S.c = F.bid;
    S.idxoff = (unsigned)WS_ETOK; S.tileoff = tileoff; S.ecnt = (const LAS int*)(F.lds + LDS_ECNT); S.bstride = (unsigned)(512 * D_ * 2);
    pg8::EpiSwiGLU E{(bf16*)(ws + WS_HID)};
    pg8::gemm_phase<pg8::EpiSwiGLU, pg8::MoeOrder<true>, true, true>(F.tid, ws, F.lds, idxlds, D_, S, E); }
__global__ void __launch_bounds__(NTHR, 2) k_moe2(Args A) { MKF();
    const unsigned* gcount = (const unsigned*)(ws + WS_CTL) + CW_CNT + A.ph_lo * 64;
    build_tileoff(F, gcount);
    pg8::MoeOrder<false> S; S.A = (unsigned)WS_HID; S.Bt = (unsigned)(L == 2 ? WS_WEB + 65 * MiB : WS_WE2); S.K = 256; S.nct_log = 2; S.nunits = __builtin_amdgcn_readfirstlane(tileoff[65]) * 4; S.G = F.G; S.c = F.bid;
    S.idxoff = (unsigned)WS_EW; S.tileoff = tileoff; S.ecnt = (const LAS int*)(F.lds + LDS_ECNT); S.bstride = (unsigned)(D_ * 256 * 2);
    pg8::EpiScale E{ws + WS_BIG, 256 * __builtin_amdgcn_readfirstlane(tileoff[64])};
    pg8::gemm_phase<pg8::EpiScale, pg8::MoeOrder<false>, false, false>(F.tid, ws, F.lds, idxlds, 256, S, E); }
#endif
extern "C" void kernel_launch(void* const* d_in, const int* in_sizes, int n_in, void* d_out, int out_size, void* d_ws, size_t ws_size, hipStream_t stream) {
    static int grid = 0;
    if (grid == 0) {
        if (n_in != 23 || in_sizes[0] != T_ * D_ || out_size != T_ * D_ || ws_size < WS_END) {
            fprintf(stderr, "kernel_launch: unexpected shapes (n_in %d, in0 %d, out %d, ws %zu < %zu); nothing launched\n", n_in, n_in > 0 ? in_sizes[0] : -1, out_size, ws_size, (size_t)WS_END); grid = -1; return; }
        int dev = 0, cus = 0, per_cu = 0;
        if (hipGetDevice(&dev) != hipSuccess || hipDeviceGetAttribute(&cus, hipDeviceAttributeMultiprocessorCount, dev) != hipSuccess) { grid = -1; return; }
#if MK_FUSED
        if (hipFuncSetAttribute((const void*)mk_fwd, hipFuncAttributeMaxDynamicSharedMemorySize, LDS_BYTES) != hipSuccess) { fprintf(stderr, "kernel_launch: hipFuncSetAttribute failed\n"); grid = -1; return; }
        if (hipOccupancyMaxActiveBlocksPerMultiprocessor(&per_cu, (const void*)mk_fwd, NTHR, LDS_BYTES) != hipSuccess || per_cu < 1)
            fprintf(stderr, "kernel_launch: note: occupancy query reports %d workgroups per CU\n", per_cu);
#else
        { const void* ks[] = {(const void*)k_pro, (const void*)k_modx, (const void*)k_attn, (const void*)k_lnr, (const void*)k_scat, (const void*)k_lnm, (const void*)k_gprep, (const void*)k_gscan, (const void*)k_gpost,
                              (const void*)k_gemm_qkv, (const void*)k_gemm_out, (const void*)k_gemm_gin, (const void*)k_moe1, (const void*)k_moe2};
          for (const void* k : ks) if (hipFuncSetAttribute(k, hipFuncAttributeMaxDynamicSharedMemorySize, LDS_BYTES) != hipSuccess) { fprintf(stderr, "kernel_launch: hipFuncSetAttribute failed\n"); grid = -1; return; } }
        (void)per_cu;
#endif
        (void)hipGetLastError();
        grid = cus;
    }
    if (grid < 0) return;
    (void)hipMemsetAsync((char*)d_ws + WS_CTL, 0, CTL_ZERO_BYTES, stream);
    Args a{};
    a.x = (const float*)d_in[0]; a.c = (const float*)d_in[1]; a.pos = (const int*)d_in[2]; a.ada_w = (const float*)d_in[3]; a.ada_b = (const float*)d_in[4];
    a.ln_g = (const float*)d_in[5]; a.ln_b = (const float*)d_in[6]; a.attn_w_in = (const float*)d_in[7]; a.attn_w_out = (const float*)d_in[8];
    a.gdn_w_in = (const float*)d_in[9]; a.gdn_conv_w = (const float*)d_in[10]; a.gdn_a_log = (const float*)d_in[11]; a.gdn_dt_bias = (const float*)d_in[12];
    a.gdn_norm_w = (const float*)d_in[13]; a.gdn_w_out = (const float*)d_in[14]; a.router_w = (const float*)d_in[15]; a.router_bias = (const float*)d_in[16];
    a.ew1 = (const float*)d_in[17]; a.ew3 = (const float*)d_in[18]; a.ew2 = (const float*)d_in[19]; a.sw1 = (const float*)d_in[20]; a.sw3 = (const float*)d_in[21]; a.sw2 = (const float*)d_in[22];
    a.out = (float*)d_out; a.ws = (unsigned char*)d_ws;
#if MK_FUSED
    a.ph_lo = 0; a.ph_hi = N_PHASES;
    hipLaunchKernelGGL(mk_fwd, dim3(grid), dim3(NTHR), LDS_BYTES, stream, a);
#else
#define LAUNCH(k, arg) do { a.ph_lo = (arg); a.ph_hi = (arg) + 1; hipLaunchKernelGGL(k, dim3(grid), dim3(NTHR), LDS_BYTES, stream, a); } while (0)
    LAUNCH(k_pro, 0); LAUNCH(k_modx, 0);
    for (int L = 0; L < 4; ++L) {
        const int lp = L >> 1;
        if ((L & 1) == 0) { LAUNCH(k_gemm_qkv, lp); LAUNCH(k_attn, 0); LAUNCH(k_gemm_out, 2 * lp); }
        else { LAUNCH(k_gemm_gin, lp); LAUNCH(k_gprep, lp); LAUNCH(k_gscan, 0); LAUNCH(k_gpost, lp); LAUNCH(k_gemm_out, 2 * lp + 1); }
        LAUNCH(k_lnr, L); LAUNCH(k_scat, L); LAUNCH(k_moe1, L); LAUNCH(k_moe2, L); LAUNCH(k_lnm, L);
    }
#undef LAUNCH
#endif
    const hipError_t le = hipPeekAtLastError();
    if (le != hipSuccess) fprintf(stderr, "kernel_launch: launch failed: %s\n", hipGetErrorName(le));
}
```

```cpp
#include <hip/hip_runtime.h>
#include <cstdio>
#include <cstdint>

#define GAS __attribute__((address_space(1)))
#define LAS __attribute__((address_space(3)))
typedef unsigned short bf16;
typedef unsigned u32x4 __attribute__((ext_vector_type(4)));
typedef unsigned u32x2 __attribute__((ext_vector_type(2)));
typedef float f32x2 __attribute__((ext_vector_type(2)));
typedef float f32x4 __attribute__((ext_vector_type(4)));
typedef float f32x16 __attribute__((ext_vector_type(16)));
typedef short bf16x8 __attribute__((ext_vector_type(8)));
typedef short s16x4 __attribute__((ext_vector_type(4)));
typedef __bf16 bf16x2_t __attribute__((ext_vector_type(2)));
#define DI __device__ __forceinline__

DI unsigned cvtpk(float lo, float hi) { f32x2 v = {lo, hi}; bf16x2_t b = __builtin_convertvector(v, bf16x2_t); return __builtin_bit_cast(unsigned, b); }
DI unsigned cvtpk_fp8(float a, float b, float c, float d) { int w = __builtin_amdgcn_cvt_pk_fp8_f32(a, b, 0, false); w = __builtin_amdgcn_cvt_pk_fp8_f32(c, d, w, true); return (unsigned)w; }
constexpr bool YS_BF16 = true;
constexpr bool YS_MERGED = true;
constexpr float YE_SCALE = 16.0f;
DI float silu_f(float a) { return a * __builtin_amdgcn_rcpf(1.0f + __expf(-a)); }
DI float bf_lo(unsigned u) { return __builtin_bit_cast(float, u << 16); }
DI float bf_hi(unsigned u) { return __builtin_bit_cast(float, u & 0xffff0000u); }
template <int M> DI float shx(float v) { return __builtin_bit_cast(float, __builtin_amdgcn_ds_swizzle(__builtin_bit_cast(int, v), (M << 10) | 0x1f)); }
DI float bperm(float v, int srclane) { return __builtin_bit_cast(float, __builtin_amdgcn_ds_bpermute(srclane << 2, __builtin_bit_cast(int, v))); }
DI float rdlane(float v, int l) { return __builtin_bit_cast(float, __builtin_amdgcn_readlane(__builtin_bit_cast(int, v), l)); }
template <int CTRL> DI float dppmov(float v) { return __builtin_bit_cast(float, __builtin_amdgcn_update_dpp(0, __builtin_bit_cast(int, v), CTRL, 0xf, 0xf, true)); }
DI float wave_sum(float v) { v += dppmov<0xB1>(v); v += dppmov<0x4E>(v); v += dppmov<0x141>(v); v += dppmov<0x140>(v); return (rdlane(v, 0) + rdlane(v, 16)) + (rdlane(v, 32) + rdlane(v, 48)); }
DI float wave_max(float v) { v = fmaxf(v, dppmov<0xB1>(v)); v = fmaxf(v, dppmov<0x4E>(v)); v = fmaxf(v, dppmov<0x141>(v)); v = fmaxf(v, dppmov<0x140>(v)); return fmaxf(fmaxf(rdlane(v, 0), rdlane(v, 16)), fmaxf(rdlane(v, 32), rdlane(v, 48))); }
#define LDS_WAIT() asm volatile("s_waitcnt lgkmcnt(0)" ::: "memory")
#define VM_WAIT() asm volatile("s_waitcnt vmcnt(0)" ::: "memory")

namespace pg8 {
constexpr int BM = 256, BK = 64, HALF = 128, HTB = HALF * BK * 2, STAGE_BYTES = 8 * HTB;
DI int lds_byte(int r, int c) { const int st = (r >> 4) * 2 + (c >> 5), rr = r & 15, cc = c & 31, ob = rr * 64 + cc * 2; return st * 1024 + (ob ^ (((ob >> 9) & 1) << 5)); }
DI void stage_rc(int b, int& R, int& C) { const int st = b / 1024, sb = b % 1024, swz = sb ^ (((sb >> 9) & 1) << 5); R = (st >> 1) * 16 + swz / 64; C = (st & 1) * 32 + (swz % 64) / 2; }
DI int perm32(int rho) { const int n = rho >> 4, i = rho & 15; return 8 * (i >> 2) + 4 * n + (i & 3); }

DI const char* rfl_ptr(const char* p) {
    const unsigned long long v = (unsigned long long)p; const unsigned lo = __builtin_amdgcn_readfirstlane((unsigned)v), hi = __builtin_amdgcn_readfirstlane((unsigned)(v >> 32));
    return (const char*)(const __attribute__((address_space(1))) char*)(((unsigned long long)hi << 32) | lo); }
struct Unit { unsigned a; unsigned b; int r0; int c0; int e; int rb; int nv; };

template <class Epi, class Sched, bool ALIGN_EPI, bool SP2>
DI void gemm_phase(const int tid, const void* wsbase, LAS unsigned char* lds, LAS int* idxlds, const int K, const Sched& S, const Epi& E) {
    const __amdgpu_buffer_rsrc_t rsrc = __builtin_amdgcn_make_buffer_rsrc((void*)wsbase, 0, 0xffffffff, 0x00020000);
    const int wid = __builtin_amdgcn_readfirstlane(tid >> 6), lane = tid & 63, wr = wid >> 2, wc = wid & 3, fr = lane & 15, fq = lane >> 4;
    const int nt = K / BK;
    unsigned voffB[2], voffA[2][2];
#pragma unroll
    for (int i = 0; i < 2; ++i) { int R, C; stage_rc(tid * 16 + i * 8192, R, C); const int Rb = Epi::PERM ? ((R & ~31) + perm32(R & 31)) : R;
        voffB[i] = (unsigned)(Rb * K + C) * 2u;
        voffA[0][i] = (unsigned)(R * K + C) * 2u; voffA[1][i] = (unsigned)((R + HALF) * K + C) * 2u; }
    const unsigned kstep = (unsigned)(BK * 2);
    const unsigned hstep = (unsigned)(HALF * K * 2);
    const unsigned ldsw = (unsigned)wid * 1024u;
    const int aoff = lds_byte(wr * 64 + fr, fq * 8), boff = lds_byte(wc * 32 + fr, fq * 8);
#define PG8_SA(b, h) (((b) * 2 + (h)) * HTB)
#define PG8_SB(b, h) ((4 + (b) * 2 + (h)) * HTB)
#define PG8_STAGE(bufoff, soff, voff) do { const int _so = __builtin_amdgcn_readfirstlane((int)(soff)); _Pragma("unroll") for (int _i = 0; _i < 2; ++_i) \
        __builtin_amdgcn_raw_ptr_buffer_load_lds(rsrc, (LAS void*)(lds + (bufoff) + ldsw + _i * 8192), 16, (int)(voff)[_i], _so, 0, 0); } while (0)
#define PG8_LDA(dst, b, h) do { _Pragma("unroll") for (int m = 0; m < 4; ++m) _Pragma("unroll") for (int k = 0; k < 2; ++k) dst[m][k] = *(const LAS bf16x8*)(lds + PG8_SA(b, h) + aoff + m * 2048 + k * 1024); } while (0)
#define PG8_LDB(dst, b, h) do { _Pragma("unroll") for (int n = 0; n < 2; ++n) _Pragma("unroll") for (int k = 0; k < 2; ++k) dst[n][k] = *(const LAS bf16x8*)(lds + PG8_SB(b, h) + boff + n * 2048 + k * 1024); } while (0)
#define PG8_MMA(ai, bj, At, Bt) do { __builtin_amdgcn_s_setprio(1); _Pragma("unroll") for (int m = 0; m < 4; ++m) _Pragma("unroll") for (int n = 0; n < 2; ++n) _Pragma("unroll") for (int k = 0; k < 2; ++k) \
        acc[ai][bj][m][n] = __builtin_amdgcn_mfma_f32_16x16x32_bf16(Bt[n][k], At[m][k], acc[ai][bj][m][n], 0, 0, 0); __builtin_amdgcn_s_setprio(0); } while (0)
#define PG8_WAIT_V(n) asm volatile("s_waitcnt vmcnt(" #n ")" ::: "memory")
#define PG8_WAIT_L(n) asm volatile("s_waitcnt lgkmcnt(" #n ")" ::: "memory")
#define PG8_BAR __builtin_amdgcn_s_barrier()
#define PG8_SCHED __builtin_amdgcn_sched_barrier(0)
#define PG8_IDX_ISSUE(u, slot) __builtin_amdgcn_raw_ptr_buffer_load_lds(rsrc, (LAS void*)(idxlds + (slot) * 256 + (wid & 3) * 64), 4, lane * 4, \
        __builtin_amdgcn_readfirstlane((int)(S.idxoff + (unsigned)((u).rb + (wid & 3) * 64) * 4u)), 0, 0)
#define PG8_IDX_READ(dst, h_, slot, nv_) do { int _t = tid; asm volatile("" : "+v"(_t));   \
        _Pragma("unroll") for (int _i = 0; _i < 2; ++_i) { int _R, _C; stage_rc(_t * 16 + _i * 8192, _R, _C); \
        const int _ix = ((h_) * HALF + _R) < (nv_) ? idxlds[(slot) * 256 + (h_) * HALF + _R] : S.padrow;        \
        dst[_i] = (unsigned)_ix * (unsigned)(K * 2) + (unsigned)(_C * 2); } } while (0)
    Unit cur, nxt; int ui = 0;
    if (!S.next(0, cur)) return;
    f32x4 acc[2][2][4][2];
#pragma unroll
    for (int a = 0; a < 2; ++a)
#pragma unroll
        for (int b = 0; b < 2; ++b)
#pragma unroll
            for (int m = 0; m < 4; ++m)
#pragma unroll
                for (int n = 0; n < 2; ++n) acc[a][b][m][n] = (f32x4){0.f, 0.f, 0.f, 0.f};
    bf16x8 At[4][2], B0[2][2], B1[2][2];
    unsigned cA = cur.a, cB = cur.b;
    if constexpr (Sched::GATHER || Epi::ROWAUX) {
        PG8_IDX_ISSUE(cur, 0); PG8_WAIT_V(0); PG8_BAR;     asm volatile("" ::: "memory");
        if constexpr (Sched::GATHER) { PG8_IDX_READ(voffA[0], 0, 0, cur.nv); PG8_IDX_READ(voffA[1], 1, 0, cur.nv); }
    }
    if constexpr (SP2) {
        PG8_STAGE(PG8_SB(0, 0), cB, voffB); PG8_STAGE(PG8_SB(0, 1), cB + hstep, voffB); PG8_STAGE(PG8_SA(0, 0), cA, voffA[0]); PG8_STAGE(PG8_SA(0, 1), cA, voffA[1]);
        if (wr == 1) PG8_BAR;
        PG8_WAIT_V(2); PG8_BAR;
        PG8_STAGE(PG8_SB(1, 0), cB + kstep, voffB); PG8_STAGE(PG8_SA(1, 0), cA + kstep, voffA[0]); PG8_STAGE(PG8_SB(1, 1), cB + hstep + kstep, voffB);
        PG8_WAIT_V(6); PG8_BAR;
    } else {
        PG8_STAGE(PG8_SB(0, 0), cB, voffB); PG8_STAGE(PG8_SA(0, 0), cA, voffA[0]); PG8_STAGE(PG8_SB(0, 1), cB + hstep, voffB); PG8_STAGE(PG8_SA(0, 1), cA, voffA[1]);
        if (wr == 1) PG8_BAR;
        PG8_WAIT_V(4); PG8_BAR;
        PG8_STAGE(PG8_SB(1, 0), cB + kstep, voffB); PG8_STAGE(PG8_SA(1, 0), cA + kstep, voffA[0]); PG8_STAGE(PG8_SB(1, 1), cB + hstep + kstep, voffB);
        PG8_WAIT_V(6); PG8_BAR;
    }
    for (;;) {
        const bool has_next = S.next(ui + 1, nxt);
        const unsigned nA = has_next ? nxt.a : cA, nB = has_next ? nxt.b : cB;
        for (int t = 0; t < nt; t += 2) {
            const bool last = (t == nt - 2);
            const unsigned a1 = cA + (unsigned)(t + 1) * kstep;
            const unsigned a2 = last ? nA : cA + (unsigned)(t + 2) * kstep, b2 = last ? nB : cB + (unsigned)(t + 2) * kstep;
            const unsigned a3 = a2 + kstep, b3 = b2 + kstep;
            if constexpr (Sched::GATHER || Epi::ROWAUX) { if (t == 0 && has_next) PG8_IDX_ISSUE(nxt, (ui + 1) % 3); }
            if constexpr (Sched::GATHER) { if (last && has_next) PG8_IDX_READ(voffA[0], 0, (ui + 1) % 3, nxt.nv); }
#define PG8_NEXT_H1() do { if constexpr (Sched::GATHER) { if (last && has_next) PG8_IDX_READ(voffA[1], 1, (ui + 1) % 3, nxt.nv); } } while (0)
            if constexpr (SP2) {
            PG8_LDB(B0, 0, 0); PG8_LDB(B1, 0, 1); PG8_SCHED; PG8_LDA(At, 0, 0); PG8_STAGE(PG8_SA(1, 1), a1, voffA[1]); PG8_NEXT_H1();
            PG8_WAIT_V(8); PG8_WAIT_L(0); PG8_BAR; PG8_MMA(0, 0, At, B0); PG8_MMA(0, 1, At, B1); PG8_BAR; PG8_SCHED;
            PG8_LDA(At, 0, 1); PG8_STAGE(PG8_SB(0, 0), b2, voffB); PG8_STAGE(PG8_SB(0, 1), b2 + hstep, voffB); PG8_STAGE(PG8_SA(0, 0), a2, voffA[0]);
            PG8_WAIT_V(8); PG8_WAIT_L(0); PG8_BAR; PG8_MMA(1, 0, At, B0); PG8_MMA(1, 1, At, B1); PG8_BAR; PG8_SCHED;
            PG8_LDB(B0, 1, 0); PG8_LDB(B1, 1, 1); PG8_SCHED; PG8_LDA(At, 1, 0); PG8_STAGE(PG8_SA(0, 1), a2, voffA[1]);
            PG8_WAIT_V(8); PG8_WAIT_L(0); PG8_BAR; PG8_MMA(0, 0, At, B0); PG8_MMA(0, 1, At, B1); PG8_BAR; PG8_SCHED;
            PG8_LDA(At, 1, 1); PG8_STAGE(PG8_SB(1, 0), b3, voffB); PG8_STAGE(PG8_SB(1, 1), b3 + hstep, voffB); PG8_STAGE(PG8_SA(1, 0), a3, voffA[0]);
            PG8_WAIT_V(8); PG8_WAIT_L(0); PG8_BAR; PG8_MMA(1, 0, At, B0); PG8_MMA(1, 1, At, B1); PG8_BAR; PG8_SCHED;
            } else {
            PG8_LDB(B0, 0, 0); PG8_SCHED; PG8_LDA(At, 0, 0); PG8_STAGE(PG8_SA(1, 1), a1, voffA[1]); PG8_NEXT_H1();
            PG8_WAIT_L(8); PG8_BAR; PG8_WAIT_L(0); PG8_MMA(0, 0, At, B0); PG8_BAR; PG8_SCHED;
            PG8_LDB(B1, 0, 1); PG8_STAGE(PG8_SB(0, 0), b2, voffB);
            PG8_BAR; PG8_WAIT_L(0); PG8_MMA(0, 1, At, B1); PG8_BAR;
            PG8_LDA(At, 0, 1); PG8_STAGE(PG8_SA(0, 0), a2, voffA[0]);
            PG8_BAR; PG8_WAIT_L(0); PG8_MMA(1, 0, At, B0); PG8_BAR; PG8_SCHED;
            PG8_STAGE(PG8_SB(0, 1), b2 + hstep, voffB);
            PG8_WAIT_V(6); PG8_BAR; PG8_MMA(1, 1, At, B1); PG8_BAR;
            PG8_LDB(B0, 1, 0); PG8_SCHED; PG8_LDA(At, 1, 0); PG8_STAGE(PG8_SA(0, 1), a2, voffA[1]);
            PG8_WAIT_L(8); PG8_BAR; PG8_WAIT_L(0); PG8_MMA(0, 0, At, B0); PG8_BAR; PG8_SCHED;
            PG8_LDB(B1, 1, 1); PG8_STAGE(PG8_SB(1, 0), b3, voffB);
            PG8_BAR; PG8_WAIT_L(0); PG8_MMA(0, 1, At, B1); PG8_BAR;
            PG8_LDA(At, 1, 1); PG8_STAGE(PG8_SA(1, 0), a3, voffA[0]);
            PG8_BAR; PG8_WAIT_L(0); PG8_MMA(1, 0, At, B0); PG8_BAR; PG8_SCHED;
            PG8_STAGE(PG8_SB(1, 1), b3 + hstep, voffB);
            PG8_WAIT_V(6); PG8_BAR; PG8_MMA(1, 1, At, B1); PG8_BAR;
            }
        }
        if constexpr (ALIGN_EPI) { if (wr == 0) PG8_BAR; }
        if constexpr (Epi::ROWAUX) E(acc, cur, wr, wc, fr, fq, idxlds + (ui % 3) * 256); else E(acc, cur, wr, wc, fr, fq);
        if (!has_next) break;
#pragma unroll
        for (int a = 0; a < 2; ++a)
#pragma unroll
            for (int b = 0; b < 2; ++b)
#pragma unroll
                for (int m = 0; m < 4; ++m)
#pragma unroll
                    for (int n = 0; n < 2; ++n) acc[a][b][m][n] = (f32x4){0.f, 0.f, 0.f, 0.f};
        cur = nxt; cA = nA; cB = nB; ++ui;
        if constexpr (ALIGN_EPI) { if (wr == 1) PG8_BAR; }
    }
    PG8_WAIT_V(0);
    if constexpr (!ALIGN_EPI) { if (wr == 0) PG8_BAR; }
    PG8_BAR;
#undef PG8_SA
#undef PG8_SB
#undef PG8_STAGE
#undef PG8_LDA
#undef PG8_LDB
#undef PG8_MMA
#undef PG8_WAIT_V
#undef PG8_WAIT_L
#undef PG8_BAR
#undef PG8_SCHED
#undef PG8_IDX_ISSUE
#undef PG8_IDX_READ
#undef PG8_NEXT_H1
}
}
constexpr int T_ = 16384, D_ = 1024, NB_ = 4, S_ = 4096, NEXP = 64, TOPK = 8;
constexpr int ECAP = 16384;
constexpr int PMAX = 163840;
constexpr float LN_EPS = 1e-5f, RMS_EPS = 1e-6f;
constexpr float ALPHA_DN = 1.6817928305074290f;
constexpr float QSCALE = 0.125f * 1.4426950408889634f;

namespace pg8 {
constexpr int NXCD = 8, WGM = 8;
struct DenseOrder {
    static constexpr bool GATHER = false;
    unsigned A, Bt; int K; int nM, nN, nwg, G, c; unsigned idxoff; static constexpr int padrow = 0;
    DI void init(size_t A_, size_t Bt_, int M, int N, int K_, int G_, int c_) { A = (unsigned)A_; Bt = (unsigned)Bt_; K = K_; nM = M / BM; nN = N / BM; nwg = nM * nN; G = G_; c = c_; idxoff = 0u; }
    DI bool next(int i, Unit& u) const {
        const long L = (long)i * G + c; if (L >= nwg) return false;
        int wgid = (int)L; { const int q = nwg / NXCD, r = nwg % NXCD, xcd = wgid % NXCD, off = wgid / NXCD; wgid = (xcd < r ? xcd * (q + 1) : r * (q + 1) + (xcd - r) * q) + off; }
        const int nig = WGM * nN, gid = wgid / nig, fm = gid * WGM, gsz = (nM - fm) < WGM ? (nM - fm) : WGM;
        const int pm = fm + ((wgid % nig) % gsz), pn = (wgid % nig) / gsz;
        u.a = A + (unsigned)(pm * BM * K * 2); u.b = Bt + (unsigned)(pn * BM * K * 2); u.r0 = pm * BM; u.c0 = pn * BM; u.e = 0; u.rb = 0; u.nv = BM; return true;
    }
};
template <bool GATH> struct MoeOrder {
    static constexpr bool GATHER = GATH;
    unsigned A, Bt; int K; int nct_log, nunits, G, c; unsigned idxoff; const LAS int* tileoff; const LAS int* ecnt; unsigned bstride; static constexpr int padrow = T_;
    DI bool next(int i, Unit& u) const {
        const long L = (long)i * G + c; if (L >= nunits) return false;
        int wgid = (int)L; { const int q = nunits / NXCD, r = nunits % NXCD, xcd = wgid % NXCD, off = wgid / NXCD; wgid = (xcd < r ? xcd * (q + 1) : r * (q + 1) + (xcd - r) * q) + off; }
        const int tile = wgid >> nct_log, pn = wgid & ((1 << nct_log) - 1);
        int e = 0;
#pragma unroll 1
        for (int j = 32; j >= 1; j >>= 1) { const int cand = e + j; if (tileoff[cand] <= tile) e = cand; }
        if (e < NEXP && tileoff[e + 1] <= tile) e += 1;
        e = __builtin_amdgcn_readfirstlane(e);
        u.e = e; u.r0 = tile * BM; u.c0 = pn * BM;
        { const int ti = tile - __builtin_amdgcn_readfirstlane(tileoff[e]); u.rb = e * ECAP + ti * BM; u.nv = __builtin_amdgcn_readfirstlane(ecnt[e]) - ti * BM; }
        u.a = GATH ? A : A + (unsigned)(tile * BM * K * 2);
        u.b = Bt + (unsigned)e * bstride + (unsigned)(pn * BM * K * 2);
        return true;
    }
};

struct EpiF32 {
    static constexpr bool PERM = false, ROWAUX = false;
    float* C; int ldc;
    DI void operator()(const f32x4 (&acc)[2][2][4][2], const Unit& u, int wr, int wc, int fr, int fq) const {
        const int row0 = u.r0 + wr * 64 + fr, col0 = u.c0 + wc * 32 + 4 * fq;
#pragma unroll
        for (int ai = 0; ai < 2; ++ai)
#pragma unroll
            for (int m = 0; m < 4; ++m) { float* rowp = C + (size_t)(row0 + ai * HALF + m * 16) * ldc + col0;
#pragma unroll
                for (int bj = 0; bj < 2; ++bj)
#pragma unroll
                    for (int n = 0; n < 2; ++n) *(f32x4*)(rowp + bj * HALF + n * 16) = acc[ai][bj][m][n]; }
    }
};
struct EpiBf16 {
    static constexpr bool PERM = true, ROWAUX = false;
    bf16* O; int ldc;
    DI void operator()(const f32x4 (&acc)[2][2][4][2], const Unit& u, int wr, int wc, int fr, int fq) const {
        const int row0 = u.r0 + wr * 64 + fr, col0 = u.c0 + wc * 32 + 8 * fq;
#pragma unroll
        for (int ai = 0; ai < 2; ++ai)
#pragma unroll
            for (int m = 0; m < 4; ++m) { bf16* rowp = O + (size_t)(row0 + ai * HALF + m * 16) * ldc + col0;
#pragma unroll
                for (int bj = 0; bj < 2; ++bj) { const f32x4 v0 = acc[ai][bj][m][0], v1 = acc[ai][bj][m][1];
                    u32x4 w; w.x = cvtpk(v0[0], v0[1]); w.y = cvtpk(v0[2], v0[3]); w.z = cvtpk(v1[0], v1[1]); w.w = cvtpk(v1[2], v1[3]);
                    *(u32x4*)(rowp + bj * HALF) = w; } }
    }
};
struct EpiQKV {
    static constexpr bool PERM = true, ROWAUX = false;
    bf16* QKV; const float* COS; const float* SIN;
    DI void operator()(const f32x4 (&acc)[2][2][4][2], const Unit& u, int wr, int wc, int fr, int fq) const {
        const int pn = u.c0 >> 8, g = pn / 12, which = (pn >> 2) % 3, hq = pn & 3;
        const int ldil = 2 * g, dil = 1 << ldil;
        const int idx = 4 * (wc & 1) + fq, b = u.r0 >> 12;
        const int row0 = u.r0 + wr * 64 + fr;
#pragma unroll
        for (int ai = 0; ai < 2; ++ai)
#pragma unroll
            for (int m = 0; m < 4; ++m) {
                const int r = row0 + ai * HALF + m * 16, t = r & (S_ - 1);
                const int prow = (t & (dil - 1)) * (S_ >> ldil) + (t >> ldil);
                f32x4 c4 = (f32x4){1.f, 1.f, 1.f, 1.f}, s4 = (f32x4){0.f, 0.f, 0.f, 0.f};
                if (which < 2) { c4 = *(const f32x4*)(COS + (size_t)r * 32 + 4 * idx); s4 = *(const f32x4*)(SIN + (size_t)r * 32 + 4 * idx); }
#pragma unroll
                for (int bj = 0; bj < 2; ++bj) {
                    const int head = 4 * hq + 2 * bj + (wc >> 1);
                    const f32x4 v0 = acc[ai][bj][m][0], v1 = acc[ai][bj][m][1];
                    f32x4 o0 = v0 * c4 - v1 * s4, o1 = v1 * c4 + v0 * s4;
                    if (which == 0) { o0 = o0 * QSCALE; o1 = o1 * QSCALE; }
                    u32x4 w; w.x = cvtpk(o0[0], o0[1]); w.y = cvtpk(o0[2], o0[3]); w.z = cvtpk(o1[0], o1[1]); w.w = cvtpk(o1[2], o1[3]);
                    bf16* dst = QKV + ((((size_t)(which * 3 + g) * NB_ + b) * 16 + head) * S_ + prow) * 64 + 8 * idx;
                    *(u32x4*)dst = w;
                }
            }
    }
};
struct EpiSwiGLU {
    static constexpr bool PERM = true, ROWAUX = false;
    bf16* HID;
    DI void operator()(const f32x4 (&acc)[2][2][4][2], const Unit& u, int wr, int wc, int fr, int fq) const {
        const int row0 = u.r0 + wr * 64 + fr, col0 = (u.c0 >> 1) + wc * 32 + 8 * fq;
#pragma unroll
        for (int ai = 0; ai < 2; ++ai)
#pragma unroll
            for (int m = 0; m < 4; ++m) {
                float hv[8];
#pragma unroll
                for (int n = 0; n < 2; ++n)
#pragma unroll
                    for (int j = 0; j < 4; ++j) { const float a = acc[ai][0][m][n][j], bb = acc[ai][1][m][n][j]; hv[4 * n + j] = silu_f(a) * bb; }
                u32x4 w; w.x = cvtpk(hv[0], hv[1]); w.y = cvtpk(hv[2], hv[3]); w.z = cvtpk(hv[4], hv[5]); w.w = cvtpk(hv[6], hv[7]);
                *(u32x4*)(HID + (size_t)(row0 + ai * HALF + m * 16) * 256 + col0) = w;
            }
    }
};
constexpr size_t YS_OFF = (size_t)160 << 20;
struct EpiScale {
    static constexpr bool PERM = true, ROWAUX = true;
    unsigned char* YE;
    int s0;
    DI void operator()(const f32x4 (&acc)[2][2][4][2], const Unit& u, int wr, int wc, int fr, int fq, const LAS int* aux) const {
        const int row0 = wr * 64 + fr, col0 = u.c0 + wc * 32 + 8 * fq;
        if (u.e == NEXP) {
            bf16* base = (bf16*)pg8::rfl_ptr((const char*)(YE + YS_OFF) + (size_t)(u.r0 - s0) * (D_ * 2));
#pragma unroll
            for (int ai = 0; ai < 2; ++ai)
#pragma unroll
                for (int m = 0; m < 4; ++m) { const unsigned ro = (unsigned)((row0 + ai * HALF + m * 16) * D_ + col0) * 2u;
#pragma unroll
                    for (int bj = 0; bj < 2; ++bj) { const f32x4 v0 = acc[ai][bj][m][0], v1 = acc[ai][bj][m][1];
                        u32x4 w; w.x = cvtpk(v0[0], v0[1]); w.y = cvtpk(v0[2], v0[3]); w.z = cvtpk(v1[0], v1[1]); w.w = cvtpk(v1[2], v1[3]);
                        *(u32x4*)((char*)base + ro + bj * HALF * 2) = w; } }
        } else {
            unsigned char* base = (unsigned char*)pg8::rfl_ptr((const char*)YE + (size_t)u.r0 * D_);
#pragma unroll
            for (int ai = 0; ai < 2; ++ai)
#pragma unroll
                for (int m = 0; m < 4; ++m) { const int rl = row0 + ai * HALF + m * 16; const float wgt = __builtin_bit_cast(float, aux[rl]) * YE_SCALE; const unsigned ro = (unsigned)(rl * D_ + col0);
#pragma unroll
                    for (int bj = 0; bj < 2; ++bj) { const f32x4 v0 = acc[ai][bj][m][0] * wgt, v1 = acc[ai][bj][m][1] * wgt;
                        u32x2 w; w.x = cvtpk_fp8(v0[0], v0[1], v0[2], v0[3]); w.y = cvtpk_fp8(v1[0], v1[1], v1[2], v1[3]);
                        *(u32x2*)(base + ro + bj * HALF) = w; } }
        }
    }
};
}
constexpr size_t MiB = 1u << 20;
constexpr size_t WS_CTL = 0, CTL_ZERO_BYTES = 1 * MiB;
constexpr size_t WS_MOD = 1 * MiB;
constexpr size_t WS_COS = 2 * MiB;
constexpr size_t WS_SIN = 4 * MiB;
constexpr size_t WS_ASG_E = 6 * MiB;
constexpr size_t WS_ASG_R = 6 * MiB + 512 * 1024;
constexpr size_t WS_ASG_W = 7 * MiB;
constexpr size_t WS_ASG_ROW = 7 * MiB + 512 * 1024;
constexpr size_t WS_ROWTOK = 8 * MiB;
constexpr size_t WS_ROWW = 9 * MiB;
constexpr size_t WS_AB = 10 * MiB;
constexpr size_t WS_GALPHA = 11 * MiB;
constexpr size_t WS_GBETA = 11 * MiB + 512 * 1024;
constexpr size_t WS_X = 12 * MiB;
constexpr size_t WS_Y = 76 * MiB;
constexpr size_t WS_H = 140 * MiB;
constexpr size_t WS_O = 173 * MiB;
constexpr size_t WS_WA_IN = 205 * MiB;
constexpr size_t WS_WA_OUT = 241 * MiB;
constexpr size_t WS_WG_IN = 245 * MiB;
constexpr size_t WS_WG_OUT = 261 * MiB;
constexpr size_t WS_WE1 = 265 * MiB;
constexpr size_t WS_WE2 = 330 * MiB;
constexpr size_t WS_HID = 363 * MiB;
constexpr size_t WS_BIG = 443 * MiB;
constexpr size_t WS_YS_OFF = pg8::YS_OFF;
constexpr size_t WS_WEB = WS_BIG + 368 * MiB;
constexpr size_t WS_WRF = WS_BIG + 466 * MiB;
constexpr size_t WS_WABF = WS_WRF + 1 * MiB;
constexpr size_t WS_ETOK = WS_WABF + 1 * MiB;
constexpr size_t WS_EW = WS_ETOK + 5 * MiB;
constexpr size_t WS_END = WS_EW + 5 * MiB;
constexpr size_t BIG_PROJ = 0, BIG_QN = 128 * MiB, BIG_KN = 192 * MiB, BIG_VV = 256 * MiB, BIG_ORAW = 320 * MiB;
constexpr int CW_BAR = 4096;
constexpr int CW_CNT = 16384;
constexpr int RING_BYTES = 131072;
constexpr int LDS_IDX = RING_BYTES;
constexpr int LDS_TILEOFF = LDS_IDX + 3072;
constexpr int LDS_LCNT = LDS_TILEOFF + 512;
constexpr int LDS_LBASE = LDS_LCNT + 256;
constexpr int LDS_LASG = LDS_LBASE + 256;
constexpr int LDS_ECNT = LDS_LASG;
constexpr int LDS_LW = LDS_IDX;
constexpr int LDS_MISC = LDS_LASG + 2048;
constexpr int LDS_LG = LDS_MISC + 128;
constexpr int LDS_BYTES = 147456;
static_assert(LDS_LG + 8192 <= LDS_BYTES, "LDS map");
constexpr int NWAVES = 8, NTHR = 512;

#define XB_TMO      128
#define XB_XCNT(j)  (256  + 64 * (j))
#define XB_XSUB(j)  (1280 + 64 * (j))
#define XB_XGEN(j)  (2304 + 64 * (j))
#define XB_TOP      3328
#define XB_TOPGEN   3392
#define XCD_BAR_WORDS 3456
#define XB_SPIN_CAP (1u << 18)
__device__ __forceinline__ unsigned xb_ld(unsigned* p)              { return __hip_atomic_load(p, __ATOMIC_RELAXED, __HIP_MEMORY_SCOPE_AGENT); }
__device__ __forceinline__ unsigned xb_add(unsigned* p, unsigned v) { return __hip_atomic_fetch_add(p, v, __ATOMIC_RELAXED, __HIP_MEMORY_SCOPE_AGENT); }
__device__ __forceinline__ unsigned xb_xcc_id() { return (unsigned)__builtin_amdgcn_s_getreg((3 << 11) | 20) & 0xFu; }
#define XB_SPIN(cond, bar) do { unsigned _sp = 0; while (cond) { __builtin_amdgcn_s_sleep(1); \
    if ((++_sp & 255u) == 0u) { if (xb_ld(&(bar)[XB_TMO])) break; if (_sp > XB_SPIN_CAP) { atomicAdd(&(bar)[XB_TMO], 1u); break; } } } } while (0)
struct XcdBarrier { unsigned* bar; unsigned x; volatile LAS unsigned* st; };
__device__ __forceinline__ XcdBarrier xcd_barrier_post(unsigned* bar, volatile LAS unsigned* st) {
    XcdBarrier b; b.bar = bar; b.x = xb_xcc_id(); b.st = st;
    if (threadIdx.x == 0) (void)xb_add(&bar[XB_XCNT(b.x)], 1u);
    return b;
}
__device__ __forceinline__ void xcd_barrier_complete(unsigned* bar, unsigned x, unsigned& nloc, unsigned& nx) {
    const unsigned G = gridDim.x * gridDim.y * gridDim.z;
    unsigned sum, cnt, mine, sp = 0u;
    for (;;) {
        sum = 0u; cnt = 0u; mine = 0u;
#pragma unroll
        for (unsigned j = 0; j < 16; ++j) { const unsigned c = xb_ld(&bar[XB_XCNT(j)]); sum += c; cnt += (c > 0u) ? 1u : 0u; mine = (j == x) ? c : mine; }
        if (sum == G) break;
        __builtin_amdgcn_s_sleep(1);
        if ((++sp & 255u) == 0u) { if (xb_ld(&bar[XB_TMO])) break; if (sp > XB_SPIN_CAP) { atomicAdd(&bar[XB_TMO], 1u); break; } }
    }
    nloc = mine > 0u ? mine : 1u; nx = cnt > 0u ? cnt : 1u;
}
__device__ __forceinline__ void xcd_barrier(const XcdBarrier& b, const int tid) {
    asm volatile("s_waitcnt vmcnt(0)" ::: "memory");
    __syncthreads();
    if (tid == 0) {
        unsigned* bar = b.bar;
        __builtin_amdgcn_s_waitcnt(0);
        unsigned nloc = b.st[0], nx = b.st[1];
        if (nloc == 0u) { xcd_barrier_complete(bar, b.x, nloc, nx); b.st[0] = nloc; b.st[1] = nx; }
        const unsigned old = xb_add(&bar[XB_XSUB(b.x)], 1u);
        const unsigned gen = old / nloc;
        if (old + 1u == (gen + 1u) * nloc) {
            __builtin_amdgcn_fence(__ATOMIC_RELEASE, "agent");
            asm volatile("s_waitcnt vmcnt(0)" ::: "memory");
            const unsigned og = xb_add(&bar[XB_TOP], 1u);
            const unsigned tg = og / nx;
            if (og + 1u == (tg + 1u) * nx) xb_add(&bar[XB_TOPGEN], 1u);
            else XB_SPIN(xb_ld(&bar[XB_TOPGEN]) == tg, bar);
            __builtin_amdgcn_fence(__ATOMIC_ACQUIRE, "agent");
            xb_add(&bar[XB_XGEN(b.x)], 1u);
            asm volatile("s_waitcnt vmcnt(0)" ::: "memory");
        } else {
            XB_SPIN(xb_ld(&bar[XB_XGEN(b.x)]) == gen, bar);
            __builtin_amdgcn_fence(__ATOMIC_ACQUIRE, "agent");
            asm volatile("s_waitcnt vmcnt(0)" ::: "memory");
        }
    }
    __syncthreads();
}

struct Args {
    const float* x; const float* c; const int* pos; const float* ada_w; const float* ada_b; const float* ln_g; const float* ln_b;
    const float* attn_w_in; const float* attn_w_out; const float* gdn_w_in; const float* gdn_conv_w; const float* gdn_a_log; const float* gdn_dt_bias;
    const float* gdn_norm_w; const float* gdn_w_out; const float* router_w; const float* router_bias; const float* ew1; const float* ew3; const float* ew2;
    const float* sw1; const float* sw3; const float* sw2;
    float* out; unsigned char* ws; int ph_lo, ph_hi;
};
typedef __attribute__((address_space(1))) unsigned char gas_u8;
DI unsigned char* opq(unsigned char* p) { gas_u8* g = (gas_u8*)p; asm volatile("" : "+s"(g)); return (unsigned char*)g; }
template <class T> DI T* asg(T* p) { typedef __attribute__((address_space(1))) T gT; return (T*)(gT*)p; }
struct Frame {
    LAS unsigned char* lds;
    int tid, lane, wave, G, bid;
};
template <class Map> DI void transpose_item(const float* W, int ldn, int K, bf16* WT, const Map& map, LAS float* scr, int kb, int nb, int lane) {
    const int k0 = 64 * kb, n0 = 32 * nb;
    float tv[32];
#pragma unroll
    for (int i = 0; i < 32; ++i) tv[i] = __builtin_nontemporal_load(&W[(size_t)(k0 + 2 * i + (lane >> 5)) * ldn + n0 + (lane & 31)]);
#pragma unroll
    for (int i = 0; i < 32; ++i) scr[(2 * i + (lane >> 5)) * 33 + (lane & 31)] = tv[i];
    LDS_WAIT(); asm volatile("" ::: "memory");
    const int c = lane & 7;
#pragma unroll
    for (int j = 0; j < 4; ++j) { const int n = (lane >> 3) + 8 * j; const LAS float* s = scr + (8 * c) * 33 + n;
        u32x4 o; o.x = cvtpk(s[0 * 33], s[1 * 33]); o.y = cvtpk(s[2 * 33], s[3 * 33]); o.z = cvtpk(s[4 * 33], s[5 * 33]); o.w = cvtpk(s[6 * 33], s[7 * 33]);
        __builtin_nontemporal_store(o, (u32x4*)(WT + (size_t)map(n0 + n) * K + k0 + 8 * c)); }
    LDS_WAIT(); asm volatile("" ::: "memory");
}
struct MapId { int off; DI int operator()(int n) const { return off + n; } };
struct MapQKV { DI int operator()(int n) const {
    const int which = (n >> 10) % 3; if (which == 2) return n;
    const int d = n & 63, idx = (d & 31) >> 2, lo = d & 3, hi = d >> 5; return (n & ~63) + 8 * idx + 4 * hi + lo; } };
struct MapW13 { int second; DI int operator()(int n) const { return (n >> 7) * 256 + second * 128 + (n & 127); } };
template <class Map> DI void convert_matrix(const Frame& F, const float* W, int ldn, int K, int N, bf16* WT, const Map& map) {
    LAS float* scr = (LAS float*)(F.lds + F.wave * 16384);
    const int gw = F.bid * NWAVES + F.wave, NGW = F.G * NWAVES, nblk = N / 32, nitems = (K / 64) * nblk;
    for (int it = gw; it < nitems; it += NGW) transpose_item(W, ldn, K, WT, map, scr, it / nblk, it % nblk, F.lane);
}

DI void prologue_phase(const Frame& F, const Args& A) {
    unsigned char* ws = opq(A.ws);
    {
        LAS float* red = (LAS float*)F.lds;
        float* MOD = (float*)(ws + WS_MOD);
        for (int item = F.bid; item < 8 * 48; item += F.G) {
            const int ls = item / 48, n = (item % 48) * 64 + F.lane;
            const float* w = A.ada_w + ((size_t)ls * D_ + F.wave * 128) * 3072 + n;
            const float* cc = A.c + F.wave * 128;
            float a0 = 0.f, a1 = 0.f, a2 = 0.f, a3 = 0.f;
#pragma unroll 32
            for (int k = 0; k < 128; ++k) { const float wv = __builtin_nontemporal_load(&w[(size_t)k * 3072]);        a0 += cc[k] * wv; a1 += cc[D_ + k] * wv; a2 += cc[2 * D_ + k] * wv; a3 += cc[3 * D_ + k] * wv; }
            red[(F.wave * 4 + 0) * 64 + F.lane] = a0; red[(F.wave * 4 + 1) * 64 + F.lane] = a1; red[(F.wave * 4 + 2) * 64 + F.lane] = a2; red[(F.wave * 4 + 3) * 64 + F.lane] = a3;
            __syncthreads();
            if (F.wave < 4) { float s = A.ada_b[ls * 3072 + n];
#pragma unroll
                for (int w8 = 0; w8 < 8; ++w8) s += red[(w8 * 4 + F.wave) * 64 + F.lane];
                MOD[((size_t)ls * 4 + F.wave) * 3072 + n] = s; }
            __syncthreads();
        }
    }
    {
        float* COS = (float*)(ws + WS_COS); float* SIN = (float*)(ws + WS_SIN);
        for (int idx = F.bid * NTHR + F.tid; idx < T_ * 32; idx += F.G * NTHR) {
            const int t = idx >> 5, i = idx & 31;
            const float inv = powf(10000.0f, -(float)i / 32.0f);
            const float ang = (float)A.pos[t] * inv;
            COS[idx] = cosf(ang); SIN[idx] = sinf(ang);
        }
    }
    {
        bf16* WRF = (bf16*)(ws + WS_WRF); bf16* WABF = (bf16*)(ws + WS_WABF);
        for (int idx = F.bid * NTHR + F.tid; idx < 4 * 4 * 32 * 64 * 8; idx += F.G * NTHR) {
            const int jx = idx & 7, ln = (idx >> 3) & 63, ks = (idx >> 9) & 31, nt = (idx >> 14) & 3, layer = idx >> 16;
            const int d = 32 * ks + 8 * (ln >> 4) + jx, e = 16 * nt + (ln & 15);
            const float wv = A.router_w[((size_t)layer * D_ + d) * NEXP + e];
            const unsigned hi = cvtpk(wv, 0.f) & 0xffffu; const float res = wv - bf_lo(hi);
            const size_t o = (size_t)layer * 2 * 65536 + (idx & 65535);
            WRF[o] = (bf16)hi; WRF[o + 65536] = (bf16)(cvtpk(res, 0.f) & 0xffffu);
        }
        for (int idx = F.bid * NTHR + F.tid; idx < 2 * 32 * 64 * 8; idx += F.G * NTHR) {
            const int jx = idx & 7, ln = (idx >> 3) & 63, ks = (idx >> 9) & 31, jl = idx >> 14;
            const int d = 32 * ks + 8 * (ln >> 4) + jx, e = ln & 15;
            const float wv = A.gdn_w_in[((size_t)jl * D_ + d) * 4112 + 4096 + e];
            const unsigned hi = cvtpk(wv, 0.f) & 0xffffu; const float res = wv - bf_lo(hi);
            const size_t o = (size_t)jl * 2 * 16384 + (idx & 16383);
            WABF[o] = (bf16)hi; WABF[o + 16384] = (bf16)(cvtpk(res, 0.f) & 0xffffu);
        }
    }
    if (F.bid == 0) { bf16* H = (bf16*)(ws + WS_H); for (int cidx = F.tid; cidx < D_; cidx += NTHR) H[(size_t)T_ * D_ + cidx] = 0; }
    for (int j = 0; j < 2; ++j) {
        convert_matrix(F, A.attn_w_in + (size_t)j * D_ * 9216, 9216, D_, 9216, (bf16*)(ws + WS_WA_IN) + (size_t)j * 9216 * D_, MapQKV{});
        convert_matrix(F, A.attn_w_out + (size_t)j * D_ * D_, D_, D_, D_, (bf16*)(ws + WS_WA_OUT) + (size_t)j * D_ * D_, MapId{0});
        convert_matrix(F, A.gdn_w_in + (size_t)j * D_ * 4112, 4112, D_, 4096, (bf16*)(ws + WS_WG_IN) + (size_t)j * 4096 * D_, MapId{0});
        convert_matrix(F, A.gdn_w_out + (size_t)j * D_ * D_, D_, D_, D_, (bf16*)(ws + WS_WG_OUT) + (size_t)j * D_ * D_, MapId{0});
    }
}
struct XItem { const float* src; bf16* dst; int ldn, K, mode, n0; };
DI XItem xi_decode(const Args& A, int layer, bf16* WE1, bf16* WE2, int it) {
    constexpr int I13 = (D_ / 64) * (256 / 32), I2 = (256 / 64) * (D_ / 32), IPE = 2 * I13 + I2;
    const int e = it / IPE; int r = it % IPE; XItem x;
    if (r < 2 * I13) { const int second = r >= I13 ? 1 : 0; r -= second * I13; const int kb = r >> 3, nb = r & 7;
        const float* w = second ? (e < 64 ? A.ew3 + ((size_t)layer * 64 + e) * D_ * 256 : A.sw3 + (size_t)layer * D_ * 256) : (e < 64 ? A.ew1 + ((size_t)layer * 64 + e) * D_ * 256 : A.sw1 + (size_t)layer * D_ * 256);
        x.src = w + (size_t)(64 * kb) * 256 + 32 * nb; x.ldn = 256; x.K = D_; x.mode = 1 + second; x.n0 = 32 * nb; x.dst = WE1 + (size_t)e * 512 * D_ + 64 * kb;
    } else { r -= 2 * I13; const int kb = r >> 5, nb = r & 31;
        const float* w = e < 64 ? A.ew2 + ((size_t)layer * 64 + e) * 256 * D_ : A.sw2 + (size_t)layer * 256 * D_;
        x.src = w + (size_t)(64 * kb) * D_ + 32 * nb; x.ldn = D_; x.K = 256; x.mode = 0; x.n0 = 32 * nb; x.dst = WE2 + (size_t)e * D_ * 256 + 64 * kb; }
    return x;
}
#define XI_LOAD(buf, XT) do { const char* _b = pg8::rfl_ptr((const char*)(XT).src); const unsigned _ro = (unsigned)((XT).ldn * 4); \
    _Pragma("unroll") for (int _i = 0; _i < 8; ++_i) buf[_i] = __builtin_nontemporal_load((const f32x4*)(_b + ((unsigned)(8 * _i + (lane >> 3)) * _ro + (unsigned)(lane & 7) * 16u))); } while (0)
#define XI_PUT(buf, XT) do { \
    _Pragma("unroll") for (int _i = 0; _i < 8; ++_i) _Pragma("unroll") for (int _e = 0; _e < 4; ++_e) scr[(8 * _i + (lane >> 3)) * 33 + 4 * (lane & 7) + _e] = buf[_i][_e]; \
    LDS_WAIT(); asm volatile("" ::: "memory"); \
    const int _c = lane & 7; \
    _Pragma("unroll") for (int _j = 0; _j < 4; ++_j) { const int _n = (XT).n0 + (lane >> 3) + 8 * _j; const LAS float* _s = scr + (8 * _c) * 33 + (lane >> 3) + 8 * _j; \
        const int _row = (XT).mode == 0 ? _n : (_n >> 7) * 256 + ((XT).mode - 1) * 128 + (_n & 127); \
        u32x4 _o; _o.x = cvtpk(_s[0 * 33], _s[1 * 33]); _o.y = cvtpk(_s[2 * 33], _s[3 * 33]); _o.z = cvtpk(_s[4 * 33], _s[5 * 33]); _o.w = cvtpk(_s[6 * 33], _s[7 * 33]); \
        __builtin_nontemporal_store(_o, (u32x4*)((XT).dst + (size_t)_row * (XT).K + 8 * _c)); } \
    LDS_WAIT(); asm volatile("" ::: "memory"); } while (0)
DI void convert_experts(const Frame& F, const Args& A, int layer, int set, int wg0, int nwg) {
    if (F.bid < wg0 || F.bid >= wg0 + nwg) return;
    unsigned char* ws = opq(A.ws);
    LAS float* scr = (LAS float*)(F.lds + F.wave * 16384);
    bf16* WE1 = (bf16*)(ws + (set ? WS_WEB : WS_WE1)); bf16* WE2 = (bf16*)(ws + (set ? WS_WEB + 65 * MiB : WS_WE2));
    const int gw = (F.bid - wg0) * NWAVES + F.wave, NGW = nwg * NWAVES, lane = F.lane;
    constexpr int NIT = 65 * 384;
    f32x4 ba[8], bb[8];
    int it = gw;
    if (it >= NIT) return;
    XItem xa = xi_decode(A, layer, WE1, WE2, it), xb = xa;
    XI_LOAD(ba, xa);
#pragma unroll 1
    for (;;) {
        const bool hb = it + NGW < NIT;
        if (hb) { xb = xi_decode(A, layer, WE1, WE2, it + NGW); XI_LOAD(bb, xb); }
        __builtin_amdgcn_sched_barrier(0);
        XI_PUT(ba, xa);
        if (!hb) break;
        it += NGW;
        const bool ha = it + NGW < NIT;
        if (ha) { xa = xi_decode(A, layer, WE1, WE2, it + NGW); XI_LOAD(ba, xa); }
        __builtin_amdgcn_sched_barrier(0);
        XI_PUT(bb, xb);
        if (!ha) break;
        it += NGW;
    }
}
#undef XI_LOAD
#undef XI_PUT

DI void load_row16(const float* p, int lane, f32x4 (&v)[4]) {
#pragma unroll
    for (int j = 0; j < 4; ++j) v[j] = *(const f32x4*)(p + 4 * lane + 256 * j);
}
DI void store_row16(float* p, int lane, const f32x4 (&v)[4]) {
#pragma unroll
    for (int j = 0; j < 4; ++j) *(f32x4*)(p + 4 * lane + 256 * j) = v[j];
}
DI void store_row16_bf16(bf16* p, int lane, const f32x4 (&v)[4]) {
#pragma unroll
    for (int j = 0; j < 4; ++j) { u32x2 w; w.x = cvtpk(v[j][0], v[j][1]); w.y = cvtpk(v[j][2], v[j][3]); *(u32x2*)(p + 4 * lane + 256 * j) = w; }
}
DI void add_row16_bf16(const bf16* p, int lane, f32x4 (&v)[4]) {
#pragma unroll
    for (int j = 0; j < 4; ++j) { const u32x2 w = *(const u32x2*)(p + 4 * lane + 256 * j); v[j][0] += bf_lo(w.x); v[j][1] += bf_hi(w.x); v[j][2] += bf_lo(w.y); v[j][3] += bf_hi(w.y); }
}
DI void add_row16_fp8(const unsigned char* p, int lane, f32x4 (&v)[4]) {
#pragma unroll
    for (int j = 0; j < 4; ++j) { const int w = *(const int*)(p + 4 * lane + 256 * j);
        const f32x2 a = __builtin_amdgcn_cvt_pk_f32_fp8(w, false), b = __builtin_amdgcn_cvt_pk_f32_fp8(w, true);
        v[j][0] += a[0]; v[j][1] += a[1]; v[j][2] += b[0]; v[j][3] += b[1]; }
}
DI void layer_norm16(f32x4 (&v)[4], const f32x4 (&g)[4], const f32x4 (&b)[4]) {
    float s = 0.f;
#pragma unroll
    for (int j = 0; j < 4; ++j) s += (v[j][0] + v[j][1]) + (v[j][2] + v[j][3]);
    const float mean = wave_sum(s) * (1.0f / D_);
    float q = 0.f;
#pragma unroll
    for (int j = 0; j < 4; ++j) { v[j] = v[j] - mean; q += (v[j][0] * v[j][0] + v[j][1] * v[j][1]) + (v[j][2] * v[j][2] + v[j][3] * v[j][3]); }
    const float rstd = 1.0f / sqrtf(wave_sum(q) * (1.0f / D_) + LN_EPS);
#pragma unroll
    for (int j = 0; j < 4; ++j) v[j] = v[j] * rstd * g[j] + b[j];
}

DI void modx_phase(const Frame& F, const Args& A) {
    unsigned char* ws = opq(A.ws);
    const float* MOD = (const float*)(ws + WS_MOD); bf16* H = (bf16*)(ws + WS_H);
    const int gw = F.bid * NWAVES + F.wave, NGW = F.G * NWAVES;
    for (int row = gw; row < T_; row += NGW) {
        const int b = row >> 12; f32x4 v[4], sc[4], sh[4];
        load_row16(A.x + (size_t)row * D_, F.lane, v); load_row16(MOD + (size_t)(0 * 4 + b) * 3072 + 1024, F.lane, sc); load_row16(MOD + (size_t)(0 * 4 + b) * 3072, F.lane, sh);
#pragma unroll
        for (int j = 0; j < 4; ++j) v[j] = v[j] * (1.0f + sc[j]) + sh[j];
        store_row16_bf16(H + (size_t)row * D_, F.lane, v);
    }
}

DI void build_tileoff(const Frame& F, const unsigned* gcount) {
    LAS int* tileoff = (LAS int*)(F.lds + LDS_TILEOFF);
    __syncthreads();
    if (F.wave == 0) {
        const unsigned cn = __hip_atomic_load(gcount + F.lane, __ATOMIC_RELAXED, __HIP_MEMORY_SCOPE_AGENT);
        const int nt = (int)((cn + 255u) >> 8); int inc = nt;
#pragma unroll
        for (int o = 1; o < 64; o <<= 1) { const int t = __builtin_amdgcn_ds_bpermute((F.lane - o) << 2, inc); if (F.lane >= o) inc += t; }
        tileoff[F.lane] = inc - nt; ((LAS int*)(F.lds + LDS_ECNT))[F.lane] = (int)cn;
        if (F.lane == 63) { tileoff[64] = inc; tileoff[65] = inc + T_ / 256; ((LAS int*)(F.lds + LDS_ECNT))[NEXP] = T_; }
    }
    __syncthreads();
}

DI void deepnorm_row(f32x4 (&v)[4], const f32x4 (&y)[4], const float* gate, const float* lng, const float* lnb, float* xout, const float* mod_shift, int lane) {
    f32x4 t[4];
    load_row16(gate, lane, t);
#pragma unroll
    for (int j = 0; j < 4; ++j) v[j] = ALPHA_DN * v[j] + (1.0f + t[j]) * y[j];
    float s = 0.f;
#pragma unroll
    for (int j = 0; j < 4; ++j) s += (v[j][0] + v[j][1]) + (v[j][2] + v[j][3]);
    const float mean = wave_sum(s) * (1.0f / D_);
    float q = 0.f;
#pragma unroll
    for (int j = 0; j < 4; ++j) { v[j] = v[j] - mean; q += (v[j][0] * v[j][0] + v[j][1] * v[j][1]) + (v[j][2] * v[j][2] + v[j][3] * v[j][3]); }
    const float rstd = 1.0f / sqrtf(wave_sum(q) * (1.0f / D_) + LN_EPS);
    load_row16(lng, lane, t);
#pragma unroll
    for (int j = 0; j < 4; ++j) v[j] = v[j] * rstd * t[j];
    load_row16(lnb, lane, t);
#pragma unroll
    for (int j = 0; j < 4; ++j) v[j] = v[j] + t[j];
    store_row16(xout, lane, v);
    if (mod_shift) {
        load_row16(mod_shift + 1024, lane, t);
#pragma unroll
        for (int j = 0; j < 4; ++j) v[j] = v[j] * (1.0f + t[j]);
        load_row16(mod_shift, lane, t);
#pragma unroll
        for (int j = 0; j < 4; ++j) v[j] = v[j] + t[j];
    }
}
DI void put_hilo(LAS unsigned char* lds, int p, int lane, const f32x4 (&v)[4]) {
#pragma unroll
    for (int j = 0; j < 4; ++j) {
        const int c = 4 * lane + 256 * j;
        const unsigned h0 = cvtpk(v[j][0], v[j][1]), h1 = cvtpk(v[j][2], v[j][3]);
        const unsigned l0 = cvtpk(v[j][0] - bf_lo(h0), v[j][1] - bf_hi(h0)), l1 = cvtpk(v[j][2] - bf_lo(h1), v[j][3] - bf_hi(h1));
        const int off = ((((p >> 4) * 32 + (c >> 5)) * 64 + ((c & 31) >> 3) * 16 + (p & 15)) * 16) + (c & 7) * 2;
        *(LAS u32x2*)(lds + off) = (u32x2){h0, h1}; *(LAS u32x2*)(lds + 65536 + off) = (u32x2){l0, l1};
    }
}
DI f32x4 small_proj(const LAS unsigned char* lds, int mt, int lane, const bf16* wf_hi, const bf16* wf_lo) {
    f32x4 a0 = (f32x4){0.f, 0.f, 0.f, 0.f}, a1 = a0, a2 = a0;
#pragma unroll 8
    for (int ks = 0; ks < 32; ++ks) {
        const bf16x8 ah = *(const LAS bf16x8*)(lds + ((mt * 32 + ks) * 64 + lane) * 16), al = *(const LAS bf16x8*)(lds + 65536 + ((mt * 32 + ks) * 64 + lane) * 16);
        const bf16x8 bh = *(const bf16x8*)(wf_hi + (ks * 64 + lane) * 8), bl = *(const bf16x8*)(wf_lo + (ks * 64 + lane) * 8);
        a0 = __builtin_amdgcn_mfma_f32_16x16x32_bf16(ah, bh, a0, 0, 0, 0); a1 = __builtin_amdgcn_mfma_f32_16x16x32_bf16(ah, bl, a1, 0, 0, 0); a2 = __builtin_amdgcn_mfma_f32_16x16x32_bf16(al, bh, a2, 0, 0, 0);
    }
    return a0 + (a1 + a2);
}
DI void small_proj2(const LAS unsigned char* lds, int kh, int lane, const bf16* wf_hi, const bf16* wf_lo, f32x4& o0, f32x4& o1) {
    f32x4 a[2][3];
#pragma unroll
    for (int mt = 0; mt < 2; ++mt)
#pragma unroll
        for (int e = 0; e < 3; ++e) a[mt][e] = (f32x4){0.f, 0.f, 0.f, 0.f};
#pragma unroll 8
    for (int k = 0; k < 16; ++k) {
        const int ks = 16 * kh + k;
        const bf16x8 bh = *(const bf16x8*)(wf_hi + (ks * 64 + lane) * 8), bl = *(const bf16x8*)(wf_lo + (ks * 64 + lane) * 8);
#pragma unroll
        for (int mt = 0; mt < 2; ++mt) {
            const bf16x8 ah = *(const LAS bf16x8*)(lds + ((mt * 32 + ks) * 64 + lane) * 16), al = *(const LAS bf16x8*)(lds + 65536 + ((mt * 32 + ks) * 64 + lane) * 16);
            a[mt][0] = __builtin_amdgcn_mfma_f32_16x16x32_bf16(ah, bh, a[mt][0], 0, 0, 0); a[mt][1] = __builtin_amdgcn_mfma_f32_16x16x32_bf16(ah, bl, a[mt][1], 0, 0, 0); a[mt][2] = __builtin_amdgcn_mfma_f32_16x16x32_bf16(al, bh, a[mt][2], 0, 0, 0);
        }
    }
    o0 = a[0][0] + (a[0][1] + a[0][2]); o1 = a[1][0] + (a[1][1] + a[1][2]);
}
DI void deepnorm_row_c(f32x4 (&v)[4], const f32x4 (&y)[4], const f32x4 (&cg)[4], const f32x4 (&cng)[4], const f32x4 (&cnb)[4]) {
#pragma unroll
    for (int j = 0; j < 4; ++j) v[j] = ALPHA_DN * v[j] + (1.0f + cg[j]) * y[j];
    float s = 0.f;
#pragma unroll
    for (int j = 0; j < 4; ++j) s += (v[j][0] + v[j][1]) + (v[j][2] + v[j][3]);
    const float mean = wave_sum(s) * (1.0f / D_);
    float q = 0.f;
#pragma unroll
    for (int j = 0; j < 4; ++j) { v[j] = v[j] - mean; q += (v[j][0] * v[j][0] + v[j][1] * v[j][1]) + (v[j][2] * v[j][2] + v[j][3] * v[j][3]); }
    const float rstd = 1.0f / sqrtf(wave_sum(q) * (1.0f / D_) + LN_EPS);
#pragma unroll
    for (int j = 0; j < 4; ++j) v[j] = v[j] * rstd * cng[j] + cnb[j];
}
template <bool L0> DI void ln_router_phase(const Frame& F, const Args& A, int layer, bool dry = false) {
    unsigned char* ws = opq(A.ws);
    const float* MOD = (const float*)(ws + WS_MOD); bf16* X = (bf16*)(ws + WS_X); const float* Y = (const float*)(ws + WS_Y); bf16* H = (bf16*)(ws + WS_H);
    int* asg_e = (int*)(ws + WS_ASG_E); int* asg_r = (int*)(ws + WS_ASG_R); int* etok = (int*)(ws + WS_ETOK); float* egate = (float*)(ws + WS_EW);
    unsigned* gcount = (unsigned*)(ws + WS_CTL) + CW_CNT + layer * 64;
    const int ls0 = layer * 2, ls1 = layer * 2 + 1;
    const bf16* wrf = (const bf16*)(ws + WS_WRF) + (size_t)layer * 2 * 65536 + (size_t)(F.wave & 3) * 32 * 512;
    const float rb = A.router_bias[layer * NEXP + F.lane];
    LAS float* lg = (LAS float*)(F.lds + LDS_LG);
    LAS int* lcnt = (LAS int*)(F.lds + LDS_LCNT); LAS int* lbase = (LAS int*)(F.lds + LDS_LBASE); LAS int* lasg = (LAS int*)(F.lds + LDS_LASG);
    const unsigned l8_ = (unsigned)F.lane * 8u, l16_ = (unsigned)F.lane * 16u;
    u32x2 yb[4][4], xb[L0 ? 1 : 4][4]; f32x4 xf[L0 ? 4 : 1][4];
#define LNR_LOAD(rb_) do { unsigned l8 = l8_, l16 = l16_; asm volatile("" : "+v"(l8), "+v"(l16)); \
        _Pragma("unroll") for (int t = 0; t < 4; ++t) { const int row = (rb_) + t; const char* py = pg8::rfl_ptr((const char*)Y + (size_t)row * (D_ * 2)); \
            if constexpr (L0) { const char* px = pg8::rfl_ptr((const char*)A.x + (size_t)row * (D_ * 4)); _Pragma("unroll") for (int j = 0; j < 4; ++j) xf[t][j] = __builtin_nontemporal_load((const f32x4*)(px + l16 + 1024 * j)); } \
            else { const char* px = pg8::rfl_ptr((const char*)X + (size_t)row * (D_ * 2)); _Pragma("unroll") for (int j = 0; j < 4; ++j) xb[t][j] = __builtin_nontemporal_load((const u32x2*)(px + l8 + 512 * j)); } \
            _Pragma("unroll") for (int j = 0; j < 4; ++j) yb[t][j] = __builtin_nontemporal_load((const u32x2*)(py + l8 + 512 * j)); } } while (0)
    for (int blk = F.bid; blk < T_ / 64; blk += F.G) {
        const int b = blk >> 6;
        const char* gate = pg8::rfl_ptr((const char*)(MOD + (size_t)(ls0 * 4 + b) * 3072 + 2048)); const char* modn = pg8::rfl_ptr((const char*)(MOD + (size_t)(ls1 * 4 + b) * 3072));
        const char* lng = pg8::rfl_ptr((const char*)(A.ln_g + (size_t)ls0 * D_)); const char* lnb = pg8::rfl_ptr((const char*)(A.ln_b + (size_t)ls0 * D_));
        f32x4 cg[4], cng[4], cnb[4], csc[4], csh[4];
#pragma unroll
        for (int j = 0; j < 4; ++j) { cg[j] = *(const f32x4*)(gate + l16_ + 1024 * j); cng[j] = *(const f32x4*)(lng + l16_ + 1024 * j); cnb[j] = *(const f32x4*)(lnb + l16_ + 1024 * j);
            csc[j] = *(const f32x4*)(modn + 4096 + l16_ + 1024 * j); csh[j] = *(const f32x4*)(modn + l16_ + 1024 * j); }
        if constexpr (!L0) { LNR_LOAD(blk * 64 + F.wave * 4); }
        __builtin_amdgcn_sched_barrier(0);
#pragma unroll 1
        for (int ps = 0; ps < 2; ++ps) {
            const int rbase = blk * 64 + ps * 32 + F.wave * 4;
            if constexpr (L0) { LNR_LOAD(rbase); }
            { unsigned l8 = l8_; asm volatile("" : "+v"(l8));
#pragma unroll
              for (int t = 0; t < 4; ++t) { const int row = rbase + t; f32x4 v[4], y[4];
#pragma unroll
                for (int j = 0; j < 4; ++j) { y[j] = (f32x4){bf_lo(yb[t][j].x), bf_hi(yb[t][j].x), bf_lo(yb[t][j].y), bf_hi(yb[t][j].y)};
                    if constexpr (L0) v[j] = xf[t][j]; else v[j] = (f32x4){bf_lo(xb[t][j].x), bf_hi(xb[t][j].x), bf_lo(xb[t][j].y), bf_hi(xb[t][j].y)}; }
                deepnorm_row_c(v, y, cg, cng, cnb);
                char* xp = (char*)pg8::rfl_ptr((const char*)(dry ? (const bf16*)(ws + WS_Y + 32 * MiB) : X) + (size_t)row * (D_ * 2));
                char* hp = (char*)pg8::rfl_ptr((const char*)H + (size_t)row * (D_ * 2));
#pragma unroll
                for (int j = 0; j < 4; ++j) { { u32x2 o; o.x = cvtpk(v[j][0], v[j][1]); o.y = cvtpk(v[j][2], v[j][3]); __builtin_nontemporal_store(o, (u32x2*)(xp + l8 + 512 * j)); }
                    v[j] = v[j] * (1.0f + csc[j]) + csh[j]; u32x2 o; o.x = cvtpk(v[j][0], v[j][1]); o.y = cvtpk(v[j][2], v[j][3]); *(u32x2*)(hp + l8 + 512 * j) = o; }
                put_hilo(F.lds, F.wave * 4 + t, F.lane, v); } }
            if constexpr (!L0) { if (ps == 0) { LNR_LOAD(blk * 64 + 32 + F.wave * 4); } }
            __syncthreads();
            { const int nt = F.wave & 3, kh = F.wave >> 2, r = F.lane & 15, q = F.lane >> 4;
              f32x4 acc0, acc1; small_proj2(F.lds, kh, F.lane, wrf, wrf + 65536, acc0, acc1);
              if (kh == 0) {
#pragma unroll
                  for (int reg = 0; reg < 4; ++reg) { lg[(4 * q + reg) * 64 + 16 * nt + r] = acc0[reg]; lg[(16 + 4 * q + reg) * 64 + 16 * nt + r] = acc1[reg]; } }
              __syncthreads();
              if (kh == 1) {
#pragma unroll
                  for (int reg = 0; reg < 4; ++reg) { lg[(4 * q + reg) * 64 + 16 * nt + r] += acc0[reg]; lg[(16 + 4 * q + reg) * 64 + 16 * nt + r] += acc1[reg]; } } }
            __syncthreads();
#pragma unroll 2
            for (int rr = 0; rr < 4; ++rr) {
                const int row = rbase + rr, rl = ps * 32 + F.wave * 4 + rr;
                int ln = F.lane; asm volatile("" : "+v"(ln));
                const float logit = lg[(F.wave * 4 + rr) * 64 + F.lane];
                const float s = 1.0f / (1.0f + __expf(-logit)); const float bi = s + rb;
                float m1 = bi; m1 = fmaxf(m1, dppmov<0xB1>(m1)); m1 = fmaxf(m1, dppmov<0x4E>(m1)); m1 = fmaxf(m1, dppmov<0x141>(m1));
                const unsigned long long eq = __ballot(bi == m1);
                const int first = __ffs((int)((eq >> (ln & ~7)) & 0xffull)) - 1;
                float m2 = ((ln & 7) == first) ? -INFINITY : bi; m2 = fmaxf(m2, dppmov<0xB1>(m2)); m2 = fmaxf(m2, dppmov<0x4E>(m2)); m2 = fmaxf(m2, dppmov<0x141>(m2));
                const float gs = m1 + m2; int grank = 0;
#pragma unroll
                for (int j = 0; j < 8; ++j) { const float gj = rdlane(gs, 8 * j); grank += ((gj > gs) || (gj == gs && j < (ln >> 3))) ? 1 : 0; }
                const bool gsel = grank < 4;
                float mv = gsel ? bi : -INFINITY; int cnt = -1;
#pragma unroll
                for (int it = 0; it < TOPK; ++it) { const float mx = wave_max(mv); const unsigned long long em = __ballot(mv == mx); const int fl = __ffsll((long long)em) - 1;
                    if (ln == fl) { cnt = it; mv = -INFINITY; } }
                const bool sel = cnt >= 0;
                const float gsum = wave_sum(sel ? s : 0.f);
                if (sel) { const int lr = __hip_atomic_fetch_add(&lcnt[F.lane], 1, __ATOMIC_RELAXED, __HIP_MEMORY_SCOPE_WORKGROUP); lasg[rl * 8 + cnt] = (F.lane << 16) | lr;
                    asg_e[(size_t)row * 8 + cnt] = F.lane; ((LAS float*)(F.lds + LDS_LW))[rl * 8 + cnt] = s / gsum * 2.5f; }
            }
        }
        __syncthreads();
        if (F.tid < NEXP) { const int cn = lcnt[F.tid]; lbase[F.tid] = (cn && !dry) ? (int)atomicAdd(&gcount[F.tid], (unsigned)cn) : 0; lcnt[F.tid] = 0; }
        __syncthreads();
        { const int v = lasg[F.tid], e = v >> 16, rank = lbase[e] + (v & 0xffff); asg_r[(size_t)blk * 512 + F.tid] = rank;
          etok[(size_t)e * ECAP + rank] = blk * 64 + (F.tid >> 3); egate[(size_t)e * ECAP + rank] = ((const LAS float*)(F.lds + LDS_LW))[F.tid];
          if (F.tid < 64) { etok[(size_t)NEXP * ECAP + blk * 64 + F.tid] = blk * 64 + F.tid; egate[(size_t)NEXP * ECAP + blk * 64 + F.tid] = 1.0f; } }
        __syncthreads();
    }
#undef LNR_LOAD
}

DI void moe_scatter_phase(const Frame& F, const Args& A, int layer) {
    unsigned char* ws = opq(A.ws);
    const int* asg_e = (const int*)(ws + WS_ASG_E); const int* asg_r = (const int*)(ws + WS_ASG_R); const float* asg_w = (const float*)(ws + WS_ASG_W); int* asg_row = (int*)(ws + WS_ASG_ROW);
    int* rowtok = (int*)(ws + WS_ROWTOK); float* roww = (float*)(ws + WS_ROWW);
    const unsigned* gcount = (const unsigned*)(ws + WS_CTL) + CW_CNT + layer * 64;
    build_tileoff(F, gcount);
    const LAS int* tileoff = (const LAS int*)(F.lds + LDS_TILEOFF);
    for (int idx = F.bid * NTHR + F.tid; idx < T_ * TOPK; idx += F.G * NTHR) {
        const int e = asg_e[idx], row = 256 * tileoff[e] + asg_r[idx];
        rowtok[row] = idx >> 3; roww[row] = asg_w[idx]; asg_row[idx] = row;
    }
    for (int e = F.bid; e < NEXP; e += F.G) {
        const int cnt = (int)__hip_atomic_load(gcount + e, __ATOMIC_RELAXED, __HIP_MEMORY_SCOPE_AGENT), end = 256 * tileoff[e + 1];
        for (int row = 256 * tileoff[e] + cnt + F.tid; row < end; row += NTHR) { rowtok[row] = T_; roww[row] = 0.f; }
    }
    const int s0 = 256 * tileoff[64];
    for (int t = F.bid * NTHR + F.tid; t < T_; t += F.G * NTHR) { rowtok[s0 + t] = t; roww[s0 + t] = 1.0f; }
}

DI void ln_moe_phase(const Frame& F, const Args& A, int layer, float* dry_out) {
    unsigned char* ws = opq(A.ws);
    const float* MOD = (const float*)(ws + WS_MOD); const char* YE = (const char*)(ws + WS_BIG);
    float* AB = (float*)(ws + WS_AB);
    int s0 = 0;
    { const unsigned* gcount = (const unsigned*)(ws + WS_CTL) + CW_CNT + layer * 64; build_tileoff(F, gcount); s0 = 256 * ((const LAS int*)(F.lds + LDS_TILEOFF))[64]; }
    const int* asg_e = (const int*)(ws + WS_ASG_E); const int* asg_r = (const int*)(ws + WS_ASG_R);
    const int ls0 = layer * 2 + 1, ls1 = layer * 2 + 2; const bool last = layer == 3, want_ab = (layer & 1) == 0;
    const bf16* wabf = (const bf16*)(ws + WS_WABF) + (size_t)(layer >> 1) * 2 * 16384;
    const unsigned l4_ = (unsigned)F.lane * 4u, l8_ = (unsigned)F.lane * 8u, l16_ = (unsigned)F.lane * 16u;
    for (int blk = F.bid; blk < T_ / 64; blk += F.G) {
        const int b = blk >> 6;
        const char* gate = pg8::rfl_ptr((const char*)(MOD + (size_t)(ls0 * 4 + b) * 3072 + 2048)); const char* modn = pg8::rfl_ptr((const char*)(MOD + (size_t)((last ? ls0 : ls1) * 4 + b) * 3072));
        const char* lng = pg8::rfl_ptr((const char*)(A.ln_g + (size_t)ls0 * D_)); const char* lnb = pg8::rfl_ptr((const char*)(A.ln_b + (size_t)ls0 * D_));
        f32x4 cg[4], cng[4], cnb[4], csc[4], csh[4];
#pragma unroll
        for (int j = 0; j < 4; ++j) { cg[j] = *(const f32x4*)(gate + l16_ + 1024 * j); cng[j] = *(const f32x4*)(lng + l16_ + 1024 * j); cnb[j] = *(const f32x4*)(lnb + l16_ + 1024 * j);
            csc[j] = *(const f32x4*)(modn + 4096 + l16_ + 1024 * j); csh[j] = *(const f32x4*)(modn + l16_ + 1024 * j); }
#pragma unroll 1
        for (int ps = 0; ps < 2; ++ps) {
            const int rbase = blk * 64 + ps * 32 + F.wave * 4;
            const int ev = *(const int*)(pg8::rfl_ptr((const char*)(asg_e + (size_t)rbase * 8)) + (l4_ & 127u)), rv = *(const int*)(pg8::rfl_ptr((const char*)(asg_r + (size_t)rbase * 8)) + (l4_ & 127u));
            const int idxv = 256 * ((const LAS int*)(F.lds + LDS_TILEOFF))[ev] + rv;
#pragma unroll 1
            for (int rr = 0; rr < 4; ++rr) {
                const int row = rbase + rr; f32x4 v[4], y[4]; int w[9][4]; u32x2 sh[4];
                unsigned l4 = l4_, l8 = l8_, l16 = l16_; asm volatile("" : "+v"(l4), "+v"(l8), "+v"(l16));
#pragma unroll
                for (int k = 0; k < TOPK; ++k) { const int src = __builtin_amdgcn_readlane(idxv, rr * 8 + k); const char* p = pg8::rfl_ptr(YE + (size_t)src * D_);
#pragma unroll
                    for (int j = 0; j < 4; ++j) w[k][j] = __builtin_nontemporal_load((const int*)(p + l4 + 256 * j)); }
                if (YS_BF16) { const char* p = pg8::rfl_ptr(YE + WS_YS_OFF + (size_t)row * (D_ * 2));
#pragma unroll
                    for (int j = 0; j < 4; ++j) sh[j] = __builtin_nontemporal_load((const u32x2*)(p + l8 + 512 * j));
                } else { const char* p = pg8::rfl_ptr(YE + (size_t)(s0 + row) * D_);
#pragma unroll
                    for (int j = 0; j < 4; ++j) w[8][j] = *(const int*)(p + l4 + 256 * j);
                }
                u32x2 xb[4];
                { const char* p = pg8::rfl_ptr((const char*)(ws + WS_X) + (size_t)row * (D_ * 2));
#pragma unroll
                  for (int j = 0; j < 4; ++j) xb[j] = __builtin_nontemporal_load((const u32x2*)(p + l8 + 512 * j)); }
                __builtin_amdgcn_sched_barrier(0);
#pragma unroll
                for (int j = 0; j < 4; ++j) { y[j] = (f32x4){0.f, 0.f, 0.f, 0.f}; v[j] = (f32x4){bf_lo(xb[j].x), bf_hi(xb[j].x), bf_lo(xb[j].y), bf_hi(xb[j].y)}; }
#pragma unroll
                for (int k = 0; k < (YS_BF16 ? TOPK : TOPK + 1); ++k) {
                    asm volatile("" : "+v"(w[k][0]), "+v"(w[k][1]), "+v"(w[k][2]), "+v"(w[k][3]), "+v"(y[0]), "+v"(y[1]), "+v"(y[2]), "+v"(y[3]));
#pragma unroll
                    for (int j = 0; j < 4; ++j) { const f32x2 a = __builtin_amdgcn_cvt_pk_f32_fp8(w[k][j], false), c = __builtin_amdgcn_cvt_pk_f32_fp8(w[k][j], true);
                        y[j][0] += a[0]; y[j][1] += a[1]; y[j][2] += c[0]; y[j][3] += c[1]; }
                    __builtin_amdgcn_sched_barrier(0);
                }
#pragma unroll
                for (int j = 0; j < 4; ++j) y[j] = y[j] * (1.0f / YE_SCALE);
                if (YS_BF16) {
#pragma unroll
                    for (int j = 0; j < 4; ++j) { y[j][0] += bf_lo(sh[j].x); y[j][1] += bf_hi(sh[j].x); y[j][2] += bf_lo(sh[j].y); y[j][3] += bf_hi(sh[j].y); }
                }
                deepnorm_row_c(v, y, cg, cng, cnb);
                if (last || dry_out) { char* op = (char*)pg8::rfl_ptr((const char*)(dry_out ? dry_out : A.out) + (size_t)row * (D_ * 4));
#pragma unroll
                    for (int j = 0; j < 4; ++j) __builtin_nontemporal_store(v[j], (f32x4*)(op + l16 + 1024 * j));
                } else { char* xp = (char*)pg8::rfl_ptr((const char*)(ws + WS_X) + (size_t)row * (D_ * 2));
#pragma unroll
                    for (int j = 0; j < 4; ++j) { u32x2 o; o.x = cvtpk(v[j][0], v[j][1]); o.y = cvtpk(v[j][2], v[j][3]); __builtin_nontemporal_store(o, (u32x2*)(xp + l8 + 512 * j)); } }
                if (!last) { char* hp = (char*)pg8::rfl_ptr((const char*)(ws + WS_H) + (size_t)row * (D_ * 2));
#pragma unroll
                    for (int j = 0; j < 4; ++j) { v[j] = v[j] * (1.0f + csc[j]) + csh[j]; u32x2 o; o.x = cvtpk(v[j][0], v[j][1]); o.y = cvtpk(v[j][2], v[j][3]); *(u32x2*)(hp + l8 + 512 * j) = o; }
                    if (want_ab) put_hilo(F.lds, F.wave * 4 + rr, F.lane, v);
                }
            }
            if (!last && want_ab) {
                __syncthreads();
                if (F.wave < 2) { const int mt = F.wave, r = F.lane & 15, q = F.lane >> 4;
                    const f32x4 acc = small_proj(F.lds, mt, F.lane, wabf, wabf + 16384);
#pragma unroll
                    for (int reg = 0; reg < 4; ++reg) AB[(size_t)(blk * 64 + ps * 32 + 16 * mt + 4 * q + reg) * 16 + r] = acc[reg]; }
                __syncthreads();
            }
        }
    }
}
DI int crow(int r, int h) { return (r & 3) + 8 * (r >> 2) + 4 * h; }
typedef short v4i16_t __attribute__((ext_vector_type(4)));
DI s16x4 vtr(const LAS unsigned char* p) { return __builtin_bit_cast(s16x4, __builtin_amdgcn_ds_read_tr16_b64_v4i16((LAS v4i16_t*)p)); }
#define MFMA32(a, b, c) __builtin_amdgcn_mfma_f32_32x32x16_bf16((a), (b), (c), 0, 0, 0)
constexpr int ATT_ORUN = 0, ATT_LRUN = 65536, ATT_VBUF = 65536 + 2048, ATT_VSTRIDE = 144, ATT_VBYTES = 32 * ATT_VSTRIDE;

#ifndef REP_A1
#define REP_A1 1
#define REP_A2 1
#endif
DI void attn_phase(const Frame& F, const Args& A) {
    unsigned char* ws = opq(A.ws);
    const bf16* QKV = (const bf16*)(ws + WS_BIG); bf16* O = (bf16*)(ws + WS_O);
    LAS unsigned char* orun = F.lds + ATT_ORUN;
    LAS float* lrun = (LAS float*)(F.lds + ATT_LRUN);
    LAS unsigned char* vbuf = F.lds + ATT_VBUF + F.wave * ATT_VBYTES;
    const int lane = F.lane, qi = lane & 31, h = lane >> 5;
    const int g16 = lane >> 4, q4 = (lane & 15) >> 2, p4 = lane & 3;
    for (int it = F.bid; it < NB_ * 16 * 8; it += F.G) {
        int item = it;
        if (F.G == 256) { const int w = it & 255, xcd = w & 7, j = w >> 3; item = (((it >> 8) * 32 + xcd * 4 + (j >> 3)) << 3) | (j & 7); }
        const int b = item >> 7, head = (item >> 3) & 15, ck = item & 7;
        for (int gi = 0; gi < 3; ++gi) {
            const int g = 2 - gi, ldil = 2 * g, Lg = S_ >> ldil;
            const size_t hb = (((size_t)g * NB_ + b) * 16 + head) * S_ * 64;
            const bf16* Qg = QKV + hb; const bf16* Kg = QKV + (size_t)3 * NB_ * 16 * S_ * 64 + hb; const bf16* Vg = QKV + (size_t)6 * NB_ * 16 * S_ * 64 + hb;
            for (int sub = F.wave; sub < 16; sub += NWAVES) {
                int r_, tile;
                if (g == 0) { r_ = 0; tile = sub; } else if (g == 1) { r_ = sub >> 2; tile = sub & 3; } else { r_ = sub; tile = 0; }
                const int m0 = ((512 * ck) >> ldil) + 32 * tile;
                const bf16* Kr = Kg + (size_t)r_ * Lg * 64; const bf16* Vr = Vg + (size_t)r_ * Lg * 64;
                f32x16 st[5]; u32x4 vv[5][4]; float mx, lsum;
#pragma unroll 1
                for (int rep1 = 0; rep1 < REP_A1; ++rep1) {
                unsigned lc = (unsigned)((lane >> 3) * 128 + (lane & 7) * 16); asm volatile("" : "+v"(lc));
                const int wofs = (lane >> 3) * ATT_VSTRIDE + (lane & 7) * 16, rofs = qi * ATT_VSTRIDE + 64 * h;
                u32x4 qv[4], kv[5][4];
                { const char* qp = pg8::rfl_ptr((const char*)(Qg + ((size_t)r_ * Lg + m0) * 64));
#pragma unroll
                  for (int i = 0; i < 4; ++i) qv[i] = __builtin_nontemporal_load((const u32x4*)(qp + lc + 1024 * i)); }
#pragma unroll
                for (int kt = 0; kt < 5; ++kt) { const int mk0 = m0 - 128 + 32 * kt; const char* kp = pg8::rfl_ptr((const char*)(Kr + (size_t)(mk0 < 0 ? 0 : mk0) * 64));
#pragma unroll
                    for (int i = 0; i < 4; ++i) kv[kt][i] = *(const u32x4*)(kp + lc + 1024 * i); }
                __builtin_amdgcn_sched_barrier(0);
                bf16x8 qf[4];
#pragma unroll
                for (int i = 0; i < 4; ++i) *(LAS u32x4*)(vbuf + wofs + 8 * i * ATT_VSTRIDE) = qv[i];
                LDS_WAIT(); asm volatile("" ::: "memory");
#pragma unroll
                for (int s = 0; s < 4; ++s) qf[s] = *(const LAS bf16x8*)(vbuf + rofs + 16 * s);
                LDS_WAIT(); asm volatile("" ::: "memory");
#pragma unroll
                for (int kt = 0; kt < 5; ++kt) {
                    const int mk0 = m0 - 128 + 32 * kt;
                    bf16x8 kf[4];
#pragma unroll
                    for (int i = 0; i < 4; ++i) *(LAS u32x4*)(vbuf + wofs + 8 * i * ATT_VSTRIDE) = kv[kt][i];
                    LDS_WAIT(); asm volatile("" ::: "memory");
#pragma unroll
                    for (int s = 0; s < 4; ++s) kf[s] = *(const LAS bf16x8*)(vbuf + rofs + 16 * s);
                    { const char* vp = pg8::rfl_ptr((const char*)(Vr + (size_t)(mk0 < 0 ? 0 : mk0) * 64));
#pragma unroll
                      for (int i = 0; i < 4; ++i) vv[kt][i] = *(const u32x4*)(vp + lc + 1024 * i); }
                    LDS_WAIT(); asm volatile("" ::: "memory");
#pragma unroll
                    for (int r = 0; r < 16; ++r) st[kt][r] = 0.f;
#pragma unroll
                    for (int s = 0; s < 4; ++s) st[kt] = MFMA32(kf[s], qf[s], st[kt]);
                    if (mk0 < 0) {
#pragma unroll
                        for (int r = 0; r < 16; ++r) st[kt][r] = -INFINITY;
                    }
                }
#pragma unroll
                for (int r = 0; r < 16; ++r) { const int kr = crow(r, h); if (kr < qi) st[0][r] = -INFINITY; if (kr > qi) st[4][r] = -INFINITY; }
                mx = -INFINITY;
#pragma unroll
                for (int kt = 0; kt < 5; ++kt)
#pragma unroll
                    for (int r = 0; r < 16; ++r) mx = fmaxf(mx, st[kt][r]);
                mx = fmaxf(mx, bperm(mx, F.lane ^ 32));
                lsum = 0.f;
#pragma unroll
                for (int kt = 0; kt < 5; ++kt)
#pragma unroll
                    for (int r = 0; r < 16; ++r) { const float p = __builtin_amdgcn_exp2f(st[kt][r] - mx); st[kt][r] = p; lsum += p; }
                lsum += bperm(lsum, F.lane ^ 32);
                }
                f32x16 oacc[2];
#pragma unroll 1
                for (int rep2 = 0; rep2 < REP_A2; ++rep2) {
#pragma unroll
                for (int r = 0; r < 16; ++r) { oacc[0][r] = 0.f; oacc[1][r] = 0.f; }
#pragma unroll
                for (int kt = 0; kt < 5; ++kt) {
                    const int mk0 = m0 - 128 + 32 * kt;
                    if (mk0 >= 0) {
#pragma unroll
                        for (int i = 0; i < 4; ++i) *(LAS u32x4*)(vbuf + ((lane >> 3) + 8 * i) * ATT_VSTRIDE + (lane & 7) * 16) = vv[kt][i];
                        LDS_WAIT(); asm volatile("" ::: "memory");
                        s16x4 flo[2][2], fhi[2][2];
#pragma unroll
                        for (int sp = 0; sp < 2; ++sp)
#pragma unroll
                            for (int dvt = 0; dvt < 2; ++dvt) {
                                const int colb = (32 * dvt + 16 * (g16 & 1) + 4 * p4) * 2;
                                flo[sp][dvt] = vtr(vbuf + (16 * sp + 4 * h + q4) * ATT_VSTRIDE + colb);
                                fhi[sp][dvt] = vtr(vbuf + (16 * sp + 8 + 4 * h + q4) * ATT_VSTRIDE + colb);
                            }
                        LDS_WAIT(); asm volatile("" ::: "memory");
#pragma unroll
                        for (int sp = 0; sp < 2; ++sp) {
                            bf16x8 pf; {
                                const unsigned w0 = cvtpk(st[kt][8 * sp + 0], st[kt][8 * sp + 1]), w1 = cvtpk(st[kt][8 * sp + 2], st[kt][8 * sp + 3]);
                                const unsigned w2 = cvtpk(st[kt][8 * sp + 4], st[kt][8 * sp + 5]), w3 = cvtpk(st[kt][8 * sp + 6], st[kt][8 * sp + 7]);
                                pf = __builtin_bit_cast(bf16x8, (u32x4){w0, w1, w2, w3}); }
#pragma unroll
                            for (int dvt = 0; dvt < 2; ++dvt) {
                                const bf16x8 vf = __builtin_shufflevector(flo[sp][dvt], fhi[sp][dvt], 0, 1, 2, 3, 4, 5, 6, 7);
                                oacc[dvt] = MFMA32(vf, pf, oacc[dvt]);
                            }
                        }
                    }
                }
                asm volatile("" : "+v"(oacc[0]), "+v"(oacc[1]));
                }
                const float inv = __builtin_amdgcn_rcpf(lsum), lse = mx + __builtin_amdgcn_logf(lsum);
                const int tl = ((32 * tile + qi) << ldil) + r_;
                float wa = 0.f, wb = 1.f;
                if (gi > 0) { const float L0 = lrun[tl]; const float M = fmaxf(L0, lse); const float ea = __builtin_amdgcn_exp2f(L0 - M), eb = __builtin_amdgcn_exp2f(lse - M);
                    const float isum = __builtin_amdgcn_rcpf(ea + eb); wa = ea * isum; wb = eb * isum; asm volatile("" ::: "memory");
                    if (h == 0) lrun[tl] = M + __builtin_amdgcn_logf(ea + eb); }
                else if (h == 0) lrun[tl] = lse;
                wb *= inv;
#pragma unroll
                for (int dvt = 0; dvt < 2; ++dvt)
#pragma unroll
                    for (int k4 = 0; k4 < 4; ++k4) {
                        const int dv = 32 * dvt + 8 * k4 + 4 * h;
                        float o0 = oacc[dvt][4 * k4 + 0] * wb, o1 = oacc[dvt][4 * k4 + 1] * wb, o2 = oacc[dvt][4 * k4 + 2] * wb, o3 = oacc[dvt][4 * k4 + 3] * wb;
                        LAS u32x2* op = (LAS u32x2*)(orun + tl * 128 + dv * 2);
                        if (gi > 0) { const u32x2 w = *op; o0 += wa * bf_lo(w.x); o1 += wa * bf_hi(w.x); o2 += wa * bf_lo(w.y); o3 += wa * bf_hi(w.y); }
                        u32x2 wo; wo.x = cvtpk(o0, o1); wo.y = cvtpk(o2, o3);
                        if (gi < 2) *op = wo;
                        else *(u32x2*)(O + ((size_t)b * S_ + 512 * ck + tl) * D_ + head * 64 + dv) = wo;
                    }
            }
            __syncthreads();
        }
    }
}

DI void gdn_post_phase(const Frame& F, const Args& A, int j) {
    unsigned char* ws = opq(A.ws); unsigned char* big = ws + WS_BIG;
    const bf16* Oraw = (const bf16*)(ws + WS_Y); const bf16* PROJ = (const bf16*)(big + BIG_PROJ); bf16* O = (bf16*)(ws + WS_O);
    const float* nw = A.gdn_norm_w + (size_t)j * 128;
    const int gw = F.bid * NWAVES + F.wave, NGW = F.G * NWAVES, lane = F.lane;
    const f32x4 nwv = *(const f32x4*)(nw + ((4 * lane) & 127));
    const unsigned l8_ = (unsigned)lane * 8u;
#pragma unroll 2
    for (int row = gw; row < T_; row += NGW) {
        unsigned l8 = l8_; asm volatile("" : "+v"(l8));
        const char* op = pg8::rfl_ptr((const char*)(Oraw + (size_t)row * D_)); const char* zp = pg8::rfl_ptr((const char*)(PROJ + (size_t)row * 4096 + 3072));
        u32x2 ow[4], zw[4];
#pragma unroll
        for (int jj = 0; jj < 4; ++jj) { ow[jj] = __builtin_nontemporal_load((const u32x2*)(op + l8 + 512 * jj)); zw[jj] = __builtin_nontemporal_load((const u32x2*)(zp + l8 + 512 * jj)); }
        f32x4 v[4];
#pragma unroll
        for (int jj = 0; jj < 4; ++jj) {
            v[jj] = (f32x4){bf_lo(ow[jj].x), bf_hi(ow[jj].x), bf_lo(ow[jj].y), bf_hi(ow[jj].y)};
            float ss = (v[jj][0] * v[jj][0] + v[jj][1] * v[jj][1]) + (v[jj][2] * v[jj][2] + v[jj][3] * v[jj][3]);
            ss += dppmov<0xB1>(ss); ss += dppmov<0x4E>(ss); ss += dppmov<0x141>(ss); ss += dppmov<0x140>(ss); ss += shx<16>(ss);
            const float rs = rsqrtf(ss * (1.0f / 128.0f) + RMS_EPS);
            const float z0 = bf_lo(zw[jj].x), z1 = bf_hi(zw[jj].x), z2 = bf_lo(zw[jj].y), z3 = bf_hi(zw[jj].y);
            v[jj][0] = v[jj][0] * rs * nwv[0] * silu_f(z0); v[jj][1] = v[jj][1] * rs * nwv[1] * silu_f(z1);
            v[jj][2] = v[jj][2] * rs * nwv[2] * silu_f(z2); v[jj][3] = v[jj][3] * rs * nwv[3] * silu_f(z3);
        }
        store_row16_bf16(O + (size_t)row * D_, lane, v);
    }
}
constexpr size_t GB_KR = 128 * MiB, GB_QR = 160 * MiB, GB_KT = 192 * MiB, GB_VT = 224 * MiB, GB_BLOB = 256 * MiB;
constexpr int BLOB_ELEMS = 28672, BLOB_W = 0, BLOB_QG = 8192, BLOB_QK = 16384, BLOB_KDT = 20480;
DI int frag_pos(int row, int k, int nks) { const int kk = k & 31; return ((((row >> 4) * nks + (k >> 5)) * 64 + ((kk >> 2) & 3) * 16 + (row & 15)) * 8) + 4 * (kk >> 4) + (kk & 3); }
#define MFMA16(a, b, c) __builtin_amdgcn_mfma_f32_16x16x32_bf16((a), (b), (c), 0, 0, 0)
DI u32x2 pk4(float a, float b, float c, float d) { u32x2 w; w.x = cvtpk(a, b); w.y = cvtpk(c, d); return w; }

DI int tile_off(int t, int c) { return t * 256 + ((((c >> 4) ^ (t & 7)) << 5) | ((c & 15) << 1)); }
template <int WH> DI void prep_conv_pass(const bf16* PROJ, const float* cw, int b, int hh, int t0, int lane, LAS unsigned char* tile, bf16* rowdst, const LAS float* escale, bool normalize, float nscale) {
    float w[4][2];
#pragma unroll
    for (int jj = 0; jj < 4; ++jj) { const f32x2 t = *(const f32x2*)(cw + (size_t)jj * 3072 + WH * 1024 + hh * 128 + 2 * lane); w[jj][0] = t.x; w[jj][1] = t.y; }
    float A0[35], A1[35];
#pragma unroll
    for (int jj = 0; jj < 3; ++jj) { const int t = t0 - 3 + jj; unsigned u = 0u;
        if (t >= 0) u = *(const unsigned*)(PROJ + ((size_t)b * S_ + t) * 4096 + WH * 1024 + hh * 128 + 2 * lane);
        A0[jj] = bf_lo(u); A1[jj] = bf_hi(u); }
#pragma unroll 1
    for (int hb = 0; hb < 2; ++hb) {
        { unsigned xin[32];
#pragma unroll
          for (int i = 0; i < 32; ++i) xin[i] = __builtin_nontemporal_load((const unsigned*)(PROJ + ((size_t)b * S_ + t0 + 32 * hb + i) * 4096 + WH * 1024 + hh * 128 + 2 * lane));
#pragma unroll
          for (int i = 0; i < 32; ++i) { A0[3 + i] = bf_lo(xin[i]); A1[3 + i] = bf_hi(xin[i]); } }
#pragma unroll
        for (int i = 0; i < 32; ++i) {
            A0[i] = w[0][0] * A0[i] + w[1][0] * A0[i + 1] + w[2][0] * A0[i + 2] + w[3][0] * A0[i + 3];
            A1[i] = w[0][1] * A1[i] + w[1][1] * A1[i + 1] + w[2][1] * A1[i + 2] + w[3][1] * A1[i + 3]; }
#pragma unroll
        for (int i = 0; i < 32; ++i) { A0[i] = silu_f(A0[i]); A1[i] = silu_f(A1[i]); }
        if (normalize) {
            float rs[32];
#pragma unroll
            for (int i = 0; i < 32; ++i) rs[i] = wave_sum(A0[i] * A0[i] + A1[i] * A1[i]);
#pragma unroll
            for (int i = 0; i < 32; ++i) { const float r = rsqrtf(rs[i] + RMS_EPS) * nscale; A0[i] *= r; A1[i] *= r; }
        }
#pragma unroll
        for (int i = 0; i < 32; ++i) {
            const int tt = 32 * hb + i;
            if (rowdst) *(unsigned*)(rowdst + (size_t)tt * 128 + 2 * lane) = cvtpk(A0[i], A1[i]);
            const float es = escale ? escale[tt] : 1.0f;
            *(LAS unsigned*)(tile + tile_off(tt, 2 * lane)) = cvtpk(A0[i] * es, A1[i] * es);
        }
#pragma unroll
        for (int jj = 0; jj < 3; ++jj) { A0[jj] = A0[32 + jj]; A1[jj] = A1[32 + jj]; }
    }
    LDS_WAIT(); asm volatile("" ::: "memory");
}
DI void tile_tr8(const LAS unsigned char* tile, int tb, int tb2, int cb, int lane, s16x4& lo, s16x4& hi) {
    const int q4 = (lane & 15) >> 2, p4 = lane & 3;
    lo = vtr(tile + tile_off(tb + q4, cb + 4 * p4)); hi = vtr(tile + tile_off(tb2 + q4, cb + 4 * p4));
}
DI void gdn_prep2_phase(const Frame& F, const Args& A, int j) {
    unsigned char* ws = opq(A.ws); unsigned char* big = ws + WS_BIG;
    const bf16* PROJ = (const bf16*)(big + BIG_PROJ);
    bf16* KR = (bf16*)(big + GB_KR); bf16* QR = (bf16*)(big + GB_QR); bf16* KT = (bf16*)(big + GB_KT); bf16* VT = (bf16*)(big + GB_VT); bf16* BLOB = (bf16*)(big + GB_BLOB);
    const float* AB = (const float*)(ws + WS_AB); float* GC = (float*)(ws + WS_GALPHA); float* GB = (float*)(ws + WS_GBETA);
    const float* cw = A.gdn_conv_w + (size_t)j * 4 * 3072;
    const int gw = F.bid * NWAVES + F.wave, NGW = F.G * NWAVES, lane = F.lane, g16 = lane >> 4, i16 = lane & 15;
    LAS unsigned char* tile = F.lds + F.wave * 16384;
    LAS float* egl = (LAS float*)(F.lds + LDS_LG + F.wave * 512); LAS float* ekl = egl + 64;
    for (int it = gw; it < NB_ * 8 * 64; it += NGW) {
        const int b = it >> 9, hh = (it >> 6) & 7, n = it & 63, t0 = 64 * n, bh = b * 8 + hh;
        { const int row = b * S_ + t0 + lane; const float a = AB[(size_t)row * 16 + hh], bl = AB[(size_t)row * 16 + 8 + hh];
          const float xs = a + A.gdn_dt_bias[j * 8 + hh]; const float ey = __expf(xs); const float sp = xs > 20.f ? xs : (ey < 1e-3f ? ey * (1.0f - 0.5f * ey) : __logf(1.0f + ey));
          float gc = -__expf(A.gdn_a_log[j * 8 + hh]) * sp;
#pragma unroll
          for (int o = 1; o < 64; o <<= 1) { const float t = bperm(gc, lane - o); if (lane >= o) gc += t; }
          const float gl = rdlane(gc, 63);
          GC[(size_t)bh * S_ + t0 + lane] = gc; GB[(size_t)bh * S_ + t0 + lane] = 1.0f / (1.0f + __expf(-bl));
          egl[lane] = __expf(gc); ekl[lane] = __expf(gl - gc); }
        LDS_WAIT(); asm volatile("" ::: "memory");
        bf16* blob = BLOB + (size_t)it * BLOB_ELEMS;
        bf16* ktc = KT + (size_t)it * 8192; bf16* vtc = VT + (size_t)it * 8192;
        const size_t rbase = ((size_t)bh * S_ + t0) * 128;
        prep_conv_pass<1>(PROJ, cw, b, hh, t0, lane, tile, KR + rbase, nullptr, true, 1.0f);
#pragma unroll 2
        for (int db = 0; db < 8; ++db)
#pragma unroll
            for (int half = 0; half < 2; ++half) { s16x4 lo, hi; const int tb = 32 * half + 8 * g16; tile_tr8(tile, tb, tb + 4, 16 * db, lane, lo, hi);
                *(bf16x8*)(ktc + (16 * db + i16) * 64 + tb) = __builtin_shufflevector(lo, hi, 0, 1, 2, 3, 4, 5, 6, 7); }
#pragma unroll 2
        for (int a = 0; a < 8; ++a)
#pragma unroll
            for (int ks = 0; ks < 2; ++ks) { s16x4 lo, hi; const int tb = 32 * ks + 4 * g16; tile_tr8(tile, tb, tb + 16, 16 * a, lane, lo, hi);
                const f32x4 e0 = *(const LAS f32x4*)(ekl + tb), e1 = *(const LAS f32x4*)(ekl + tb + 16);
                u32x4 wv;
                wv.x = cvtpk(bf_lo((unsigned)(unsigned short)lo[0]) * e0[0], bf_lo((unsigned)(unsigned short)lo[1]) * e0[1]); wv.y = cvtpk(bf_lo((unsigned)(unsigned short)lo[2]) * e0[2], bf_lo((unsigned)(unsigned short)lo[3]) * e0[3]);
                wv.z = cvtpk(bf_lo((unsigned)(unsigned short)hi[0]) * e1[0], bf_lo((unsigned)(unsigned short)hi[1]) * e1[1]); wv.w = cvtpk(bf_lo((unsigned)(unsigned short)hi[2]) * e1[2], bf_lo((unsigned)(unsigned short)hi[3]) * e1[3]);
                *(u32x4*)(blob + BLOB_KDT + ((a * 2 + ks) * 64 + lane) * 8) = wv; }
        LDS_WAIT(); asm volatile("" ::: "memory");
        prep_conv_pass<2>(PROJ, cw, b, hh, t0, lane, tile, nullptr, nullptr, false, 1.0f);
#pragma unroll 2
        for (int db = 0; db < 8; ++db)
#pragma unroll
            for (int half = 0; half < 2; ++half) { s16x4 lo, hi; const int tb = 32 * half + 8 * g16; tile_tr8(tile, tb, tb + 4, 16 * db, lane, lo, hi);
                *(bf16x8*)(vtc + (16 * db + i16) * 64 + tb) = __builtin_shufflevector(lo, hi, 0, 1, 2, 3, 4, 5, 6, 7); }
        LDS_WAIT(); asm volatile("" ::: "memory");
        prep_conv_pass<0>(PROJ, cw, b, hh, t0, lane, tile, QR + rbase, egl, true, 0.08838834764831845f);
#pragma unroll 2
        for (int tm = 0; tm < 4; ++tm)
#pragma unroll
            for (int ks = 0; ks < 4; ++ks) {
                const u32x2 p0 = *(const LAS u32x2*)(tile + tile_off(16 * tm + i16, 32 * ks + 4 * g16)), p1 = *(const LAS u32x2*)(tile + tile_off(16 * tm + i16, 32 * ks + 16 + 4 * g16));
                *(u32x4*)(blob + BLOB_QG + ((tm * 4 + ks) * 64 + lane) * 8) = (u32x4){p0.x, p0.y, p1.x, p1.y}; }
        LDS_WAIT(); asm volatile("" ::: "memory");
    }
}

DI void gdn_wy_phase(const Frame& F, const Args& A) {
    unsigned char* ws = opq(A.ws); unsigned char* big = ws + WS_BIG;
    const bf16* KR = (const bf16*)(big + GB_KR); const bf16* QR = (const bf16*)(big + GB_QR); const bf16* KT = (const bf16*)(big + GB_KT); const bf16* VT = (const bf16*)(big + GB_VT);
    bf16* BLOB = (bf16*)(big + GB_BLOB); float* U = (float*)(ws + WS_HID);
    const float* GC = (const float*)(ws + WS_GALPHA); const float* GB = (const float*)(ws + WS_GBETA);
    const int gw = F.bid * NWAVES + F.wave, NGW = F.G * NWAVES, lane = F.lane, r = lane & 15, q = lane >> 4;
    LAS float* Af = (LAS float*)(F.lds + F.wave * 16384);
    asm volatile("s_waitcnt vmcnt(0)" ::: "memory"); __builtin_amdgcn_fence(__ATOMIC_ACQUIRE, "agent");
    for (int it = gw; it < NB_ * 8 * 64; it += NGW) {
        const int bh = it >> 6, n = it & 63;
        const char* kr = pg8::rfl_ptr((const char*)(KR + ((size_t)bh * S_ + 64 * n) * 128)); const char* qr = pg8::rfl_ptr((const char*)(QR + ((size_t)bh * S_ + 64 * n) * 128));
        const char* kt = pg8::rfl_ptr((const char*)(KT + (size_t)it * 8192)); const char* vt = pg8::rfl_ptr((const char*)(VT + (size_t)it * 8192));
        char* blob = (char*)pg8::rfl_ptr((const char*)(BLOB + (size_t)it * BLOB_ELEMS)); char* ub = (char*)pg8::rfl_ptr((const char*)(U + (size_t)it * 8192));
        const unsigned lrow = (unsigned)(r * 128 + 8 * q) * 2u, ltr = (unsigned)(r * 64 + 8 * q) * 2u, lfrag = (unsigned)(q * 16 + r) * 16u;
        const float gcl = GC[(size_t)bh * S_ + 64 * n + lane], bel = GB[(size_t)bh * S_ + 64 * n + lane];
        __builtin_amdgcn_wave_barrier();
        bf16x8 kfr[4][4], qfr[4][4];
#pragma unroll
        for (int t4 = 0; t4 < 4; ++t4)
#pragma unroll
            for (int ks = 0; ks < 4; ++ks) { kfr[t4][ks] = *(const bf16x8*)(kr + lrow + (16 * t4 * 128 + 32 * ks) * 2); qfr[t4][ks] = *(const bf16x8*)(qr + lrow + (16 * t4 * 128 + 32 * ks) * 2); }
#pragma unroll
        for (int ti = 0; ti < 4; ++ti) {
            const float gi = bperm(gcl, 16 * ti + r), bi = bperm(bel, 16 * ti + r);
#pragma unroll
            for (int tj = 0; tj < 4; ++tj) {
                char* qkdst = blob + (BLOB_QK + ((ti * 2 + (tj >> 1)) * 64) * 8 + 4 * (tj & 1)) * 2 + lfrag;
                if (tj > ti) { *(u32x2*)qkdst = (u32x2){0u, 0u}; *(LAS f32x4*)(Af + (16 * ti + r) * 64 + 16 * tj + 4 * q) = (f32x4){0.f, 0.f, 0.f, 0.f}; continue; }
                f32x4 p1 = (f32x4){0.f, 0.f, 0.f, 0.f}, p2 = p1;
#pragma unroll
                for (int ks = 0; ks < 4; ++ks) { p1 = MFMA16(kfr[tj][ks], kfr[ti][ks], p1); p2 = MFMA16(kfr[tj][ks], qfr[ti][ks], p2); }
                const int i = 16 * ti + r; f32x4 av, qv;
#pragma unroll
                for (int reg = 0; reg < 4; ++reg) { const int jx = 16 * tj + 4 * q + reg; const float gj = bperm(gcl, jx);
                    const float dec = (jx <= i) ? __expf(gi - gj) : 0.f;
                    av[reg] = (jx < i) ? bi * p1[reg] * dec : 0.f; qv[reg] = p2[reg] * dec; }
                *(LAS f32x4*)(Af + i * 64 + 16 * tj + 4 * q) = av;
                *(u32x2*)qkdst = pk4(qv[0], qv[1], qv[2], qv[3]);
                asm volatile("" ::: "memory");
            }
        }
        LDS_WAIT(); asm volatile("" ::: "memory");
#pragma unroll 1
        for (int i0 = 0; i0 < 64; i0 += 4) {
            float a0 = (i0 + 0 == lane) ? 1.0f : 0.0f, a1 = (i0 + 1 == lane) ? 1.0f : 0.0f, a2 = (i0 + 2 == lane) ? 1.0f : 0.0f, a3 = (i0 + 3 == lane) ? 1.0f : 0.0f;
#pragma unroll 2
            for (int j4 = 0; j4 < (i0 >> 2); ++j4) {
                const float t0 = Af[(4 * j4 + 0) * 64 + lane], t1 = Af[(4 * j4 + 1) * 64 + lane], t2 = Af[(4 * j4 + 2) * 64 + lane], t3 = Af[(4 * j4 + 3) * 64 + lane];
                const f32x4 r0 = *(const LAS f32x4*)(Af + (i0 + 0) * 64 + 4 * j4), r1 = *(const LAS f32x4*)(Af + (i0 + 1) * 64 + 4 * j4);
                const f32x4 r2 = *(const LAS f32x4*)(Af + (i0 + 2) * 64 + 4 * j4), r3 = *(const LAS f32x4*)(Af + (i0 + 3) * 64 + 4 * j4);
                a0 -= r0[0] * t0 + r0[1] * t1 + r0[2] * t2 + r0[3] * t3; a1 -= r1[0] * t0 + r1[1] * t1 + r1[2] * t2 + r1[3] * t3;
                a2 -= r2[0] * t0 + r2[1] * t1 + r2[2] * t2 + r2[3] * t3; a3 -= r3[0] * t0 + r3[1] * t1 + r3[2] * t2 + r3[3] * t3;
            }
            const f32x4 d1 = *(const LAS f32x4*)(Af + (i0 + 1) * 64 + i0), d2 = *(const LAS f32x4*)(Af + (i0 + 2) * 64 + i0), d3 = *(const LAS f32x4*)(Af + (i0 + 3) * 64 + i0);
            a1 -= d1[0] * a0; a2 -= d2[0] * a0 + d2[1] * a1; a3 -= d3[0] * a0 + d3[1] * a1 + d3[2] * a2;
            LDS_WAIT(); asm volatile("" ::: "memory");
            Af[(i0 + 0) * 64 + lane] = a0; Af[(i0 + 1) * 64 + lane] = a1; Af[(i0 + 2) * 64 + lane] = a2; Af[(i0 + 3) * 64 + lane] = a3;
            LDS_WAIT(); asm volatile("" ::: "memory");
        }
        bf16x8 tuf[4][2], twf[4][2];
        {
            const float* gcp = GC + (size_t)bh * S_ + 64 * n; const float* gbp = GB + (size_t)bh * S_ + 64 * n;
#pragma unroll
            for (int ks = 0; ks < 2; ++ks) {
                float su[8], sw[8];
#pragma unroll
                for (int h4 = 0; h4 < 2; ++h4) { const f32x4 bv = *(const f32x4*)(gbp + 32 * ks + 8 * q + 4 * h4), gv = *(const f32x4*)(gcp + 32 * ks + 8 * q + 4 * h4);
#pragma unroll
                    for (int e = 0; e < 4; ++e) { su[4 * h4 + e] = bv[e]; sw[4 * h4 + e] = -bv[e] * __expf(gv[e]); } }
#pragma unroll
                for (int tm = 0; tm < 4; ++tm) {
                    const f32x4 x0 = *(const LAS f32x4*)(Af + (16 * tm + r) * 64 + 32 * ks + 8 * q), x1 = *(const LAS f32x4*)(Af + (16 * tm + r) * 64 + 32 * ks + 8 * q + 4);
                    tuf[tm][ks] = __builtin_bit_cast(bf16x8, (u32x4){cvtpk(x0[0] * su[0], x0[1] * su[1]), cvtpk(x0[2] * su[2], x0[3] * su[3]), cvtpk(x1[0] * su[4], x1[1] * su[5]), cvtpk(x1[2] * su[6], x1[3] * su[7])});
                    twf[tm][ks] = __builtin_bit_cast(bf16x8, (u32x4){cvtpk(x0[0] * sw[0], x0[1] * sw[1]), cvtpk(x0[2] * sw[2], x0[3] * sw[3]), cvtpk(x1[0] * sw[4], x1[1] * sw[5]), cvtpk(x1[2] * sw[6], x1[3] * sw[7])});
                }
            }
        }
        LDS_WAIT(); asm volatile("" ::: "memory");
        {
#pragma unroll
            for (int w8 = 0; w8 < 8; ++w8) {
                bf16x8 vb[2];
#pragma unroll
                for (int ks = 0; ks < 2; ++ks) vb[ks] = *(const bf16x8*)(vt + ltr + (16 * w8 * 64 + 32 * ks) * 2);
#pragma unroll
                for (int tm = 0; tm < 4; ++tm) { f32x4 acc = (f32x4){0.f, 0.f, 0.f, 0.f};
#pragma unroll
                    for (int ks = 0; ks < 2; ++ks) acc = MFMA16(tuf[tm][ks], vb[ks], acc);
                    *(f32x4*)(ub + (unsigned)lane * 16u + ((w8 * 4 + tm) * 64) * 16) = acc; }
            }
        }
        {
#pragma unroll
            for (int a = 0; a < 8; ++a) {
                bf16x8 ka[2];
#pragma unroll
                for (int ks = 0; ks < 2; ++ks) ka[ks] = *(const bf16x8*)(kt + ltr + (16 * a * 64 + 32 * ks) * 2);
#pragma unroll
                for (int ti = 0; ti < 4; ++ti) { f32x4 acc = (f32x4){0.f, 0.f, 0.f, 0.f};
#pragma unroll
                    for (int ks = 0; ks < 2; ++ks) acc = MFMA16(ka[ks], twf[ti][ks], acc);
                    *(u32x2*)(blob + (BLOB_W + ((ti * 4 + (a >> 1)) * 64) * 8 + 4 * (a & 1)) * 2 + lfrag) = pk4(acc[0], acc[1], acc[2], acc[3]); }
            }
        }
        LDS_WAIT(); asm volatile("" ::: "memory");
    }
}

constexpr int SCAN_BUF = BLOB_ELEMS * 2;
DI bf16x8 pack8(const f32x4& lo, const f32x4& hi) { return __builtin_bit_cast(bf16x8, (u32x4){cvtpk(lo[0], lo[1]), cvtpk(lo[2], lo[3]), cvtpk(hi[0], hi[1]), cvtpk(hi[2], hi[3])}); }
DI void ld16_asm(u32x4& dst, const char* sbase, unsigned voff) { asm volatile("global_load_dwordx4 %0, %1, %2" : "=v"(dst) : "v"(voff), "s"(sbase) : "memory"); }
#define SCAN_LOAD(RSET, chunk) do { const char* _cb = pg8::rfl_ptr(src + (size_t)(chunk) * SCAN_BUF); \
    _Pragma("unroll") for (int i = 0; i < 14; ++i) ld16_asm(RSET[i], pg8::rfl_ptr(_cb + i * 4096), ltid16); } while (0)
#define SCAN_PUT(RSET, BUF) do { _Pragma("unroll") for (int i = 0; i < 14; ++i) *(LAS u32x4*)(F.lds + (BUF) * SCAN_BUF + i * 4096 + ltid16) = RSET[i]; } while (0)
#define SCAN_LSTEP(n_, BUFN, RFREE, RNEXT) do { const int n = (n_); \
    if (n + 3 < 64) { SCAN_LOAD(RFREE, n + 3); asm volatile("s_waitcnt vmcnt(28)" ::: "memory"); } else { asm volatile("s_waitcnt vmcnt(0)" ::: "memory"); } \
    __builtin_amdgcn_sched_barrier(0); \
    if (n + 1 < 64) SCAN_PUT(RNEXT, BUFN); \
    asm volatile("s_waitcnt lgkmcnt(0)" ::: "memory"); __builtin_amdgcn_s_barrier(); asm volatile("" ::: "memory"); } while (0)
#define SCAN_CSTEP(n_, BUFC, UC) do { const int n = (n_); \
        const LAS unsigned char* buf = F.lds + (BUFC) * SCAN_BUF; \
        f32x4 vn[4]; \
        _Pragma("unroll") for (int tm = 0; tm < 4; ++tm) vn[tm] = UC[tm]; \
        if (n + 2 < 64) { const char* u2 = pg8::rfl_ptr(ubase + (size_t)(n + 2) * 8192 * 4); _Pragma("unroll") for (int tm = 0; tm < 4; ++tm) UC[tm] = __builtin_nontemporal_load((const f32x4*)(u2 + lane16 + tm * 1024)); } \
        if (n > 0) { char* op = (char*)pg8::rfl_ptr(obase + (size_t)(64 * (n - 1)) * D_ * 2); \
            _Pragma("unroll") for (int tm = 0; tm < 4; ++tm) _Pragma("unroll") for (int reg = 0; reg < 4; ++reg) *(bf16*)(op + olane + (16 * tm + reg) * D_ * 2) = (bf16)cvtpk(o[tm][reg], 0.f); } \
        const float glast = rdlane(gl_all, n); \
        bf16x8 sb[4]; \
        _Pragma("unroll") for (int ks = 0; ks < 4; ++ks) sb[ks] = pack8(S[2 * ks], S[2 * ks + 1]); \
          \
        bf16x8 fw[16], fq[16], fk[8], fd[16]; bf16x8 vb[2]; \
        _Pragma("unroll") for (int i = 0; i < 16; ++i) fw[i] = *(const LAS bf16x8*)(buf + BLOB_W * 2 + (i * 64 + lane) * 16); \
        __builtin_amdgcn_sched_barrier(0); \
        _Pragma("unroll") for (int i = 0; i < 16; ++i) fq[i] = *(const LAS bf16x8*)(buf + BLOB_QG * 2 + (i * 64 + lane) * 16); \
        __builtin_amdgcn_sched_barrier(0); \
        _Pragma("unroll") for (int tm = 0; tm < 4; ++tm) _Pragma("unroll") for (int ks = 0; ks < 4; ++ks) vn[tm] = MFMA16(fw[tm * 4 + ks], sb[ks], vn[tm]); \
        __builtin_amdgcn_sched_barrier(0); \
        _Pragma("unroll") for (int i = 0; i < 8; ++i) fk[i] = *(const LAS bf16x8*)(buf + BLOB_QK * 2 + (i * 64 + lane) * 16); \
        __builtin_amdgcn_sched_barrier(0); \
        _Pragma("unroll") for (int tm = 0; tm < 4; ++tm) { o[tm] = (f32x4){0.f, 0.f, 0.f, 0.f}; \
            _Pragma("unroll") for (int ks = 0; ks < 4; ++ks) o[tm] = MFMA16(fq[tm * 4 + ks], sb[ks], o[tm]); } \
        _Pragma("unroll") for (int k2 = 0; k2 < 2; ++k2) vb[k2] = pack8(vn[2 * k2], vn[2 * k2 + 1]); \
        __builtin_amdgcn_sched_barrier(0); \
        _Pragma("unroll") for (int i = 0; i < 16; ++i) fd[i] = *(const LAS bf16x8*)(buf + BLOB_KDT * 2 + (i * 64 + lane) * 16); \
        __builtin_amdgcn_sched_barrier(0); \
        _Pragma("unroll") for (int tm = 0; tm < 4; ++tm) _Pragma("unroll") for (int k2 = 0; k2 < 2; ++k2) o[tm] = MFMA16(fk[tm * 2 + k2], vb[k2], o[tm]); \
        __builtin_amdgcn_sched_barrier(0); \
        _Pragma("unroll") for (int a = 0; a < 8; ++a) { S[a] = S[a] * glast; \
            _Pragma("unroll") for (int k2 = 0; k2 < 2; ++k2) S[a] = MFMA16(fd[a * 2 + k2], vb[k2], S[a]); } \
    asm volatile("s_waitcnt lgkmcnt(0)" ::: "memory"); __builtin_amdgcn_s_barrier(); asm volatile("" ::: "memory"); } while (0)

DI void gdn_scan2_phase(const Frame& F, const Args& A) {
    unsigned char* ws = opq(A.ws); unsigned char* big = ws + WS_BIG;
    const bf16* BLOB = (const bf16*)(big + GB_BLOB); const float* U = (const float*)(ws + WS_HID); bf16* Oraw = (bf16*)(ws + WS_Y);
    const float* GC = (const float*)(ws + WS_GALPHA);
    const int lane = F.lane, r = lane & 15, q = lane >> 4, w = F.wave;
    for (int it2 = F.bid; it2 < NB_ * 8 * 2; it2 += F.G) {
        const int item = it2 >> 1, half = it2 & 1, b = item >> 3, hh = item & 7, dvw = 4 * half + (w & 3);
        const char* src = pg8::rfl_ptr((const char*)(BLOB + (size_t)item * 64 * BLOB_ELEMS));
        __syncthreads();
        if (w >= 4) {
            const unsigned ltid16 = (unsigned)((w & 3) * 64 + lane) * 16u;
            u32x4 r0[14], r1[14], r2[14];
            SCAN_LOAD(r0, 0); SCAN_LOAD(r1, 1); SCAN_LOAD(r2, 2); asm volatile("s_waitcnt vmcnt(28)" ::: "memory"); __builtin_amdgcn_sched_barrier(0); SCAN_PUT(r0, 0);
            asm volatile("s_waitcnt lgkmcnt(0)" ::: "memory"); __builtin_amdgcn_s_barrier(); asm volatile("" ::: "memory");
#pragma unroll 1
            for (int n6 = 0; n6 < 60; n6 += 6) {
                SCAN_LSTEP(n6 + 0, 1, r0, r1); SCAN_LSTEP(n6 + 1, 0, r1, r2); SCAN_LSTEP(n6 + 2, 1, r2, r0);
                SCAN_LSTEP(n6 + 3, 0, r0, r1); SCAN_LSTEP(n6 + 4, 1, r1, r2); SCAN_LSTEP(n6 + 5, 0, r2, r0);
            }
            SCAN_LSTEP(60, 1, r0, r1); SCAN_LSTEP(61, 0, r1, r2); SCAN_LSTEP(62, 1, r2, r0); SCAN_LSTEP(63, 0, r0, r1);
        } else {
            f32x4 S[8];
#pragma unroll
            for (int a = 0; a < 8; ++a) S[a] = (f32x4){0.f, 0.f, 0.f, 0.f};
            const char* ubase = pg8::rfl_ptr((const char*)(U + (size_t)item * 64 * 8192 + (size_t)(dvw * 4) * 256));
            const char* obase = pg8::rfl_ptr((const char*)(Oraw + (size_t)b * S_ * D_ + hh * 128 + 16 * dvw));
            const unsigned lane16 = (unsigned)lane * 16u, olane = (unsigned)((4 * q) * D_ + r) * 2u;
            const float gl_all = __expf(GC[(size_t)item * S_ + 64 * lane + 63]);
            f32x4 ua[4], ub[4], o[4];
#pragma unroll
            for (int tm = 0; tm < 4; ++tm) { ua[tm] = __builtin_nontemporal_load((const f32x4*)(ubase + lane16 + tm * 1024)); ub[tm] = __builtin_nontemporal_load((const f32x4*)(ubase + 8192 * 4 + lane16 + tm * 1024)); o[tm] = (f32x4){0.f, 0.f, 0.f, 0.f}; }
            asm volatile("s_waitcnt lgkmcnt(0)" ::: "memory"); __builtin_amdgcn_s_barrier(); asm volatile("" ::: "memory");
#pragma unroll 1
            for (int n2 = 0; n2 < 64; n2 += 2) { SCAN_CSTEP(n2, 0, ua); SCAN_CSTEP(n2 + 1, 1, ub); }
            { char* op = (char*)obase + (size_t)(64 * 63) * D_ * 2;
#pragma unroll
              for (int tm = 0; tm < 4; ++tm)
#pragma unroll
                  for (int reg = 0; reg < 4; ++reg) *(bf16*)(op + olane + (16 * tm + reg) * D_ * 2) = (bf16)cvtpk(o[tm][reg], 0.f); }
        }
    }
}
#undef SCAN_LSTEP
#undef SCAN_CSTEP
#undef SCAN_LOAD
#undef SCAN_PUT
constexpr int N_PHASES = 42;
#ifndef MK_FUSED
#define MK_FUSED 1
#endif

#if MK_FUSED
typedef const __attribute__((address_space(4))) Args* CArgsP;
DI Args fresh_args() {
#if defined(__HIP_DEVICE_COMPILE__)
    CArgsP kp = (CArgsP)__builtin_amdgcn_kernarg_segment_ptr(); asm volatile("" : "+s"(kp)); Args a = *kp;
    a.x = asg(a.x); a.c = asg(a.c); a.pos = asg(a.pos); a.ada_w = asg(a.ada_w); a.ada_b = asg(a.ada_b); a.ln_g = asg(a.ln_g); a.ln_b = asg(a.ln_b);
    a.attn_w_in = asg(a.attn_w_in); a.attn_w_out = asg(a.attn_w_out); a.gdn_w_in = asg(a.gdn_w_in); a.gdn_conv_w = asg(a.gdn_conv_w); a.gdn_a_log = asg(a.gdn_a_log); a.gdn_dt_bias = asg(a.gdn_dt_bias);
    a.gdn_norm_w = asg(a.gdn_norm_w); a.gdn_w_out = asg(a.gdn_w_out); a.router_w = asg(a.router_w); a.router_bias = asg(a.router_bias); a.ew1 = asg(a.ew1); a.ew3 = asg(a.ew3); a.ew2 = asg(a.ew2);
    a.sw1 = asg(a.sw1); a.sw3 = asg(a.sw3); a.sw2 = asg(a.sw2); a.out = asg(a.out); a.ws = asg(a.ws);
    return a;
#else
    return Args{};
#endif
}
DI Frame fresh_frame(int wave_s) { Frame F; int g = gridDim.x; asm volatile("" : "+s"(g)); int b = blockIdx.x; asm volatile("" : "+s"(b)); unsigned l = 0u; asm volatile("" : "+s"(l));
    int w = wave_s; asm volatile("" : "+s"(w)); int ln; asm volatile("v_mbcnt_lo_u32_b32 %0, -1, 0\n\tv_mbcnt_hi_u32_b32 %0, -1, %0" : "=&v"(ln));
    F.lds = (LAS unsigned char*)(size_t)l; F.tid = w * 64 + ln; F.lane = ln; F.wave = w; F.G = g; F.bid = b; return F; }
#define PHF() const Args A = fresh_args(); const Frame F = fresh_frame(wave_s); \
    unsigned char* ws = opq(A.ws); LAS int* idxlds = (LAS int*)(F.lds + LDS_IDX); const LAS int* tileoff = (const LAS int*)(F.lds + LDS_TILEOFF); (void)ws; (void)idxlds; (void)tileoff;
DI void ph_pro(const int wave_s) { PHF(); prologue_phase(F, A); convert_experts(F, A, 0, 0, 0, F.G); }
DI void ph_modx(const int wave_s) { PHF(); modx_phase(F, A); }
DI void ph_attn(const int wave_s) { PHF(); attn_phase(F, A); }
DI void ph_lnr(const int wave_s, int L) { PHF(); if (L == 0) ln_router_phase<true>(F, A, L); else ln_router_phase<false>(F, A, L); }
DI void ph_lnr_dry(const int wave_s, int L) { PHF(); if (L == 0) ln_router_phase<true>(F, A, L, true); else ln_router_phase<false>(F, A, L, true); }
DI void ph_scat(const int wave_s, int L) { PHF(); moe_scatter_phase(F, A, L); }
DI void ph_lnm(const int wave_s, int L) { PHF(); ln_moe_phase(F, A, L, nullptr); }
DI void ph_lnm_dry(const int wave_s, int L) { PHF(); ln_moe_phase(F, A, L, (float*)(ws + WS_Y)); }
DI void ph_gprep(const int wave_s, int lp) { PHF(); gdn_prep2_phase(F, A, lp); }
DI void ph_gwy(const int wave_s) { PHF(); gdn_wy_phase(F, A); }
DI void ph_gscan(const int wave_s, int L) { PHF(); gdn_scan2_phase(F, A); if (F.G > 128) { convert_experts(F, A, L, 0, 64, F.G - 64); if (L == 1) convert_experts(F, A, 2, 1, 64, F.G - 64); } else { convert_experts(F, A, L, 0, 0, F.G); if (L == 1) convert_experts(F, A, 2, 1, 0, F.G); } }
DI void ph_gpost(const int wave_s, int lp) { PHF(); gdn_post_phase(F, A, lp); }
DI void ph_gemm_qkv(const int wave_s, int lp) { PHF();
    pg8::DenseOrder S; S.init(WS_H, WS_WA_IN + (size_t)lp * 9216 * D_ * 2, T_, 9216, D_, F.G, F.bid);
    pg8::EpiQKV E{(bf16*)(ws + WS_BIG), (const float*)(ws + WS_COS), (const float*)(ws + WS_SIN)};
    pg8::gemm_phase<pg8::EpiQKV, pg8::DenseOrder, true, true>(F.tid, ws, F.lds, idxlds, D_, S, E); }
DI void ph_gemm_out(const int wave_s, int lp, int isg) { PHF();
    pg8::DenseOrder S; S.init(WS_O, (isg ? WS_WG_OUT : WS_WA_OUT) + (size_t)lp * D_ * D_ * 2, T_, D_, D_, F.G, F.bid);
    pg8::EpiBf16 E{(bf16*)(ws + WS_Y), D_};
    pg8::gemm_phase<pg8::EpiBf16, pg8::DenseOrder, true, true>(F.tid, ws, F.lds, idxlds, D_, S, E); }
DI void ph_gemm_gin(const int wave_s, int lp) { PHF();
    pg8::DenseOrder S; S.init(WS_H, WS_WG_IN + (size_t)lp * 4096 * D_ * 2, T_, 4096, D_, F.G, F.bid);
    pg8::EpiBf16 E{(bf16*)(ws + WS_BIG + BIG_PROJ), 4096};
    pg8::gemm_phase<pg8::EpiBf16, pg8::DenseOrder, true, true>(F.tid, ws, F.lds, idxlds, D_, S, E); }
DI void ph_moe1(const int wave_s, int L) { PHF();
    const unsigned* gcount = (const unsigned*)(ws + WS_CTL) + CW_CNT + L * 64;
    build_tileoff(F, gcount);
    pg8::MoeOrder<true> S; S.A = (unsigned)WS_H; S.Bt = (unsigned)(L == 2 ? WS_WEB : WS_WE1); S.K = D_; S.nct_log = 1; S.nunits = __builtin_amdgcn_readfirstlane(tileoff[65]) * 2; S.G = F.G; S.c = F.bid;
    S.idxoff = (unsigned)WS_ETOK; S.tileoff = tileoff; S.ecnt = (const LAS int*)(F.lds + LDS_ECNT); S.bstride = (unsigned)(512 * D_ * 2);
    pg8::EpiSwiGLU E{(bf16*)(ws + WS_HID)};
    pg8::gemm_phase<pg8::EpiSwiGLU, pg8::MoeOrder<true>, true, true>(F.tid, ws, F.lds, idxlds, D_, S, E); }
DI void ph_moe2(const int wave_s, int L) { PHF();
    const unsigned* gcount = (const unsigned*)(ws + WS_CTL) + CW_CNT + L * 64;
    build_tileoff(F, gcount);
    pg8::MoeOrder<false> S; S.A = (unsigned)WS_HID; S.Bt = (unsigned)(L == 2 ? WS_WEB + 65 * MiB : WS_WE2); S.K = 256; S.nct_log = 2; S.nunits = __builtin_amdgcn_readfirstlane(tileoff[(YS_BF16 && !YS_MERGED) ? 64 : 65]) * 4; S.G = F.G; S.c = F.bid;
    S.idxoff = (unsigned)WS_EW; S.tileoff = tileoff; S.ecnt = (const LAS int*)(F.lds + LDS_ECNT); S.bstride = (unsigned)(D_ * 256 * 2);
    pg8::EpiScale E{ws + WS_BIG, 256 * __builtin_amdgcn_readfirstlane(tileoff[64])};
    pg8::gemm_phase<pg8::EpiScale, pg8::MoeOrder<false>, false, false>(F.tid, ws, F.lds, idxlds, 256, S, E); }
DI void ph_moe2s(const int wave_s, int L) { PHF();
    __syncthreads();
    const size_t s0 = (size_t)(256 * __builtin_amdgcn_readfirstlane(((const LAS int*)(F.lds + LDS_TILEOFF))[64]));
    pg8::DenseOrder S; S.init(WS_HID + s0 * 256 * 2, (L == 2 ? WS_WEB + 65 * MiB : WS_WE2) + (size_t)NEXP * D_ * 256 * 2, T_, D_, 256, F.G, F.bid);
    pg8::EpiBf16 E{(bf16*)(ws + WS_BIG + WS_YS_OFF), D_};
    pg8::gemm_phase<pg8::EpiBf16, pg8::DenseOrder, false, false>(F.tid, ws, F.lds, idxlds, 256, S, E); }

DI void grid_bar(const int wave_s) { PHF(); XcdBarrier b; b.bar = (unsigned*)(ws + WS_CTL) + CW_BAR; volatile LAS unsigned* misc = (volatile LAS unsigned*)(F.lds + LDS_MISC); b.st = misc + 8;
    b.x = (unsigned)__builtin_amdgcn_readfirstlane((int)misc[10]); xcd_barrier(b, F.tid); }
__global__ void __launch_bounds__(NTHR, 2) mk_fwd(Args Ain) {
    extern __shared__ __attribute__((aligned(16))) unsigned char lds_raw[];
    LAS unsigned char* lds = (LAS unsigned char*)lds_raw;
    for (int u = threadIdx.x; u < (LDS_BYTES - RING_BYTES) / 4; u += NTHR) ((LAS unsigned*)(lds + RING_BYTES))[u] = 0u;
    __syncthreads();
    const int wave_s = __builtin_amdgcn_readfirstlane((int)threadIdx.x >> 6);
    { XcdBarrier bar = xcd_barrier_post((unsigned*)(Ain.ws + WS_CTL) + CW_BAR, (volatile LAS unsigned*)(lds + LDS_MISC) + 8);
      if (threadIdx.x == 0) ((volatile LAS unsigned*)(lds + LDS_MISC))[10] = bar.x; }
    __syncthreads();
#ifndef REP_BAR
#define REP_BAR 1
#define REP_PRO 1
#define REP_POST 1
#define REP_QKV 1
#define REP_OUT 1
#define REP_GIN 1
#define REP_M1 1
#define REP_M2 1
#define REP_LNM 1
#define REP_LNR 1
#endif
#define GBAR() do { for (int _b = 0; _b < REP_BAR; ++_b) grid_bar(wave_s); } while (0)
#ifndef REP_ATTN
#define REP_ATTN 1
#define REP_SCAN 1
#define REP_GEMM 1
#define REP_PREP 1
#define REP_CONV 1
#define REP_WY 1
#endif
    for (int r = 0; r < REP_PRO; ++r) { ph_pro(wave_s); GBAR(); }
    ph_modx(wave_s); GBAR();
#pragma unroll 1
    for (int L = 0; L < 4; ++L) {
        const int lp = L >> 1;
        if ((L & 1) == 0) { for (int r = 0; r < REP_QKV; ++r) { ph_gemm_qkv(wave_s, lp); GBAR(); } for (int r = 0; r < REP_ATTN; ++r) { ph_attn(wave_s); GBAR(); } for (int r = 0; r < REP_OUT; ++r) { ph_gemm_out(wave_s, lp, 0); GBAR(); } }
        else { for (int r = 0; r < REP_GIN; ++r) { ph_gemm_gin(wave_s, lp); GBAR(); } for (int r = 0; r < REP_PREP; ++r) { ph_gprep(wave_s, lp); GBAR(); } for (int r = 0; r < REP_WY; ++r) { ph_gwy(wave_s); GBAR(); } for (int r = 0; r < REP_SCAN; ++r) { ph_gscan(wave_s, L); GBAR(); } for (int r = 0; r < REP_POST; ++r) { ph_gpost(wave_s, lp); GBAR(); } for (int r = 0; r < REP_OUT; ++r) { ph_gemm_out(wave_s, lp, 1); GBAR(); } }
        for (int r = 1; r < REP_LNR; ++r) { ph_lnr_dry(wave_s, L); GBAR(); }
        ph_lnr(wave_s, L); GBAR();
        for (int r = 0; r < REP_M1; ++r) { ph_moe1(wave_s, L); GBAR(); }
        for (int r = 0; r < REP_M2; ++r) { ph_moe2(wave_s, L); if (YS_BF16 && !YS_MERGED) ph_moe2s(wave_s, L); GBAR(); }
        for (int r = 1; r < REP_LNM; ++r) { ph_lnm_dry(wave_s, L); GBAR(); }
        ph_lnm(wave_s, L); if (L < 3) GBAR();
    }
#undef GBAR
}
#else

#define MKF() extern __shared__ __attribute__((aligned(16))) unsigned char lds_raw[]; Frame F; F.lds = (LAS unsigned char*)lds_raw; F.tid = threadIdx.x; F.lane = F.tid & 63; \
    F.wave = __builtin_amdgcn_readfirstlane(F.tid >> 6); F.G = gridDim.x; F.bid = blockIdx.x; unsigned char* ws = opq(A.ws); LAS int* idxlds = (LAS int*)(F.lds + LDS_IDX); \
    const LAS int* tileoff = (const LAS int*)(F.lds + LDS_TILEOFF); (void)ws; (void)idxlds; (void)tileoff; \
    for (int u = F.tid; u < (LDS_BYTES - RING_BYTES) / 4; u += NTHR) ((LAS unsigned*)(F.lds + RING_BYTES))[u] = 0u; __syncthreads();
__global__ void __launch_bounds__(NTHR, 2) k_pro(Args A) { MKF(); prologue_phase(F, A); }
__global__ void __launch_bounds__(NTHR, 2) k_modx(Args A) { MKF(); modx_phase(F, A); }
__global__ void __launch_bounds__(NTHR, 2) k_attn(Args A) { MKF(); attn_phase(F, A); }
__global__ void __launch_bounds__(NTHR, 2) k_lnr(Args A) { MKF(); const int L = A.ph_lo; ln_router_phase<false>(F, A, L); }
__global__ void __launch_bounds__(NTHR, 2) k_scat(Args A) { MKF(); moe_scatter_phase(F, A, A.ph_lo); convert_experts(F, A, A.ph_lo); }
__global__ void __launch_bounds__(NTHR, 2) k_lnm(Args A) { MKF(); const int L = A.ph_lo; ln_moe_phase(F, A, L, nullptr); }
__global__ void __launch_bounds__(NTHR, 2) k_gprep(Args A) { MKF(); gdn_prep_phase(F, A, A.ph_lo); }
__global__ void __launch_bounds__(NTHR, 2) k_gscan(Args A) { MKF(); gdn_scan_phase(F, A); }
__global__ void __launch_bounds__(NTHR, 2) k_gpost(Args A) { MKF(); gdn_post_phase(F, A, A.ph_lo); }
__global__ void __launch_bounds__(NTHR, 2) k_gemm_qkv(Args A) { MKF(); const int lp = A.ph_lo;
    pg8::DenseOrder S; S.init(WS_H, WS_WA_IN + (size_t)lp * 9216 * D_ * 2, T_, 9216, D_, F.G, F.bid);
    pg8::EpiQKV E{(bf16*)(ws + WS_BIG), (const float*)(ws + WS_COS), (const float*)(ws + WS_SIN)};
    pg8::gemm_phase<pg8::EpiQKV, pg8::DenseOrder, true, true>(F.tid, ws, F.lds, idxlds, D_, S, E); }
__global__ void __launch_bounds__(NTHR, 2) k_gemm_out(Args A) { MKF(); const int lp = A.ph_lo >> 1, isg = A.ph_lo & 1;
    pg8::DenseOrder S; S.init(WS_O, (isg ? WS_WG_OUT : WS_WA_OUT) + (size_t)lp * D_ * D_ * 2, T_, D_, D_, F.G, F.bid);
    pg8::EpiF32 E{(float*)(ws + WS_Y), D_};
    pg8::gemm_phase<pg8::EpiF32, pg8::DenseOrder, true, true>(F.tid, ws, F.lds, idxlds, D_, S, E); }
__global__ void __launch_bounds__(NTHR, 2) k_gemm_gin(Args A) { MKF(); const int lp = A.ph_lo;
    pg8::DenseOrder S; S.init(WS_H, WS_WG_IN + (size_t)lp * 4096 * D_ * 2, T_, 4096, D_, F.G, F.bid);
    pg8::EpiBf16 E{(bf16*)(ws + WS_BIG + BIG_PROJ), 4096};
    pg8::gemm_phase<pg8::EpiBf16, pg8::DenseOrder, true, true>(F.tid, ws, F.lds, idxlds, D_, S, E); }
__global__ void __launch_bounds__(NTHR, 2) k_moe1(Args A) { MKF();
    const unsigned* gcount = (const unsigned*)(ws + WS_CTL) + CW_CNT + A.ph_lo * 64;
    build_tileoff(F, gcount);
    pg8::MoeOrder<true> S; S.A = (unsigned)WS_H; S.Bt = (unsigned)(L == 2 ? WS_WEB : WS_WE1); S.K = D_; S.nct_log = 1; S.nunits = __builtin_amdgcn_readfirstlane(tileoff[65]) * 2; S.G = F.G; S.c = F.bid;
    S.idxoff = (unsigned)WS_ETOK; S.tileoff = tileoff; S.ecnt = (const LAS int*)(F.lds + LDS_ECNT); S.bstride = (unsigned)(512 * D_ * 2);
    pg8::EpiSwiGLU E{(bf16*)(ws + WS_HID)};
    pg8::gemm_phase<pg8::EpiSwiGLU, pg8::MoeOrder<true>, true, true>(F.tid, ws, F.lds, idxlds, D_, S, E); }
__global__ void __launch_bounds__(NTHR, 2) k_moe2(Args A) { MKF();
    const unsigned* gcount = (const unsigned*)(ws + WS_CTL) + CW_CNT + A.ph_lo * 64;
    build_tileoff(F, gcount);
    pg8::MoeOrder<false> S; S.A = (unsigned)WS_HID; S.Bt = (unsigned)(L == 2 ? WS_WEB + 65 * MiB : WS_WE2); S.K = 256; S.nct_log = 2; S.nunits = __builtin_amdgcn_readfirstlane(tileoff[65]) * 4; S.G = F.G; S.c = F.bid;
    S.idxoff = (unsigned)WS_EW; S.tileoff = tileoff; S.ecnt = (const LAS int*)(F.lds + LDS_ECNT); S.bstride = (unsigned)(D_ * 256 * 2);
    pg8::EpiScale E{ws + WS_BIG, 256 * __builtin_amdgcn_readfirstlane(tileoff[64])};
    pg8::gemm_phase<pg8::EpiScale, pg8::MoeOrder<false>, false, false>(F.tid, ws, F.lds, idxlds, 256, S, E); }
#endif
extern "C" void kernel_launch(void* const* d_in, const int* in_sizes, int n_in, void* d_out, int out_size, void* d_ws, size_t ws_size, hipStream_t stream) {
    static int grid = 0;
    if (grid == 0) {
        if (n_in != 23 || in_sizes[0] != T_ * D_ || out_size != T_ * D_ || ws_size < WS_END) {
            fprintf(stderr, "kernel_launch: unexpected shapes (n_in %d, in0 %d, out %d, ws %zu < %zu); nothing launched\n", n_in, n_in > 0 ? in_sizes[0] : -1, out_size, ws_size, (size_t)WS_END); grid = -1; return; }
        int dev = 0, cus = 0, per_cu = 0;
        if (hipGetDevice(&dev) != hipSuccess || hipDeviceGetAttribute(&cus, hipDeviceAttributeMultiprocessorCount, dev) != hipSuccess) { grid = -1; return; }
#if MK_FUSED
        if (hipFuncSetAttribute((const void*)mk_fwd, hipFuncAttributeMaxDynamicSharedMemorySize, LDS_BYTES) != hipSuccess) { fprintf(stderr, "kernel_launch: hipFuncSetAttribute failed\n"); grid = -1; return; }
        if (hipOccupancyMaxActiveBlocksPerMultiprocessor(&per_cu, (const void*)mk_fwd, NTHR, LDS_BYTES) != hipSuccess || per_cu < 1)
            fprintf(stderr, "kernel_launch: note: occupancy query reports %d workgroups per CU\n", per_cu);
#else
        { const void* ks[] = {(const void*)k_pro, (const void*)k_modx, (const void*)k_attn, (const void*)k_lnr, (const void*)k_scat, (const void*)k_lnm, (const void*)k_gprep, (const void*)k_gscan, (const void*)k_gpost,
                              (const void*)k_gemm_qkv, (const void*)k_gemm_out, (const void*)k_gemm_gin, (const void*)k_moe1, (const void*)k_moe2};
          for (const void* k : ks) if (hipFuncSetAttribute(k, hipFuncAttributeMaxDynamicSharedMemorySize, LDS_BYTES) != hipSuccess) { fprintf(stderr, "kernel_launch: hipFuncSetAttribute failed\n"); grid = -1; return; } }
        (void)per_cu;
#endif
        (void)hipGetLastError();
        grid = cus;
    }
    if (grid < 0) return;
    (void)hipMemsetAsync((char*)d_ws + WS_CTL, 0, CTL_ZERO_BYTES, stream);
    Args a{};
    a.x = (const float*)d_in[0]; a.c = (const float*)d_in[1]; a.pos = (const int*)d_in[2]; a.ada_w = (const float*)d_in[3]; a.ada_b = (const float*)d_in[4];
    a.ln_g = (const float*)d_in[5]; a.ln_b = (const float*)d_in[6]; a.attn_w_in = (const float*)d_in[7]; a.attn_w_out = (const float*)d_in[8];
    a.gdn_w_in = (const float*)d_in[9]; a.gdn_conv_w = (const float*)d_in[10]; a.gdn_a_log = (const float*)d_in[11]; a.gdn_dt_bias = (const float*)d_in[12];
    a.gdn_norm_w = (const float*)d_in[13]; a.gdn_w_out = (const float*)d_in[14]; a.router_w = (const float*)d_in[15]; a.router_bias = (const float*)d_in[16];
    a.ew1 = (const float*)d_in[17]; a.ew3 = (const float*)d_in[18]; a.ew2 = (const float*)d_in[19]; a.sw1 = (const float*)d_in[20]; a.sw3 = (const float*)d_in[21]; a.sw2 = (const float*)d_in[22];
    a.out = (float*)d_out; a.ws = (unsigned char*)d_ws;
#if MK_FUSED
    a.ph_lo = 0; a.ph_hi = N_PHASES;
    hipLaunchKernelGGL(mk_fwd, dim3(grid), dim3(NTHR), LDS_BYTES, stream, a);
#else
#define LAUNCH(k, arg) do { a.ph_lo = (arg); a.ph_hi = (arg) + 1; hipLaunchKernelGGL(k, dim3(grid), dim3(NTHR), LDS_BYTES, stream, a); } while (0)
    LAUNCH(k_pro, 0); LAUNCH(k_modx, 0);
    for (int L = 0; L < 4; ++L) {
        const int lp = L >> 1;
        if ((L & 1) == 0) { LAUNCH(k_gemm_qkv, lp); LAUNCH(k_attn, 0); LAUNCH(k_gemm_out, 2 * lp); }
        else { LAUNCH(k_gemm_gin, lp); LAUNCH(k_gprep, lp); LAUNCH(k_gscan, 0); LAUNCH(k_gpost, lp); LAUNCH(k_gemm_out, 2 * lp + 1); }
        LAUNCH(k_lnr, L); LAUNCH(k_scat, L); LAUNCH(k_moe1, L); LAUNCH(k_moe2, L); LAUNCH(k_lnm, L);
    }
#undef LAUNCH
#endif
    const hipError_t le = hipPeekAtLastError();
    if (le != hipSuccess) fprintf(stderr, "kernel_launch: launch failed: %s\n", hipGetErrorName(le));
}
```

```cpp
#include <hip/hip_runtime.h>
#include <cstdio>
#include <cstdint>

#define GAS __attribute__((address_space(1)))
#define LAS __attribute__((address_space(3)))
typedef unsigned short bf16;
typedef unsigned u32x4 __attribute__((ext_vector_type(4)));
typedef unsigned u32x2 __attribute__((ext_vector_type(2)));
typedef float f32x2 __attribute__((ext_vector_type(2)));
typedef float f32x4 __attribute__((ext_vector_type(4)));
typedef float f32x16 __attribute__((ext_vector_type(16)));
typedef short bf16x8 __attribute__((ext_vector_type(8)));
typedef short s16x4 __attribute__((ext_vector_type(4)));
typedef __bf16 bf16x2_t __attribute__((ext_vector_type(2)));
#define DI __device__ __forceinline__

DI unsigned cvtpk(float lo, float hi) { f32x2 v = {lo, hi}; bf16x2_t b = __builtin_convertvector(v, bf16x2_t); return __builtin_bit_cast(unsigned, b); }
DI unsigned cvtpk_fp8(float a, float b, float c, float d) { int w = __builtin_amdgcn_cvt_pk_fp8_f32(a, b, 0, false); w = __builtin_amdgcn_cvt_pk_fp8_f32(c, d, w, true); return (unsigned)w; }
constexpr bool YS_BF16 = true;
constexpr bool YS_MERGED = true;
constexpr float YE_SCALE = 16.0f;
DI float silu_f(float a) { return a * __builtin_amdgcn_rcpf(1.0f + __expf(-a)); }
DI float bf_lo(unsigned u) { return __builtin_bit_cast(float, u << 16); }
DI float bf_hi(unsigned u) { return __builtin_bit_cast(float, u & 0xffff0000u); }
template <int M> DI float shx(float v) { return __builtin_bit_cast(float, __builtin_amdgcn_ds_swizzle(__builtin_bit_cast(int, v), (M << 10) | 0x1f)); }
DI float bperm(float v, int srclane) { return __builtin_bit_cast(float, __builtin_amdgcn_ds_bpermute(srclane << 2, __builtin_bit_cast(int, v))); }
DI float rdlane(float v, int l) { return __builtin_bit_cast(float, __builtin_amdgcn_readlane(__builtin_bit_cast(int, v), l)); }
template <int CTRL> DI float dppmov(float v) { return __builtin_bit_cast(float, __builtin_amdgcn_update_dpp(0, __builtin_bit_cast(int, v), CTRL, 0xf, 0xf, true)); }
DI float wave_sum(float v) { v += dppmov<0xB1>(v); v += dppmov<0x4E>(v); v += dppmov<0x141>(v); v += dppmov<0x140>(v); return (rdlane(v, 0) + rdlane(v, 16)) + (rdlane(v, 32) + rdlane(v, 48)); }
DI float wave_max(float v) { v = fmaxf(v, dppmov<0xB1>(v)); v = fmaxf(v, dppmov<0x4E>(v)); v = fmaxf(v, dppmov<0x141>(v)); v = fmaxf(v, dppmov<0x140>(v)); return fmaxf(fmaxf(rdlane(v, 0), rdlane(v, 16)), fmaxf(rdlane(v, 32), rdlane(v, 48))); }
#define LDS_WAIT() asm volatile("s_waitcnt lgkmcnt(0)" ::: "memory")
#define VM_WAIT() asm volatile("s_waitcnt vmcnt(0)" ::: "memory")

namespace pg8 {
constexpr int BM = 256, BK = 64, HALF = 128, HTB = HALF * BK * 2, STAGE_BYTES = 8 * HTB;
DI int lds_byte(int r, int c) { const int st = (r >> 4) * 2 + (c >> 5), rr = r & 15, cc = c & 31, ob = rr * 64 + cc * 2; return st * 1024 + (ob ^ (((ob >> 9) & 1) << 5)); }
DI void stage_rc(int b, int& R, int& C) { const int st = b / 1024, sb = b % 1024, swz = sb ^ (((sb >> 9) & 1) << 5); R = (st >> 1) * 16 + swz / 64; C = (st & 1) * 32 + (swz % 64) / 2; }
DI int perm32(int rho) { const int n = rho >> 4, i = rho & 15; return 8 * (i >> 2) + 4 * n + (i & 3); }

DI const char* rfl_ptr(const char* p) {
    const unsigned long long v = (unsigned long long)p; const unsigned lo = __builtin_amdgcn_readfirstlane((unsigned)v), hi = __builtin_amdgcn_readfirstlane((unsigned)(v >> 32));
    return (const char*)(const __attribute__((address_space(1))) char*)(((unsigned long long)hi << 32) | lo); }
struct Unit { unsigned a; unsigned b; int r0; int c0; int e; int rb; int nv; };

template <class Epi, class Sched, bool ALIGN_EPI, bool SP2>
DI void gemm_phase(const int tid, const void* wsbase, LAS unsigned char* lds, LAS int* idxlds, const int K, const Sched& S, const Epi& E) {
    const __amdgpu_buffer_rsrc_t rsrc = __builtin_amdgcn_make_buffer_rsrc((void*)wsbase, 0, 0xffffffff, 0x00020000);
    const int wid = __builtin_amdgcn_readfirstlane(tid >> 6), lane = tid & 63, wr = wid >> 2, wc = wid & 3, fr = lane & 15, fq = lane >> 4;
    const int nt = K / BK;
    unsigned voffB[2], voffA[2][2];
#pragma unroll
    for (int i = 0; i < 2; ++i) { int R, C; stage_rc(tid * 16 + i * 8192, R, C); const int Rb = Epi::PERM ? ((R & ~31) + perm32(R & 31)) : R;
        voffB[i] = (unsigned)(Rb * K + C) * 2u;
        voffA[0][i] = (unsigned)(R * K + C) * 2u; voffA[1][i] = (unsigned)((R + HALF) * K + C) * 2u; }
    const unsigned kstep = (unsigned)(BK * 2);
    const unsigned hstep = (unsigned)(HALF * K * 2);
    const unsigned ldsw = (unsigned)wid * 1024u;
    const int aoff = lds_byte(wr * 64 + fr, fq * 8), boff = lds_byte(wc * 32 + fr, fq * 8);
#define PG8_SA(b, h) (((b) * 2 + (h)) * HTB)
#define PG8_SB(b, h) ((4 + (b) * 2 + (h)) * HTB)
#define PG8_STAGE(bufoff, soff, voff) do { const int _so = __builtin_amdgcn_readfirstlane((int)(soff)); _Pragma("unroll") for (int _i = 0; _i < 2; ++_i) \
        __builtin_amdgcn_raw_ptr_buffer_load_lds(rsrc, (LAS void*)(lds + (bufoff) + ldsw + _i * 8192), 16, (int)(voff)[_i], _so, 0, 0); } while (0)
#define PG8_LDA(dst, b, h) do { _Pragma("unroll") for (int m = 0; m < 4; ++m) _Pragma("unroll") for (int k = 0; k < 2; ++k) dst[m][k] = *(const LAS bf16x8*)(lds + PG8_SA(b, h) + aoff + m * 2048 + k * 1024); } while (0)
#define PG8_LDB(dst, b, h) do { _Pragma("unroll") for (int n = 0; n < 2; ++n) _Pragma("unroll") for (int k = 0; k < 2; ++k) dst[n][k] = *(const LAS bf16x8*)(lds + PG8_SB(b, h) + boff + n * 2048 + k * 1024); } while (0)
#define PG8_MMA(ai, bj, At, Bt) do { __builtin_amdgcn_s_setprio(1); _Pragma("unroll") for (int m = 0; m < 4; ++m) _Pragma("unroll") for (int n = 0; n < 2; ++n) _Pragma("unroll") for (int k = 0; k < 2; ++k) \
        acc[ai][bj][m][n] = __builtin_amdgcn_mfma_f32_16x16x32_bf16(Bt[n][k], At[m][k], acc[ai][bj][m][n], 0, 0, 0); __builtin_amdgcn_s_setprio(0); } while (0)
#define PG8_WAIT_V(n) asm volatile("s_waitcnt vmcnt(" #n ")" ::: "memory")
#define PG8_WAIT_L(n) asm volatile("s_waitcnt lgkmcnt(" #n ")" ::: "memory")
#define PG8_BAR __builtin_amdgcn_s_barrier()
#define PG8_SCHED __builtin_amdgcn_sched_barrier(0)
#define PG8_IDX_ISSUE(u, slot) __builtin_amdgcn_raw_ptr_buffer_load_lds(rsrc, (LAS void*)(idxlds + (slot) * 256 + (wid & 3) * 64), 4, lane * 4, \
        __builtin_amdgcn_readfirstlane((int)(S.idxoff + (unsigned)((u).rb + (wid & 3) * 64) * 4u)), 0, 0)
#define PG8_IDX_READ(dst, h_, slot, nv_) do { int _t = tid; asm volatile("" : "+v"(_t));   \
        _Pragma("unroll") for (int _i = 0; _i < 2; ++_i) { int _R, _C; stage_rc(_t * 16 + _i * 8192, _R, _C); \
        const int _ix = ((h_) * HALF + _R) < (nv_) ? idxlds[(slot) * 256 + (h_) * HALF + _R] : S.padrow;        \
        dst[_i] = (unsigned)_ix * (unsigned)(K * 2) + (unsigned)(_C * 2); } } while (0)
    Unit cur, nxt; int ui = 0;
    if (!S.next(0, cur)) return;
    f32x4 acc[2][2][4][2];
#pragma unroll
    for (int a = 0; a < 2; ++a)
#pragma unroll
        for (int b = 0; b < 2; ++b)
#pragma unroll
            for (int m = 0; m < 4; ++m)
#pragma unroll
                for (int n = 0; n < 2; ++n) acc[a][b][m][n] = (f32x4){0.f, 0.f, 0.f, 0.f};
    bf16x8 At[4][2], B0[2][2], B1[2][2];
    unsigned cA = cur.a, cB = cur.b;
    if constexpr (Sched::GATHER || Epi::ROWAUX) {
        PG8_IDX_ISSUE(cur, 0); PG8_WAIT_V(0); PG8_BAR;     asm volatile("" ::: "memory");
        if constexpr (Sched::GATHER) { PG8_IDX_READ(voffA[0], 0, 0, cur.nv); PG8_IDX_READ(voffA[1], 1, 0, cur.nv); }
    }
    if constexpr (SP2) {
        PG8_STAGE(PG8_SB(0, 0), cB, voffB); PG8_STAGE(PG8_SB(0, 1), cB + hstep, voffB); PG8_STAGE(PG8_SA(0, 0), cA, voffA[0]); PG8_STAGE(PG8_SA(0, 1), cA, voffA[1]);
        if (wr == 1) PG8_BAR;
        PG8_WAIT_V(2); PG8_BAR;
        PG8_STAGE(PG8_SB(1, 0), cB + kstep, voffB); PG8_STAGE(PG8_SA(1, 0), cA + kstep, voffA[0]); PG8_STAGE(PG8_SB(1, 1), cB + hstep + kstep, voffB);
        PG8_WAIT_V(6); PG8_BAR;
    } else {
        PG8_STAGE(PG8_SB(0, 0), cB, voffB); PG8_STAGE(PG8_SA(0, 0), cA, voffA[0]); PG8_STAGE(PG8_SB(0, 1), cB + hstep, voffB); PG8_STAGE(PG8_SA(0, 1), cA, voffA[1]);
        if (wr == 1) PG8_BAR;
        PG8_WAIT_V(4); PG8_BAR;
        PG8_STAGE(PG8_SB(1, 0), cB + kstep, voffB); PG8_STAGE(PG8_SA(1, 0), cA + kstep, voffA[0]); PG8_STAGE(PG8_SB(1, 1), cB + hstep + kstep, voffB);
        PG8_WAIT_V(6); PG8_BAR;
    }
    for (;;) {
        const bool has_next = S.next(ui + 1, nxt);
        const unsigned nA = has_next ? nxt.a : cA, nB = has_next ? nxt.b : cB;
        for (int t = 0; t < nt; t += 2) {
            const bool last = (t == nt - 2);
            const unsigned a1 = cA + (unsigned)(t + 1) * kstep;
            const unsigned a2 = last ? nA : cA + (unsigned)(t + 2) * kstep, b2 = last ? nB : cB + (unsigned)(t + 2) * kstep;
            const unsigned a3 = a2 + kstep, b3 = b2 + kstep;
            if constexpr (Sched::GATHER || Epi::ROWAUX) { if (t == 0 && has_next) PG8_IDX_ISSUE(nxt, (ui + 1) % 3); }
            if constexpr (Sched::GATHER) { if (last && has_next) PG8_IDX_READ(voffA[0], 0, (ui + 1) % 3, nxt.nv); }
#define PG8_NEXT_H1() do { if constexpr (Sched::GATHER) { if (last && has_next) PG8_IDX_READ(voffA[1], 1, (ui + 1) % 3, nxt.nv); } } while (0)
            if constexpr (SP2) {
            PG8_LDB(B0, 0, 0); PG8_LDB(B1, 0, 1); PG8_SCHED; PG8_LDA(At, 0, 0); PG8_STAGE(PG8_SA(1, 1), a1, voffA[1]); PG8_NEXT_H1();
            PG8_WAIT_V(8); PG8_WAIT_L(0); PG8_BAR; PG8_MMA(0, 0, At, B0); PG8_MMA(0, 1, At, B1); PG8_BAR; PG8_SCHED;
            PG8_LDA(At, 0, 1); PG8_STAGE(PG8_SB(0, 0), b2, voffB); PG8_STAGE(PG8_SB(0, 1), b2 + hstep, voffB); PG8_STAGE(PG8_SA(0, 0), a2, voffA[0]);
            PG8_WAIT_V(8); PG8_WAIT_L(0); PG8_BAR; PG8_MMA(1, 0, At, B0); PG8_MMA(1, 1, At, B1); PG8_BAR; PG8_SCHED;
            PG8_LDB(B0, 1, 0); PG8_LDB(B1, 1, 1); PG8_SCHED; PG8_LDA(At, 1, 0); PG8_STAGE(PG8_SA(0, 1), a2, voffA[1]);
            PG8_WAIT_V(8); PG8_WAIT_L(0); PG8_BAR; PG8_MMA(0, 0, At, B0); PG8_MMA(0, 1, At, B1); PG8_BAR; PG8_SCHED;
            PG8_LDA(At, 1, 1); PG8_STAGE(PG8_SB(1, 0), b3, voffB); PG8_STAGE(PG8_SB(1, 1), b3 + hstep, voffB); PG8_STAGE(PG8_SA(1, 0), a3, voffA[0]);
            PG8_WAIT_V(8); PG8_WAIT_L(0); PG8_BAR; PG8_MMA(1, 0, At, B0); PG8_MMA(1, 1, At, B1); PG8_BAR; PG8_SCHED;
            } else {
            PG8_LDB(B0, 0, 0); PG8_SCHED; PG8_LDA(At, 0, 0); PG8_STAGE(PG8_SA(1, 1), a1, voffA[1]); PG8_NEXT_H1();
            PG8_WAIT_L(8); PG8_BAR; PG8_WAIT_L(0); PG8_MMA(0, 0, At, B0); PG8_BAR; PG8_SCHED;
            PG8_LDB(B1, 0, 1); PG8_STAGE(PG8_SB(0, 0), b2, voffB);
            PG8_BAR; PG8_WAIT_L(0); PG8_MMA(0, 1, At, B1); PG8_BAR;
            PG8_LDA(At, 0, 1); PG8_STAGE(PG8_SA(0, 0), a2, voffA[0]);
            PG8_BAR; PG8_WAIT_L(0); PG8_MMA(1, 0, At, B0); PG8_BAR; PG8_SCHED;
            PG8_STAGE(PG8_SB(0, 1), b2 + hstep, voffB);
            PG8_WAIT_V(6); PG8_BAR; PG8_MMA(1, 1, At, B1); PG8_BAR;
            PG8_LDB(B0, 1, 0); PG8_SCHED; PG8_LDA(At, 1, 0); PG8_STAGE(PG8_SA(0, 1), a2, voffA[1]);
            PG8_WAIT_L(8); PG8_BAR; PG8_WAIT_L(0); PG8_MMA(0, 0, At, B0); PG8_BAR; PG8_SCHED;
            PG8_LDB(B1, 1, 1); PG8_STAGE(PG8_SB(1, 0), b3, voffB);
            PG8_BAR; PG8_WAIT_L(0); PG8_MMA(0, 1, At, B1); PG8_BAR;
            PG8_LDA(At, 1, 1); PG8_STAGE(PG8_SA(1, 0), a3, voffA[0]);
            PG8_BAR; PG8_WAIT_L(0); PG8_MMA(1, 0, At, B0); PG8_BAR; PG8_SCHED;
            PG8_STAGE(PG8_SB(1, 1), b3 + hstep, voffB);
            PG8_WAIT_V(6); PG8_BAR; PG8_MMA(1, 1, At, B1); PG8_BAR;
            }
        }
        if constexpr (ALIGN_EPI) { if (wr == 0) PG8_BAR; }
        if constexpr (Epi::ROWAUX) E(acc, cur, wr, wc, fr, fq, idxlds + (ui % 3) * 256); else E(acc, cur, wr, wc, fr, fq);
        if (!has_next) break;
#pragma unroll
        for (int a = 0; a < 2; ++a)
#pragma unroll
            for (int b = 0; b < 2; ++b)
#pragma unroll
                for (int m = 0; m < 4; ++m)
#pragma unroll
                    for (int n = 0; n < 2; ++n) acc[a][b][m][n] = (f32x4){0.f, 0.f, 0.f, 0.f};
        cur = nxt; cA = nA; cB = nB; ++ui;
        if constexpr (ALIGN_EPI) { if (wr == 1) PG8_BAR; }
    }
    PG8_WAIT_V(0);
    if constexpr (!ALIGN_EPI) { if (wr == 0) PG8_BAR; }
    PG8_BAR;
#undef PG8_SA
#undef PG8_SB
#undef PG8_STAGE
#undef PG8_LDA
#undef PG8_LDB
#undef PG8_MMA
#undef PG8_WAIT_V
#undef PG8_WAIT_L
#undef PG8_BAR
#undef PG8_SCHED
#undef PG8_IDX_ISSUE
#undef PG8_IDX_READ
#undef PG8_NEXT_H1
}
}
constexpr int T_ = 16384, D_ = 1024, NB_ = 4, S_ = 4096, NEXP = 64, TOPK = 8;
constexpr int ECAP = 16384;
constexpr int PMAX = 163840;
constexpr float LN_EPS = 1e-5f, RMS_EPS = 1e-6f;
constexpr float ALPHA_DN = 1.6817928305074290f;
constexpr float QSCALE = 0.125f * 1.4426950408889634f;

namespace pg8 {
constexpr int NXCD = 8, WGM = 8;
struct DenseOrder {
    static constexpr bool GATHER = false;
    unsigned A, Bt; int K; int nM, nN, nwg, G, c; unsigned idxoff; static constexpr int padrow = 0;
    DI void init(size_t A_, size_t Bt_, int M, int N, int K_, int G_, int c_) { A = (unsigned)A_; Bt = (unsigned)Bt_; K = K_; nM = M / BM; nN = N / BM; nwg = nM * nN; G = G_; c = c_; idxoff = 0u; }
    DI bool next(int i, Unit& u) const {
        const long L = (long)i * G + c; if (L >= nwg) return false;
        int wgid = (int)L; { const int q = nwg / NXCD, r = nwg % NXCD, xcd = wgid % NXCD, off = wgid / NXCD; wgid = (xcd < r ? xcd * (q + 1) : r * (q + 1) + (xcd - r) * q) + off; }
        const int nig = WGM * nN, gid = wgid / nig, fm = gid * WGM, gsz = (nM - fm) < WGM ? (nM - fm) : WGM;
        const int pm = fm + ((wgid % nig) % gsz), pn = (wgid % nig) / gsz;
        u.a = A + (unsigned)(pm * BM * K * 2); u.b = Bt + (unsigned)(pn * BM * K * 2); u.r0 = pm * BM; u.c0 = pn * BM; u.e = 0; u.rb = 0; u.nv = BM; return true;
    }
};
template <bool GATH> struct MoeOrder {
    static constexpr bool GATHER = GATH;
    unsigned A, Bt; int K; int nct_log, nunits, G, c; unsigned idxoff; const LAS int* tileoff; const LAS int* ecnt; unsigned bstride; static constexpr int padrow = T_;
    DI bool next(int i, Unit& u) const {
        const long L = (long)i * G + c; if (L >= nunits) return false;
        int wgid = (int)L; { const int q = nunits / NXCD, r = nunits % NXCD, xcd = wgid % NXCD, off = wgid / NXCD; wgid = (xcd < r ? xcd * (q + 1) : r * (q + 1) + (xcd - r) * q) + off; }
        const int tile = wgid >> nct_log, pn = wgid & ((1 << nct_log) - 1);
        int e = 0;
#pragma unroll 1
        for (int j = 32; j >= 1; j >>= 1) { const int cand = e + j; if (tileoff[cand] <= tile) e = cand; }
        if (e < NEXP && tileoff[e + 1] <= tile) e += 1;
        e = __builtin_amdgcn_readfirstlane(e);
        u.e = e; u.r0 = tile * BM; u.c0 = pn * BM;
        { const int ti = tile - __builtin_amdgcn_readfirstlane(tileoff[e]); u.rb = e * ECAP + ti * BM; u.nv = __builtin_amdgcn_readfirstlane(ecnt[e]) - ti * BM; }
        u.a = GATH ? A : A + (unsigned)(tile * BM * K * 2);
        u.b = Bt + (unsigned)e * bstride + (unsigned)(pn * BM * K * 2);
        return true;
    }
};

struct EpiF32 {
    static constexpr bool PERM = false, ROWAUX = false;
    float* C; int ldc;
    DI void operator()(const f32x4 (&acc)[2][2][4][2], const Unit& u, int wr, int wc, int fr, int fq) const {
        const int row0 = u.r0 + wr * 64 + fr, col0 = u.c0 + wc * 32 + 4 * fq;
#pragma unroll
        for (int ai = 0; ai < 2; ++ai)
#pragma unroll
            for (int m = 0; m < 4; ++m) { float* rowp = C + (size_t)(row0 + ai * HALF + m * 16) * ldc + col0;
#pragma unroll
                for (int bj = 0; bj < 2; ++bj)
#pragma unroll
                    for (int n = 0; n < 2; ++n) *(f32x4*)(rowp + bj * HALF + n * 16) = acc[ai][bj][m][n]; }
    }
};
struct EpiBf16 {
    static constexpr bool PERM = true, ROWAUX = false;
    bf16* O; int ldc;
    DI void operator()(const f32x4 (&acc)[2][2][4][2], const Unit& u, int wr, int wc, int fr, int fq) const {
        const int row0 = u.r0 + wr * 64 + fr, col0 = u.c0 + wc * 32 + 8 * fq;
#pragma unroll
        for (int ai = 0; ai < 2; ++ai)
#pragma unroll
            for (int m = 0; m < 4; ++m) { bf16* rowp = O + (size_t)(row0 + ai * HALF + m * 16) * ldc + col0;
#pragma unroll
                for (int bj = 0; bj < 2; ++bj) { const f32x4 v0 = acc[ai][bj][m][0], v1 = acc[ai][bj][m][1];
                    u32x4 w; w.x = cvtpk(v0[0], v0[1]); w.y = cvtpk(v0[2], v0[3]); w.z = cvtpk(v1[0], v1[1]); w.w = cvtpk(v1[2], v1[3]);
                    *(u32x4*)(rowp + bj * HALF) = w; } }
    }
};
struct EpiQKV {
    static constexpr bool PERM = true, ROWAUX = false;
    bf16* QKV; const float* COS; const float* SIN;
    DI void operator()(const f32x4 (&acc)[2][2][4][2], const Unit& u, int wr, int wc, int fr, int fq) const {
        const int pn = u.c0 >> 8, g = pn / 12, which = (pn >> 2) % 3, hq = pn & 3;
        const int ldil = 2 * g, dil = 1 << ldil;
        const int idx = 4 * (wc & 1) + fq, b = u.r0 >> 12;
        const int row0 = u.r0 + wr * 64 + fr;
#pragma unroll
        for (int ai = 0; ai < 2; ++ai)
#pragma unroll
            for (int m = 0; m < 4; ++m) {
                const int r = row0 + ai * HALF + m * 16, t = r & (S_ - 1);
                const int prow = (t & (dil - 1)) * (S_ >> ldil) + (t >> ldil);
                f32x4 c4 = (f32x4){1.f, 1.f, 1.f, 1.f}, s4 = (f32x4){0.f, 0.f, 0.f, 0.f};
                if (which < 2) { c4 = *(const f32x4*)(COS + (size_t)r * 32 + 4 * idx); s4 = *(const f32x4*)(SIN + (size_t)r * 32 + 4 * idx); }
#pragma unroll
                for (int bj = 0; bj < 2; ++bj) {
                    const int head = 4 * hq + 2 * bj + (wc >> 1);
                    const f32x4 v0 = acc[ai][bj][m][0], v1 = acc[ai][bj][m][1];
                    f32x4 o0 = v0 * c4 - v1 * s4, o1 = v1 * c4 + v0 * s4;
                    if (which == 0) { o0 = o0 * QSCALE; o1 = o1 * QSCALE; }
                    u32x4 w; w.x = cvtpk(o0[0], o0[1]); w.y = cvtpk(o0[2], o0[3]); w.z = cvtpk(o1[0], o1[1]); w.w = cvtpk(o1[2], o1[3]);
                    bf16* dst = QKV + ((((size_t)(which * 3 + g) * NB_ + b) * 16 + head) * S_ + prow) * 64 + 8 * idx;
                    *(u32x4*)dst = w;
                }
            }
    }
};
struct EpiSwiGLU {
    static constexpr bool PERM = true, ROWAUX = false;
    bf16* HID;
    DI void operator()(const f32x4 (&acc)[2][2][4][2], const Unit& u, int wr, int wc, int fr, int fq) const {
        const int row0 = u.r0 + wr * 64 + fr, col0 = (u.c0 >> 1) + wc * 32 + 8 * fq;
#pragma unroll
        for (int ai = 0; ai < 2; ++ai)
#pragma unroll
            for (int m = 0; m < 4; ++m) {
                float hv[8];
#pragma unroll
                for (int n = 0; n < 2; ++n)
#pragma unroll
                    for (int j = 0; j < 4; ++j) { const float a = acc[ai][0][m][n][j], bb = acc[ai][1][m][n][j]; hv[4 * n + j] = silu_f(a) * bb; }
                u32x4 w; w.x = cvtpk(hv[0], hv[1]); w.y = cvtpk(hv[2], hv[3]); w.z = cvtpk(hv[4], hv[5]); w.w = cvtpk(hv[6], hv[7]);
                *(u32x4*)(HID + (size_t)(row0 + ai * HALF + m * 16) * 256 + col0) = w;
            }
    }
};
constexpr size_t YS_OFF = (size_t)160 << 20;
struct EpiScale {
    static constexpr bool PERM = true, ROWAUX = true;
    unsigned char* YE;
    int s0;
    DI void operator()(const f32x4 (&acc)[2][2][4][2], const Unit& u, int wr, int wc, int fr, int fq, const LAS int* aux) const {
        const int row0 = wr * 64 + fr, col0 = u.c0 + wc * 32 + 8 * fq;
        if (u.e == NEXP) {
            bf16* base = (bf16*)pg8::rfl_ptr((const char*)(YE + YS_OFF) + (size_t)(u.r0 - s0) * (D_ * 2));
#pragma unroll
            for (int ai = 0; ai < 2; ++ai)
#pragma unroll
                for (int m = 0; m < 4; ++m) { const unsigned ro = (unsigned)((row0 + ai * HALF + m * 16) * D_ + col0) * 2u;
#pragma unroll
                    for (int bj = 0; bj < 2; ++bj) { const f32x4 v0 = acc[ai][bj][m][0], v1 = acc[ai][bj][m][1];
                        u32x4 w; w.x = cvtpk(v0[0], v0[1]); w.y = cvtpk(v0[2], v0[3]); w.z = cvtpk(v1[0], v1[1]); w.w = cvtpk(v1[2], v1[3]);
                        *(u32x4*)((char*)base + ro + bj * HALF * 2) = w; } }
        } else {
            unsigned char* base = (unsigned char*)pg8::rfl_ptr((const char*)YE + (size_t)u.r0 * D_);
#pragma unroll
            for (int ai = 0; ai < 2; ++ai)
#pragma unroll
                for (int m = 0; m < 4; ++m) { const int rl = row0 + ai * HALF + m * 16; const float wgt = __builtin_bit_cast(float, aux[rl]) * YE_SCALE; const unsigned ro = (unsigned)(rl * D_ + col0);
#pragma unroll
                    for (int bj = 0; bj < 2; ++bj) { const f32x4 v0 = acc[ai][bj][m][0] * wgt, v1 = acc[ai][bj][m][1] * wgt;
                        u32x2 w; w.x = cvtpk_fp8(v0[0], v0[1], v0[2], v0[3]); w.y = cvtpk_fp8(v1[0], v1[1], v1[2], v1[3]);
                        *(u32x2*)(base + ro + bj * HALF) = w; } }
        }
    }
};
}
constexpr size_t MiB = 1u << 20;
constexpr size_t WS_CTL = 0, CTL_ZERO_BYTES = 1 * MiB;
constexpr size_t WS_MOD = 1 * MiB;
constexpr size_t WS_COS = 2 * MiB;
constexpr size_t WS_SIN = 4 * MiB;
constexpr size_t WS_ASG_E = 6 * MiB;
constexpr size_t WS_ASG_R = 6 * MiB + 512 * 1024;
constexpr size_t WS_ASG_W = 7 * MiB;
constexpr size_t WS_ASG_ROW = 7 * MiB + 512 * 1024;
constexpr size_t WS_ROWTOK = 8 * MiB;
constexpr size_t WS_ROWW = 9 * MiB;
constexpr size_t WS_AB = 10 * MiB;
constexpr size_t WS_GALPHA = 11 * MiB;
constexpr size_t WS_GBETA = 11 * MiB + 512 * 1024;
constexpr size_t WS_X = 12 * MiB;
constexpr size_t WS_Y = 76 * MiB;
constexpr size_t WS_H = 140 * MiB;
constexpr size_t WS_O = 173 * MiB;
constexpr size_t WS_WA_IN = 205 * MiB;
constexpr size_t WS_WA_OUT = 241 * MiB;
constexpr size_t WS_WG_IN = 245 * MiB;
constexpr size_t WS_WG_OUT = 261 * MiB;
constexpr size_t WS_WE1 = 265 * MiB;
constexpr size_t WS_WE2 = 330 * MiB;
constexpr size_t WS_HID = 363 * MiB;
constexpr size_t WS_BIG = 443 * MiB;
constexpr size_t WS_YS_OFF = pg8::YS_OFF;
constexpr size_t WS_WEB = WS_BIG + 368 * MiB;
constexpr size_t WS_WRF = WS_BIG + 466 * MiB;
constexpr size_t WS_WABF = WS_WRF + 1 * MiB;
constexpr size_t WS_ETOK = WS_WABF + 1 * MiB;
constexpr size_t WS_EW = WS_ETOK + 5 * MiB;
constexpr size_t WS_END = WS_EW + 5 * MiB;
constexpr size_t BIG_PROJ = 0, BIG_QN = 128 * MiB, BIG_KN = 192 * MiB, BIG_VV = 256 * MiB, BIG_ORAW = 320 * MiB;
constexpr int CW_BAR = 4096;
constexpr int CW_CNT = 16384;
constexpr int RING_BYTES = 131072;
constexpr int LDS_IDX = RING_BYTES;
constexpr int LDS_TILEOFF = LDS_IDX + 3072;
constexpr int LDS_LCNT = LDS_TILEOFF + 512;
constexpr int LDS_LBASE = LDS_LCNT + 256;
constexpr int LDS_LASG = LDS_LBASE + 256;
constexpr int LDS_ECNT = LDS_LASG;
constexpr int LDS_LW = LDS_IDX;
constexpr int LDS_MISC = LDS_LASG + 2048;
constexpr int LDS_LG = LDS_MISC + 128;
constexpr int LDS_BYTES = 147456;
static_assert(LDS_LG + 8192 <= LDS_BYTES, "LDS map");
constexpr int NWAVES = 8, NTHR = 512;

#define XB_TMO      128
#define XB_XCNT(j)  (256  + 64 * (j))
#define XB_XSUB(j)  (1280 + 64 * (j))
#define XB_XGEN(j)  (2304 + 64 * (j))
#define XB_TOP      3328
#define XB_TOPGEN   3392
#define XCD_BAR_WORDS 3456
#define XB_SPIN_CAP (1u << 18)
__device__ __forceinline__ unsigned xb_ld(unsigned* p)              { return __hip_atomic_load(p, __ATOMIC_RELAXED, __HIP_MEMORY_SCOPE_AGENT); }
__device__ __forceinline__ unsigned xb_add(unsigned* p, unsigned v) { return __hip_atomic_fetch_add(p, v, __ATOMIC_RELAXED, __HIP_MEMORY_SCOPE_AGENT); }
__device__ __forceinline__ unsigned xb_xcc_id() { return (unsigned)__builtin_amdgcn_s_getreg((3 << 11) | 20) & 0xFu; }
#define XB_SPIN(cond, bar) do { unsigned _sp = 0; while (cond) { __builtin_amdgcn_s_sleep(1); \
    if ((++_sp & 255u) == 0u) { if (xb_ld(&(bar)[XB_TMO])) break; if (_sp > XB_SPIN_CAP) { atomicAdd(&(bar)[XB_TMO], 1u); break; } } } } while (0)
struct XcdBarrier { unsigned* bar; unsigned x; volatile LAS unsigned* st; };
__device__ __forceinline__ XcdBarrier xcd_barrier_post(unsigned* bar, volatile LAS unsigned* st) {
    XcdBarrier b; b.bar = bar; b.x = xb_xcc_id(); b.st = st;
    if (threadIdx.x == 0) (void)xb_add(&bar[XB_XCNT(b.x)], 1u);
    return b;
}
__device__ __forceinline__ void xcd_barrier_complete(unsigned* bar, unsigned x, unsigned& nloc, unsigned& nx) {
    const unsigned G = gridDim.x * gridDim.y * gridDim.z;
    unsigned sum, cnt, mine, sp = 0u;
    for (;;) {
        sum = 0u; cnt = 0u; mine = 0u;
#pragma unroll
        for (unsigned j = 0; j < 16; ++j) { const unsigned c = xb_ld(&bar[XB_XCNT(j)]); sum += c; cnt += (c > 0u) ? 1u : 0u; mine = (j == x) ? c : mine; }
        if (sum == G) break;
        __builtin_amdgcn_s_sleep(1);
        if ((++sp & 255u) == 0u) { if (xb_ld(&bar[XB_TMO])) break; if (sp > XB_SPIN_CAP) { atomicAdd(&bar[XB_TMO], 1u); break; } }
    }
    nloc = mine > 0u ? mine : 1u; nx = cnt > 0u ? cnt : 1u;
}
__device__ __forceinline__ void xcd_barrier(const XcdBarrier& b, const int tid) {
    asm volatile("s_waitcnt vmcnt(0)" ::: "memory");
    __syncthreads();
    if (tid == 0) {
        unsigned* bar = b.bar;
        __builtin_amdgcn_s_waitcnt(0);
        unsigned nloc = b.st[0], nx = b.st[1];
        if (nloc == 0u) { xcd_barrier_complete(bar, b.x, nloc, nx); b.st[0] = nloc; b.st[1] = nx; }
        const unsigned old = xb_add(&bar[XB_XSUB(b.x)], 1u);
        const unsigned gen = old / nloc;
        if (old + 1u == (gen + 1u) * nloc) {
            __builtin_amdgcn_fence(__ATOMIC_RELEASE, "agent");
            asm volatile("s_waitcnt vmcnt(0)" ::: "memory");
            const unsigned og = xb_add(&bar[XB_TOP], 1u);
            const unsigned tg = og / nx;
            if (og + 1u == (tg + 1u) * nx) xb_add(&bar[XB_TOPGEN], 1u);
            else XB_SPIN(xb_ld(&bar[XB_TOPGEN]) == tg, bar);
            __builtin_amdgcn_fence(__ATOMIC_ACQUIRE, "agent");
            xb_add(&bar[XB_XGEN(b.x)], 1u);
            asm volatile("s_waitcnt vmcnt(0)" ::: "memory");
        } else {
            XB_SPIN(xb_ld(&bar[XB_XGEN(b.x)]) == gen, bar);
            __builtin_amdgcn_fence(__ATOMIC_ACQUIRE, "agent");
            asm volatile("s_waitcnt vmcnt(0)" ::: "memory");
        }
    }
    __syncthreads();
}

struct Args {
    const float* x; const float* c; const int* pos; const float* ada_w; const float* ada_b; const float* ln_g; const float* ln_b;
    const float* attn_w_in; const float* attn_w_out; const float* gdn_w_in; const float* gdn_conv_w; const float* gdn_a_log; const float* gdn_dt_bias;
    const float* gdn_norm_w; const float* gdn_w_out; const float* router_w; const float* router_bias; const float* ew1; const float* ew3; const float* ew2;
    const float* sw1; const float* sw3; const float* sw2;
    float* out; unsigned char* ws; int ph_lo, ph_hi;
};
typedef __attribute__((address_space(1))) unsigned char gas_u8;
DI unsigned char* opq(unsigned char* p) { gas_u8* g = (gas_u8*)p; asm volatile("" : "+s"(g)); return (unsigned char*)g; }
template <class T> DI T* asg(T* p) { typedef __attribute__((address_space(1))) T gT; return (T*)(gT*)p; }
struct Frame {
    LAS unsigned char* lds;
    int tid, lane, wave, G, bid;
};
template <class Map> DI void transpose_item(const float* W, int ldn, int K, bf16* WT, const Map& map, LAS float* scr, int kb, int nb, int lane) {
    const int k0 = 64 * kb, n0 = 32 * nb;
    float tv[32];
#pragma unroll
    for (int i = 0; i < 32; ++i) tv[i] = __builtin_nontemporal_load(&W[(size_t)(k0 + 2 * i + (lane >> 5)) * ldn + n0 + (lane & 31)]);
#pragma unroll
    for (int i = 0; i < 32; ++i) scr[(2 * i + (lane >> 5)) * 33 + (lane & 31)] = tv[i];
    LDS_WAIT(); asm volatile("" ::: "memory");
    const int c = lane & 7;
#pragma unroll
    for (int j = 0; j < 4; ++j) { const int n = (lane >> 3) + 8 * j; const LAS float* s = scr + (8 * c) * 33 + n;
        u32x4 o; o.x = cvtpk(s[0 * 33], s[1 * 33]); o.y = cvtpk(s[2 * 33], s[3 * 33]); o.z = cvtpk(s[4 * 33], s[5 * 33]); o.w = cvtpk(s[6 * 33], s[7 * 33]);
        __builtin_nontemporal_store(o, (u32x4*)(WT + (size_t)map(n0 + n) * K + k0 + 8 * c)); }
    LDS_WAIT(); asm volatile("" ::: "memory");
}
struct MapId { int off; DI int operator()(int n) const { return off + n; } };
struct MapQKV { DI int operator()(int n) const {
    const int which = (n >> 10) % 3; if (which == 2) return n;
    const int d = n & 63, idx = (d & 31) >> 2, lo = d & 3, hi = d >> 5; return (n & ~63) + 8 * idx + 4 * hi + lo; } };
struct MapW13 { int second; DI int operator()(int n) const { return (n >> 7) * 256 + second * 128 + (n & 127); } };
template <class Map> DI void convert_matrix(const Frame& F, const float* W, int ldn, int K, int N, bf16* WT, const Map& map) {
    LAS float* scr = (LAS float*)(F.lds + F.wave * 16384);
    const int gw = F.bid * NWAVES + F.wave, NGW = F.G * NWAVES, nblk = N / 32, nitems = (K / 64) * nblk;
    for (int it = gw; it < nitems; it += NGW) transpose_item(W, ldn, K, WT, map, scr, it / nblk, it % nblk, F.lane);
}

DI void prologue_phase(const Frame& F, const Args& A) {
    unsigned char* ws = opq(A.ws);
    {
        LAS float* red = (LAS float*)F.lds;
        float* MOD = (float*)(ws + WS_MOD);
        for (int item = F.bid; item < 8 * 48; item += F.G) {
            const int ls = item / 48, n = (item % 48) * 64 + F.lane;
            const float* w = A.ada_w + ((size_t)ls * D_ + F.wave * 128) * 3072 + n;
            const float* cc = A.c + F.wave * 128;
            float a0 = 0.f, a1 = 0.f, a2 = 0.f, a3 = 0.f;
#pragma unroll 32
            for (int k = 0; k < 128; ++k) { const float wv = __builtin_nontemporal_load(&w[(size_t)k * 3072]);        a0 += cc[k] * wv; a1 += cc[D_ + k] * wv; a2 += cc[2 * D_ + k] * wv; a3 += cc[3 * D_ + k] * wv; }
            red[(F.wave * 4 + 0) * 64 + F.lane] = a0; red[(F.wave * 4 + 1) * 64 + F.lane] = a1; red[(F.wave * 4 + 2) * 64 + F.lane] = a2; red[(F.wave * 4 + 3) * 64 + F.lane] = a3;
            __syncthreads();
            if (F.wave < 4) { float s = A.ada_b[ls * 3072 + n];
#pragma unroll
                for (int w8 = 0; w8 < 8; ++w8) s += red[(w8 * 4 + F.wave) * 64 + F.lane];
                MOD[((size_t)ls * 4 + F.wave) * 3072 + n] = s; }
            __syncthreads();
        }
    }
    {
        float* COS = (float*)(ws + WS_COS); float* SIN = (float*)(ws + WS_SIN);
        for (int idx = F.bid * NTHR + F.tid; idx < T_ * 32; idx += F.G * NTHR) {
            const int t = idx >> 5, i = idx & 31;
            const float inv = powf(10000.0f, -(float)i / 32.0f);
            const float ang = (float)A.pos[t] * inv;
            COS[idx] = cosf(ang); SIN[idx] = sinf(ang);
        }
    }
    {
        bf16* WRF = (bf16*)(ws + WS_WRF); bf16* WABF = (bf16*)(ws + WS_WABF);
        for (int idx = F.bid * NTHR + F.tid; idx < 4 * 4 * 32 * 64 * 8; idx += F.G * NTHR) {
            const int jx = idx & 7, ln = (idx >> 3) & 63, ks = (idx >> 9) & 31, nt = (idx >> 14) & 3, layer = idx >> 16;
            const int d = 32 * ks + 8 * (ln >> 4) + jx, e = 16 * nt + (ln & 15);
            const float wv = A.router_w[((size_t)layer * D_ + d) * NEXP + e];
            const unsigned hi = cvtpk(wv, 0.f) & 0xffffu; const float res = wv - bf_lo(hi);
            const size_t o = (size_t)layer * 2 * 65536 + (idx & 65535);
            WRF[o] = (bf16)hi; WRF[o + 65536] = (bf16)(cvtpk(res, 0.f) & 0xffffu);
        }
        for (int idx = F.bid * NTHR + F.tid; idx < 2 * 32 * 64 * 8; idx += F.G * NTHR) {
            const int jx = idx & 7, ln = (idx >> 3) & 63, ks = (idx >> 9) & 31, jl = idx >> 14;
            const int d = 32 * ks + 8 * (ln >> 4) + jx, e = ln & 15;
            const float wv = A.gdn_w_in[((size_t)jl * D_ + d) * 4112 + 4096 + e];
            const unsigned hi = cvtpk(wv, 0.f) & 0xffffu; const float res = wv - bf_lo(hi);
            const size_t o = (size_t)jl * 2 * 16384 + (idx & 16383);
            WABF[o] = (bf16)hi; WABF[o + 16384] = (bf16)(cvtpk(res, 0.f) & 0xffffu);
        }
    }
    if (F.bid == 0) { bf16* H = (bf16*)(ws + WS_H); for (int cidx = F.tid; cidx < D_; cidx += NTHR) H[(size_t)T_ * D_ + cidx] = 0; }
    for (int j = 0; j < 2; ++j) {
        convert_matrix(F, A.attn_w_in + (size_t)j * D_ * 9216, 9216, D_, 9216, (bf16*)(ws + WS_WA_IN) + (size_t)j * 9216 * D_, MapQKV{});
        convert_matrix(F, A.attn_w_out + (size_t)j * D_ * D_, D_, D_, D_, (bf16*)(ws + WS_WA_OUT) + (size_t)j * D_ * D_, MapId{0});
        convert_matrix(F, A.gdn_w_in + (size_t)j * D_ * 4112, 4112, D_, 4096, (bf16*)(ws + WS_WG_IN) + (size_t)j * 4096 * D_, MapId{0});
        convert_matrix(F, A.gdn_w_out + (size_t)j * D_ * D_, D_, D_, D_, (bf16*)(ws + WS_WG_OUT) + (size_t)j * D_ * D_, MapId{0});
    }
}
struct XItem { const float* src; bf16* dst; int ldn, K, mode, n0; };
DI XItem xi_decode(const Args& A, int layer, bf16* WE1, bf16* WE2, int it) {
    constexpr int I13 = (D_ / 64) * (256 / 32), I2 = (256 / 64) * (D_ / 32), IPE = 2 * I13 + I2;
    const int e = it / IPE; int r = it % IPE; XItem x;
    if (r < 2 * I13) { const int second = r >= I13 ? 1 : 0; r -= second * I13; const int kb = r >> 3, nb = r & 7;
        const float* w = second ? (e < 64 ? A.ew3 + ((size_t)layer * 64 + e) * D_ * 256 : A.sw3 + (size_t)layer * D_ * 256) : (e < 64 ? A.ew1 + ((size_t)layer * 64 + e) * D_ * 256 : A.sw1 + (size_t)layer * D_ * 256);
        x.src = w + (size_t)(64 * kb) * 256 + 32 * nb; x.ldn = 256; x.K = D_; x.mode = 1 + second; x.n0 = 32 * nb; x.dst = WE1 + (size_t)e * 512 * D_ + 64 * kb;
    } else { r -= 2 * I13; const int kb = r >> 5, nb = r & 31;
        const float* w = e < 64 ? A.ew2 + ((size_t)layer * 64 + e) * 256 * D_ : A.sw2 + (size_t)layer * 256 * D_;
        x.src = w + (size_t)(64 * kb) * D_ + 32 * nb; x.ldn = D_; x.K = 256; x.mode = 0; x.n0 = 32 * nb; x.dst = WE2 + (size_t)e * D_ * 256 + 64 * kb; }
    return x;
}
#define XI_LOAD(buf, XT) do { const char* _b = pg8::rfl_ptr((const char*)(XT).src); const unsigned _ro = (unsigned)((XT).ldn * 4); \
    _Pragma("unroll") for (int _i = 0; _i < 8; ++_i) buf[_i] = __builtin_nontemporal_load((const f32x4*)(_b + ((unsigned)(8 * _i + (lane >> 3)) * _ro + (unsigned)(lane & 7) * 16u))); } while (0)
#define XI_PUT(buf, XT) do { \
    _Pragma("unroll") for (int _i = 0; _i < 8; ++_i) _Pragma("unroll") for (int _e = 0; _e < 4; ++_e) scr[(8 * _i + (lane >> 3)) * 33 + 4 * (lane & 7) + _e] = buf[_i][_e]; \
    LDS_WAIT(); asm volatile("" ::: "memory"); \
    const int _c = lane & 7; \
    _Pragma("unroll") for (int _j = 0; _j < 4; ++_j) { const int _n = (XT).n0 + (lane >> 3) + 8 * _j; const LAS float* _s = scr + (8 * _c) * 33 + (lane >> 3) + 8 * _j; \
        const int _row = (XT).mode == 0 ? _n : (_n >> 7) * 256 + ((XT).mode - 1) * 128 + (_n & 127); \
        u32x4 _o; _o.x = cvtpk(_s[0 * 33], _s[1 * 33]); _o.y = cvtpk(_s[2 * 33], _s[3 * 33]); _o.z = cvtpk(_s[4 * 33], _s[5 * 33]); _o.w = cvtpk(_s[6 * 33], _s[7 * 33]); \
        __builtin_nontemporal_store(_o, (u32x4*)((XT).dst + (size_t)_row * (XT).K + 8 * _c)); } \
    LDS_WAIT(); asm volatile("" ::: "memory"); } while (0)
DI void convert_experts(const Frame& F, const Args& A, int layer, int set, int wg0, int nwg) {
    if (F.bid < wg0 || F.bid >= wg0 + nwg) return;
    unsigned char* ws = opq(A.ws);
    LAS float* scr = (LAS float*)(F.lds + F.wave * 16384);
    bf16* WE1 = (bf16*)(ws + (set ? WS_WEB : WS_WE1)); bf16* WE2 = (bf16*)(ws + (set ? WS_WEB + 65 * MiB : WS_WE2));
    const int gw = (F.bid - wg0) * NWAVES + F.wave, NGW = nwg * NWAVES, lane = F.lane;
    constexpr int NIT = 65 * 384;
    f32x4 ba[8], bb[8];
    int it = gw;
    if (it >= NIT) return;
    XItem xa = xi_decode(A, layer, WE1, WE2, it), xb = xa;
    XI_LOAD(ba, xa);
#pragma unroll 1
    for (;;) {
        const bool hb = it + NGW < NIT;
        if (hb) { xb = xi_decode(A, layer, WE1, WE2, it + NGW); XI_LOAD(bb, xb); }
        __builtin_amdgcn_sched_barrier(0);
        XI_PUT(ba, xa);
        if (!hb) break;
        it += NGW;
        const bool ha = it + NGW < NIT;
        if (ha) { xa = xi_decode(A, layer, WE1, WE2, it + NGW); XI_LOAD(ba, xa); }
        __builtin_amdgcn_sched_barrier(0);
        XI_PUT(bb, xb);
        if (!ha) break;
        it += NGW;
    }
}
#undef XI_LOAD
#undef XI_PUT

DI void load_row16(const float* p, int lane, f32x4 (&v)[4]) {
#pragma unroll
    for (int j = 0; j < 4; ++j) v[j] = *(const f32x4*)(p + 4 * lane + 256 * j);
}
DI void store_row16(float* p, int lane, const f32x4 (&v)[4]) {
#pragma unroll
    for (int j = 0; j < 4; ++j) *(f32x4*)(p + 4 * lane + 256 * j) = v[j];
}
DI void store_row16_bf16(bf16* p, int lane, const f32x4 (&v)[4]) {
#pragma unroll
    for (int j = 0; j < 4; ++j) { u32x2 w; w.x = cvtpk(v[j][0], v[j][1]); w.y = cvtpk(v[j][2], v[j][3]); *(u32x2*)(p + 4 * lane + 256 * j) = w; }
}
DI void add_row16_bf16(const bf16* p, int lane, f32x4 (&v)[4]) {
#pragma unroll
    for (int j = 0; j < 4; ++j) { const u32x2 w = *(const u32x2*)(p + 4 * lane + 256 * j); v[j][0] += bf_lo(w.x); v[j][1] += bf_hi(w.x); v[j][2] += bf_lo(w.y); v[j][3] += bf_hi(w.y); }
}
DI void add_row16_fp8(const unsigned char* p, int lane, f32x4 (&v)[4]) {
#pragma unroll
    for (int j = 0; j < 4; ++j) { const int w = *(const int*)(p + 4 * lane + 256 * j);
        const f32x2 a = __builtin_amdgcn_cvt_pk_f32_fp8(w, false), b = __builtin_amdgcn_cvt_pk_f32_fp8(w, true);
        v[j][0] += a[0]; v[j][1] += a[1]; v[j][2] += b[0]; v[j][3] += b[1]; }
}
DI void layer_norm16(f32x4 (&v)[4], const f32x4 (&g)[4], const f32x4 (&b)[4]) {
    float s = 0.f;
#pragma unroll
    for (int j = 0; j < 4; ++j) s += (v[j][0] + v[j][1]) + (v[j][2] + v[j][3]);
    const float mean = wave_sum(s) * (1.0f / D_);
    float q = 0.f;
#pragma unroll
    for (int j = 0; j < 4; ++j) { v[j] = v[j] - mean; q += (v[j][0] * v[j][0] + v[j][1] * v[j][1]) + (v[j][2] * v[j][2] + v[j][3] * v[j][3]); }
    const float rstd = 1.0f / sqrtf(wave_sum(q) * (1.0f / D_) + LN_EPS);
#pragma unroll
    for (int j = 0; j < 4; ++j) v[j] = v[j] * rstd * g[j] + b[j];
}

DI void modx_phase(const Frame& F, const Args& A) {
    unsigned char* ws = opq(A.ws);
    const float* MOD = (const float*)(ws + WS_MOD); bf16* H = (bf16*)(ws + WS_H);
    const int gw = F.bid * NWAVES + F.wave, NGW = F.G * NWAVES;
    for (int row = gw; row < T_; row += NGW) {
        const int b = row >> 12; f32x4 v[4], sc[4], sh[4];
        load_row16(A.x + (size_t)row * D_, F.lane, v); load_row16(MOD + (size_t)(0 * 4 + b) * 3072 + 1024, F.lane, sc); load_row16(MOD + (size_t)(0 * 4 + b) * 3072, F.lane, sh);
#pragma unroll
        for (int j = 0; j < 4; ++j) v[j] = v[j] * (1.0f + sc[j]) + sh[j];
        store_row16_bf16(H + (size_t)row * D_, F.lane, v);
    }
}

DI void build_tileoff(const Frame& F, const unsigned* gcount) {
    LAS int* tileoff = (LAS int*)(F.lds + LDS_TILEOFF);
    __syncthreads();
    if (F.wave == 0) {
        const unsigned cn = __hip_atomic_load(gcount + F.lane, __ATOMIC_RELAXED, __HIP_MEMORY_SCOPE_AGENT);
        const int nt = (int)((cn + 255u) >> 8); int inc = nt;
#pragma unroll
        for (int o = 1; o < 64; o <<= 1) { const int t = __builtin_amdgcn_ds_bpermute((F.lane - o) << 2, inc); if (F.lane >= o) inc += t; }
        tileoff[F.lane] = inc - nt; ((LAS int*)(F.lds + LDS_ECNT))[F.lane] = (int)cn;
        if (F.lane == 63) { tileoff[64] = inc; tileoff[65] = inc + T_ / 256; ((LAS int*)(F.lds + LDS_ECNT))[NEXP] = T_; }
    }
    __syncthreads();
}

DI void deepnorm_row(f32x4 (&v)[4], const f32x4 (&y)[4], const float* gate, const float* lng, const float* lnb, float* xout, const float* mod_shift, int lane) {
    f32x4 t[4];
    load_row16(gate, lane, t);
#pragma unroll
    for (int j = 0; j < 4; ++j) v[j] = ALPHA_DN * v[j] + (1.0f + t[j]) * y[j];
    float s = 0.f;
#pragma unroll
    for (int j = 0; j < 4; ++j) s += (v[j][0] + v[j][1]) + (v[j][2] + v[j][3]);
    const float mean = wave_sum(s) * (1.0f / D_);
    float q = 0.f;
#pragma unroll
    for (int j = 0; j < 4; ++j) { v[j] = v[j] - mean; q += (v[j][0] * v[j][0] + v[j][1] * v[j][1]) + (v[j][2] * v[j][2] + v[j][3] * v[j][3]); }
    const float rstd = 1.0f / sqrtf(wave_sum(q) * (1.0f / D_) + LN_EPS);
    load_row16(lng, lane, t);
#pragma unroll
    for (int j = 0; j < 4; ++j) v[j] = v[j] * rstd * t[j];
    load_row16(lnb, lane, t);
#pragma unroll
    for (int j = 0; j < 4; ++j) v[j] = v[j] + t[j];
    store_row16(xout, lane, v);
    if (mod_shift) {
        load_row16(mod_shift + 1024, lane, t);
#pragma unroll
        for (int j = 0; j < 4; ++j) v[j] = v[j] * (1.0f + t[j]);
        load_row16(mod_shift, lane, t);
#pragma unroll
        for (int j = 0; j < 4; ++j) v[j] = v[j] + t[j];
    }
}
DI void put_hilo(LAS unsigned char* lds, int p, int lane, const f32x4 (&v)[4]) {
#pragma unroll
    for (int j = 0; j < 4; ++j) {
        const int c = 4 * lane + 256 * j;
        const unsigned h0 = cvtpk(v[j][0], v[j][1]), h1 = cvtpk(v[j][2], v[j][3]);
        const unsigned l0 = cvtpk(v[j][0] - bf_lo(h0), v[j][1] - bf_hi(h0)), l1 = cvtpk(v[j][2] - bf_lo(h1), v[j][3] - bf_hi(h1));
        const int off = ((((p >> 4) * 32 + (c >> 5)) * 64 + ((c & 31) >> 3) * 16 + (p & 15)) * 16) + (c & 7) * 2;
        *(LAS u32x2*)(lds + off) = (u32x2){h0, h1}; *(LAS u32x2*)(lds + 65536 + off) = (u32x2){l0, l1};
    }
}
DI f32x4 small_proj(const LAS unsigned char* lds, int mt, int lane, const bf16* wf_hi, const bf16* wf_lo) {
    f32x4 a0 = (f32x4){0.f, 0.f, 0.f, 0.f}, a1 = a0, a2 = a0;
#pragma unroll 8
    for (int ks = 0; ks < 32; ++ks) {
        const bf16x8 ah = *(const LAS bf16x8*)(lds + ((mt * 32 + ks) * 64 + lane) * 16), al = *(const LAS bf16x8*)(lds + 65536 + ((mt * 32 + ks) * 64 + lane) * 16);
        const bf16x8 bh = *(const bf16x8*)(wf_hi + (ks * 64 + lane) * 8), bl = *(const bf16x8*)(wf_lo + (ks * 64 + lane) * 8);
        a0 = __builtin_amdgcn_mfma_f32_16x16x32_bf16(ah, bh, a0, 0, 0, 0); a1 = __builtin_amdgcn_mfma_f32_16x16x32_bf16(ah, bl, a1, 0, 0, 0); a2 = __builtin_amdgcn_mfma_f32_16x16x32_bf16(al, bh, a2, 0, 0, 0);
    }
    return a0 + (a1 + a2);
}
DI f32x4 small_proj_range(const LAS unsigned char* lds, int mt, int k0, int nk, int lane, const bf16* wf_hi, const bf16* wf_lo) {
    f32x4 a0 = (f32x4){0.f, 0.f, 0.f, 0.f}, a1 = a0, a2 = a0;
#pragma unroll 8
    for (int k = 0; k < nk; ++k) { const int ks = k0 + k;
        const bf16x8 ah = *(const LAS bf16x8*)(lds + ((mt * 32 + ks) * 64 + lane) * 16), al = *(const LAS bf16x8*)(lds + 65536 + ((mt * 32 + ks) * 64 + lane) * 16);
        const bf16x8 bh = *(const bf16x8*)(wf_hi + (ks * 64 + lane) * 8), bl = *(const bf16x8*)(wf_lo + (ks * 64 + lane) * 8);
        a0 = __builtin_amdgcn_mfma_f32_16x16x32_bf16(ah, bh, a0, 0, 0, 0); a1 = __builtin_amdgcn_mfma_f32_16x16x32_bf16(ah, bl, a1, 0, 0, 0); a2 = __builtin_amdgcn_mfma_f32_16x16x32_bf16(al, bh, a2, 0, 0, 0);
    }
    return a0 + (a1 + a2);
}
DI void small_proj2(const LAS unsigned char* lds, int kh, int lane, const bf16* wf_hi, const bf16* wf_lo, f32x4& o0, f32x4& o1) {
    f32x4 a[2][3];
#pragma unroll
    for (int mt = 0; mt < 2; ++mt)
#pragma unroll
        for (int e = 0; e < 3; ++e) a[mt][e] = (f32x4){0.f, 0.f, 0.f, 0.f};
#pragma unroll 8
    for (int k = 0; k < 16; ++k) {
        const int ks = 16 * kh + k;
        const bf16x8 bh = *(const bf16x8*)(wf_hi + (ks * 64 + lane) * 8), bl = *(const bf16x8*)(wf_lo + (ks * 64 + lane) * 8);
#pragma unroll
        for (int mt = 0; mt < 2; ++mt) {
            const bf16x8 ah = *(const LAS bf16x8*)(lds + ((mt * 32 + ks) * 64 + lane) * 16), al = *(const LAS bf16x8*)(lds + 65536 + ((mt * 32 + ks) * 64 + lane) * 16);
            a[mt][0] = __builtin_amdgcn_mfma_f32_16x16x32_bf16(ah, bh, a[mt][0], 0, 0, 0); a[mt][1] = __builtin_amdgcn_mfma_f32_16x16x32_bf16(ah, bl, a[mt][1], 0, 0, 0); a[mt][2] = __builtin_amdgcn_mfma_f32_16x16x32_bf16(al, bh, a[mt][2], 0, 0, 0);
        }
    }
    o0 = a[0][0] + (a[0][1] + a[0][2]); o1 = a[1][0] + (a[1][1] + a[1][2]);
}
DI void deepnorm_row_c(f32x4 (&v)[4], const f32x4 (&y)[4], const f32x4 (&cg)[4], const f32x4 (&cng)[4], const f32x4 (&cnb)[4]) {
#pragma unroll
    for (int j = 0; j < 4; ++j) v[j] = ALPHA_DN * v[j] + (1.0f + cg[j]) * y[j];
    float s = 0.f;
#pragma unroll
    for (int j = 0; j < 4; ++j) s += (v[j][0] + v[j][1]) + (v[j][2] + v[j][3]);
    const float mean = wave_sum(s) * (1.0f / D_);
    float q = 0.f;
#pragma unroll
    for (int j = 0; j < 4; ++j) { v[j] = v[j] - mean; q += (v[j][0] * v[j][0] + v[j][1] * v[j][1]) + (v[j][2] * v[j][2] + v[j][3] * v[j][3]); }
    const float rstd = 1.0f / sqrtf(wave_sum(q) * (1.0f / D_) + LN_EPS);
#pragma unroll
    for (int j = 0; j < 4; ++j) v[j] = v[j] * rstd * cng[j] + cnb[j];
}
template <bool L0> DI void ln_router_phase(const Frame& F, const Args& A, int layer, bool dry = false) {
    unsigned char* ws = opq(A.ws);
    const float* MOD = (const float*)(ws + WS_MOD); bf16* X = (bf16*)(ws + WS_X); const float* Y = (const float*)(ws + WS_Y); bf16* H = (bf16*)(ws + WS_H);
    int* asg_e = (int*)(ws + WS_ASG_E); int* asg_r = (int*)(ws + WS_ASG_R); int* etok = (int*)(ws + WS_ETOK); float* egate = (float*)(ws + WS_EW);
    unsigned* gcount = (unsigned*)(ws + WS_CTL) + CW_CNT + layer * 64;
    const int ls0 = layer * 2, ls1 = layer * 2 + 1;
    const bf16* wrf = (const bf16*)(ws + WS_WRF) + (size_t)layer * 2 * 65536 + (size_t)(F.wave & 3) * 32 * 512;
    const float rb = A.router_bias[layer * NEXP + F.lane];
    LAS float* lg = (LAS float*)(F.lds + LDS_LG);
    LAS int* lcnt = (LAS int*)(F.lds + LDS_LCNT); LAS int* lbase = (LAS int*)(F.lds + LDS_LBASE); LAS int* lasg = (LAS int*)(F.lds + LDS_LASG);
    const unsigned l8_ = (unsigned)F.lane * 8u, l16_ = (unsigned)F.lane * 16u;
    u32x2 yb[4][4], xb[L0 ? 1 : 4][4]; f32x4 xf[L0 ? 4 : 1][4];
#define LNR_LOAD(rb_) do { unsigned l8 = l8_, l16 = l16_; asm volatile("" : "+v"(l8), "+v"(l16)); \
        _Pragma("unroll") for (int t = 0; t < 4; ++t) { const int row = (rb_) + t; const char* py = pg8::rfl_ptr((const char*)Y + (size_t)row * (D_ * 2)); \
            if constexpr (L0) { const char* px = pg8::rfl_ptr((const char*)A.x + (size_t)row * (D_ * 4)); _Pragma("unroll") for (int j = 0; j < 4; ++j) xf[t][j] = __builtin_nontemporal_load((const f32x4*)(px + l16 + 1024 * j)); } \
            else { const char* px = pg8::rfl_ptr((const char*)X + (size_t)row * (D_ * 2)); _Pragma("unroll") for (int j = 0; j < 4; ++j) xb[t][j] = __builtin_nontemporal_load((const u32x2*)(px + l8 + 512 * j)); } \
            _Pragma("unroll") for (int j = 0; j < 4; ++j) yb[t][j] = __builtin_nontemporal_load((const u32x2*)(py + l8 + 512 * j)); } } while (0)
    for (int blk = F.bid; blk < T_ / 64; blk += F.G) {
        const int b = blk >> 6;
        const char* gate = pg8::rfl_ptr((const char*)(MOD + (size_t)(ls0 * 4 + b) * 3072 + 2048)); const char* modn = pg8::rfl_ptr((const char*)(MOD + (size_t)(ls1 * 4 + b) * 3072));
        const char* lng = pg8::rfl_ptr((const char*)(A.ln_g + (size_t)ls0 * D_)); const char* lnb = pg8::rfl_ptr((const char*)(A.ln_b + (size_t)ls0 * D_));
        f32x4 cg[4], cng[4], cnb[4], csc[4], csh[4];
#pragma unroll
        for (int j = 0; j < 4; ++j) { cg[j] = *(const f32x4*)(gate + l16_ + 1024 * j); cng[j] = *(const f32x4*)(lng + l16_ + 1024 * j); cnb[j] = *(const f32x4*)(lnb + l16_ + 1024 * j);
            csc[j] = *(const f32x4*)(modn + 4096 + l16_ + 1024 * j); csh[j] = *(const f32x4*)(modn + l16_ + 1024 * j); }
        if constexpr (!L0) { LNR_LOAD(blk * 64 + F.wave * 4); }
        __builtin_amdgcn_sched_barrier(0);
#pragma unroll 1
        for (int ps = 0; ps < 2; ++ps) {
            const int rbase = blk * 64 + ps * 32 + F.wave * 4;
            if constexpr (L0) { LNR_LOAD(rbase); }
            { unsigned l8 = l8_; asm volatile("" : "+v"(l8));
#pragma unroll
              for (int t = 0; t < 4; ++t) { const int row = rbase + t; f32x4 v[4], y[4];
#pragma unroll
                for (int j = 0; j < 4; ++j) { y[j] = (f32x4){bf_lo(yb[t][j].x), bf_hi(yb[t][j].x), bf_lo(yb[t][j].y), bf_hi(yb[t][j].y)};
                    if constexpr (L0) v[j] = xf[t][j]; else v[j] = (f32x4){bf_lo(xb[t][j].x), bf_hi(xb[t][j].x), bf_lo(xb[t][j].y), bf_hi(xb[t][j].y)}; }
                deepnorm_row_c(v, y, cg, cng, cnb);
                char* xp = (char*)pg8::rfl_ptr((const char*)(dry ? (const bf16*)(ws + WS_Y + 32 * MiB) : X) + (size_t)row * (D_ * 2));
                char* hp = (char*)pg8::rfl_ptr((const char*)H + (size_t)row * (D_ * 2));
#pragma unroll
                for (int j = 0; j < 4; ++j) { { u32x2 o; o.x = cvtpk(v[j][0], v[j][1]); o.y = cvtpk(v[j][2], v[j][3]); __builtin_nontemporal_store(o, (u32x2*)(xp + l8 + 512 * j)); }
                    v[j] = v[j] * (1.0f + csc[j]) + csh[j]; u32x2 o; o.x = cvtpk(v[j][0], v[j][1]); o.y = cvtpk(v[j][2], v[j][3]); *(u32x2*)(hp + l8 + 512 * j) = o; }
                put_hilo(F.lds, F.wave * 4 + t, F.lane, v); } }
            if constexpr (!L0) { if (ps == 0) { LNR_LOAD(blk * 64 + 32 + F.wave * 4); } }
            __syncthreads();
            { const int nt = F.wave & 3, kh = F.wave >> 2, r = F.lane & 15, q = F.lane >> 4;
              f32x4 acc0, acc1; small_proj2(F.lds, kh, F.lane, wrf, wrf + 65536, acc0, acc1);
              if (kh == 0) {
#pragma unroll
                  for (int reg = 0; reg < 4; ++reg) { lg[(4 * q + reg) * 64 + 16 * nt + r] = acc0[reg]; lg[(16 + 4 * q + reg) * 64 + 16 * nt + r] = acc1[reg]; } }
              __syncthreads();
              if (kh == 1) {
#pragma unroll
                  for (int reg = 0; reg < 4; ++reg) { lg[(4 * q + reg) * 64 + 16 * nt + r] += acc0[reg]; lg[(16 + 4 * q + reg) * 64 + 16 * nt + r] += acc1[reg]; } } }
            __syncthreads();
#pragma unroll 2
            for (int rr = 0; rr < 4; ++rr) {
                const int row = rbase + rr, rl = ps * 32 + F.wave * 4 + rr;
                int ln = F.lane; asm volatile("" : "+v"(ln));
                const float logit = lg[(F.wave * 4 + rr) * 64 + F.lane];
                const float s = 1.0f / (1.0f + __expf(-logit)); const float bi = s + rb;
                float m1 = bi; m1 = fmaxf(m1, dppmov<0xB1>(m1)); m1 = fmaxf(m1, dppmov<0x4E>(m1)); m1 = fmaxf(m1, dppmov<0x141>(m1));
                const unsigned long long eq = __ballot(bi == m1);
                const int first = __ffs((int)((eq >> (ln & ~7)) & 0xffull)) - 1;
                float m2 = ((ln & 7) == first) ? -INFINITY : bi; m2 = fmaxf(m2, dppmov<0xB1>(m2)); m2 = fmaxf(m2, dppmov<0x4E>(m2)); m2 = fmaxf(m2, dppmov<0x141>(m2));
                const float gs = m1 + m2; int grank = 0;
#pragma unroll
                for (int j = 0; j < 8; ++j) { const float gj = rdlane(gs, 8 * j); grank += ((gj > gs) || (gj == gs && j < (ln >> 3))) ? 1 : 0; }
                const bool gsel = grank < 4;
                float mv = gsel ? bi : -INFINITY; int cnt = -1;
#pragma unroll
                for (int it = 0; it < TOPK; ++it) { const float mx = wave_max(mv); const unsigned long long em = __ballot(mv == mx); const int fl = __ffsll((long long)em) - 1;
                    if (ln == fl) { cnt = it; mv = -INFINITY; } }
                const bool sel = cnt >= 0;
                const float gsum = wave_sum(sel ? s : 0.f);
                if (sel) { const int lr = __hip_atomic_fetch_add(&lcnt[F.lane], 1, __ATOMIC_RELAXED, __HIP_MEMORY_SCOPE_WORKGROUP); lasg[rl * 8 + cnt] = (F.lane << 16) | lr;
                    asg_e[(size_t)row * 8 + cnt] = F.lane; ((LAS float*)(F.lds + LDS_LW))[rl * 8 + cnt] = s / gsum * 2.5f; }
            }
        }
        __syncthreads();
        if (F.tid < NEXP) { const int cn = lcnt[F.tid]; lbase[F.tid] = (cn && !dry) ? (int)atomicAdd(&gcount[F.tid], (unsigned)cn) : 0; lcnt[F.tid] = 0; }
        __syncthreads();
        { const int v = lasg[F.tid], e = v >> 16, rank = lbase[e] + (v & 0xffff); asg_r[(size_t)blk * 512 + F.tid] = rank;
          etok[(size_t)e * ECAP + rank] = blk * 64 + (F.tid >> 3); egate[(size_t)e * ECAP + rank] = ((const LAS float*)(F.lds + LDS_LW))[F.tid];
          if (F.tid < 64) { etok[(size_t)NEXP * ECAP + blk * 64 + F.tid] = blk * 64 + F.tid; egate[(size_t)NEXP * ECAP + blk * 64 + F.tid] = 1.0f; } }
        __syncthreads();
    }
#undef LNR_LOAD
}

DI void moe_scatter_phase(const Frame& F, const Args& A, int layer) {
    unsigned char* ws = opq(A.ws);
    const int* asg_e = (const int*)(ws + WS_ASG_E); const int* asg_r = (const int*)(ws + WS_ASG_R); const float* asg_w = (const float*)(ws + WS_ASG_W); int* asg_row = (int*)(ws + WS_ASG_ROW);
    int* rowtok = (int*)(ws + WS_ROWTOK); float* roww = (float*)(ws + WS_ROWW);
    const unsigned* gcount = (const unsigned*)(ws + WS_CTL) + CW_CNT + layer * 64;
    build_tileoff(F, gcount);
    const LAS int* tileoff = (const LAS int*)(F.lds + LDS_TILEOFF);
    for (int idx = F.bid * NTHR + F.tid; idx < T_ * TOPK; idx += F.G * NTHR) {
        const int e = asg_e[idx], row = 256 * tileoff[e] + asg_r[idx];
        rowtok[row] = idx >> 3; roww[row] = asg_w[idx]; asg_row[idx] = row;
    }
    for (int e = F.bid; e < NEXP; e += F.G) {
        const int cnt = (int)__hip_atomic_load(gcount + e, __ATOMIC_RELAXED, __HIP_MEMORY_SCOPE_AGENT), end = 256 * tileoff[e + 1];
        for (int row = 256 * tileoff[e] + cnt + F.tid; row < end; row += NTHR) { rowtok[row] = T_; roww[row] = 0.f; }
    }
    const int s0 = 256 * tileoff[64];
    for (int t = F.bid * NTHR + F.tid; t < T_; t += F.G * NTHR) { rowtok[s0 + t] = t; roww[s0 + t] = 1.0f; }
}

DI void ln_moe_phase(const Frame& F, const Args& A, int layer, float* dry_out) {
    unsigned char* ws = opq(A.ws);
    const float* MOD = (const float*)(ws + WS_MOD); const char* YE = (const char*)(ws + WS_BIG);
    float* AB = (float*)(ws + WS_AB);
    int s0 = 0;
    { const unsigned* gcount = (const unsigned*)(ws + WS_CTL) + CW_CNT + layer * 64; build_tileoff(F, gcount); s0 = 256 * ((const LAS int*)(F.lds + LDS_TILEOFF))[64]; }
    const int* asg_e = (const int*)(ws + WS_ASG_E); const int* asg_r = (const int*)(ws + WS_ASG_R);
    const int ls0 = layer * 2 + 1, ls1 = layer * 2 + 2; const bool last = layer == 3, want_ab = (layer & 1) == 0;
    const bf16* wabf = (const bf16*)(ws + WS_WABF) + (size_t)(layer >> 1) * 2 * 16384;
    const unsigned l4_ = (unsigned)F.lane * 4u, l8_ = (unsigned)F.lane * 8u, l16_ = (unsigned)F.lane * 16u;
    for (int blk = F.bid; blk < T_ / 64; blk += F.G) {
        const int b = blk >> 6;
        const char* gate = pg8::rfl_ptr((const char*)(MOD + (size_t)(ls0 * 4 + b) * 3072 + 2048)); const char* modn = pg8::rfl_ptr((const char*)(MOD + (size_t)((last ? ls0 : ls1) * 4 + b) * 3072));
        const char* lng = pg8::rfl_ptr((const char*)(A.ln_g + (size_t)ls0 * D_)); const char* lnb = pg8::rfl_ptr((const char*)(A.ln_b + (size_t)ls0 * D_));
        f32x4 cg[4], cng[4], cnb[4], csc[4], csh[4];
#pragma unroll
        for (int j = 0; j < 4; ++j) { cg[j] = *(const f32x4*)(gate + l16_ + 1024 * j); cng[j] = *(const f32x4*)(lng + l16_ + 1024 * j); cnb[j] = *(const f32x4*)(lnb + l16_ + 1024 * j);
            csc[j] = *(const f32x4*)(modn + 4096 + l16_ + 1024 * j); csh[j] = *(const f32x4*)(modn + l16_ + 1024 * j); }
#pragma unroll 1
        for (int ps = 0; ps < 2; ++ps) {
            const int rbase = blk * 64 + ps * 32 + F.wave * 4;
            const int ev = *(const int*)(pg8::rfl_ptr((const char*)(asg_e + (size_t)rbase * 8)) + (l4_ & 127u)), rv = *(const int*)(pg8::rfl_ptr((const char*)(asg_r + (size_t)rbase * 8)) + (l4_ & 127u));
            const int idxv = 256 * ((const LAS int*)(F.lds + LDS_TILEOFF))[ev] + rv;
#pragma unroll 1
            for (int rr = 0; rr < 4; ++rr) {
                const int row = rbase + rr; f32x4 v[4], y[4]; int w[9][4]; u32x2 sh[4];
                unsigned l4 = l4_, l8 = l8_, l16 = l16_; asm volatile("" : "+v"(l4), "+v"(l8), "+v"(l16));
#pragma unroll
                for (int k = 0; k < TOPK; ++k) { const int src = __builtin_amdgcn_readlane(idxv, rr * 8 + k); const char* p = pg8::rfl_ptr(YE + (size_t)src * D_);
#pragma unroll
                    for (int j = 0; j < 4; ++j) w[k][j] = __builtin_nontemporal_load((const int*)(p + l4 + 256 * j)); }
                if (YS_BF16) { const char* p = pg8::rfl_ptr(YE + WS_YS_OFF + (size_t)row * (D_ * 2));
#pragma unroll
                    for (int j = 0; j < 4; ++j) sh[j] = __builtin_nontemporal_load((const u32x2*)(p + l8 + 512 * j));
                } else { const char* p = pg8::rfl_ptr(YE + (size_t)(s0 + row) * D_);
#pragma unroll
                    for (int j = 0; j < 4; ++j) w[8][j] = *(const int*)(p + l4 + 256 * j);
                }
                u32x2 xb[4];
                { const char* p = pg8::rfl_ptr((const char*)(ws + WS_X) + (size_t)row * (D_ * 2));
#pragma unroll
                  for (int j = 0; j < 4; ++j) xb[j] = __builtin_nontemporal_load((const u32x2*)(p + l8 + 512 * j)); }
                __builtin_amdgcn_sched_barrier(0);
#pragma unroll
                for (int j = 0; j < 4; ++j) { y[j] = (f32x4){0.f, 0.f, 0.f, 0.f}; v[j] = (f32x4){bf_lo(xb[j].x), bf_hi(xb[j].x), bf_lo(xb[j].y), bf_hi(xb[j].y)}; }
#pragma unroll
                for (int k = 0; k < (YS_BF16 ? TOPK : TOPK + 1); ++k) {
                    asm volatile("" : "+v"(w[k][0]), "+v"(w[k][1]), "+v"(w[k][2]), "+v"(w[k][3]), "+v"(y[0]), "+v"(y[1]), "+v"(y[2]), "+v"(y[3]));
#pragma unroll
                    for (int j = 0; j < 4; ++j) { const f32x2 a = __builtin_amdgcn_cvt_pk_f32_fp8(w[k][j], false), c = __builtin_amdgcn_cvt_pk_f32_fp8(w[k][j], true);
                        y[j][0] += a[0]; y[j][1] += a[1]; y[j][2] += c[0]; y[j][3] += c[1]; }
                    __builtin_amdgcn_sched_barrier(0);
                }
#pragma unroll
                for (int j = 0; j < 4; ++j) y[j] = y[j] * (1.0f / YE_SCALE);
                if (YS_BF16) {
#pragma unroll
                    for (int j = 0; j < 4; ++j) { y[j][0] += bf_lo(sh[j].x); y[j][1] += bf_hi(sh[j].x); y[j][2] += bf_lo(sh[j].y); y[j][3] += bf_hi(sh[j].y); }
                }
                deepnorm_row_c(v, y, cg, cng, cnb);
                if (last || dry_out) { char* op = (char*)pg8::rfl_ptr((const char*)(dry_out ? dry_out : A.out) + (size_t)row * (D_ * 4));
#pragma unroll
                    for (int j = 0; j < 4; ++j) __builtin_nontemporal_store(v[j], (f32x4*)(op + l16 + 1024 * j));
                } else { char* xp = (char*)pg8::rfl_ptr((const char*)(ws + WS_X) + (size_t)row * (D_ * 2));
#pragma unroll
                    for (int j = 0; j < 4; ++j) { u32x2 o; o.x = cvtpk(v[j][0], v[j][1]); o.y = cvtpk(v[j][2], v[j][3]); __builtin_nontemporal_store(o, (u32x2*)(xp + l8 + 512 * j)); } }
                if (!last) { char* hp = (char*)pg8::rfl_ptr((const char*)(ws + WS_H) + (size_t)row * (D_ * 2));
#pragma unroll
                    for (int j = 0; j < 4; ++j) { v[j] = v[j] * (1.0f + csc[j]) + csh[j]; u32x2 o; o.x = cvtpk(v[j][0], v[j][1]); o.y = cvtpk(v[j][2], v[j][3]); *(u32x2*)(hp + l8 + 512 * j) = o; }
                    if (want_ab) put_hilo(F.lds, F.wave * 4 + rr, F.lane, v);
                }
            }
            if (!last && want_ab) {
                __syncthreads();
                { const int mt = F.wave & 1, kq = F.wave >> 1;
                  const f32x4 part = small_proj_range(F.lds, mt, 8 * kq, 8, F.lane, wabf, wabf + 16384);
                  *(LAS f32x4*)(F.lds + LDS_LG + ((kq * 2 + mt) * 64 + F.lane) * 16) = part; }
                __syncthreads();
                if (F.wave < 2) { const int mt = F.wave, r = F.lane & 15, q = F.lane >> 4;
                    const LAS f32x4* pp = (const LAS f32x4*)(F.lds + LDS_LG) + mt * 64 + F.lane;
                    const f32x4 acc = ((pp[0] + pp[128]) + pp[256]) + pp[384];
#pragma unroll
                    for (int reg = 0; reg < 4; ++reg) AB[(size_t)(blk * 64 + ps * 32 + 16 * mt + 4 * q + reg) * 16 + r] = acc[reg]; }
            }
        }
    }
}
DI int crow(int r, int h) { return (r & 3) + 8 * (r >> 2) + 4 * h; }
typedef short v4i16_t __attribute__((ext_vector_type(4)));
DI s16x4 vtr(const LAS unsigned char* p) { return __builtin_bit_cast(s16x4, __builtin_amdgcn_ds_read_tr16_b64_v4i16((LAS v4i16_t*)p)); }
#define MFMA32(a, b, c) __builtin_amdgcn_mfma_f32_32x32x16_bf16((a), (b), (c), 0, 0, 0)
constexpr int ATT_ORUN = 0, ATT_LRUN = 65536, ATT_VBUF = 65536 + 2048, ATT_VSTRIDE = 144, ATT_VBYTES = 32 * ATT_VSTRIDE;

#ifndef REP_A1
#define REP_A1 1
#define REP_A2 1
#endif
DI void attn_phase(const Frame& F, const Args& A) {
    unsigned char* ws = opq(A.ws);
    const bf16* QKV = (const bf16*)(ws + WS_BIG); bf16* O = (bf16*)(ws + WS_O);
    LAS unsigned char* orun = F.lds + ATT_ORUN;
    LAS float* lrun = (LAS float*)(F.lds + ATT_LRUN);
    LAS unsigned char* vbuf = F.lds + ATT_VBUF + F.wave * ATT_VBYTES;
    const int lane = F.lane, qi = lane & 31, h = lane >> 5;
    const int g16 = lane >> 4, q4 = (lane & 15) >> 2, p4 = lane & 3;
    for (int it = F.bid; it < NB_ * 16 * 8; it += F.G) {
        int item = it;
        if (F.G == 256) { const int w = it & 255, xcd = w & 7, j = w >> 3; item = (((it >> 8) * 32 + xcd * 4 + (j >> 3)) << 3) | (j & 7); }
        const int b = item >> 7, head = (item >> 3) & 15, ck = item & 7;
        for (int gi = 0; gi < 3; ++gi) {
            const int g = 2 - gi, ldil = 2 * g, Lg = S_ >> ldil;
            const size_t hb = (((size_t)g * NB_ + b) * 16 + head) * S_ * 64;
            const bf16* Qg = QKV + hb; const bf16* Kg = QKV + (size_t)3 * NB_ * 16 * S_ * 64 + hb; const bf16* Vg = QKV + (size_t)6 * NB_ * 16 * S_ * 64 + hb;
            for (int sub = F.wave; sub < 16; sub += NWAVES) {
                int r_, tile;
                if (g == 0) { r_ = 0; tile = sub; } else if (g == 1) { r_ = sub >> 2; tile = sub & 3; } else { r_ = sub; tile = 0; }
                const int m0 = ((512 * ck) >> ldil) + 32 * tile;
                const bf16* Kr = Kg + (size_t)r_ * Lg * 64; const bf16* Vr = Vg + (size_t)r_ * Lg * 64;
                f32x16 st[5]; u32x4 vv[5][4]; float mx, lsum;
#pragma unroll 1
                for (int rep1 = 0; rep1 < REP_A1; ++rep1) {
                unsigned lc = (unsigned)((lane >> 3) * 128 + (lane & 7) * 16); asm volatile("" : "+v"(lc));
                const int wofs = (lane >> 3) * ATT_VSTRIDE + (lane & 7) * 16, rofs = qi * ATT_VSTRIDE + 64 * h;
                u32x4 qv[4], kv[5][4];
                { const char* qp = pg8::rfl_ptr((const char*)(Qg + ((size_t)r_ * Lg + m0) * 64));
#pragma unroll
                  for (int i = 0; i < 4; ++i) qv[i] = __builtin_nontemporal_load((const u32x4*)(qp + lc + 1024 * i)); }
#pragma unroll
                for (int kt = 0; kt < 5; ++kt) { const int mk0 = m0 - 128 + 32 * kt; const char* kp = pg8::rfl_ptr((const char*)(Kr + (size_t)(mk0 < 0 ? 0 : mk0) * 64));
#pragma unroll
                    for (int i = 0; i < 4; ++i) kv[kt][i] = *(const u32x4*)(kp + lc + 1024 * i); }
                __builtin_amdgcn_sched_barrier(0);
                bf16x8 qf[4];
#pragma unroll
                for (int i = 0; i < 4; ++i) *(LAS u32x4*)(vbuf + wofs + 8 * i * ATT_VSTRIDE) = qv[i];
                LDS_WAIT(); asm volatile("" ::: "memory");
#pragma unroll
                for (int s = 0; s < 4; ++s) qf[s] = *(const LAS bf16x8*)(vbuf + rofs + 16 * s);
                LDS_WAIT(); asm volatile("" ::: "memory");
#pragma unroll
                for (int kt = 0; kt < 5; ++kt) {
                    const int mk0 = m0 - 128 + 32 * kt;
                    bf16x8 kf[4];
#pragma unroll
                    for (int i = 0; i < 4; ++i) *(LAS u32x4*)(vbuf + wofs + 8 * i * ATT_VSTRIDE) = kv[kt][i];
                    LDS_WAIT(); asm volatile("" ::: "memory");
#pragma unroll
                    for (int s = 0; s < 4; ++s) kf[s] = *(const LAS bf16x8*)(vbuf + rofs + 16 * s);
                    { const char* vp = pg8::rfl_ptr((const char*)(Vr + (size_t)(mk0 < 0 ? 0 : mk0) * 64));
#pragma unroll
                      for (int i = 0; i < 4; ++i) vv[kt][i] = *(const u32x4*)(vp + lc + 1024 * i); }
                    LDS_WAIT(); asm volatile("" ::: "memory");
#pragma unroll
                    for (int r = 0; r < 16; ++r) st[kt][r] = 0.f;
#pragma unroll
                    for (int s = 0; s < 4; ++s) st[kt] = MFMA32(kf[s], qf[s], st[kt]);
                    if (mk0 < 0) {
#pragma unroll
                        for (int r = 0; r < 16; ++r) st[kt][r] = -INFINITY;
                    }
                }
#pragma unroll
                for (int r = 0; r < 16; ++r) { const int kr = crow(r, h); if (kr < qi) st[0][r] = -INFINITY; if (kr > qi) st[4][r] = -INFINITY; }
                mx = -INFINITY;
#pragma unroll
                for (int kt = 0; kt < 5; ++kt)
#pragma unroll
                    for (int r = 0; r < 16; ++r) mx = fmaxf(mx, st[kt][r]);
                mx = fmaxf(mx, bperm(mx, F.lane ^ 32));
                lsum = 0.f;
#pragma unroll
                for (int kt = 0; kt < 5; ++kt)
#pragma unroll
                    for (int r = 0; r < 16; ++r) { const float p = __builtin_amdgcn_exp2f(st[kt][r] - mx); st[kt][r] = p; lsum += p; }
                lsum += bperm(lsum, F.lane ^ 32);
                }
                f32x16 oacc[2];
#pragma unroll 1
                for (int rep2 = 0; rep2 < REP_A2; ++rep2) {
#pragma unroll
                for (int r = 0; r < 16; ++r) { oacc[0][r] = 0.f; oacc[1][r] = 0.f; }
#pragma unroll
                for (int kt = 0; kt < 5; ++kt) {
                    const int mk0 = m0 - 128 + 32 * kt;
                    if (mk0 >= 0) {
#pragma unroll
                        for (int i = 0; i < 4; ++i) *(LAS u32x4*)(vbuf + ((lane >> 3) + 8 * i) * ATT_VSTRIDE + (lane & 7) * 16) = vv[kt][i];
                        LDS_WAIT(); asm volatile("" ::: "memory");
                        s16x4 flo[2][2], fhi[2][2];
#pragma unroll
                        for (int sp = 0; sp < 2; ++sp)
#pragma unroll
                            for (int dvt = 0; dvt < 2; ++dvt) {
                                const int colb = (32 * dvt + 16 * (g16 & 1) + 4 * p4) * 2;
                                flo[sp][dvt] = vtr(vbuf + (16 * sp + 4 * h + q4) * ATT_VSTRIDE + colb);
                                fhi[sp][dvt] = vtr(vbuf + (16 * sp + 8 + 4 * h + q4) * ATT_VSTRIDE + colb);
                            }
                        LDS_WAIT(); asm volatile("" ::: "memory");
#pragma unroll
                        for (int sp = 0; sp < 2; ++sp) {
                            bf16x8 pf; {
                                const unsigned w0 = cvtpk(st[kt][8 * sp + 0], st[kt][8 * sp + 1]), w1 = cvtpk(st[kt][8 * sp + 2], st[kt][8 * sp + 3]);
                                const unsigned w2 = cvtpk(st[kt][8 * sp + 4], st[kt][8 * sp + 5]), w3 = cvtpk(st[kt][8 * sp + 6], st[kt][8 * sp + 7]);
                                pf = __builtin_bit_cast(bf16x8, (u32x4){w0, w1, w2, w3}); }
#pragma unroll
                            for (int dvt = 0; dvt < 2; ++dvt) {
                                const bf16x8 vf = __builtin_shufflevector(flo[sp][dvt], fhi[sp][dvt], 0, 1, 2, 3, 4, 5, 6, 7);
                                oacc[dvt] = MFMA32(vf, pf, oacc[dvt]);
                            }
                        }
                    }
                }
                asm volatile("" : "+v"(oacc[0]), "+v"(oacc[1]));
                }
                const float inv = __builtin_amdgcn_rcpf(lsum), lse = mx + __builtin_amdgcn_logf(lsum);
                const int tl = ((32 * tile + qi) << ldil) + r_;
                float wa = 0.f, wb = 1.f;
                if (gi > 0) { const float L0 = lrun[tl]; const float M = fmaxf(L0, lse); const float ea = __builtin_amdgcn_exp2f(L0 - M), eb = __builtin_amdgcn_exp2f(lse - M);
                    const float isum = __builtin_amdgcn_rcpf(ea + eb); wa = ea * isum; wb = eb * isum; asm volatile("" ::: "memory");
                    if (h == 0) lrun[tl] = M + __builtin_amdgcn_logf(ea + eb); }
                else if (h == 0) lrun[tl] = lse;
                wb *= inv;
#pragma unroll
                for (int dvt = 0; dvt < 2; ++dvt)
#pragma unroll
                    for (int k4 = 0; k4 < 4; ++k4) {
                        const int dv = 32 * dvt + 8 * k4 + 4 * h;
                        float o0 = oacc[dvt][4 * k4 + 0] * wb, o1 = oacc[dvt][4 * k4 + 1] * wb, o2 = oacc[dvt][4 * k4 + 2] * wb, o3 = oacc[dvt][4 * k4 + 3] * wb;
                        LAS u32x2* op = (LAS u32x2*)(orun + tl * 128 + dv * 2);
                        if (gi > 0) { const u32x2 w = *op; o0 += wa * bf_lo(w.x); o1 += wa * bf_hi(w.x); o2 += wa * bf_lo(w.y); o3 += wa * bf_hi(w.y); }
                        u32x2 wo; wo.x = cvtpk(o0, o1); wo.y = cvtpk(o2, o3);
                        if (gi < 2) *op = wo;
                        else *(u32x2*)(O + ((size_t)b * S_ + 512 * ck + tl) * D_ + head * 64 + dv) = wo;
                    }
            }
            __syncthreads();
        }
    }
}

DI void gdn_post_phase(const Frame& F, const Args& A, int j) {
    unsigned char* ws = opq(A.ws); unsigned char* big = ws + WS_BIG;
    const bf16* Oraw = (const bf16*)(ws + WS_Y); const bf16* PROJ = (const bf16*)(big + BIG_PROJ); bf16* O = (bf16*)(ws + WS_O);
    const float* nw = A.gdn_norm_w + (size_t)j * 128;
    const int gw = F.bid * NWAVES + F.wave, NGW = F.G * NWAVES, lane = F.lane;
    const f32x4 nwv = *(const f32x4*)(nw + ((4 * lane) & 127));
    const unsigned l8_ = (unsigned)lane * 8u;
#pragma unroll 2
    for (int row = gw; row < T_; row += NGW) {
        unsigned l8 = l8_; asm volatile("" : "+v"(l8));
        const char* op = pg8::rfl_ptr((const char*)(Oraw + (size_t)row * D_)); const char* zp = pg8::rfl_ptr((const char*)(PROJ + (size_t)row * 4096 + 3072));
        u32x2 ow[4], zw[4];
#pragma unroll
        for (int jj = 0; jj < 4; ++jj) { ow[jj] = __builtin_nontemporal_load((const u32x2*)(op + l8 + 512 * jj)); zw[jj] = __builtin_nontemporal_load((const u32x2*)(zp + l8 + 512 * jj)); }
        f32x4 v[4];
#pragma unroll
        for (int jj = 0; jj < 4; ++jj) {
            v[jj] = (f32x4){bf_lo(ow[jj].x), bf_hi(ow[jj].x), bf_lo(ow[jj].y), bf_hi(ow[jj].y)};
            float ss = (v[jj][0] * v[jj][0] + v[jj][1] * v[jj][1]) + (v[jj][2] * v[jj][2] + v[jj][3] * v[jj][3]);
            ss += dppmov<0xB1>(ss); ss += dppmov<0x4E>(ss); ss += dppmov<0x141>(ss); ss += dppmov<0x140>(ss); ss += shx<16>(ss);
            const float rs = rsqrtf(ss * (1.0f / 128.0f) + RMS_EPS);
            const float z0 = bf_lo(zw[jj].x), z1 = bf_hi(zw[jj].x), z2 = bf_lo(zw[jj].y), z3 = bf_hi(zw[jj].y);
            v[jj][0] = v[jj][0] * rs * nwv[0] * silu_f(z0); v[jj][1] = v[jj][1] * rs * nwv[1] * silu_f(z1);
            v[jj][2] = v[jj][2] * rs * nwv[2] * silu_f(z2); v[jj][3] = v[jj][3] * rs * nwv[3] * silu_f(z3);
        }
        store_row16_bf16(O + (size_t)row * D_, lane, v);
    }
}
constexpr size_t GB_KR = 128 * MiB, GB_QR = 160 * MiB, GB_KT = 192 * MiB, GB_VT = 224 * MiB, GB_BLOB = 256 * MiB;
constexpr int BLOB_ELEMS = 28672, BLOB_W = 0, BLOB_QG = 8192, BLOB_QK = 16384, BLOB_KDT = 20480;
DI int frag_pos(int row, int k, int nks) { const int kk = k & 31; return ((((row >> 4) * nks + (k >> 5)) * 64 + ((kk >> 2) & 3) * 16 + (row & 15)) * 8) + 4 * (kk >> 4) + (kk & 3); }
#define MFMA16(a, b, c) __builtin_amdgcn_mfma_f32_16x16x32_bf16((a), (b), (c), 0, 0, 0)
DI u32x2 pk4(float a, float b, float c, float d) { u32x2 w; w.x = cvtpk(a, b); w.y = cvtpk(c, d); return w; }

DI int tile_off(int t, int c) { return t * 256 + ((((c >> 4) ^ (t & 7)) << 5) | ((c & 15) << 1)); }
template <int WH> DI void prep_conv_pass(const bf16* PROJ, const float* cw, int b, int hh, int t0, int lane, LAS unsigned char* tile, bf16* rowdst, const LAS float* escale, bool normalize, float nscale) {
    float w[4][2];
#pragma unroll
    for (int jj = 0; jj < 4; ++jj) { const f32x2 t = *(const f32x2*)(cw + (size_t)jj * 3072 + WH * 1024 + hh * 128 + 2 * lane); w[jj][0] = t.x; w[jj][1] = t.y; }
    float A0[35], A1[35];
#pragma unroll
    for (int jj = 0; jj < 3; ++jj) { const int t = t0 - 3 + jj; unsigned u = 0u;
        if (t >= 0) u = *(const unsigned*)(PROJ + ((size_t)b * S_ + t) * 4096 + WH * 1024 + hh * 128 + 2 * lane);
        A0[jj] = bf_lo(u); A1[jj] = bf_hi(u); }
#pragma unroll 1
    for (int hb = 0; hb < 2; ++hb) {
        { unsigned xin[32];
#pragma unroll
          for (int i = 0; i < 32; ++i) xin[i] = __builtin_nontemporal_load((const unsigned*)(PROJ + ((size_t)b * S_ + t0 + 32 * hb + i) * 4096 + WH * 1024 + hh * 128 + 2 * lane));
#pragma unroll
          for (int i = 0; i < 32; ++i) { A0[3 + i] = bf_lo(xin[i]); A1[3 + i] = bf_hi(xin[i]); } }
#pragma unroll
        for (int i = 0; i < 32; ++i) {
            A0[i] = w[0][0] * A0[i] + w[1][0] * A0[i + 1] + w[2][0] * A0[i + 2] + w[3][0] * A0[i + 3];
            A1[i] = w[0][1] * A1[i] + w[1][1] * A1[i + 1] + w[2][1] * A1[i + 2] + w[3][1] * A1[i + 3]; }
#pragma unroll
        for (int i = 0; i < 32; ++i) { A0[i] = silu_f(A0[i]); A1[i] = silu_f(A1[i]); }
        if (normalize) {
            float rs[32];
#pragma unroll
            for (int i = 0; i < 32; ++i) rs[i] = wave_sum(A0[i] * A0[i] + A1[i] * A1[i]);
#pragma unroll
            for (int i = 0; i < 32; ++i) { const float r = rsqrtf(rs[i] + RMS_EPS) * nscale; A0[i] *= r; A1[i] *= r; }
        }
#pragma unroll
        for (int i = 0; i < 32; ++i) {
            const int tt = 32 * hb + i;
            if (rowdst) *(unsigned*)(rowdst + (size_t)tt * 128 + 2 * lane) = cvtpk(A0[i], A1[i]);
            const float es = escale ? escale[tt] : 1.0f;
            *(LAS unsigned*)(tile + tile_off(tt, 2 * lane)) = cvtpk(A0[i] * es, A1[i] * es);
        }
#pragma unroll
        for (int jj = 0; jj < 3; ++jj) { A0[jj] = A0[32 + jj]; A1[jj] = A1[32 + jj]; }
    }
    LDS_WAIT(); asm volatile("" ::: "memory");
}
DI void tile_tr8(const LAS unsigned char* tile, int tb, int tb2, int cb, int lane, s16x4& lo, s16x4& hi) {
    const int q4 = (lane & 15) >> 2, p4 = lane & 3;
    lo = vtr(tile + tile_off(tb + q4, cb + 4 * p4)); hi = vtr(tile + tile_off(tb2 + q4, cb + 4 * p4));
}
DI void gdn_prep2_phase(const Frame& F, const Args& A, int j) {
    unsigned char* ws = opq(A.ws); unsigned char* big = ws + WS_BIG;
    const bf16* PROJ = (const bf16*)(big + BIG_PROJ);
    bf16* KR = (bf16*)(big + GB_KR); bf16* QR = (bf16*)(big + GB_QR); bf16* KT = (bf16*)(big + GB_KT); bf16* VT = (bf16*)(big + GB_VT); bf16* BLOB = (bf16*)(big + GB_BLOB);
    const float* AB = (const float*)(ws + WS_AB); float* GC = (float*)(ws + WS_GALPHA); float* GB = (float*)(ws + WS_GBETA);
    const float* cw = A.gdn_conv_w + (size_t)j * 4 * 3072;
    const int gw = F.bid * NWAVES + F.wave, NGW = F.G * NWAVES, lane = F.lane, g16 = lane >> 4, i16 = lane & 15;
    LAS unsigned char* tile = F.lds + F.wave * 16384;
    LAS float* egl = (LAS float*)(F.lds + LDS_LG + F.wave * 512); LAS float* ekl = egl + 64;
    for (int it = gw; it < NB_ * 8 * 64; it += NGW) {
        const int b = it >> 9, hh = (it >> 6) & 7, n = it & 63, t0 = 64 * n, bh = b * 8 + hh;
        { const int row = b * S_ + t0 + lane; const float a = AB[(size_t)row * 16 + hh], bl = AB[(size_t)row * 16 + 8 + hh];
          const float xs = a + A.gdn_dt_bias[j * 8 + hh]; const float ey = __expf(xs); const float sp = xs > 20.f ? xs : (ey < 1e-3f ? ey * (1.0f - 0.5f * ey) : __logf(1.0f + ey));
          float gc = -__expf(A.gdn_a_log[j * 8 + hh]) * sp;
#pragma unroll
          for (int o = 1; o < 64; o <<= 1) { const float t = bperm(gc, lane - o); if (lane >= o) gc += t; }
          const float gl = rdlane(gc, 63);
          GC[(size_t)bh * S_ + t0 + lane] = gc; GB[(size_t)bh * S_ + t0 + lane] = 1.0f / (1.0f + __expf(-bl));
          egl[lane] = __expf(gc); ekl[lane] = __expf(gl - gc); }
        LDS_WAIT(); asm volatile("" ::: "memory");
        bf16* blob = BLOB + (size_t)it * BLOB_ELEMS;
        bf16* ktc = KT + (size_t)it * 8192; bf16* vtc = VT + (size_t)it * 8192;
        const size_t rbase = ((size_t)bh * S_ + t0) * 128;
        prep_conv_pass<1>(PROJ, cw, b, hh, t0, lane, tile, KR + rbase, nullptr, true, 1.0f);
#pragma unroll 2
        for (int db = 0; db < 8; ++db)
#pragma unroll
            for (int half = 0; half < 2; ++half) { s16x4 lo, hi; const int tb = 32 * half + 8 * g16; tile_tr8(tile, tb, tb + 4, 16 * db, lane, lo, hi);
                *(bf16x8*)(ktc + (16 * db + i16) * 64 + tb) = __builtin_shufflevector(lo, hi, 0, 1, 2, 3, 4, 5, 6, 7); }
#pragma unroll 2
        for (int a = 0; a < 8; ++a)
#pragma unroll
            for (int ks = 0; ks < 2; ++ks) { s16x4 lo, hi; const int tb = 32 * ks + 4 * g16; tile_tr8(tile, tb, tb + 16, 16 * a, lane, lo, hi);
                const f32x4 e0 = *(const LAS f32x4*)(ekl + tb), e1 = *(const LAS f32x4*)(ekl + tb + 16);
                u32x4 wv;
                wv.x = cvtpk(bf_lo((unsigned)(unsigned short)lo[0]) * e0[0], bf_lo((unsigned)(unsigned short)lo[1]) * e0[1]); wv.y = cvtpk(bf_lo((unsigned)(unsigned short)lo[2]) * e0[2], bf_lo((unsigned)(unsigned short)lo[3]) * e0[3]);
                wv.z = cvtpk(bf_lo((unsigned)(unsigned short)hi[0]) * e1[0], bf_lo((unsigned)(unsigned short)hi[1]) * e1[1]); wv.w = cvtpk(bf_lo((unsigned)(unsigned short)hi[2]) * e1[2], bf_lo((unsigned)(unsigned short)hi[3]) * e1[3]);
                *(u32x4*)(blob + BLOB_KDT + ((a * 2 + ks) * 64 + lane) * 8) = wv; }
        LDS_WAIT(); asm volatile("" ::: "memory");
        prep_conv_pass<2>(PROJ, cw, b, hh, t0, lane, tile, nullptr, nullptr, false, 1.0f);
#pragma unroll 2
        for (int db = 0; db < 8; ++db)
#pragma unroll
            for (int half = 0; half < 2; ++half) { s16x4 lo, hi; const int tb = 32 * half + 8 * g16; tile_tr8(tile, tb, tb + 4, 16 * db, lane, lo, hi);
                *(bf16x8*)(vtc + (16 * db + i16) * 64 + tb) = __builtin_shufflevector(lo, hi, 0, 1, 2, 3, 4, 5, 6, 7); }
        LDS_WAIT(); asm volatile("" ::: "memory");
        prep_conv_pass<0>(PROJ, cw, b, hh, t0, lane, tile, QR + rbase, egl, true, 0.08838834764831845f);
#pragma unroll 2
        for (int tm = 0; tm < 4; ++tm)
#pragma unroll
            for (int ks = 0; ks < 4; ++ks) {
                const u32x2 p0 = *(const LAS u32x2*)(tile + tile_off(16 * tm + i16, 32 * ks + 4 * g16)), p1 = *(const LAS u32x2*)(tile + tile_off(16 * tm + i16, 32 * ks + 16 + 4 * g16));
                *(u32x4*)(blob + BLOB_QG + ((tm * 4 + ks) * 64 + lane) * 8) = (u32x4){p0.x, p0.y, p1.x, p1.y}; }
        LDS_WAIT(); asm volatile("" ::: "memory");
    }
}

DI void gdn_wy_phase(const Frame& F, const Args& A) {
    unsigned char* ws = opq(A.ws); unsigned char* big = ws + WS_BIG;
    const bf16* KR = (const bf16*)(big + GB_KR); const bf16* QR = (const bf16*)(big + GB_QR); const bf16* KT = (const bf16*)(big + GB_KT); const bf16* VT = (const bf16*)(big + GB_VT);
    bf16* BLOB = (bf16*)(big + GB_BLOB); float* U = (float*)(ws + WS_HID);
    const float* GC = (const float*)(ws + WS_GALPHA); const float* GB = (const float*)(ws + WS_GBETA);
    const int gw = F.bid * NWAVES + F.wave, NGW = F.G * NWAVES, lane = F.lane, r = lane & 15, q = lane >> 4;
    LAS float* Af = (LAS float*)(F.lds + F.wave * 16384);
    asm volatile("s_waitcnt vmcnt(0)" ::: "memory"); __builtin_amdgcn_fence(__ATOMIC_ACQUIRE, "agent");
    for (int it = gw; it < NB_ * 8 * 64; it += NGW) {
        const int bh = it >> 6, n = it & 63;
        const char* kr = pg8::rfl_ptr((const char*)(KR + ((size_t)bh * S_ + 64 * n) * 128)); const char* qr = pg8::rfl_ptr((const char*)(QR + ((size_t)bh * S_ + 64 * n) * 128));
        const char* kt = pg8::rfl_ptr((const char*)(KT + (size_t)it * 8192)); const char* vt = pg8::rfl_ptr((const char*)(VT + (size_t)it * 8192));
        char* blob = (char*)pg8::rfl_ptr((const char*)(BLOB + (size_t)it * BLOB_ELEMS)); char* ub = (char*)pg8::rfl_ptr((const char*)(U + (size_t)it * 8192));
        const unsigned lrow = (unsigned)(r * 128 + 8 * q) * 2u, ltr = (unsigned)(r * 64 + 8 * q) * 2u, lfrag = (unsigned)(q * 16 + r) * 16u;
        const float gcl = GC[(size_t)bh * S_ + 64 * n + lane], bel = GB[(size_t)bh * S_ + 64 * n + lane];
        __builtin_amdgcn_wave_barrier();
        bf16x8 kfr[4][4], qfr[4][4];
#pragma unroll
        for (int t4 = 0; t4 < 4; ++t4)
#pragma unroll
            for (int ks = 0; ks < 4; ++ks) { kfr[t4][ks] = *(const bf16x8*)(kr + lrow + (16 * t4 * 128 + 32 * ks) * 2); qfr[t4][ks] = *(const bf16x8*)(qr + lrow + (16 * t4 * 128 + 32 * ks) * 2); }
#pragma unroll
        for (int ti = 0; ti < 4; ++ti) {
            const float gi = bperm(gcl, 16 * ti + r), bi = bperm(bel, 16 * ti + r);
#pragma unroll
            for (int tj = 0; tj < 4; ++tj) {
                char* qkdst = blob + (BLOB_QK + ((ti * 2 + (tj >> 1)) * 64) * 8 + 4 * (tj & 1)) * 2 + lfrag;
                if (tj > ti) { *(u32x2*)qkdst = (u32x2){0u, 0u}; *(LAS f32x4*)(Af + (16 * ti + r) * 64 + 16 * tj + 4 * q) = (f32x4){0.f, 0.f, 0.f, 0.f}; continue; }
                f32x4 p1 = (f32x4){0.f, 0.f, 0.f, 0.f}, p2 = p1;
#pragma unroll
                for (int ks = 0; ks < 4; ++ks) { p1 = MFMA16(kfr[tj][ks], kfr[ti][ks], p1); p2 = MFMA16(kfr[tj][ks], qfr[ti][ks], p2); }
                const int i = 16 * ti + r; f32x4 av, qv;
#pragma unroll
                for (int reg = 0; reg < 4; ++reg) { const int jx = 16 * tj + 4 * q + reg; const float gj = bperm(gcl, jx);
                    const float dec = (jx <= i) ? __expf(gi - gj) : 0.f;
                    av[reg] = (jx < i) ? bi * p1[reg] * dec : 0.f; qv[reg] = p2[reg] * dec; }
                *(LAS f32x4*)(Af + i * 64 + 16 * tj + 4 * q) = av;
                *(u32x2*)qkdst = pk4(qv[0], qv[1], qv[2], qv[3]);
                asm volatile("" ::: "memory");
            }
        }
        LDS_WAIT(); asm volatile("" ::: "memory");
#pragma unroll 1
        for (int i0 = 0; i0 < 64; i0 += 4) {
            float a0 = (i0 + 0 == lane) ? 1.0f : 0.0f, a1 = (i0 + 1 == lane) ? 1.0f : 0.0f, a2 = (i0 + 2 == lane) ? 1.0f : 0.0f, a3 = (i0 + 3 == lane) ? 1.0f : 0.0f;
#pragma unroll 2
            for (int j4 = 0; j4 < (i0 >> 2); ++j4) {
                const float t0 = Af[(4 * j4 + 0) * 64 + lane], t1 = Af[(4 * j4 + 1) * 64 + lane], t2 = Af[(4 * j4 + 2) * 64 + lane], t3 = Af[(4 * j4 + 3) * 64 + lane];
                const f32x4 r0 = *(const LAS f32x4*)(Af + (i0 + 0) * 64 + 4 * j4), r1 = *(const LAS f32x4*)(Af + (i0 + 1) * 64 + 4 * j4);
                const f32x4 r2 = *(const LAS f32x4*)(Af + (i0 + 2) * 64 + 4 * j4), r3 = *(const LAS f32x4*)(Af + (i0 + 3) * 64 + 4 * j4);
                a0 -= r0[0] * t0 + r0[1] * t1 + r0[2] * t2 + r0[3] * t3; a1 -= r1[0] * t0 + r1[1] * t1 + r1[2] * t2 + r1[3] * t3;
                a2 -= r2[0] * t0 + r2[1] * t1 + r2[2] * t2 + r2[3] * t3; a3 -= r3[0] * t0 + r3[1] * t1 + r3[2] * t2 + r3[3] * t3;
            }
            const f32x4 d1 = *(const LAS f32x4*)(Af + (i0 + 1) * 64 + i0), d2 = *(const LAS f32x4*)(Af + (i0 + 2) * 64 + i0), d3 = *(const LAS f32x4*)(Af + (i0 + 3) * 64 + i0);
            a1 -= d1[0] * a0; a2 -= d2[0] * a0 + d2[1] * a1; a3 -= d3[0] * a0 + d3[1] * a1 + d3[2] * a2;
            LDS_WAIT(); asm volatile("" ::: "memory");
            Af[(i0 + 0) * 64 + lane] = a0; Af[(i0 + 1) * 64 + lane] = a1; Af[(i0 + 2) * 64 + lane] = a2; Af[(i0 + 3) * 64 + lane] = a3;
            LDS_WAIT(); asm volatile("" ::: "memory");
        }
        bf16x8 tuf[4][2], twf[4][2];
        {
            const float* gcp = GC + (size_t)bh * S_ + 64 * n; const float* gbp = GB + (size_t)bh * S_ + 64 * n;
#pragma unroll
            for (int ks = 0; ks < 2; ++ks) {
                float su[8], sw[8];
#pragma unroll
                for (int h4 = 0; h4 < 2; ++h4) { const f32x4 bv = *(const f32x4*)(gbp + 32 * ks + 8 * q + 4 * h4), gv = *(const f32x4*)(gcp + 32 * ks + 8 * q + 4 * h4);
#pragma unroll
                    for (int e = 0; e < 4; ++e) { su[4 * h4 + e] = bv[e]; sw[4 * h4 + e] = -bv[e] * __expf(gv[e]); } }
#pragma unroll
                for (int tm = 0; tm < 4; ++tm) {
                    const f32x4 x0 = *(const LAS f32x4*)(Af + (16 * tm + r) * 64 + 32 * ks + 8 * q), x1 = *(const LAS f32x4*)(Af + (16 * tm + r) * 64 + 32 * ks + 8 * q + 4);
                    tuf[tm][ks] = __builtin_bit_cast(bf16x8, (u32x4){cvtpk(x0[0] * su[0], x0[1] * su[1]), cvtpk(x0[2] * su[2], x0[3] * su[3]), cvtpk(x1[0] * su[4], x1[1] * su[5]), cvtpk(x1[2] * su[6], x1[3] * su[7])});
                    twf[tm][ks] = __builtin_bit_cast(bf16x8, (u32x4){cvtpk(x0[0] * sw[0], x0[1] * sw[1]), cvtpk(x0[2] * sw[2], x0[3] * sw[3]), cvtpk(x1[0] * sw[4], x1[1] * sw[5]), cvtpk(x1[2] * sw[6], x1[3] * sw[7])});
                }
            }
        }
        LDS_WAIT(); asm volatile("" ::: "memory");
        {
#pragma unroll
            for (int w8 = 0; w8 < 8; ++w8) {
                bf16x8 vb[2];
#pragma unroll
                for (int ks = 0; ks < 2; ++ks) vb[ks] = *(const bf16x8*)(vt + ltr + (16 * w8 * 64 + 32 * ks) * 2);
#pragma unroll
                for (int tm = 0; tm < 4; ++tm) { f32x4 acc = (f32x4){0.f, 0.f, 0.f, 0.f};
#pragma unroll
                    for (int ks = 0; ks < 2; ++ks) acc = MFMA16(tuf[tm][ks], vb[ks], acc);
                    *(f32x4*)(ub + (unsigned)lane * 16u + ((w8 * 4 + tm) * 64) * 16) = acc; }
            }
        }
        {
#pragma unroll
            for (int a = 0; a < 8; ++a) {
                bf16x8 ka[2];
#pragma unroll
                for (int ks = 0; ks < 2; ++ks) ka[ks] = *(const bf16x8*)(kt + ltr + (16 * a * 64 + 32 * ks) * 2);
#pragma unroll
                for (int ti = 0; ti < 4; ++ti) { f32x4 acc = (f32x4){0.f, 0.f, 0.f, 0.f};
#pragma unroll
                    for (int ks = 0; ks < 2; ++ks) acc = MFMA16(ka[ks], twf[ti][ks], acc);
                    *(u32x2*)(blob + (BLOB_W + ((ti * 4 + (a >> 1)) * 64) * 8 + 4 * (a & 1)) * 2 + lfrag) = pk4(acc[0], acc[1], acc[2], acc[3]); }
            }
        }
        LDS_WAIT(); asm volatile("" ::: "memory");
    }
}

constexpr int SCAN_BUF = BLOB_ELEMS * 2;
DI bf16x8 pack8(const f32x4& lo, const f32x4& hi) { return __builtin_bit_cast(bf16x8, (u32x4){cvtpk(lo[0], lo[1]), cvtpk(lo[2], lo[3]), cvtpk(hi[0], hi[1]), cvtpk(hi[2], hi[3])}); }
DI void ld16_asm(u32x4& dst, const char* sbase, unsigned voff) { asm volatile("global_load_dwordx4 %0, %1, %2" : "=v"(dst) : "v"(voff), "s"(sbase) : "memory"); }
#define SCAN_LOAD(RSET, chunk) do { const char* _cb = pg8::rfl_ptr(src + (size_t)(chunk) * SCAN_BUF); \
    _Pragma("unroll") for (int i = 0; i < 14; ++i) ld16_asm(RSET[i], pg8::rfl_ptr(_cb + i * 4096), ltid16); } while (0)
#define SCAN_PUT(RSET, BUF) do { _Pragma("unroll") for (int i = 0; i < 14; ++i) *(LAS u32x4*)(F.lds + (BUF) * SCAN_BUF + i * 4096 + ltid16) = RSET[i]; } while (0)
#define SCAN_LSTEP(n_, BUFN, RFREE, RNEXT) do { const int n = (n_); \
    if (n + 3 < 64) { SCAN_LOAD(RFREE, n + 3); asm volatile("s_waitcnt vmcnt(28)" ::: "memory"); } else { asm volatile("s_waitcnt vmcnt(0)" ::: "memory"); } \
    __builtin_amdgcn_sched_barrier(0); \
    if (n + 1 < 64) SCAN_PUT(RNEXT, BUFN); \
    asm volatile("s_waitcnt lgkmcnt(0)" ::: "memory"); __builtin_amdgcn_s_barrier(); asm volatile("" ::: "memory"); } while (0)
#define SCAN_CSTEP(n_, BUFC, UC) do { const int n = (n_); \
        const LAS unsigned char* buf = F.lds + (BUFC) * SCAN_BUF; \
        f32x4 vn[4]; \
        _Pragma("unroll") for (int tm = 0; tm < 4; ++tm) vn[tm] = UC[tm]; \
        if (n + 2 < 64) { const char* u2 = pg8::rfl_ptr(ubase + (size_t)(n + 2) * 8192 * 4); _Pragma("unroll") for (int tm = 0; tm < 4; ++tm) UC[tm] = __builtin_nontemporal_load((const f32x4*)(u2 + lane16 + tm * 1024)); } \
        if (n > 0) { char* op = (char*)pg8::rfl_ptr(obase + (size_t)(64 * (n - 1)) * D_ * 2); \
            _Pragma("unroll") for (int tm = 0; tm < 4; ++tm) _Pragma("unroll") for (int reg = 0; reg < 4; ++reg) *(bf16*)(op + olane + (16 * tm + reg) * D_ * 2) = (bf16)cvtpk(o[tm][reg], 0.f); } \
        const float glast = rdlane(gl_all, n); \
        bf16x8 sb[4]; \
        _Pragma("unroll") for (int ks = 0; ks < 4; ++ks) sb[ks] = pack8(S[2 * ks], S[2 * ks + 1]); \
          \
        bf16x8 fw[16], fq[16], fk[8], fd[16]; bf16x8 vb[2]; \
        _Pragma("unroll") for (int i = 0; i < 16; ++i) fw[i] = *(const LAS bf16x8*)(buf + BLOB_W * 2 + (i * 64 + lane) * 16); \
        __builtin_amdgcn_sched_barrier(0); \
        _Pragma("unroll") for (int i = 0; i < 16; ++i) fq[i] = *(const LAS bf16x8*)(buf + BLOB_QG * 2 + (i * 64 + lane) * 16); \
        __builtin_amdgcn_sched_barrier(0); \
        _Pragma("unroll") for (int tm = 0; tm < 4; ++tm) _Pragma("unroll") for (int ks = 0; ks < 4; ++ks) vn[tm] = MFMA16(fw[tm * 4 + ks], sb[ks], vn[tm]); \
        __builtin_amdgcn_sched_barrier(0); \
        _Pragma("unroll") for (int i = 0; i < 8; ++i) fk[i] = *(const LAS bf16x8*)(buf + BLOB_QK * 2 + (i * 64 + lane) * 16); \
        __builtin_amdgcn_sched_barrier(0); \
        _Pragma("unroll") for (int tm = 0; tm < 4; ++tm) { o[tm] = (f32x4){0.f, 0.f, 0.f, 0.f}; \
            _Pragma("unroll") for (int ks = 0; ks < 4; ++ks) o[tm] = MFMA16(fq[tm * 4 + ks], sb[ks], o[tm]); } \
        _Pragma("unroll") for (int k2 = 0; k2 < 2; ++k2) vb[k2] = pack8(vn[2 * k2], vn[2 * k2 + 1]); \
        __builtin_amdgcn_sched_barrier(0); \
        _Pragma("unroll") for (int i = 0; i < 16; ++i) fd[i] = *(const LAS bf16x8*)(buf + BLOB_KDT * 2 + (i * 64 + lane) * 16); \
        __builtin_amdgcn_sched_barrier(0); \
        _Pragma("unroll") for (int tm = 0; tm < 4; ++tm) _Pragma("unroll") for (int k2 = 0; k2 < 2; ++k2) o[tm] = MFMA16(fk[tm * 2 + k2], vb[k2], o[tm]); \
        __builtin_amdgcn_sched_barrier(0); \
        _Pragma("unroll") for (int a = 0; a < 8; ++a) { S[a] = S[a] * glast; \
            _Pragma("unroll") for (int k2 = 0; k2 < 2; ++k2) S[a] = MFMA16(fd[a * 2 + k2], vb[k2], S[a]); } \
    asm volatile("s_waitcnt lgkmcnt(0)" ::: "memory"); __builtin_amdgcn_s_barrier(); asm volatile("" ::: "memory"); } while (0)

DI void gdn_scan2_phase(const Frame& F, const Args& A) {
    unsigned char* ws = opq(A.ws); unsigned char* big = ws + WS_BIG;
    const bf16* BLOB = (const bf16*)(big + GB_BLOB); const float* U = (const float*)(ws + WS_HID); bf16* Oraw = (bf16*)(ws + WS_Y);
    const float* GC = (const float*)(ws + WS_GALPHA);
    const int lane = F.lane, r = lane & 15, q = lane >> 4, w = F.wave;
    for (int it2 = F.bid; it2 < NB_ * 8 * 2; it2 += F.G) {
        const int item = it2 >> 1, half = it2 & 1, b = item >> 3, hh = item & 7, dvw = 4 * half + (w & 3);
        const char* src = pg8::rfl_ptr((const char*)(BLOB + (size_t)item * 64 * BLOB_ELEMS));
        __syncthreads();
        if (w >= 4) {
            const unsigned ltid16 = (unsigned)((w & 3) * 64 + lane) * 16u;
            u32x4 r0[14], r1[14], r2[14];
            SCAN_LOAD(r0, 0); SCAN_LOAD(r1, 1); SCAN_LOAD(r2, 2); asm volatile("s_waitcnt vmcnt(28)" ::: "memory"); __builtin_amdgcn_sched_barrier(0); SCAN_PUT(r0, 0);
            asm volatile("s_waitcnt lgkmcnt(0)" ::: "memory"); __builtin_amdgcn_s_barrier(); asm volatile("" ::: "memory");
#pragma unroll 1
            for (int n6 = 0; n6 < 60; n6 += 6) {
                SCAN_LSTEP(n6 + 0, 1, r0, r1); SCAN_LSTEP(n6 + 1, 0, r1, r2); SCAN_LSTEP(n6 + 2, 1, r2, r0);
                SCAN_LSTEP(n6 + 3, 0, r0, r1); SCAN_LSTEP(n6 + 4, 1, r1, r2); SCAN_LSTEP(n6 + 5, 0, r2, r0);
            }
            SCAN_LSTEP(60, 1, r0, r1); SCAN_LSTEP(61, 0, r1, r2); SCAN_LSTEP(62, 1, r2, r0); SCAN_LSTEP(63, 0, r0, r1);
        } else {
            f32x4 S[8];
#pragma unroll
            for (int a = 0; a < 8; ++a) S[a] = (f32x4){0.f, 0.f, 0.f, 0.f};
            const char* ubase = pg8::rfl_ptr((const char*)(U + (size_t)item * 64 * 8192 + (size_t)(dvw * 4) * 256));
            const char* obase = pg8::rfl_ptr((const char*)(Oraw + (size_t)b * S_ * D_ + hh * 128 + 16 * dvw));
            const unsigned lane16 = (unsigned)lane * 16u, olane = (unsigned)((4 * q) * D_ + r) * 2u;
            const float gl_all = __expf(GC[(size_t)item * S_ + 64 * lane + 63]);
            f32x4 ua[4], ub[4], o[4];
#pragma unroll
            for (int tm = 0; tm < 4; ++tm) { ua[tm] = __builtin_nontemporal_load((const f32x4*)(ubase + lane16 + tm * 1024)); ub[tm] = __builtin_nontemporal_load((const f32x4*)(ubase + 8192 * 4 + lane16 + tm * 1024)); o[tm] = (f32x4){0.f, 0.f, 0.f, 0.f}; }
            asm volatile("s_waitcnt lgkmcnt(0)" ::: "memory"); __builtin_amdgcn_s_barrier(); asm volatile("" ::: "memory");
#pragma unroll 1
            for (int n2 = 0; n2 < 64; n2 += 2) { SCAN_CSTEP(n2, 0, ua); SCAN_CSTEP(n2 + 1, 1, ub); }
            { char* op = (char*)obase + (size_t)(64 * 63) * D_ * 2;
#pragma unroll
              for (int tm = 0; tm < 4; ++tm)
#pragma unroll
                  for (int reg = 0; reg < 4; ++reg) *(bf16*)(op + olane + (16 * tm + reg) * D_ * 2) = (bf16)cvtpk(o[tm][reg], 0.f); }
        }
    }
}
#undef SCAN_LSTEP
#undef SCAN_CSTEP
#undef SCAN_LOAD
#undef SCAN_PUT
constexpr int N_PHASES = 42;
#ifndef MK_FUSED
#define MK_FUSED 1
#endif

#if MK_FUSED
typedef const __attribute__((address_space(4))) Args* CArgsP;
DI Args fresh_args() {
#if defined(__HIP_DEVICE_COMPILE__)
    CArgsP kp = (CArgsP)__builtin_amdgcn_kernarg_segment_ptr(); asm volatile("" : "+s"(kp)); Args a = *kp;
    a.x = asg(a.x); a.c = asg(a.c); a.pos = asg(a.pos); a.ada_w = asg(a.ada_w); a.ada_b = asg(a.ada_b); a.ln_g = asg(a.ln_g); a.ln_b = asg(a.ln_b);
    a.attn_w_in = asg(a.attn_w_in); a.attn_w_out = asg(a.attn_w_out); a.gdn_w_in = asg(a.gdn_w_in); a.gdn_conv_w = asg(a.gdn_conv_w); a.gdn_a_log = asg(a.gdn_a_log); a.gdn_dt_bias = asg(a.gdn_dt_bias);
    a.gdn_norm_w = asg(a.gdn_norm_w); a.gdn_w_out = asg(a.gdn_w_out); a.router_w = asg(a.router_w); a.router_bias = asg(a.router_bias); a.ew1 = asg(a.ew1); a.ew3 = asg(a.ew3); a.ew2 = asg(a.ew2);
    a.sw1 = asg(a.sw1); a.sw3 = asg(a.sw3); a.sw2 = asg(a.sw2); a.out = asg(a.out); a.ws = asg(a.ws);
    return a;
#else
    return Args{};
#endif
}
DI Frame fresh_frame(int wave_s) { Frame F; int g = gridDim.x; asm volatile("" : "+s"(g)); int b = blockIdx.x; asm volatile("" : "+s"(b)); unsigned l = 0u; asm volatile("" : "+s"(l));
    int w = wave_s; asm volatile("" : "+s"(w)); int ln; asm volatile("v_mbcnt_lo_u32_b32 %0, -1, 0\n\tv_mbcnt_hi_u32_b32 %0, -1, %0" : "=&v"(ln));
    F.lds = (LAS unsigned char*)(size_t)l; F.tid = w * 64 + ln; F.lane = ln; F.wave = w; F.G = g; F.bid = b; return F; }
#define PHF() const Args A = fresh_args(); const Frame F = fresh_frame(wave_s); \
    unsigned char* ws = opq(A.ws); LAS int* idxlds = (LAS int*)(F.lds + LDS_IDX); const LAS int* tileoff = (const LAS int*)(F.lds + LDS_TILEOFF); (void)ws; (void)idxlds; (void)tileoff;
DI void ph_pro(const int wave_s) { PHF(); prologue_phase(F, A); convert_experts(F, A, 0, 0, 0, F.G); }
DI void ph_modx(const int wave_s) { PHF(); modx_phase(F, A); }
DI void ph_attn(const int wave_s) { PHF(); attn_phase(F, A); }
DI void ph_lnr(const int wave_s, int L) { PHF(); if (L == 0) ln_router_phase<true>(F, A, L); else ln_router_phase<false>(F, A, L); }
DI void ph_lnr_dry(const int wave_s, int L) { PHF(); if (L == 0) ln_router_phase<true>(F, A, L, true); else ln_router_phase<false>(F, A, L, true); }
DI void ph_scat(const int wave_s, int L) { PHF(); moe_scatter_phase(F, A, L); }
DI void ph_lnm(const int wave_s, int L) { PHF(); ln_moe_phase(F, A, L, nullptr); }
DI void ph_lnm_dry(const int wave_s, int L) { PHF(); ln_moe_phase(F, A, L, (float*)(ws + WS_Y)); }
DI void ph_gprep(const int wave_s, int lp) { PHF(); gdn_prep2_phase(F, A, lp); }
DI void ph_gwy(const int wave_s) { PHF(); gdn_wy_phase(F, A); }
DI void ph_gscan(const int wave_s, int L) { PHF(); gdn_scan2_phase(F, A); if (F.G > 128) { convert_experts(F, A, L, 0, 64, F.G - 64); if (L == 1) convert_experts(F, A, 2, 1, 64, F.G - 64); } else { convert_experts(F, A, L, 0, 0, F.G); if (L == 1) convert_experts(F, A, 2, 1, 0, F.G); } }
DI void ph_gpost(const int wave_s, int lp) { PHF(); gdn_post_phase(F, A, lp); }
DI void ph_gemm_qkv(const int wave_s, int lp) { PHF();
    pg8::DenseOrder S; S.init(WS_H, WS_WA_IN + (size_t)lp * 9216 * D_ * 2, T_, 9216, D_, F.G, F.bid);
    pg8::EpiQKV E{(bf16*)(ws + WS_BIG), (const float*)(ws + WS_COS), (const float*)(ws + WS_SIN)};
    pg8::gemm_phase<pg8::EpiQKV, pg8::DenseOrder, true, true>(F.tid, ws, F.lds, idxlds, D_, S, E); }
DI void ph_gemm_out(const int wave_s, int lp, int isg) { PHF();
    pg8::DenseOrder S; S.init(WS_O, (isg ? WS_WG_OUT : WS_WA_OUT) + (size_t)lp * D_ * D_ * 2, T_, D_, D_, F.G, F.bid);
    pg8::EpiBf16 E{(bf16*)(ws + WS_Y), D_};
    pg8::gemm_phase<pg8::EpiBf16, pg8::DenseOrder, true, true>(F.tid, ws, F.lds, idxlds, D_, S, E); }
DI void ph_gemm_gin(const int wave_s, int lp) { PHF();
    pg8::DenseOrder S; S.init(WS_H, WS_WG_IN + (size_t)lp * 4096 * D_ * 2, T_, 4096, D_, F.G, F.bid);
    pg8::EpiBf16 E{(bf16*)(ws + WS_BIG + BIG_PROJ), 4096};
    pg8::gemm_phase<pg8::EpiBf16, pg8::DenseOrder, true, true>(F.tid, ws, F.lds, idxlds, D_, S, E); }
DI void ph_moe1(const int wave_s, int L) { PHF();
    const unsigned* gcount = (const unsigned*)(ws + WS_CTL) + CW_CNT + L * 64;
    build_tileoff(F, gcount);
    pg8::MoeOrder<true> S; S.A = (unsigned)WS_H; S.Bt = (unsigned)(L == 2 ? WS_WEB : WS_WE1); S.K = D_; S.nct_log = 1; S.nunits = __builtin_amdgcn_readfirstlane(tileoff[65]) * 2; S.G = F.G; S.c = F.bid;
    S.idxoff = (unsigned)WS_ETOK; S.tileoff = tileoff; S.ecnt = (const LAS int*)(F.lds + LDS_ECNT); S.bstride = (unsigned)(512 * D_ * 2);
    pg8::EpiSwiGLU E{(bf16*)(ws + WS_HID)};
    pg8::gemm_phase<pg8::EpiSwiGLU, pg8::MoeOrder<true>, true, true>(F.tid, ws, F.lds, idxlds, D_, S, E); }
DI void ph_moe2(const int wave_s, int L) { PHF();
    const unsigned* gcount = (const unsigned*)(ws + WS_CTL) + CW_CNT + L * 64;
    build_tileoff(F, gcount);
    pg8::MoeOrder<false> S; S.A = (unsigned)WS_HID; S.Bt = (unsigned)(L == 2 ? WS_WEB + 65 * MiB : WS_WE2); S.K = 256; S.nct_log = 2; S.nunits = __builtin_amdgcn_readfirstlane(tileoff[(YS_BF16 && !YS_MERGED) ? 64 : 65]) * 4; S.G = F.G; S.c = F.bid;
    S.idxoff = (unsigned)WS_EW; S.tileoff = tileoff; S.ecnt = (const LAS int*)(F.lds + LDS_ECNT); S.bstride = (unsigned)(D_ * 256 * 2);
    pg8::EpiScale E{ws + WS_BIG, 256 * __builtin_amdgcn_readfirstlane(tileoff[64])};
    pg8::gemm_phase<pg8::EpiScale, pg8::MoeOrder<false>, false, false>(F.tid, ws, F.lds, idxlds, 256, S, E); }
DI void ph_moe2s(const int wave_s, int L) { PHF();
    __syncthreads();
    const size_t s0 = (size_t)(256 * __builtin_amdgcn_readfirstlane(((const LAS int*)(F.lds + LDS_TILEOFF))[64]));
    pg8::DenseOrder S; S.init(WS_HID + s0 * 256 * 2, (L == 2 ? WS_WEB + 65 * MiB : WS_WE2) + (size_t)NEXP * D_ * 256 * 2, T_, D_, 256, F.G, F.bid);
    pg8::EpiBf16 E{(bf16*)(ws + WS_BIG + WS_YS_OFF), D_};
    pg8::gemm_phase<pg8::EpiBf16, pg8::DenseOrder, false, false>(F.tid, ws, F.lds, idxlds, 256, S, E); }

DI void grid_bar(const int wave_s) { PHF(); XcdBarrier b; b.bar = (unsigned*)(ws + WS_CTL) + CW_BAR; volatile LAS unsigned* misc = (volatile LAS unsigned*)(F.lds + LDS_MISC); b.st = misc + 8;
    b.x = (unsigned)__builtin_amdgcn_readfirstlane((int)misc[10]); xcd_barrier(b, F.tid); }
__global__ void __launch_bounds__(NTHR, 2) mk_fwd(Args Ain) {
    extern __shared__ __attribute__((aligned(16))) unsigned char lds_raw[];
    LAS unsigned char* lds = (LAS unsigned char*)lds_raw;
    for (int u = threadIdx.x; u < (LDS_BYTES - RING_BYTES) / 4; u += NTHR) ((LAS unsigned*)(lds + RING_BYTES))[u] = 0u;
    __syncthreads();
    const int wave_s = __builtin_amdgcn_readfirstlane((int)threadIdx.x >> 6);
    { XcdBarrier bar = xcd_barrier_post((unsigned*)(Ain.ws + WS_CTL) + CW_BAR, (volatile LAS unsigned*)(lds + LDS_MISC) + 8);
      if (threadIdx.x == 0) ((volatile LAS unsigned*)(lds + LDS_MISC))[10] = bar.x; }
    __syncthreads();
#ifndef REP_BAR
#define REP_BAR 1
#define REP_PRO 1
#define REP_POST 1
#define REP_QKV 1
#define REP_OUT 1
#define REP_GIN 1
#define REP_M1 1
#define REP_M2 1
#define REP_LNM 1
#define REP_LNR 1
#endif
#define GBAR() do { for (int _b = 0; _b < REP_BAR; ++_b) grid_bar(wave_s); } while (0)
#ifndef REP_ATTN
#define REP_ATTN 1
#define REP_SCAN 1
#define REP_GEMM 1
#define REP_PREP 1
#define REP_CONV 1
#define REP_WY 1
#endif
    for (int r = 0; r < REP_PRO; ++r) { ph_pro(wave_s); GBAR(); }
    ph_modx(wave_s); GBAR();
#pragma unroll 1
    for (int L = 0; L < 4; ++L) {
        const int lp = L >> 1;
        if ((L & 1) == 0) { for (int r = 0; r < REP_QKV; ++r) { ph_gemm_qkv(wave_s, lp); GBAR(); } for (int r = 0; r < REP_ATTN; ++r) { ph_attn(wave_s); GBAR(); } for (int r = 0; r < REP_OUT; ++r) { ph_gemm_out(wave_s, lp, 0); GBAR(); } }
        else { for (int r = 0; r < REP_GIN; ++r) { ph_gemm_gin(wave_s, lp); GBAR(); } for (int r = 0; r < REP_PREP; ++r) { ph_gprep(wave_s, lp); GBAR(); } for (int r = 0; r < REP_WY; ++r) { ph_gwy(wave_s); GBAR(); } for (int r = 0; r < REP_SCAN; ++r) { ph_gscan(wave_s, L); GBAR(); } for (int r = 0; r < REP_POST; ++r) { ph_gpost(wave_s, lp); GBAR(); } for (int r = 0; r < REP_OUT; ++r) { ph_gemm_out(wave_s, lp, 1); GBAR(); } }
        for (int r = 1; r < REP_LNR; ++r) { ph_lnr_dry(wave_s, L); GBAR(); }
        ph_lnr(wave_s, L); GBAR();
        for (int r = 0; r < REP_M1; ++r) { ph_moe1(wave_s, L); GBAR(); }
        for (int r = 0; r < REP_M2; ++r) { ph_moe2(wave_s, L); if (YS_BF16 && !YS_MERGED) ph_moe2s(wave_s, L); GBAR(); }
        for (int r = 1; r < REP_LNM; ++r) { ph_lnm_dry(wave_s, L); GBAR(); }
        ph_lnm(wave_s, L); if (L < 3) GBAR();
    }
#undef GBAR
}
#else

#define MKF() extern __shared__ __attribute__((aligned(16))) unsigned char lds_raw[]; Frame F; F.lds = (LAS unsigned char*)lds_raw; F.tid = threadIdx.x; F.lane = F.tid & 63; \
    F.wave = __builtin_amdgcn_readfirstlane(F.tid >> 6); F.G = gridDim.x; F.bid = blockIdx.x; unsigned char* ws = opq(A.ws); LAS int* idxlds = (LAS int*)(F.lds + LDS_IDX); \
    const LAS int* tileoff = (const LAS int*)(F.lds + LDS_TILEOFF); (void)ws; (void)idxlds; (void)tileoff; \
    for (int u = F.tid; u < (LDS_BYTES - RING_BYTES) / 4; u += NTHR) ((LAS unsigned*)(F.lds + RING_BYTES))[u] = 0u; __syncthreads();
__global__ void __launch_bounds__(NTHR, 2) k_pro(Args A) { MKF(); prologue_phase(F, A); }
__global__ void __launch_bounds__(NTHR, 2) k_modx(Args A) { MKF(); modx_phase(F, A); }
__global__ void __launch_bounds__(NTHR, 2) k_attn(Args A) { MKF(); attn_phase(F, A); }
__global__ void __launch_bounds__(NTHR, 2) k_lnr(Args A) { MKF(); const int L = A.ph_lo; ln_router_phase<false>(F, A, L); }
__global__ void __launch_bounds__(NTHR, 2) k_scat(Args A) { MKF(); moe_scatter_phase(F, A, A.ph_lo); convert_experts(F, A, A.ph_lo); }
__global__ void __launch_bounds__(NTHR, 2) k_lnm(Args A) { MKF(); const int L = A.ph_lo; ln_moe_phase(F, A, L, nullptr); }
__global__ void __launch_bounds__(NTHR, 2) k_gprep(Args A) { MKF(); gdn_prep_phase(F, A, A.ph_lo); }
__global__ void __launch_bounds__(NTHR, 2) k_gscan(Args A) { MKF(); gdn_scan_phase(F, A); }
__global__ void __launch_bounds__(NTHR, 2) k_gpost(Args A) { MKF(); gdn_post_phase(F, A, A.ph_lo); }
__global__ void __launch_bounds__(NTHR, 2) k_gemm_qkv(Args A) { MKF(); const int lp = A.ph_lo;
    pg8::DenseOrder S; S.init(WS_H, WS_WA_IN + (size_t)lp * 9216 * D_ * 2, T_, 9216, D_, F.G, F.bid);
    pg8::EpiQKV E{(bf16*)(ws + WS_BIG), (const float*)(ws + WS_COS), (const float*)(ws + WS_SIN)};
    pg8::gemm_phase<pg8::EpiQKV, pg8::DenseOrder, true, true>(F.tid, ws, F.lds, idxlds, D_, S, E); }
__global__ void __launch_bounds__(NTHR, 2) k_gemm_out(Args A) { MKF(); const int lp = A.ph_lo >> 1, isg = A.ph_lo & 1;
    pg8::DenseOrder S; S.init(WS_O, (isg ? WS_WG_OUT : WS_WA_OUT) + (size_t)lp * D_ * D_ * 2, T_, D_, D_, F.G, F.bid);
    pg8::EpiF32 E{(float*)(ws + WS_Y), D_};
    pg8::gemm_phase<pg8::EpiF32, pg8::DenseOrder, true, true>(F.tid, ws, F.lds, idxlds, D_, S, E); }
__global__ void __launch_bounds__(NTHR, 2) k_gemm_gin(Args A) { MKF(); const int lp = A.ph_lo;
    pg8::DenseOrder S; S.init(WS_H, WS_WG_IN + (size_t)lp * 4096 * D_ * 2, T_, 4096, D_, F.G, F.bid);
    pg8::EpiBf16 E{(bf16*)(ws + WS_BIG + BIG_PROJ), 4096};
    pg8::gemm_phase<pg8::EpiBf16, pg8::DenseOrder, true, true>(F.tid, ws, F.lds, idxlds, D_, S, E); }
__global__ void __launch_bounds__(NTHR, 2) k_moe1(Args A) { MKF();
    const unsigned* gcount = (const unsigned*)(ws + WS_CTL) + CW_CNT + A.ph_lo * 64;
    build_tileoff(F, gcount);
    pg8::MoeOrder<true> S; S.A = (unsigned)WS_H; S.Bt = (unsigned)(L == 2 ? WS_WEB : WS_WE1); S.K = D_; S.nct_log = 1; S.nunits = __builtin_amdgcn_readfirstlane(tileoff[65]) * 2; S.G = F.G; S.c = F.bid;
    S.idxoff = (unsigned)WS_ETOK; S.tileoff = tileoff; S.ecnt = (const LAS int*)(F.lds + LDS_ECNT); S.bstride = (unsigned)(512 * D_ * 2);
    pg8::EpiSwiGLU E{(bf16*)(ws + WS_HID)};
    pg8::gemm_phase<pg8::EpiSwiGLU, pg8::MoeOrder<true>, true, true>(F.tid, ws, F.lds, idxlds, D_, S, E); }
__global__ void __launch_bounds__(NTHR, 2) k_moe2(Args A) { MKF();
    const unsigned* gcount = (const unsigned*)(ws + WS_CTL) + CW_CNT + A.ph_lo * 64;
    build_tileoff(F, gcount);
    pg8::MoeOrder<false> S; S.A = (unsigned)WS_HID; S.Bt = (unsigned)(L == 2 ? WS_WEB + 65 * MiB : WS_WE2); S.K = 256; S.nct_log = 2; S.nunits = __builtin_amdgcn_readfirstlane(tileoff[65]) * 4; S.G = F.G; S.c = F.bid;
    S.idxoff = (unsigned)WS_EW; S.tileoff = tileoff; S.ecnt = (const LAS int*)(F.lds + LDS_ECNT); S.bstride = (unsigned)(D_ * 256 * 2);
    pg8::EpiScale E{ws + WS_BIG, 256 * __builtin_amdgcn_readfirstlane(tileoff[64])};
    pg8::gemm_phase<pg8::EpiScale, pg8::MoeOrder<false>, false, false>(F.tid, ws, F.lds, idxlds, 256, S, E); }
#endif
extern "C" void kernel_launch(void* const* d_in, const int* in_sizes, int n_in, void* d_out, int out_size, void* d_ws, size_t ws_size, hipStream_t stream) {
    static int grid = 0;
    if (grid == 0) {
        if (n_in != 23 || in_sizes[0] != T_ * D_ || out_size != T_ * D_ || ws_size < WS_END) {
            fprintf(stderr, "kernel_launch: unexpected shapes (n_in %d, in0 %d, out %d, ws %zu < %zu); nothing launched\n", n_in, n_in > 0 ? in_sizes[0] : -1, out_size, ws_size, (size_t)WS_END); grid = -1; return; }
        int dev = 0, cus = 0, per_cu = 0;
        if (hipGetDevice(&dev) != hipSuccess || hipDeviceGetAttribute(&cus, hipDeviceAttributeMultiprocessorCount, dev) != hipSuccess) { grid = -1; return; }
#if MK_FUSED
        if (hipFuncSetAttribute((const void*)mk_fwd, hipFuncAttributeMaxDynamicSharedMemorySize, LDS_BYTES) != hipSuccess) { fprintf(stderr, "kernel_launch: hipFuncSetAttribute failed\n"); grid = -1; return; }
        if (hipOccupancyMaxActiveBlocksPerMultiprocessor(&per_cu, (const void*)mk_fwd, NTHR, LDS_BYTES) != hipSuccess || per_cu < 1)
            fprintf(stderr, "kernel_launch: note: occupancy query reports %d workgroups per CU\n", per_cu);
#else
        { const void* ks[] = {(const void*)k_pro, (const void*)k_modx, (const void*)k_attn, (const void*)k_lnr, (const void*)k_scat, (const void*)k_lnm, (const void*)k_gprep, (const void*)k_gscan, (const void*)k_gpost,
                              (const void*)k_gemm_qkv, (const void*)k_gemm_out, (const void*)k_gemm_gin, (const void*)k_moe1, (const void*)k_moe2};
          for (const void* k : ks) if (hipFuncSetAttribute(k, hipFuncAttributeMaxDynamicSharedMemorySize, LDS_BYTES) != hipSuccess) { fprintf(stderr, "kernel_launch: hipFuncSetAttribute failed\n"); grid = -1; return; } }
        (void)per_cu;
#endif
        (void)hipGetLastError();
        grid = cus;
    }
    if (grid < 0) return;
    (void)hipMemsetAsync((char*)d_ws + WS_CTL, 0, CTL_ZERO_BYTES, stream);
    Args a{};
    a.x = (const float*)d_in[0]; a.c = (const float*)d_in[1]; a.pos = (const int*)d_in[2]; a.ada_w = (const float*)d_in[3]; a.ada_b = (const float*)d_in[4];
    a.ln_g = (const float*)d_in[5]; a.ln_b = (const float*)d_in[6]; a.attn_w_in = (const float*)d_in[7]; a.attn_w_out = (const float*)d_in[8];
    a.gdn_w_in = (const float*)d_in[9]; a.gdn_conv_w = (const float*)d_in[10]; a.gdn_a_log = (const float*)d_in[11]; a.gdn_dt_bias = (const float*)d_in[12];
    a.gdn_norm_w = (const float*)d_in[13]; a.gdn_w_out = (const float*)d_in[14]; a.router_w = (const float*)d_in[15]; a.router_bias = (const float*)d_in[16];
    a.ew1 = (const float*)d_in[17]; a.ew3 = (const float*)d_in[18]; a.ew2 = (const float*)d_in[19]; a.sw1 = (const float*)d_in[20]; a.sw3 = (const float*)d_in[21]; a.sw2 = (const float*)d_in[22];
    a.out = (float*)d_out; a.ws = (unsigned char*)d_ws;
#if MK_FUSED
    a.ph_lo = 0; a.ph_hi = N_PHASES;
    hipLaunchKernelGGL(mk_fwd, dim3(grid), dim3(NTHR), LDS_BYTES, stream, a);
#else
#define LAUNCH(k, arg) do { a.ph_lo = (arg); a.ph_hi = (arg) + 1; hipLaunchKernelGGL(k, dim3(grid), dim3(NTHR), LDS_BYTES, stream, a); } while (0)
    LAUNCH(k_pro, 0); LAUNCH(k_modx, 0);
    for (int L = 0; L < 4; ++L) {
        const int lp = L >> 1;
        if ((L & 1) == 0) { LAUNCH(k_gemm_qkv, lp); LAUNCH(k_attn, 0); LAUNCH(k_gemm_out, 2 * lp); }
        else { LAUNCH(k_gemm_gin, lp); LAUNCH(k_gprep, lp); LAUNCH(k_gscan, 0); LAUNCH(k_gpost, lp); LAUNCH(k_gemm_out, 2 * lp + 1); }
        LAUNCH(k_lnr, L); LAUNCH(k_scat, L); LAUNCH(k_moe1, L); LAUNCH(k_moe2, L); LAUNCH(k_lnm, L);
    }
#undef LAUNCH
#endif
    const hipError_t le = hipPeekAtLastError();
    if (le != hipSuccess) fprintf(stderr, "kernel_launch: launch failed: %s\n", hipGetErrorName(le));
}
```

```cpp
#include <hip/hip_runtime.h>
#include <cstdio>
#include <cstdint>

#define GAS __attribute__((address_space(1)))
#define LAS __attribute__((address_space(3)))
typedef unsigned short bf16;
typedef unsigned u32x4 __attribute__((ext_vector_type(4)));
typedef unsigned u32x2 __attribute__((ext_vector_type(2)));
typedef float f32x2 __attribute__((ext_vector_type(2)));
typedef float f32x4 __attribute__((ext_vector_type(4)));
typedef float f32x16 __attribute__((ext_vector_type(16)));
typedef short bf16x8 __attribute__((ext_vector_type(8)));
typedef short s16x4 __attribute__((ext_vector_type(4)));
typedef __bf16 bf16x2_t __attribute__((ext_vector_type(2)));
#define DI __device__ __forceinline__

DI unsigned cvtpk(float lo, float hi) { f32x2 v = {lo, hi}; bf16x2_t b = __builtin_convertvector(v, bf16x2_t); return __builtin_bit_cast(unsigned, b); }
DI unsigned cvtpk_fp8(float a, float b, float c, float d) { int w = __builtin_amdgcn_cvt_pk_fp8_f32(a, b, 0, false); w = __builtin_amdgcn_cvt_pk_fp8_f32(c, d, w, true); return (unsigned)w; }
constexpr bool YS_BF16 = true;
constexpr bool YS_MERGED = true;
constexpr float YE_SCALE = 16.0f;
DI float silu_f(float a) { return a * __builtin_amdgcn_rcpf(1.0f + __expf(-a)); }
DI float bf_lo(unsigned u) { return __builtin_bit_cast(float, u << 16); }
DI float bf_hi(unsigned u) { return __builtin_bit_cast(float, u & 0xffff0000u); }
template <int M> DI float shx(float v) { return __builtin_bit_cast(float, __builtin_amdgcn_ds_swizzle(__builtin_bit_cast(int, v), (M << 10) | 0x1f)); }
DI float bperm(float v, int srclane) { return __builtin_bit_cast(float, __builtin_amdgcn_ds_bpermute(srclane << 2, __builtin_bit_cast(int, v))); }
DI float rdlane(float v, int l) { return __builtin_bit_cast(float, __builtin_amdgcn_readlane(__builtin_bit_cast(int, v), l)); }
template <int CTRL> DI float dppmov(float v) { return __builtin_bit_cast(float, __builtin_amdgcn_update_dpp(0, __builtin_bit_cast(int, v), CTRL, 0xf, 0xf, true)); }
DI float wave_sum(float v) { v += dppmov<0xB1>(v); v += dppmov<0x4E>(v); v += dppmov<0x141>(v); v += dppmov<0x140>(v); return (rdlane(v, 0) + rdlane(v, 16)) + (rdlane(v, 32) + rdlane(v, 48)); }
DI float wave_max(float v) { v = fmaxf(v, dppmov<0xB1>(v)); v = fmaxf(v, dppmov<0x4E>(v)); v = fmaxf(v, dppmov<0x141>(v)); v = fmaxf(v, dppmov<0x140>(v)); return fmaxf(fmaxf(rdlane(v, 0), rdlane(v, 16)), fmaxf(rdlane(v, 32), rdlane(v, 48))); }
#define LDS_WAIT() asm volatile("s_waitcnt lgkmcnt(0)" ::: "memory")
#define VM_WAIT() asm volatile("s_waitcnt vmcnt(0)" ::: "memory")

namespace pg8 {
constexpr int BM = 256, BK = 64, HALF = 128, HTB = HALF * BK * 2, STAGE_BYTES = 8 * HTB;
DI int lds_byte(int r, int c) { const int st = (r >> 4) * 2 + (c >> 5), rr = r & 15, cc = c & 31, ob = rr * 64 + cc * 2; return st * 1024 + (ob ^ (((ob >> 9) & 1) << 5)); }
DI void stage_rc(int b, int& R, int& C) { const int st = b / 1024, sb = b % 1024, swz = sb ^ (((sb >> 9) & 1) << 5); R = (st >> 1) * 16 + swz / 64; C = (st & 1) * 32 + (swz % 64) / 2; }
DI int perm32(int rho) { const int n = rho >> 4, i = rho & 15; return 8 * (i >> 2) + 4 * n + (i & 3); }

DI const char* rfl_ptr(const char* p) {
    const unsigned long long v = (unsigned long long)p; const unsigned lo = __builtin_amdgcn_readfirstlane((unsigned)v), hi = __builtin_amdgcn_readfirstlane((unsigned)(v >> 32));
    return (const char*)(const __attribute__((address_space(1))) char*)(((unsigned long long)hi << 32) | lo); }
struct Unit { unsigned a; unsigned b; int r0; int c0; int e; int rb; int nv; };

template <class Epi, class Sched, bool ALIGN_EPI, bool SP2>
DI void gemm_phase(const int tid, const void* wsbase, LAS unsigned char* lds, LAS int* idxlds, const int K, const Sched& S, const Epi& E) {
    const __amdgpu_buffer_rsrc_t rsrc = __builtin_amdgcn_make_buffer_rsrc((void*)wsbase, 0, 0xffffffff, 0x00020000);
    const int wid = __builtin_amdgcn_readfirstlane(tid >> 6), lane = tid & 63, wr = wid >> 2, wc = wid & 3, fr = lane & 15, fq = lane >> 4;
    const int nt = K / BK;
    unsigned voffB[2], voffA[2][2];
#pragma unroll
    for (int i = 0; i < 2; ++i) { int R, C; stage_rc(tid * 16 + i * 8192, R, C); const int Rb = Epi::PERM ? ((R & ~31) + perm32(R & 31)) : R;
        voffB[i] = (unsigned)(Rb * K + C) * 2u;
        voffA[0][i] = (unsigned)(R * K + C) * 2u; voffA[1][i] = (unsigned)((R + HALF) * K + C) * 2u; }
    const unsigned kstep = (unsigned)(BK * 2);
    const unsigned hstep = (unsigned)(HALF * K * 2);
    const unsigned ldsw = (unsigned)wid * 1024u;
    const int aoff = lds_byte(wr * 64 + fr, fq * 8), boff = lds_byte(wc * 32 + fr, fq * 8);
#define PG8_SA(b, h) (((b) * 2 + (h)) * HTB)
#define PG8_SB(b, h) ((4 + (b) * 2 + (h)) * HTB)
#define PG8_STAGE(bufoff, soff, voff) do { const int _so = __builtin_amdgcn_readfirstlane((int)(soff)); _Pragma("unroll") for (int _i = 0; _i < 2; ++_i) \
        __builtin_amdgcn_raw_ptr_buffer_load_lds(rsrc, (LAS void*)(lds + (bufoff) + ldsw + _i * 8192), 16, (int)(voff)[_i], _so, 0, 0); } while (0)
#define PG8_LDA(dst, b, h) do { _Pragma("unroll") for (int m = 0; m < 4; ++m) _Pragma("unroll") for (int k = 0; k < 2; ++k) dst[m][k] = *(const LAS bf16x8*)(lds + PG8_SA(b, h) + aoff + m * 2048 + k * 1024); } while (0)
#define PG8_LDB(dst, b, h) do { _Pragma("unroll") for (int n = 0; n < 2; ++n) _Pragma("unroll") for (int k = 0; k < 2; ++k) dst[n][k] = *(const LAS bf16x8*)(lds + PG8_SB(b, h) + boff + n * 2048 + k * 1024); } while (0)
#define PG8_MMA(ai, bj, At, Bt) do { __builtin_amdgcn_s_setprio(1); _Pragma("unroll") for (int m = 0; m < 4; ++m) _Pragma("unroll") for (int n = 0; n < 2; ++n) _Pragma("unroll") for (int k = 0; k < 2; ++k) \
        acc[ai][bj][m][n] = __builtin_amdgcn_mfma_f32_16x16x32_bf16(Bt[n][k], At[m][k], acc[ai][bj][m][n], 0, 0, 0); __builtin_amdgcn_s_setprio(0); } while (0)
#define PG8_WAIT_V(n) asm volatile("s_waitcnt vmcnt(" #n ")" ::: "memory")
#define PG8_WAIT_L(n) asm volatile("s_waitcnt lgkmcnt(" #n ")" ::: "memory")
#define PG8_BAR __builtin_amdgcn_s_barrier()
#define PG8_SCHED __builtin_amdgcn_sched_barrier(0)
#define PG8_IDX_ISSUE(u, slot) __builtin_amdgcn_raw_ptr_buffer_load_lds(rsrc, (LAS void*)(idxlds + (slot) * 256 + (wid & 3) * 64), 4, lane * 4, \
        __builtin_amdgcn_readfirstlane((int)(S.idxoff + (unsigned)((u).rb + (wid & 3) * 64) * 4u)), 0, 0)
#define PG8_IDX_READ(dst, h_, slot, nv_) do { int _t = tid; asm volatile("" : "+v"(_t));   \
        _Pragma("unroll") for (int _i = 0; _i < 2; ++_i) { int _R, _C; stage_rc(_t * 16 + _i * 8192, _R, _C); \
        const int _ix = ((h_) * HALF + _R) < (nv_) ? idxlds[(slot) * 256 + (h_) * HALF + _R] : S.padrow;        \
        dst[_i] = (unsigned)_ix * (unsigned)(K * 2) + (unsigned)(_C * 2); } } while (0)
    Unit cur, nxt; int ui = 0;
    if (!S.next(0, cur)) return;
    f32x4 acc[2][2][4][2];
#pragma unroll
    for (int a = 0; a < 2; ++a)
#pragma unroll
        for (int b = 0; b < 2; ++b)
#pragma unroll
            for (int m = 0; m < 4; ++m)
#pragma unroll
                for (int n = 0; n < 2; ++n) acc[a][b][m][n] = (f32x4){0.f, 0.f, 0.f, 0.f};
    bf16x8 At[4][2], B0[2][2], B1[2][2];
    unsigned cA = cur.a, cB = cur.b;
    if constexpr (Sched::GATHER || Epi::ROWAUX) {
        PG8_IDX_ISSUE(cur, 0); PG8_WAIT_V(0); PG8_BAR;     asm volatile("" ::: "memory");
        if constexpr (Sched::GATHER) { PG8_IDX_READ(voffA[0], 0, 0, cur.nv); PG8_IDX_READ(voffA[1], 1, 0, cur.nv); }
    }
    if constexpr (SP2) {
        PG8_STAGE(PG8_SB(0, 0), cB, voffB); PG8_STAGE(PG8_SB(0, 1), cB + hstep, voffB); PG8_STAGE(PG8_SA(0, 0), cA, voffA[0]); PG8_STAGE(PG8_SA(0, 1), cA, voffA[1]);
        if (wr == 1) PG8_BAR;
        PG8_WAIT_V(2); PG8_BAR;
        PG8_STAGE(PG8_SB(1, 0), cB + kstep, voffB); PG8_STAGE(PG8_SA(1, 0), cA + kstep, voffA[0]); PG8_STAGE(PG8_SB(1, 1), cB + hstep + kstep, voffB);
        PG8_WAIT_V(6); PG8_BAR;
    } else {
        PG8_STAGE(PG8_SB(0, 0), cB, voffB); PG8_STAGE(PG8_SA(0, 0), cA, voffA[0]); PG8_STAGE(PG8_SB(0, 1), cB + hstep, voffB); PG8_STAGE(PG8_SA(0, 1), cA, voffA[1]);
        if (wr == 1) PG8_BAR;
        PG8_WAIT_V(4); PG8_BAR;
        PG8_STAGE(PG8_SB(1, 0), cB + kstep, voffB); PG8_STAGE(PG8_SA(1, 0), cA + kstep, voffA[0]); PG8_STAGE(PG8_SB(1, 1), cB + hstep + kstep, voffB);
        PG8_WAIT_V(6); PG8_BAR;
    }
    for (;;) {
        const bool has_next = S.next(ui + 1, nxt);
        const unsigned nA = has_next ? nxt.a : cA, nB = has_next ? nxt.b : cB;
        for (int t = 0; t < nt; t += 2) {
            const bool last = (t == nt - 2);
            const unsigned a1 = cA + (unsigned)(t + 1) * kstep;
            const unsigned a2 = last ? nA : cA + (unsigned)(t + 2) * kstep, b2 = last ? nB : cB + (unsigned)(t + 2) * kstep;
            const unsigned a3 = a2 + kstep, b3 = b2 + kstep;
            if constexpr (Sched::GATHER || Epi::ROWAUX) { if (t == 0 && has_next) PG8_IDX_ISSUE(nxt, (ui + 1) % 3); }
            if constexpr (Sched::GATHER) { if (last && has_next) PG8_IDX_READ(voffA[0], 0, (ui + 1) % 3, nxt.nv); }
#define PG8_NEXT_H1() do { if constexpr (Sched::GATHER) { if (last && has_next) PG8_IDX_READ(voffA[1], 1, (ui + 1) % 3, nxt.nv); } } while (0)
            if constexpr (SP2) {
            PG8_LDB(B0, 0, 0); PG8_LDB(B1, 0, 1); PG8_SCHED; PG8_LDA(At, 0, 0); PG8_STAGE(PG8_SA(1, 1), a1, voffA[1]); PG8_NEXT_H1();
            PG8_WAIT_V(8); PG8_WAIT_L(0); PG8_BAR; PG8_MMA(0, 0, At, B0); PG8_MMA(0, 1, At, B1); PG8_BAR; PG8_SCHED;
            PG8_LDA(At, 0, 1); PG8_STAGE(PG8_SB(0, 0), b2, voffB); PG8_STAGE(PG8_SB(0, 1), b2 + hstep, voffB); PG8_STAGE(PG8_SA(0, 0), a2, voffA[0]);
            PG8_WAIT_V(8); PG8_WAIT_L(0); PG8_BAR; PG8_MMA(1, 0, At, B0); PG8_MMA(1, 1, At, B1); PG8_BAR; PG8_SCHED;
            PG8_LDB(B0, 1, 0); PG8_LDB(B1, 1, 1); PG8_SCHED; PG8_LDA(At, 1, 0); PG8_STAGE(PG8_SA(0, 1), a2, voffA[1]);
            PG8_WAIT_V(8); PG8_WAIT_L(0); PG8_BAR; PG8_MMA(0, 0, At, B0); PG8_MMA(0, 1, At, B1); PG8_BAR; PG8_SCHED;
            PG8_LDA(At, 1, 1); PG8_STAGE(PG8_SB(1, 0), b3, voffB); PG8_STAGE(PG8_SB(1, 1), b3 + hstep, voffB); PG8_STAGE(PG8_SA(1, 0), a3, voffA[0]);
            PG8_WAIT_V(8); PG8_WAIT_L(0); PG8_BAR; PG8_MMA(1, 0, At, B0); PG8_MMA(1, 1, At, B1); PG8_BAR; PG8_SCHED;
            } else {
            PG8_LDB(B0, 0, 0); PG8_SCHED; PG8_LDA(At, 0, 0); PG8_STAGE(PG8_SA(1, 1), a1, voffA[1]); PG8_NEXT_H1();
            PG8_WAIT_L(8); PG8_BAR; PG8_WAIT_L(0); PG8_MMA(0, 0, At, B0); PG8_BAR; PG8_SCHED;
            PG8_LDB(B1, 0, 1); PG8_STAGE(PG8_SB(0, 0), b2, voffB);
            PG8_BAR; PG8_WAIT_L(0); PG8_MMA(0, 1, At, B1); PG8_BAR;
            PG8_LDA(At, 0, 1); PG8_STAGE(PG8_SA(0, 0), a2, voffA[0]);
            PG8_BAR; PG8_WAIT_L(0); PG8_MMA(1, 0, At, B0); PG8_BAR; PG8_SCHED;
            PG8_STAGE(PG8_SB(0, 1), b2 + hstep, voffB);
            PG8_WAIT_V(6); PG8_BAR; PG8_MMA(1, 1, At, B1); PG8_BAR;
            PG8_LDB(B0, 1, 0); PG8_SCHED; PG8_LDA(At, 1, 0); PG8_STAGE(PG8_SA(0, 1), a2, voffA[1]);
            PG8_WAIT_L(8); PG8_BAR; PG8_WAIT_L(0); PG8_MMA(0, 0, At, B0); PG8_BAR; PG8_SCHED;
            PG8_LDB(B1, 1, 1); PG8_STAGE(PG8_SB(1, 0), b3, voffB);
            PG8_BAR; PG8_WAIT_L(0); PG8_MMA(0, 1, At, B1); PG8_BAR;
            PG8_LDA(At, 1, 1); PG8_STAGE(PG8_SA(1, 0), a3, voffA[0]);
            PG8_BAR; PG8_WAIT_L(0); PG8_MMA(1, 0, At, B0); PG8_BAR; PG8_SCHED;
            PG8_STAGE(PG8_SB(1, 1), b3 + hstep, voffB);
            PG8_WAIT_V(6); PG8_BAR; PG8_MMA(1, 1, At, B1); PG8_BAR;
            }
        }
        if constexpr (ALIGN_EPI) { if (wr == 0) PG8_BAR; }
        if constexpr (Epi::ROWAUX) E(acc, cur, wr, wc, fr, fq, idxlds + (ui % 3) * 256); else E(acc, cur, wr, wc, fr, fq);
        if (!has_next) break;
#pragma unroll
        for (int a = 0; a < 2; ++a)
#pragma unroll
            for (int b = 0; b < 2; ++b)
#pragma unroll
                for (int m = 0; m < 4; ++m)
#pragma unroll
                    for (int n = 0; n < 2; ++n) acc[a][b][m][n] = (f32x4){0.f, 0.f, 0.f, 0.f};
        cur = nxt; cA = nA; cB = nB; ++ui;
        if constexpr (ALIGN_EPI) { if (wr == 1) PG8_BAR; }
    }
    PG8_WAIT_V(0);
    if constexpr (!ALIGN_EPI) { if (wr == 0) PG8_BAR; }
    PG8_BAR;
#undef PG8_SA
#undef PG8_SB
#undef PG8_STAGE
#undef PG8_LDA
#undef PG8_LDB
#undef PG8_MMA
#undef PG8_WAIT_V
#undef PG8_WAIT_L
#undef PG8_BAR
#undef PG8_SCHED
#undef PG8_IDX_ISSUE
#undef PG8_IDX_READ
#undef PG8_NEXT_H1
}
}
constexpr int T_ = 16384, D_ = 1024, NB_ = 4, S_ = 4096, NEXP = 64, TOPK = 8;
constexpr int ECAP = 16384;
constexpr int PMAX = 163840;
constexpr float LN_EPS = 1e-5f, RMS_EPS = 1e-6f;
constexpr float ALPHA_DN = 1.6817928305074290f;
constexpr float QSCALE = 0.125f * 1.4426950408889634f;

namespace pg8 {
constexpr int NXCD = 8, WGM = 8;
struct DenseOrder {
    static constexpr bool GATHER = false;
    unsigned A, Bt; int K; int nM, nN, nwg, G, c; unsigned idxoff; static constexpr int padrow = 0;
    DI void init(size_t A_, size_t Bt_, int M, int N, int K_, int G_, int c_) { A = (unsigned)A_; Bt = (unsigned)Bt_; K = K_; nM = M / BM; nN = N / BM; nwg = nM * nN; G = G_; c = c_; idxoff = 0u; }
    DI bool next(int i, Unit& u) const {
        const long L = (long)i * G + c; if (L >= nwg) return false;
        int wgid = (int)L; { const int q = nwg / NXCD, r = nwg % NXCD, xcd = wgid % NXCD, off = wgid / NXCD; wgid = (xcd < r ? xcd * (q + 1) : r * (q + 1) + (xcd - r) * q) + off; }
        const int nig = WGM * nN, gid = wgid / nig, fm = gid * WGM, gsz = (nM - fm) < WGM ? (nM - fm) : WGM;
        const int pm = fm + ((wgid % nig) % gsz), pn = (wgid % nig) / gsz;
        u.a = A + (unsigned)(pm * BM * K * 2); u.b = Bt + (unsigned)(pn * BM * K * 2); u.r0 = pm * BM; u.c0 = pn * BM; u.e = 0; u.rb = 0; u.nv = BM; return true;
    }
};
template <bool GATH> struct MoeOrder {
    static constexpr bool GATHER = GATH;
    unsigned A, Bt; int K; int nct_log, nunits, G, c; unsigned idxoff; const LAS int* tileoff; const LAS int* ecnt; unsigned bstride; static constexpr int padrow = T_;
    DI bool next(int i, Unit& u) const {
        const long L = (long)i * G + c; if (L >= nunits) return false;
        int wgid = (int)L; { const int q = nunits / NXCD, r = nunits % NXCD, xcd = wgid % NXCD, off = wgid / NXCD; wgid = (xcd < r ? xcd * (q + 1) : r * (q + 1) + (xcd - r) * q) + off; }
        const int tile = wgid >> nct_log, pn = wgid & ((1 << nct_log) - 1);
        int e = 0;
#pragma unroll 1
        for (int j = 32; j >= 1; j >>= 1) { const int cand = e + j; if (tileoff[cand] <= tile) e = cand; }
        if (e < NEXP && tileoff[e + 1] <= tile) e += 1;
        e = __builtin_amdgcn_readfirstlane(e);
        u.e = e; u.r0 = tile * BM; u.c0 = pn * BM;
        { const int ti = tile - __builtin_amdgcn_readfirstlane(tileoff[e]); u.rb = e * ECAP + ti * BM; u.nv = __builtin_amdgcn_readfirstlane(ecnt[e]) - ti * BM; }
        u.a = GATH ? A : A + (unsigned)(tile * BM * K * 2);
        u.b = Bt + (unsigned)e * bstride + (unsigned)(pn * BM * K * 2);
        return true;
    }
};

struct EpiF32 {
    static constexpr bool PERM = false, ROWAUX = false;
    float* C; int ldc;
    DI void operator()(const f32x4 (&acc)[2][2][4][2], const Unit& u, int wr, int wc, int fr, int fq) const {
        const int row0 = u.r0 + wr * 64 + fr, col0 = u.c0 + wc * 32 + 4 * fq;
#pragma unroll
        for (int ai = 0; ai < 2; ++ai)
#pragma unroll
            for (int m = 0; m < 4; ++m) { float* rowp = C + (size_t)(row0 + ai * HALF + m * 16) * ldc + col0;
#pragma unroll
                for (int bj = 0; bj < 2; ++bj)
#pragma unroll
                    for (int n = 0; n < 2; ++n) *(f32x4*)(rowp + bj * HALF + n * 16) = acc[ai][bj][m][n]; }
    }
};
struct EpiBf16 {
    static constexpr bool PERM = true, ROWAUX = false;
    bf16* O; int ldc;
    DI void operator()(const f32x4 (&acc)[2][2][4][2], const Unit& u, int wr, int wc, int fr, int fq) const {
        const int row0 = u.r0 + wr * 64 + fr, col0 = u.c0 + wc * 32 + 8 * fq;
#pragma unroll
        for (int ai = 0; ai < 2; ++ai)
#pragma unroll
            for (int m = 0; m < 4; ++m) { bf16* rowp = O + (size_t)(row0 + ai * HALF + m * 16) * ldc + col0;
#pragma unroll
                for (int bj = 0; bj < 2; ++bj) { const f32x4 v0 = acc[ai][bj][m][0], v1 = acc[ai][bj][m][1];
                    u32x4 w; w.x = cvtpk(v0[0], v0[1]); w.y = cvtpk(v0[2], v0[3]); w.z = cvtpk(v1[0], v1[1]); w.w = cvtpk(v1[2], v1[3]);
                    *(u32x4*)(rowp + bj * HALF) = w; } }
    }
};
struct EpiQKV {
    static constexpr bool PERM = true, ROWAUX = false;
    bf16* QKV; const float* COS; const float* SIN;
    DI void operator()(const f32x4 (&acc)[2][2][4][2], const Unit& u, int wr, int wc, int fr, int fq) const {
        const int pn = u.c0 >> 8, g = pn / 12, which = (pn >> 2) % 3, hq = pn & 3;
        const int ldil = 2 * g, dil = 1 << ldil;
        const int idx = 4 * (wc & 1) + fq, b = u.r0 >> 12;
        const int row0 = u.r0 + wr * 64 + fr;
#pragma unroll
        for (int ai = 0; ai < 2; ++ai)
#pragma unroll
            for (int m = 0; m < 4; ++m) {
                const int r = row0 + ai * HALF + m * 16, t = r & (S_ - 1);
                const int prow = (t & (dil - 1)) * (S_ >> ldil) + (t >> ldil);
                f32x4 c4 = (f32x4){1.f, 1.f, 1.f, 1.f}, s4 = (f32x4){0.f, 0.f, 0.f, 0.f};
                if (which < 2) { c4 = *(const f32x4*)(COS + (size_t)r * 32 + 4 * idx); s4 = *(const f32x4*)(SIN + (size_t)r * 32 + 4 * idx); }
#pragma unroll
                for (int bj = 0; bj < 2; ++bj) {
                    const int head = 4 * hq + 2 * bj + (wc >> 1);
                    const f32x4 v0 = acc[ai][bj][m][0], v1 = acc[ai][bj][m][1];
                    f32x4 o0 = v0 * c4 - v1 * s4, o1 = v1 * c4 + v0 * s4;
                    if (which == 0) { o0 = o0 * QSCALE; o1 = o1 * QSCALE; }
                    u32x4 w; w.x = cvtpk(o0[0], o0[1]); w.y = cvtpk(o0[2], o0[3]); w.z = cvtpk(o1[0], o1[1]); w.w = cvtpk(o1[2], o1[3]);
                    bf16* dst = QKV + ((((size_t)(which * 3 + g) * NB_ + b) * 16 + head) * S_ + prow) * 64 + 8 * idx;
                    *(u32x4*)dst = w;
                }
            }
    }
};
struct EpiSwiGLU {
    static constexpr bool PERM = true, ROWAUX = false;
    bf16* HID;
    DI void operator()(const f32x4 (&acc)[2][2][4][2], const Unit& u, int wr, int wc, int fr, int fq) const {
        const int row0 = u.r0 + wr * 64 + fr, col0 = (u.c0 >> 1) + wc * 32 + 8 * fq;
#pragma unroll
        for (int ai = 0; ai < 2; ++ai)
#pragma unroll
            for (int m = 0; m < 4; ++m) {
                float hv[8];
#pragma unroll
                for (int n = 0; n < 2; ++n)
#pragma unroll
                    for (int j = 0; j < 4; ++j) { const float a = acc[ai][0][m][n][j], bb = acc[ai][1][m][n][j]; hv[4 * n + j] = silu_f(a) * bb; }
                u32x4 w; w.x = cvtpk(hv[0], hv[1]); w.y = cvtpk(hv[2], hv[3]); w.z = cvtpk(hv[4], hv[5]); w.w = cvtpk(hv[6], hv[7]);
                *(u32x4*)(HID + (size_t)(row0 + ai * HALF + m * 16) * 256 + col0) = w;
            }
    }
};
constexpr size_t YS_OFF = (size_t)160 << 20;
struct EpiScale {
    static constexpr bool PERM = true, ROWAUX = true;
    unsigned char* YE;
    int s0;
    DI void operator()(const f32x4 (&acc)[2][2][4][2], const Unit& u, int wr, int wc, int fr, int fq, const LAS int* aux) const {
        const int row0 = wr * 64 + fr, col0 = u.c0 + wc * 32 + 8 * fq;
        if (u.e == NEXP) {
            bf16* base = (bf16*)pg8::rfl_ptr((const char*)(YE + YS_OFF) + (size_t)(u.r0 - s0) * (D_ * 2));
#pragma unroll
            for (int ai = 0; ai < 2; ++ai)
#pragma unroll
                for (int m = 0; m < 4; ++m) { const unsigned ro = (unsigned)((row0 + ai * HALF + m * 16) * D_ + col0) * 2u;
#pragma unroll
                    for (int bj = 0; bj < 2; ++bj) { const f32x4 v0 = acc[ai][bj][m][0], v1 = acc[ai][bj][m][1];
                        u32x4 w; w.x = cvtpk(v0[0], v0[1]); w.y = cvtpk(v0[2], v0[3]); w.z = cvtpk(v1[0], v1[1]); w.w = cvtpk(v1[2], v1[3]);
                        *(u32x4*)((char*)base + ro + bj * HALF * 2) = w; } }
        } else {
            unsigned char* base = (unsigned char*)pg8::rfl_ptr((const char*)YE + (size_t)u.r0 * D_);
#pragma unroll
            for (int ai = 0; ai < 2; ++ai)
#pragma unroll
                for (int m = 0; m < 4; ++m) { const int rl = row0 + ai * HALF + m * 16; const float wgt = __builtin_bit_cast(float, aux[rl]) * YE_SCALE; const unsigned ro = (unsigned)(rl * D_ + col0);
#pragma unroll
                    for (int bj = 0; bj < 2; ++bj) { const f32x4 v0 = acc[ai][bj][m][0] * wgt, v1 = acc[ai][bj][m][1] * wgt;
                        u32x2 w; w.x = cvtpk_fp8(v0[0], v0[1], v0[2], v0[3]); w.y = cvtpk_fp8(v1[0], v1[1], v1[2], v1[3]);
                        *(u32x2*)(base + ro + bj * HALF) = w; } }
        }
    }
};
}
constexpr size_t MiB = 1u << 20;
constexpr size_t WS_CTL = 0, CTL_ZERO_BYTES = 128 * 1024;
constexpr size_t WS_MOD = 1 * MiB;
constexpr size_t WS_COS = 2 * MiB;
constexpr size_t WS_SIN = 4 * MiB;
constexpr size_t WS_ASG_E = 6 * MiB;
constexpr size_t WS_ASG_R = 6 * MiB + 512 * 1024;
constexpr size_t WS_ASG_W = 7 * MiB;
constexpr size_t WS_ASG_ROW = 7 * MiB + 512 * 1024;
constexpr size_t WS_ROWTOK = 8 * MiB;
constexpr size_t WS_ROWW = 9 * MiB;
constexpr size_t WS_AB = 10 * MiB;
constexpr size_t WS_GALPHA = 11 * MiB;
constexpr size_t WS_GBETA = 11 * MiB + 512 * 1024;
constexpr size_t WS_X = 12 * MiB;
constexpr size_t WS_Y = 76 * MiB;
constexpr size_t WS_H = 140 * MiB;
constexpr size_t WS_O = 173 * MiB;
constexpr size_t WS_WA_IN = 205 * MiB;
constexpr size_t WS_WA_OUT = 241 * MiB;
constexpr size_t WS_WG_IN = 245 * MiB;
constexpr size_t WS_WG_OUT = 261 * MiB;
constexpr size_t WS_WE1 = 265 * MiB;
constexpr size_t WS_WE2 = 330 * MiB;
constexpr size_t WS_HID = 363 * MiB;
constexpr size_t WS_BIG = 443 * MiB;
constexpr size_t WS_YS_OFF = pg8::YS_OFF;
constexpr size_t WS_WEB = WS_BIG + 368 * MiB;
constexpr size_t WS_WRF = WS_BIG + 466 * MiB;
constexpr size_t WS_WABF = WS_WRF + 1 * MiB;
constexpr size_t WS_ETOK = WS_WABF + 1 * MiB;
constexpr size_t WS_EW = WS_ETOK + 5 * MiB;
constexpr size_t WS_END = WS_EW + 5 * MiB;
constexpr size_t BIG_PROJ = 0, BIG_QN = 128 * MiB, BIG_KN = 192 * MiB, BIG_VV = 256 * MiB, BIG_ORAW = 320 * MiB;
constexpr int CW_BAR = 4096;
constexpr int CW_CNT = 16384;
constexpr int RING_BYTES = 131072;
constexpr int LDS_IDX = RING_BYTES;
constexpr int LDS_TILEOFF = LDS_IDX + 3072;
constexpr int LDS_LCNT = LDS_TILEOFF + 512;
constexpr int LDS_LBASE = LDS_LCNT + 256;
constexpr int LDS_LASG = LDS_LBASE + 256;
constexpr int LDS_ECNT = LDS_LASG;
constexpr int LDS_LW = LDS_IDX;
constexpr int LDS_MISC = LDS_LASG + 2048;
constexpr int LDS_LG = LDS_MISC + 128;
constexpr int LDS_BYTES = 147456;
static_assert(LDS_LG + 8192 <= LDS_BYTES, "LDS map");
constexpr int NWAVES = 8, NTHR = 512;

#define XB_TMO      128
#define XB_XCNT(j)  (256  + 64 * (j))
#define XB_XSUB(j)  (1280 + 64 * (j))
#define XB_XGEN(j)  (2304 + 64 * (j))
#define XB_TOP      3328
#define XB_TOPGEN   3392
#define XCD_BAR_WORDS 3456
#define XB_SPIN_CAP (1u << 18)
__device__ __forceinline__ unsigned xb_ld(unsigned* p)              { return __hip_atomic_load(p, __ATOMIC_RELAXED, __HIP_MEMORY_SCOPE_AGENT); }
__device__ __forceinline__ unsigned xb_add(unsigned* p, unsigned v) { return __hip_atomic_fetch_add(p, v, __ATOMIC_RELAXED, __HIP_MEMORY_SCOPE_AGENT); }
__device__ __forceinline__ unsigned xb_xcc_id() { return (unsigned)__builtin_amdgcn_s_getreg((3 << 11) | 20) & 0xFu; }
#define XB_SPIN(cond, bar) do { unsigned _sp = 0; while (cond) { __builtin_amdgcn_s_sleep(1); \
    if ((++_sp & 255u) == 0u) { if (xb_ld(&(bar)[XB_TMO])) break; if (_sp > XB_SPIN_CAP) { atomicAdd(&(bar)[XB_TMO], 1u); break; } } } } while (0)
struct XcdBarrier { unsigned* bar; unsigned x; volatile LAS unsigned* st; };
__device__ __forceinline__ XcdBarrier xcd_barrier_post(unsigned* bar, volatile LAS unsigned* st) {
    XcdBarrier b; b.bar = bar; b.x = xb_xcc_id(); b.st = st;
    if (threadIdx.x == 0) (void)xb_add(&bar[XB_XCNT(b.x)], 1u);
    return b;
}
__device__ __forceinline__ void xcd_barrier_complete(unsigned* bar, unsigned x, unsigned& nloc, unsigned& nx) {
    const unsigned G = gridDim.x * gridDim.y * gridDim.z;
    unsigned sum, cnt, mine, sp = 0u;
    for (;;) {
        sum = 0u; cnt = 0u; mine = 0u;
#pragma unroll
        for (unsigned j = 0; j < 16; ++j) { const unsigned c = xb_ld(&bar[XB_XCNT(j)]); sum += c; cnt += (c > 0u) ? 1u : 0u; mine = (j == x) ? c : mine; }
        if (sum == G) break;
        __builtin_amdgcn_s_sleep(1);
        if ((++sp & 255u) == 0u) { if (xb_ld(&bar[XB_TMO])) break; if (sp > XB_SPIN_CAP) { atomicAdd(&bar[XB_TMO], 1u); break; } }
    }
    nloc = mine > 0u ? mine : 1u; nx = cnt > 0u ? cnt : 1u;
}
__device__ __forceinline__ void xcd_barrier(const XcdBarrier& b, const int tid) {
    asm volatile("s_waitcnt vmcnt(0)" ::: "memory");
    __syncthreads();
    if (tid == 0) {
        unsigned* bar = b.bar;
        __builtin_amdgcn_s_waitcnt(0);
        unsigned nloc = b.st[0], nx = b.st[1];
        if (nloc == 0u) { xcd_barrier_complete(bar, b.x, nloc, nx); b.st[0] = nloc; b.st[1] = nx; }
        const unsigned old = xb_add(&bar[XB_XSUB(b.x)], 1u);
        const unsigned gen = old / nloc;
        if (old + 1u == (gen + 1u) * nloc) {
            __builtin_amdgcn_fence(__ATOMIC_RELEASE, "agent");
            asm volatile("s_waitcnt vmcnt(0)" ::: "memory");
            const unsigned og = xb_add(&bar[XB_TOP], 1u);
            const unsigned tg = og / nx;
            if (og + 1u == (tg + 1u) * nx) xb_add(&bar[XB_TOPGEN], 1u);
            else XB_SPIN(xb_ld(&bar[XB_TOPGEN]) == tg, bar);
            __builtin_amdgcn_fence(__ATOMIC_ACQUIRE, "agent");
            xb_add(&bar[XB_XGEN(b.x)], 1u);
            asm volatile("s_waitcnt vmcnt(0)" ::: "memory");
        } else {
            XB_SPIN(xb_ld(&bar[XB_XGEN(b.x)]) == gen, bar);
            __builtin_amdgcn_fence(__ATOMIC_ACQUIRE, "agent");
            asm volatile("s_waitcnt vmcnt(0)" ::: "memory");
        }
    }
    __syncthreads();
}

struct Args {
    const float* x; const float* c; const int* pos; const float* ada_w; const float* ada_b; const float* ln_g; const float* ln_b;
    const float* attn_w_in; const float* attn_w_out; const float* gdn_w_in; const float* gdn_conv_w; const float* gdn_a_log; const float* gdn_dt_bias;
    const float* gdn_norm_w; const float* gdn_w_out; const float* router_w; const float* router_bias; const float* ew1; const float* ew3; const float* ew2;
    const float* sw1; const float* sw3; const float* sw2;
    float* out; unsigned char* ws; int ph_lo, ph_hi;
};
typedef __attribute__((address_space(1))) unsigned char gas_u8;
DI unsigned char* opq(unsigned char* p) { gas_u8* g = (gas_u8*)p; asm volatile("" : "+s"(g)); return (unsigned char*)g; }
template <class T> DI T* asg(T* p) { typedef __attribute__((address_space(1))) T gT; return (T*)(gT*)p; }
struct Frame {
    LAS unsigned char* lds;
    int tid, lane, wave, G, bid;
};
template <class Map> DI void transpose_item(const float* W, int ldn, int K, bf16* WT, const Map& map, LAS float* scr, int kb, int nb, int lane) {
    const int k0 = 64 * kb, n0 = 32 * nb;
    float tv[32];
#pragma unroll
    for (int i = 0; i < 32; ++i) tv[i] = __builtin_nontemporal_load(&W[(size_t)(k0 + 2 * i + (lane >> 5)) * ldn + n0 + (lane & 31)]);
#pragma unroll
    for (int i = 0; i < 32; ++i) scr[(2 * i + (lane >> 5)) * 33 + (lane & 31)] = tv[i];
    LDS_WAIT(); asm volatile("" ::: "memory");
    const int c = lane & 7;
#pragma unroll
    for (int j = 0; j < 4; ++j) { const int n = (lane >> 3) + 8 * j; const LAS float* s = scr + (8 * c) * 33 + n;
        u32x4 o; o.x = cvtpk(s[0 * 33], s[1 * 33]); o.y = cvtpk(s[2 * 33], s[3 * 33]); o.z = cvtpk(s[4 * 33], s[5 * 33]); o.w = cvtpk(s[6 * 33], s[7 * 33]);
        __builtin_nontemporal_store(o, (u32x4*)(WT + (size_t)map(n0 + n) * K + k0 + 8 * c)); }
    LDS_WAIT(); asm volatile("" ::: "memory");
}
struct MapId { int off; DI int operator()(int n) const { return off + n; } };
struct MapQKV { DI int operator()(int n) const {
    const int which = (n >> 10) % 3; if (which == 2) return n;
    const int d = n & 63, idx = (d & 31) >> 2, lo = d & 3, hi = d >> 5; return (n & ~63) + 8 * idx + 4 * hi + lo; } };
struct MapW13 { int second; DI int operator()(int n) const { return (n >> 7) * 256 + second * 128 + (n & 127); } };
template <class Map> DI void convert_matrix(const Frame& F, const float* W, int ldn, int K, int N, bf16* WT, const Map& map) {
    LAS float* scr = (LAS float*)(F.lds + F.wave * 16384);
    const int gw = F.bid * NWAVES + F.wave, NGW = F.G * NWAVES, nblk = N / 32, nitems = (K / 64) * nblk;
    for (int it = gw; it < nitems; it += NGW) transpose_item(W, ldn, K, WT, map, scr, it / nblk, it % nblk, F.lane);
}

DI void prologue_phase(const Frame& F, const Args& A) {
    unsigned char* ws = opq(A.ws);
    {
        LAS float* red = (LAS float*)F.lds;
        float* MOD = (float*)(ws + WS_MOD);
        for (int item = F.bid; item < 8 * 48; item += F.G) {
            const int ls = item / 48, n = (item % 48) * 64 + F.lane;
            const float* w = A.ada_w + ((size_t)ls * D_ + F.wave * 128) * 3072 + n;
            const float* cc = A.c + F.wave * 128;
            float a0 = 0.f, a1 = 0.f, a2 = 0.f, a3 = 0.f;
#pragma unroll 32
            for (int k = 0; k < 128; ++k) { const float wv = __builtin_nontemporal_load(&w[(size_t)k * 3072]);        a0 += cc[k] * wv; a1 += cc[D_ + k] * wv; a2 += cc[2 * D_ + k] * wv; a3 += cc[3 * D_ + k] * wv; }
            red[(F.wave * 4 + 0) * 64 + F.lane] = a0; red[(F.wave * 4 + 1) * 64 + F.lane] = a1; red[(F.wave * 4 + 2) * 64 + F.lane] = a2; red[(F.wave * 4 + 3) * 64 + F.lane] = a3;
            __syncthreads();
            if (F.wave < 4) { float s = A.ada_b[ls * 3072 + n];
#pragma unroll
                for (int w8 = 0; w8 < 8; ++w8) s += red[(w8 * 4 + F.wave) * 64 + F.lane];
                MOD[((size_t)ls * 4 + F.wave) * 3072 + n] = s; }
            __syncthreads();
        }
    }
    {
        float* COS = (float*)(ws + WS_COS); float* SIN = (float*)(ws + WS_SIN);
        for (int idx = F.bid * NTHR + F.tid; idx < T_ * 32; idx += F.G * NTHR) {
            const int t = idx >> 5, i = idx & 31;
            const float inv = powf(10000.0f, -(float)i / 32.0f);
            const float ang = (float)A.pos[t] * inv;
            COS[idx] = cosf(ang); SIN[idx] = sinf(ang);
        }
    }
    {
        bf16* WRF = (bf16*)(ws + WS_WRF); bf16* WABF = (bf16*)(ws + WS_WABF);
        for (int idx = F.bid * NTHR + F.tid; idx < 4 * 4 * 32 * 64 * 8; idx += F.G * NTHR) {
            const int jx = idx & 7, ln = (idx >> 3) & 63, ks = (idx >> 9) & 31, nt = (idx >> 14) & 3, layer = idx >> 16;
            const int d = 32 * ks + 8 * (ln >> 4) + jx, e = 16 * nt + (ln & 15);
            const float wv = A.router_w[((size_t)layer * D_ + d) * NEXP + e];
            const unsigned hi = cvtpk(wv, 0.f) & 0xffffu; const float res = wv - bf_lo(hi);
            const size_t o = (size_t)layer * 2 * 65536 + (idx & 65535);
            WRF[o] = (bf16)hi; WRF[o + 65536] = (bf16)(cvtpk(res, 0.f) & 0xffffu);
        }
        for (int idx = F.bid * NTHR + F.tid; idx < 2 * 32 * 64 * 8; idx += F.G * NTHR) {
            const int jx = idx & 7, ln = (idx >> 3) & 63, ks = (idx >> 9) & 31, jl = idx >> 14;
            const int d = 32 * ks + 8 * (ln >> 4) + jx, e = ln & 15;
            const float wv = A.gdn_w_in[((size_t)jl * D_ + d) * 4112 + 4096 + e];
            const unsigned hi = cvtpk(wv, 0.f) & 0xffffu; const float res = wv - bf_lo(hi);
            const size_t o = (size_t)jl * 2 * 16384 + (idx & 16383);
            WABF[o] = (bf16)hi; WABF[o + 16384] = (bf16)(cvtpk(res, 0.f) & 0xffffu);
        }
    }
    if (F.bid == 0) { bf16* H = (bf16*)(ws + WS_H); for (int cidx = F.tid; cidx < D_; cidx += NTHR) H[(size_t)T_ * D_ + cidx] = 0; }
    for (int j = 0; j < 2; ++j) {
        convert_matrix(F, A.attn_w_in + (size_t)j * D_ * 9216, 9216, D_, 9216, (bf16*)(ws + WS_WA_IN) + (size_t)j * 9216 * D_, MapQKV{});
        convert_matrix(F, A.attn_w_out + (size_t)j * D_ * D_, D_, D_, D_, (bf16*)(ws + WS_WA_OUT) + (size_t)j * D_ * D_, MapId{0});
        convert_matrix(F, A.gdn_w_in + (size_t)j * D_ * 4112, 4112, D_, 4096, (bf16*)(ws + WS_WG_IN) + (size_t)j * 4096 * D_, MapId{0});
        convert_matrix(F, A.gdn_w_out + (size_t)j * D_ * D_, D_, D_, D_, (bf16*)(ws + WS_WG_OUT) + (size_t)j * D_ * D_, MapId{0});
    }
}
struct XItem { const float* src; bf16* dst; int ldn, K, mode, n0; };
DI XItem xi_decode(const Args& A, int layer, bf16* WE1, bf16* WE2, int it) {
    constexpr int I13 = (D_ / 64) * (256 / 32), I2 = (256 / 64) * (D_ / 32), IPE = 2 * I13 + I2;
    const int e = it / IPE; int r = it % IPE; XItem x;
    if (r < 2 * I13) { const int second = r >= I13 ? 1 : 0; r -= second * I13; const int kb = r >> 3, nb = r & 7;
        const float* w = second ? (e < 64 ? A.ew3 + ((size_t)layer * 64 + e) * D_ * 256 : A.sw3 + (size_t)layer * D_ * 256) : (e < 64 ? A.ew1 + ((size_t)layer * 64 + e) * D_ * 256 : A.sw1 + (size_t)layer * D_ * 256);
        x.src = w + (size_t)(64 * kb) * 256 + 32 * nb; x.ldn = 256; x.K = D_; x.mode = 1 + second; x.n0 = 32 * nb; x.dst = WE1 + (size_t)e * 512 * D_ + 64 * kb;
    } else { r -= 2 * I13; const int kb = r >> 5, nb = r & 31;
        const float* w = e < 64 ? A.ew2 + ((size_t)layer * 64 + e) * 256 * D_ : A.sw2 + (size_t)layer * 256 * D_;
        x.src = w + (size_t)(64 * kb) * D_ + 32 * nb; x.ldn = D_; x.K = 256; x.mode = 0; x.n0 = 32 * nb; x.dst = WE2 + (size_t)e * D_ * 256 + 64 * kb; }
    return x;
}
#define XI_LOAD(buf, XT) do { const char* _b = pg8::rfl_ptr((const char*)(XT).src); const unsigned _ro = (unsigned)((XT).ldn * 4); \
    _Pragma("unroll") for (int _i = 0; _i < 8; ++_i) buf[_i] = __builtin_nontemporal_load((const f32x4*)(_b + ((unsigned)(8 * _i + (lane >> 3)) * _ro + (unsigned)(lane & 7) * 16u))); } while (0)
#define XI_PUT(buf, XT) do { \
    _Pragma("unroll") for (int _i = 0; _i < 8; ++_i) _Pragma("unroll") for (int _e = 0; _e < 4; ++_e) scr[(8 * _i + (lane >> 3)) * 33 + 4 * (lane & 7) + _e] = buf[_i][_e]; \
    LDS_WAIT(); asm volatile("" ::: "memory"); \
    const int _c = lane & 7; \
    _Pragma("unroll") for (int _j = 0; _j < 4; ++_j) { const int _n = (XT).n0 + (lane >> 3) + 8 * _j; const LAS float* _s = scr + (8 * _c) * 33 + (lane >> 3) + 8 * _j; \
        const int _row = (XT).mode == 0 ? _n : (_n >> 7) * 256 + ((XT).mode - 1) * 128 + (_n & 127); \
        u32x4 _o; _o.x = cvtpk(_s[0 * 33], _s[1 * 33]); _o.y = cvtpk(_s[2 * 33], _s[3 * 33]); _o.z = cvtpk(_s[4 * 33], _s[5 * 33]); _o.w = cvtpk(_s[6 * 33], _s[7 * 33]); \
        __builtin_nontemporal_store(_o, (u32x4*)((XT).dst + (size_t)_row * (XT).K + 8 * _c)); } \
    LDS_WAIT(); asm volatile("" ::: "memory"); } while (0)
DI void convert_experts(const Frame& F, const Args& A, int layer, int set, int wg0, int nwg) {
    if (F.bid < wg0 || F.bid >= wg0 + nwg) return;
    unsigned char* ws = opq(A.ws);
    LAS float* scr = (LAS float*)(F.lds + F.wave * 16384);
    bf16* WE1 = (bf16*)(ws + (set ? WS_WEB : WS_WE1)); bf16* WE2 = (bf16*)(ws + (set ? WS_WEB + 65 * MiB : WS_WE2));
    const int gw = (F.bid - wg0) * NWAVES + F.wave, NGW = nwg * NWAVES, lane = F.lane;
    constexpr int NIT = 65 * 384;
    f32x4 ba[8], bb[8];
    int it = gw;
    if (it >= NIT) return;
    XItem xa = xi_decode(A, layer, WE1, WE2, it), xb = xa;
    XI_LOAD(ba, xa);
#pragma unroll 1
    for (;;) {
        const bool hb = it + NGW < NIT;
        if (hb) { xb = xi_decode(A, layer, WE1, WE2, it + NGW); XI_LOAD(bb, xb); }
        __builtin_amdgcn_sched_barrier(0);
        XI_PUT(ba, xa);
        if (!hb) break;
        it += NGW;
        const bool ha = it + NGW < NIT;
        if (ha) { xa = xi_decode(A, layer, WE1, WE2, it + NGW); XI_LOAD(ba, xa); }
        __builtin_amdgcn_sched_barrier(0);
        XI_PUT(bb, xb);
        if (!ha) break;
        it += NGW;
    }
}
#undef XI_LOAD
#undef XI_PUT

DI void load_row16(const float* p, int lane, f32x4 (&v)[4]) {
#pragma unroll
    for (int j = 0; j < 4; ++j) v[j] = *(const f32x4*)(p + 4 * lane + 256 * j);
}
DI void store_row16(float* p, int lane, const f32x4 (&v)[4]) {
#pragma unroll
    for (int j = 0; j < 4; ++j) *(f32x4*)(p + 4 * lane + 256 * j) = v[j];
}
DI void store_row16_bf16(bf16* p, int lane, const f32x4 (&v)[4]) {
#pragma unroll
    for (int j = 0; j < 4; ++j) { u32x2 w; w.x = cvtpk(v[j][0], v[j][1]); w.y = cvtpk(v[j][2], v[j][3]); *(u32x2*)(p + 4 * lane + 256 * j) = w; }
}
DI void add_row16_bf16(const bf16* p, int lane, f32x4 (&v)[4]) {
#pragma unroll
    for (int j = 0; j < 4; ++j) { const u32x2 w = *(const u32x2*)(p + 4 * lane + 256 * j); v[j][0] += bf_lo(w.x); v[j][1] += bf_hi(w.x); v[j][2] += bf_lo(w.y); v[j][3] += bf_hi(w.y); }
}
DI void add_row16_fp8(const unsigned char* p, int lane, f32x4 (&v)[4]) {
#pragma unroll
    for (int j = 0; j < 4; ++j) { const int w = *(const int*)(p + 4 * lane + 256 * j);
        const f32x2 a = __builtin_amdgcn_cvt_pk_f32_fp8(w, false), b = __builtin_amdgcn_cvt_pk_f32_fp8(w, true);
        v[j][0] += a[0]; v[j][1] += a[1]; v[j][2] += b[0]; v[j][3] += b[1]; }
}
DI void layer_norm16(f32x4 (&v)[4], const f32x4 (&g)[4], const f32x4 (&b)[4]) {
    float s = 0.f;
#pragma unroll
    for (int j = 0; j < 4; ++j) s += (v[j][0] + v[j][1]) + (v[j][2] + v[j][3]);
    const float mean = wave_sum(s) * (1.0f / D_);
    float q = 0.f;
#pragma unroll
    for (int j = 0; j < 4; ++j) { v[j] = v[j] - mean; q += (v[j][0] * v[j][0] + v[j][1] * v[j][1]) + (v[j][2] * v[j][2] + v[j][3] * v[j][3]); }
    const float rstd = 1.0f / sqrtf(wave_sum(q) * (1.0f / D_) + LN_EPS);
#pragma unroll
    for (int j = 0; j < 4; ++j) v[j] = v[j] * rstd * g[j] + b[j];
}

DI void modx_phase(const Frame& F, const Args& A) {
    unsigned char* ws = opq(A.ws);
    const float* MOD = (const float*)(ws + WS_MOD); bf16* H = (bf16*)(ws + WS_H);
    const int gw = F.bid * NWAVES + F.wave, NGW = F.G * NWAVES;
    for (int row = gw; row < T_; row += NGW) {
        const int b = row >> 12; f32x4 v[4], sc[4], sh[4];
        load_row16(A.x + (size_t)row * D_, F.lane, v); load_row16(MOD + (size_t)(0 * 4 + b) * 3072 + 1024, F.lane, sc); load_row16(MOD + (size_t)(0 * 4 + b) * 3072, F.lane, sh);
#pragma unroll
        for (int j = 0; j < 4; ++j) v[j] = v[j] * (1.0f + sc[j]) + sh[j];
        store_row16_bf16(H + (size_t)row * D_, F.lane, v);
    }
}

DI void build_tileoff(const Frame& F, const unsigned* gcount) {
    LAS int* tileoff = (LAS int*)(F.lds + LDS_TILEOFF);
    __syncthreads();
    if (F.wave == 0) {
        const unsigned cn = __hip_atomic_load(gcount + F.lane, __ATOMIC_RELAXED, __HIP_MEMORY_SCOPE_AGENT);
        const int nt = (int)((cn + 255u) >> 8); int inc = nt;
#pragma unroll
        for (int o = 1; o < 64; o <<= 1) { const int t = __builtin_amdgcn_ds_bpermute((F.lane - o) << 2, inc); if (F.lane >= o) inc += t; }
        tileoff[F.lane] = inc - nt; ((LAS int*)(F.lds + LDS_ECNT))[F.lane] = (int)cn;
        if (F.lane == 63) { tileoff[64] = inc; tileoff[65] = inc + T_ / 256; ((LAS int*)(F.lds + LDS_ECNT))[NEXP] = T_; }
    }
    __syncthreads();
}

DI void deepnorm_row(f32x4 (&v)[4], const f32x4 (&y)[4], const float* gate, const float* lng, const float* lnb, float* xout, const float* mod_shift, int lane) {
    f32x4 t[4];
    load_row16(gate, lane, t);
#pragma unroll
    for (int j = 0; j < 4; ++j) v[j] = ALPHA_DN * v[j] + (1.0f + t[j]) * y[j];
    float s = 0.f;
#pragma unroll
    for (int j = 0; j < 4; ++j) s += (v[j][0] + v[j][1]) + (v[j][2] + v[j][3]);
    const float mean = wave_sum(s) * (1.0f / D_);
    float q = 0.f;
#pragma unroll
    for (int j = 0; j < 4; ++j) { v[j] = v[j] - mean; q += (v[j][0] * v[j][0] + v[j][1] * v[j][1]) + (v[j][2] * v[j][2] + v[j][3] * v[j][3]); }
    const float rstd = 1.0f / sqrtf(wave_sum(q) * (1.0f / D_) + LN_EPS);
    load_row16(lng, lane, t);
#pragma unroll
    for (int j = 0; j < 4; ++j) v[j] = v[j] * rstd * t[j];
    load_row16(lnb, lane, t);
#pragma unroll
    for (int j = 0; j < 4; ++j) v[j] = v[j] + t[j];
    store_row16(xout, lane, v);
    if (mod_shift) {
        load_row16(mod_shift + 1024, lane, t);
#pragma unroll
        for (int j = 0; j < 4; ++j) v[j] = v[j] * (1.0f + t[j]);
        load_row16(mod_shift, lane, t);
#pragma unroll
        for (int j = 0; j < 4; ++j) v[j] = v[j] + t[j];
    }
}
DI void put_hilo(LAS unsigned char* lds, int p, int lane, const f32x4 (&v)[4]) {
#pragma unroll
    for (int j = 0; j < 4; ++j) {
        const int c = 4 * lane + 256 * j;
        const unsigned h0 = cvtpk(v[j][0], v[j][1]), h1 = cvtpk(v[j][2], v[j][3]);
        const unsigned l0 = cvtpk(v[j][0] - bf_lo(h0), v[j][1] - bf_hi(h0)), l1 = cvtpk(v[j][2] - bf_lo(h1), v[j][3] - bf_hi(h1));
        const int off = ((((p >> 4) * 32 + (c >> 5)) * 64 + ((c & 31) >> 3) * 16 + (p & 15)) * 16) + (c & 7) * 2;
        *(LAS u32x2*)(lds + off) = (u32x2){h0, h1}; *(LAS u32x2*)(lds + 65536 + off) = (u32x2){l0, l1};
    }
}
DI f32x4 small_proj(const LAS unsigned char* lds, int mt, int lane, const bf16* wf_hi, const bf16* wf_lo) {
    f32x4 a0 = (f32x4){0.f, 0.f, 0.f, 0.f}, a1 = a0, a2 = a0;
#pragma unroll 8
    for (int ks = 0; ks < 32; ++ks) {
        const bf16x8 ah = *(const LAS bf16x8*)(lds + ((mt * 32 + ks) * 64 + lane) * 16), al = *(const LAS bf16x8*)(lds + 65536 + ((mt * 32 + ks) * 64 + lane) * 16);
        const bf16x8 bh = *(const bf16x8*)(wf_hi + (ks * 64 + lane) * 8), bl = *(const bf16x8*)(wf_lo + (ks * 64 + lane) * 8);
        a0 = __builtin_amdgcn_mfma_f32_16x16x32_bf16(ah, bh, a0, 0, 0, 0); a1 = __builtin_amdgcn_mfma_f32_16x16x32_bf16(ah, bl, a1, 0, 0, 0); a2 = __builtin_amdgcn_mfma_f32_16x16x32_bf16(al, bh, a2, 0, 0, 0);
    }
    return a0 + (a1 + a2);
}
DI f32x4 small_proj_range(const LAS unsigned char* lds, int mt, int k0, int nk, int lane, const bf16* wf_hi, const bf16* wf_lo) {
    f32x4 a0 = (f32x4){0.f, 0.f, 0.f, 0.f}, a1 = a0, a2 = a0;
#pragma unroll 8
    for (int k = 0; k < nk; ++k) { const int ks = k0 + k;
        const bf16x8 ah = *(const LAS bf16x8*)(lds + ((mt * 32 + ks) * 64 + lane) * 16), al = *(const LAS bf16x8*)(lds + 65536 + ((mt * 32 + ks) * 64 + lane) * 16);
        const bf16x8 bh = *(const bf16x8*)(wf_hi + (ks * 64 + lane) * 8), bl = *(const bf16x8*)(wf_lo + (ks * 64 + lane) * 8);
        a0 = __builtin_amdgcn_mfma_f32_16x16x32_bf16(ah, bh, a0, 0, 0, 0); a1 = __builtin_amdgcn_mfma_f32_16x16x32_bf16(ah, bl, a1, 0, 0, 0); a2 = __builtin_amdgcn_mfma_f32_16x16x32_bf16(al, bh, a2, 0, 0, 0);
    }
    return a0 + (a1 + a2);
}
DI void small_proj2(const LAS unsigned char* lds, int kh, int lane, const bf16* wf_hi, const bf16* wf_lo, f32x4& o0, f32x4& o1) {
    f32x4 a[2][3];
#pragma unroll
    for (int mt = 0; mt < 2; ++mt)
#pragma unroll
        for (int e = 0; e < 3; ++e) a[mt][e] = (f32x4){0.f, 0.f, 0.f, 0.f};
#pragma unroll 8
    for (int k = 0; k < 16; ++k) {
        const int ks = 16 * kh + k;
        const bf16x8 bh = *(const bf16x8*)(wf_hi + (ks * 64 + lane) * 8), bl = *(const bf16x8*)(wf_lo + (ks * 64 + lane) * 8);
#pragma unroll
        for (int mt = 0; mt < 2; ++mt) {
            const bf16x8 ah = *(const LAS bf16x8*)(lds + ((mt * 32 + ks) * 64 + lane) * 16), al = *(const LAS bf16x8*)(lds + 65536 + ((mt * 32 + ks) * 64 + lane) * 16);
            a[mt][0] = __builtin_amdgcn_mfma_f32_16x16x32_bf16(ah, bh, a[mt][0], 0, 0, 0); a[mt][1] = __builtin_amdgcn_mfma_f32_16x16x32_bf16(ah, bl, a[mt][1], 0, 0, 0); a[mt][2] = __builtin_amdgcn_mfma_f32_16x16x32_bf16(al, bh, a[mt][2], 0, 0, 0);
        }
    }
    o0 = a[0][0] + (a[0][1] + a[0][2]); o1 = a[1][0] + (a[1][1] + a[1][2]);
}
DI void deepnorm_row_c(f32x4 (&v)[4], const f32x4 (&y)[4], const f32x4 (&cg)[4], const f32x4 (&cng)[4], const f32x4 (&cnb)[4]) {
#pragma unroll
    for (int j = 0; j < 4; ++j) v[j] = ALPHA_DN * v[j] + cg[j] * y[j];
    float s = 0.f;
#pragma unroll
    for (int j = 0; j < 4; ++j) s += (v[j][0] + v[j][1]) + (v[j][2] + v[j][3]);
    const float mean = wave_sum(s) * (1.0f / D_);
    float q = 0.f;
#pragma unroll
    for (int j = 0; j < 4; ++j) { v[j] = v[j] - mean; q += (v[j][0] * v[j][0] + v[j][1] * v[j][1]) + (v[j][2] * v[j][2] + v[j][3] * v[j][3]); }
    const float rstd = 1.0f / sqrtf(wave_sum(q) * (1.0f / D_) + LN_EPS);
#pragma unroll
    for (int j = 0; j < 4; ++j) v[j] = v[j] * rstd * cng[j] + cnb[j];
}
template <bool L0> DI void ln_router_phase(const Frame& F, const Args& A, int layer, bool dry = false) {
    unsigned char* ws = opq(A.ws);
    const float* MOD = (const float*)(ws + WS_MOD); bf16* X = (bf16*)(ws + WS_X); const float* Y = (const float*)(ws + WS_Y); bf16* H = (bf16*)(ws + WS_H);
    int* asg_e = (int*)(ws + WS_ASG_E); int* asg_r = (int*)(ws + WS_ASG_R); int* etok = (int*)(ws + WS_ETOK); float* egate = (float*)(ws + WS_EW);
    unsigned* gcount = (unsigned*)(ws + WS_CTL) + CW_CNT + layer * 64;
    const int ls0 = layer * 2, ls1 = layer * 2 + 1;
    const bf16* wrf = (const bf16*)(ws + WS_WRF) + (size_t)layer * 2 * 65536 + (size_t)(F.wave & 3) * 32 * 512;
    const float rb = A.router_bias[layer * NEXP + F.lane];
    LAS float* lg = (LAS float*)(F.lds + LDS_LG);
    LAS int* lcnt = (LAS int*)(F.lds + LDS_LCNT); LAS int* lbase = (LAS int*)(F.lds + LDS_LBASE); LAS int* lasg = (LAS int*)(F.lds + LDS_LASG);
    const unsigned l8_ = (unsigned)F.lane * 8u, l16_ = (unsigned)F.lane * 16u;
    u32x2 yb[4][4], xb[L0 ? 1 : 4][4]; f32x4 xf[L0 ? 4 : 1][4];
#define LNR_LOAD(rb_) do { unsigned l8 = l8_, l16 = l16_; asm volatile("" : "+v"(l8), "+v"(l16)); \
        _Pragma("unroll") for (int t = 0; t < 4; ++t) { const int row = (rb_) + t; const char* py = pg8::rfl_ptr((const char*)Y + (size_t)row * (D_ * 2)); \
            if constexpr (L0) { const char* px = pg8::rfl_ptr((const char*)A.x + (size_t)row * (D_ * 4)); _Pragma("unroll") for (int j = 0; j < 4; ++j) xf[t][j] = __builtin_nontemporal_load((const f32x4*)(px + l16 + 1024 * j)); } \
            else { const char* px = pg8::rfl_ptr((const char*)X + (size_t)row * (D_ * 2)); _Pragma("unroll") for (int j = 0; j < 4; ++j) xb[t][j] = __builtin_nontemporal_load((const u32x2*)(px + l8 + 512 * j)); } \
            _Pragma("unroll") for (int j = 0; j < 4; ++j) yb[t][j] = __builtin_nontemporal_load((const u32x2*)(py + l8 + 512 * j)); } } while (0)
    for (int blk = F.bid; blk < T_ / 64; blk += F.G) {
        const int b = blk >> 6;
        const char* gate = pg8::rfl_ptr((const char*)(MOD + (size_t)(ls0 * 4 + b) * 3072 + 2048)); const char* modn = pg8::rfl_ptr((const char*)(MOD + (size_t)(ls1 * 4 + b) * 3072));
        const char* lng = pg8::rfl_ptr((const char*)(A.ln_g + (size_t)ls0 * D_)); const char* lnb = pg8::rfl_ptr((const char*)(A.ln_b + (size_t)ls0 * D_));
        f32x4 cg[4], cng[4], cnb[4], csc[4], csh[4];
#pragma unroll
        for (int j = 0; j < 4; ++j) { cg[j] = *(const f32x4*)(gate + l16_ + 1024 * j); cng[j] = *(const f32x4*)(lng + l16_ + 1024 * j); cnb[j] = *(const f32x4*)(lnb + l16_ + 1024 * j);
            csc[j] = *(const f32x4*)(modn + 4096 + l16_ + 1024 * j); csh[j] = *(const f32x4*)(modn + l16_ + 1024 * j); }
#pragma unroll
        for (int j = 0; j < 4; ++j) { cg[j] = 1.0f + cg[j]; csc[j] = 1.0f + csc[j]; }
        if constexpr (!L0) { LNR_LOAD(blk * 64 + F.wave * 4); }
        __builtin_amdgcn_sched_barrier(0);
#pragma unroll 1
        for (int ps = 0; ps < 2; ++ps) {
            const int rbase = blk * 64 + ps * 32 + F.wave * 4;
            if constexpr (L0) { LNR_LOAD(rbase); }
            { unsigned l8 = l8_; asm volatile("" : "+v"(l8));
#pragma unroll
              for (int t = 0; t < 4; ++t) { const int row = rbase + t; f32x4 v[4], y[4];
#pragma unroll
                for (int j = 0; j < 4; ++j) { y[j] = (f32x4){bf_lo(yb[t][j].x), bf_hi(yb[t][j].x), bf_lo(yb[t][j].y), bf_hi(yb[t][j].y)};
                    if constexpr (L0) v[j] = xf[t][j]; else v[j] = (f32x4){bf_lo(xb[t][j].x), bf_hi(xb[t][j].x), bf_lo(xb[t][j].y), bf_hi(xb[t][j].y)}; }
                deepnorm_row_c(v, y, cg, cng, cnb);
                char* xp = (char*)pg8::rfl_ptr((const char*)(dry ? (const bf16*)(ws + WS_Y + 32 * MiB) : X) + (size_t)row * (D_ * 2));
                char* hp = (char*)pg8::rfl_ptr((const char*)H + (size_t)row * (D_ * 2));
#pragma unroll
                for (int j = 0; j < 4; ++j) { { u32x2 o; o.x = cvtpk(v[j][0], v[j][1]); o.y = cvtpk(v[j][2], v[j][3]); __builtin_nontemporal_store(o, (u32x2*)(xp + l8 + 512 * j)); }
                    v[j] = v[j] * csc[j] + csh[j]; u32x2 o; o.x = cvtpk(v[j][0], v[j][1]); o.y = cvtpk(v[j][2], v[j][3]); *(u32x2*)(hp + l8 + 512 * j) = o; }
                put_hilo(F.lds, F.wave * 4 + t, F.lane, v); } }
            if constexpr (!L0) { if (ps == 0) { LNR_LOAD(blk * 64 + 32 + F.wave * 4); } }
            LDS_WAIT(); __builtin_amdgcn_s_barrier(); asm volatile("" ::: "memory");
            { const int nt = F.wave & 3, kh = F.wave >> 2, r = F.lane & 15, q = F.lane >> 4;
              f32x4 acc0, acc1; small_proj2(F.lds, kh, F.lane, wrf, wrf + 65536, acc0, acc1);
              if (kh == 0) {
#pragma unroll
                  for (int reg = 0; reg < 4; ++reg) { lg[(4 * q + reg) * 64 + 16 * nt + r] = acc0[reg]; lg[(16 + 4 * q + reg) * 64 + 16 * nt + r] = acc1[reg]; } }
              LDS_WAIT(); __builtin_amdgcn_s_barrier(); asm volatile("" ::: "memory");
              if (kh == 1) {
#pragma unroll
                  for (int reg = 0; reg < 4; ++reg) { lg[(4 * q + reg) * 64 + 16 * nt + r] += acc0[reg]; lg[(16 + 4 * q + reg) * 64 + 16 * nt + r] += acc1[reg]; } } }
            LDS_WAIT(); __builtin_amdgcn_s_barrier(); asm volatile("" ::: "memory");
#pragma unroll 2
            for (int rr = 0; rr < 4; ++rr) {
                const int row = rbase + rr, rl = ps * 32 + F.wave * 4 + rr;
                int ln = F.lane; asm volatile("" : "+v"(ln));
                const float logit = lg[(F.wave * 4 + rr) * 64 + F.lane];
                const float s = 1.0f / (1.0f + __expf(-logit)); const float bi = s + rb;
                float m1 = bi; m1 = fmaxf(m1, dppmov<0xB1>(m1)); m1 = fmaxf(m1, dppmov<0x4E>(m1)); m1 = fmaxf(m1, dppmov<0x141>(m1));
                const unsigned long long eq = __ballot(bi == m1);
                const int first = __ffs((int)((eq >> (ln & ~7)) & 0xffull)) - 1;
                float m2 = ((ln & 7) == first) ? -INFINITY : bi; m2 = fmaxf(m2, dppmov<0xB1>(m2)); m2 = fmaxf(m2, dppmov<0x4E>(m2)); m2 = fmaxf(m2, dppmov<0x141>(m2));
                const float gs = m1 + m2; int grank = 0;
#pragma unroll
                for (int j = 0; j < 8; ++j) { const float gj = rdlane(gs, 8 * j); grank += ((gj > gs) || (gj == gs && j < (ln >> 3))) ? 1 : 0; }
                const bool gsel = grank < 4;
                float mv = gsel ? bi : -INFINITY; int cnt = -1;
#pragma unroll
                for (int it = 0; it < TOPK; ++it) { const float mx = wave_max(mv); const unsigned long long em = __ballot(mv == mx); const int fl = __ffsll((long long)em) - 1;
                    if (ln == fl) { cnt = it; mv = -INFINITY; } }
                const bool sel = cnt >= 0;
                const float gsum = wave_sum(sel ? s : 0.f);
                if (sel) { const int lr = __hip_atomic_fetch_add(&lcnt[F.lane], 1, __ATOMIC_RELAXED, __HIP_MEMORY_SCOPE_WORKGROUP); lasg[rl * 8 + cnt] = (F.lane << 16) | lr;
                    asg_e[(size_t)row * 8 + cnt] = F.lane; ((LAS float*)(F.lds + LDS_LW))[rl * 8 + cnt] = s / gsum * 2.5f; }
            }
        }
        LDS_WAIT(); __builtin_amdgcn_s_barrier(); asm volatile("" ::: "memory");
        if (F.tid < NEXP) { const int cn = lcnt[F.tid]; lbase[F.tid] = (cn && !dry) ? (int)atomicAdd(&gcount[F.tid], (unsigned)cn) : 0; lcnt[F.tid] = 0; }
        LDS_WAIT(); __builtin_amdgcn_s_barrier(); asm volatile("" ::: "memory");
        { const int v = lasg[F.tid], e = v >> 16, rank = lbase[e] + (v & 0xffff); asg_r[(size_t)blk * 512 + F.tid] = rank;
          etok[(size_t)e * ECAP + rank] = blk * 64 + (F.tid >> 3); egate[(size_t)e * ECAP + rank] = ((const LAS float*)(F.lds + LDS_LW))[F.tid];
          if (F.tid < 64) { etok[(size_t)NEXP * ECAP + blk * 64 + F.tid] = blk * 64 + F.tid; egate[(size_t)NEXP * ECAP + blk * 64 + F.tid] = 1.0f; } }
        LDS_WAIT(); __builtin_amdgcn_s_barrier(); asm volatile("" ::: "memory");
    }
#undef LNR_LOAD
}

DI void moe_scatter_phase(const Frame& F, const Args& A, int layer) {
    unsigned char* ws = opq(A.ws);
    const int* asg_e = (const int*)(ws + WS_ASG_E); const int* asg_r = (const int*)(ws + WS_ASG_R); const float* asg_w = (const float*)(ws + WS_ASG_W); int* asg_row = (int*)(ws + WS_ASG_ROW);
    int* rowtok = (int*)(ws + WS_ROWTOK); float* roww = (float*)(ws + WS_ROWW);
    const unsigned* gcount = (const unsigned*)(ws + WS_CTL) + CW_CNT + layer * 64;
    build_tileoff(F, gcount);
    const LAS int* tileoff = (const LAS int*)(F.lds + LDS_TILEOFF);
    for (int idx = F.bid * NTHR + F.tid; idx < T_ * TOPK; idx += F.G * NTHR) {
        const int e = asg_e[idx], row = 256 * tileoff[e] + asg_r[idx];
        rowtok[row] = idx >> 3; roww[row] = asg_w[idx]; asg_row[idx] = row;
    }
    for (int e = F.bid; e < NEXP; e += F.G) {
        const int cnt = (int)__hip_atomic_load(gcount + e, __ATOMIC_RELAXED, __HIP_MEMORY_SCOPE_AGENT), end = 256 * tileoff[e + 1];
        for (int row = 256 * tileoff[e] + cnt + F.tid; row < end; row += NTHR) { rowtok[row] = T_; roww[row] = 0.f; }
    }
    const int s0 = 256 * tileoff[64];
    for (int t = F.bid * NTHR + F.tid; t < T_; t += F.G * NTHR) { rowtok[s0 + t] = t; roww[s0 + t] = 1.0f; }
}

DI void ln_moe_phase(const Frame& F, const Args& A, int layer, float* dry_out) {
    unsigned char* ws = opq(A.ws);
    const float* MOD = (const float*)(ws + WS_MOD); const char* YE = (const char*)(ws + WS_BIG);
    float* AB = (float*)(ws + WS_AB);
    int s0 = 0;
    s0 = 256 * ((const LAS int*)(F.lds + LDS_TILEOFF))[64];
    const int* asg_e = (const int*)(ws + WS_ASG_E); const int* asg_r = (const int*)(ws + WS_ASG_R);
    const int ls0 = layer * 2 + 1, ls1 = layer * 2 + 2; const bool last = layer == 3, want_ab = (layer & 1) == 0;
    const bf16* wabf = (const bf16*)(ws + WS_WABF) + (size_t)(layer >> 1) * 2 * 16384;
    const unsigned l4_ = (unsigned)F.lane * 4u, l8_ = (unsigned)F.lane * 8u, l16_ = (unsigned)F.lane * 16u;
    for (int blk = F.bid; blk < T_ / 64; blk += F.G) {
        const int b = blk >> 6;
        const char* gate = pg8::rfl_ptr((const char*)(MOD + (size_t)(ls0 * 4 + b) * 3072 + 2048)); const char* modn = pg8::rfl_ptr((const char*)(MOD + (size_t)((last ? ls0 : ls1) * 4 + b) * 3072));
        const char* lng = pg8::rfl_ptr((const char*)(A.ln_g + (size_t)ls0 * D_)); const char* lnb = pg8::rfl_ptr((const char*)(A.ln_b + (size_t)ls0 * D_));
        f32x4 cg[4], cng[4], cnb[4], csc[4], csh[4];
#pragma unroll
        for (int j = 0; j < 4; ++j) { cg[j] = *(const f32x4*)(gate + l16_ + 1024 * j); cng[j] = *(const f32x4*)(lng + l16_ + 1024 * j); cnb[j] = *(const f32x4*)(lnb + l16_ + 1024 * j);
            csc[j] = *(const f32x4*)(modn + 4096 + l16_ + 1024 * j); csh[j] = *(const f32x4*)(modn + l16_ + 1024 * j); }
#pragma unroll
        for (int j = 0; j < 4; ++j) { cg[j] = 1.0f + cg[j]; csc[j] = 1.0f + csc[j]; }
#pragma unroll 1
        for (int ps = 0; ps < 2; ++ps) {
            const int rbase = blk * 64 + ps * 32 + F.wave * 4;
            const int ev = *(const int*)(pg8::rfl_ptr((const char*)(asg_e + (size_t)rbase * 8)) + (l4_ & 127u)), rv = *(const int*)(pg8::rfl_ptr((const char*)(asg_r + (size_t)rbase * 8)) + (l4_ & 127u));
            const int idxv = 256 * ((const LAS int*)(F.lds + LDS_TILEOFF))[ev] + rv;
#pragma unroll 1
            for (int rr = 0; rr < 4; ++rr) {
                const int row = rbase + rr; f32x4 v[4], y[4]; int w[9][4]; u32x2 sh[4];
                unsigned l4 = l4_, l8 = l8_, l16 = l16_; asm volatile("" : "+v"(l4), "+v"(l8), "+v"(l16));
#pragma unroll
                for (int k = 0; k < TOPK; ++k) { const int src = __builtin_amdgcn_readlane(idxv, rr * 8 + k); const char* p = pg8::rfl_ptr(YE + (size_t)src * D_);
#pragma unroll
                    for (int j = 0; j < 4; ++j) w[k][j] = __builtin_nontemporal_load((const int*)(p + l4 + 256 * j)); }
                if (YS_BF16) { const char* p = pg8::rfl_ptr(YE + WS_YS_OFF + (size_t)row * (D_ * 2));
#pragma unroll
                    for (int j = 0; j < 4; ++j) sh[j] = __builtin_nontemporal_load((const u32x2*)(p + l8 + 512 * j));
                } else { const char* p = pg8::rfl_ptr(YE + (size_t)(s0 + row) * D_);
#pragma unroll
                    for (int j = 0; j < 4; ++j) w[8][j] = *(const int*)(p + l4 + 256 * j);
                }
                u32x2 xb[4];
                { const char* p = pg8::rfl_ptr((const char*)(ws + WS_X) + (size_t)row * (D_ * 2));
#pragma unroll
                  for (int j = 0; j < 4; ++j) xb[j] = __builtin_nontemporal_load((const u32x2*)(p + l8 + 512 * j)); }
                __builtin_amdgcn_sched_barrier(0);
#pragma unroll
                for (int j = 0; j < 4; ++j) { y[j] = (f32x4){0.f, 0.f, 0.f, 0.f}; v[j] = (f32x4){bf_lo(xb[j].x), bf_hi(xb[j].x), bf_lo(xb[j].y), bf_hi(xb[j].y)}; }
#pragma unroll
                for (int k = 0; k < (YS_BF16 ? TOPK : TOPK + 1); ++k) {
                    asm volatile("" : "+v"(w[k][0]), "+v"(w[k][1]), "+v"(w[k][2]), "+v"(w[k][3]), "+v"(y[0]), "+v"(y[1]), "+v"(y[2]), "+v"(y[3]));
#pragma unroll
                    for (int j = 0; j < 4; ++j) { const f32x2 a = __builtin_amdgcn_cvt_pk_f32_fp8(w[k][j], false), c = __builtin_amdgcn_cvt_pk_f32_fp8(w[k][j], true);
                        y[j][0] += a[0]; y[j][1] += a[1]; y[j][2] += c[0]; y[j][3] += c[1]; }
                    __builtin_amdgcn_sched_barrier(0);
                }
#pragma unroll
                for (int j = 0; j < 4; ++j) y[j] = y[j] * (1.0f / YE_SCALE);
                if (YS_BF16) {
#pragma unroll
                    for (int j = 0; j < 4; ++j) { y[j][0] += bf_lo(sh[j].x); y[j][1] += bf_hi(sh[j].x); y[j][2] += bf_lo(sh[j].y); y[j][3] += bf_hi(sh[j].y); }
                }
                deepnorm_row_c(v, y, cg, cng, cnb);
                if (last || dry_out) { char* op = (char*)pg8::rfl_ptr((const char*)(dry_out ? dry_out : A.out) + (size_t)row * (D_ * 4));
#pragma unroll
                    for (int j = 0; j < 4; ++j) __builtin_nontemporal_store(v[j], (f32x4*)(op + l16 + 1024 * j));
                } else { char* xp = (char*)pg8::rfl_ptr((const char*)(ws + WS_X) + (size_t)row * (D_ * 2));
#pragma unroll
                    for (int j = 0; j < 4; ++j) { u32x2 o; o.x = cvtpk(v[j][0], v[j][1]); o.y = cvtpk(v[j][2], v[j][3]); __builtin_nontemporal_store(o, (u32x2*)(xp + l8 + 512 * j)); } }
                if (!last) { char* hp = (char*)pg8::rfl_ptr((const char*)(ws + WS_H) + (size_t)row * (D_ * 2));
#pragma unroll
                    for (int j = 0; j < 4; ++j) { v[j] = v[j] * csc[j] + csh[j]; u32x2 o; o.x = cvtpk(v[j][0], v[j][1]); o.y = cvtpk(v[j][2], v[j][3]); *(u32x2*)(hp + l8 + 512 * j) = o; }
                    if (want_ab) put_hilo(F.lds, F.wave * 4 + rr, F.lane, v);
                }
            }
            if (!last && want_ab) {
                LDS_WAIT(); __builtin_amdgcn_s_barrier(); asm volatile("" ::: "memory");
                { const int mt = F.wave & 1, kq = F.wave >> 1;
                  const f32x4 part = small_proj_range(F.lds, mt, 8 * kq, 8, F.lane, wabf, wabf + 16384);
                  *(LAS f32x4*)(F.lds + LDS_LG + ((kq * 2 + mt) * 64 + F.lane) * 16) = part; }
                LDS_WAIT(); __builtin_amdgcn_s_barrier(); asm volatile("" ::: "memory");
                if (F.wave < 2) { const int mt = F.wave, r = F.lane & 15, q = F.lane >> 4;
                    const LAS f32x4* pp = (const LAS f32x4*)(F.lds + LDS_LG) + mt * 64 + F.lane;
                    const f32x4 acc = ((pp[0] + pp[128]) + pp[256]) + pp[384];
#pragma unroll
                    for (int reg = 0; reg < 4; ++reg) AB[(size_t)(blk * 64 + ps * 32 + 16 * mt + 4 * q + reg) * 16 + r] = acc[reg]; }
            }
        }
    }
}
DI int crow(int r, int h) { return (r & 3) + 8 * (r >> 2) + 4 * h; }
typedef short v4i16_t __attribute__((ext_vector_type(4)));
DI s16x4 vtr(const LAS unsigned char* p) { return __builtin_bit_cast(s16x4, __builtin_amdgcn_ds_read_tr16_b64_v4i16((LAS v4i16_t*)p)); }
#define MFMA32(a, b, c) __builtin_amdgcn_mfma_f32_32x32x16_bf16((a), (b), (c), 0, 0, 0)
constexpr int ATT_ORUN = 0, ATT_LRUN = 65536, ATT_VBUF = 65536 + 2048, ATT_VSTRIDE = 144, ATT_VBYTES = 32 * ATT_VSTRIDE;

#ifndef REP_A1
#define REP_A1 1
#define REP_A2 1
#endif
DI void attn_phase(const Frame& F, const Args& A) {
    unsigned char* ws = opq(A.ws);
    const bf16* QKV = (const bf16*)(ws + WS_BIG); bf16* O = (bf16*)(ws + WS_O);
    LAS unsigned char* orun = F.lds + ATT_ORUN;
    LAS float* lrun = (LAS float*)(F.lds + ATT_LRUN);
    LAS unsigned char* vbuf = F.lds + ATT_VBUF + F.wave * ATT_VBYTES;
    const int lane = F.lane, qi = lane & 31, h = lane >> 5;
    const int g16 = lane >> 4, q4 = (lane & 15) >> 2, p4 = lane & 3;
    for (int it = F.bid; it < NB_ * 16 * 8; it += F.G) {
        int item = it;
        if (F.G == 256) { const int w = it & 255, xcd = w & 7, j = w >> 3; item = (((it >> 8) * 32 + xcd * 4 + (j >> 3)) << 3) | (j & 7); }
        const int b = item >> 7, head = (item >> 3) & 15, ck = item & 7;
        for (int gi = 0; gi < 3; ++gi) {
            const int g = 2 - gi, ldil = 2 * g, Lg = S_ >> ldil;
            const size_t hb = (((size_t)g * NB_ + b) * 16 + head) * S_ * 64;
            const bf16* Qg = QKV + hb; const bf16* Kg = QKV + (size_t)3 * NB_ * 16 * S_ * 64 + hb; const bf16* Vg = QKV + (size_t)6 * NB_ * 16 * S_ * 64 + hb;
            for (int sub = F.wave; sub < 16; sub += NWAVES) {
                int r_, tile;
                if (g == 0) { r_ = 0; tile = sub; } else if (g == 1) { r_ = sub >> 2; tile = sub & 3; } else { r_ = sub; tile = 0; }
                const int m0 = ((512 * ck) >> ldil) + 32 * tile;
                const bf16* Kr = Kg + (size_t)r_ * Lg * 64; const bf16* Vr = Vg + (size_t)r_ * Lg * 64;
                f32x16 st[5]; u32x4 vv[5][4]; float mx, lsum;
#pragma unroll 1
                for (int rep1 = 0; rep1 < REP_A1; ++rep1) {
                unsigned lc = (unsigned)((lane >> 3) * 128 + (lane & 7) * 16); asm volatile("" : "+v"(lc));
                const int wofs = (lane >> 3) * ATT_VSTRIDE + (lane & 7) * 16, rofs = qi * ATT_VSTRIDE + 64 * h;
                u32x4 qv[4], kv[5][4];
                { const char* qp = pg8::rfl_ptr((const char*)(Qg + ((size_t)r_ * Lg + m0) * 64));
#pragma unroll
                  for (int i = 0; i < 4; ++i) qv[i] = __builtin_nontemporal_load((const u32x4*)(qp + lc + 1024 * i)); }
#pragma unroll
                for (int kt = 0; kt < 5; ++kt) { const int mk0 = m0 - 128 + 32 * kt; const char* kp = pg8::rfl_ptr((const char*)(Kr + (size_t)(mk0 < 0 ? 0 : mk0) * 64));
#pragma unroll
                    for (int i = 0; i < 4; ++i) kv[kt][i] = *(const u32x4*)(kp + lc + 1024 * i); }
                __builtin_amdgcn_sched_barrier(0);
                bf16x8 qf[4];
#pragma unroll
                for (int i = 0; i < 4; ++i) *(LAS u32x4*)(vbuf + wofs + 8 * i * ATT_VSTRIDE) = qv[i];
                LDS_WAIT(); asm volatile("" ::: "memory");
#pragma unroll
                for (int s = 0; s < 4; ++s) qf[s] = *(const LAS bf16x8*)(vbuf + rofs + 16 * s);
                LDS_WAIT(); asm volatile("" ::: "memory");
#pragma unroll
                for (int kt = 0; kt < 5; ++kt) {
                    const int mk0 = m0 - 128 + 32 * kt;
                    bf16x8 kf[4];
#pragma unroll
                    for (int i = 0; i < 4; ++i) *(LAS u32x4*)(vbuf + wofs + 8 * i * ATT_VSTRIDE) = kv[kt][i];
                    LDS_WAIT(); asm volatile("" ::: "memory");
#pragma unroll
                    for (int s = 0; s < 4; ++s) kf[s] = *(const LAS bf16x8*)(vbuf + rofs + 16 * s);
                    { const char* vp = pg8::rfl_ptr((const char*)(Vr + (size_t)(mk0 < 0 ? 0 : mk0) * 64));
#pragma unroll
                      for (int i = 0; i < 4; ++i) vv[kt][i] = *(const u32x4*)(vp + lc + 1024 * i); }
                    LDS_WAIT(); asm volatile("" ::: "memory");
#pragma unroll
                    for (int r = 0; r < 16; ++r) st[kt][r] = 0.f;
#pragma unroll
                    for (int s = 0; s < 4; ++s) st[kt] = MFMA32(kf[s], qf[s], st[kt]);
                    if (mk0 < 0) {
#pragma unroll
                        for (int r = 0; r < 16; ++r) st[kt][r] = -INFINITY;
                    }
                }
#pragma unroll
                for (int r = 0; r < 16; ++r) { const int kr = crow(r, h); if (kr < qi) st[0][r] = -INFINITY; if (kr > qi) st[4][r] = -INFINITY; }
                mx = -INFINITY;
#pragma unroll
                for (int kt = 0; kt < 5; ++kt)
#pragma unroll
                    for (int r = 0; r < 16; ++r) mx = fmaxf(mx, st[kt][r]);
                mx = fmaxf(mx, bperm(mx, F.lane ^ 32));
                lsum = 0.f;
#pragma unroll
                for (int kt = 0; kt < 5; ++kt)
#pragma unroll
                    for (int r = 0; r < 16; ++r) { const float p = __builtin_amdgcn_exp2f(st[kt][r] - mx); st[kt][r] = p; lsum += p; }
                lsum += bperm(lsum, F.lane ^ 32);
                }
                f32x16 oacc[2];
#pragma unroll 1
                for (int rep2 = 0; rep2 < REP_A2; ++rep2) {
#pragma unroll
                for (int r = 0; r < 16; ++r) { oacc[0][r] = 0.f; oacc[1][r] = 0.f; }
#pragma unroll
                for (int kt = 0; kt < 5; ++kt) {
                    const int mk0 = m0 - 128 + 32 * kt;
                    if (mk0 >= 0) {
#pragma unroll
                        for (int i = 0; i < 4; ++i) *(LAS u32x4*)(vbuf + ((lane >> 3) + 8 * i) * ATT_VSTRIDE + (lane & 7) * 16) = vv[kt][i];
                        LDS_WAIT(); asm volatile("" ::: "memory");
                        s16x4 flo[2][2], fhi[2][2];
#pragma unroll
                        for (int sp = 0; sp < 2; ++sp)
#pragma unroll
                            for (int dvt = 0; dvt < 2; ++dvt) {
                                const int colb = (32 * dvt + 16 * (g16 & 1) + 4 * p4) * 2;
                                flo[sp][dvt] = vtr(vbuf + (16 * sp + 4 * h + q4) * ATT_VSTRIDE + colb);
                                fhi[sp][dvt] = vtr(vbuf + (16 * sp + 8 + 4 * h + q4) * ATT_VSTRIDE + colb);
                            }
                        LDS_WAIT(); asm volatile("" ::: "memory");
#pragma unroll
                        for (int sp = 0; sp < 2; ++sp) {
                            bf16x8 pf; {
                                const unsigned w0 = cvtpk(st[kt][8 * sp + 0], st[kt][8 * sp + 1]), w1 = cvtpk(st[kt][8 * sp + 2], st[kt][8 * sp + 3]);
                                const unsigned w2 = cvtpk(st[kt][8 * sp + 4], st[kt][8 * sp + 5]), w3 = cvtpk(st[kt][8 * sp + 6], st[kt][8 * sp + 7]);
                                pf = __builtin_bit_cast(bf16x8, (u32x4){w0, w1, w2, w3}); }
#pragma unroll
                            for (int dvt = 0; dvt < 2; ++dvt) {
                                const bf16x8 vf = __builtin_shufflevector(flo[sp][dvt], fhi[sp][dvt], 0, 1, 2, 3, 4, 5, 6, 7);
                                oacc[dvt] = MFMA32(vf, pf, oacc[dvt]);
                            }
                        }
                    }
                }
                asm volatile("" : "+v"(oacc[0]), "+v"(oacc[1]));
                }
                const float inv = __builtin_amdgcn_rcpf(lsum), lse = mx + __builtin_amdgcn_logf(lsum);
                const int tl = ((32 * tile + qi) << ldil) + r_;
                if (sub == F.wave) { LDS_WAIT(); __builtin_amdgcn_s_barrier(); asm volatile("" ::: "memory"); }
                float wa = 0.f, wb = 1.f;
                if (gi > 0) { const float L0 = lrun[tl]; const float M = fmaxf(L0, lse); const float ea = __builtin_amdgcn_exp2f(L0 - M), eb = __builtin_amdgcn_exp2f(lse - M);
                    const float isum = __builtin_amdgcn_rcpf(ea + eb); wa = ea * isum; wb = eb * isum; asm volatile("" ::: "memory");
                    if (h == 0) lrun[tl] = M + __builtin_amdgcn_logf(ea + eb); }
                else if (h == 0) lrun[tl] = lse;
                wb *= inv;
#pragma unroll
                for (int dvt = 0; dvt < 2; ++dvt)
#pragma unroll
                    for (int k4 = 0; k4 < 4; ++k4) {
                        const int dv = 32 * dvt + 8 * k4 + 4 * h;
                        float o0 = oacc[dvt][4 * k4 + 0] * wb, o1 = oacc[dvt][4 * k4 + 1] * wb, o2 = oacc[dvt][4 * k4 + 2] * wb, o3 = oacc[dvt][4 * k4 + 3] * wb;
                        LAS u32x2* op = (LAS u32x2*)(orun + tl * 128 + dv * 2);
                        if (gi > 0) { const u32x2 w = *op; o0 += wa * bf_lo(w.x); o1 += wa * bf_hi(w.x); o2 += wa * bf_lo(w.y); o3 += wa * bf_hi(w.y); }
                        u32x2 wo; wo.x = cvtpk(o0, o1); wo.y = cvtpk(o2, o3);
                        if (gi < 2) *op = wo;
                        else *(u32x2*)(O + ((size_t)b * S_ + 512 * ck + tl) * D_ + head * 64 + dv) = wo;
                    }
            }
        }
    }
}

DI void gdn_post_phase(const Frame& F, const Args& A, int j) {
    unsigned char* ws = opq(A.ws); unsigned char* big = ws + WS_BIG;
    const bf16* Oraw = (const bf16*)(ws + WS_Y); const bf16* PROJ = (const bf16*)(big + BIG_PROJ); bf16* O = (bf16*)(ws + WS_O);
    const float* nw = A.gdn_norm_w + (size_t)j * 128;
    const int gw = F.bid * NWAVES + F.wave, NGW = F.G * NWAVES, lane = F.lane;
    const f32x4 nwv = *(const f32x4*)(nw + ((4 * lane) & 127));
    const unsigned l8_ = (unsigned)lane * 8u;
#pragma unroll 2
    for (int row = gw; row < T_; row += NGW) {
        unsigned l8 = l8_; asm volatile("" : "+v"(l8));
        const char* op = pg8::rfl_ptr((const char*)(Oraw + (size_t)row * D_)); const char* zp = pg8::rfl_ptr((const char*)(PROJ + (size_t)row * 4096 + 3072));
        u32x2 ow[4], zw[4];
#pragma unroll
        for (int jj = 0; jj < 4; ++jj) { ow[jj] = __builtin_nontemporal_load((const u32x2*)(op + l8 + 512 * jj)); zw[jj] = __builtin_nontemporal_load((const u32x2*)(zp + l8 + 512 * jj)); }
        f32x4 v[4];
#pragma unroll
        for (int jj = 0; jj < 4; ++jj) {
            v[jj] = (f32x4){bf_lo(ow[jj].x), bf_hi(ow[jj].x), bf_lo(ow[jj].y), bf_hi(ow[jj].y)};
            float ss = (v[jj][0] * v[jj][0] + v[jj][1] * v[jj][1]) + (v[jj][2] * v[jj][2] + v[jj][3] * v[jj][3]);
            ss += dppmov<0xB1>(ss); ss += dppmov<0x4E>(ss); ss += dppmov<0x141>(ss); ss += dppmov<0x140>(ss); ss += shx<16>(ss);
            const float rs = rsqrtf(ss * (1.0f / 128.0f) + RMS_EPS);
            const float z0 = bf_lo(zw[jj].x), z1 = bf_hi(zw[jj].x), z2 = bf_lo(zw[jj].y), z3 = bf_hi(zw[jj].y);
            v[jj][0] = v[jj][0] * rs * nwv[0] * silu_f(z0); v[jj][1] = v[jj][1] * rs * nwv[1] * silu_f(z1);
            v[jj][2] = v[jj][2] * rs * nwv[2] * silu_f(z2); v[jj][3] = v[jj][3] * rs * nwv[3] * silu_f(z3);
        }
        store_row16_bf16(O + (size_t)row * D_, lane, v);
    }
}
constexpr size_t GB_KR = 128 * MiB, GB_QR = 160 * MiB, GB_KT = 192 * MiB, GB_VT = 224 * MiB, GB_BLOB = 256 * MiB;
constexpr int BLOB_ELEMS = 28672, BLOB_W = 0, BLOB_QG = 8192, BLOB_QK = 16384, BLOB_KDT = 20480;
DI int frag_pos(int row, int k, int nks) { const int kk = k & 31; return ((((row >> 4) * nks + (k >> 5)) * 64 + ((kk >> 2) & 3) * 16 + (row & 15)) * 8) + 4 * (kk >> 4) + (kk & 3); }
#define MFMA16(a, b, c) __builtin_amdgcn_mfma_f32_16x16x32_bf16((a), (b), (c), 0, 0, 0)
DI u32x2 pk4(float a, float b, float c, float d) { u32x2 w; w.x = cvtpk(a, b); w.y = cvtpk(c, d); return w; }

DI int tile_off(int t, int c) { return t * 256 + ((((c >> 4) ^ (t & 7)) << 5) | ((c & 15) << 1)); }
template <int WH> DI void prep_conv_pass(const bf16* PROJ, const float* cw, int b, int hh, int t0, int lane, LAS unsigned char* tile, bf16* rowdst, const LAS float* escale, bool normalize, float nscale) {
    float w[4][2];
#pragma unroll
    for (int jj = 0; jj < 4; ++jj) { const f32x2 t = *(const f32x2*)(cw + (size_t)jj * 3072 + WH * 1024 + hh * 128 + 2 * lane); w[jj][0] = t.x; w[jj][1] = t.y; }
    float A0[35], A1[35];
#pragma unroll
    for (int jj = 0; jj < 3; ++jj) { const int t = t0 - 3 + jj; unsigned u = 0u;
        if (t >= 0) u = *(const unsigned*)(PROJ + ((size_t)b * S_ + t) * 4096 + WH * 1024 + hh * 128 + 2 * lane);
        A0[jj] = bf_lo(u); A1[jj] = bf_hi(u); }
#pragma unroll 1
    for (int hb = 0; hb < 2; ++hb) {
        { unsigned xin[32];
#pragma unroll
          for (int i = 0; i < 32; ++i) xin[i] = __builtin_nontemporal_load((const unsigned*)(PROJ + ((size_t)b * S_ + t0 + 32 * hb + i) * 4096 + WH * 1024 + hh * 128 + 2 * lane));
#pragma unroll
          for (int i = 0; i < 32; ++i) { A0[3 + i] = bf_lo(xin[i]); A1[3 + i] = bf_hi(xin[i]); } }
#pragma unroll
        for (int i = 0; i < 32; ++i) {
            A0[i] = w[0][0] * A0[i] + w[1][0] * A0[i + 1] + w[2][0] * A0[i + 2] + w[3][0] * A0[i + 3];
            A1[i] = w[0][1] * A1[i] + w[1][1] * A1[i + 1] + w[2][1] * A1[i + 2] + w[3][1] * A1[i + 3]; }
#pragma unroll
        for (int i = 0; i < 32; ++i) { A0[i] = silu_f(A0[i]); A1[i] = silu_f(A1[i]); }
        if (normalize) {
            float rs[32];
#pragma unroll
            for (int i = 0; i < 32; ++i) rs[i] = wave_sum(A0[i] * A0[i] + A1[i] * A1[i]);
#pragma unroll
            for (int i = 0; i < 32; ++i) { const float r = rsqrtf(rs[i] + RMS_EPS) * nscale; A0[i] *= r; A1[i] *= r; }
        }
#pragma unroll
        for (int i = 0; i < 32; ++i) {
            const int tt = 32 * hb + i;
            if (rowdst) *(unsigned*)(rowdst + (size_t)tt * 128 + 2 * lane) = cvtpk(A0[i], A1[i]);
            const float es = escale ? escale[tt] : 1.0f;
            *(LAS unsigned*)(tile + tile_off(tt, 2 * lane)) = cvtpk(A0[i] * es, A1[i] * es);
        }
#pragma unroll
        for (int jj = 0; jj < 3; ++jj) { A0[jj] = A0[32 + jj]; A1[jj] = A1[32 + jj]; }
    }
    LDS_WAIT(); asm volatile("" ::: "memory");
}
DI void tile_tr8(const LAS unsigned char* tile, int tb, int tb2, int cb, int lane, s16x4& lo, s16x4& hi) {
    const int q4 = (lane & 15) >> 2, p4 = lane & 3;
    lo = vtr(tile + tile_off(tb + q4, cb + 4 * p4)); hi = vtr(tile + tile_off(tb2 + q4, cb + 4 * p4));
}
DI void gdn_prep2_phase(const Frame& F, const Args& A, int j) {
    unsigned char* ws = opq(A.ws); unsigned char* big = ws + WS_BIG;
    const bf16* PROJ = (const bf16*)(big + BIG_PROJ);
    bf16* KR = (bf16*)(big + GB_KR); bf16* QR = (bf16*)(big + GB_QR); bf16* KT = (bf16*)(big + GB_KT); bf16* VT = (bf16*)(big + GB_VT); bf16* BLOB = (bf16*)(big + GB_BLOB);
    const float* AB = (const float*)(ws + WS_AB); float* GC = (float*)(ws + WS_GALPHA); float* GB = (float*)(ws + WS_GBETA);
    const float* cw = A.gdn_conv_w + (size_t)j * 4 * 3072;
    const int gw = F.bid * NWAVES + F.wave, NGW = F.G * NWAVES, lane = F.lane, g16 = lane >> 4, i16 = lane & 15;
    LAS unsigned char* tile = F.lds + F.wave * 16384;
    LAS float* egl = (LAS float*)(F.lds + LDS_LG + F.wave * 512); LAS float* ekl = egl + 64;
    for (int it = gw; it < NB_ * 8 * 64; it += NGW) {
        const int b = it >> 9, hh = (it >> 6) & 7, n = it & 63, t0 = 64 * n, bh = b * 8 + hh;
        { const int row = b * S_ + t0 + lane; const float a = AB[(size_t)row * 16 + hh], bl = AB[(size_t)row * 16 + 8 + hh];
          const float xs = a + A.gdn_dt_bias[j * 8 + hh]; const float ey = __expf(xs); const float sp = xs > 20.f ? xs : (ey < 1e-3f ? ey * (1.0f - 0.5f * ey) : __logf(1.0f + ey));
          float gc = -__expf(A.gdn_a_log[j * 8 + hh]) * sp;
#pragma unroll
          for (int o = 1; o < 64; o <<= 1) { const float t = bperm(gc, lane - o); if (lane >= o) gc += t; }
          const float gl = rdlane(gc, 63);
          GC[(size_t)bh * S_ + t0 + lane] = gc; GB[(size_t)bh * S_ + t0 + lane] = 1.0f / (1.0f + __expf(-bl));
          egl[lane] = __expf(gc); ekl[lane] = __expf(gl - gc); }
        LDS_WAIT(); asm volatile("" ::: "memory");
        bf16* blob = BLOB + (size_t)it * BLOB_ELEMS;
        bf16* ktc = KT + (size_t)it * 8192; bf16* vtc = VT + (size_t)it * 8192;
        const size_t rbase = ((size_t)bh * S_ + t0) * 128;
        prep_conv_pass<1>(PROJ, cw, b, hh, t0, lane, tile, KR + rbase, nullptr, true, 1.0f);
#pragma unroll 2
        for (int db = 0; db < 8; ++db)
#pragma unroll
            for (int half = 0; half < 2; ++half) { s16x4 lo, hi; const int tb = 32 * half + 8 * g16; tile_tr8(tile, tb, tb + 4, 16 * db, lane, lo, hi);
                *(bf16x8*)(ktc + (16 * db + i16) * 64 + tb) = __builtin_shufflevector(lo, hi, 0, 1, 2, 3, 4, 5, 6, 7); }
#pragma unroll 2
        for (int a = 0; a < 8; ++a)
#pragma unroll
            for (int ks = 0; ks < 2; ++ks) { s16x4 lo, hi; const int tb = 32 * ks + 4 * g16; tile_tr8(tile, tb, tb + 16, 16 * a, lane, lo, hi);
                const f32x4 e0 = *(const LAS f32x4*)(ekl + tb), e1 = *(const LAS f32x4*)(ekl + tb + 16);
                u32x4 wv;
                wv.x = cvtpk(bf_lo((unsigned)(unsigned short)lo[0]) * e0[0], bf_lo((unsigned)(unsigned short)lo[1]) * e0[1]); wv.y = cvtpk(bf_lo((unsigned)(unsigned short)lo[2]) * e0[2], bf_lo((unsigned)(unsigned short)lo[3]) * e0[3]);
                wv.z = cvtpk(bf_lo((unsigned)(unsigned short)hi[0]) * e1[0], bf_lo((unsigned)(unsigned short)hi[1]) * e1[1]); wv.w = cvtpk(bf_lo((unsigned)(unsigned short)hi[2]) * e1[2], bf_lo((unsigned)(unsigned short)hi[3]) * e1[3]);
                *(u32x4*)(blob + BLOB_KDT + ((a * 2 + ks) * 64 + lane) * 8) = wv; }
        LDS_WAIT(); asm volatile("" ::: "memory");
        prep_conv_pass<2>(PROJ, cw, b, hh, t0, lane, tile, nullptr, nullptr, false, 1.0f);
#pragma unroll 2
        for (int db = 0; db < 8; ++db)
#pragma unroll
            for (int half = 0; half < 2; ++half) { s16x4 lo, hi; const int tb = 32 * half + 8 * g16; tile_tr8(tile, tb, tb + 4, 16 * db, lane, lo, hi);
                *(bf16x8*)(vtc + (16 * db + i16) * 64 + tb) = __builtin_shufflevector(lo, hi, 0, 1, 2, 3, 4, 5, 6, 7); }
        LDS_WAIT(); asm volatile("" ::: "memory");
        prep_conv_pass<0>(PROJ, cw, b, hh, t0, lane, tile, QR + rbase, egl, true, 0.08838834764831845f);
#pragma unroll 2
        for (int tm = 0; tm < 4; ++tm)
#pragma unroll
            for (int ks = 0; ks < 4; ++ks) {
                const u32x2 p0 = *(const LAS u32x2*)(tile + tile_off(16 * tm + i16, 32 * ks + 4 * g16)), p1 = *(const LAS u32x2*)(tile + tile_off(16 * tm + i16, 32 * ks + 16 + 4 * g16));
                *(u32x4*)(blob + BLOB_QG + ((tm * 4 + ks) * 64 + lane) * 8) = (u32x4){p0.x, p0.y, p1.x, p1.y}; }
        LDS_WAIT(); asm volatile("" ::: "memory");
    }
}

DI void gdn_wy_phase(const Frame& F, const Args& A) {
    unsigned char* ws = opq(A.ws); unsigned char* big = ws + WS_BIG;
    const bf16* KR = (const bf16*)(big + GB_KR); const bf16* QR = (const bf16*)(big + GB_QR); const bf16* KT = (const bf16*)(big + GB_KT); const bf16* VT = (const bf16*)(big + GB_VT);
    bf16* BLOB = (bf16*)(big + GB_BLOB); float* U = (float*)(ws + WS_HID);
    const float* GC = (const float*)(ws + WS_GALPHA); const float* GB = (const float*)(ws + WS_GBETA);
    const int gw = F.bid * NWAVES + F.wave, NGW = F.G * NWAVES, lane = F.lane, r = lane & 15, q = lane >> 4;
    LAS float* Af = (LAS float*)(F.lds + F.wave * 16384);
    for (int it = gw; it < NB_ * 8 * 64; it += NGW) {
        const int bh = it >> 6, n = it & 63;
        const char* kr = pg8::rfl_ptr((const char*)(KR + ((size_t)bh * S_ + 64 * n) * 128)); const char* qr = pg8::rfl_ptr((const char*)(QR + ((size_t)bh * S_ + 64 * n) * 128));
        const char* kt = pg8::rfl_ptr((const char*)(KT + (size_t)it * 8192)); const char* vt = pg8::rfl_ptr((const char*)(VT + (size_t)it * 8192));
        char* blob = (char*)pg8::rfl_ptr((const char*)(BLOB + (size_t)it * BLOB_ELEMS)); char* ub = (char*)pg8::rfl_ptr((const char*)((bf16*)U + (size_t)it * 8192));
        const unsigned lrow = (unsigned)(r * 128 + 8 * q) * 2u, ltr = (unsigned)(r * 64 + 8 * q) * 2u, lfrag = (unsigned)(q * 16 + r) * 16u;
        const float gcl = GC[(size_t)bh * S_ + 64 * n + lane], bel = GB[(size_t)bh * S_ + 64 * n + lane];
        __builtin_amdgcn_wave_barrier();
        bf16x8 kfr[4][4], qfr[4][4];
#pragma unroll
        for (int t4 = 0; t4 < 4; ++t4)
#pragma unroll
            for (int ks = 0; ks < 4; ++ks) { kfr[t4][ks] = __builtin_nontemporal_load((const bf16x8*)(kr + lrow + (16 * t4 * 128 + 32 * ks) * 2)); qfr[t4][ks] = __builtin_nontemporal_load((const bf16x8*)(qr + lrow + (16 * t4 * 128 + 32 * ks) * 2)); }
#pragma unroll
        for (int ti = 0; ti < 4; ++ti) {
            const float gi = bperm(gcl, 16 * ti + r), bi = bperm(bel, 16 * ti + r);
#pragma unroll
            for (int tj = 0; tj < 4; ++tj) {
                char* qkdst = blob + (BLOB_QK + ((ti * 2 + (tj >> 1)) * 64) * 8 + 4 * (tj & 1)) * 2 + lfrag;
                if (tj > ti) { *(u32x2*)qkdst = (u32x2){0u, 0u}; *(LAS f32x4*)(Af + (16 * ti + r) * 64 + 16 * tj + 4 * q) = (f32x4){0.f, 0.f, 0.f, 0.f}; continue; }
                f32x4 p1 = (f32x4){0.f, 0.f, 0.f, 0.f}, p2 = p1;
#pragma unroll
                for (int ks = 0; ks < 4; ++ks) { p1 = MFMA16(kfr[tj][ks], kfr[ti][ks], p1); p2 = MFMA16(kfr[tj][ks], qfr[ti][ks], p2); }
                const int i = 16 * ti + r; f32x4 av, qv;
#pragma unroll
                for (int reg = 0; reg < 4; ++reg) { const int jx = 16 * tj + 4 * q + reg; const float gj = bperm(gcl, jx);
                    const float dec = (jx <= i) ? __expf(gi - gj) : 0.f;
                    av[reg] = (jx < i) ? bi * p1[reg] * dec : 0.f; qv[reg] = p2[reg] * dec; }
                *(LAS f32x4*)(Af + i * 64 + 16 * tj + 4 * q) = av;
                *(u32x2*)qkdst = pk4(qv[0], qv[1], qv[2], qv[3]);
                asm volatile("" ::: "memory");
            }
        }
        LDS_WAIT(); asm volatile("" ::: "memory");
#pragma unroll 1
        for (int i0 = 0; i0 < 64; i0 += 4) {
            float a0 = (i0 + 0 == lane) ? 1.0f : 0.0f, a1 = (i0 + 1 == lane) ? 1.0f : 0.0f, a2 = (i0 + 2 == lane) ? 1.0f : 0.0f, a3 = (i0 + 3 == lane) ? 1.0f : 0.0f;
#pragma unroll 2
            for (int j4 = 0; j4 < (i0 >> 2); ++j4) {
                const float t0 = Af[(4 * j4 + 0) * 64 + lane], t1 = Af[(4 * j4 + 1) * 64 + lane], t2 = Af[(4 * j4 + 2) * 64 + lane], t3 = Af[(4 * j4 + 3) * 64 + lane];
                const f32x4 r0 = *(const LAS f32x4*)(Af + (i0 + 0) * 64 + 4 * j4), r1 = *(const LAS f32x4*)(Af + (i0 + 1) * 64 + 4 * j4);
                const f32x4 r2 = *(const LAS f32x4*)(Af + (i0 + 2) * 64 + 4 * j4), r3 = *(const LAS f32x4*)(Af + (i0 + 3) * 64 + 4 * j4);
                a0 -= r0[0] * t0 + r0[1] * t1 + r0[2] * t2 + r0[3] * t3; a1 -= r1[0] * t0 + r1[1] * t1 + r1[2] * t2 + r1[3] * t3;
                a2 -= r2[0] * t0 + r2[1] * t1 + r2[2] * t2 + r2[3] * t3; a3 -= r3[0] * t0 + r3[1] * t1 + r3[2] * t2 + r3[3] * t3;
            }
            const f32x4 d1 = *(const LAS f32x4*)(Af + (i0 + 1) * 64 + i0), d2 = *(const LAS f32x4*)(Af + (i0 + 2) * 64 + i0), d3 = *(const LAS f32x4*)(Af + (i0 + 3) * 64 + i0);
            a1 -= d1[0] * a0; a2 -= d2[0] * a0 + d2[1] * a1; a3 -= d3[0] * a0 + d3[1] * a1 + d3[2] * a2;
            LDS_WAIT(); asm volatile("" ::: "memory");
            Af[(i0 + 0) * 64 + lane] = a0; Af[(i0 + 1) * 64 + lane] = a1; Af[(i0 + 2) * 64 + lane] = a2; Af[(i0 + 3) * 64 + lane] = a3;
            LDS_WAIT(); asm volatile("" ::: "memory");
        }
        bf16x8 tuf[4][2], twf[4][2];
        {
            const float* gcp = GC + (size_t)bh * S_ + 64 * n; const float* gbp = GB + (size_t)bh * S_ + 64 * n;
#pragma unroll
            for (int ks = 0; ks < 2; ++ks) {
                float su[8], sw[8];
#pragma unroll
                for (int h4 = 0; h4 < 2; ++h4) { const f32x4 bv = *(const f32x4*)(gbp + 32 * ks + 8 * q + 4 * h4), gv = *(const f32x4*)(gcp + 32 * ks + 8 * q + 4 * h4);
#pragma unroll
                    for (int e = 0; e < 4; ++e) { su[4 * h4 + e] = bv[e]; sw[4 * h4 + e] = -bv[e] * __expf(gv[e]); } }
#pragma unroll
                for (int tm = 0; tm < 4; ++tm) {
                    const f32x4 x0 = *(const LAS f32x4*)(Af + (16 * tm + r) * 64 + 32 * ks + 8 * q), x1 = *(const LAS f32x4*)(Af + (16 * tm + r) * 64 + 32 * ks + 8 * q + 4);
                    tuf[tm][ks] = __builtin_bit_cast(bf16x8, (u32x4){cvtpk(x0[0] * su[0], x0[1] * su[1]), cvtpk(x0[2] * su[2], x0[3] * su[3]), cvtpk(x1[0] * su[4], x1[1] * su[5]), cvtpk(x1[2] * su[6], x1[3] * su[7])});
                    twf[tm][ks] = __builtin_bit_cast(bf16x8, (u32x4){cvtpk(x0[0] * sw[0], x0[1] * sw[1]), cvtpk(x0[2] * sw[2], x0[3] * sw[3]), cvtpk(x1[0] * sw[4], x1[1] * sw[5]), cvtpk(x1[2] * sw[6], x1[3] * sw[7])});
                }
            }
        }
        LDS_WAIT(); asm volatile("" ::: "memory");
        {
#pragma unroll
            for (int w8 = 0; w8 < 8; ++w8) {
                bf16x8 vb[2];
#pragma unroll
                for (int ks = 0; ks < 2; ++ks) vb[ks] = __builtin_nontemporal_load((const bf16x8*)(vt + ltr + (16 * w8 * 64 + 32 * ks) * 2));
#pragma unroll
                for (int tm = 0; tm < 4; ++tm) { f32x4 acc = (f32x4){0.f, 0.f, 0.f, 0.f};
#pragma unroll
                    for (int ks = 0; ks < 2; ++ks) acc = MFMA16(tuf[tm][ks], vb[ks], acc);
                    *(u32x2*)(ub + (unsigned)lane * 8u + ((w8 * 4 + tm) * 64) * 8) = pk4(acc[0], acc[1], acc[2], acc[3]); }
            }
        }
        {
#pragma unroll
            for (int a = 0; a < 8; ++a) {
                bf16x8 ka[2];
#pragma unroll
                for (int ks = 0; ks < 2; ++ks) ka[ks] = __builtin_nontemporal_load((const bf16x8*)(kt + ltr + (16 * a * 64 + 32 * ks) * 2));
#pragma unroll
                for (int ti = 0; ti < 4; ++ti) { f32x4 acc = (f32x4){0.f, 0.f, 0.f, 0.f};
#pragma unroll
                    for (int ks = 0; ks < 2; ++ks) acc = MFMA16(ka[ks], twf[ti][ks], acc);
                    *(u32x2*)(blob + (BLOB_W + ((ti * 4 + (a >> 1)) * 64) * 8 + 4 * (a & 1)) * 2 + lfrag) = pk4(acc[0], acc[1], acc[2], acc[3]); }
            }
        }
        LDS_WAIT(); asm volatile("" ::: "memory");
    }
}

constexpr int SCAN_BUF = BLOB_ELEMS * 2;
DI bf16x8 pack8(const f32x4& lo, const f32x4& hi) { return __builtin_bit_cast(bf16x8, (u32x4){cvtpk(lo[0], lo[1]), cvtpk(lo[2], lo[3]), cvtpk(hi[0], hi[1]), cvtpk(hi[2], hi[3])}); }
DI void ld16_asm(u32x4& dst, const char* sbase, unsigned voff) { asm volatile("global_load_dwordx4 %0, %1, %2" : "=v"(dst) : "v"(voff), "s"(sbase) : "memory"); }
#define SCAN_LOAD(RSET, chunk) do { const char* _cb = pg8::rfl_ptr(src + (size_t)(chunk) * SCAN_BUF); \
    _Pragma("unroll") for (int i = 0; i < 14; ++i) ld16_asm(RSET[i], pg8::rfl_ptr(_cb + i * 4096), ltid16); } while (0)
#define SCAN_PUT(RSET, BUF) do { _Pragma("unroll") for (int i = 0; i < 14; ++i) *(LAS u32x4*)(F.lds + (BUF) * SCAN_BUF + i * 4096 + ltid16) = RSET[i]; } while (0)
#define SCAN_LSTEP(n_, BUFN, RFREE, RNEXT) do { const int n = (n_); \
    if (n + 3 < 64) { SCAN_LOAD(RFREE, n + 3); asm volatile("s_waitcnt vmcnt(28)" ::: "memory"); } else { asm volatile("s_waitcnt vmcnt(0)" ::: "memory"); } \
    __builtin_amdgcn_sched_barrier(0); \
    if (n + 1 < 64) SCAN_PUT(RNEXT, BUFN); \
    asm volatile("s_waitcnt lgkmcnt(0)" ::: "memory"); __builtin_amdgcn_s_barrier(); asm volatile("" ::: "memory"); } while (0)
#define SCAN_CSTEP(n_, BUFC, UC) do { const int n = (n_); \
        const LAS unsigned char* buf = F.lds + (BUFC) * SCAN_BUF; \
        f32x4 vn[4]; \
        _Pragma("unroll") for (int tm = 0; tm < 4; ++tm) vn[tm] = (f32x4){bf_lo(UC[tm].x), bf_hi(UC[tm].x), bf_lo(UC[tm].y), bf_hi(UC[tm].y)}; \
        if (n + 2 < 64) { const char* u2 = pg8::rfl_ptr(ubase + (size_t)(n + 2) * 8192 * 2); _Pragma("unroll") for (int tm = 0; tm < 4; ++tm) UC[tm] = __builtin_nontemporal_load((const u32x2*)(u2 + lane8 + tm * 512)); } \
        if (n > 0) { char* op = (char*)pg8::rfl_ptr(obase + (size_t)(64 * (n - 1)) * D_ * 2); \
            _Pragma("unroll") for (int tm = 0; tm < 4; ++tm) _Pragma("unroll") for (int reg = 0; reg < 4; ++reg) *(bf16*)(op + olane + (16 * tm + reg) * D_ * 2) = (bf16)cvtpk(o[tm][reg], 0.f); } \
        const float glast = rdlane(gl_all, n); \
        bf16x8 sb[4]; \
        _Pragma("unroll") for (int ks = 0; ks < 4; ++ks) sb[ks] = pack8(S[2 * ks], S[2 * ks + 1]); \
          \
        bf16x8 fw[16], fq[16], fk[8], fd[16]; bf16x8 vb[2]; \
        _Pragma("unroll") for (int i = 0; i < 16; ++i) fw[i] = *(const LAS bf16x8*)(buf + BLOB_W * 2 + (i * 64 + lane) * 16); \
        __builtin_amdgcn_sched_barrier(0); \
        _Pragma("unroll") for (int i = 0; i < 16; ++i) fq[i] = *(const LAS bf16x8*)(buf + BLOB_QG * 2 + (i * 64 + lane) * 16); \
        __builtin_amdgcn_sched_barrier(0); \
        _Pragma("unroll") for (int tm = 0; tm < 4; ++tm) _Pragma("unroll") for (int ks = 0; ks < 4; ++ks) vn[tm] = MFMA16(fw[tm * 4 + ks], sb[ks], vn[tm]); \
        __builtin_amdgcn_sched_barrier(0); \
        _Pragma("unroll") for (int i = 0; i < 8; ++i) fk[i] = *(const LAS bf16x8*)(buf + BLOB_QK * 2 + (i * 64 + lane) * 16); \
        __builtin_amdgcn_sched_barrier(0); \
        _Pragma("unroll") for (int tm = 0; tm < 4; ++tm) { o[tm] = (f32x4){0.f, 0.f, 0.f, 0.f}; \
            _Pragma("unroll") for (int ks = 0; ks < 4; ++ks) o[tm] = MFMA16(fq[tm * 4 + ks], sb[ks], o[tm]); } \
        _Pragma("unroll") for (int k2 = 0; k2 < 2; ++k2) vb[k2] = pack8(vn[2 * k2], vn[2 * k2 + 1]); \
        __builtin_amdgcn_sched_barrier(0); \
        _Pragma("unroll") for (int i = 0; i < 16; ++i) fd[i] = *(const LAS bf16x8*)(buf + BLOB_KDT * 2 + (i * 64 + lane) * 16); \
        __builtin_amdgcn_sched_barrier(0); \
        _Pragma("unroll") for (int tm = 0; tm < 4; ++tm) _Pragma("unroll") for (int k2 = 0; k2 < 2; ++k2) o[tm] = MFMA16(fk[tm * 2 + k2], vb[k2], o[tm]); \
        __builtin_amdgcn_sched_barrier(0); \
        _Pragma("unroll") for (int a = 0; a < 8; ++a) { S[a] = S[a] * glast; \
            _Pragma("unroll") for (int k2 = 0; k2 < 2; ++k2) S[a] = MFMA16(fd[a * 2 + k2], vb[k2], S[a]); } \
    asm volatile("s_waitcnt lgkmcnt(0)" ::: "memory"); __builtin_amdgcn_s_barrier(); asm volatile("" ::: "memory"); } while (0)

DI void gdn_scan2_phase(const Frame& F, const Args& A) {
    unsigned char* ws = opq(A.ws); unsigned char* big = ws + WS_BIG;
    const bf16* BLOB = (const bf16*)(big + GB_BLOB); const float* U = (const float*)(ws + WS_HID); bf16* Oraw = (bf16*)(ws + WS_Y);
    const float* GC = (const float*)(ws + WS_GALPHA);
    const int lane = F.lane, r = lane & 15, q = lane >> 4, w = F.wave;
    for (int it2 = F.bid; it2 < NB_ * 8 * 2; it2 += F.G) {
        const int item = it2 >> 1, half = it2 & 1, b = item >> 3, hh = item & 7, dvw = 4 * half + (w & 3);
        const char* src = pg8::rfl_ptr((const char*)(BLOB + (size_t)item * 64 * BLOB_ELEMS));
        __syncthreads();
        if (w >= 4) {
            const unsigned ltid16 = (unsigned)((w & 3) * 64 + lane) * 16u;
            u32x4 r0[14], r1[14], r2[14];
            SCAN_LOAD(r0, 0); SCAN_LOAD(r1, 1); SCAN_LOAD(r2, 2); asm volatile("s_waitcnt vmcnt(28)" ::: "memory"); __builtin_amdgcn_sched_barrier(0); SCAN_PUT(r0, 0);
            asm volatile("s_waitcnt lgkmcnt(0)" ::: "memory"); __builtin_amdgcn_s_barrier(); asm volatile("" ::: "memory");
#pragma unroll 1
            for (int n6 = 0; n6 < 60; n6 += 6) {
                SCAN_LSTEP(n6 + 0, 1, r0, r1); SCAN_LSTEP(n6 + 1, 0, r1, r2); SCAN_LSTEP(n6 + 2, 1, r2, r0);
                SCAN_LSTEP(n6 + 3, 0, r0, r1); SCAN_LSTEP(n6 + 4, 1, r1, r2); SCAN_LSTEP(n6 + 5, 0, r2, r0);
            }
            SCAN_LSTEP(60, 1, r0, r1); SCAN_LSTEP(61, 0, r1, r2); SCAN_LSTEP(62, 1, r2, r0); SCAN_LSTEP(63, 0, r0, r1);
        } else {
            f32x4 S[8];
#pragma unroll
            for (int a = 0; a < 8; ++a) S[a] = (f32x4){0.f, 0.f, 0.f, 0.f};
            const char* ubase = pg8::rfl_ptr((const char*)((const bf16*)U + (size_t)item * 64 * 8192 + (size_t)(dvw * 4) * 256));
            const char* obase = pg8::rfl_ptr((const char*)(Oraw + (size_t)b * S_ * D_ + hh * 128 + 16 * dvw));
            const unsigned lane16 = (unsigned)lane * 16u, lane8 = (unsigned)lane * 8u, olane = (unsigned)((4 * q) * D_ + r) * 2u;
            const float gl_all = __expf(GC[(size_t)item * S_ + 64 * lane + 63]);
            u32x2 ua[4], ub[4]; f32x4 o[4];
#pragma unroll
            for (int tm = 0; tm < 4; ++tm) { ua[tm] = __builtin_nontemporal_load((const u32x2*)(ubase + lane8 + tm * 512)); ub[tm] = __builtin_nontemporal_load((const u32x2*)(ubase + 8192 * 2 + lane8 + tm * 512)); o[tm] = (f32x4){0.f, 0.f, 0.f, 0.f}; }
            asm volatile("s_waitcnt lgkmcnt(0)" ::: "memory"); __builtin_amdgcn_s_barrier(); asm volatile("" ::: "memory");
#pragma unroll 1
            for (int n2 = 0; n2 < 64; n2 += 2) { SCAN_CSTEP(n2, 0, ua); SCAN_CSTEP(n2 + 1, 1, ub); }
            { char* op = (char*)obase + (size_t)(64 * 63) * D_ * 2;
#pragma unroll
              for (int tm = 0; tm < 4; ++tm)
#pragma unroll
                  for (int reg = 0; reg < 4; ++reg) *(bf16*)(op + olane + (16 * tm + reg) * D_ * 2) = (bf16)cvtpk(o[tm][reg], 0.f); }
        }
    }
}
#undef SCAN_LSTEP
#undef SCAN_CSTEP
#undef SCAN_LOAD
#undef SCAN_PUT
constexpr int N_PHASES = 42;
#ifndef MK_FUSED
#define MK_FUSED 1
#endif

#if MK_FUSED
typedef const __attribute__((address_space(4))) Args* CArgsP;
DI Args fresh_args() {
#if defined(__HIP_DEVICE_COMPILE__)
    CArgsP kp = (CArgsP)__builtin_amdgcn_kernarg_segment_ptr(); asm volatile("" : "+s"(kp)); Args a = *kp;
    a.x = asg(a.x); a.c = asg(a.c); a.pos = asg(a.pos); a.ada_w = asg(a.ada_w); a.ada_b = asg(a.ada_b); a.ln_g = asg(a.ln_g); a.ln_b = asg(a.ln_b);
    a.attn_w_in = asg(a.attn_w_in); a.attn_w_out = asg(a.attn_w_out); a.gdn_w_in = asg(a.gdn_w_in); a.gdn_conv_w = asg(a.gdn_conv_w); a.gdn_a_log = asg(a.gdn_a_log); a.gdn_dt_bias = asg(a.gdn_dt_bias);
    a.gdn_norm_w = asg(a.gdn_norm_w); a.gdn_w_out = asg(a.gdn_w_out); a.router_w = asg(a.router_w); a.router_bias = asg(a.router_bias); a.ew1 = asg(a.ew1); a.ew3 = asg(a.ew3); a.ew2 = asg(a.ew2);
    a.sw1 = asg(a.sw1); a.sw3 = asg(a.sw3); a.sw2 = asg(a.sw2); a.out = asg(a.out); a.ws = asg(a.ws);
    return a;
#else
    return Args{};
#endif
}
DI Frame fresh_frame(int wave_s) { Frame F; int g = gridDim.x; asm volatile("" : "+s"(g)); int b = blockIdx.x; asm volatile("" : "+s"(b)); unsigned l = 0u; asm volatile("" : "+s"(l));
    int w = wave_s; asm volatile("" : "+s"(w)); int ln; asm volatile("v_mbcnt_lo_u32_b32 %0, -1, 0\n\tv_mbcnt_hi_u32_b32 %0, -1, %0" : "=&v"(ln));
    F.lds = (LAS unsigned char*)(size_t)l; F.tid = w * 64 + ln; F.lane = ln; F.wave = w; F.G = g; F.bid = b; return F; }
#define PHF() const Args A = fresh_args(); const Frame F = fresh_frame(wave_s); \
    unsigned char* ws = opq(A.ws); LAS int* idxlds = (LAS int*)(F.lds + LDS_IDX); const LAS int* tileoff = (const LAS int*)(F.lds + LDS_TILEOFF); (void)ws; (void)idxlds; (void)tileoff;
DI void ph_pro(const int wave_s) { PHF(); prologue_phase(F, A); convert_experts(F, A, 0, 0, 0, F.G); }
DI void ph_modx(const int wave_s) { PHF(); modx_phase(F, A); }
DI void ph_attn(const int wave_s) { PHF(); attn_phase(F, A); }
DI void ph_lnr(const int wave_s, int L) { PHF(); if (L == 0) ln_router_phase<true>(F, A, L); else ln_router_phase<false>(F, A, L); }
DI void ph_lnr_dry(const int wave_s, int L) { PHF(); if (L == 0) ln_router_phase<true>(F, A, L, true); else ln_router_phase<false>(F, A, L, true); }
DI void ph_scat(const int wave_s, int L) { PHF(); moe_scatter_phase(F, A, L); }
DI void ph_lnm(const int wave_s, int L) { PHF(); ln_moe_phase(F, A, L, nullptr); }
DI void ph_lnm_dry(const int wave_s, int L) { PHF(); ln_moe_phase(F, A, L, (float*)(ws + WS_Y)); }
DI void ph_gprep(const int wave_s, int lp) { PHF(); gdn_prep2_phase(F, A, lp); }
DI void ph_gwy(const int wave_s) { PHF(); gdn_wy_phase(F, A); }
DI void ph_gscan(const int wave_s, int L) { PHF(); gdn_scan2_phase(F, A); if (F.G > 128) { convert_experts(F, A, L, 0, 64, F.G - 64); if (L == 1) convert_experts(F, A, 2, 1, 64, F.G - 64); } else { convert_experts(F, A, L, 0, 0, F.G); if (L == 1) convert_experts(F, A, 2, 1, 0, F.G); } }
DI void ph_gpost(const int wave_s, int lp) { PHF(); gdn_post_phase(F, A, lp); }
DI void ph_gemm_qkv(const int wave_s, int lp) { PHF();
    pg8::DenseOrder S; S.init(WS_H, WS_WA_IN + (size_t)lp * 9216 * D_ * 2, T_, 9216, D_, F.G, F.bid);
    pg8::EpiQKV E{(bf16*)(ws + WS_BIG), (const float*)(ws + WS_COS), (const float*)(ws + WS_SIN)};
    pg8::gemm_phase<pg8::EpiQKV, pg8::DenseOrder, true, true>(F.tid, ws, F.lds, idxlds, D_, S, E); }
DI void ph_gemm_out(const int wave_s, int lp, int isg) { PHF();
    pg8::DenseOrder S; S.init(WS_O, (isg ? WS_WG_OUT : WS_WA_OUT) + (size_t)lp * D_ * D_ * 2, T_, D_, D_, F.G, F.bid);
    pg8::EpiBf16 E{(bf16*)(ws + WS_Y), D_};
    pg8::gemm_phase<pg8::EpiBf16, pg8::DenseOrder, true, true>(F.tid, ws, F.lds, idxlds, D_, S, E); }
DI void ph_gemm_gin(const int wave_s, int lp) { PHF();
    pg8::DenseOrder S; S.init(WS_H, WS_WG_IN + (size_t)lp * 4096 * D_ * 2, T_, 4096, D_, F.G, F.bid);
    pg8::EpiBf16 E{(bf16*)(ws + WS_BIG + BIG_PROJ), 4096};
    pg8::gemm_phase<pg8::EpiBf16, pg8::DenseOrder, true, true>(F.tid, ws, F.lds, idxlds, D_, S, E); }
DI void ph_moe1(const int wave_s, int L) { PHF();
    const unsigned* gcount = (const unsigned*)(ws + WS_CTL) + CW_CNT + L * 64;
    build_tileoff(F, gcount);
    pg8::MoeOrder<true> S; S.A = (unsigned)WS_H; S.Bt = (unsigned)(L == 2 ? WS_WEB : WS_WE1); S.K = D_; S.nct_log = 1; S.nunits = __builtin_amdgcn_readfirstlane(tileoff[65]) * 2; S.G = F.G; S.c = F.bid;
    S.idxoff = (unsigned)WS_ETOK; S.tileoff = tileoff; S.ecnt = (const LAS int*)(F.lds + LDS_ECNT); S.bstride = (unsigned)(512 * D_ * 2);
    pg8::EpiSwiGLU E{(bf16*)(ws + WS_HID)};
    pg8::gemm_phase<pg8::EpiSwiGLU, pg8::MoeOrder<true>, true, true>(F.tid, ws, F.lds, idxlds, D_, S, E); }
DI void ph_moe2(const int wave_s, int L) { PHF();
    const unsigned* gcount = (const unsigned*)(ws + WS_CTL) + CW_CNT + L * 64;
    (void)gcount;
    pg8::MoeOrder<false> S; S.A = (unsigned)WS_HID; S.Bt = (unsigned)(L == 2 ? WS_WEB + 65 * MiB : WS_WE2); S.K = 256; S.nct_log = 2; S.nunits = __builtin_amdgcn_readfirstlane(tileoff[(YS_BF16 && !YS_MERGED) ? 64 : 65]) * 4; S.G = F.G; S.c = F.bid;
    S.idxoff = (unsigned)WS_EW; S.tileoff = tileoff; S.ecnt = (const LAS int*)(F.lds + LDS_ECNT); S.bstride = (unsigned)(D_ * 256 * 2);
    pg8::EpiScale E{ws + WS_BIG, 256 * __builtin_amdgcn_readfirstlane(tileoff[64])};
    pg8::gemm_phase<pg8::EpiScale, pg8::MoeOrder<false>, false, false>(F.tid, ws, F.lds, idxlds, 256, S, E); }
DI void ph_moe2s(const int wave_s, int L) { PHF();
    __syncthreads();
    const size_t s0 = (size_t)(256 * __builtin_amdgcn_readfirstlane(((const LAS int*)(F.lds + LDS_TILEOFF))[64]));
    pg8::DenseOrder S; S.init(WS_HID + s0 * 256 * 2, (L == 2 ? WS_WEB + 65 * MiB : WS_WE2) + (size_t)NEXP * D_ * 256 * 2, T_, D_, 256, F.G, F.bid);
    pg8::EpiBf16 E{(bf16*)(ws + WS_BIG + WS_YS_OFF), D_};
    pg8::gemm_phase<pg8::EpiBf16, pg8::DenseOrder, false, false>(F.tid, ws, F.lds, idxlds, 256, S, E); }

DI void grid_bar(const int wave_s) { PHF(); XcdBarrier b; b.bar = (unsigned*)(ws + WS_CTL) + CW_BAR; volatile LAS unsigned* misc = (volatile LAS unsigned*)(F.lds + LDS_MISC); b.st = misc + 8;
    b.x = (unsigned)__builtin_amdgcn_readfirstlane((int)misc[10]); xcd_barrier(b, F.tid); }
__global__ void __launch_bounds__(NTHR, 2) mk_fwd(Args Ain) {
    extern __shared__ __attribute__((aligned(16))) unsigned char lds_raw[];
    LAS unsigned char* lds = (LAS unsigned char*)lds_raw;
    for (int u = threadIdx.x; u < (LDS_BYTES - RING_BYTES) / 4; u += NTHR) ((LAS unsigned*)(lds + RING_BYTES))[u] = 0u;
    __syncthreads();
    const int wave_s = __builtin_amdgcn_readfirstlane((int)threadIdx.x >> 6);
    { XcdBarrier bar = xcd_barrier_post((unsigned*)(Ain.ws + WS_CTL) + CW_BAR, (volatile LAS unsigned*)(lds + LDS_MISC) + 8);
      if (threadIdx.x == 0) ((volatile LAS unsigned*)(lds + LDS_MISC))[10] = bar.x; }
    __syncthreads();
#ifndef REP_BAR
#define REP_BAR 1
#define REP_PRO 1
#define REP_POST 1
#define REP_QKV 1
#define REP_OUT 1
#define REP_GIN 1
#define REP_M1 1
#define REP_M2 1
#define REP_LNM 1
#define REP_LNR 1
#endif
#define GBAR() do { for (int _b = 0; _b < REP_BAR; ++_b) grid_bar(wave_s); } while (0)
#ifndef REP_ATTN
#define REP_ATTN 1
#define REP_SCAN 1
#define REP_GEMM 1
#define REP_PREP 1
#define REP_CONV 1
#define REP_WY 1
#endif
    for (int r = 0; r < REP_PRO; ++r) { ph_pro(wave_s); GBAR(); }
    ph_modx(wave_s); GBAR();
#pragma unroll 1
    for (int L = 0; L < 4; ++L) {
        const int lp = L >> 1;
        if ((L & 1) == 0) { for (int r = 0; r < REP_QKV; ++r) { ph_gemm_qkv(wave_s, lp); GBAR(); } for (int r = 0; r < REP_ATTN; ++r) { ph_attn(wave_s); GBAR(); } for (int r = 0; r < REP_OUT; ++r) { ph_gemm_out(wave_s, lp, 0); GBAR(); } }
        else { for (int r = 0; r < REP_GIN; ++r) { ph_gemm_gin(wave_s, lp); GBAR(); } for (int r = 0; r < REP_PREP; ++r) { ph_gprep(wave_s, lp); GBAR(); } for (int r = 0; r < REP_WY; ++r) { ph_gwy(wave_s); GBAR(); } for (int r = 0; r < REP_SCAN; ++r) { ph_gscan(wave_s, L); GBAR(); } for (int r = 0; r < REP_POST; ++r) { ph_gpost(wave_s, lp); GBAR(); } for (int r = 0; r < REP_OUT; ++r) { ph_gemm_out(wave_s, lp, 1); GBAR(); } }
        for (int r = 1; r < REP_LNR; ++r) { ph_lnr_dry(wave_s, L); GBAR(); }
        ph_lnr(wave_s, L); GBAR();
        for (int r = 0; r < REP_M1; ++r) { ph_moe1(wave_s, L); GBAR(); }
        for (int r = 0; r < REP_M2; ++r) { ph_moe2(wave_s, L); if (YS_BF16 && !YS_MERGED) ph_moe2s(wave_s, L); GBAR(); }
        for (int r = 1; r < REP_LNM; ++r) { ph_lnm_dry(wave_s, L); GBAR(); }
        ph_lnm(wave_s, L); if (L < 3) GBAR();
    }
#undef GBAR
}
#else

#define MKF() extern __shared__ __attribute__((aligned(16))) unsigned char lds_raw[]; Frame F; F.lds = (LAS unsigned char*)lds_raw; F.tid = threadIdx.x; F.lane = F.tid & 63; \
    F.wave = __builtin_amdgcn_readfirstlane(F.tid >> 6); F.G = gridDim.x; F.bid = blockIdx.x; unsigned char* ws = opq(A.ws); LAS int* idxlds = (LAS int*)(F.lds + LDS_IDX); \
    const LAS int* tileoff = (const LAS int*)(F.lds + LDS_TILEOFF); (void)ws; (void)idxlds; (void)tileoff; \
    for (int u = F.tid; u < (LDS_BYTES - RING_BYTES) / 4; u += NTHR) ((LAS unsigned*)(F.lds + RING_BYTES))[u] = 0u; __syncthreads();
__global__ void __launch_bounds__(NTHR, 2) k_pro(Args A) { MKF(); prologue_phase(F, A); }
__global__ void __launch_bounds__(NTHR, 2) k_modx(Args A) { MKF(); modx_phase(F, A); }
__global__ void __launch_bounds__(NTHR, 2) k_attn(Args A) { MKF(); attn_phase(F, A); }
__global__ void __launch_bounds__(NTHR, 2) k_lnr(Args A) { MKF(); const int L = A.ph_lo; ln_router_phase<false>(F, A, L); }
__global__ void __launch_bounds__(NTHR, 2) k_scat(Args A) { MKF(); moe_scatter_phase(F, A, A.ph_lo); convert_experts(F, A, A.ph_lo); }
__global__ void __launch_bounds__(NTHR, 2) k_lnm(Args A) { MKF(); const int L = A.ph_lo; ln_moe_phase(F, A, L, nullptr); }
__global__ void __launch_bounds__(NTHR, 2) k_gprep(Args A) { MKF(); gdn_prep_phase(F, A, A.ph_lo); }
__global__ void __launch_bounds__(NTHR, 2) k_gscan(Args A) { MKF(); gdn_scan_phase(F, A); }
__global__ void __launch_bounds__(NTHR, 2) k_gpost(Args A) { MKF(); gdn_post_phase(F, A, A.ph_lo); }
__global__ void __launch_bounds__(NTHR, 2) k_gemm_qkv(Args A) { MKF(); const int lp = A.ph_lo;
    pg8::DenseOrder S; S.init(WS_H, WS_WA_IN + (size_t)lp * 9216 * D_ * 2, T_, 9216, D_, F.G, F.bid);
    pg8::EpiQKV E{(bf16*)(ws + WS_BIG), (const float*)(ws + WS_COS), (const float*)(ws + WS_SIN)};
    pg8::gemm_phase<pg8::EpiQKV, pg8::DenseOrder, true, true>(F.tid, ws, F.lds, idxlds, D_, S, E); }
__global__ void __launch_bounds__(NTHR, 2) k_gemm_out(Args A) { MKF(); const int lp = A.ph_lo >> 1, isg = A.ph_lo & 1;
    pg8::DenseOrder S; S.init(WS_O, (isg ? WS_WG_OUT : WS_WA_OUT) + (size_t)lp * D_ * D_ * 2, T_, D_, D_, F.G, F.bid);
    pg8::EpiF32 E{(float*)(ws + WS_Y), D_};
    pg8::gemm_phase<pg8::EpiF32, pg8::DenseOrder, true, true>(F.tid, ws, F.lds, idxlds, D_, S, E); }
__global__ void __launch_bounds__(NTHR, 2) k_gemm_gin(Args A) { MKF(); const int lp = A.ph_lo;
    pg8::DenseOrder S; S.init(WS_H, WS_WG_IN + (size_t)lp * 4096 * D_ * 2, T_, 4096, D_, F.G, F.bid);
    pg8::EpiBf16 E{(bf16*)(ws + WS_BIG + BIG_PROJ), 4096};
    pg8::gemm_phase<pg8::EpiBf16, pg8::DenseOrder, true, true>(F.tid, ws, F.lds, idxlds, D_, S, E); }
__global__ void __launch_bounds__(NTHR, 2) k_moe1(Args A) { MKF();
    const unsigned* gcount = (const unsigned*)(ws + WS_CTL) + CW_CNT + A.ph_lo * 64;
    build_tileoff(F, gcount);
    pg8::MoeOrder<true> S; S.A = (unsigned)WS_H; S.Bt = (unsigned)(L == 2 ? WS_WEB : WS_WE1); S.K = D_; S.nct_log = 1; S.nunits = __builtin_amdgcn_readfirstlane(tileoff[65]) * 2; S.G = F.G; S.c = F.bid;
    S.idxoff = (unsigned)WS_ETOK; S.tileoff = tileoff; S.ecnt = (const LAS int*)(F.lds + LDS_ECNT); S.bstride = (unsigned)(512 * D_ * 2);
    pg8::EpiSwiGLU E{(bf16*)(ws + WS_HID)};
    pg8::gemm_phase<pg8::EpiSwiGLU, pg8::MoeOrder<true>, true, true>(F.tid, ws, F.lds, idxlds, D_, S, E); }
__global__ void __launch_bounds__(NTHR, 2) k_moe2(Args A) { MKF();
    const unsigned* gcount = (const unsigned*)(ws + WS_CTL) + CW_CNT + A.ph_lo * 64;
    build_tileoff(F, gcount);
    pg8::MoeOrder<false> S; S.A = (unsigned)WS_HID; S.Bt = (unsigned)(L == 2 ? WS_WEB + 65 * MiB : WS_WE2); S.K = 256; S.nct_log = 2; S.nunits = __builtin_amdgcn_readfirstlane(tileoff[65]) * 4; S.G = F.G; S.c = F.bid;
    S.idxoff = (unsigned)WS_EW; S.tileoff = tileoff; S.ecnt = (const LAS int*)(F.lds + LDS_ECNT); S.bstride = (unsigned)(D_ * 256 * 2);
    pg8::EpiScale E{ws + WS_BIG, 256 * __builtin_amdgcn_readfirstlane(tileoff[64])};
    pg8::gemm_phase<pg8::EpiScale, pg8::MoeOrder<false>, false, false>(F.tid, ws, F.lds, idxlds, 256, S, E); }
#endif
extern "C" void kernel_launch(void* const* d_in, const int* in_sizes, int n_in, void* d_out, int out_size, void* d_ws, size_t ws_size, hipStream_t stream) {
    static int grid = 0;
    if (grid == 0) {
        if (n_in != 23 || in_sizes[0] != T_ * D_ || out_size != T_ * D_ || ws_size < WS_END) {
            fprintf(stderr, "kernel_launch: unexpected shapes (n_in %d, in0 %d, out %d, ws %zu < %zu); nothing launched\n", n_in, n_in > 0 ? in_sizes[0] : -1, out_size, ws_size, (size_t)WS_END); grid = -1; return; }
        int dev = 0, cus = 0, per_cu = 0;
        if (hipGetDevice(&dev) != hipSuccess || hipDeviceGetAttribute(&cus, hipDeviceAttributeMultiprocessorCount, dev) != hipSuccess) { grid = -1; return; }
#if MK_FUSED
        if (hipFuncSetAttribute((const void*)mk_fwd, hipFuncAttributeMaxDynamicSharedMemorySize, LDS_BYTES) != hipSuccess) { fprintf(stderr, "kernel_launch: hipFuncSetAttribute failed\n"); grid = -1; return; }
        if (hipOccupancyMaxActiveBlocksPerMultiprocessor(&per_cu, (const void*)mk_fwd, NTHR, LDS_BYTES) != hipSuccess || per_cu < 1)
            fprintf(stderr, "kernel_launch: note: occupancy query reports %d workgroups per CU\n", per_cu);
#else
        { const void* ks[] = {(const void*)k_pro, (const void*)k_modx, (const void*)k_attn, (const void*)k_lnr, (const void*)k_scat, (const void*)k_lnm, (const void*)k_gprep, (const void*)k_gscan, (const void*)k_gpost,
                              (const void*)k_gemm_qkv, (const void*)k_gemm_out, (const void*)k_gemm_gin, (const void*)k_moe1, (const void*)k_moe2};
          for (const void* k : ks) if (hipFuncSetAttribute(k, hipFuncAttributeMaxDynamicSharedMemorySize, LDS_BYTES) != hipSuccess) { fprintf(stderr, "kernel_launch: hipFuncSetAttribute failed\n"); grid = -1; return; } }
        (void)per_cu;
#endif
        (void)hipGetLastError();
        grid = cus;
    }
    if (grid < 0) return;
    (void)hipMemsetAsync((char*)d_ws + WS_CTL, 0, CTL_ZERO_BYTES, stream);
    Args a{};
    a.x = (const float*)d_in[0]; a.c = (const float*)d_in[1]; a.pos = (const int*)d_in[2]; a.ada_w = (const float*)d_in[3]; a.ada_b = (const float*)d_in[4];
    a.ln_g = (const float*)d_in[5]; a.ln_b = (const float*)d_in[6]; a.attn_w_in = (const float*)d_in[7]; a.attn_w_out = (const float*)d_in[8];
    a.gdn_w_in = (const float*)d_in[9]; a.gdn_conv_w = (const float*)d_in[10]; a.gdn_a_log = (const float*)d_in[11]; a.gdn_dt_bias = (const float*)d_in[12];
    a.gdn_norm_w = (const float*)d_in[13]; a.gdn_w_out = (const float*)d_in[14]; a.router_w = (const float*)d_in[15]; a.router_bias = (const float*)d_in[16];
    a.ew1 = (const float*)d_in[17]; a.ew3 = (const float*)d_in[18]; a.ew2 = (const float*)d_in[19]; a.sw1 = (const float*)d_in[20]; a.sw3 = (const float*)d_in[21]; a.sw2 = (const float*)d_in[22];
    a.out = (float*)d_out; a.ws = (unsigned char*)d_ws;
#if MK_FUSED
    a.ph_lo = 0; a.ph_hi = N_PHASES;
    hipLaunchKernelGGL(mk_fwd, dim3(grid), dim3(NTHR), LDS_BYTES, stream, a);
#else
#define LAUNCH(k, arg) do { a.ph_lo = (arg); a.ph_hi = (arg) + 1; hipLaunchKernelGGL(k, dim3(grid), dim3(NTHR), LDS_BYTES, stream, a); } while (0)
    LAUNCH(k_pro, 0); LAUNCH(k_modx, 0);
    for (int L = 0; L < 4; ++L) {
        const int lp = L >> 1;
        if ((L & 1) == 0) { LAUNCH(k_gemm_qkv, lp); LAUNCH(k_attn, 0); LAUNCH(k_gemm_out, 2 * lp); }
        else { LAUNCH(k_gemm_gin, lp); LAUNCH(k_gprep, lp); LAUNCH(k_gscan, 0); LAUNCH(k_gpost, lp); LAUNCH(k_gemm_out, 2 * lp + 1); }
        LAUNCH(k_lnr, L); LAUNCH(k_scat, L); LAUNCH(k_moe1, L); LAUNCH(k_moe2, L); LAUNCH(k_lnm, L);
    }
#undef LAUNCH
#endif
    const hipError_t le = hipPeekAtLastError();
    if (le != hipSuccess) fprintf(stderr, "kernel_launch: launch failed: %s\n", hipGetErrorName(le));
}
```
